# Optimizing an MI355X kernel written in HIP

```python
import math
import jax, jax.numpy as jnp
from jax import lax
import numpy as np

D_MODEL = 1024
BATCH = 16
SEQ = 256
DEPTH = 2
DEC_BATCH = 4
DEC_SEQ = 2048
PAST_LEN = 256

GRID_W = 64
N_DIR = 2
S5_WIDTH = D_MODEL // 2
S5_GROUP_CH = 16
S5_GROUPS = S5_WIDTH // S5_GROUP_CH
S5_STATE = 64
GLA_WIDTH = D_MODEL // 2
GLA_HEADS = 4
GLA_DV = GLA_WIDTH // GLA_HEADS
GLA_DK = GLA_DV // 2
GLA_KEY_WIDTH = GLA_HEADS * GLA_DK
GLA_GATE_RANK = 16
GLA_GATE_NORM = 16.0
GLA_CHUNK = 32
EPS = 1e-6
IN_WIDTHS = (S5_WIDTH, S5_WIDTH, GLA_KEY_WIDTH, GLA_KEY_WIDTH, GLA_WIDTH, GLA_WIDTH, GLA_GATE_RANK, D_MODEL, D_MODEL)
D_IN = sum(IN_WIDTHS)

kernel_name = 'hybrid_s5_gla_flow_step'


def rmsnorm(x, g):
    xf = x.astype(jnp.float32)
    y = xf * lax.rsqrt(jnp.mean(xf * xf, axis=-1, keepdims=True) + EPS)
    return (y * g.astype(jnp.float32)).astype(x.dtype)


def _split_points():
    pts, acc = [], 0
    for w in IN_WIDTHS[:-1]:
        acc += w
        pts.append(acc)
    return pts


def grid_pos_embed(length, dim, dtype):
    rows = length // GRID_W
    quarter = dim // 4
    freqs = jnp.exp(-math.log(10000.0) * jnp.arange(quarter, dtype=jnp.float32) / quarter)

    def sincos(pos):
        ang = pos.astype(jnp.float32)[:, None] * freqs[None, :]
        return jnp.concatenate([jnp.sin(ang), jnp.cos(ang)], axis=-1)

    er = sincos(jnp.arange(rows))
    ec = sincos(jnp.arange(GRID_W))
    pe = jnp.concatenate([jnp.broadcast_to(er[:, None, :], (rows, GRID_W, dim // 2)),
                          jnp.broadcast_to(ec[None, :, :], (rows, GRID_W, dim // 2))], axis=-1)
    return pe.reshape(rows * GRID_W, dim).astype(dtype)


def _lin_combine(e1, e2):
    a1, b1 = e1
    a2, b2 = e2
    return a2 * a1, a2 * b1 + b2


def s5_direction(u, lam_re, lam_im, log_dt, b_c, h0):
    lam = lax.complex(lam_re.astype(jnp.float32), lam_im.astype(jnp.float32))
    dt = jnp.exp(log_dt.astype(jnp.float32))[:, None]
    a_bar = jnp.exp(lam * dt)
    b_bar = ((a_bar - 1.0) / lam)[..., None] * b_c
    bu = jnp.einsum('gpc,blgc->blgp', b_bar, u.astype(jnp.complex64))
    bu = bu.at[:, 0].add(a_bar[None] * h0)
    a = jnp.broadcast_to(a_bar, bu.shape)
    _, h = lax.associative_scan(_lin_combine, (a, bu), axis=1)
    return h


def s5_branch(u, p, h0_re, h0_im):
    bsz, length, _ = u.shape
    uf = u.astype(jnp.float32).reshape(bsz, length, S5_GROUPS, S5_GROUP_CH)
    b_c = lax.complex(p['s5_b_re'].astype(jnp.float32), p['s5_b_im'].astype(jnp.float32))
    c_c = lax.complex(p['s5_c_re'].astype(jnp.float32), p['s5_c_im'].astype(jnp.float32))
    h0 = lax.complex(h0_re.astype(jnp.float32), h0_im.astype(jnp.float32))
    h_f = s5_direction(uf, p['s5_lam_re'][0], p['s5_lam_im'][0], p['s5_log_dt'][0], b_c, h0[:, 0])
    h_b = jnp.flip(s5_direction(jnp.flip(uf, 1), p['s5_lam_re'][1], p['s5_lam_im'][1],
                                p['s5_log_dt'][1], b_c, h0[:, 1]), 1)
    y = jnp.einsum('gcp,blgp->blgc', c_c, h_f + h_b).real.reshape(bsz, length, S5_WIDTH)
    y = y + p['s5_d'].astype(jnp.float32) * uf.reshape(bsz, length, S5_WIDTH)
    y = jax.nn.gelu(y).astype(u.dtype)
    y = y * jax.nn.sigmoid(y @ p['w_glu'] + p['b_glu'])
    h_final = jnp.stack([h_f[:, -1], h_b[:, 0]], axis=1)
    return y, h_final.real, h_final.imag


def gla_chunked(q, k, v, g, s0):
    bsz, length, nh, dk = q.shape
    dv = v.shape[-1]
    n = length // GLA_CHUNK
    q = q.astype(jnp.float32).reshape(bsz, n, GLA_CHUNK, nh, dk)
    k = k.astype(jnp.float32).reshape(bsz, n, GLA_CHUNK, nh, dk)
    v = v.astype(jnp.float32).reshape(bsz, n, GLA_CHUNK, nh, dv)
    g = g.astype(jnp.float32).reshape(bsz, n, GLA_CHUNK, nh, dk)
    b = jnp.cumsum(g, axis=2)
    b_last = b[:, :, -1]
    causal = jnp.tril(jnp.ones((GLA_CHUNK, GLA_CHUNK), dtype=bool))[None, None, :, :, None, None]
    diff = b[:, :, :, None] - b[:, :, None, :]
    decay = jnp.exp(jnp.where(causal, diff, -jnp.inf))
    scores = jnp.einsum('bnihd,bnijhd,bnjhd->bnhij', q, decay, k)
    o_intra = jnp.einsum('bnhij,bnjhe->bnihe', scores, v)
    k_to_end = k * jnp.exp(b_last[:, :, None] - b)
    u_chunk = jnp.einsum('bnjhd,bnjhe->bnhde', k_to_end, v)
    a_chunk = jnp.exp(b_last)

    def step(s, inp):
        a_c, u_c = inp
        return a_c[..., None] * s + u_c, s

    s_final, s_start = lax.scan(step, s0.astype(jnp.float32),
                                (jnp.moveaxis(a_chunk, 1, 0), jnp.moveaxis(u_chunk, 1, 0)))
    s_start = jnp.moveaxis(s_start, 0, 1)
    o_inter = jnp.einsum('bnihd,bnhde->bnihe', q * jnp.exp(b), s_start)
    o = (o_intra + o_inter).reshape(bsz, length, nh, dv)
    return o, s_final


def gla_branch(q_in, k_in, v_in, g_low, p, s0):
    bsz, length, _ = q_in.shape
    q = q_in.reshape(bsz, length, GLA_HEADS, GLA_DK) * (GLA_DK ** -0.5)
    k = k_in.reshape(bsz, length, GLA_HEADS, GLA_DK)
    v = v_in.reshape(bsz, length, GLA_HEADS, GLA_DV)

    def log_decay(d):
        logits = (g_low @ p['gla_wg_up'][d] + p['gla_bg'][d]).astype(jnp.float32)
        return (jax.nn.log_sigmoid(logits) / GLA_GATE_NORM).reshape(bsz, length, GLA_HEADS, GLA_DK)

    o_f, s_f = gla_chunked(q, k, v, log_decay(0), s0[:, 0])
    o_b, s_b = gla_chunked(jnp.flip(q, 1), jnp.flip(k, 1), jnp.flip(v, 1), jnp.flip(log_decay(1), 1), s0[:, 1])
    o = o_f + jnp.flip(o_b, 1)
    o = rmsnorm(o, p['gla_norm_g'].reshape(GLA_HEADS, GLA_DV)).reshape(bsz, length, GLA_WIDTH)
    return o.astype(q_in.dtype), jnp.stack([s_f, s_b], axis=1)


def trunk_layer(x, cond, p, s5_re0, s5_im0, gla0):
    mod = jax.nn.silu(cond) @ p['w_mod'] + p['b_mod']
    shift, scale, gate = jnp.split(mod[:, None, :], 3, axis=-1)
    h = rmsnorm(x, p['norm_g']) * (1.0 + scale) + shift
    proj = h @ p['w_in']
    u_a, gate_a, q, k, v, gate_b, g_low, m_a, m_b = jnp.split(proj, _split_points(), axis=-1)
    y_a, s5_re, s5_im = s5_branch(u_a, p, s5_re0, s5_im0)
    y_a = y_a * jax.nn.silu(gate_a)
    y_b, gla_s = gla_branch(q, k, v, g_low, p, gla0)
    y_b = y_b * jax.nn.silu(gate_b)
    merged = jax.nn.sigmoid(m_a) * (y_a @ p['w_pa']) + jax.nn.sigmoid(m_b) * (y_b @ p['w_pb'])
    x = x + gate * (merged @ p['w_o'])
    return x, s5_re, s5_im, gla_s


def setup_inputs(seed: int = 0) -> dict:
    key = jax.random.key(seed)
    ks = jax.random.split(key, 32)
    nrm = lambda i, shape, s=1.0: s * jax.random.normal(ks[i], shape, jnp.float32)
    d = D_MODEL
    lam_im_base = math.pi * jnp.arange(S5_STATE, dtype=jnp.float32)
    return {
        'x_prompt': nrm(0, (BATCH, SEQ, d)),
        'x_sample': nrm(1, (DEC_BATCH, DEC_SEQ, d)),
        'c': nrm(2, (DEC_BATCH, d)),
        'state_s5_re': nrm(3, (DEC_BATCH, DEPTH, N_DIR, S5_GROUPS, S5_STATE), 0.3),
        'state_s5_im': nrm(4, (DEC_BATCH, DEPTH, N_DIR, S5_GROUPS, S5_STATE), 0.3),
        'state_gla': nrm(5, (DEC_BATCH, DEPTH, N_DIR, GLA_HEADS, GLA_DK, GLA_DV), 0.3),
        'c_ctx': nrm(6, (d,)),
        'norm_g': 1.0 + nrm(7, (DEPTH, d), 0.02),
        'w_mod': nrm(8, (DEPTH, d, 3 * d), d ** -0.5),
        'b_mod': nrm(9, (DEPTH, 3 * d), 0.02),
        'w_in': nrm(10, (DEPTH, d, D_IN), d ** -0.5),
        'gla_wg_up': nrm(11, (DEPTH, N_DIR, GLA_GATE_RANK, GLA_KEY_WIDTH), GLA_GATE_RANK ** -0.5),
        'gla_bg': nrm(12, (DEPTH, N_DIR, GLA_KEY_WIDTH), 0.1),
        'gla_norm_g': 1.0 + nrm(13, (DEPTH, GLA_WIDTH), 0.02),
        's5_lam_re': -0.5 + nrm(14, (DEPTH, N_DIR, S5_GROUPS, S5_STATE), 0.01),
        's5_lam_im': lam_im_base + nrm(15, (DEPTH, N_DIR, S5_GROUPS, S5_STATE), 0.01),
        's5_log_dt': jax.random.uniform(ks[16], (DEPTH, N_DIR, S5_GROUPS), jnp.float32,
                                        math.log(1e-3), math.log(1e-1)),
        's5_b_re': nrm(17, (DEPTH, S5_GROUPS, S5_STATE, S5_GROUP_CH), (2 * S5_GROUP_CH) ** -0.5),
        's5_b_im': nrm(18, (DEPTH, S5_GROUPS, S5_STATE, S5_GROUP_CH), (2 * S5_GROUP_CH) ** -0.5),
        's5_c_re': nrm(19, (DEPTH, S5_GROUPS, S5_GROUP_CH, S5_STATE), S5_STATE ** -0.5),
        's5_c_im': nrm(20, (DEPTH, S5_GROUPS, S5_GROUP_CH, S5_STATE), S5_STATE ** -0.5),
        's5_d': nrm(21, (DEPTH, S5_WIDTH)),
        'w_glu': nrm(22, (DEPTH, S5_WIDTH, S5_WIDTH), S5_WIDTH ** -0.5),
        'b_glu': nrm(23, (DEPTH, S5_WIDTH), 0.02),
        'w_pa': nrm(24, (DEPTH, S5_WIDTH, d), S5_WIDTH ** -0.5),
        'w_pb': nrm(25, (DEPTH, GLA_WIDTH, d), GLA_WIDTH ** -0.5),
        'w_o': nrm(26, (DEPTH, d, d), d ** -0.5),
        'final_norm_g': 1.0 + nrm(27, (d,), 0.02),
    }


def reference(x_prompt, x_sample, c, state_s5_re, state_s5_im, state_gla, c_ctx, norm_g, w_mod, b_mod,
              w_in, gla_wg_up, gla_bg, gla_norm_g, s5_lam_re, s5_lam_im, s5_log_dt, s5_b_re, s5_b_im,
              s5_c_re, s5_c_im, s5_d, w_glu, b_glu, w_pa, w_pb, w_o, final_norm_g):
    bp = x_prompt.shape[0]
    xp = x_prompt
    xs = x_sample + grid_pos_embed(x_sample.shape[1], D_MODEL, x_sample.dtype)[None]
    zero_s5 = jnp.zeros((bp, N_DIR, S5_GROUPS, S5_STATE), jnp.float32)
    zero_gla = jnp.zeros((bp, N_DIR, GLA_HEADS, GLA_DK, GLA_DV), jnp.float32)
    cond_ctx = c_ctx[None]
    new_re, new_im, new_gla = [], [], []
    for l in range(DEPTH):
        p = {'norm_g': norm_g[l], 'w_mod': w_mod[l], 'b_mod': b_mod[l], 'w_in': w_in[l],
             'gla_wg_up': gla_wg_up[l], 'gla_bg': gla_bg[l], 'gla_norm_g': gla_norm_g[l],
             's5_lam_re': s5_lam_re[l], 's5_lam_im': s5_lam_im[l], 's5_log_dt': s5_log_dt[l],
             's5_b_re': s5_b_re[l], 's5_b_im': s5_b_im[l], 's5_c_re': s5_c_re[l], 's5_c_im': s5_c_im[l],
             's5_d': s5_d[l], 'w_glu': w_glu[l], 'b_glu': b_glu[l], 'w_pa': w_pa[l], 'w_pb': w_pb[l],
             'w_o': w_o[l]}
        xp, re_l, im_l, gla_l = trunk_layer(xp, cond_ctx, p, zero_s5, zero_s5, zero_gla)
        new_re.append(re_l)
        new_im.append(im_l)
        new_gla.append(gla_l)
        xs, _, _, _ = trunk_layer(xs, c, p, state_s5_re[:, l], state_s5_im[:, l], state_gla[:, l])
    y_prompt = rmsnorm(xp, final_norm_g)
    y_sample = rmsnorm(xs, final_norm_g)
    new_s5_re = jnp.stack(new_re, axis=1).astype(x_prompt.dtype)
    new_s5_im = jnp.stack(new_im, axis=1).astype(x_prompt.dtype)
    new_gla_state = jnp.stack(new_gla, axis=1).astype(x_prompt.dtype)
    return (y_prompt, y_sample, new_s5_re, new_s5_im, new_gla_state)
```

```cpp
#include <hip/hip_runtime.h>
#include <hip/hip_cooperative_groups.h>
#include <stdint.h>
#include <math.h>
#include <stdio.h>
namespace cg = cooperative_groups;

#ifndef ONE_LAUNCH
#define ONE_LAUNCH 0
#endif

typedef unsigned short bfu;
typedef __attribute__((ext_vector_type(8))) short bf16x8;
typedef __attribute__((ext_vector_type(16))) float f32x16;
typedef __attribute__((ext_vector_type(2))) __bf16 bf2_t;
typedef __attribute__((ext_vector_type(2))) float f2_t;

#define DI __device__ __forceinline__

constexpr int D = 1024;
constexpr int NTOK = 12288;
constexpr int NPROMPT = 4096;
constexpr int DIN = 4624;
constexpr int DINP = 4736;
constexpr int OFF_GA = 512, OFF_Q = 1024, OFF_K = 1280, OFF_V = 1536, OFF_GB = 2048, OFF_GL = 2560,
              OFF_MA = 2576, OFF_MB = 3600;
constexpr size_t OUT_RE = (size_t)NTOK * D;
constexpr size_t OUT_IM = OUT_RE + 131072;
constexpr size_t OUT_GLA = OUT_IM + 131072;
constexpr float EPS = 1e-6f;

struct Params {
  const float *x_prompt, *x_sample, *c, *st_re, *st_im, *st_gla, *c_ctx, *norm_g, *w_mod, *b_mod, *w_in,
      *wg_up, *bg, *gla_norm_g, *lam_re, *lam_im, *log_dt, *b_re, *b_im, *c_re, *c_im, *s5_d, *w_glu,
      *b_glu, *w_pa, *w_pb, *w_o, *final_g;
  float* out;
  bfu *w_inT, *w_gluT, *w_paT, *w_pbT, *w_oT;
  float *mod, *pos_r, *pos_c, *tmp_s5, *tmp_gla;
  bfu *h, *proj, *ys5, *ya, *yb, *merged;
};

DI int tid_() { int t = threadIdx.x; asm volatile("" : "+v"(t)); return t; }
DI float bf2f(bfu v) { return __uint_as_float(((unsigned)v) << 16); }
DI bfu f2bf(float x) { __bf16 b = (__bf16)x; return __builtin_bit_cast(unsigned short, b); }
DI unsigned pack2(float lo, float hi) {
  f2_t v = {lo, hi};
  bf2_t w = __builtin_convertvector(v, bf2_t);
  return __builtin_bit_cast(unsigned, w);
}
DI float sigmoidf_(float x) { return 1.f / (1.f + __expf(-x)); }
DI float siluf_(float x) { return x / (1.f + __expf(-x)); }
DI float geluf_(float x) {
  float u = 0.7978845608028654f * (x + 0.044715f * x * x * x);
  float t = 1.f - 2.f / (__expf(2.f * u) + 1.f);
  return 0.5f * x * (1.f + t);
}
DI float wave_sum(float v) {
#pragma unroll
  for (int o = 32; o >= 1; o >>= 1) v += __shfl_xor(v, o);
  return v;
}
DI int cond_of_tok(int tok) { return tok < NPROMPT ? 0 : 1 + ((tok - NPROMPT) >> 11); }

DI void transpose_tile(const float* __restrict__ src, int K, int N, bfu* __restrict__ dst, int kt, int nt,
                       float* sm) {
  const int tid = tid_(), c = tid & 63, r4 = tid >> 6;
  const int k0 = kt * 64, n0 = nt * 64;
#pragma unroll 4
  for (int i = 0; i < 16; ++i) {
    int k = i * 4 + r4, n = n0 + c;
    sm[k * 65 + c] = (n < N) ? src[(size_t)(k0 + k) * N + n] : 0.f;
  }
  __syncthreads();
#pragma unroll 4
  for (int i = 0; i < 16; ++i) {
    int n = i * 4 + r4;
    dst[(size_t)(n0 + n) * K + k0 + c] = f2bf(sm[c * 65 + n]);
  }
  __syncthreads();
}

DI void phase_prep(const Params& p, char* smem) {
  float* sm = (float*)smem;
  const int tid = tid_();
  for (int it = blockIdx.x; it < 96; it += gridDim.x) {
    const int l = it / 48, jb = it % 48;
    float* ssil = sm;
    float* sred = sm + 5 * 1024;
    for (int idx = tid; idx < 5120; idx += 256) {
      int ci = idx >> 10, k = idx & 1023;
      float cv = (ci == 0) ? p.c_ctx[k] : p.c[(ci - 1) * 1024 + k];
      ssil[idx] = cv / (1.f + expf(-cv));
    }
    __syncthreads();
    const int jj = tid & 63, kq = tid >> 6;
    const int j = jb * 64 + jj;
    float acc[5] = {0.f, 0.f, 0.f, 0.f, 0.f};
    const float* wp = p.w_mod + ((size_t)l * 1024 + kq * 256) * 3072 + j;
#pragma unroll 8
    for (int k = 0; k < 256; ++k) {
      float w = wp[(size_t)k * 3072];
#pragma unroll
      for (int ci = 0; ci < 5; ++ci) acc[ci] += ssil[ci * 1024 + kq * 256 + k] * w;
    }
#pragma unroll
    for (int ci = 0; ci < 5; ++ci) sred[(kq * 5 + ci) * 64 + jj] = acc[ci];
    __syncthreads();
    for (int idx = tid; idx < 320; idx += 256) {
      int ci = idx >> 6, j2 = idx & 63;
      float s = p.b_mod[l * 3072 + jb * 64 + j2];
#pragma unroll
      for (int q = 0; q < 4; ++q) s += sred[(q * 5 + ci) * 64 + j2];
      p.mod[(size_t)(l * 5 + ci) * 3072 + jb * 64 + j2] = s;
    }
    __syncthreads();
  }
  for (int idx = blockIdx.x * 256 + tid; idx < 96 * 512; idx += gridDim.x * 256) {
    int r = idx >> 9, i = idx & 511;
    int pos = r < 32 ? r : r - 32;
    int q = i & 255;
    double f = exp(-log(10000.0) * (double)q / 256.0);
    double ang = (double)pos * f;
    float v = (float)((i < 256) ? sin(ang) : cos(ang));
    if (r < 32) p.pos_r[r * 512 + i] = v; else p.pos_c[(r - 32) * 512 + i] = v;
  }
  for (int it = blockIdx.x; it < 3520; it += gridDim.x) {
    int l = it / 1760, r = it % 1760;
    if (r < 1184) {
      transpose_tile(p.w_in + (size_t)l * 1024 * DIN, 1024, DIN, p.w_inT + (size_t)l * DINP * 1024, r % 16, r / 16, sm);
    } else if (r < 1248) {
      r -= 1184;
      transpose_tile(p.w_glu + (size_t)l * 512 * 512, 512, 512, p.w_gluT + (size_t)l * 512 * 512, r % 8, r / 8, sm);
    } else if (r < 1376) {
      r -= 1248;
      transpose_tile(p.w_pa + (size_t)l * 512 * 1024, 512, 1024, p.w_paT + (size_t)l * 1024 * 512, r % 8, r / 8, sm);
    } else if (r < 1504) {
      r -= 1376;
      transpose_tile(p.w_pb + (size_t)l * 512 * 1024, 512, 1024, p.w_pbT + (size_t)l * 1024 * 512, r % 8, r / 8, sm);
    } else {
      r -= 1504;
      transpose_tile(p.w_o + (size_t)l * 1024 * 1024, 1024, 1024, p.w_oT + (size_t)l * 1024 * 1024, r % 16, r / 16, sm);
    }
  }
}

DI void phase_h(const Params& p, int l) {
  const int tid = tid_(), lane = tid & 63, w = tid >> 6;
  for (int it = blockIdx.x; it < NTOK / 4; it += gridDim.x) {
    const int tok = it * 4 + w;
    float4 v[4];
    float* xs = p.out + (size_t)tok * D;
    if (l == 0) {
      const float* src = tok < NPROMPT ? p.x_prompt + (size_t)tok * D : p.x_sample + (size_t)(tok - NPROMPT) * D;
#pragma unroll
      for (int i = 0; i < 4; ++i) v[i] = *(const float4*)(src + lane * 4 + 256 * i);
      if (tok >= NPROMPT) {
        int t = (tok - NPROMPT) & 2047, row = t >> 6, col = t & 63;
#pragma unroll
        for (int i = 0; i < 4; ++i) {
          int d = lane * 4 + 256 * i;
          const float* pe = d < 512 ? p.pos_r + row * 512 + d : p.pos_c + col * 512 + (d - 512);
          float4 e = *(const float4*)pe;
          v[i].x += e.x; v[i].y += e.y; v[i].z += e.z; v[i].w += e.w;
        }
      }
#pragma unroll
      for (int i = 0; i < 4; ++i) *(float4*)(xs + lane * 4 + 256 * i) = v[i];
    } else {
#pragma unroll
      for (int i = 0; i < 4; ++i) v[i] = *(const float4*)(xs + lane * 4 + 256 * i);
    }
    float ss = 0.f;
#pragma unroll
    for (int i = 0; i < 4; ++i) ss += v[i].x * v[i].x + v[i].y * v[i].y + v[i].z * v[i].z + v[i].w * v[i].w;
    ss = wave_sum(ss);
    const float rstd = rsqrtf(ss * (1.f / 1024.f) + EPS);
    const float* md = p.mod + (size_t)(l * 5 + cond_of_tok(tok)) * 3072;
    const float* ng = p.norm_g + l * 1024;
#pragma unroll
    for (int i = 0; i < 4; ++i) {
      int d = lane * 4 + 256 * i;
      float4 g = *(const float4*)(ng + d);
      float4 sh = *(const float4*)(md + d);
      float4 sc = *(const float4*)(md + 1024 + d);
      float a0 = v[i].x * rstd * g.x * (1.f + sc.x) + sh.x;
      float a1 = v[i].y * rstd * g.y * (1.f + sc.y) + sh.y;
      float a2 = v[i].z * rstd * g.z * (1.f + sc.z) + sh.z;
      float a3 = v[i].w * rstd * g.w * (1.f + sc.w) + sh.w;
      uint2 o; o.x = pack2(a0, a1); o.y = pack2(a2, a3);
      *(uint2*)(p.h + (size_t)tok * D + d) = o;
    }
  }
}

DI void gemm_core(const bfu* __restrict__ A, int lda, const bfu* __restrict__ B, int ldb, int K, char* smem,
                  f32x16 (&acc)[2][2]) {
  const int tid = tid_(), lane = tid & 63, w = tid >> 6, wm = w >> 1, wn = w & 1;
  const int c8 = tid & 7, r0 = tid >> 3;
  const bfu* ga = A + (size_t)r0 * lda + c8 * 8;
  const bfu* gb = B + (size_t)r0 * ldb + c8 * 8;
  const int st_off = r0 * 128 + ((c8 ^ ((r0 >> 1) & 7)) * 16);
  const int fr = lane & 31, hh = lane >> 5, fsw = (fr >> 1) & 7;
  const int a_base = (wm * 64 + fr) * 128;
  const int b_base = 16384 + (wn * 64 + fr) * 128;
  uint4 ra[4], rb[4];
#pragma unroll
  for (int i = 0; i < 4; ++i) {
    ra[i] = *(const uint4*)(ga + (size_t)i * 32 * lda);
    rb[i] = *(const uint4*)(gb + (size_t)i * 32 * ldb);
  }
#pragma unroll
  for (int i = 0; i < 4; ++i) {
    *(uint4*)(smem + st_off + i * 4096) = ra[i];
    *(uint4*)(smem + 16384 + st_off + i * 4096) = rb[i];
  }
  __syncthreads();
  const int KT = K >> 6;
#define GEMM_COMPUTE(cur)                                                                  \
  _Pragma("unroll") for (int s = 0; s < 4; ++s) {                                          \
    const int co = ((2 * s + hh) ^ fsw) * 16;                                              \
    bf16x8 a0 = *(const bf16x8*)((cur) + a_base + co);                                     \
    bf16x8 a1 = *(const bf16x8*)((cur) + a_base + 4096 + co);                              \
    bf16x8 b0 = *(const bf16x8*)((cur) + b_base + co);                                     \
    bf16x8 b1 = *(const bf16x8*)((cur) + b_base + 4096 + co);                              \
    acc[0][0] = __builtin_amdgcn_mfma_f32_32x32x16_bf16(a0, b0, acc[0][0], 0, 0, 0);       \
    acc[0][1] = __builtin_amdgcn_mfma_f32_32x32x16_bf16(a0, b1, acc[0][1], 0, 0, 0);       \
    acc[1][0] = __builtin_amdgcn_mfma_f32_32x32x16_bf16(a1, b0, acc[1][0], 0, 0, 0);       \
    acc[1][1] = __builtin_amdgcn_mfma_f32_32x32x16_bf16(a1, b1, acc[1][1], 0, 0, 0);       \
  }
#define GEMM_LOAD()                                                                        \
  _Pragma("unroll") for (int i = 0; i < 4; ++i) {                                          \
    ra[i] = *(const uint4*)(ga + (size_t)i * 32 * lda);                                    \
    rb[i] = *(const uint4*)(gb + (size_t)i * 32 * ldb);                                    \
  }
#define GEMM_STORE(buf)                                                                    \
  _Pragma("unroll") for (int i = 0; i < 4; ++i) {                                          \
    *(uint4*)((buf) + st_off + i * 4096) = ra[i];                                          \
    *(uint4*)((buf) + 16384 + st_off + i * 4096) = rb[i];                                  \
  }
#pragma unroll 1
  for (int kt = 0; kt < KT; kt += 2) {
    ga += 64; gb += 64;
    GEMM_LOAD()
    GEMM_COMPUTE(smem)
    GEMM_STORE(smem + 32768)
    __syncthreads();
    const int adv = (kt + 2 < KT) ? 64 : 0;
    ga += adv; gb += adv;
    GEMM_LOAD()
    GEMM_COMPUTE(smem + 32768)
    GEMM_STORE(smem)
    __syncthreads();
  }
}

DI void acc_zero(f32x16 (&acc)[2][2]) {
#pragma unroll
  for (int i = 0; i < 2; ++i)
#pragma unroll
    for (int j = 0; j < 2; ++j)
#pragma unroll
      for (int r = 0; r < 16; ++r) acc[i][j][r] = 0.f;
}

DI void acc_to_lds(const f32x16 (&acc)[2][2], char* smem) {
  float* sf = (float*)smem;
  const int tid = tid_(), lane = tid & 63, w = tid >> 6;
  const int rb = (w >> 1) * 64 + 4 * (lane >> 5), cb = (w & 1) * 64 + (lane & 31);
#pragma unroll
  for (int i = 0; i < 2; ++i)
#pragma unroll
    for (int j = 0; j < 2; ++j)
#pragma unroll
      for (int r = 0; r < 16; ++r)
        sf[(rb + i * 32 + (r & 3) + 8 * (r >> 2)) * 128 + cb + j * 32] = acc[i][j][r];
}
DI void unpack8(const uint4 v, float (&f)[8]) {
  f[0] = __uint_as_float(v.x << 16); f[1] = __uint_as_float(v.x & 0xffff0000u);
  f[2] = __uint_as_float(v.y << 16); f[3] = __uint_as_float(v.y & 0xffff0000u);
  f[4] = __uint_as_float(v.z << 16); f[5] = __uint_as_float(v.z & 0xffff0000u);
  f[6] = __uint_as_float(v.w << 16); f[7] = __uint_as_float(v.w & 0xffff0000u);
}
DI uint4 pack8(const float (&f)[8]) {
  uint4 o;
  o.x = pack2(f[0], f[1]); o.y = pack2(f[2], f[3]); o.z = pack2(f[4], f[5]); o.w = pack2(f[6], f[7]);
  return o;
}
#define EPI_LDS(...)                                                             \
  {                                                                              \
    acc_to_lds(acc, smem);                                                       \
    __syncthreads();                                                             \
    _Pragma("unroll 1") for (int it_ = 0; it_ < 8; ++it_) {                      \
      const int row = (tid_() >> 4) + 16 * it_;                             \
      const int c0 = (tid_() & 15) * 8;                                     \
      float v[8];                                                                \
      {                                                                          \
        const float4 t0 = *(const float4*)(smem + (row * 128 + c0) * 4);         \
        const float4 t1 = *(const float4*)(smem + (row * 128 + c0 + 4) * 4);     \
        v[0] = t0.x; v[1] = t0.y; v[2] = t0.z; v[3] = t0.w;                      \
        v[4] = t1.x; v[5] = t1.y; v[6] = t1.z; v[7] = t1.w;                      \
      }                                                                          \
      __VA_ARGS__                                                                \
    }                                                                            \
    __syncthreads();                                                             \
  }

DI void phase_gemm_in(const Params& p, int l, char* smem) {
  const bfu* W = p.w_inT + (size_t)l * DINP * 1024;
  for (int it = blockIdx.x; it < 96 * 37; it += gridDim.x) {
    const int mt = it / 37, nt = it % 37;
    f32x16 acc[2][2];
    acc_zero(acc);
    gemm_core(p.h + (size_t)mt * 128 * D, D, W + (size_t)nt * 128 * 1024, 1024, 1024, smem, acc);
    const int m0 = mt * 128, n0 = nt * 128;
    EPI_LDS({
      const int n = n0 + c0;
      if (n < DIN) *(uint4*)(p.proj + (size_t)(m0 + row) * DIN + n) = pack8(v);
    })
  }
}

DI void phase_s5_simple(const Params& p, int l) {
  const int tid = tid_(), lane = tid & 63, w = tid >> 6;
  for (int it = blockIdx.x; it < 160; it += gridDim.x) {
    const int wi = it * 4 + w;
    int tok0, L, b, g;
    bool prompt;
    if (wi < 128) { b = wi >> 5; g = wi & 31; tok0 = NPROMPT + b * 2048; L = 2048; prompt = false; }
    else { int q = wi - 128; b = q >> 5; g = q & 31; tok0 = b * 256; L = 256; prompt = true; }
    float cre[16], cim[16];
#pragma unroll
    for (int c = 0; c < 16; ++c) {
      cre[c] = p.c_re[((size_t)(l * 32 + g) * 16 + c) * 64 + lane];
      cim[c] = p.c_im[((size_t)(l * 32 + g) * 16 + c) * 64 + lane];
    }
    float dsk = p.s5_d[l * 512 + g * 16 + (((lane >> 5) & 1) * 8 + ((lane >> 4) & 1) * 4 + ((lane >> 3) & 1) * 2 + ((lane >> 2) & 1))];
    const int myc = ((lane >> 5) & 1) * 8 + ((lane >> 4) & 1) * 4 + ((lane >> 3) & 1) * 2 + ((lane >> 2) & 1);
    for (int dir = 1; dir >= 0; --dir) {
      const size_t pi = ((size_t)(l * 2 + dir) * 32 + g) * 64 + lane;
      const float lr = p.lam_re[pi], li = p.lam_im[pi];
      const float dt = expf(p.log_dt[(l * 2 + dir) * 32 + g]);
      const float mag = expf(lr * dt);
      float sn, cs;
      sincosf(li * dt, &sn, &cs);
      const float are = mag * cs, aim = mag * sn;
      const float nr = are - 1.f, ni = aim, den = lr * lr + li * li;
      const float kr = (nr * lr + ni * li) / den, ki = (ni * lr - nr * li) / den;
      float bbr[16], bbi[16];
#pragma unroll
      for (int c = 0; c < 16; ++c) {
        float br = p.b_re[((size_t)(l * 32 + g) * 64 + lane) * 16 + c];
        float bi = p.b_im[((size_t)(l * 32 + g) * 64 + lane) * 16 + c];
        bbr[c] = kr * br - ki * bi;
        bbi[c] = kr * bi + ki * br;
      }
      float hre = 0.f, him = 0.f;
      if (!prompt) {
        size_t si = ((size_t)((b * 2 + l) * 2 + dir)) * 2048 + g * 64 + lane;
        hre = p.st_re[si]; him = p.st_im[si];
      }
      const int tstep = dir == 0 ? 1 : -1;
      int tok = tok0 + (dir == 0 ? 0 : L - 1);
      uint4 u0 = *(const uint4*)(p.proj + (size_t)tok * DIN + g * 16);
      uint4 u1 = *(const uint4*)(p.proj + (size_t)tok * DIN + g * 16 + 8);
      float part = 0.f;
      if (dir == 0) part = p.tmp_s5[(size_t)tok * 512 + g * 16 + myc];
      for (int s = 0; s < L; ++s) {
        const int tokn = (s + 1 < L) ? tok + tstep : tok;
        uint4 n0 = *(const uint4*)(p.proj + (size_t)tokn * DIN + g * 16);
        uint4 n1 = *(const uint4*)(p.proj + (size_t)tokn * DIN + g * 16 + 8);
        float partn = 0.f;
        if (dir == 0) partn = p.tmp_s5[(size_t)tokn * 512 + g * 16 + myc];
        float u[16];
        u[0] = __uint_as_float(u0.x << 16); u[1] = __uint_as_float(u0.x & 0xffff0000u);
        u[2] = __uint_as_float(u0.y << 16); u[3] = __uint_as_float(u0.y & 0xffff0000u);
        u[4] = __uint_as_float(u0.z << 16); u[5] = __uint_as_float(u0.z & 0xffff0000u);
        u[6] = __uint_as_float(u0.w << 16); u[7] = __uint_as_float(u0.w & 0xffff0000u);
        u[8] = __uint_as_float(u1.x << 16); u[9] = __uint_as_float(u1.x & 0xffff0000u);
        u[10] = __uint_as_float(u1.y << 16); u[11] = __uint_as_float(u1.y & 0xffff0000u);
        u[12] = __uint_as_float(u1.z << 16); u[13] = __uint_as_float(u1.z & 0xffff0000u);
        u[14] = __uint_as_float(u1.w << 16); u[15] = __uint_as_float(u1.w & 0xffff0000u);
        float bur = 0.f, bui = 0.f;
#pragma unroll
        for (int c = 0; c < 16; ++c) { bur += bbr[c] * u[c]; bui += bbi[c] * u[c]; }
        const float nre = are * hre - aim * him + bur;
        const float nim = are * him + aim * hre + bui;
        hre = nre; him = nim;
        float v[16];
#pragma unroll
        for (int c = 0; c < 16; ++c) v[c] = cre[c] * hre - cim[c] * him;
        {
          const bool up = lane & 32;
#pragma unroll
          for (int i = 0; i < 8; ++i) {
            float send = up ? v[i] : v[i + 8];
            float keep = up ? v[i + 8] : v[i];
            v[i] = keep + __shfl_xor(send, 32);
          }
        }
        {
          const bool up = lane & 16;
#pragma unroll
          for (int i = 0; i < 4; ++i) {
            float send = up ? v[i] : v[i + 4];
            float keep = up ? v[i + 4] : v[i];
            v[i] = keep + __shfl_xor(send, 16);
          }
        }
        {
          const bool up = lane & 8;
#pragma unroll
          for (int i = 0; i < 2; ++i) {
            float send = up ? v[i] : v[i + 2];
            float keep = up ? v[i + 2] : v[i];
            v[i] = keep + __shfl_xor(send, 8);
          }
        }
        {
          const bool up = lane & 4;
          float send = up ? v[0] : v[1];
          float keep = up ? v[1] : v[0];
          v[0] = keep + __shfl_xor(send, 4);
        }
        v[0] += __shfl_xor(v[0], 2);
        v[0] += __shfl_xor(v[0], 1);
        float umy = 0.f;
#pragma unroll
        for (int c = 0; c < 16; ++c) umy = (c == myc) ? u[c] : umy;
        if ((lane & 3) == 0) {
          if (dir == 1) {
            p.tmp_s5[(size_t)tok * 512 + g * 16 + myc] = v[0];
          } else {
            float y = v[0] + part + dsk * umy;
            p.ys5[(size_t)tok * 512 + g * 16 + myc] = f2bf(geluf_(y));
          }
        }
        tok = tokn; u0 = n0; u1 = n1; part = partn;
      }
      if (prompt) {
        size_t oi = ((size_t)((b * 2 + l) * 2 + dir)) * 2048 + g * 64 + lane;
        p.out[OUT_RE + oi] = hre;
        p.out[OUT_IM + oi] = him;
      }
    }
  }
}

DI void phase_glu(const Params& p, int l, char* smem) {
  const bfu* W = p.w_gluT + (size_t)l * 512 * 512;
  for (int it = blockIdx.x; it < 96 * 4; it += gridDim.x) {
    const int mt = it >> 2, nt = it & 3;
    f32x16 acc[2][2];
    acc_zero(acc);
    gemm_core(p.ys5 + (size_t)mt * 128 * 512, 512, W + (size_t)nt * 128 * 512, 512, 512, smem, acc);
    const int m0 = mt * 128, n0 = nt * 128;
    EPI_LDS({
      const int n = n0 + c0;
      const size_t tk = (size_t)(m0 + row);
      float y[8], ga[8], o[8];
      unpack8(*(const uint4*)(p.ys5 + tk * 512 + n), y);
      unpack8(*(const uint4*)(p.proj + tk * DIN + OFF_GA + n), ga);
      const float* bg = p.b_glu + l * 512 + n;
      _Pragma("unroll") for (int e = 0; e < 8; ++e) o[e] = y[e] * sigmoidf_(v[e] + bg[e]) * siluf_(ga[e]);
      *(uint4*)(p.ya + tk * 512 + n) = pack8(o);
    })
  }
}

DI void phase_gla_simple(const Params& p, int l, char* smem) {
  float* sq = (float*)smem;
  float* sk = sq + 2048;
  float* sa = sk + 2048;
  float* sv = sa + 2048;
  const int tid = tid_();
  for (int it0 = blockIdx.x; it0 < 80; it0 += gridDim.x) {
    const int it = it0;
    int tok0, L, b, hd;
    bool prompt;
    if (it < 16) { b = it >> 2; hd = it & 3; tok0 = NPROMPT + b * 2048; L = 2048; prompt = false; }
    else { int q = it - 16; b = q >> 2; hd = q & 3; tok0 = b * 256; L = 256; prompt = true; }
    const int j = tid >> 1, r = tid & 1;
    const int dl = tid & 63;
    for (int dir = 1; dir >= 0; --dir) {
      float wg[16];
#pragma unroll
      for (int q = 0; q < 16; ++q) wg[q] = p.wg_up[((size_t)(l * 2 + dir) * 16 + q) * 256 + hd * 64 + dl];
      const float bgv = p.bg[(l * 2 + dir) * 256 + hd * 64 + dl];
      float S[32];
      if (prompt) {
#pragma unroll
        for (int i = 0; i < 32; ++i) S[i] = 0.f;
      } else {
        const float* sp = p.st_gla + ((size_t)(((b * 2 + l) * 2 + dir) * 4 + hd)) * 8192;
#pragma unroll
        for (int i = 0; i < 32; ++i) S[i] = sp[(r * 32 + i) * 128 + j];
      }
      for (int c0 = 0; c0 < L; c0 += 32) {
        __syncthreads();
#pragma unroll
        for (int i = 0; i < 8; ++i) {
          const int tt = (tid >> 6) + 4 * i;
          const int t = dir == 0 ? c0 + tt : L - 1 - (c0 + tt);
          const bfu* pr = p.proj + (size_t)(tok0 + t) * DIN;
          sq[tt * 64 + dl] = bf2f(pr[OFF_Q + hd * 64 + dl]) * 0.125f;
          sk[tt * 64 + dl] = bf2f(pr[OFF_K + hd * 64 + dl]);
          float lg = bgv;
#pragma unroll
          for (int q = 0; q < 16; ++q) lg += bf2f(pr[OFF_GL + q]) * wg[q];
          float ls = fminf(lg, 0.f) - log1pf(expf(-fabsf(lg)));
          sa[tt * 64 + dl] = expf(ls * (1.f / 16.f));
        }
#pragma unroll
        for (int i = 0; i < 16; ++i) {
          const int idx = tid + 256 * i;
          const int tt = idx >> 7, jj = idx & 127;
          const int t = dir == 0 ? c0 + tt : L - 1 - (c0 + tt);
          sv[tt * 128 + jj] = bf2f(p.proj[(size_t)(tok0 + t) * DIN + OFF_V + hd * 128 + jj]);
        }
        __syncthreads();
        for (int tt = 0; tt < 32; ++tt) {
          const float vj = sv[tt * 128 + j];
          float o = 0.f;
          const float4* pa = (const float4*)(sa + tt * 64 + r * 32);
          const float4* pk = (const float4*)(sk + tt * 64 + r * 32);
          const float4* pq = (const float4*)(sq + tt * 64 + r * 32);
#pragma unroll
          for (int i = 0; i < 8; ++i) {
            float4 a4 = pa[i], k4 = pk[i], q4 = pq[i];
            S[4 * i + 0] = a4.x * S[4 * i + 0] + k4.x * vj; o += q4.x * S[4 * i + 0];
            S[4 * i + 1] = a4.y * S[4 * i + 1] + k4.y * vj; o += q4.y * S[4 * i + 1];
            S[4 * i + 2] = a4.z * S[4 * i + 2] + k4.z * vj; o += q4.z * S[4 * i + 2];
            S[4 * i + 3] = a4.w * S[4 * i + 3] + k4.w * vj; o += q4.w * S[4 * i + 3];
          }
          o += __shfl_xor(o, 1);
          if (r == 0) {
            const int t = dir == 0 ? c0 + tt : L - 1 - (c0 + tt);
            float* dst = p.tmp_gla + (size_t)(tok0 + t) * 512 + hd * 128 + j;
            if (dir == 1) *dst = o; else *dst += o;
          }
        }
      }
      if (prompt) {
        float* op = p.out + OUT_GLA + ((size_t)(((b * 2 + l) * 2 + dir) * 4 + hd)) * 8192;
#pragma unroll
        for (int i = 0; i < 32; ++i) op[(r * 32 + i) * 128 + j] = S[i];
      }
    }
    __syncthreads();
  }
}

DI void phase_gla_norm(const Params& p, int l) {
  const int tid = tid_(), lane = tid & 63, w = tid >> 6;
  for (int it = blockIdx.x; it < NTOK / 4; it += gridDim.x) {
    const int tok = it * 4 + w;
    const float* src = p.tmp_gla + (size_t)tok * 512 + lane * 8;
    float4 a = *(const float4*)src, b = *(const float4*)(src + 4);
    float ss = a.x * a.x + a.y * a.y + a.z * a.z + a.w * a.w + b.x * b.x + b.y * b.y + b.z * b.z + b.w * b.w;
    ss += __shfl_xor(ss, 1); ss += __shfl_xor(ss, 2); ss += __shfl_xor(ss, 4); ss += __shfl_xor(ss, 8);
    const float rs = rsqrtf(ss * (1.f / 128.f) + EPS);
    const float* g = p.gla_norm_g + l * 512 + lane * 8;
    uint4 gb = *(const uint4*)(p.proj + (size_t)tok * DIN + OFF_GB + lane * 8);
    float o[8] = {a.x, a.y, a.z, a.w, b.x, b.y, b.z, b.w};
    unsigned gw[4] = {gb.x, gb.y, gb.z, gb.w};
    float res[8];
#pragma unroll
    for (int i = 0; i < 8; ++i) {
      float gt = (i & 1) ? __uint_as_float(gw[i >> 1] & 0xffff0000u) : __uint_as_float(gw[i >> 1] << 16);
      res[i] = o[i] * rs * g[i] * siluf_(gt);
    }
    uint4 ov;
    ov.x = pack2(res[0], res[1]); ov.y = pack2(res[2], res[3]); ov.z = pack2(res[4], res[5]); ov.w = pack2(res[6], res[7]);
    *(uint4*)(p.yb + (size_t)tok * 512 + lane * 8) = ov;
  }
}

DI void phase_merge(const Params& p, int l, char* smem) {
  const bfu* WA = p.w_paT + (size_t)l * 1024 * 512;
  const bfu* WB = p.w_pbT + (size_t)l * 1024 * 512;
  for (int it = blockIdx.x; it < 96 * 8; it += gridDim.x) {
    const int mt = it >> 3, nt = it & 7;
    const int m0 = mt * 128, n0 = nt * 128;
    f32x16 acc[2][2];
    acc_zero(acc);
    gemm_core(p.ya + (size_t)m0 * 512, 512, WA + (size_t)n0 * 512, 512, 512, smem, acc);
    EPI_LDS({
      float ma[8], o[8];
      unpack8(*(const uint4*)(p.proj + (size_t)(m0 + row) * DIN + OFF_MA + n0 + c0), ma);
      _Pragma("unroll") for (int e = 0; e < 8; ++e) o[e] = sigmoidf_(ma[e]) * v[e];
      *(uint4*)(p.merged + (size_t)(m0 + row) * D + n0 + c0) = pack8(o);
    })
    acc_zero(acc);
    gemm_core(p.yb + (size_t)m0 * 512, 512, WB + (size_t)n0 * 512, 512, 512, smem, acc);
    EPI_LDS({
      float mb[8], o[8], pr[8];
      unpack8(*(const uint4*)(p.proj + (size_t)(m0 + row) * DIN + OFF_MB + n0 + c0), mb);
      uint4* mp = (uint4*)(p.merged + (size_t)(m0 + row) * D + n0 + c0);
      unpack8(*mp, pr);
      _Pragma("unroll") for (int e = 0; e < 8; ++e) o[e] = pr[e] + sigmoidf_(mb[e]) * v[e];
      *mp = pack8(o);
    })
  }
}

DI void phase_out(const Params& p, int l, char* smem) {
  const bfu* W = p.w_oT + (size_t)l * 1024 * 1024;
  for (int it = blockIdx.x; it < 96 * 8; it += gridDim.x) {
    const int mt = it >> 3, nt = it & 7;
    const int m0 = mt * 128, n0 = nt * 128;
    f32x16 acc[2][2];
    acc_zero(acc);
    gemm_core(p.merged + (size_t)m0 * D, D, W + (size_t)n0 * 1024, 1024, 1024, smem, acc);
    const float* gate = p.mod + (size_t)(l * 5 + cond_of_tok(m0)) * 3072 + 2048;
    EPI_LDS({
      float* xp = p.out + (size_t)(m0 + row) * D + n0 + c0;
      const float* gp = gate + n0 + c0;
      float4 x0 = *(const float4*)xp, x1 = *(const float4*)(xp + 4);
      const float4 g0 = *(const float4*)gp, g1 = *(const float4*)(gp + 4);
      x0.x += g0.x * v[0]; x0.y += g0.y * v[1]; x0.z += g0.z * v[2]; x0.w += g0.w * v[3];
      x1.x += g1.x * v[4]; x1.y += g1.y * v[5]; x1.z += g1.z * v[6]; x1.w += g1.w * v[7];
      *(float4*)xp = x0; *(float4*)(xp + 4) = x1;
    })
  }
}

DI void phase_final(const Params& p) {
  const int tid = tid_(), lane = tid & 63, w = tid >> 6;
  for (int it = blockIdx.x; it < NTOK / 4; it += gridDim.x) {
    const int tok = it * 4 + w;
    float* xs = p.out + (size_t)tok * D;
    float4 v[4];
#pragma unroll
    for (int i = 0; i < 4; ++i) v[i] = *(const float4*)(xs + lane * 4 + 256 * i);
    float ss = 0.f;
#pragma unroll
    for (int i = 0; i < 4; ++i) ss += v[i].x * v[i].x + v[i].y * v[i].y + v[i].z * v[i].z + v[i].w * v[i].w;
    ss = wave_sum(ss);
    const float rstd = rsqrtf(ss * (1.f / 1024.f) + EPS);
#pragma unroll
    for (int i = 0; i < 4; ++i) {
      float4 g = *(const float4*)(p.final_g + lane * 4 + 256 * i);
      float4 o;
      o.x = v[i].x * rstd * g.x; o.y = v[i].y * rstd * g.y; o.z = v[i].z * rstd * g.z; o.w = v[i].w * rstd * g.w;
      *(float4*)(xs + lane * 4 + 256 * i) = o;
    }
  }
}

__global__ void __launch_bounds__(256, 2) k_phase(Params p, int ph, int l) {
  __shared__ __attribute__((aligned(16))) char smem[65536];
  switch (ph) {
    case 0: phase_prep(p, smem); break;
    case 1: phase_h(p, l); break;
    case 2: phase_gemm_in(p, l, smem); break;
    case 3: phase_s5_simple(p, l); break;
    case 4: phase_gla_simple(p, l, smem); break;
    case 5: phase_glu(p, l, smem); break;
    case 6: phase_gla_norm(p, l); break;
    case 7: phase_merge(p, l, smem); break;
    case 8: phase_out(p, l, smem); break;
    case 9: phase_final(p); break;
  }
}

__global__ void __launch_bounds__(256, 2) k_mega(Params p) {
  __shared__ __attribute__((aligned(16))) char smem[65536];
  cg::grid_group grid = cg::this_grid();
  phase_prep(p, smem);
  grid.sync();
  for (int l = 0; l < 2; ++l) {
    phase_h(p, l);
    grid.sync();
    phase_gemm_in(p, l, smem);
    grid.sync();
    phase_s5_simple(p, l);
    phase_gla_simple(p, l, smem);
    grid.sync();
    phase_glu(p, l, smem);
    phase_gla_norm(p, l);
    grid.sync();
    phase_merge(p, l, smem);
    grid.sync();
    phase_out(p, l, smem);
    grid.sync();
  }
  phase_final(p);
}

extern "C" void kernel_launch(void* const* d_in, const int* in_sizes, int n_in, void* d_out, int out_size,
                              void* d_ws, size_t ws_size, hipStream_t stream) {
  Params p{};
  const float* const* in = (const float* const*)d_in;
  p.x_prompt = in[0]; p.x_sample = in[1]; p.c = in[2]; p.st_re = in[3]; p.st_im = in[4]; p.st_gla = in[5];
  p.c_ctx = in[6]; p.norm_g = in[7]; p.w_mod = in[8]; p.b_mod = in[9]; p.w_in = in[10]; p.wg_up = in[11];
  p.bg = in[12]; p.gla_norm_g = in[13]; p.lam_re = in[14]; p.lam_im = in[15]; p.log_dt = in[16];
  p.b_re = in[17]; p.b_im = in[18]; p.c_re = in[19]; p.c_im = in[20]; p.s5_d = in[21]; p.w_glu = in[22];
  p.b_glu = in[23]; p.w_pa = in[24]; p.w_pb = in[25]; p.w_o = in[26]; p.final_g = in[27];
  p.out = (float*)d_out;
  char* ws = (char*)d_ws;
  size_t off = 0;
  auto take = [&](size_t bytes) { char* r = ws + off; off += (bytes + 255) & ~(size_t)255; return r; };
  p.w_inT = (bfu*)take((size_t)2 * DINP * 1024 * 2);
  p.w_gluT = (bfu*)take((size_t)2 * 512 * 512 * 2);
  p.w_paT = (bfu*)take((size_t)2 * 1024 * 512 * 2);
  p.w_pbT = (bfu*)take((size_t)2 * 1024 * 512 * 2);
  p.w_oT = (bfu*)take((size_t)2 * 1024 * 1024 * 2);
  p.mod = (float*)take((size_t)2 * 5 * 3072 * 4);
  p.pos_r = (float*)take((size_t)32 * 512 * 4);
  p.pos_c = (float*)take((size_t)64 * 512 * 4);
  p.h = (bfu*)take((size_t)NTOK * D * 2);
  p.proj = (bfu*)take((size_t)NTOK * DIN * 2);
  p.ys5 = (bfu*)take((size_t)NTOK * 512 * 2);
  p.ya = (bfu*)take((size_t)NTOK * 512 * 2);
  p.yb = (bfu*)take((size_t)NTOK * 512 * 2);
  p.merged = (bfu*)take((size_t)NTOK * D * 2);
  p.tmp_s5 = (float*)p.merged;
  p.tmp_gla = (float*)p.h;
#if ONE_LAUNCH
  static int grid_blocks = 0;
  if (!grid_blocks) {
    int dev = 0, cus = 0, per_cu = 0;
    hipGetDevice(&dev);
    hipDeviceGetAttribute(&cus, hipDeviceAttributeMultiprocessorCount, dev);
    hipOccupancyMaxActiveBlocksPerMultiprocessor(&per_cu, k_mega, 256, 0);
    if (per_cu > 2) per_cu = 2;
    grid_blocks = cus * per_cu;
  }
  void* args[] = {&p};
  hipError_t e = hipLaunchCooperativeKernel((void*)k_mega, dim3(grid_blocks), dim3(256), args, 0, stream);
  if (e != hipSuccess) fprintf(stderr, "cooperative launch failed: %s (grid %d)\n", hipGetErrorString(e), grid_blocks);
#else
  const int G = 1024;
  k_phase<<<G, 256, 0, stream>>>(p, 0, 0);
  for (int l = 0; l < 2; ++l) {
    k_phase<<<G, 256, 0, stream>>>(p, 1, l);
    k_phase<<<G, 256, 0, stream>>>(p, 2, l);
    k_phase<<<G, 256, 0, stream>>>(p, 3, l);
    k_phase<<<G, 256, 0, stream>>>(p, 4, l);
    k_phase<<<G, 256, 0, stream>>>(p, 5, l);
    k_phase<<<G, 256, 0, stream>>>(p, 6, l);
    k_phase<<<G, 256, 0, stream>>>(p, 7, l);
    k_phase<<<G, 256, 0, stream>>>(p, 8, l);
  }
  k_phase<<<G, 256, 0, stream>>>(p, 9, 0);
#endif
}
```

```cpp
#include <hip/hip_runtime.h>
#include <hip/hip_cooperative_groups.h>
#include <stdint.h>
#include <math.h>
#include <stdio.h>
namespace cg = cooperative_groups;

#ifndef ONE_LAUNCH
#define ONE_LAUNCH 1
#endif

typedef unsigned short bfu;
typedef __attribute__((ext_vector_type(8))) short bf16x8;
typedef __attribute__((ext_vector_type(16))) float f32x16;
typedef __attribute__((ext_vector_type(2))) __bf16 bf2_t;
typedef __attribute__((ext_vector_type(2))) float f2_t;

#define DI __device__ __forceinline__

constexpr int D = 1024;
constexpr int NTOK = 12288;
constexpr int NPROMPT = 4096;
constexpr int DIN = 4624;
constexpr int DINP = 4736;
constexpr int OFF_GA = 512, OFF_Q = 1024, OFF_K = 1280, OFF_V = 1536, OFF_GB = 2048, OFF_GL = 2560,
              OFF_MA = 2576, OFF_MB = 3600;
constexpr size_t OUT_RE = (size_t)NTOK * D;
constexpr size_t OUT_IM = OUT_RE + 131072;
constexpr size_t OUT_GLA = OUT_IM + 131072;
constexpr float EPS = 1e-6f;

struct Params {
  const float *x_prompt, *x_sample, *c, *st_re, *st_im, *st_gla, *c_ctx, *norm_g, *w_mod, *b_mod, *w_in,
      *wg_up, *bg, *gla_norm_g, *lam_re, *lam_im, *log_dt, *b_re, *b_im, *c_re, *c_im, *s5_d, *w_glu,
      *b_glu, *w_pa, *w_pb, *w_o, *final_g;
  float* out;
  bfu *w_inT, *w_gluT, *w_paT, *w_pbT, *w_oT;
  float *mod, *pos_r, *pos_c, *tmp_s5, *tmp_gla;
  bfu *h, *proj, *ys5, *ya, *yb, *merged;
};

DI int tid_() { int t = threadIdx.x; asm volatile("" : "+v"(t)); return t; }
DI float bf2f(bfu v) { return __uint_as_float(((unsigned)v) << 16); }
DI bfu f2bf(float x) { __bf16 b = (__bf16)x; return __builtin_bit_cast(unsigned short, b); }
DI unsigned pack2(float lo, float hi) {
  f2_t v = {lo, hi};
  bf2_t w = __builtin_convertvector(v, bf2_t);
  return __builtin_bit_cast(unsigned, w);
}
DI float sigmoidf_(float x) { return 1.f / (1.f + __expf(-x)); }
DI float siluf_(float x) { return x / (1.f + __expf(-x)); }
DI float geluf_(float x) {
  float u = 0.7978845608028654f * (x + 0.044715f * x * x * x);
  float t = 1.f - 2.f / (__expf(2.f * u) + 1.f);
  return 0.5f * x * (1.f + t);
}
DI float wave_sum(float v) {
#pragma unroll
  for (int o = 32; o >= 1; o >>= 1) v += __shfl_xor(v, o);
  return v;
}
DI int cond_of_tok(int tok) { return tok < NPROMPT ? 0 : 1 + ((tok - NPROMPT) >> 11); }

DI void transpose_tile(const float* __restrict__ src, int K, int N, bfu* __restrict__ dst, int kt, int nt,
                       float* sm) {
  const int tid = tid_(), c = tid & 63, r4 = tid >> 6;
  const int k0 = kt * 64, n0 = nt * 64;
#pragma unroll 4
  for (int i = 0; i < 16; ++i) {
    int k = i * 4 + r4, n = n0 + c;
    sm[k * 65 + c] = (n < N) ? src[(size_t)(k0 + k) * N + n] : 0.f;
  }
  __syncthreads();
#pragma unroll 4
  for (int i = 0; i < 16; ++i) {
    int n = i * 4 + r4;
    dst[(size_t)(n0 + n) * K + k0 + c] = f2bf(sm[c * 65 + n]);
  }
  __syncthreads();
}

DI void phase_prep(const Params& p, char* smem) {
  float* sm = (float*)smem;
  const int tid = tid_();
  for (int it = blockIdx.x; it < 96; it += gridDim.x) {
    const int l = it / 48, jb = it % 48;
    float* ssil = sm;
    float* sred = sm + 5 * 1024;
    for (int idx = tid; idx < 5120; idx += 256) {
      int ci = idx >> 10, k = idx & 1023;
      float cv = (ci == 0) ? p.c_ctx[k] : p.c[(ci - 1) * 1024 + k];
      ssil[idx] = cv / (1.f + expf(-cv));
    }
    __syncthreads();
    const int jj = tid & 63, kq = tid >> 6;
    const int j = jb * 64 + jj;
    float acc[5] = {0.f, 0.f, 0.f, 0.f, 0.f};
    const float* wp = p.w_mod + ((size_t)l * 1024 + kq * 256) * 3072 + j;
#pragma unroll 8
    for (int k = 0; k < 256; ++k) {
      float w = wp[(size_t)k * 3072];
#pragma unroll
      for (int ci = 0; ci < 5; ++ci) acc[ci] += ssil[ci * 1024 + kq * 256 + k] * w;
    }
#pragma unroll
    for (int ci = 0; ci < 5; ++ci) sred[(kq * 5 + ci) * 64 + jj] = acc[ci];
    __syncthreads();
    for (int idx = tid; idx < 320; idx += 256) {
      int ci = idx >> 6, j2 = idx & 63;
      float s = p.b_mod[l * 3072 + jb * 64 + j2];
#pragma unroll
      for (int q = 0; q < 4; ++q) s += sred[(q * 5 + ci) * 64 + j2];
      p.mod[(size_t)(l * 5 + ci) * 3072 + jb * 64 + j2] = s;
    }
    __syncthreads();
  }
  for (int idx = blockIdx.x * 256 + tid; idx < 96 * 512; idx += gridDim.x * 256) {
    int r = idx >> 9, i = idx & 511;
    int pos = r < 32 ? r : r - 32;
    int q = i & 255;
    double f = exp(-log(10000.0) * (double)q / 256.0);
    double ang = (double)pos * f;
    float v = (float)((i < 256) ? sin(ang) : cos(ang));
    if (r < 32) p.pos_r[r * 512 + i] = v; else p.pos_c[(r - 32) * 512 + i] = v;
  }
  for (int it = blockIdx.x; it < 3520; it += gridDim.x) {
    int l = it / 1760, r = it % 1760;
    if (r < 1184) {
      transpose_tile(p.w_in + (size_t)l * 1024 * DIN, 1024, DIN, p.w_inT + (size_t)l * DINP * 1024, r % 16, r / 16, sm);
    } else if (r < 1248) {
      r -= 1184;
      transpose_tile(p.w_glu + (size_t)l * 512 * 512, 512, 512, p.w_gluT + (size_t)l * 512 * 512, r % 8, r / 8, sm);
    } else if (r < 1376) {
      r -= 1248;
      transpose_tile(p.w_pa + (size_t)l * 512 * 1024, 512, 1024, p.w_paT + (size_t)l * 1024 * 512, r % 8, r / 8, sm);
    } else if (r < 1504) {
      r -= 1376;
      transpose_tile(p.w_pb + (size_t)l * 512 * 1024, 512, 1024, p.w_pbT + (size_t)l * 1024 * 512, r % 8, r / 8, sm);
    } else {
      r -= 1504;
      transpose_tile(p.w_o + (size_t)l * 1024 * 1024, 1024, 1024, p.w_oT + (size_t)l * 1024 * 1024, r % 16, r / 16, sm);
    }
  }
}

DI void phase_h(const Params& p, int l) {
  const int tid = tid_(), lane = tid & 63, w = tid >> 6;
  for (int it = blockIdx.x; it < NTOK / 4; it += gridDim.x) {
    const int tok = it * 4 + w;
    float4 v[4];
    float* xs = p.out + (size_t)tok * D;
    if (l == 0) {
      const float* src = tok < NPROMPT ? p.x_prompt + (size_t)tok * D : p.x_sample + (size_t)(tok - NPROMPT) * D;
#pragma unroll
      for (int i = 0; i < 4; ++i) v[i] = *(const float4*)(src + lane * 4 + 256 * i);
      if (tok >= NPROMPT) {
        int t = (tok - NPROMPT) & 2047, row = t >> 6, col = t & 63;
#pragma unroll
        for (int i = 0; i < 4; ++i) {
          int d = lane * 4 + 256 * i;
          const float* pe = d < 512 ? p.pos_r + row * 512 + d : p.pos_c + col * 512 + (d - 512);
          float4 e = *(const float4*)pe;
          v[i].x += e.x; v[i].y += e.y; v[i].z += e.z; v[i].w += e.w;
        }
      }
#pragma unroll
      for (int i = 0; i < 4; ++i) *(float4*)(xs + lane * 4 + 256 * i) = v[i];
    } else {
#pragma unroll
      for (int i = 0; i < 4; ++i) v[i] = *(const float4*)(xs + lane * 4 + 256 * i);
    }
    float ss = 0.f;
#pragma unroll
    for (int i = 0; i < 4; ++i) ss += v[i].x * v[i].x + v[i].y * v[i].y + v[i].z * v[i].z + v[i].w * v[i].w;
    ss = wave_sum(ss);
    const float rstd = rsqrtf(ss * (1.f / 1024.f) + EPS);
    const float* md = p.mod + (size_t)(l * 5 + cond_of_tok(tok)) * 3072;
    const float* ng = p.norm_g + l * 1024;
#pragma unroll
    for (int i = 0; i < 4; ++i) {
      int d = lane * 4 + 256 * i;
      float4 g = *(const float4*)(ng + d);
      float4 sh = *(const float4*)(md + d);
      float4 sc = *(const float4*)(md + 1024 + d);
      float a0 = v[i].x * rstd * g.x * (1.f + sc.x) + sh.x;
      float a1 = v[i].y * rstd * g.y * (1.f + sc.y) + sh.y;
      float a2 = v[i].z * rstd * g.z * (1.f + sc.z) + sh.z;
      float a3 = v[i].w * rstd * g.w * (1.f + sc.w) + sh.w;
      uint2 o; o.x = pack2(a0, a1); o.y = pack2(a2, a3);
      *(uint2*)(p.h + (size_t)tok * D + d) = o;
    }
  }
}

DI void gemm_core(const bfu* __restrict__ A, int lda, const bfu* __restrict__ B, int ldb, int K, char* smem,
                  f32x16 (&acc)[2][2]) {
  const int tid = tid_(), lane = tid & 63, w = tid >> 6, wm = w >> 1, wn = w & 1;
  const int c8 = tid & 7, r0 = tid >> 3;
  const bfu* ga = A + (size_t)r0 * lda + c8 * 8;
  const bfu* gb = B + (size_t)r0 * ldb + c8 * 8;
  const int st_off = r0 * 128 + ((c8 ^ ((r0 >> 1) & 7)) * 16);
  const int fr = lane & 31, hh = lane >> 5, fsw = (fr >> 1) & 7;
  const int a_base = (wm * 64 + fr) * 128;
  const int b_base = 16384 + (wn * 64 + fr) * 128;
  uint4 ra[4], rb[4];
#pragma unroll
  for (int i = 0; i < 4; ++i) {
    ra[i] = *(const uint4*)(ga + (size_t)i * 32 * lda);
    rb[i] = *(const uint4*)(gb + (size_t)i * 32 * ldb);
  }
#pragma unroll
  for (int i = 0; i < 4; ++i) {
    *(uint4*)(smem + st_off + i * 4096) = ra[i];
    *(uint4*)(smem + 16384 + st_off + i * 4096) = rb[i];
  }
  __syncthreads();
  const int KT = K >> 6;
#define GEMM_COMPUTE(cur)                                                                  \
  _Pragma("unroll") for (int s = 0; s < 4; ++s) {                                          \
    const int co = ((2 * s + hh) ^ fsw) * 16;                                              \
    bf16x8 a0 = *(const bf16x8*)((cur) + a_base + co);                                     \
    bf16x8 a1 = *(const bf16x8*)((cur) + a_base + 4096 + co);                              \
    bf16x8 b0 = *(const bf16x8*)((cur) + b_base + co);                                     \
    bf16x8 b1 = *(const bf16x8*)((cur) + b_base + 4096 + co);                              \
    acc[0][0] = __builtin_amdgcn_mfma_f32_32x32x16_bf16(a0, b0, acc[0][0], 0, 0, 0);       \
    acc[0][1] = __builtin_amdgcn_mfma_f32_32x32x16_bf16(a0, b1, acc[0][1], 0, 0, 0);       \
    acc[1][0] = __builtin_amdgcn_mfma_f32_32x32x16_bf16(a1, b0, acc[1][0], 0, 0, 0);       \
    acc[1][1] = __builtin_amdgcn_mfma_f32_32x32x16_bf16(a1, b1, acc[1][1], 0, 0, 0);       \
  }
#define GEMM_LOAD()                                                                        \
  _Pragma("unroll") for (int i = 0; i < 4; ++i) {                                          \
    ra[i] = *(const uint4*)(ga + (size_t)i * 32 * lda);                                    \
    rb[i] = *(const uint4*)(gb + (size_t)i * 32 * ldb);                                    \
  }
#define GEMM_STORE(buf)                                                                    \
  _Pragma("unroll") for (int i = 0; i < 4; ++i) {                                          \
    *(uint4*)((buf) + st_off + i * 4096) = ra[i];                                          \
    *(uint4*)((buf) + 16384 + st_off + i * 4096) = rb[i];                                  \
  }
#pragma unroll 1
  for (int kt = 0; kt < KT; kt += 2) {
    ga += 64; gb += 64;
    GEMM_LOAD()
    GEMM_COMPUTE(smem)
    GEMM_STORE(smem + 32768)
    __syncthreads();
    const int adv = (kt + 2 < KT) ? 64 : 0;
    ga += adv; gb += adv;
    GEMM_LOAD()
    GEMM_COMPUTE(smem + 32768)
    GEMM_STORE(smem)
    __syncthreads();
  }
}

DI void acc_zero(f32x16 (&acc)[2][2]) {
#pragma unroll
  for (int i = 0; i < 2; ++i)
#pragma unroll
    for (int j = 0; j < 2; ++j)
#pragma unroll
      for (int r = 0; r < 16; ++r) acc[i][j][r] = 0.f;
}

DI void acc_to_lds(const f32x16 (&acc)[2][2], char* smem) {
  float* sf = (float*)smem;
  const int tid = tid_(), lane = tid & 63, w = tid >> 6;
  const int rb = (w >> 1) * 64 + 4 * (lane >> 5), cb = (w & 1) * 64 + (lane & 31);
#pragma unroll
  for (int i = 0; i < 2; ++i)
#pragma unroll
    for (int j = 0; j < 2; ++j)
#pragma unroll
      for (int r = 0; r < 16; ++r)
        sf[(rb + i * 32 + (r & 3) + 8 * (r >> 2)) * 128 + cb + j * 32] = acc[i][j][r];
}
DI void unpack8(const uint4 v, float (&f)[8]) {
  f[0] = __uint_as_float(v.x << 16); f[1] = __uint_as_float(v.x & 0xffff0000u);
  f[2] = __uint_as_float(v.y << 16); f[3] = __uint_as_float(v.y & 0xffff0000u);
  f[4] = __uint_as_float(v.z << 16); f[5] = __uint_as_float(v.z & 0xffff0000u);
  f[6] = __uint_as_float(v.w << 16); f[7] = __uint_as_float(v.w & 0xffff0000u);
}
DI uint4 pack8(const float (&f)[8]) {
  uint4 o;
  o.x = pack2(f[0], f[1]); o.y = pack2(f[2], f[3]); o.z = pack2(f[4], f[5]); o.w = pack2(f[6], f[7]);
  return o;
}
#define EPI_LDS(...)                                                             \
  {                                                                              \
    acc_to_lds(acc, smem);                                                       \
    __syncthreads();                                                             \
    _Pragma("unroll 1") for (int it_ = 0; it_ < 8; ++it_) {                      \
      const int row = (tid_() >> 4) + 16 * it_;                             \
      const int c0 = (tid_() & 15) * 8;                                     \
      float v[8];                                                                \
      {                                                                          \
        const float4 t0 = *(const float4*)(smem + (row * 128 + c0) * 4);         \
        const float4 t1 = *(const float4*)(smem + (row * 128 + c0 + 4) * 4);     \
        v[0] = t0.x; v[1] = t0.y; v[2] = t0.z; v[3] = t0.w;                      \
        v[4] = t1.x; v[5] = t1.y; v[6] = t1.z; v[7] = t1.w;                      \
      }                                                                          \
      __VA_ARGS__                                                                \
    }                                                                            \
    __syncthreads();                                                             \
  }

DI void phase_gemm_in(const Params& p, int l, char* smem) {
  const bfu* W = p.w_inT + (size_t)l * DINP * 1024;
  for (int it = blockIdx.x; it < 96 * 37; it += gridDim.x) {
    const int mt = it / 37, nt = it % 37;
    f32x16 acc[2][2];
    acc_zero(acc);
    gemm_core(p.h + (size_t)mt * 128 * D, D, W + (size_t)nt * 128 * 1024, 1024, 1024, smem, acc);
    const int m0 = mt * 128, n0 = nt * 128;
    EPI_LDS({
      const int n = n0 + c0;
      if (n < DIN) *(uint4*)(p.proj + (size_t)(m0 + row) * DIN + n) = pack8(v);
    })
  }
}

DI void phase_s5_simple(const Params& p, int l) {
  const int tid = tid_(), lane = tid & 63, w = tid >> 6;
  for (int it = blockIdx.x; it < 160; it += gridDim.x) {
    const int wi = it * 4 + w;
    int tok0, L, b, g;
    bool prompt;
    if (wi < 128) { b = wi >> 5; g = wi & 31; tok0 = NPROMPT + b * 2048; L = 2048; prompt = false; }
    else { int q = wi - 128; b = q >> 5; g = q & 31; tok0 = b * 256; L = 256; prompt = true; }
    float cre[16], cim[16];
#pragma unroll
    for (int c = 0; c < 16; ++c) {
      cre[c] = p.c_re[((size_t)(l * 32 + g) * 16 + c) * 64 + lane];
      cim[c] = p.c_im[((size_t)(l * 32 + g) * 16 + c) * 64 + lane];
    }
    float dsk = p.s5_d[l * 512 + g * 16 + (((lane >> 5) & 1) * 8 + ((lane >> 4) & 1) * 4 + ((lane >> 3) & 1) * 2 + ((lane >> 2) & 1))];
    const int myc = ((lane >> 5) & 1) * 8 + ((lane >> 4) & 1) * 4 + ((lane >> 3) & 1) * 2 + ((lane >> 2) & 1);
    for (int dir = 1; dir >= 0; --dir) {
      const size_t pi = ((size_t)(l * 2 + dir) * 32 + g) * 64 + lane;
      const float lr = p.lam_re[pi], li = p.lam_im[pi];
      const float dt = expf(p.log_dt[(l * 2 + dir) * 32 + g]);
      const float mag = expf(lr * dt);
      float sn, cs;
      sincosf(li * dt, &sn, &cs);
      const float are = mag * cs, aim = mag * sn;
      const float nr = are - 1.f, ni = aim, den = lr * lr + li * li;
      const float kr = (nr * lr + ni * li) / den, ki = (ni * lr - nr * li) / den;
      float bbr[16], bbi[16];
#pragma unroll
      for (int c = 0; c < 16; ++c) {
        float br = p.b_re[((size_t)(l * 32 + g) * 64 + lane) * 16 + c];
        float bi = p.b_im[((size_t)(l * 32 + g) * 64 + lane) * 16 + c];
        bbr[c] = kr * br - ki * bi;
        bbi[c] = kr * bi + ki * br;
      }
      float hre = 0.f, him = 0.f;
      if (!prompt) {
        size_t si = ((size_t)((b * 2 + l) * 2 + dir)) * 2048 + g * 64 + lane;
        hre = p.st_re[si]; him = p.st_im[si];
      }
      const int tstep = dir == 0 ? 1 : -1;
      int tok = tok0 + (dir == 0 ? 0 : L - 1);
      uint4 u0 = *(const uint4*)(p.proj + (size_t)tok * DIN + g * 16);
      uint4 u1 = *(const uint4*)(p.proj + (size_t)tok * DIN + g * 16 + 8);
      float part = 0.f;
      if (dir == 0) part = p.tmp_s5[(size_t)tok * 512 + g * 16 + myc];
      for (int s = 0; s < L; ++s) {
        const int tokn = (s + 1 < L) ? tok + tstep : tok;
        uint4 n0 = *(const uint4*)(p.proj + (size_t)tokn * DIN + g * 16);
        uint4 n1 = *(const uint4*)(p.proj + (size_t)tokn * DIN + g * 16 + 8);
        float partn = 0.f;
        if (dir == 0) partn = p.tmp_s5[(size_t)tokn * 512 + g * 16 + myc];
        float u[16];
        u[0] = __uint_as_float(u0.x << 16); u[1] = __uint_as_float(u0.x & 0xffff0000u);
        u[2] = __uint_as_float(u0.y << 16); u[3] = __uint_as_float(u0.y & 0xffff0000u);
        u[4] = __uint_as_float(u0.z << 16); u[5] = __uint_as_float(u0.z & 0xffff0000u);
        u[6] = __uint_as_float(u0.w << 16); u[7] = __uint_as_float(u0.w & 0xffff0000u);
        u[8] = __uint_as_float(u1.x << 16); u[9] = __uint_as_float(u1.x & 0xffff0000u);
        u[10] = __uint_as_float(u1.y << 16); u[11] = __uint_as_float(u1.y & 0xffff0000u);
        u[12] = __uint_as_float(u1.z << 16); u[13] = __uint_as_float(u1.z & 0xffff0000u);
        u[14] = __uint_as_float(u1.w << 16); u[15] = __uint_as_float(u1.w & 0xffff0000u);
        float bur = 0.f, bui = 0.f;
#pragma unroll
        for (int c = 0; c < 16; ++c) { bur += bbr[c] * u[c]; bui += bbi[c] * u[c]; }
        const float nre = are * hre - aim * him + bur;
        const float nim = are * him + aim * hre + bui;
        hre = nre; him = nim;
        float v[16];
#pragma unroll
        for (int c = 0; c < 16; ++c) v[c] = cre[c] * hre - cim[c] * him;
        {
          const bool up = lane & 32;
#pragma unroll
          for (int i = 0; i < 8; ++i) {
            float send = up ? v[i] : v[i + 8];
            float keep = up ? v[i + 8] : v[i];
            v[i] = keep + __shfl_xor(send, 32);
          }
        }
        {
          const bool up = lane & 16;
#pragma unroll
          for (int i = 0; i < 4; ++i) {
            float send = up ? v[i] : v[i + 4];
            float keep = up ? v[i + 4] : v[i];
            v[i] = keep + __shfl_xor(send, 16);
          }
        }
        {
          const bool up = lane & 8;
#pragma unroll
          for (int i = 0; i < 2; ++i) {
            float send = up ? v[i] : v[i + 2];
            float keep = up ? v[i + 2] : v[i];
            v[i] = keep + __shfl_xor(send, 8);
          }
        }
        {
          const bool up = lane & 4;
          float send = up ? v[0] : v[1];
          float keep = up ? v[1] : v[0];
          v[0] = keep + __shfl_xor(send, 4);
        }
        v[0] += __shfl_xor(v[0], 2);
        v[0] += __shfl_xor(v[0], 1);
        float umy = 0.f;
#pragma unroll
        for (int c = 0; c < 16; ++c) umy = (c == myc) ? u[c] : umy;
        if ((lane & 3) == 0) {
          if (dir == 1) {
            p.tmp_s5[(size_t)tok * 512 + g * 16 + myc] = v[0];
          } else {
            float y = v[0] + part + dsk * umy;
            p.ys5[(size_t)tok * 512 + g * 16 + myc] = f2bf(geluf_(y));
          }
        }
        tok = tokn; u0 = n0; u1 = n1; part = partn;
      }
      if (prompt) {
        size_t oi = ((size_t)((b * 2 + l) * 2 + dir)) * 2048 + g * 64 + lane;
        p.out[OUT_RE + oi] = hre;
        p.out[OUT_IM + oi] = him;
      }
    }
  }
}

DI void phase_glu(const Params& p, int l, char* smem) {
  const bfu* W = p.w_gluT + (size_t)l * 512 * 512;
  for (int it = blockIdx.x; it < 96 * 4; it += gridDim.x) {
    const int mt = it >> 2, nt = it & 3;
    f32x16 acc[2][2];
    acc_zero(acc);
    gemm_core(p.ys5 + (size_t)mt * 128 * 512, 512, W + (size_t)nt * 128 * 512, 512, 512, smem, acc);
    const int m0 = mt * 128, n0 = nt * 128;
    EPI_LDS({
      const int n = n0 + c0;
      const size_t tk = (size_t)(m0 + row);
      float y[8], ga[8], o[8];
      unpack8(*(const uint4*)(p.ys5 + tk * 512 + n), y);
      unpack8(*(const uint4*)(p.proj + tk * DIN + OFF_GA + n), ga);
      const float* bg = p.b_glu + l * 512 + n;
      _Pragma("unroll") for (int e = 0; e < 8; ++e) o[e] = y[e] * sigmoidf_(v[e] + bg[e]) * siluf_(ga[e]);
      *(uint4*)(p.ya + tk * 512 + n) = pack8(o);
    })
  }
}

DI void phase_gla_simple(const Params& p, int l, char* smem) {
  float* sq = (float*)smem;
  float* sk = sq + 2048;
  float* sa = sk + 2048;
  float* sv = sa + 2048;
  const int tid = tid_();
  for (int it0 = gridDim.x - 1 - blockIdx.x; it0 < 80; it0 += gridDim.x) {
    const int it = it0;
    int tok0, L, b, hd;
    bool prompt;
    if (it < 16) { b = it >> 2; hd = it & 3; tok0 = NPROMPT + b * 2048; L = 2048; prompt = false; }
    else { int q = it - 16; b = q >> 2; hd = q & 3; tok0 = b * 256; L = 256; prompt = true; }
    const int j = tid >> 1, r = tid & 1;
    const int dl = tid & 63;
    for (int dir = 1; dir >= 0; --dir) {
      float wg[16];
#pragma unroll
      for (int q = 0; q < 16; ++q) wg[q] = p.wg_up[((size_t)(l * 2 + dir) * 16 + q) * 256 + hd * 64 + dl];
      const float bgv = p.bg[(l * 2 + dir) * 256 + hd * 64 + dl];
      float S[32];
      if (prompt) {
#pragma unroll
        for (int i = 0; i < 32; ++i) S[i] = 0.f;
      } else {
        const float* sp = p.st_gla + ((size_t)(((b * 2 + l) * 2 + dir) * 4 + hd)) * 8192;
#pragma unroll
        for (int i = 0; i < 32; ++i) S[i] = sp[(r * 32 + i) * 128 + j];
      }
      for (int c0 = 0; c0 < L; c0 += 32) {
        __syncthreads();
#pragma unroll
        for (int i = 0; i < 8; ++i) {
          const int tt = (tid >> 6) + 4 * i;
          const int t = dir == 0 ? c0 + tt : L - 1 - (c0 + tt);
          const bfu* pr = p.proj + (size_t)(tok0 + t) * DIN;
          sq[tt * 64 + dl] = bf2f(pr[OFF_Q + hd * 64 + dl]) * 0.125f;
          sk[tt * 64 + dl] = bf2f(pr[OFF_K + hd * 64 + dl]);
          float lg = bgv;
#pragma unroll
          for (int q = 0; q < 16; ++q) lg += bf2f(pr[OFF_GL + q]) * wg[q];
          float ls = fminf(lg, 0.f) - log1pf(expf(-fabsf(lg)));
          sa[tt * 64 + dl] = expf(ls * (1.f / 16.f));
        }
#pragma unroll
        for (int i = 0; i < 16; ++i) {
          const int idx = tid + 256 * i;
          const int tt = idx >> 7, jj = idx & 127;
          const int t = dir == 0 ? c0 + tt : L - 1 - (c0 + tt);
          sv[tt * 128 + jj] = bf2f(p.proj[(size_t)(tok0 + t) * DIN + OFF_V + hd * 128 + jj]);
        }
        __syncthreads();
        for (int tt = 0; tt < 32; ++tt) {
          const float vj = sv[tt * 128 + j];
          float o = 0.f;
          const float4* pa = (const float4*)(sa + tt * 64 + r * 32);
          const float4* pk = (const float4*)(sk + tt * 64 + r * 32);
          const float4* pq = (const float4*)(sq + tt * 64 + r * 32);
#pragma unroll
          for (int i = 0; i < 8; ++i) {
            float4 a4 = pa[i], k4 = pk[i], q4 = pq[i];
            S[4 * i + 0] = a4.x * S[4 * i + 0] + k4.x * vj; o += q4.x * S[4 * i + 0];
            S[4 * i + 1] = a4.y * S[4 * i + 1] + k4.y * vj; o += q4.y * S[4 * i + 1];
            S[4 * i + 2] = a4.z * S[4 * i + 2] + k4.z * vj; o += q4.z * S[4 * i + 2];
            S[4 * i + 3] = a4.w * S[4 * i + 3] + k4.w * vj; o += q4.w * S[4 * i + 3];
          }
          o += __shfl_xor(o, 1);
          if (r == 0) {
            const int t = dir == 0 ? c0 + tt : L - 1 - (c0 + tt);
            float* dst = p.tmp_gla + (size_t)(tok0 + t) * 512 + hd * 128 + j;
            if (dir == 1) *dst = o; else *dst += o;
          }
        }
      }
      if (prompt) {
        float* op = p.out + OUT_GLA + ((size_t)(((b * 2 + l) * 2 + dir) * 4 + hd)) * 8192;
#pragma unroll
        for (int i = 0; i < 32; ++i) op[(r * 32 + i) * 128 + j] = S[i];
      }
    }
    __syncthreads();
  }
}

DI void phase_gla_norm(const Params& p, int l) {
  const int tid = tid_(), lane = tid & 63, w = tid >> 6;
  for (int it = blockIdx.x; it < NTOK / 4; it += gridDim.x) {
    const int tok = it * 4 + w;
    const float* src = p.tmp_gla + (size_t)tok * 512 + lane * 8;
    float4 a = *(const float4*)src, b = *(const float4*)(src + 4);
    float ss = a.x * a.x + a.y * a.y + a.z * a.z + a.w * a.w + b.x * b.x + b.y * b.y + b.z * b.z + b.w * b.w;
    ss += __shfl_xor(ss, 1); ss += __shfl_xor(ss, 2); ss += __shfl_xor(ss, 4); ss += __shfl_xor(ss, 8);
    const float rs = rsqrtf(ss * (1.f / 128.f) + EPS);
    const float* g = p.gla_norm_g + l * 512 + lane * 8;
    uint4 gb = *(const uint4*)(p.proj + (size_t)tok * DIN + OFF_GB + lane * 8);
    float o[8] = {a.x, a.y, a.z, a.w, b.x, b.y, b.z, b.w};
    unsigned gw[4] = {gb.x, gb.y, gb.z, gb.w};
    float res[8];
#pragma unroll
    for (int i = 0; i < 8; ++i) {
      float gt = (i & 1) ? __uint_as_float(gw[i >> 1] & 0xffff0000u) : __uint_as_float(gw[i >> 1] << 16);
      res[i] = o[i] * rs * g[i] * siluf_(gt);
    }
    uint4 ov;
    ov.x = pack2(res[0], res[1]); ov.y = pack2(res[2], res[3]); ov.z = pack2(res[4], res[5]); ov.w = pack2(res[6], res[7]);
    *(uint4*)(p.yb + (size_t)tok * 512 + lane * 8) = ov;
  }
}

DI void phase_merge(const Params& p, int l, char* smem) {
  const bfu* WA = p.w_paT + (size_t)l * 1024 * 512;
  const bfu* WB = p.w_pbT + (size_t)l * 1024 * 512;
  for (int it = blockIdx.x; it < 96 * 8; it += gridDim.x) {
    const int mt = it >> 3, nt = it & 7;
    const int m0 = mt * 128, n0 = nt * 128;
    f32x16 acc[2][2];
    acc_zero(acc);
    gemm_core(p.ya + (size_t)m0 * 512, 512, WA + (size_t)n0 * 512, 512, 512, smem, acc);
    EPI_LDS({
      float ma[8], o[8];
      unpack8(*(const uint4*)(p.proj + (size_t)(m0 + row) * DIN + OFF_MA + n0 + c0), ma);
      _Pragma("unroll") for (int e = 0; e < 8; ++e) o[e] = sigmoidf_(ma[e]) * v[e];
      *(uint4*)(p.merged + (size_t)(m0 + row) * D + n0 + c0) = pack8(o);
    })
    acc_zero(acc);
    gemm_core(p.yb + (size_t)m0 * 512, 512, WB + (size_t)n0 * 512, 512, 512, smem, acc);
    EPI_LDS({
      float mb[8], o[8], pr[8];
      unpack8(*(const uint4*)(p.proj + (size_t)(m0 + row) * DIN + OFF_MB + n0 + c0), mb);
      uint4* mp = (uint4*)(p.merged + (size_t)(m0 + row) * D + n0 + c0);
      unpack8(*mp, pr);
      _Pragma("unroll") for (int e = 0; e < 8; ++e) o[e] = pr[e] + sigmoidf_(mb[e]) * v[e];
      *mp = pack8(o);
    })
  }
}

DI void phase_out(const Params& p, int l, char* smem) {
  const bfu* W = p.w_oT + (size_t)l * 1024 * 1024;
  for (int it = blockIdx.x; it < 96 * 8; it += gridDim.x) {
    const int mt = it >> 3, nt = it & 7;
    const int m0 = mt * 128, n0 = nt * 128;
    f32x16 acc[2][2];
    acc_zero(acc);
    gemm_core(p.merged + (size_t)m0 * D, D, W + (size_t)n0 * 1024, 1024, 1024, smem, acc);
    const float* gate = p.mod + (size_t)(l * 5 + cond_of_tok(m0)) * 3072 + 2048;
    EPI_LDS({
      float* xp = p.out + (size_t)(m0 + row) * D + n0 + c0;
      const float* gp = gate + n0 + c0;
      float4 x0 = *(const float4*)xp, x1 = *(const float4*)(xp + 4);
      const float4 g0 = *(const float4*)gp, g1 = *(const float4*)(gp + 4);
      x0.x += g0.x * v[0]; x0.y += g0.y * v[1]; x0.z += g0.z * v[2]; x0.w += g0.w * v[3];
      x1.x += g1.x * v[4]; x1.y += g1.y * v[5]; x1.z += g1.z * v[6]; x1.w += g1.w * v[7];
      *(float4*)xp = x0; *(float4*)(xp + 4) = x1;
    })
  }
}

DI void phase_final(const Params& p) {
  const int tid = tid_(), lane = tid & 63, w = tid >> 6;
  for (int it = blockIdx.x; it < NTOK / 4; it += gridDim.x) {
    const int tok = it * 4 + w;
    float* xs = p.out + (size_t)tok * D;
    float4 v[4];
#pragma unroll
    for (int i = 0; i < 4; ++i) v[i] = *(const float4*)(xs + lane * 4 + 256 * i);
    float ss = 0.f;
#pragma unroll
    for (int i = 0; i < 4; ++i) ss += v[i].x * v[i].x + v[i].y * v[i].y + v[i].z * v[i].z + v[i].w * v[i].w;
    ss = wave_sum(ss);
    const float rstd = rsqrtf(ss * (1.f / 1024.f) + EPS);
#pragma unroll
    for (int i = 0; i < 4; ++i) {
      float4 g = *(const float4*)(p.final_g + lane * 4 + 256 * i);
      float4 o;
      o.x = v[i].x * rstd * g.x; o.y = v[i].y * rstd * g.y; o.z = v[i].z * rstd * g.z; o.w = v[i].w * rstd * g.w;
      *(float4*)(xs + lane * 4 + 256 * i) = o;
    }
  }
}

__global__ void __launch_bounds__(256, 2) k_phase(Params p, int ph, int l) {
  __shared__ __attribute__((aligned(16))) char smem[65536];
  switch (ph) {
    case 0: phase_prep(p, smem); break;
    case 1: phase_h(p, l); break;
    case 2: phase_gemm_in(p, l, smem); break;
    case 3: phase_s5_simple(p, l); break;
    case 4: phase_gla_simple(p, l, smem); break;
    case 5: phase_glu(p, l, smem); break;
    case 6: phase_gla_norm(p, l); break;
    case 7: phase_merge(p, l, smem); break;
    case 8: phase_out(p, l, smem); break;
    case 9: phase_final(p); break;
  }
}

__global__ void __launch_bounds__(256, 2) k_mega(Params p) {
  __shared__ __attribute__((aligned(16))) char smem[65536];
  cg::grid_group grid = cg::this_grid();
  phase_prep(p, smem);
  grid.sync();
  for (int l = 0; l < 2; ++l) {
    phase_h(p, l);
    grid.sync();
    phase_gemm_in(p, l, smem);
    grid.sync();
    phase_s5_simple(p, l);
    phase_gla_simple(p, l, smem);
    grid.sync();
    phase_glu(p, l, smem);
    phase_gla_norm(p, l);
    grid.sync();
    phase_merge(p, l, smem);
    grid.sync();
    phase_out(p, l, smem);
    grid.sync();
  }
  phase_final(p);
}

extern "C" void kernel_launch(void* const* d_in, const int* in_sizes, int n_in, void* d_out, int out_size,
                              void* d_ws, size_t ws_size, hipStream_t stream) {
  Params p{};
  const float* const* in = (const float* const*)d_in;
  p.x_prompt = in[0]; p.x_sample = in[1]; p.c = in[2]; p.st_re = in[3]; p.st_im = in[4]; p.st_gla = in[5];
  p.c_ctx = in[6]; p.norm_g = in[7]; p.w_mod = in[8]; p.b_mod = in[9]; p.w_in = in[10]; p.wg_up = in[11];
  p.bg = in[12]; p.gla_norm_g = in[13]; p.lam_re = in[14]; p.lam_im = in[15]; p.log_dt = in[16];
  p.b_re = in[17]; p.b_im = in[18]; p.c_re = in[19]; p.c_im = in[20]; p.s5_d = in[21]; p.w_glu = in[22];
  p.b_glu = in[23]; p.w_pa = in[24]; p.w_pb = in[25]; p.w_o = in[26]; p.final_g = in[27];
  p.out = (float*)d_out;
  char* ws = (char*)d_ws;
  size_t off = 0;
  auto take = [&](size_t bytes) { char* r = ws + off; off += (bytes + 255) & ~(size_t)255; return r; };
  p.w_inT = (bfu*)take((size_t)2 * DINP * 1024 * 2);
  p.w_gluT = (bfu*)take((size_t)2 * 512 * 512 * 2);
  p.w_paT = (bfu*)take((size_t)2 * 1024 * 512 * 2);
  p.w_pbT = (bfu*)take((size_t)2 * 1024 * 512 * 2);
  p.w_oT = (bfu*)take((size_t)2 * 1024 * 1024 * 2);
  p.mod = (float*)take((size_t)2 * 5 * 3072 * 4);
  p.pos_r = (float*)take((size_t)32 * 512 * 4);
  p.pos_c = (float*)take((size_t)64 * 512 * 4);
  p.h = (bfu*)take((size_t)NTOK * D * 2);
  p.proj = (bfu*)take((size_t)NTOK * DIN * 2);
  p.ys5 = (bfu*)take((size_t)NTOK * 512 * 2);
  p.ya = (bfu*)take((size_t)NTOK * 512 * 2);
  p.yb = (bfu*)take((size_t)NTOK * 512 * 2);
  p.merged = (bfu*)take((size_t)NTOK * D * 2);
  p.tmp_s5 = (float*)p.merged;
  p.tmp_gla = (float*)p.h;
#if ONE_LAUNCH
  static int grid_blocks = 0;
  if (!grid_blocks) {
    int dev = 0, cus = 0, per_cu = 0;
    hipGetDevice(&dev);
    hipDeviceGetAttribute(&cus, hipDeviceAttributeMultiprocessorCount, dev);
    hipOccupancyMaxActiveBlocksPerMultiprocessor(&per_cu, k_mega, 256, 0);
    if (per_cu > 2) per_cu = 2;
    grid_blocks = cus * per_cu;
  }
  void* args[] = {&p};
  hipError_t e = hipLaunchCooperativeKernel((void*)k_mega, dim3(grid_blocks), dim3(256), args, 0, stream);
  if (e != hipSuccess) fprintf(stderr, "cooperative launch failed: %s (grid %d)\n", hipGetErrorString(e), grid_blocks);
#else
  const int G = 1024;
  k_phase<<<G, 256, 0, stream>>>(p, 0, 0);
  for (int l = 0; l < 2; ++l) {
    k_phase<<<G, 256, 0, stream>>>(p, 1, l);
    k_phase<<<G, 256, 0, stream>>>(p, 2, l);
    k_phase<<<G, 256, 0, stream>>>(p, 3, l);
    k_phase<<<G, 256, 0, stream>>>(p, 4, l);
    k_phase<<<G, 256, 0, stream>>>(p, 5, l);
    k_phase<<<G, 256, 0, stream>>>(p, 6, l);
    k_phase<<<G, 256, 0, stream>>>(p, 7, l);
    k_phase<<<G, 256, 0, stream>>>(p, 8, l);
  }
  k_phase<<<G, 256, 0, stream>>>(p, 9, 0);
#endif
}
```

```cpp
#include <hip/hip_runtime.h>
#include <hip/hip_cooperative_groups.h>
#include <stdint.h>
#include <math.h>
#include <stdio.h>
namespace cg = cooperative_groups;

#ifndef ONE_LAUNCH
#define ONE_LAUNCH 1
#endif

typedef unsigned short bfu;
typedef __attribute__((ext_vector_type(8))) short bf16x8;
typedef __attribute__((ext_vector_type(16))) float f32x16;
typedef __attribute__((ext_vector_type(2))) __bf16 bf2_t;
typedef __attribute__((ext_vector_type(2))) float f2_t;

#define DI __device__ __forceinline__

constexpr int D = 1024;
constexpr int NTOK = 12288;
constexpr int NPROMPT = 4096;
constexpr int DIN = 4624;
constexpr int DINP = 4736;
constexpr int PW = 4112;
constexpr int OFF_GA = 0, OFF_Q = 512, OFF_K = 768, OFF_V = 1024, OFF_GB = 1536, OFF_GL = 2048,
              OFF_MA = 2064, OFF_MB = 3088;
constexpr int NCHUNK = NTOK / 32;
constexpr size_t OUT_RE = (size_t)NTOK * D;
constexpr size_t OUT_IM = OUT_RE + 131072;
constexpr size_t OUT_GLA = OUT_IM + 131072;
constexpr float EPS = 1e-6f;

struct Params {
  const float *x_prompt, *x_sample, *c, *st_re, *st_im, *st_gla, *c_ctx, *norm_g, *w_mod, *b_mod, *w_in,
      *wg_up, *bg, *gla_norm_g, *lam_re, *lam_im, *log_dt, *b_re, *b_im, *c_re, *c_im, *s5_d, *w_glu,
      *b_glu, *w_pa, *w_pb, *w_o, *final_g;
  float* out;
  bfu *w_inT, *w_gluT, *w_paT, *w_pbT, *w_oT;
  float *mod, *pos_r, *pos_c, *tmp_s5, *tmp_gla;
  bfu *h, *proj, *ys5, *ya, *yb, *merged;
  bfu *ug, *opMG, *opE, *carry;
  float* ebuf;
};

DI int tid_() { int t = threadIdx.x; asm volatile("" : "+v"(t)); return t; }
DI float bf2f(bfu v) { return __uint_as_float(((unsigned)v) << 16); }
DI bfu f2bf(float x) { __bf16 b = (__bf16)x; return __builtin_bit_cast(unsigned short, b); }
DI unsigned pack2(float lo, float hi) {
  f2_t v = {lo, hi};
  bf2_t w = __builtin_convertvector(v, bf2_t);
  return __builtin_bit_cast(unsigned, w);
}
DI float sigmoidf_(float x) { return 1.f / (1.f + __expf(-x)); }
DI float siluf_(float x) { return x / (1.f + __expf(-x)); }
DI float geluf_(float x) {
  float u = 0.7978845608028654f * (x + 0.044715f * x * x * x);
  float t = 1.f - 2.f / (__expf(2.f * u) + 1.f);
  return 0.5f * x * (1.f + t);
}
DI float wave_sum(float v) {
#pragma unroll
  for (int o = 32; o >= 1; o >>= 1) v += __shfl_xor(v, o);
  return v;
}
DI int cond_of_tok(int tok) { return tok < NPROMPT ? 0 : 1 + ((tok - NPROMPT) >> 11); }

DI void transpose_tile(const float* __restrict__ src, int K, int N, bfu* __restrict__ dst, int kt, int nt,
                       float* sm) {
  const int tid = tid_(), c = tid & 63, r4 = tid >> 6;
  const int k0 = kt * 64, n0 = nt * 64;
#pragma unroll 4
  for (int i = 0; i < 16; ++i) {
    int k = i * 4 + r4, n = n0 + c;
    sm[k * 65 + c] = (n < N) ? src[(size_t)(k0 + k) * N + n] : 0.f;
  }
  __syncthreads();
#pragma unroll 4
  for (int i = 0; i < 16; ++i) {
    int n = i * 4 + r4;
    dst[(size_t)(n0 + n) * K + k0 + c] = f2bf(sm[c * 65 + n]);
  }
  __syncthreads();
}

DI void phase_prep(const Params& p, char* smem) {
  float* sm = (float*)smem;
  const int tid = tid_();
  for (int it = blockIdx.x; it < 96; it += gridDim.x) {
    const int l = it / 48, jb = it % 48;
    float* ssil = sm;
    float* sred = sm + 5 * 1024;
    for (int idx = tid; idx < 5120; idx += 256) {
      int ci = idx >> 10, k = idx & 1023;
      float cv = (ci == 0) ? p.c_ctx[k] : p.c[(ci - 1) * 1024 + k];
      ssil[idx] = cv / (1.f + expf(-cv));
    }
    __syncthreads();
    const int jj = tid & 63, kq = tid >> 6;
    const int j = jb * 64 + jj;
    float acc[5] = {0.f, 0.f, 0.f, 0.f, 0.f};
    const float* wp = p.w_mod + ((size_t)l * 1024 + kq * 256) * 3072 + j;
#pragma unroll 8
    for (int k = 0; k < 256; ++k) {
      float w = wp[(size_t)k * 3072];
#pragma unroll
      for (int ci = 0; ci < 5; ++ci) acc[ci] += ssil[ci * 1024 + kq * 256 + k] * w;
    }
#pragma unroll
    for (int ci = 0; ci < 5; ++ci) sred[(kq * 5 + ci) * 64 + jj] = acc[ci];
    __syncthreads();
    for (int idx = tid; idx < 320; idx += 256) {
      int ci = idx >> 6, j2 = idx & 63;
      float s = p.b_mod[l * 3072 + jb * 64 + j2];
#pragma unroll
      for (int q = 0; q < 4; ++q) s += sred[(q * 5 + ci) * 64 + j2];
      p.mod[(size_t)(l * 5 + ci) * 3072 + jb * 64 + j2] = s;
    }
    __syncthreads();
  }
  for (int idx = blockIdx.x * 256 + tid; idx < 96 * 512; idx += gridDim.x * 256) {
    int r = idx >> 9, i = idx & 511;
    int pos = r < 32 ? r : r - 32;
    int q = i & 255;
    double f = exp(-log(10000.0) * (double)q / 256.0);
    double ang = (double)pos * f;
    float v = (float)((i < 256) ? sin(ang) : cos(ang));
    if (r < 32) p.pos_r[r * 512 + i] = v; else p.pos_c[(r - 32) * 512 + i] = v;
  }
  for (int it = blockIdx.x; it < 3520; it += gridDim.x) {
    int l = it / 1760, r = it % 1760;
    if (r < 1184) {
      transpose_tile(p.w_in + (size_t)l * 1024 * DIN, 1024, DIN, p.w_inT + (size_t)l * DINP * 1024, r % 16, r / 16, sm);
    } else if (r < 1248) {
      r -= 1184;
      transpose_tile(p.w_glu + (size_t)l * 512 * 512, 512, 512, p.w_gluT + (size_t)l * 512 * 512, r % 8, r / 8, sm);
    } else if (r < 1376) {
      r -= 1248;
      transpose_tile(p.w_pa + (size_t)l * 512 * 1024, 512, 1024, p.w_paT + (size_t)l * 1024 * 512, r % 8, r / 8, sm);
    } else if (r < 1504) {
      r -= 1376;
      transpose_tile(p.w_pb + (size_t)l * 512 * 1024, 512, 1024, p.w_pbT + (size_t)l * 1024 * 512, r % 8, r / 8, sm);
    } else {
      r -= 1504;
      transpose_tile(p.w_o + (size_t)l * 1024 * 1024, 1024, 1024, p.w_oT + (size_t)l * 1024 * 1024, r % 16, r / 16, sm);
    }
  }
}

DI void phase_h(const Params& p, int l) {
  const int tid = tid_(), lane = tid & 63, w = tid >> 6;
  for (int it = blockIdx.x; it < NTOK / 4; it += gridDim.x) {
    const int tok = it * 4 + w;
    float4 v[4];
    float* xs = p.out + (size_t)tok * D;
    if (l == 0) {
      const float* src = tok < NPROMPT ? p.x_prompt + (size_t)tok * D : p.x_sample + (size_t)(tok - NPROMPT) * D;
#pragma unroll
      for (int i = 0; i < 4; ++i) v[i] = *(const float4*)(src + lane * 4 + 256 * i);
      if (tok >= NPROMPT) {
        int t = (tok - NPROMPT) & 2047, row = t >> 6, col = t & 63;
#pragma unroll
        for (int i = 0; i < 4; ++i) {
          int d = lane * 4 + 256 * i;
          const float* pe = d < 512 ? p.pos_r + row * 512 + d : p.pos_c + col * 512 + (d - 512);
          float4 e = *(const float4*)pe;
          v[i].x += e.x; v[i].y += e.y; v[i].z += e.z; v[i].w += e.w;
        }
      }
#pragma unroll
      for (int i = 0; i < 4; ++i) *(float4*)(xs + lane * 4 + 256 * i) = v[i];
    } else {
#pragma unroll
      for (int i = 0; i < 4; ++i) v[i] = *(const float4*)(xs + lane * 4 + 256 * i);
    }
    float ss = 0.f;
#pragma unroll
    for (int i = 0; i < 4; ++i) ss += v[i].x * v[i].x + v[i].y * v[i].y + v[i].z * v[i].z + v[i].w * v[i].w;
    ss = wave_sum(ss);
    const float rstd = rsqrtf(ss * (1.f / 1024.f) + EPS);
    const float* md = p.mod + (size_t)(l * 5 + cond_of_tok(tok)) * 3072;
    const float* ng = p.norm_g + l * 1024;
#pragma unroll
    for (int i = 0; i < 4; ++i) {
      int d = lane * 4 + 256 * i;
      float4 g = *(const float4*)(ng + d);
      float4 sh = *(const float4*)(md + d);
      float4 sc = *(const float4*)(md + 1024 + d);
      float a0 = v[i].x * rstd * g.x * (1.f + sc.x) + sh.x;
      float a1 = v[i].y * rstd * g.y * (1.f + sc.y) + sh.y;
      float a2 = v[i].z * rstd * g.z * (1.f + sc.z) + sh.z;
      float a3 = v[i].w * rstd * g.w * (1.f + sc.w) + sh.w;
      uint2 o; o.x = pack2(a0, a1); o.y = pack2(a2, a3);
      *(uint2*)(p.h + (size_t)tok * D + d) = o;
    }
  }
}

DI void gemm_core(const bfu* __restrict__ A, int lda, const bfu* __restrict__ B, int ldb, int K, char* smem,
                  f32x16 (&acc)[2][2]) {
  const int tid = tid_(), lane = tid & 63, w = tid >> 6, wm = w >> 1, wn = w & 1;
  const int c8 = tid & 7, r0 = tid >> 3;
  const bfu* ga = A + (size_t)r0 * lda + c8 * 8;
  const bfu* gb = B + (size_t)r0 * ldb + c8 * 8;
  const int st_off = r0 * 128 + ((c8 ^ ((r0 >> 1) & 7)) * 16);
  const int fr = lane & 31, hh = lane >> 5, fsw = (fr >> 1) & 7;
  const int a_base = (wm * 64 + fr) * 128;
  const int b_base = 16384 + (wn * 64 + fr) * 128;
  uint4 ra[4], rb[4];
#pragma unroll
  for (int i = 0; i < 4; ++i) {
    ra[i] = *(const uint4*)(ga + (size_t)i * 32 * lda);
    rb[i] = *(const uint4*)(gb + (size_t)i * 32 * ldb);
  }
#pragma unroll
  for (int i = 0; i < 4; ++i) {
    *(uint4*)(smem + st_off + i * 4096) = ra[i];
    *(uint4*)(smem + 16384 + st_off + i * 4096) = rb[i];
  }
  __syncthreads();
  const int KT = K >> 6;
#define GEMM_COMPUTE(cur)                                                                  \
  _Pragma("unroll") for (int s = 0; s < 4; ++s) {                                          \
    const int co = ((2 * s + hh) ^ fsw) * 16;                                              \
    bf16x8 a0 = *(const bf16x8*)((cur) + a_base + co);                                     \
    bf16x8 a1 = *(const bf16x8*)((cur) + a_base + 4096 + co);                              \
    bf16x8 b0 = *(const bf16x8*)((cur) + b_base + co);                                     \
    bf16x8 b1 = *(const bf16x8*)((cur) + b_base + 4096 + co);                              \
    acc[0][0] = __builtin_amdgcn_mfma_f32_32x32x16_bf16(a0, b0, acc[0][0], 0, 0, 0);       \
    acc[0][1] = __builtin_amdgcn_mfma_f32_32x32x16_bf16(a0, b1, acc[0][1], 0, 0, 0);       \
    acc[1][0] = __builtin_amdgcn_mfma_f32_32x32x16_bf16(a1, b0, acc[1][0], 0, 0, 0);       \
    acc[1][1] = __builtin_amdgcn_mfma_f32_32x32x16_bf16(a1, b1, acc[1][1], 0, 0, 0);       \
  }
#define GEMM_LOAD()                                                                        \
  _Pragma("unroll") for (int i = 0; i < 4; ++i) {                                          \
    ra[i] = *(const uint4*)(ga + (size_t)i * 32 * lda);                                    \
    rb[i] = *(const uint4*)(gb + (size_t)i * 32 * ldb);                                    \
  }
#define GEMM_STORE(buf)                                                                    \
  _Pragma("unroll") for (int i = 0; i < 4; ++i) {                                          \
    *(uint4*)((buf) + st_off + i * 4096) = ra[i];                                          \
    *(uint4*)((buf) + 16384 + st_off + i * 4096) = rb[i];                                  \
  }
#pragma unroll 1
  for (int kt = 0; kt < KT; kt += 2) {
    ga += 64; gb += 64;
    GEMM_LOAD()
    GEMM_COMPUTE(smem)
    GEMM_STORE(smem + 32768)
    __syncthreads();
    const int adv = (kt + 2 < KT) ? 64 : 0;
    ga += adv; gb += adv;
    GEMM_LOAD()
    GEMM_COMPUTE(smem + 32768)
    GEMM_STORE(smem)
    __syncthreads();
  }
}

DI void acc_zero(f32x16 (&acc)[2][2]) {
#pragma unroll
  for (int i = 0; i < 2; ++i)
#pragma unroll
    for (int j = 0; j < 2; ++j)
#pragma unroll
      for (int r = 0; r < 16; ++r) acc[i][j][r] = 0.f;
}

DI void acc_to_lds(const f32x16 (&acc)[2][2], char* smem) {
  float* sf = (float*)smem;
  const int tid = tid_(), lane = tid & 63, w = tid >> 6;
  const int rb = (w >> 1) * 64 + 4 * (lane >> 5), cb = (w & 1) * 64 + (lane & 31);
#pragma unroll
  for (int i = 0; i < 2; ++i)
#pragma unroll
    for (int j = 0; j < 2; ++j)
#pragma unroll
      for (int r = 0; r < 16; ++r)
        sf[(rb + i * 32 + (r & 3) + 8 * (r >> 2)) * 128 + cb + j * 32] = acc[i][j][r];
}
DI void unpack8(const uint4 v, float (&f)[8]) {
  f[0] = __uint_as_float(v.x << 16); f[1] = __uint_as_float(v.x & 0xffff0000u);
  f[2] = __uint_as_float(v.y << 16); f[3] = __uint_as_float(v.y & 0xffff0000u);
  f[4] = __uint_as_float(v.z << 16); f[5] = __uint_as_float(v.z & 0xffff0000u);
  f[6] = __uint_as_float(v.w << 16); f[7] = __uint_as_float(v.w & 0xffff0000u);
}
DI uint4 pack8(const float (&f)[8]) {
  uint4 o;
  o.x = pack2(f[0], f[1]); o.y = pack2(f[2], f[3]); o.z = pack2(f[4], f[5]); o.w = pack2(f[6], f[7]);
  return o;
}
#define EPI_LDS(...)                                                             \
  {                                                                              \
    acc_to_lds(acc, smem);                                                       \
    __syncthreads();                                                             \
    _Pragma("unroll 1") for (int it_ = 0; it_ < 8; ++it_) {                      \
      const int row = (tid_() >> 4) + 16 * it_;                             \
      const int c0 = (tid_() & 15) * 8;                                     \
      float v[8];                                                                \
      {                                                                          \
        const float4 t0 = *(const float4*)(smem + (row * 128 + c0) * 4);         \
        const float4 t1 = *(const float4*)(smem + (row * 128 + c0 + 4) * 4);     \
        v[0] = t0.x; v[1] = t0.y; v[2] = t0.z; v[3] = t0.w;                      \
        v[4] = t1.x; v[5] = t1.y; v[6] = t1.z; v[7] = t1.w;                      \
      }                                                                          \
      __VA_ARGS__                                                                \
    }                                                                            \
    __syncthreads();                                                             \
  }

DI void phase_gemm_in(const Params& p, int l, char* smem) {
  const bfu* W = p.w_inT + (size_t)l * DINP * 1024;
  for (int it = blockIdx.x; it < 96 * 37; it += gridDim.x) {
    const int mt = it / 37, nt = it % 37;
    f32x16 acc[2][2];
    acc_zero(acc);
    gemm_core(p.h + (size_t)mt * 128 * D, D, W + (size_t)nt * 128 * 1024, 1024, 1024, smem, acc);
    const int m0 = mt * 128, n0 = nt * 128;
    EPI_LDS({
      const int n = n0 + c0;
      if (n < 512) *(uint4*)(p.ug + ((size_t)(n >> 4) * NTOK + (m0 + row)) * 16 + (n & 15)) = pack8(v);
      else if (n < DIN) *(uint4*)(p.proj + (size_t)(m0 + row) * PW + (n - 512)) = pack8(v);
    })
  }
}

DI void s5_gen_item(const Params& p, int l, int item, char* smem) {
  const int tid = tid_();
  const int g = item >> 3, r = item & 7;
  float* sBr = (float*)smem;
  float* sBi = sBr + 2048;
  float* sCr = sBi + 2048;
  float* sCi = sCr + 1024;
  float* sAK = sCi + 1024;
  float* sAE = sAK + 1024;
  float* sAG = sAE + 1024;
  float* sK = sAG + 1024;
  bfu* E = p.opE + (size_t)g * 256 * 512;
  bfu* MG = p.opMG + (size_t)g * 512 * 768;
  __syncthreads();
  if (tid < 128) {
    const int d = tid >> 6, pp = tid & 63;
    const size_t pi = ((size_t)(l * 2 + d) * 32 + g) * 64 + pp;
    const float lr = p.lam_re[pi], li = p.lam_im[pi];
    const float dt = expf(p.log_dt[(l * 2 + d) * 32 + g]);
    const float mag = expf(lr * dt);
    float sn, cs;
    sincosf(li * dt, &sn, &cs);
    const float are = mag * cs, aim = mag * sn;
    const float nr = are - 1.f, ni = aim, den = lr * lr + li * li;
    const float kr = (nr * lr + ni * li) / den, ki = (ni * lr - nr * li) / den;
#pragma unroll
    for (int c = 0; c < 16; ++c) {
      float br = p.b_re[((size_t)(l * 32 + g) * 64 + pp) * 16 + c];
      float bi = p.b_im[((size_t)(l * 32 + g) * 64 + pp) * 16 + c];
      sBr[(d * 64 + pp) * 16 + c] = kr * br - ki * bi;
      sBi[(d * 64 + pp) * 16 + c] = kr * bi + ki * br;
    }
#pragma unroll
    for (int q = 0; q < 4; ++q) {
      const int t = 4 * r + q;
      const int nK = t;
      const int nE = d == 0 ? 31 - t : t;
      const int nG = d == 0 ? t + 1 : 32 - t;
      float m, s_, c_;
      m = expf(lr * dt * (float)nK); sincosf(li * dt * (float)nK, &s_, &c_);
      sAK[((d * 4 + q) * 64 + pp) * 2] = m * c_; sAK[((d * 4 + q) * 64 + pp) * 2 + 1] = m * s_;
      m = expf(lr * dt * (float)nE); sincosf(li * dt * (float)nE, &s_, &c_);
      sAE[((d * 4 + q) * 64 + pp) * 2] = m * c_; sAE[((d * 4 + q) * 64 + pp) * 2 + 1] = m * s_;
      m = expf(lr * dt * (float)nG); sincosf(li * dt * (float)nG, &s_, &c_);
      sAG[((d * 4 + q) * 64 + pp) * 2] = m * c_; sAG[((d * 4 + q) * 64 + pp) * 2 + 1] = m * s_;
    }
  } else {
    for (int idx = tid - 128; idx < 1024; idx += 128) {
      sCr[idx] = p.c_re[(size_t)(l * 32 + g) * 1024 + idx];
      sCi[idx] = p.c_im[(size_t)(l * 32 + g) * 1024 + idx];
    }
  }
  __syncthreads();
  for (int idx = tid; idx < 256 * 64; idx += 256) {
    const int row = idx >> 6, cc = idx & 63, q = cc >> 4, c = cc & 15;
    const int part = row >> 6, pp = row & 63, d = part >> 1;
    const float ar = sAE[((d * 4 + q) * 64 + pp) * 2], ai = sAE[((d * 4 + q) * 64 + pp) * 2 + 1];
    const float br = sBr[(d * 64 + pp) * 16 + c], bi = sBi[(d * 64 + pp) * 16 + c];
    const float v = (part & 1) ? (ar * bi + ai * br) : (ar * br - ai * bi);
    E[(size_t)row * 512 + (4 * r + q) * 16 + c] = f2bf(v);
  }
  for (int idx = tid; idx < 64 * 256; idx += 256) {
    const int rr = idx >> 8, col = idx & 255, q = rr >> 4, c = rr & 15;
    const int part = col >> 6, pp = col & 63, d = part >> 1;
    const float ar = sAG[((d * 4 + q) * 64 + pp) * 2], ai = sAG[((d * 4 + q) * 64 + pp) * 2 + 1];
    const float cr = sCr[c * 64 + pp], ci = sCi[c * 64 + pp];
    const float v = (part & 1) ? -(cr * ai + ci * ar) : (cr * ar - ci * ai);
    MG[(size_t)((4 * r + q) * 16 + c) * 768 + 512 + col] = f2bf(v);
  }
  {
    const int d = tid >> 7, q = (tid >> 5) & 3, c = (tid >> 1) & 15, ch = tid & 1;
    float acc[8];
#pragma unroll
    for (int e = 0; e < 8; ++e) acc[e] = 0.f;
    for (int pp = 0; pp < 64; ++pp) {
      const float ar = sAK[((d * 4 + q) * 64 + pp) * 2], ai = sAK[((d * 4 + q) * 64 + pp) * 2 + 1];
      const float cr = sCr[c * 64 + pp], ci = sCi[c * 64 + pp];
      const float wr = cr * ar - ci * ai, wi = cr * ai + ci * ar;
#pragma unroll
      for (int e = 0; e < 8; ++e)
        acc[e] += wr * sBr[(d * 64 + pp) * 16 + ch * 8 + e] - wi * sBi[(d * 64 + pp) * 16 + ch * 8 + e];
    }
#pragma unroll
    for (int e = 0; e < 8; ++e) sK[((d * 4 + q) * 16 + c) * 16 + ch * 8 + e] = acc[e];
  }
  __syncthreads();
  for (int idx = tid; idx < 8192; idx += 256) {
    const int ch = idx & 1, c = (idx >> 1) & 15, tp = (idx >> 5) & 31, q = (idx >> 10) & 3, d = idx >> 12;
    const int tau = 4 * r + q;
    int sp;
    bool valid;
    if (d == 0) { sp = tp - tau; valid = sp >= 0; } else { sp = tp + tau; valid = (sp <= 31) && (tau > 0); }
    if (valid) {
      float v[8];
#pragma unroll
      for (int e = 0; e < 8; ++e) {
        float x = sK[((d * 4 + q) * 16 + c) * 16 + ch * 8 + e];
        if (tau == 0) x += sK[((1 * 4 + q) * 16 + c) * 16 + ch * 8 + e];
        v[e] = x;
      }
      *(uint4*)(MG + (size_t)(tp * 16 + c) * 768 + sp * 16 + ch * 8) = pack8(v);
    }
  }
  __syncthreads();
}

DI void phase_s5_gen(const Params& p, int l, char* smem) {
  for (int it = gridDim.x - 1 - blockIdx.x; it < 256; it += gridDim.x) s5_gen_item(p, l, it, smem);
}

DI void phase_s5_e(const Params& p, char* smem) {
  for (int it = blockIdx.x; it < 32 * 3 * 2; it += gridDim.x) {
    const int g = it / 6, r6 = it % 6, mt = r6 >> 1, nt = r6 & 1;
    f32x16 acc[2][2];
    acc_zero(acc);
    gemm_core(p.ug + ((size_t)g * NCHUNK + mt * 128) * 512, 512, p.opE + ((size_t)g * 256 + nt * 128) * 512, 512, 512,
              smem, acc);
    EPI_LDS({
      float* dst = p.ebuf + ((size_t)g * NCHUNK + mt * 128 + row) * 256 + nt * 128 + c0;
      *(float4*)dst = make_float4(v[0], v[1], v[2], v[3]);
      *(float4*)(dst + 4) = make_float4(v[4], v[5], v[6], v[7]);
    })
  }
}

DI void phase_s5_scan(const Params& p, int l) {
  const int tid = tid_();
  for (int it = blockIdx.x; it < 320; it += gridDim.x) {
    const int wi = it * 2 + (tid >> 7);
    const int dir = (tid >> 6) & 1, pp = tid & 63;
    int chunk0, n, b, g;
    bool prompt;
    if (wi < 128) { b = wi >> 5; g = wi & 31; chunk0 = (NPROMPT + b * 2048) >> 5; n = 64; prompt = false; }
    else { int q = wi - 128; b = q >> 5; g = q & 31; chunk0 = (b * 256) >> 5; n = 8; prompt = true; }
    const size_t pi = ((size_t)(l * 2 + dir) * 32 + g) * 64 + pp;
    const float lr = p.lam_re[pi], li = p.lam_im[pi];
    const float dt = expf(p.log_dt[(l * 2 + dir) * 32 + g]);
    const float mag = expf(lr * dt * 32.f);
    float sn, cs;
    sincosf(li * dt * 32.f, &sn, &cs);
    const float are = mag * cs, aim = mag * sn;
    float hre = 0.f, him = 0.f;
    if (!prompt) {
      size_t si = ((size_t)((b * 2 + l) * 2 + dir)) * 2048 + g * 64 + pp;
      hre = p.st_re[si]; him = p.st_im[si];
    }
    const float* eb = p.ebuf + ((size_t)g * NCHUNK + chunk0) * 256 + dir * 128 + pp;
    bfu* cb = p.carry + ((size_t)g * NCHUNK + chunk0) * 256 + dir * 128 + pp;
    for (int k0 = 0; k0 < n; k0 += 8) {
      float er[8], ei[8];
#pragma unroll
      for (int j = 0; j < 8; ++j) {
        const int k = dir == 0 ? k0 + j : n - 1 - (k0 + j);
        er[j] = eb[(size_t)k * 256];
        ei[j] = eb[(size_t)k * 256 + 64];
      }
#pragma unroll
      for (int j = 0; j < 8; ++j) {
        const int k = dir == 0 ? k0 + j : n - 1 - (k0 + j);
        cb[(size_t)k * 256] = f2bf(hre);
        cb[(size_t)k * 256 + 64] = f2bf(him);
        const float nre = are * hre - aim * him + er[j];
        const float nim = are * him + aim * hre + ei[j];
        hre = nre; him = nim;
      }
    }
    if (prompt) {
      size_t oi = ((size_t)((b * 2 + l) * 2 + dir)) * 2048 + g * 64 + pp;
      p.out[OUT_RE + oi] = hre;
      p.out[OUT_IM + oi] = him;
    }
  }
}

DI void phase_s5_y(const Params& p, int l, char* smem) {
  for (int it = blockIdx.x; it < 32 * 3 * 4; it += gridDim.x) {
    const int g = it / 12, r12 = it % 12, mt = r12 >> 2, nt = r12 & 3;
    f32x16 acc[2][2];
    acc_zero(acc);
    const bfu* Bm = p.opMG + ((size_t)g * 512 + nt * 128) * 768;
    gemm_core(p.ug + ((size_t)g * NCHUNK + mt * 128) * 512, 512, Bm, 768, 512, smem, acc);
    gemm_core(p.carry + ((size_t)g * NCHUNK + mt * 128) * 256, 256, Bm + 512, 768, 256, smem, acc);
    EPI_LDS({
      const int chunk = mt * 128 + row, nn = nt * 128 + c0, tp = nn >> 4, c = nn & 15;
      const int tok = chunk * 32 + tp;
      float u[8], o[8];
      unpack8(*(const uint4*)(p.ug + ((size_t)g * NTOK + tok) * 16 + c), u);
      const float* dsk = p.s5_d + l * 512 + g * 16 + c;
      _Pragma("unroll") for (int e = 0; e < 8; ++e) o[e] = geluf_(v[e] + dsk[e] * u[e]);
      *(uint4*)(p.ys5 + (size_t)tok * 512 + g * 16 + c) = pack8(o);
    })
  }
}

DI void phase_glu(const Params& p, int l, char* smem) {
  const bfu* W = p.w_gluT + (size_t)l * 512 * 512;
  for (int it = blockIdx.x; it < 96 * 4; it += gridDim.x) {
    const int mt = it >> 2, nt = it & 3;
    f32x16 acc[2][2];
    acc_zero(acc);
    gemm_core(p.ys5 + (size_t)mt * 128 * 512, 512, W + (size_t)nt * 128 * 512, 512, 512, smem, acc);
    const int m0 = mt * 128, n0 = nt * 128;
    EPI_LDS({
      const int n = n0 + c0;
      const size_t tk = (size_t)(m0 + row);
      float y[8], ga[8], o[8];
      unpack8(*(const uint4*)(p.ys5 + tk * 512 + n), y);
      unpack8(*(const uint4*)(p.proj + tk * PW + OFF_GA + n), ga);
      const float* bg = p.b_glu + l * 512 + n;
      _Pragma("unroll") for (int e = 0; e < 8; ++e) o[e] = y[e] * sigmoidf_(v[e] + bg[e]) * siluf_(ga[e]);
      *(uint4*)(p.ya + tk * 512 + n) = pack8(o);
    })
  }
}

DI void phase_gla_simple(const Params& p, int l, char* smem) {
  float* sq = (float*)smem;
  float* sk = sq + 2048;
  float* sa = sk + 2048;
  float* sv = sa + 2048;
  const int tid = tid_();
  for (int it0 = gridDim.x - 1 - blockIdx.x; it0 < 80; it0 += gridDim.x) {
    const int it = it0;
    int tok0, L, b, hd;
    bool prompt;
    if (it < 16) { b = it >> 2; hd = it & 3; tok0 = NPROMPT + b * 2048; L = 2048; prompt = false; }
    else { int q = it - 16; b = q >> 2; hd = q & 3; tok0 = b * 256; L = 256; prompt = true; }
    const int j = tid >> 1, r = tid & 1;
    const int dl = tid & 63;
    for (int dir = 1; dir >= 0; --dir) {
      float wg[16];
#pragma unroll
      for (int q = 0; q < 16; ++q) wg[q] = p.wg_up[((size_t)(l * 2 + dir) * 16 + q) * 256 + hd * 64 + dl];
      const float bgv = p.bg[(l * 2 + dir) * 256 + hd * 64 + dl];
      float S[32];
      if (prompt) {
#pragma unroll
        for (int i = 0; i < 32; ++i) S[i] = 0.f;
      } else {
        const float* sp = p.st_gla + ((size_t)(((b * 2 + l) * 2 + dir) * 4 + hd)) * 8192;
#pragma unroll
        for (int i = 0; i < 32; ++i) S[i] = sp[(r * 32 + i) * 128 + j];
      }
      for (int c0 = 0; c0 < L; c0 += 32) {
        __syncthreads();
#pragma unroll
        for (int i = 0; i < 8; ++i) {
          const int tt = (tid >> 6) + 4 * i;
          const int t = dir == 0 ? c0 + tt : L - 1 - (c0 + tt);
          const bfu* pr = p.proj + (size_t)(tok0 + t) * PW;
          sq[tt * 64 + dl] = bf2f(pr[OFF_Q + hd * 64 + dl]) * 0.125f;
          sk[tt * 64 + dl] = bf2f(pr[OFF_K + hd * 64 + dl]);
          float lg = bgv;
#pragma unroll
          for (int q = 0; q < 16; ++q) lg += bf2f(pr[OFF_GL + q]) * wg[q];
          float ls = fminf(lg, 0.f) - log1pf(expf(-fabsf(lg)));
          sa[tt * 64 + dl] = expf(ls * (1.f / 16.f));
        }
#pragma unroll
        for (int i = 0; i < 16; ++i) {
          const int idx = tid + 256 * i;
          const int tt = idx >> 7, jj = idx & 127;
          const int t = dir == 0 ? c0 + tt : L - 1 - (c0 + tt);
          sv[tt * 128 + jj] = bf2f(p.proj[(size_t)(tok0 + t) * PW + OFF_V + hd * 128 + jj]);
        }
        __syncthreads();
        for (int tt = 0; tt < 32; ++tt) {
          const float vj = sv[tt * 128 + j];
          float o = 0.f;
          const float4* pa = (const float4*)(sa + tt * 64 + r * 32);
          const float4* pk = (const float4*)(sk + tt * 64 + r * 32);
          const float4* pq = (const float4*)(sq + tt * 64 + r * 32);
#pragma unroll
          for (int i = 0; i < 8; ++i) {
            float4 a4 = pa[i], k4 = pk[i], q4 = pq[i];
            S[4 * i + 0] = a4.x * S[4 * i + 0] + k4.x * vj; o += q4.x * S[4 * i + 0];
            S[4 * i + 1] = a4.y * S[4 * i + 1] + k4.y * vj; o += q4.y * S[4 * i + 1];
            S[4 * i + 2] = a4.z * S[4 * i + 2] + k4.z * vj; o += q4.z * S[4 * i + 2];
            S[4 * i + 3] = a4.w * S[4 * i + 3] + k4.w * vj; o += q4.w * S[4 * i + 3];
          }
          o += __shfl_xor(o, 1);
          if (r == 0) {
            const int t = dir == 0 ? c0 + tt : L - 1 - (c0 + tt);
            float* dst = p.tmp_gla + (size_t)(tok0 + t) * 512 + hd * 128 + j;
            if (dir == 1) *dst = o; else *dst += o;
          }
        }
      }
      if (prompt) {
        float* op = p.out + OUT_GLA + ((size_t)(((b * 2 + l) * 2 + dir) * 4 + hd)) * 8192;
#pragma unroll
        for (int i = 0; i < 32; ++i) op[(r * 32 + i) * 128 + j] = S[i];
      }
    }
    __syncthreads();
  }
}

DI void phase_gla_norm(const Params& p, int l) {
  const int tid = tid_(), lane = tid & 63, w = tid >> 6;
  for (int it = blockIdx.x; it < NTOK / 4; it += gridDim.x) {
    const int tok = it * 4 + w;
    const float* src = p.tmp_gla + (size_t)tok * 512 + lane * 8;
    float4 a = *(const float4*)src, b = *(const float4*)(src + 4);
    float ss = a.x * a.x + a.y * a.y + a.z * a.z + a.w * a.w + b.x * b.x + b.y * b.y + b.z * b.z + b.w * b.w;
    ss += __shfl_xor(ss, 1); ss += __shfl_xor(ss, 2); ss += __shfl_xor(ss, 4); ss += __shfl_xor(ss, 8);
    const float rs = rsqrtf(ss * (1.f / 128.f) + EPS);
    const float* g = p.gla_norm_g + l * 512 + lane * 8;
    uint4 gb = *(const uint4*)(p.proj + (size_t)tok * PW + OFF_GB + lane * 8);
    float o[8] = {a.x, a.y, a.z, a.w, b.x, b.y, b.z, b.w};
    unsigned gw[4] = {gb.x, gb.y, gb.z, gb.w};
    float res[8];
#pragma unroll
    for (int i = 0; i < 8; ++i) {
      float gt = (i & 1) ? __uint_as_float(gw[i >> 1] & 0xffff0000u) : __uint_as_float(gw[i >> 1] << 16);
      res[i] = o[i] * rs * g[i] * siluf_(gt);
    }
    uint4 ov;
    ov.x = pack2(res[0], res[1]); ov.y = pack2(res[2], res[3]); ov.z = pack2(res[4], res[5]); ov.w = pack2(res[6], res[7]);
    *(uint4*)(p.yb + (size_t)tok * 512 + lane * 8) = ov;
  }
}

DI void phase_merge(const Params& p, int l, char* smem) {
  const bfu* WA = p.w_paT + (size_t)l * 1024 * 512;
  const bfu* WB = p.w_pbT + (size_t)l * 1024 * 512;
  for (int it = blockIdx.x; it < 96 * 8; it += gridDim.x) {
    const int mt = it >> 3, nt = it & 7;
    const int m0 = mt * 128, n0 = nt * 128;
    f32x16 acc[2][2];
    acc_zero(acc);
    gemm_core(p.ya + (size_t)m0 * 512, 512, WA + (size_t)n0 * 512, 512, 512, smem, acc);
    EPI_LDS({
      float ma[8], o[8];
      unpack8(*(const uint4*)(p.proj + (size_t)(m0 + row) * PW + OFF_MA + n0 + c0), ma);
      _Pragma("unroll") for (int e = 0; e < 8; ++e) o[e] = sigmoidf_(ma[e]) * v[e];
      *(uint4*)(p.merged + (size_t)(m0 + row) * D + n0 + c0) = pack8(o);
    })
    acc_zero(acc);
    gemm_core(p.yb + (size_t)m0 * 512, 512, WB + (size_t)n0 * 512, 512, 512, smem, acc);
    EPI_LDS({
      float mb[8], o[8], pr[8];
      unpack8(*(const uint4*)(p.proj + (size_t)(m0 + row) * PW + OFF_MB + n0 + c0), mb);
      uint4* mp = (uint4*)(p.merged + (size_t)(m0 + row) * D + n0 + c0);
      unpack8(*mp, pr);
      _Pragma("unroll") for (int e = 0; e < 8; ++e) o[e] = pr[e] + sigmoidf_(mb[e]) * v[e];
      *mp = pack8(o);
    })
  }
}

DI void phase_out(const Params& p, int l, char* smem) {
  const bfu* W = p.w_oT + (size_t)l * 1024 * 1024;
  for (int it = blockIdx.x; it < 96 * 8; it += gridDim.x) {
    const int mt = it >> 3, nt = it & 7;
    const int m0 = mt * 128, n0 = nt * 128;
    f32x16 acc[2][2];
    acc_zero(acc);
    gemm_core(p.merged + (size_t)m0 * D, D, W + (size_t)n0 * 1024, 1024, 1024, smem, acc);
    const float* gate = p.mod + (size_t)(l * 5 + cond_of_tok(m0)) * 3072 + 2048;
    EPI_LDS({
      float* xp = p.out + (size_t)(m0 + row) * D + n0 + c0;
      const float* gp = gate + n0 + c0;
      float4 x0 = *(const float4*)xp, x1 = *(const float4*)(xp + 4);
      const float4 g0 = *(const float4*)gp, g1 = *(const float4*)(gp + 4);
      x0.x += g0.x * v[0]; x0.y += g0.y * v[1]; x0.z += g0.z * v[2]; x0.w += g0.w * v[3];
      x1.x += g1.x * v[4]; x1.y += g1.y * v[5]; x1.z += g1.z * v[6]; x1.w += g1.w * v[7];
      *(float4*)xp = x0; *(float4*)(xp + 4) = x1;
    })
  }
}

DI void phase_final(const Params& p) {
  const int tid = tid_(), lane = tid & 63, w = tid >> 6;
  for (int it = blockIdx.x; it < NTOK / 4; it += gridDim.x) {
    const int tok = it * 4 + w;
    float* xs = p.out + (size_t)tok * D;
    float4 v[4];
#pragma unroll
    for (int i = 0; i < 4; ++i) v[i] = *(const float4*)(xs + lane * 4 + 256 * i);
    float ss = 0.f;
#pragma unroll
    for (int i = 0; i < 4; ++i) ss += v[i].x * v[i].x + v[i].y * v[i].y + v[i].z * v[i].z + v[i].w * v[i].w;
    ss = wave_sum(ss);
    const float rstd = rsqrtf(ss * (1.f / 1024.f) + EPS);
#pragma unroll
    for (int i = 0; i < 4; ++i) {
      float4 g = *(const float4*)(p.final_g + lane * 4 + 256 * i);
      float4 o;
      o.x = v[i].x * rstd * g.x; o.y = v[i].y * rstd * g.y; o.z = v[i].z * rstd * g.z; o.w = v[i].w * rstd * g.w;
      *(float4*)(xs + lane * 4 + 256 * i) = o;
    }
  }
}

__global__ void __launch_bounds__(256, 2) k_phase(Params p, int ph, int l) {
  __shared__ __attribute__((aligned(16))) char smem[65536];
  switch (ph) {
    case 0: phase_prep(p, smem); break;
    case 1: phase_h(p, l); break;
    case 2: phase_gemm_in(p, l, smem); break;
    case 3: phase_s5_e(p, smem); break;
    case 10: phase_s5_gen(p, l, smem); break;
    case 11: phase_s5_scan(p, l); break;
    case 12: phase_s5_y(p, l, smem); break;
    case 4: phase_gla_simple(p, l, smem); break;
    case 5: phase_glu(p, l, smem); break;
    case 6: phase_gla_norm(p, l); break;
    case 7: phase_merge(p, l, smem); break;
    case 8: phase_out(p, l, smem); break;
    case 9: phase_final(p); break;
  }
}

__global__ void __launch_bounds__(256, 2) k_mega(Params p) {
  __shared__ __attribute__((aligned(16))) char smem[65536];
  cg::grid_group grid = cg::this_grid();
  phase_prep(p, smem);
  phase_s5_gen(p, 0, smem);
  grid.sync();
  for (int l = 0; l < 2; ++l) {
    phase_h(p, l);
    grid.sync();
    phase_gemm_in(p, l, smem);
    grid.sync();
    phase_s5_e(p, smem);
    phase_gla_simple(p, l, smem);
    grid.sync();
    phase_s5_scan(p, l);
    grid.sync();
    phase_s5_y(p, l, smem);
    phase_gla_norm(p, l);
    grid.sync();
    phase_glu(p, l, smem);
    if (l == 0) phase_s5_gen(p, 1, smem);
    grid.sync();
    phase_merge(p, l, smem);
    grid.sync();
    phase_out(p, l, smem);
    grid.sync();
  }
  phase_final(p);
}

extern "C" void kernel_launch(void* const* d_in, const int* in_sizes, int n_in, void* d_out, int out_size,
                              void* d_ws, size_t ws_size, hipStream_t stream) {
  Params p{};
  const float* const* in = (const float* const*)d_in;
  p.x_prompt = in[0]; p.x_sample = in[1]; p.c = in[2]; p.st_re = in[3]; p.st_im = in[4]; p.st_gla = in[5];
  p.c_ctx = in[6]; p.norm_g = in[7]; p.w_mod = in[8]; p.b_mod = in[9]; p.w_in = in[10]; p.wg_up = in[11];
  p.bg = in[12]; p.gla_norm_g = in[13]; p.lam_re = in[14]; p.lam_im = in[15]; p.log_dt = in[16];
  p.b_re = in[17]; p.b_im = in[18]; p.c_re = in[19]; p.c_im = in[20]; p.s5_d = in[21]; p.w_glu = in[22];
  p.b_glu = in[23]; p.w_pa = in[24]; p.w_pb = in[25]; p.w_o = in[26]; p.final_g = in[27];
  p.out = (float*)d_out;
  char* ws = (char*)d_ws;
  size_t off = 0;
  auto take = [&](size_t bytes) { char* r = ws + off; off += (bytes + 255) & ~(size_t)255; return r; };
  p.w_inT = (bfu*)take((size_t)2 * DINP * 1024 * 2);
  p.w_gluT = (bfu*)take((size_t)2 * 512 * 512 * 2);
  p.w_paT = (bfu*)take((size_t)2 * 1024 * 512 * 2);
  p.w_pbT = (bfu*)take((size_t)2 * 1024 * 512 * 2);
  p.w_oT = (bfu*)take((size_t)2 * 1024 * 1024 * 2);
  p.mod = (float*)take((size_t)2 * 5 * 3072 * 4);
  p.pos_r = (float*)take((size_t)32 * 512 * 4);
  p.pos_c = (float*)take((size_t)64 * 512 * 4);
  p.h = (bfu*)take((size_t)NTOK * D * 2);
  p.proj = (bfu*)take((size_t)NTOK * PW * 2);
  p.ys5 = (bfu*)take((size_t)NTOK * 512 * 2);
  p.ya = (bfu*)take((size_t)NTOK * 512 * 2);
  p.yb = (bfu*)take((size_t)NTOK * 512 * 2);
  p.merged = (bfu*)take((size_t)NTOK * D * 2);
  p.tmp_s5 = nullptr;
  p.ebuf = (float*)p.merged;
  p.carry = (bfu*)((char*)p.merged + (size_t)32 * NCHUNK * 256 * 4);
  p.ug = (bfu*)take((size_t)32 * NTOK * 16 * 2);
  p.opMG = (bfu*)take((size_t)32 * 512 * 768 * 2);
  p.opE = (bfu*)take((size_t)32 * 256 * 512 * 2);
  p.tmp_gla = (float*)p.h;
#if ONE_LAUNCH
  static int grid_blocks = 0;
  if (!grid_blocks) {
    int dev = 0, cus = 0, per_cu = 0;
    hipGetDevice(&dev);
    hipDeviceGetAttribute(&cus, hipDeviceAttributeMultiprocessorCount, dev);
    hipOccupancyMaxActiveBlocksPerMultiprocessor(&per_cu, k_mega, 256, 0);
    if (per_cu > 2) per_cu = 2;
    grid_blocks = cus * per_cu;
  }
  void* args[] = {&p};
  hipError_t e = hipLaunchCooperativeKernel((void*)k_mega, dim3(grid_blocks), dim3(256), args, 0, stream);
  if (e != hipSuccess) fprintf(stderr, "cooperative launch failed: %s (grid %d)\n", hipGetErrorString(e), grid_blocks);
#else
  const int G = 1024;
  k_phase<<<G, 256, 0, stream>>>(p, 0, 0);
  for (int l = 0; l < 2; ++l) {
    k_phase<<<G, 256, 0, stream>>>(p, 1, l);
    k_phase<<<G, 256, 0, stream>>>(p, 2, l);
    k_phase<<<G, 256, 0, stream>>>(p, 3, l);
    k_phase<<<G, 256, 0, stream>>>(p, 4, l);
    k_phase<<<G, 256, 0, stream>>>(p, 5, l);
    k_phase<<<G, 256, 0, stream>>>(p, 6, l);
    k_phase<<<G, 256, 0, stream>>>(p, 7, l);
    k_phase<<<G, 256, 0, stream>>>(p, 8, l);
  }
  k_phase<<<G, 256, 0, stream>>>(p, 9, 0);
#endif
}
```

```cpp
#include <hip/hip_runtime.h>
#include <hip/hip_cooperative_groups.h>
#include <stdint.h>
#include <math.h>
#include <stdio.h>
namespace cg = cooperative_groups;

#ifndef ONE_LAUNCH
#define ONE_LAUNCH 1
#endif

typedef unsigned short bfu;
typedef __attribute__((ext_vector_type(8))) short bf16x8;
typedef __attribute__((ext_vector_type(16))) float f32x16;
typedef __attribute__((ext_vector_type(2))) __bf16 bf2_t;
typedef __attribute__((ext_vector_type(2))) float f2_t;

#define DI __device__ __forceinline__

constexpr int D = 1024;
constexpr int NTOK = 12288;
constexpr int NPROMPT = 4096;
constexpr int DIN = 4624;
constexpr int DINP = 4736;
constexpr int PW = 4112;
constexpr int OFF_GA = 0, OFF_Q = 512, OFF_K = 768, OFF_V = 1024, OFF_GB = 1536, OFF_GL = 2048,
              OFF_MA = 2064, OFF_MB = 3088;
constexpr int NCHUNK = NTOK / 32;
constexpr size_t OUT_RE = (size_t)NTOK * D;
constexpr size_t OUT_IM = OUT_RE + 131072;
constexpr size_t OUT_GLA = OUT_IM + 131072;
constexpr float EPS = 1e-6f;

struct Params {
  const float *x_prompt, *x_sample, *c, *st_re, *st_im, *st_gla, *c_ctx, *norm_g, *w_mod, *b_mod, *w_in,
      *wg_up, *bg, *gla_norm_g, *lam_re, *lam_im, *log_dt, *b_re, *b_im, *c_re, *c_im, *s5_d, *w_glu,
      *b_glu, *w_pa, *w_pb, *w_o, *final_g;
  float* out;
  bfu *w_inT, *w_gluT, *w_paT, *w_pbT, *w_oT;
  float *mod, *pos_r, *pos_c, *tmp_s5, *tmp_gla;
  bfu *h, *proj, *ys5, *ya, *yb, *merged;
  bfu *ug, *opMG, *opE, *carry;
  float *ebuf, *gla_sloc, *gla_aseg;
};

DI int tid_() { int t = threadIdx.x; asm volatile("" : "+v"(t)); return t; }
DI float bf2f(bfu v) { return __uint_as_float(((unsigned)v) << 16); }
DI bfu f2bf(float x) { __bf16 b = (__bf16)x; return __builtin_bit_cast(unsigned short, b); }
DI unsigned pack2(float lo, float hi) {
  f2_t v = {lo, hi};
  bf2_t w = __builtin_convertvector(v, bf2_t);
  return __builtin_bit_cast(unsigned, w);
}
DI float sigmoidf_(float x) { return 1.f / (1.f + __expf(-x)); }
DI float siluf_(float x) { return x / (1.f + __expf(-x)); }
DI float geluf_(float x) {
  float u = 0.7978845608028654f * (x + 0.044715f * x * x * x);
  float t = 1.f - 2.f / (__expf(2.f * u) + 1.f);
  return 0.5f * x * (1.f + t);
}
DI float wave_sum(float v) {
#pragma unroll
  for (int o = 32; o >= 1; o >>= 1) v += __shfl_xor(v, o);
  return v;
}
DI int cond_of_tok(int tok) { return tok < NPROMPT ? 0 : 1 + ((tok - NPROMPT) >> 11); }

DI void transpose_tile(const float* __restrict__ src, int K, int N, bfu* __restrict__ dst, int kt, int nt,
                       float* sm) {
  const int tid = tid_(), c = tid & 63, r4 = tid >> 6;
  const int k0 = kt * 64, n0 = nt * 64;
#pragma unroll 4
  for (int i = 0; i < 16; ++i) {
    int k = i * 4 + r4, n = n0 + c;
    sm[k * 65 + c] = (n < N) ? src[(size_t)(k0 + k) * N + n] : 0.f;
  }
  __syncthreads();
#pragma unroll 4
  for (int i = 0; i < 16; ++i) {
    int n = i * 4 + r4;
    dst[(size_t)(n0 + n) * K + k0 + c] = f2bf(sm[c * 65 + n]);
  }
  __syncthreads();
}

DI void phase_prep(const Params& p, char* smem) {
  float* sm = (float*)smem;
  const int tid = tid_();
  for (int it = blockIdx.x; it < 96; it += gridDim.x) {
    const int l = it / 48, jb = it % 48;
    float* ssil = sm;
    float* sred = sm + 5 * 1024;
    for (int idx = tid; idx < 5120; idx += 256) {
      int ci = idx >> 10, k = idx & 1023;
      float cv = (ci == 0) ? p.c_ctx[k] : p.c[(ci - 1) * 1024 + k];
      ssil[idx] = cv / (1.f + expf(-cv));
    }
    __syncthreads();
    const int jj = tid & 63, kq = tid >> 6;
    const int j = jb * 64 + jj;
    float acc[5] = {0.f, 0.f, 0.f, 0.f, 0.f};
    const float* wp = p.w_mod + ((size_t)l * 1024 + kq * 256) * 3072 + j;
#pragma unroll 8
    for (int k = 0; k < 256; ++k) {
      float w = wp[(size_t)k * 3072];
#pragma unroll
      for (int ci = 0; ci < 5; ++ci) acc[ci] += ssil[ci * 1024 + kq * 256 + k] * w;
    }
#pragma unroll
    for (int ci = 0; ci < 5; ++ci) sred[(kq * 5 + ci) * 64 + jj] = acc[ci];
    __syncthreads();
    for (int idx = tid; idx < 320; idx += 256) {
      int ci = idx >> 6, j2 = idx & 63;
      float s = p.b_mod[l * 3072 + jb * 64 + j2];
#pragma unroll
      for (int q = 0; q < 4; ++q) s += sred[(q * 5 + ci) * 64 + j2];
      p.mod[(size_t)(l * 5 + ci) * 3072 + jb * 64 + j2] = s;
    }
    __syncthreads();
  }
  for (int idx = blockIdx.x * 256 + tid; idx < 96 * 512; idx += gridDim.x * 256) {
    int r = idx >> 9, i = idx & 511;
    int pos = r < 32 ? r : r - 32;
    int q = i & 255;
    double f = exp(-log(10000.0) * (double)q / 256.0);
    double ang = (double)pos * f;
    float v = (float)((i < 256) ? sin(ang) : cos(ang));
    if (r < 32) p.pos_r[r * 512 + i] = v; else p.pos_c[(r - 32) * 512 + i] = v;
  }
  for (int it = blockIdx.x; it < 3520; it += gridDim.x) {
    int l = it / 1760, r = it % 1760;
    if (r < 1184) {
      transpose_tile(p.w_in + (size_t)l * 1024 * DIN, 1024, DIN, p.w_inT + (size_t)l * DINP * 1024, r % 16, r / 16, sm);
    } else if (r < 1248) {
      r -= 1184;
      transpose_tile(p.w_glu + (size_t)l * 512 * 512, 512, 512, p.w_gluT + (size_t)l * 512 * 512, r % 8, r / 8, sm);
    } else if (r < 1376) {
      r -= 1248;
      transpose_tile(p.w_pa + (size_t)l * 512 * 1024, 512, 1024, p.w_paT + (size_t)l * 1024 * 512, r % 8, r / 8, sm);
    } else if (r < 1504) {
      r -= 1376;
      transpose_tile(p.w_pb + (size_t)l * 512 * 1024, 512, 1024, p.w_pbT + (size_t)l * 1024 * 512, r % 8, r / 8, sm);
    } else {
      r -= 1504;
      transpose_tile(p.w_o + (size_t)l * 1024 * 1024, 1024, 1024, p.w_oT + (size_t)l * 1024 * 1024, r % 16, r / 16, sm);
    }
  }
}

DI void phase_h(const Params& p, int l) {
  const int tid = tid_(), lane = tid & 63, w = tid >> 6;
  for (int it = blockIdx.x; it < NTOK / 4; it += gridDim.x) {
    const int tok = it * 4 + w;
    float4 v[4];
    float* xs = p.out + (size_t)tok * D;
    if (l == 0) {
      const float* src = tok < NPROMPT ? p.x_prompt + (size_t)tok * D : p.x_sample + (size_t)(tok - NPROMPT) * D;
#pragma unroll
      for (int i = 0; i < 4; ++i) v[i] = *(const float4*)(src + lane * 4 + 256 * i);
      if (tok >= NPROMPT) {
        int t = (tok - NPROMPT) & 2047, row = t >> 6, col = t & 63;
#pragma unroll
        for (int i = 0; i < 4; ++i) {
          int d = lane * 4 + 256 * i;
          const float* pe = d < 512 ? p.pos_r + row * 512 + d : p.pos_c + col * 512 + (d - 512);
          float4 e = *(const float4*)pe;
          v[i].x += e.x; v[i].y += e.y; v[i].z += e.z; v[i].w += e.w;
        }
      }
#pragma unroll
      for (int i = 0; i < 4; ++i) *(float4*)(xs + lane * 4 + 256 * i) = v[i];
    } else {
#pragma unroll
      for (int i = 0; i < 4; ++i) v[i] = *(const float4*)(xs + lane * 4 + 256 * i);
    }
    float ss = 0.f;
#pragma unroll
    for (int i = 0; i < 4; ++i) ss += v[i].x * v[i].x + v[i].y * v[i].y + v[i].z * v[i].z + v[i].w * v[i].w;
    ss = wave_sum(ss);
    const float rstd = rsqrtf(ss * (1.f / 1024.f) + EPS);
    const float* md = p.mod + (size_t)(l * 5 + cond_of_tok(tok)) * 3072;
    const float* ng = p.norm_g + l * 1024;
#pragma unroll
    for (int i = 0; i < 4; ++i) {
      int d = lane * 4 + 256 * i;
      float4 g = *(const float4*)(ng + d);
      float4 sh = *(const float4*)(md + d);
      float4 sc = *(const float4*)(md + 1024 + d);
      float a0 = v[i].x * rstd * g.x * (1.f + sc.x) + sh.x;
      float a1 = v[i].y * rstd * g.y * (1.f + sc.y) + sh.y;
      float a2 = v[i].z * rstd * g.z * (1.f + sc.z) + sh.z;
      float a3 = v[i].w * rstd * g.w * (1.f + sc.w) + sh.w;
      uint2 o; o.x = pack2(a0, a1); o.y = pack2(a2, a3);
      *(uint2*)(p.h + (size_t)tok * D + d) = o;
    }
  }
}

DI void gemm_core(const bfu* __restrict__ A, int lda, const bfu* __restrict__ B, int ldb, int K, char* smem,
                  f32x16 (&acc)[2][2]) {
  const int tid = tid_(), lane = tid & 63, w = tid >> 6, wm = w >> 1, wn = w & 1;
  const int c8 = tid & 7, r0 = tid >> 3;
  const bfu* ga = A + (size_t)r0 * lda + c8 * 8;
  const bfu* gb = B + (size_t)r0 * ldb + c8 * 8;
  const int st_off = r0 * 128 + ((c8 ^ ((r0 >> 1) & 7)) * 16);
  const int fr = lane & 31, hh = lane >> 5, fsw = (fr >> 1) & 7;
  const int a_base = (wm * 64 + fr) * 128;
  const int b_base = 16384 + (wn * 64 + fr) * 128;
  uint4 ra[4], rb[4];
#pragma unroll
  for (int i = 0; i < 4; ++i) {
    ra[i] = *(const uint4*)(ga + (size_t)i * 32 * lda);
    rb[i] = *(const uint4*)(gb + (size_t)i * 32 * ldb);
  }
#pragma unroll
  for (int i = 0; i < 4; ++i) {
    *(uint4*)(smem + st_off + i * 4096) = ra[i];
    *(uint4*)(smem + 16384 + st_off + i * 4096) = rb[i];
  }
  __syncthreads();
  const int KT = K >> 6;
#define GEMM_COMPUTE(cur)                                                                  \
  _Pragma("unroll") for (int s = 0; s < 4; ++s) {                                          \
    const int co = ((2 * s + hh) ^ fsw) * 16;                                              \
    bf16x8 a0 = *(const bf16x8*)((cur) + a_base + co);                                     \
    bf16x8 a1 = *(const bf16x8*)((cur) + a_base + 4096 + co);                              \
    bf16x8 b0 = *(const bf16x8*)((cur) + b_base + co);                                     \
    bf16x8 b1 = *(const bf16x8*)((cur) + b_base + 4096 + co);                              \
    acc[0][0] = __builtin_amdgcn_mfma_f32_32x32x16_bf16(a0, b0, acc[0][0], 0, 0, 0);       \
    acc[0][1] = __builtin_amdgcn_mfma_f32_32x32x16_bf16(a0, b1, acc[0][1], 0, 0, 0);       \
    acc[1][0] = __builtin_amdgcn_mfma_f32_32x32x16_bf16(a1, b0, acc[1][0], 0, 0, 0);       \
    acc[1][1] = __builtin_amdgcn_mfma_f32_32x32x16_bf16(a1, b1, acc[1][1], 0, 0, 0);       \
  }
#define GEMM_LOAD()                                                                        \
  _Pragma("unroll") for (int i = 0; i < 4; ++i) {                                          \
    ra[i] = *(const uint4*)(ga + (size_t)i * 32 * lda);                                    \
    rb[i] = *(const uint4*)(gb + (size_t)i * 32 * ldb);                                    \
  }
#define GEMM_STORE(buf)                                                                    \
  _Pragma("unroll") for (int i = 0; i < 4; ++i) {                                          \
    *(uint4*)((buf) + st_off + i * 4096) = ra[i];                                          \
    *(uint4*)((buf) + 16384 + st_off + i * 4096) = rb[i];                                  \
  }
#pragma unroll 1
  for (int kt = 0; kt < KT; kt += 2) {
    ga += 64; gb += 64;
    GEMM_LOAD()
    GEMM_COMPUTE(smem)
    GEMM_STORE(smem + 32768)
    __syncthreads();
    const int adv = (kt + 2 < KT) ? 64 : 0;
    ga += adv; gb += adv;
    GEMM_LOAD()
    GEMM_COMPUTE(smem + 32768)
    GEMM_STORE(smem)
    __syncthreads();
  }
}

DI void acc_zero(f32x16 (&acc)[2][2]) {
#pragma unroll
  for (int i = 0; i < 2; ++i)
#pragma unroll
    for (int j = 0; j < 2; ++j)
#pragma unroll
      for (int r = 0; r < 16; ++r) acc[i][j][r] = 0.f;
}

DI void acc_to_lds(const f32x16 (&acc)[2][2], char* smem) {
  float* sf = (float*)smem;
  const int tid = tid_(), lane = tid & 63, w = tid >> 6;
  const int rb = (w >> 1) * 64 + 4 * (lane >> 5), cb = (w & 1) * 64 + (lane & 31);
#pragma unroll
  for (int i = 0; i < 2; ++i)
#pragma unroll
    for (int j = 0; j < 2; ++j)
#pragma unroll
      for (int r = 0; r < 16; ++r)
        sf[(rb + i * 32 + (r & 3) + 8 * (r >> 2)) * 128 + cb + j * 32] = acc[i][j][r];
}
DI void unpack8(const uint4 v, float (&f)[8]) {
  f[0] = __uint_as_float(v.x << 16); f[1] = __uint_as_float(v.x & 0xffff0000u);
  f[2] = __uint_as_float(v.y << 16); f[3] = __uint_as_float(v.y & 0xffff0000u);
  f[4] = __uint_as_float(v.z << 16); f[5] = __uint_as_float(v.z & 0xffff0000u);
  f[6] = __uint_as_float(v.w << 16); f[7] = __uint_as_float(v.w & 0xffff0000u);
}
DI uint4 pack8(const float (&f)[8]) {
  uint4 o;
  o.x = pack2(f[0], f[1]); o.y = pack2(f[2], f[3]); o.z = pack2(f[4], f[5]); o.w = pack2(f[6], f[7]);
  return o;
}
#define EPI_LDS(...)                                                             \
  {                                                                              \
    acc_to_lds(acc, smem);                                                       \
    __syncthreads();                                                             \
    _Pragma("unroll 1") for (int it_ = 0; it_ < 8; ++it_) {                      \
      const int row = (tid_() >> 4) + 16 * it_;                             \
      const int c0 = (tid_() & 15) * 8;                                     \
      float v[8];                                                                \
      {                                                                          \
        const float4 t0 = *(const float4*)(smem + (row * 128 + c0) * 4);         \
        const float4 t1 = *(const float4*)(smem + (row * 128 + c0 + 4) * 4);     \
        v[0] = t0.x; v[1] = t0.y; v[2] = t0.z; v[3] = t0.w;                      \
        v[4] = t1.x; v[5] = t1.y; v[6] = t1.z; v[7] = t1.w;                      \
      }                                                                          \
      __VA_ARGS__                                                                \
    }                                                                            \
    __syncthreads();                                                             \
  }

DI void phase_gemm_in(const Params& p, int l, char* smem) {
  const bfu* W = p.w_inT + (size_t)l * DINP * 1024;
  for (int it = blockIdx.x; it < 96 * 37; it += gridDim.x) {
    const int mt = it / 37, nt = it % 37;
    f32x16 acc[2][2];
    acc_zero(acc);
    gemm_core(p.h + (size_t)mt * 128 * D, D, W + (size_t)nt * 128 * 1024, 1024, 1024, smem, acc);
    const int m0 = mt * 128, n0 = nt * 128;
    EPI_LDS({
      const int n = n0 + c0;
      if (n < 512) *(uint4*)(p.ug + ((size_t)(n >> 4) * NTOK + (m0 + row)) * 16 + (n & 15)) = pack8(v);
      else if (n < DIN) *(uint4*)(p.proj + (size_t)(m0 + row) * PW + (n - 512)) = pack8(v);
    })
  }
}

DI void s5_gen_item(const Params& p, int l, int item, char* smem) {
  const int tid = tid_();
  const int g = item >> 3, r = item & 7;
  float* sBr = (float*)smem;
  float* sBi = sBr + 2048;
  float* sCr = sBi + 2048;
  float* sCi = sCr + 1024;
  float* sAK = sCi + 1024;
  float* sAE = sAK + 1024;
  float* sAG = sAE + 1024;
  float* sK = sAG + 1024;
  bfu* E = p.opE + (size_t)g * 256 * 512;
  bfu* MG = p.opMG + (size_t)g * 512 * 768;
  __syncthreads();
  if (tid < 128) {
    const int d = tid >> 6, pp = tid & 63;
    const size_t pi = ((size_t)(l * 2 + d) * 32 + g) * 64 + pp;
    const float lr = p.lam_re[pi], li = p.lam_im[pi];
    const float dt = expf(p.log_dt[(l * 2 + d) * 32 + g]);
    const float mag = expf(lr * dt);
    float sn, cs;
    sincosf(li * dt, &sn, &cs);
    const float are = mag * cs, aim = mag * sn;
    const float nr = are - 1.f, ni = aim, den = lr * lr + li * li;
    const float kr = (nr * lr + ni * li) / den, ki = (ni * lr - nr * li) / den;
#pragma unroll
    for (int c = 0; c < 16; ++c) {
      float br = p.b_re[((size_t)(l * 32 + g) * 64 + pp) * 16 + c];
      float bi = p.b_im[((size_t)(l * 32 + g) * 64 + pp) * 16 + c];
      sBr[(d * 64 + pp) * 16 + c] = kr * br - ki * bi;
      sBi[(d * 64 + pp) * 16 + c] = kr * bi + ki * br;
    }
#pragma unroll
    for (int q = 0; q < 4; ++q) {
      const int t = 4 * r + q;
      const int nK = t;
      const int nE = d == 0 ? 31 - t : t;
      const int nG = d == 0 ? t + 1 : 32 - t;
      float m, s_, c_;
      m = expf(lr * dt * (float)nK); sincosf(li * dt * (float)nK, &s_, &c_);
      sAK[((d * 4 + q) * 64 + pp) * 2] = m * c_; sAK[((d * 4 + q) * 64 + pp) * 2 + 1] = m * s_;
      m = expf(lr * dt * (float)nE); sincosf(li * dt * (float)nE, &s_, &c_);
      sAE[((d * 4 + q) * 64 + pp) * 2] = m * c_; sAE[((d * 4 + q) * 64 + pp) * 2 + 1] = m * s_;
      m = expf(lr * dt * (float)nG); sincosf(li * dt * (float)nG, &s_, &c_);
      sAG[((d * 4 + q) * 64 + pp) * 2] = m * c_; sAG[((d * 4 + q) * 64 + pp) * 2 + 1] = m * s_;
    }
  } else {
    for (int idx = tid - 128; idx < 1024; idx += 128) {
      sCr[idx] = p.c_re[(size_t)(l * 32 + g) * 1024 + idx];
      sCi[idx] = p.c_im[(size_t)(l * 32 + g) * 1024 + idx];
    }
  }
  __syncthreads();
  for (int idx = tid; idx < 256 * 64; idx += 256) {
    const int row = idx >> 6, cc = idx & 63, q = cc >> 4, c = cc & 15;
    const int part = row >> 6, pp = row & 63, d = part >> 1;
    const float ar = sAE[((d * 4 + q) * 64 + pp) * 2], ai = sAE[((d * 4 + q) * 64 + pp) * 2 + 1];
    const float br = sBr[(d * 64 + pp) * 16 + c], bi = sBi[(d * 64 + pp) * 16 + c];
    const float v = (part & 1) ? (ar * bi + ai * br) : (ar * br - ai * bi);
    E[(size_t)row * 512 + (4 * r + q) * 16 + c] = f2bf(v);
  }
  for (int idx = tid; idx < 64 * 256; idx += 256) {
    const int rr = idx >> 8, col = idx & 255, q = rr >> 4, c = rr & 15;
    const int part = col >> 6, pp = col & 63, d = part >> 1;
    const float ar = sAG[((d * 4 + q) * 64 + pp) * 2], ai = sAG[((d * 4 + q) * 64 + pp) * 2 + 1];
    const float cr = sCr[c * 64 + pp], ci = sCi[c * 64 + pp];
    const float v = (part & 1) ? -(cr * ai + ci * ar) : (cr * ar - ci * ai);
    MG[(size_t)((4 * r + q) * 16 + c) * 768 + 512 + col] = f2bf(v);
  }
  {
    const int d = tid >> 7, q = (tid >> 5) & 3, c = (tid >> 1) & 15, ch = tid & 1;
    float acc[8];
#pragma unroll
    for (int e = 0; e < 8; ++e) acc[e] = 0.f;
    for (int pp = 0; pp < 64; ++pp) {
      const float ar = sAK[((d * 4 + q) * 64 + pp) * 2], ai = sAK[((d * 4 + q) * 64 + pp) * 2 + 1];
      const float cr = sCr[c * 64 + pp], ci = sCi[c * 64 + pp];
      const float wr = cr * ar - ci * ai, wi = cr * ai + ci * ar;
#pragma unroll
      for (int e = 0; e < 8; ++e)
        acc[e] += wr * sBr[(d * 64 + pp) * 16 + ch * 8 + e] - wi * sBi[(d * 64 + pp) * 16 + ch * 8 + e];
    }
#pragma unroll
    for (int e = 0; e < 8; ++e) sK[((d * 4 + q) * 16 + c) * 16 + ch * 8 + e] = acc[e];
  }
  __syncthreads();
  for (int idx = tid; idx < 8192; idx += 256) {
    const int ch = idx & 1, c = (idx >> 1) & 15, tp = (idx >> 5) & 31, q = (idx >> 10) & 3, d = idx >> 12;
    const int tau = 4 * r + q;
    int sp;
    bool valid;
    if (d == 0) { sp = tp - tau; valid = sp >= 0; } else { sp = tp + tau; valid = (sp <= 31) && (tau > 0); }
    if (valid) {
      float v[8];
#pragma unroll
      for (int e = 0; e < 8; ++e) {
        float x = sK[((d * 4 + q) * 16 + c) * 16 + ch * 8 + e];
        if (tau == 0) x += sK[((1 * 4 + q) * 16 + c) * 16 + ch * 8 + e];
        v[e] = x;
      }
      *(uint4*)(MG + (size_t)(tp * 16 + c) * 768 + sp * 16 + ch * 8) = pack8(v);
    }
  }
  __syncthreads();
}

DI void phase_s5_gen(const Params& p, int l, char* smem) {
  for (int it = gridDim.x - 1 - blockIdx.x; it < 256; it += gridDim.x) s5_gen_item(p, l, it, smem);
}

DI void phase_s5_e(const Params& p, char* smem) {
  for (int it = blockIdx.x; it < 32 * 3 * 2; it += gridDim.x) {
    const int g = it / 6, r6 = it % 6, mt = r6 >> 1, nt = r6 & 1;
    f32x16 acc[2][2];
    acc_zero(acc);
    gemm_core(p.ug + ((size_t)g * NCHUNK + mt * 128) * 512, 512, p.opE + ((size_t)g * 256 + nt * 128) * 512, 512, 512,
              smem, acc);
    EPI_LDS({
      float* dst = p.ebuf + ((size_t)g * NCHUNK + mt * 128 + row) * 256 + nt * 128 + c0;
      *(float4*)dst = make_float4(v[0], v[1], v[2], v[3]);
      *(float4*)(dst + 4) = make_float4(v[4], v[5], v[6], v[7]);
    })
  }
}

DI void phase_s5_scan(const Params& p, int l) {
  const int tid = tid_();
  for (int it = blockIdx.x; it < 320; it += gridDim.x) {
    const int wi = it * 2 + (tid >> 7);
    const int dir = (tid >> 6) & 1, pp = tid & 63;
    int chunk0, n, b, g;
    bool prompt;
    if (wi < 128) { b = wi >> 5; g = wi & 31; chunk0 = (NPROMPT + b * 2048) >> 5; n = 64; prompt = false; }
    else { int q = wi - 128; b = q >> 5; g = q & 31; chunk0 = (b * 256) >> 5; n = 8; prompt = true; }
    const size_t pi = ((size_t)(l * 2 + dir) * 32 + g) * 64 + pp;
    const float lr = p.lam_re[pi], li = p.lam_im[pi];
    const float dt = expf(p.log_dt[(l * 2 + dir) * 32 + g]);
    const float mag = expf(lr * dt * 32.f);
    float sn, cs;
    sincosf(li * dt * 32.f, &sn, &cs);
    const float are = mag * cs, aim = mag * sn;
    float hre = 0.f, him = 0.f;
    if (!prompt) {
      size_t si = ((size_t)((b * 2 + l) * 2 + dir)) * 2048 + g * 64 + pp;
      hre = p.st_re[si]; him = p.st_im[si];
    }
    const float* eb = p.ebuf + ((size_t)g * NCHUNK + chunk0) * 256 + dir * 128 + pp;
    bfu* cb = p.carry + ((size_t)g * NCHUNK + chunk0) * 256 + dir * 128 + pp;
    for (int k0 = 0; k0 < n; k0 += 8) {
      float er[8], ei[8];
#pragma unroll
      for (int j = 0; j < 8; ++j) {
        const int k = dir == 0 ? k0 + j : n - 1 - (k0 + j);
        er[j] = eb[(size_t)k * 256];
        ei[j] = eb[(size_t)k * 256 + 64];
      }
#pragma unroll
      for (int j = 0; j < 8; ++j) {
        const int k = dir == 0 ? k0 + j : n - 1 - (k0 + j);
        cb[(size_t)k * 256] = f2bf(hre);
        cb[(size_t)k * 256 + 64] = f2bf(him);
        const float nre = are * hre - aim * him + er[j];
        const float nim = are * him + aim * hre + ei[j];
        hre = nre; him = nim;
      }
    }
    if (prompt) {
      size_t oi = ((size_t)((b * 2 + l) * 2 + dir)) * 2048 + g * 64 + pp;
      p.out[OUT_RE + oi] = hre;
      p.out[OUT_IM + oi] = him;
    }
  }
}

DI void phase_s5_y(const Params& p, int l, char* smem) {
  for (int it = blockIdx.x; it < 32 * 3 * 4; it += gridDim.x) {
    const int g = it / 12, r12 = it % 12, mt = r12 >> 2, nt = r12 & 3;
    f32x16 acc[2][2];
    acc_zero(acc);
    const bfu* Bm = p.opMG + ((size_t)g * 512 + nt * 128) * 768;
    gemm_core(p.ug + ((size_t)g * NCHUNK + mt * 128) * 512, 512, Bm, 768, 512, smem, acc);
    gemm_core(p.carry + ((size_t)g * NCHUNK + mt * 128) * 256, 256, Bm + 512, 768, 256, smem, acc);
    EPI_LDS({
      const int chunk = mt * 128 + row, nn = nt * 128 + c0, tp = nn >> 4, c = nn & 15;
      const int tok = chunk * 32 + tp;
      float u[8], o[8];
      unpack8(*(const uint4*)(p.ug + ((size_t)g * NTOK + tok) * 16 + c), u);
      const float* dsk = p.s5_d + l * 512 + g * 16 + c;
      _Pragma("unroll") for (int e = 0; e < 8; ++e) o[e] = geluf_(v[e] + dsk[e] * u[e]);
      *(uint4*)(p.ys5 + (size_t)tok * 512 + g * 16 + c) = pack8(o);
    })
  }
}

DI void phase_glu(const Params& p, int l, char* smem) {
  const bfu* W = p.w_gluT + (size_t)l * 512 * 512;
  for (int it = blockIdx.x; it < 96 * 4; it += gridDim.x) {
    const int mt = it >> 2, nt = it & 3;
    f32x16 acc[2][2];
    acc_zero(acc);
    gemm_core(p.ys5 + (size_t)mt * 128 * 512, 512, W + (size_t)nt * 128 * 512, 512, 512, smem, acc);
    const int m0 = mt * 128, n0 = nt * 128;
    EPI_LDS({
      const int n = n0 + c0;
      const size_t tk = (size_t)(m0 + row);
      float y[8], ga[8], o[8];
      unpack8(*(const uint4*)(p.ys5 + tk * 512 + n), y);
      unpack8(*(const uint4*)(p.proj + tk * PW + OFF_GA + n), ga);
      const float* bg = p.b_glu + l * 512 + n;
      _Pragma("unroll") for (int e = 0; e < 8; ++e) o[e] = y[e] * sigmoidf_(v[e] + bg[e]) * siluf_(ga[e]);
      *(uint4*)(p.ya + tk * 512 + n) = pack8(o);
    })
  }
}

constexpr int GL_QS = 0;
constexpr int GL_KS = GL_QS + 32 * 144;
constexpr int GL_KHT = GL_KS + 32 * 144;
constexpr int GL_VT = GL_KHT + 64 * 80;
constexpr int GL_PS = GL_VT + 128 * 80;
constexpr int GL_ST = GL_PS + 32 * 80;
constexpr int GL_AV = GL_ST + 128 * 144;
constexpr int GL_TOT = GL_AV + 256;
constexpr int GL_OS = GL_TOT + 1024;
static_assert(GL_OS + 32 * 132 * 4 <= 65536, "gla lds");

DI void gla_segment_info(int seg, int& tok_base, bool& prompt, int& b, int& sidx) {
  if (seg < 16) { prompt = true; b = seg; sidx = 0; tok_base = seg * 256; }
  else { int q = seg - 16; prompt = false; b = q >> 3; sidx = q & 7; tok_base = NPROMPT + b * 2048 + sidx * 256; }
}

template <bool STATE_ONLY>
DI void gla_chain(const Params& p, int l, char* smem, int seg, int hd, int dir) {
  const int tid = tid_(), lane = tid & 63, w = tid >> 6;
  const int fr = lane & 31, hh = lane >> 5;
  int tok_base, b, sidx;
  bool prompt;
  gla_segment_info(seg, tok_base, prompt, b, sidx);
  const int dk = tid & 63, tq = tid >> 6;
  const int dvl = tid & 127, th = tid >> 7;
  float wg[16];
#pragma unroll
  for (int q = 0; q < 16; ++q) wg[q] = p.wg_up[((size_t)(l * 2 + dir) * 16 + q) * 256 + hd * 64 + dk];
  const float bgv = p.bg[(l * 2 + dir) * 256 + hd * 64 + dk];
  float* sAv = (float*)(smem + GL_AV);
  float* sTot = (float*)(smem + GL_TOT);
  float* sOs = (float*)(smem + GL_OS);

  f32x16 S[2];
  {
    const int dvc = 32 * w + fr;
    if (STATE_ONLY || prompt) {
#pragma unroll
      for (int mt = 0; mt < 2; ++mt)
#pragma unroll
        for (int r = 0; r < 16; ++r) S[mt][r] = 0.f;
    } else {
      const float* sp = p.st_gla + ((size_t)(((b * 2 + l) * 2 + dir) * 4 + hd)) * 8192;
#pragma unroll
      for (int mt = 0; mt < 2; ++mt)
#pragma unroll
        for (int r = 0; r < 16; ++r) S[mt][r] = sp[(32 * mt + (r & 3) + 8 * (r >> 2) + 4 * hh) * 128 + dvc];
      const int nprev = dir == 0 ? sidx : 7 - sidx;
      for (int q = 0; q < nprev; ++q) {
        const int sprev = dir == 0 ? q : 7 - q;
        const size_t ci = (size_t)(((b * 8 + sprev) * 4 + hd) * 2 + dir);
        const float* sl = p.gla_sloc + ci * 8192;
        const float* al = p.gla_aseg + ci * 64;
#pragma unroll
        for (int mt = 0; mt < 2; ++mt)
#pragma unroll
          for (int r = 0; r < 16; ++r) {
            const int dkk = 32 * mt + (r & 3) + 8 * (r >> 2) + 4 * hh;
            S[mt][r] = al[dkk] * S[mt][r] + sl[dkk * 128 + dvc];
          }
      }
    }
  }
  float bsum = 0.f;
  __syncthreads();
  if (!STATE_ONLY) {
    const int dvc = 32 * w + fr;
#pragma unroll
    for (int mt = 0; mt < 2; ++mt)
#pragma unroll
      for (int q = 0; q < 4; ++q) {
        uint2 pk;
        pk.x = pack2(S[mt][4 * q], S[mt][4 * q + 1]);
        pk.y = pack2(S[mt][4 * q + 2], S[mt][4 * q + 3]);
        *(uint2*)(smem + GL_ST + dvc * 144 + (32 * mt + 8 * q + 4 * hh) * 2) = pk;
      }
  }

#pragma unroll 1
  for (int n = 0; n < 8; ++n) {
    const int cn = dir == 0 ? n : 7 - n;
    const int ctok0 = tok_base + cn * 32;
    float qv[8], kv[8], bl[8];
    {
      float run = 0.f;
#pragma unroll
      for (int i = 0; i < 8; ++i) {
        const int tau = tq * 8 + i;
        const int t = dir == 0 ? tau : 31 - tau;
        const bfu* pr = p.proj + (size_t)(ctok0 + t) * PW;
        if (!STATE_ONLY) qv[i] = bf2f(pr[OFF_Q + hd * 64 + dk]) * 0.125f;
        kv[i] = bf2f(pr[OFF_K + hd * 64 + dk]);
        float gl[16];
        unpack8(*(const uint4*)(pr + OFF_GL), *(float(*)[8])&gl[0]);
        unpack8(*(const uint4*)(pr + OFF_GL + 8), *(float(*)[8])&gl[8]);
        float lg = bgv;
#pragma unroll
        for (int q = 0; q < 16; ++q) lg += gl[q] * wg[q];
        const float ls = fminf(lg, 0.f) - __logf(1.f + __expf(-fabsf(lg)));
        run += ls * (1.f / 16.f);
        bl[i] = run;
      }
      sTot[tq * 64 + dk] = run;
    }
    {
      unsigned pk[8];
#pragma unroll
      for (int i = 0; i < 8; ++i) {
        const int tau0 = th * 16 + 2 * i;
        const int t0 = dir == 0 ? tau0 : 31 - tau0;
        const int t1 = dir == 0 ? tau0 + 1 : 30 - tau0;
        const unsigned lo = p.proj[(size_t)(ctok0 + t0) * PW + OFF_V + hd * 128 + dvl];
        const unsigned hi = p.proj[(size_t)(ctok0 + t1) * PW + OFF_V + hd * 128 + dvl];
        pk[i] = lo | (hi << 16);
      }
      *(uint4*)(smem + GL_VT + dvl * 80 + th * 32) = make_uint4(pk[0], pk[1], pk[2], pk[3]);
      *(uint4*)(smem + GL_VT + dvl * 80 + th * 32 + 16) = make_uint4(pk[4], pk[5], pk[6], pk[7]);
    }
    __syncthreads();
    {
      float off = 0.f, total = 0.f;
#pragma unroll
      for (int q = 0; q < 4; ++q) {
        const float tv = sTot[q * 64 + dk];
        total += tv;
        off += (q < tq) ? tv : 0.f;
      }
      unsigned kh[4];
      float khv[8];
#pragma unroll
      for (int i = 0; i < 8; ++i) {
        const float bb = off + bl[i];
        const int tau = tq * 8 + i;
        if (!STATE_ONLY) {
          *(bfu*)(smem + GL_QS + tau * 144 + dk * 2) = f2bf(qv[i] * __expf(bb));
          *(bfu*)(smem + GL_KS + tau * 144 + dk * 2) = f2bf(kv[i] * __expf(-bb));
        }
        khv[i] = kv[i] * __expf(total - bb);
      }
#pragma unroll
      for (int i = 0; i < 4; ++i) kh[i] = pack2(khv[2 * i], khv[2 * i + 1]);
      *(uint4*)(smem + GL_KHT + dk * 80 + tq * 16) = make_uint4(kh[0], kh[1], kh[2], kh[3]);
      if (tq == 0) { sAv[dk] = __expf(total); bsum += total; }
    }
    __syncthreads();
    f32x16 o;
    if (!STATE_ONLY) {
      f32x16 sc;
#pragma unroll
      for (int r = 0; r < 16; ++r) sc[r] = 0.f;
#pragma unroll
      for (int s4 = 0; s4 < 4; ++s4) {
        bf16x8 a = *(const bf16x8*)(smem + GL_QS + fr * 144 + (16 * s4 + 8 * hh) * 2);
        bf16x8 bq = *(const bf16x8*)(smem + GL_KS + fr * 144 + (16 * s4 + 8 * hh) * 2);
        sc = __builtin_amdgcn_mfma_f32_32x32x16_bf16(a, bq, sc, 0, 0, 0);
      }
#pragma unroll
      for (int rr = 0; rr < 4; ++rr) {
        float val = w == 0 ? sc[rr] : (w == 1 ? sc[4 + rr] : (w == 2 ? sc[8 + rr] : sc[12 + rr]));
        const int i = rr + 8 * w + 4 * hh;
        val = (fr <= i) ? val : 0.f;
        *(bfu*)(smem + GL_PS + i * 80 + fr * 2) = f2bf(val);
      }
      __syncthreads();
#pragma unroll
      for (int r = 0; r < 16; ++r) o[r] = 0.f;
    }
    {
      const int dvc = 32 * w + fr;
      bf16x8 vb0 = *(const bf16x8*)(smem + GL_VT + dvc * 80 + (8 * hh) * 2);
      bf16x8 vb1 = *(const bf16x8*)(smem + GL_VT + dvc * 80 + (16 + 8 * hh) * 2);
      if (!STATE_ONLY) {
        bf16x8 pa0 = *(const bf16x8*)(smem + GL_PS + fr * 80 + (8 * hh) * 2);
        bf16x8 pa1 = *(const bf16x8*)(smem + GL_PS + fr * 80 + (16 + 8 * hh) * 2);
        o = __builtin_amdgcn_mfma_f32_32x32x16_bf16(pa0, vb0, o, 0, 0, 0);
        o = __builtin_amdgcn_mfma_f32_32x32x16_bf16(pa1, vb1, o, 0, 0, 0);
#pragma unroll
        for (int s4 = 0; s4 < 4; ++s4) {
          bf16x8 a = *(const bf16x8*)(smem + GL_QS + fr * 144 + (16 * s4 + 8 * hh) * 2);
          bf16x8 sb = *(const bf16x8*)(smem + GL_ST + dvc * 144 + (16 * s4 + 8 * hh) * 2);
          o = __builtin_amdgcn_mfma_f32_32x32x16_bf16(a, sb, o, 0, 0, 0);
        }
      }
#pragma unroll
      for (int mt = 0; mt < 2; ++mt) {
        f32x16 U;
#pragma unroll
        for (int r = 0; r < 16; ++r) U[r] = 0.f;
        bf16x8 ka0 = *(const bf16x8*)(smem + GL_KHT + (32 * mt + fr) * 80 + (8 * hh) * 2);
        bf16x8 ka1 = *(const bf16x8*)(smem + GL_KHT + (32 * mt + fr) * 80 + (16 + 8 * hh) * 2);
        U = __builtin_amdgcn_mfma_f32_32x32x16_bf16(ka0, vb0, U, 0, 0, 0);
        U = __builtin_amdgcn_mfma_f32_32x32x16_bf16(ka1, vb1, U, 0, 0, 0);
#pragma unroll
        for (int q = 0; q < 4; ++q) {
          const float4 av = *(const float4*)(sAv + 32 * mt + 8 * q + 4 * hh);
          S[mt][4 * q + 0] = av.x * S[mt][4 * q + 0] + U[4 * q + 0];
          S[mt][4 * q + 1] = av.y * S[mt][4 * q + 1] + U[4 * q + 1];
          S[mt][4 * q + 2] = av.z * S[mt][4 * q + 2] + U[4 * q + 2];
          S[mt][4 * q + 3] = av.w * S[mt][4 * q + 3] + U[4 * q + 3];
          if (!STATE_ONLY) {
            uint2 pk;
            pk.x = pack2(S[mt][4 * q], S[mt][4 * q + 1]);
            pk.y = pack2(S[mt][4 * q + 2], S[mt][4 * q + 3]);
            *(uint2*)(smem + GL_ST + dvc * 144 + (32 * mt + 8 * q + 4 * hh) * 2) = pk;
          }
        }
      }
      if (!STATE_ONLY) {
#pragma unroll
        for (int r = 0; r < 16; ++r) sOs[((r & 3) + 8 * (r >> 2) + 4 * hh) * 132 + dvc] = o[r];
      }
    }
    __syncthreads();
    if (!STATE_ONLY) {
      const int t = tid >> 3, part = tid & 7;
      const int tau = dir == 0 ? t : 31 - t;
      const size_t tok = (size_t)(ctok0 + t);
      float ov[16];
#pragma unroll
      for (int q = 0; q < 4; ++q) {
        const float4 x = *(const float4*)(sOs + tau * 132 + part * 16 + 4 * q);
        ov[4 * q] = x.x; ov[4 * q + 1] = x.y; ov[4 * q + 2] = x.z; ov[4 * q + 3] = x.w;
      }
      float* tp = p.tmp_gla + tok * 512 + hd * 128 + part * 16;
      if (dir == 1) {
#pragma unroll
        for (int q = 0; q < 4; ++q) *(float4*)(tp + 4 * q) = make_float4(ov[4 * q], ov[4 * q + 1], ov[4 * q + 2], ov[4 * q + 3]);
      } else {
        float ss = 0.f;
#pragma unroll
        for (int q = 0; q < 4; ++q) {
          const float4 x = *(const float4*)(tp + 4 * q);
          ov[4 * q] += x.x; ov[4 * q + 1] += x.y; ov[4 * q + 2] += x.z; ov[4 * q + 3] += x.w;
        }
#pragma unroll
        for (int e = 0; e < 16; ++e) ss += ov[e] * ov[e];
        ss += __shfl_xor(ss, 1); ss += __shfl_xor(ss, 2); ss += __shfl_xor(ss, 4);
        const float rs = rsqrtf(ss * (1.f / 128.f) + EPS);
        const float* gn = p.gla_norm_g + l * 512 + hd * 128 + part * 16;
        float gt[16];
        const bfu* gp = p.proj + tok * PW + OFF_GB + hd * 128 + part * 16;
        unpack8(*(const uint4*)gp, *(float(*)[8])&gt[0]);
        unpack8(*(const uint4*)(gp + 8), *(float(*)[8])&gt[8]);
        float res[16];
#pragma unroll
        for (int e = 0; e < 16; ++e) res[e] = ov[e] * rs * gn[e] * siluf_(gt[e]);
        bfu* yp = p.yb + tok * 512 + hd * 128 + part * 16;
        *(uint4*)yp = pack8(*(float(*)[8])&res[0]);
        *(uint4*)(yp + 8) = pack8(*(float(*)[8])&res[8]);
      }
    }
  }
  const int dvc = 32 * w + fr;
  if (STATE_ONLY) {
    const size_t ci = (size_t)(((b * 8 + sidx) * 4 + hd) * 2 + dir);
    float* sl = p.gla_sloc + ci * 8192;
#pragma unroll
    for (int mt = 0; mt < 2; ++mt)
#pragma unroll
      for (int r = 0; r < 16; ++r) sl[(32 * mt + (r & 3) + 8 * (r >> 2) + 4 * hh) * 128 + dvc] = S[mt][r];
    if (tq == 0) p.gla_aseg[ci * 64 + dk] = __expf(bsum);
  } else if (prompt) {
    float* op = p.out + OUT_GLA + ((size_t)(((b * 2 + l) * 2 + dir) * 4 + hd)) * 8192;
#pragma unroll
    for (int mt = 0; mt < 2; ++mt)
#pragma unroll
      for (int r = 0; r < 16; ++r) op[(32 * mt + (r & 3) + 8 * (r >> 2) + 4 * hh) * 128 + dvc] = S[mt][r];
  }
  __syncthreads();
}

DI void phase_gla_pass1(const Params& p, int l, char* smem) {
  for (int it = gridDim.x - 1 - blockIdx.x; it < 256; it += gridDim.x) {
    const int dir = it & 1, hd = (it >> 1) & 3, seg = 16 + (it >> 3);
    gla_chain<true>(p, l, smem, seg, hd, dir);
  }
}
DI void phase_gla_main(const Params& p, int l, char* smem) {
  for (int it = gridDim.x - 1 - blockIdx.x; it < 192; it += gridDim.x) {
    const int hd = it & 3, seg = it >> 2;
    gla_chain<false>(p, l, smem, seg, hd, 1);
    gla_chain<false>(p, l, smem, seg, hd, 0);
  }
}

DI void phase_merge(const Params& p, int l, char* smem) {
  const bfu* WA = p.w_paT + (size_t)l * 1024 * 512;
  const bfu* WB = p.w_pbT + (size_t)l * 1024 * 512;
  for (int it = blockIdx.x; it < 96 * 8; it += gridDim.x) {
    const int mt = it >> 3, nt = it & 7;
    const int m0 = mt * 128, n0 = nt * 128;
    f32x16 acc[2][2];
    acc_zero(acc);
    gemm_core(p.ya + (size_t)m0 * 512, 512, WA + (size_t)n0 * 512, 512, 512, smem, acc);
    EPI_LDS({
      float ma[8], o[8];
      unpack8(*(const uint4*)(p.proj + (size_t)(m0 + row) * PW + OFF_MA + n0 + c0), ma);
      _Pragma("unroll") for (int e = 0; e < 8; ++e) o[e] = sigmoidf_(ma[e]) * v[e];
      *(uint4*)(p.merged + (size_t)(m0 + row) * D + n0 + c0) = pack8(o);
    })
    acc_zero(acc);
    gemm_core(p.yb + (size_t)m0 * 512, 512, WB + (size_t)n0 * 512, 512, 512, smem, acc);
    EPI_LDS({
      float mb[8], o[8], pr[8];
      unpack8(*(const uint4*)(p.proj + (size_t)(m0 + row) * PW + OFF_MB + n0 + c0), mb);
      uint4* mp = (uint4*)(p.merged + (size_t)(m0 + row) * D + n0 + c0);
      unpack8(*mp, pr);
      _Pragma("unroll") for (int e = 0; e < 8; ++e) o[e] = pr[e] + sigmoidf_(mb[e]) * v[e];
      *mp = pack8(o);
    })
  }
}

DI void phase_out(const Params& p, int l, char* smem) {
  const bfu* W = p.w_oT + (size_t)l * 1024 * 1024;
  for (int it = blockIdx.x; it < 96 * 8; it += gridDim.x) {
    const int mt = it >> 3, nt = it & 7;
    const int m0 = mt * 128, n0 = nt * 128;
    f32x16 acc[2][2];
    acc_zero(acc);
    gemm_core(p.merged + (size_t)m0 * D, D, W + (size_t)n0 * 1024, 1024, 1024, smem, acc);
    const float* gate = p.mod + (size_t)(l * 5 + cond_of_tok(m0)) * 3072 + 2048;
    EPI_LDS({
      float* xp = p.out + (size_t)(m0 + row) * D + n0 + c0;
      const float* gp = gate + n0 + c0;
      float4 x0 = *(const float4*)xp, x1 = *(const float4*)(xp + 4);
      const float4 g0 = *(const float4*)gp, g1 = *(const float4*)(gp + 4);
      x0.x += g0.x * v[0]; x0.y += g0.y * v[1]; x0.z += g0.z * v[2]; x0.w += g0.w * v[3];
      x1.x += g1.x * v[4]; x1.y += g1.y * v[5]; x1.z += g1.z * v[6]; x1.w += g1.w * v[7];
      *(float4*)xp = x0; *(float4*)(xp + 4) = x1;
    })
  }
}

DI void phase_final(const Params& p) {
  const int tid = tid_(), lane = tid & 63, w = tid >> 6;
  for (int it = blockIdx.x; it < NTOK / 4; it += gridDim.x) {
    const int tok = it * 4 + w;
    float* xs = p.out + (size_t)tok * D;
    float4 v[4];
#pragma unroll
    for (int i = 0; i < 4; ++i) v[i] = *(const float4*)(xs + lane * 4 + 256 * i);
    float ss = 0.f;
#pragma unroll
    for (int i = 0; i < 4; ++i) ss += v[i].x * v[i].x + v[i].y * v[i].y + v[i].z * v[i].z + v[i].w * v[i].w;
    ss = wave_sum(ss);
    const float rstd = rsqrtf(ss * (1.f / 1024.f) + EPS);
#pragma unroll
    for (int i = 0; i < 4; ++i) {
      float4 g = *(const float4*)(p.final_g + lane * 4 + 256 * i);
      float4 o;
      o.x = v[i].x * rstd * g.x; o.y = v[i].y * rstd * g.y; o.z = v[i].z * rstd * g.z; o.w = v[i].w * rstd * g.w;
      *(float4*)(xs + lane * 4 + 256 * i) = o;
    }
  }
}

__global__ void __launch_bounds__(256, 2) k_phase(Params p, int ph, int l) {
  __shared__ __attribute__((aligned(16))) char smem[65536];
  switch (ph) {
    case 0: phase_prep(p, smem); break;
    case 1: phase_h(p, l); break;
    case 2: phase_gemm_in(p, l, smem); break;
    case 3: phase_s5_e(p, smem); break;
    case 10: phase_s5_gen(p, l, smem); break;
    case 11: phase_s5_scan(p, l); break;
    case 12: phase_s5_y(p, l, smem); break;
    case 4: phase_gla_pass1(p, l, smem); break;
    case 5: phase_glu(p, l, smem); break;
    case 6: phase_gla_main(p, l, smem); break;
    case 7: phase_merge(p, l, smem); break;
    case 8: phase_out(p, l, smem); break;
    case 9: phase_final(p); break;
  }
}

__global__ void __launch_bounds__(256, 2) k_mega(Params p) {
  __shared__ __attribute__((aligned(16))) char smem[65536];
  cg::grid_group grid = cg::this_grid();
  phase_prep(p, smem);
  phase_s5_gen(p, 0, smem);
  grid.sync();
  for (int l = 0; l < 2; ++l) {
    phase_h(p, l);
    grid.sync();
    phase_gemm_in(p, l, smem);
    grid.sync();
    phase_s5_e(p, smem);
    phase_gla_pass1(p, l, smem);
    grid.sync();
    phase_s5_scan(p, l);
    phase_gla_main(p, l, smem);
    grid.sync();
    phase_s5_y(p, l, smem);
    grid.sync();
    phase_glu(p, l, smem);
    if (l == 0) phase_s5_gen(p, 1, smem);
    grid.sync();
    phase_merge(p, l, smem);
    grid.sync();
    phase_out(p, l, smem);
    grid.sync();
  }
  phase_final(p);
}

extern "C" void kernel_launch(void* const* d_in, const int* in_sizes, int n_in, void* d_out, int out_size,
                              void* d_ws, size_t ws_size, hipStream_t stream) {
  Params p{};
  const float* const* in = (const float* const*)d_in;
  p.x_prompt = in[0]; p.x_sample = in[1]; p.c = in[2]; p.st_re = in[3]; p.st_im = in[4]; p.st_gla = in[5];
  p.c_ctx = in[6]; p.norm_g = in[7]; p.w_mod = in[8]; p.b_mod = in[9]; p.w_in = in[10]; p.wg_up = in[11];
  p.bg = in[12]; p.gla_norm_g = in[13]; p.lam_re = in[14]; p.lam_im = in[15]; p.log_dt = in[16];
  p.b_re = in[17]; p.b_im = in[18]; p.c_re = in[19]; p.c_im = in[20]; p.s5_d = in[21]; p.w_glu = in[22];
  p.b_glu = in[23]; p.w_pa = in[24]; p.w_pb = in[25]; p.w_o = in[26]; p.final_g = in[27];
  p.out = (float*)d_out;
  char* ws = (char*)d_ws;
  size_t off = 0;
  auto take = [&](size_t bytes) { char* r = ws + off; off += (bytes + 255) & ~(size_t)255; return r; };
  p.w_inT = (bfu*)take((size_t)2 * DINP * 1024 * 2);
  p.w_gluT = (bfu*)take((size_t)2 * 512 * 512 * 2);
  p.w_paT = (bfu*)take((size_t)2 * 1024 * 512 * 2);
  p.w_pbT = (bfu*)take((size_t)2 * 1024 * 512 * 2);
  p.w_oT = (bfu*)take((size_t)2 * 1024 * 1024 * 2);
  p.mod = (float*)take((size_t)2 * 5 * 3072 * 4);
  p.pos_r = (float*)take((size_t)32 * 512 * 4);
  p.pos_c = (float*)take((size_t)64 * 512 * 4);
  p.h = (bfu*)take((size_t)NTOK * D * 2);
  p.proj = (bfu*)take((size_t)NTOK * PW * 2);
  p.ys5 = (bfu*)take((size_t)NTOK * 512 * 2);
  p.ya = (bfu*)take((size_t)NTOK * 512 * 2);
  p.yb = (bfu*)take((size_t)NTOK * 512 * 2);
  p.merged = (bfu*)take((size_t)NTOK * D * 2);
  p.tmp_s5 = nullptr;
  p.ebuf = (float*)p.merged;
  p.carry = (bfu*)((char*)p.merged + (size_t)32 * NCHUNK * 256 * 4);
  p.ug = (bfu*)take((size_t)32 * NTOK * 16 * 2);
  p.opMG = (bfu*)take((size_t)32 * 512 * 768 * 2);
  p.opE = (bfu*)take((size_t)32 * 256 * 512 * 2);
  p.gla_sloc = (float*)p.ys5;
  p.gla_aseg = (float*)((char*)p.ys5 + (size_t)256 * 8192 * 4);
  p.tmp_gla = (float*)p.h;
#if ONE_LAUNCH
  static int grid_blocks = 0;
  if (!grid_blocks) {
    int dev = 0, cus = 0, per_cu = 0;
    hipGetDevice(&dev);
    hipDeviceGetAttribute(&cus, hipDeviceAttributeMultiprocessorCount, dev);
    hipOccupancyMaxActiveBlocksPerMultiprocessor(&per_cu, k_mega, 256, 0);
    if (per_cu > 2) per_cu = 2;
    grid_blocks = cus * per_cu;
  }
  void* args[] = {&p};
  hipError_t e = hipLaunchCooperativeKernel((void*)k_mega, dim3(grid_blocks), dim3(256), args, 0, stream);
  if (e != hipSuccess) fprintf(stderr, "cooperative launch failed: %s (grid %d)\n", hipGetErrorString(e), grid_blocks);
#else
  const int G = 1024;
  k_phase<<<G, 256, 0, stream>>>(p, 0, 0);
  for (int l = 0; l < 2; ++l) {
    k_phase<<<G, 256, 0, stream>>>(p, 1, l);
    k_phase<<<G, 256, 0, stream>>>(p, 2, l);
    k_phase<<<G, 256, 0, stream>>>(p, 3, l);
    k_phase<<<G, 256, 0, stream>>>(p, 4, l);
    k_phase<<<G, 256, 0, stream>>>(p, 5, l);
    k_phase<<<G, 256, 0, stream>>>(p, 6, l);
    k_phase<<<G, 256, 0, stream>>>(p, 7, l);
    k_phase<<<G, 256, 0, stream>>>(p, 8, l);
  }
  k_phase<<<G, 256, 0, stream>>>(p, 9, 0);
#endif
}
```

```cpp
#include <hip/hip_runtime.h>
#include <hip/hip_cooperative_groups.h>
#include <stdint.h>
#include <math.h>
#include <stdio.h>
namespace cg = cooperative_groups;

#ifndef REP_PREP
#define REP_PREP 0
#endif
#ifndef REP_GIN
#define REP_GIN 0
#endif
#ifndef REP_X1
#define REP_X1 0
#endif
#ifndef REP_X2
#define REP_X2 0
#endif
#ifndef REP_Y
#define REP_Y 0
#endif
#ifndef REP_MERGE
#define REP_MERGE 0
#endif
#ifndef REP_SYNC
#define REP_SYNC 0
#endif
#ifndef ONE_LAUNCH
#define ONE_LAUNCH 1
#endif

typedef unsigned short bfu;
typedef __attribute__((ext_vector_type(8))) short bf16x8;
typedef __attribute__((ext_vector_type(16))) float f32x16;
typedef __attribute__((ext_vector_type(2))) __bf16 bf2_t;
typedef __attribute__((ext_vector_type(2))) float f2_t;

#define DI __device__ __forceinline__

constexpr int D = 1024;
constexpr int NTOK = 12288;
constexpr int NPROMPT = 4096;
constexpr int DIN = 4624;
constexpr int DINP = 4864;
constexpr int LDH = 1088;
constexpr int PW = 4112;
constexpr int OFF_GA = 0, OFF_Q = 512, OFF_K = 768, OFF_V = 1024, OFF_GB = 1536, OFF_GL = 2048,
              OFF_MA = 2064, OFF_MB = 3088;
constexpr int NCHUNK = NTOK / 32;
constexpr size_t OUT_RE = (size_t)NTOK * D;
constexpr size_t OUT_IM = OUT_RE + 131072;
constexpr size_t OUT_GLA = OUT_IM + 131072;
constexpr float EPS = 1e-6f;

struct Params {
  const float *x_prompt, *x_sample, *c, *st_re, *st_im, *st_gla, *c_ctx, *norm_g, *w_mod, *b_mod, *w_in,
      *wg_up, *bg, *gla_norm_g, *lam_re, *lam_im, *log_dt, *b_re, *b_im, *c_re, *c_im, *s5_d, *w_glu,
      *b_glu, *w_pa, *w_pb, *w_o, *final_g;
  float* out;
  bfu *w_inT, *w_gluT, *w_paT, *w_pbT, *w_oT;
  float *mod, *pos_r, *pos_c, *tmp_s5, *tmp_gla;
  bfu *h, *proj, *ys5, *ya, *yb, *merged;
  bfu *ug, *opMG, *opE, *carry;
  float *ebuf, *gla_sloc, *gla_aseg;
};

DI int tid_() { int t = threadIdx.x & 255; asm volatile("" : "+v"(t)); return t; }
#define VHALF ((int)__builtin_amdgcn_readfirstlane((int)(threadIdx.x >> 8)))
#define VBID ((int)(blockIdx.x * 2 + VHALF))
#define NVB ((int)(gridDim.x * 2))
#define VXCD ((int)(blockIdx.x & 7))
#define VJ ((int)((blockIdx.x >> 3) * 2 + VHALF))
#define VNLOC ((int)((gridDim.x >> 3) * 2))
DI float bf2f(bfu v) { return __uint_as_float(((unsigned)v) << 16); }
DI bfu f2bf(float x) { __bf16 b = (__bf16)x; return __builtin_bit_cast(unsigned short, b); }
DI unsigned pack2(float lo, float hi) {
  f2_t v = {lo, hi};
  bf2_t w = __builtin_convertvector(v, bf2_t);
  return __builtin_bit_cast(unsigned, w);
}
DI float sigmoidf_(float x) { return 1.f / (1.f + __expf(-x)); }
DI float siluf_(float x) { return x / (1.f + __expf(-x)); }
DI float geluf_(float x) {
  float u = 0.7978845608028654f * (x + 0.044715f * x * x * x);
  float t = 1.f - 2.f / (__expf(2.f * u) + 1.f);
  return 0.5f * x * (1.f + t);
}
DI float wave_sum(float v) {
#pragma unroll
  for (int o = 32; o >= 1; o >>= 1) v += __shfl_xor(v, o);
  return v;
}
DI int cond_of_tok(int tok) { return tok < NPROMPT ? 0 : 1 + ((tok - NPROMPT) >> 11); }

DI void transpose_tile(const float* __restrict__ src, int K, int N, bfu* __restrict__ dst, int kt, int nt,
                       float* sm, int ldd = 0) {
  if (ldd == 0) ldd = K;
  const int tid = tid_(), c = tid & 63, r4 = tid >> 6;
  const int k0 = kt * 64, n0 = nt * 64;
#pragma unroll 4
  for (int i = 0; i < 16; ++i) {
    int k = i * 4 + r4, n = n0 + c;
    sm[k * 65 + c] = (n < N) ? src[(size_t)(k0 + k) * N + n] : 0.f;
  }
  __syncthreads();
#pragma unroll 4
  for (int i = 0; i < 16; ++i) {
    int n = i * 4 + r4;
    dst[(size_t)(n0 + n) * ldd + k0 + c] = f2bf(sm[c * 65 + n]);
  }
  __syncthreads();
}

DI void phase_prep(const Params& p, char* smem) {
  float* sm = (float*)smem;
  const int tid = tid_();
  for (int it = VBID; it < 96; it += NVB) {
    const int l = it / 48, jb = it % 48;
    float* ssil = sm;
    float* sred = sm + 5 * 1024;
    for (int idx = tid; idx < 5120; idx += 256) {
      int ci = idx >> 10, k = idx & 1023;
      float cv = (ci == 0) ? p.c_ctx[k] : p.c[(ci - 1) * 1024 + k];
      ssil[idx] = cv / (1.f + expf(-cv));
    }
    __syncthreads();
    const int jj = tid & 63, kq = tid >> 6;
    const int j = jb * 64 + jj;
    float acc[5] = {0.f, 0.f, 0.f, 0.f, 0.f};
    const float* wp = p.w_mod + ((size_t)l * 1024 + kq * 256) * 3072 + j;
#pragma unroll 8
    for (int k = 0; k < 256; ++k) {
      float w = wp[(size_t)k * 3072];
#pragma unroll
      for (int ci = 0; ci < 5; ++ci) acc[ci] += ssil[ci * 1024 + kq * 256 + k] * w;
    }
#pragma unroll
    for (int ci = 0; ci < 5; ++ci) sred[(kq * 5 + ci) * 64 + jj] = acc[ci];
    __syncthreads();
    for (int idx = tid; idx < 320; idx += 256) {
      int ci = idx >> 6, j2 = idx & 63;
      float s = p.b_mod[l * 3072 + jb * 64 + j2];
#pragma unroll
      for (int q = 0; q < 4; ++q) s += sred[(q * 5 + ci) * 64 + j2];
      p.mod[(size_t)(l * 5 + ci) * 3072 + jb * 64 + j2] = s;
    }
    __syncthreads();
  }
  for (int idx = VBID * 256 + tid; idx < 96 * 512; idx += NVB * 256) {
    int r = idx >> 9, i = idx & 511;
    int pos = r < 32 ? r : r - 32;
    int q = i & 255;
    double f = exp(-log(10000.0) * (double)q / 256.0);
    double ang = (double)pos * f;
    float v = (float)((i < 256) ? sin(ang) : cos(ang));
    if (r < 32) p.pos_r[r * 512 + i] = v; else p.pos_c[(r - 32) * 512 + i] = v;
  }
  for (int it = VBID; it < 3584; it += NVB) {
    int l = it / 1792, r = it % 1792;
    if (r < 1216) {
      transpose_tile(p.w_in + (size_t)l * 1024 * DIN, 1024, DIN, p.w_inT + (size_t)l * DINP * LDH, r % 16, r / 16, sm, LDH);
    } else if (r < 1280) {
      r -= 1216;
      transpose_tile(p.w_glu + (size_t)l * 512 * 512, 512, 512, p.w_gluT + (size_t)l * 512 * 512, r % 8, r / 8, sm);
    } else if (r < 1408) {
      r -= 1280;
      transpose_tile(p.w_pa + (size_t)l * 512 * 1024, 512, 1024, p.w_paT + (size_t)l * 1024 * 512, r % 8, r / 8, sm);
    } else if (r < 1536) {
      r -= 1408;
      transpose_tile(p.w_pb + (size_t)l * 512 * 1024, 512, 1024, p.w_pbT + (size_t)l * 1024 * 512, r % 8, r / 8, sm);
    } else {
      r -= 1536;
      transpose_tile(p.w_o + (size_t)l * 1024 * 1024, 1024, 1024, p.w_oT + (size_t)l * 1024 * 1024, r % 16, r / 16, sm);
    }
  }
}

DI void phase_h(const Params& p, int l) {
  const int tid = tid_(), lane = tid & 63, w = tid >> 6;
  for (int it = VBID; it < NTOK / 4; it += NVB) {
    const int tok = it * 4 + w;
    float4 v[4];
    float* xs = p.out + (size_t)tok * D;
    if (l == 0) {
      const float* src = tok < NPROMPT ? p.x_prompt + (size_t)tok * D : p.x_sample + (size_t)(tok - NPROMPT) * D;
#pragma unroll
      for (int i = 0; i < 4; ++i) v[i] = *(const float4*)(src + lane * 4 + 256 * i);
      if (tok >= NPROMPT) {
        int t = (tok - NPROMPT) & 2047, row = t >> 6, col = t & 63;
#pragma unroll
        for (int i = 0; i < 4; ++i) {
          int d = lane * 4 + 256 * i;
          const float* pe = d < 512 ? p.pos_r + row * 512 + d : p.pos_c + col * 512 + (d - 512);
          float4 e = *(const float4*)pe;
          v[i].x += e.x; v[i].y += e.y; v[i].z += e.z; v[i].w += e.w;
        }
      }
#pragma unroll
      for (int i = 0; i < 4; ++i) *(float4*)(xs + lane * 4 + 256 * i) = v[i];
    } else {
#pragma unroll
      for (int i = 0; i < 4; ++i) v[i] = *(const float4*)(xs + lane * 4 + 256 * i);
    }
    float ss = 0.f;
#pragma unroll
    for (int i = 0; i < 4; ++i) ss += v[i].x * v[i].x + v[i].y * v[i].y + v[i].z * v[i].z + v[i].w * v[i].w;
    ss = wave_sum(ss);
    const float rstd = rsqrtf(ss * (1.f / 1024.f) + EPS);
    const float* md = p.mod + (size_t)(l * 5 + cond_of_tok(tok)) * 3072;
    const float* ng = p.norm_g + l * 1024;
#pragma unroll
    for (int i = 0; i < 4; ++i) {
      int d = lane * 4 + 256 * i;
      float4 g = *(const float4*)(ng + d);
      float4 sh = *(const float4*)(md + d);
      float4 sc = *(const float4*)(md + 1024 + d);
      float a0 = v[i].x * rstd * g.x * (1.f + sc.x) + sh.x;
      float a1 = v[i].y * rstd * g.y * (1.f + sc.y) + sh.y;
      float a2 = v[i].z * rstd * g.z * (1.f + sc.z) + sh.z;
      float a3 = v[i].w * rstd * g.w * (1.f + sc.w) + sh.w;
      uint2 o; o.x = pack2(a0, a1); o.y = pack2(a2, a3);
      *(uint2*)(p.h + (size_t)tok * LDH + d) = o;
    }
  }
}

DI void gemm_core(const bfu* __restrict__ A, int lda, const bfu* __restrict__ B, int ldb, int K, char* smem,
                  f32x16 (&acc)[2][2]) {
  const int tid = tid_(), lane = tid & 63, w = tid >> 6, wm = w >> 1, wn = w & 1;
  const int c8 = tid & 7, r0 = tid >> 3;
  const bfu* ga = A + (size_t)r0 * lda + c8 * 8;
  const bfu* gb = B + (size_t)r0 * ldb + c8 * 8;
  const int st_off = r0 * 128 + ((c8 ^ ((r0 >> 1) & 7)) * 16);
  const int fr = lane & 31, hh = lane >> 5, fsw = (fr >> 1) & 7;
  const int a_base = (wm * 64 + fr) * 128;
  const int b_base = 16384 + (wn * 64 + fr) * 128;
  uint4 ra[4], rb[4];
#pragma unroll
  for (int i = 0; i < 4; ++i) {
    ra[i] = *(const uint4*)(ga + (size_t)i * 32 * lda);
    rb[i] = *(const uint4*)(gb + (size_t)i * 32 * ldb);
  }
#pragma unroll
  for (int i = 0; i < 4; ++i) {
    *(uint4*)(smem + st_off + i * 4096) = ra[i];
    *(uint4*)(smem + 16384 + st_off + i * 4096) = rb[i];
  }
  __syncthreads();
  const int KT = K >> 6;
#define GEMM_COMPUTE(cur)                                                                  \
  _Pragma("unroll") for (int s = 0; s < 4; ++s) {                                          \
    const int co = ((2 * s + hh) ^ fsw) * 16;                                              \
    bf16x8 a0 = *(const bf16x8*)((cur) + a_base + co);                                     \
    bf16x8 a1 = *(const bf16x8*)((cur) + a_base + 4096 + co);                              \
    bf16x8 b0 = *(const bf16x8*)((cur) + b_base + co);                                     \
    bf16x8 b1 = *(const bf16x8*)((cur) + b_base + 4096 + co);                              \
    acc[0][0] = __builtin_amdgcn_mfma_f32_32x32x16_bf16(a0, b0, acc[0][0], 0, 0, 0);       \
    acc[0][1] = __builtin_amdgcn_mfma_f32_32x32x16_bf16(a0, b1, acc[0][1], 0, 0, 0);       \
    acc[1][0] = __builtin_amdgcn_mfma_f32_32x32x16_bf16(a1, b0, acc[1][0], 0, 0, 0);       \
    acc[1][1] = __builtin_amdgcn_mfma_f32_32x32x16_bf16(a1, b1, acc[1][1], 0, 0, 0);       \
  }
#define GEMM_LOAD()                                                                        \
  _Pragma("unroll") for (int i = 0; i < 4; ++i) {                                          \
    ra[i] = *(const uint4*)(ga + (size_t)i * 32 * lda);                                    \
    rb[i] = *(const uint4*)(gb + (size_t)i * 32 * ldb);                                    \
  }
#define GEMM_STORE(buf)                                                                    \
  _Pragma("unroll") for (int i = 0; i < 4; ++i) {                                          \
    *(uint4*)((buf) + st_off + i * 4096) = ra[i];                                          \
    *(uint4*)((buf) + 16384 + st_off + i * 4096) = rb[i];                                  \
  }
#pragma unroll 1
  for (int kt = 0; kt < KT; kt += 2) {
    ga += 64; gb += 64;
    GEMM_LOAD()
    __builtin_amdgcn_sched_barrier(0);
    GEMM_COMPUTE(smem)
    __builtin_amdgcn_sched_barrier(0);
    GEMM_STORE(smem + 32768)
    __syncthreads();
    const int adv = (kt + 2 < KT) ? 64 : 0;
    ga += adv; gb += adv;
    GEMM_LOAD()
    __builtin_amdgcn_sched_barrier(0);
    GEMM_COMPUTE(smem + 32768)
    __builtin_amdgcn_sched_barrier(0);
    GEMM_STORE(smem)
    __syncthreads();
  }
}

DI void acc_zero(f32x16 (&acc)[2][2]) {
#pragma unroll
  for (int i = 0; i < 2; ++i)
#pragma unroll
    for (int j = 0; j < 2; ++j)
#pragma unroll
      for (int r = 0; r < 16; ++r) acc[i][j][r] = 0.f;
}

DI void acc_to_lds(const f32x16 (&acc)[2][2], char* smem) {
  float* sf = (float*)smem;
  const int tid = tid_(), lane = tid & 63, w = tid >> 6;
  const int rb = (w >> 1) * 64 + 4 * (lane >> 5), cb = (w & 1) * 64 + (lane & 31);
#pragma unroll
  for (int i = 0; i < 2; ++i)
#pragma unroll
    for (int j = 0; j < 2; ++j)
#pragma unroll
      for (int r = 0; r < 16; ++r)
        sf[(rb + i * 32 + (r & 3) + 8 * (r >> 2)) * 128 + cb + j * 32] = acc[i][j][r];
}
DI void unpack8(const uint4 v, float (&f)[8]) {
  f[0] = __uint_as_float(v.x << 16); f[1] = __uint_as_float(v.x & 0xffff0000u);
  f[2] = __uint_as_float(v.y << 16); f[3] = __uint_as_float(v.y & 0xffff0000u);
  f[4] = __uint_as_float(v.z << 16); f[5] = __uint_as_float(v.z & 0xffff0000u);
  f[6] = __uint_as_float(v.w << 16); f[7] = __uint_as_float(v.w & 0xffff0000u);
}
DI uint4 pack8(const float (&f)[8]) {
  uint4 o;
  o.x = pack2(f[0], f[1]); o.y = pack2(f[2], f[3]); o.z = pack2(f[4], f[5]); o.w = pack2(f[6], f[7]);
  return o;
}
#define EPI_LDS(...)                                                             \
  {                                                                              \
    acc_to_lds(acc, smem);                                                       \
    __syncthreads();                                                             \
    _Pragma("unroll 1") for (int it_ = 0; it_ < 8; ++it_) {                      \
      const int row = (tid_() >> 4) + 16 * it_;                             \
      const int c0 = (tid_() & 15) * 8;                                     \
      float v[8];                                                                \
      {                                                                          \
        const float4 t0 = *(const float4*)(smem + (row * 128 + c0) * 4);         \
        const float4 t1 = *(const float4*)(smem + (row * 128 + c0 + 4) * 4);     \
        v[0] = t0.x; v[1] = t0.y; v[2] = t0.z; v[3] = t0.w;                      \
        v[4] = t1.x; v[5] = t1.y; v[6] = t1.z; v[7] = t1.w;                      \
      }                                                                          \
      __VA_ARGS__                                                                \
    }                                                                            \
    __syncthreads();                                                             \
  }

typedef __attribute__((ext_vector_type(4))) float f32x4;
constexpr int G_BK = 64, G_HALF = 128, G_HT = G_HALF * G_BK;
DI int g_lds_byte(int r, int c) {
  int st = (r >> 4) * 2 + (c >> 5), rr = r & 15, cc = c & 31, ob = rr * 64 + cc * 2;
  return st * 1024 + (ob ^ (((ob >> 9) & 1) << 5));
}
DI void g_stage_rc(int b, int& R, int& C) {
  int st = b / 1024, sb = b % 1024, swz = sb ^ (((sb >> 9) & 1) << 5);
  R = (st >> 1) * 16 + swz / 64; C = (st & 1) * 32 + (swz % 64) / 2;
}
DI const char* g_uniform(const char* ptr) {
  unsigned long long u = (unsigned long long)ptr;
  unsigned lo = __builtin_amdgcn_readfirstlane((unsigned)u), hi = __builtin_amdgcn_readfirstlane((unsigned)(u >> 32));
  return (const char*)(((unsigned long long)hi << 32) | lo);
}
DI void gemm256(const bfu* __restrict__ A, int lda, const bfu* __restrict__ Bt, int ldb, int K, int brow, int bcol,
                bfu* shm, f32x4 (&acc)[2][2][4][2]) {
#define G_SA(b, h) (shm + ((b) * 2 + (h)) * G_HT)
#define G_SB(b, h) (shm + (4 + (b) * 2 + (h)) * G_HT)
#define G_STAGE(P, BASE, LD, br, kt)                                                                   \
  do {                                                                                                 \
    const char* _u = g_uniform((const char*)((BASE) + ((long)(br) * (LD) + (long)(kt) * G_BK)));       \
    __builtin_amdgcn_global_load_lds((const unsigned*)(_u + soff_b),                                   \
        (__attribute__((address_space(3))) unsigned*)((char*)(P) + ldst), 16, 0, 0);                   \
    __builtin_amdgcn_global_load_lds((const unsigned*)(_u + 128 * (long)(LD) + soff_b),                \
        (__attribute__((address_space(3))) unsigned*)((char*)(P) + ldst + 8192), 16, 0, 0);            \
  } while (0)
#define G_LDA(dst, b, h) for (int m = 0; m < 4; ++m) for (int k = 0; k < 2; ++k) \
    dst[m][k] = *reinterpret_cast<const bf16x8*>((char*)G_SA(b, h) + a_rd + m * 2048 + k * 1024)
#define G_LDB(dst, b, h) for (int n = 0; n < 2; ++n) for (int k = 0; k < 2; ++k) \
    dst[n][k] = *reinterpret_cast<const bf16x8*>((char*)G_SB(b, h) + b_rd + n * 2048 + k * 1024)
#define G_MMA(ai, bj, At, Bt_)                                                                         \
  do {                                                                                                 \
    __builtin_amdgcn_s_setprio(1);                                                                     \
    for (int m = 0; m < 4; ++m) for (int n = 0; n < 2; ++n) for (int k = 0; k < 2; ++k)                \
      acc[ai][bj][m][n] = __builtin_amdgcn_mfma_f32_16x16x32_bf16(At[m][k], Bt_[n][k], acc[ai][bj][m][n], 0, 0, 0); \
    __builtin_amdgcn_s_setprio(0);                                                                     \
  } while (0)
#define G_WAIT_V(n) asm volatile("s_waitcnt vmcnt(" #n ")" ::: "memory")
#define G_WAIT_L(n) asm volatile("s_waitcnt lgkmcnt(" #n ")" ::: "memory")
#define G_BAR __builtin_amdgcn_s_barrier()
#define G_SCHED __builtin_amdgcn_sched_barrier(0)
  int t512 = threadIdx.x; asm volatile("" : "+v"(t512));
  const int wid = __builtin_amdgcn_readfirstlane(t512 >> 6), lane = t512 & 63, wr = wid >> 2, wc = wid & 3, fr = lane & 15, fq = lane >> 4;
  const int ldst = t512 * 16;
  unsigned soff_b;
  {
    int R0, C0;
    g_stage_rc(ldst, R0, C0);
    soff_b = (unsigned)(R0 * lda + C0) * 2u;
  }
  const int lane_off = (fr * 64 + fq * 16) ^ ((fr >> 3) << 5);
  const int a_rd = wr * 8192 + lane_off, b_rd = wc * 4096 + lane_off;
  bf16x8 At[4][2], B0[2][2], B1[2][2];
  const int nt = K / G_BK;
  G_STAGE(G_SB(0, 0), Bt, ldb, bcol, 0); G_STAGE(G_SA(0, 0), A, lda, brow, 0);
  G_STAGE(G_SB(0, 1), Bt, ldb, bcol + G_HALF, 0); G_STAGE(G_SA(0, 1), A, lda, brow + G_HALF, 0);
  if (wr == 1) G_BAR;
  G_WAIT_V(4); G_BAR;
  G_STAGE(G_SB(1, 0), Bt, ldb, bcol, 1); G_STAGE(G_SA(1, 0), A, lda, brow, 1); G_STAGE(G_SB(1, 1), Bt, ldb, bcol + G_HALF, 1);
  G_WAIT_V(6); G_BAR;
#pragma unroll 1
  for (int t = 0; t < nt - 2; t += 2) {
    G_LDB(B0, 0, 0); G_SCHED; G_LDA(At, 0, 0); G_STAGE(G_SA(1, 1), A, lda, brow + G_HALF, t + 1);
    G_WAIT_L(8); G_BAR; G_WAIT_L(0); G_MMA(0, 0, At, B0); G_BAR; G_SCHED;
    G_LDB(B1, 0, 1); G_STAGE(G_SB(0, 0), Bt, ldb, bcol, t + 2);
    G_BAR; G_WAIT_L(0); G_MMA(0, 1, At, B1); G_BAR;
    G_LDA(At, 0, 1); G_STAGE(G_SA(0, 0), A, lda, brow, t + 2);
    G_BAR; G_WAIT_L(0); G_MMA(1, 0, At, B0); G_BAR; G_SCHED;
    G_STAGE(G_SB(0, 1), Bt, ldb, bcol + G_HALF, t + 2);
    G_WAIT_V(6); G_BAR; G_MMA(1, 1, At, B1); G_BAR;
    G_LDB(B0, 1, 0); G_SCHED; G_LDA(At, 1, 0); G_STAGE(G_SA(0, 1), A, lda, brow + G_HALF, t + 2);
    G_WAIT_L(8); G_BAR; G_WAIT_L(0); G_MMA(0, 0, At, B0); G_BAR; G_SCHED;
    G_LDB(B1, 1, 1); G_STAGE(G_SB(1, 0), Bt, ldb, bcol, t + 3);
    G_BAR; G_WAIT_L(0); G_MMA(0, 1, At, B1); G_BAR;
    G_LDA(At, 1, 1); G_STAGE(G_SA(1, 0), A, lda, brow, t + 3);
    G_BAR; G_WAIT_L(0); G_MMA(1, 0, At, B0); G_BAR; G_SCHED;
    G_STAGE(G_SB(1, 1), Bt, ldb, bcol + G_HALF, t + 3);
    G_WAIT_V(6); G_BAR; G_MMA(1, 1, At, B1); G_BAR;
  }
  { G_LDB(B0, 0, 0); G_LDA(At, 0, 0); G_STAGE(G_SA(1, 1), A, lda, brow + G_HALF, nt - 1);
    G_BAR; G_WAIT_L(0); G_MMA(0, 0, At, B0); G_BAR;
    G_LDB(B1, 0, 1); G_BAR; G_WAIT_L(0); G_MMA(0, 1, At, B1); G_BAR;
    G_LDA(At, 0, 1); G_WAIT_V(4); G_BAR; G_WAIT_L(0); G_MMA(1, 0, At, B0); G_MMA(1, 1, At, B1); G_BAR; }
  { G_LDB(B0, 1, 0); G_LDA(At, 1, 0); G_WAIT_V(2); G_BAR; G_WAIT_L(0); G_MMA(0, 0, At, B0); G_BAR;
    G_LDB(B1, 1, 1); G_WAIT_V(0); G_BAR; G_WAIT_L(0); G_MMA(0, 1, At, B1); G_BAR;
    G_LDA(At, 1, 1); G_BAR; G_WAIT_L(0); G_MMA(1, 0, At, B0); G_MMA(1, 1, At, B1); G_BAR; }
  if (wr == 0) G_BAR;
}
DI void acc256_zero(f32x4 (&acc)[2][2][4][2]) {
#pragma unroll
  for (int a = 0; a < 2; ++a)
#pragma unroll
    for (int b = 0; b < 2; ++b)
#pragma unroll
      for (int m = 0; m < 4; ++m)
#pragma unroll
        for (int n = 0; n < 2; ++n) acc[a][b][m][n] = (f32x4){0.f, 0.f, 0.f, 0.f};
}
#define EPI256(...)                                                                                   \
  {                                                                                                    \
    int t512_ = threadIdx.x; asm volatile("" : "+v"(t512_));     \
    const int wid_ = t512_ >> 6, lane_ = t512_ & 63, wr_ = wid_ >> 2, wc_ = wid_ & 3,                  \
              fr_ = lane_ & 15, fq_ = lane_ >> 4;                                                      \
    float* sf_ = (float*)smem;                                                                         \
    _Pragma("unroll") for (int ai_ = 0; ai_ < 2; ++ai_) {                                              \
      __syncthreads();                                                                                 \
      _Pragma("unroll") for (int bj_ = 0; bj_ < 2; ++bj_)                                              \
      _Pragma("unroll") for (int m_ = 0; m_ < 4; ++m_)                                                 \
      _Pragma("unroll") for (int n_ = 0; n_ < 2; ++n_)                                                 \
      _Pragma("unroll") for (int j_ = 0; j_ < 4; ++j_)                                                 \
        sf_[(wr_ * 64 + m_ * 16 + fq_ * 4 + j_) * 256 + ((bj_ * 128 + wc_ * 32 + n_ * 16 + fr_) ^ (fq_ << 4))] = \
            acc[ai_][bj_][m_][n_][j_];                                                                 \
      __syncthreads();                                                                                 \
      _Pragma("unroll 1") for (int it_ = 0; it_ < 8; ++it_) {                                          \
        const int idx_ = t512_ + 512 * it_;                                                            \
        const int rl_ = idx_ >> 5, c0 = (idx_ & 31) * 8;                                               \
        const int row = ai_ * 128 + rl_;                                                               \
        float v[8];                                                                                    \
        {                                                                                              \
          const float* sp_ = sf_ + rl_ * 256 + (c0 ^ (((rl_ >> 2) & 3) << 4));                          \
          const float4 t0 = *(const float4*)sp_; const float4 t1 = *(const float4*)(sp_ + 4);          \
          v[0] = t0.x; v[1] = t0.y; v[2] = t0.z; v[3] = t0.w;                                          \
          v[4] = t1.x; v[5] = t1.y; v[6] = t1.z; v[7] = t1.w;                                          \
        }                                                                                              \
        __VA_ARGS__                                                                                    \
      }                                                                                                \
    }                                                                                                  \
    __syncthreads();                                                                                   \
  }

template <int MT, int NT, int BH>
DI bool xcd_tile(int iter, int& mt, int& nt) {
  constexpr int MPX = MT / 8, TPX = MPX * NT;
  const int xcd = VXCD, j = VJ, nloc = VNLOC;
  const int q = j + iter * nloc;
  if (q >= TPX) return false;
  const int band = q / (BH * NT), r = q % (BH * NT);
  nt = r / BH;
  mt = xcd * MPX + band * BH + (r % BH);
  return true;
}

DI bool tile256(int iter, int NT, int& mt, int& nt) {
  const int xcd = blockIdx.x & 7, j = blockIdx.x >> 3, nloc = gridDim.x >> 3;
  const int q = j + iter * nloc;
  if (q >= 6 * NT) return false;
  nt = q / 6; mt = xcd * 6 + q % 6;
  return true;
}
DI void phase_gemm_in(const Params& p, int l, char* smem) {
  const bfu* W = p.w_inT + (size_t)l * DINP * LDH;
  for (int iter = 0;; ++iter) {
    int mt, nt;
    if (!tile256(iter, 19, mt, nt)) break;
    f32x4 acc[2][2][4][2];
    acc256_zero(acc);
    gemm256(p.h, LDH, W, LDH, 1024, mt * 256, nt * 256, (bfu*)smem, acc);
    const int m0 = mt * 256, n0 = nt * 256;
    EPI256({
      const int n = n0 + c0;
      if (n < 512) *(uint4*)(p.ug + ((size_t)(n >> 4) * NTOK + (m0 + row)) * 16 + (n & 15)) = pack8(v);
      else if (n < DIN) *(uint4*)(p.proj + (size_t)(m0 + row) * PW + (n - 512)) = pack8(v);
    })
  }
}

DI void s5_gen_item(const Params& p, int l, int item, char* smem) {
  const int tid = tid_();
  const int g = item >> 3, r = item & 7;
  float* sBr = (float*)smem;
  float* sBi = sBr + 2048;
  float* sCr = sBi + 2048;
  float* sCi = sCr + 1024;
  float* sAK = sCi + 1024;
  float* sAE = sAK + 1024;
  float* sAG = sAE + 1024;
  float* sK = sAG + 1024;
  bfu* E = p.opE + (size_t)g * 256 * 512;
  bfu* MG = p.opMG + (size_t)g * 512 * 768;
  __syncthreads();
  if (tid < 128) {
    const int d = tid >> 6, pp = tid & 63;
    const size_t pi = ((size_t)(l * 2 + d) * 32 + g) * 64 + pp;
    const float lr = p.lam_re[pi], li = p.lam_im[pi];
    const float dt = expf(p.log_dt[(l * 2 + d) * 32 + g]);
    const float mag = expf(lr * dt);
    float sn, cs;
    sincosf(li * dt, &sn, &cs);
    const float are = mag * cs, aim = mag * sn;
    const float nr = are - 1.f, ni = aim, den = lr * lr + li * li;
    const float kr = (nr * lr + ni * li) / den, ki = (ni * lr - nr * li) / den;
#pragma unroll
    for (int c = 0; c < 16; ++c) {
      float br = p.b_re[((size_t)(l * 32 + g) * 64 + pp) * 16 + c];
      float bi = p.b_im[((size_t)(l * 32 + g) * 64 + pp) * 16 + c];
      sBr[(d * 64 + pp) * 16 + c] = kr * br - ki * bi;
      sBi[(d * 64 + pp) * 16 + c] = kr * bi + ki * br;
    }
#pragma unroll
    for (int q = 0; q < 4; ++q) {
      const int t = 4 * r + q;
      const int nK = t;
      const int nE = d == 0 ? 31 - t : t;
      const int nG = d == 0 ? t + 1 : 32 - t;
      float m, s_, c_;
      m = expf(lr * dt * (float)nK); sincosf(li * dt * (float)nK, &s_, &c_);
      sAK[((d * 4 + q) * 64 + pp) * 2] = m * c_; sAK[((d * 4 + q) * 64 + pp) * 2 + 1] = m * s_;
      m = expf(lr * dt * (float)nE); sincosf(li * dt * (float)nE, &s_, &c_);
      sAE[((d * 4 + q) * 64 + pp) * 2] = m * c_; sAE[((d * 4 + q) * 64 + pp) * 2 + 1] = m * s_;
      m = expf(lr * dt * (float)nG); sincosf(li * dt * (float)nG, &s_, &c_);
      sAG[((d * 4 + q) * 64 + pp) * 2] = m * c_; sAG[((d * 4 + q) * 64 + pp) * 2 + 1] = m * s_;
    }
  } else {
    for (int idx = tid - 128; idx < 1024; idx += 128) {
      sCr[idx] = p.c_re[(size_t)(l * 32 + g) * 1024 + idx];
      sCi[idx] = p.c_im[(size_t)(l * 32 + g) * 1024 + idx];
    }
  }
  __syncthreads();
  for (int idx = tid; idx < 256 * 64; idx += 256) {
    const int row = idx >> 6, cc = idx & 63, q = cc >> 4, c = cc & 15;
    const int part = row >> 6, pp = row & 63, d = part >> 1;
    const float ar = sAE[((d * 4 + q) * 64 + pp) * 2], ai = sAE[((d * 4 + q) * 64 + pp) * 2 + 1];
    const float br = sBr[(d * 64 + pp) * 16 + c], bi = sBi[(d * 64 + pp) * 16 + c];
    const float v = (part & 1) ? (ar * bi + ai * br) : (ar * br - ai * bi);
    E[(size_t)row * 512 + (4 * r + q) * 16 + c] = f2bf(v);
  }
  for (int idx = tid; idx < 64 * 256; idx += 256) {
    const int rr = idx >> 8, col = idx & 255, q = rr >> 4, c = rr & 15;
    const int part = col >> 6, pp = col & 63, d = part >> 1;
    const float ar = sAG[((d * 4 + q) * 64 + pp) * 2], ai = sAG[((d * 4 + q) * 64 + pp) * 2 + 1];
    const float cr = sCr[c * 64 + pp], ci = sCi[c * 64 + pp];
    const float v = (part & 1) ? -(cr * ai + ci * ar) : (cr * ar - ci * ai);
    MG[(size_t)((4 * r + q) * 16 + c) * 768 + 512 + col] = f2bf(v);
  }
  {
    const int d = tid >> 7, q = (tid >> 5) & 3, c = (tid >> 1) & 15, ch = tid & 1;
    float acc[8];
#pragma unroll
    for (int e = 0; e < 8; ++e) acc[e] = 0.f;
    for (int pp = 0; pp < 64; ++pp) {
      const float ar = sAK[((d * 4 + q) * 64 + pp) * 2], ai = sAK[((d * 4 + q) * 64 + pp) * 2 + 1];
      const float cr = sCr[c * 64 + pp], ci = sCi[c * 64 + pp];
      const float wr = cr * ar - ci * ai, wi = cr * ai + ci * ar;
#pragma unroll
      for (int e = 0; e < 8; ++e)
        acc[e] += wr * sBr[(d * 64 + pp) * 16 + ch * 8 + e] - wi * sBi[(d * 64 + pp) * 16 + ch * 8 + e];
    }
#pragma unroll
    for (int e = 0; e < 8; ++e) sK[((d * 4 + q) * 16 + c) * 16 + ch * 8 + e] = acc[e];
  }
  __syncthreads();
  for (int idx = tid; idx < 8192; idx += 256) {
    const int ch = idx & 1, c = (idx >> 1) & 15, tp = (idx >> 5) & 31, q = (idx >> 10) & 3, d = idx >> 12;
    const int tau = 4 * r + q;
    int sp;
    bool valid;
    if (d == 0) { sp = tp - tau; valid = sp >= 0; } else { sp = tp + tau; valid = (sp <= 31) && (tau > 0); }
    if (valid) {
      float v[8];
#pragma unroll
      for (int e = 0; e < 8; ++e) {
        float x = sK[((d * 4 + q) * 16 + c) * 16 + ch * 8 + e];
        if (tau == 0) x += sK[((1 * 4 + q) * 16 + c) * 16 + ch * 8 + e];
        v[e] = x;
      }
      *(uint4*)(MG + (size_t)(tp * 16 + c) * 768 + sp * 16 + ch * 8) = pack8(v);
    }
  }
  __syncthreads();
}

DI void phase_s5_gen(const Params& p, int l, char* smem) {
  for (int it = NVB - 1 - VBID; it < 256; it += NVB) s5_gen_item(p, l, it, smem);
}

DI void phase_s5_e(const Params& p, char* smem) {
  for (int q = VJ; q < 24; q += VNLOC) {
    const int g = VXCD * 4 + q / 6, r6 = q % 6, mt = r6 >> 1, nt = r6 & 1;
    f32x16 acc[2][2];
    acc_zero(acc);
    gemm_core(p.ug + ((size_t)g * NCHUNK + mt * 128) * 512, 512, p.opE + ((size_t)g * 256 + nt * 128) * 512, 512, 512,
              smem, acc);
    EPI_LDS({
      float* dst = p.ebuf + ((size_t)g * NCHUNK + mt * 128 + row) * 256 + nt * 128 + c0;
      *(float4*)dst = make_float4(v[0], v[1], v[2], v[3]);
      *(float4*)(dst + 4) = make_float4(v[4], v[5], v[6], v[7]);
    })
  }
}

DI void phase_s5_scan(const Params& p, int l) {
  const int tid = tid_();
  for (int it = VBID; it < 320; it += NVB) {
    const int wi = it * 2 + (tid >> 7);
    const int dir = (tid >> 6) & 1, pp = tid & 63;
    int chunk0, n, b, g;
    bool prompt;
    if (wi < 128) { b = wi >> 5; g = wi & 31; chunk0 = (NPROMPT + b * 2048) >> 5; n = 64; prompt = false; }
    else { int q = wi - 128; b = q >> 5; g = q & 31; chunk0 = (b * 256) >> 5; n = 8; prompt = true; }
    const size_t pi = ((size_t)(l * 2 + dir) * 32 + g) * 64 + pp;
    const float lr = p.lam_re[pi], li = p.lam_im[pi];
    const float dt = expf(p.log_dt[(l * 2 + dir) * 32 + g]);
    const float mag = expf(lr * dt * 32.f);
    float sn, cs;
    sincosf(li * dt * 32.f, &sn, &cs);
    const float are = mag * cs, aim = mag * sn;
    float hre = 0.f, him = 0.f;
    if (!prompt) {
      size_t si = ((size_t)((b * 2 + l) * 2 + dir)) * 2048 + g * 64 + pp;
      hre = p.st_re[si]; him = p.st_im[si];
    }
    const float* eb = p.ebuf + ((size_t)g * NCHUNK + chunk0) * 256 + dir * 128 + pp;
    bfu* cb = p.carry + ((size_t)g * NCHUNK + chunk0) * 256 + dir * 128 + pp;
    for (int k0 = 0; k0 < n; k0 += 8) {
      float er[8], ei[8];
#pragma unroll
      for (int j = 0; j < 8; ++j) {
        const int k = dir == 0 ? k0 + j : n - 1 - (k0 + j);
        er[j] = eb[(size_t)k * 256];
        ei[j] = eb[(size_t)k * 256 + 64];
      }
#pragma unroll
      for (int j = 0; j < 8; ++j) {
        const int k = dir == 0 ? k0 + j : n - 1 - (k0 + j);
        cb[(size_t)k * 256] = f2bf(hre);
        cb[(size_t)k * 256 + 64] = f2bf(him);
        const float nre = are * hre - aim * him + er[j];
        const float nim = are * him + aim * hre + ei[j];
        hre = nre; him = nim;
      }
    }
    if (prompt) {
      size_t oi = ((size_t)((b * 2 + l) * 2 + dir)) * 2048 + g * 64 + pp;
      p.out[OUT_RE + oi] = hre;
      p.out[OUT_IM + oi] = him;
    }
  }
}

DI void phase_s5_y(const Params& p, int l, char* smem) {
  for (int q = VJ; q < 48; q += VNLOC) {
    const int g = VXCD * 4 + q / 12, r12 = q % 12, mt = r12 >> 2, nt = r12 & 3;
    f32x16 acc[2][2];
    acc_zero(acc);
    const bfu* Bm = p.opMG + ((size_t)g * 512 + nt * 128) * 768;
    gemm_core(p.ug + ((size_t)g * NCHUNK + mt * 128) * 512, 512, Bm, 768, 512, smem, acc);
    gemm_core(p.carry + ((size_t)g * NCHUNK + mt * 128) * 256, 256, Bm + 512, 768, 256, smem, acc);
    EPI_LDS({
      const int chunk = mt * 128 + row, nn = nt * 128 + c0, tp = nn >> 4, c = nn & 15;
      const int tok = chunk * 32 + tp;
      float u[8], o[8];
      unpack8(*(const uint4*)(p.ug + ((size_t)g * NTOK + tok) * 16 + c), u);
      const float* dsk = p.s5_d + l * 512 + g * 16 + c;
      _Pragma("unroll") for (int e = 0; e < 8; ++e) o[e] = geluf_(v[e] + dsk[e] * u[e]);
      *(uint4*)(p.ys5 + (size_t)tok * 512 + g * 16 + c) = pack8(o);
    })
  }
}

DI void phase_glu(const Params& p, int l, char* smem) {
  const bfu* W = p.w_gluT + (size_t)l * 512 * 512;
  for (int iter = 0;; ++iter) {
    int mt, nt;
    if (!xcd_tile<96, 4, 12>(iter, mt, nt)) break;
    f32x16 acc[2][2];
    acc_zero(acc);
    gemm_core(p.ys5 + (size_t)mt * 128 * 512, 512, W + (size_t)nt * 128 * 512, 512, 512, smem, acc);
    const int m0 = mt * 128, n0 = nt * 128;
    EPI_LDS({
      const int n = n0 + c0;
      const size_t tk = (size_t)(m0 + row);
      float y[8], ga[8], o[8];
      unpack8(*(const uint4*)(p.ys5 + tk * 512 + n), y);
      unpack8(*(const uint4*)(p.proj + tk * PW + OFF_GA + n), ga);
      const float* bg = p.b_glu + l * 512 + n;
      _Pragma("unroll") for (int e = 0; e < 8; ++e) o[e] = y[e] * sigmoidf_(v[e] + bg[e]) * siluf_(ga[e]);
      *(uint4*)(p.ya + tk * 512 + n) = pack8(o);
    })
  }
}

constexpr int GL_QS = 0;
constexpr int GL_KS = GL_QS + 32 * 144;
constexpr int GL_KHT = GL_KS + 32 * 144;
constexpr int GL_VT = GL_KHT + 64 * 80;
constexpr int GL_PS = GL_VT + 128 * 80;
constexpr int GL_ST = GL_PS + 32 * 80;
constexpr int GL_AV = GL_ST + 128 * 144;
constexpr int GL_TOT = GL_AV + 256;
constexpr int GL_OS = GL_TOT + 1024;
static_assert(GL_OS + 32 * 132 * 4 <= 65536, "gla lds");

DI void gla_segment_info(int seg, int& tok_base, bool& prompt, int& b, int& sidx) {
  if (seg < 16) { prompt = true; b = seg; sidx = 0; tok_base = seg * 256; }
  else { int q = seg - 16; prompt = false; b = q >> 3; sidx = q & 7; tok_base = NPROMPT + b * 2048 + sidx * 256; }
}

template <bool STATE_ONLY>
DI void gla_chain(const Params& p, int l, char* smem, int seg, int hd, int dir) {
  const int tid = tid_(), lane = tid & 63, w = tid >> 6;
  const int fr = lane & 31, hh = lane >> 5;
  int tok_base, b, sidx;
  bool prompt;
  gla_segment_info(seg, tok_base, prompt, b, sidx);
  const int dk = tid & 63, tq = tid >> 6;
  const int dvl = tid & 127, th = tid >> 7;
  float wg[16];
#pragma unroll
  for (int q = 0; q < 16; ++q) wg[q] = p.wg_up[((size_t)(l * 2 + dir) * 16 + q) * 256 + hd * 64 + dk];
  const float bgv = p.bg[(l * 2 + dir) * 256 + hd * 64 + dk];
  float* sAv = (float*)(smem + GL_AV);
  float* sTot = (float*)(smem + GL_TOT);
  float* sOs = (float*)(smem + GL_OS);

  f32x16 S[2];
  {
    const int dvc = 32 * w + fr;
    if (STATE_ONLY || prompt) {
#pragma unroll
      for (int mt = 0; mt < 2; ++mt)
#pragma unroll
        for (int r = 0; r < 16; ++r) S[mt][r] = 0.f;
    } else {
      const float* sp = p.st_gla + ((size_t)(((b * 2 + l) * 2 + dir) * 4 + hd)) * 8192;
#pragma unroll
      for (int mt = 0; mt < 2; ++mt)
#pragma unroll
        for (int r = 0; r < 16; ++r) S[mt][r] = sp[(32 * mt + (r & 3) + 8 * (r >> 2) + 4 * hh) * 128 + dvc];
      const int nprev = dir == 0 ? sidx : 7 - sidx;
      for (int q = 0; q < nprev; ++q) {
        const int sprev = dir == 0 ? q : 7 - q;
        const size_t ci = (size_t)(((b * 8 + sprev) * 4 + hd) * 2 + dir);
        const float* sl = p.gla_sloc + ci * 8192;
        const float* al = p.gla_aseg + ci * 64;
#pragma unroll
        for (int mt = 0; mt < 2; ++mt)
#pragma unroll
          for (int r = 0; r < 16; ++r) {
            const int dkk = 32 * mt + (r & 3) + 8 * (r >> 2) + 4 * hh;
            S[mt][r] = al[dkk] * S[mt][r] + sl[dkk * 128 + dvc];
          }
      }
    }
  }
  float bsum = 0.f;
  __syncthreads();
  if (!STATE_ONLY) {
    const int dvc = 32 * w + fr;
#pragma unroll
    for (int mt = 0; mt < 2; ++mt)
#pragma unroll
      for (int q = 0; q < 4; ++q) {
        uint2 pk;
        pk.x = pack2(S[mt][4 * q], S[mt][4 * q + 1]);
        pk.y = pack2(S[mt][4 * q + 2], S[mt][4 * q + 3]);
        *(uint2*)(smem + GL_ST + dvc * 144 + (32 * mt + 8 * q + 4 * hh) * 2) = pk;
      }
  }

  uint4 rq = make_uint4(0, 0, 0, 0), rk = rq, rv0 = rq, rv1 = rq, rgl = rq;
#define GLA_ISSUE(nn)                                                                                         \
  {                                                                                                           \
    const int cn_ = dir == 0 ? (nn) : 7 - (nn);                                                               \
    const int c0_ = tok_base + cn_ * 32;                                                                      \
    const int tA = dir == 0 ? (tid >> 3) : 31 - (tid >> 3);                                                   \
    const bfu* prA = p.proj + (size_t)(c0_ + tA) * PW + hd * 64 + (tid & 7) * 8;                              \
    if (!STATE_ONLY) rq = *(const uint4*)(prA + OFF_Q);                                                       \
    rk = *(const uint4*)(prA + OFF_K);                                                                        \
    const int tV0 = dir == 0 ? (tid >> 4) : 31 - (tid >> 4);                                                  \
    const int tV1 = dir == 0 ? (tid >> 4) + 16 : 15 - (tid >> 4);                                             \
    rv0 = *(const uint4*)(p.proj + (size_t)(c0_ + tV0) * PW + OFF_V + hd * 128 + (tid & 15) * 8);             \
    rv1 = *(const uint4*)(p.proj + (size_t)(c0_ + tV1) * PW + OFF_V + hd * 128 + (tid & 15) * 8);             \
    if (tid < 64) {                                                                                           \
      const int tG = dir == 0 ? (tid >> 1) : 31 - (tid >> 1);                                                 \
      rgl = *(const uint4*)(p.proj + (size_t)(c0_ + tG) * PW + OFF_GL + (tid & 1) * 8);                       \
    }                                                                                                         \
  }
  GLA_ISSUE(0)
  char* rawQ = smem + GL_OS;
  char* rawK = smem + GL_OS + 4096;
  char* rawV = smem + GL_OS + 8192;
  char* rawG = smem + GL_PS;

#pragma unroll 1
  for (int n = 0; n < 8; ++n) {
    const int cn = dir == 0 ? n : 7 - n;
    const int ctok0 = tok_base + cn * 32;
    __syncthreads();
    if (!STATE_ONLY) *(uint4*)(rawQ + (tid >> 3) * 128 + (tid & 7) * 16) = rq;
    *(uint4*)(rawK + (tid >> 3) * 128 + (tid & 7) * 16) = rk;
    *(uint4*)(rawV + (tid >> 4) * 256 + (tid & 15) * 16) = rv0;
    *(uint4*)(rawV + ((tid >> 4) + 16) * 256 + (tid & 15) * 16) = rv1;
    if (tid < 64) *(uint4*)(rawG + (tid >> 1) * 32 + (tid & 1) * 16) = rgl;
    if (n + 1 < 8) GLA_ISSUE(n + 1)
    uint4 eg0 = make_uint4(0, 0, 0, 0), eg1 = eg0;
    float4 et[4];
    if (!STATE_ONLY) {
      const size_t tokE = (size_t)(ctok0 + (tid >> 3));
      const bfu* gp = p.proj + tokE * PW + OFF_GB + hd * 128 + (tid & 7) * 16;
      if (dir == 0) {
        eg0 = *(const uint4*)gp; eg1 = *(const uint4*)(gp + 8);
        const float* tp = p.tmp_gla + tokE * 512 + hd * 128 + (tid & 7) * 16;
#pragma unroll
        for (int q = 0; q < 4; ++q) et[q] = *(const float4*)(tp + 4 * q);
      }
    }
    __syncthreads();
    float qv[8], kv[8], bl[8];
    {
      float run = 0.f;
#pragma unroll
      for (int i = 0; i < 8; ++i) {
        const int tau = tq * 8 + i;
        if (!STATE_ONLY) qv[i] = bf2f(*(const bfu*)(rawQ + tau * 128 + dk * 2)) * 0.125f;
        kv[i] = bf2f(*(const bfu*)(rawK + tau * 128 + dk * 2));
        float gl[16];
        unpack8(*(const uint4*)(rawG + tau * 32), *(float(*)[8])&gl[0]);
        unpack8(*(const uint4*)(rawG + tau * 32 + 16), *(float(*)[8])&gl[8]);
        float lg = bgv;
#pragma unroll
        for (int q = 0; q < 16; ++q) lg += gl[q] * wg[q];
        const float ls = fminf(lg, 0.f) - __logf(1.f + __expf(-fabsf(lg)));
        run += ls * (1.f / 16.f);
        bl[i] = run;
      }
      sTot[tq * 64 + dk] = run;
    }
    {
      unsigned pk[8];
#pragma unroll
      for (int i = 0; i < 8; ++i) {
        const int tau0 = th * 16 + 2 * i;
        const unsigned lo = *(const bfu*)(rawV + tau0 * 256 + dvl * 2);
        const unsigned hi = *(const bfu*)(rawV + (tau0 + 1) * 256 + dvl * 2);
        pk[i] = lo | (hi << 16);
      }
      *(uint4*)(smem + GL_VT + dvl * 80 + th * 32) = make_uint4(pk[0], pk[1], pk[2], pk[3]);
      *(uint4*)(smem + GL_VT + dvl * 80 + th * 32 + 16) = make_uint4(pk[4], pk[5], pk[6], pk[7]);
    }
    __syncthreads();
    {
      float off = 0.f, total = 0.f;
#pragma unroll
      for (int q = 0; q < 4; ++q) {
        const float tv = sTot[q * 64 + dk];
        total += tv;
        off += (q < tq) ? tv : 0.f;
      }
      unsigned kh[4];
      float khv[8];
#pragma unroll
      for (int i = 0; i < 8; ++i) {
        const float bb = off + bl[i];
        const int tau = tq * 8 + i;
        if (!STATE_ONLY) {
          *(bfu*)(smem + GL_QS + tau * 144 + dk * 2) = f2bf(qv[i] * __expf(bb));
          *(bfu*)(smem + GL_KS + tau * 144 + dk * 2) = f2bf(kv[i] * __expf(-bb));
        }
        khv[i] = kv[i] * __expf(total - bb);
      }
#pragma unroll
      for (int i = 0; i < 4; ++i) kh[i] = pack2(khv[2 * i], khv[2 * i + 1]);
      *(uint4*)(smem + GL_KHT + dk * 80 + tq * 16) = make_uint4(kh[0], kh[1], kh[2], kh[3]);
      if (tq == 0) { sAv[dk] = __expf(total); bsum += total; }
    }
    __syncthreads();
    f32x16 o;
    if (!STATE_ONLY) {
      f32x16 sc;
#pragma unroll
      for (int r = 0; r < 16; ++r) sc[r] = 0.f;
#pragma unroll
      for (int s4 = 0; s4 < 4; ++s4) {
        bf16x8 a = *(const bf16x8*)(smem + GL_QS + fr * 144 + (16 * s4 + 8 * hh) * 2);
        bf16x8 bq = *(const bf16x8*)(smem + GL_KS + fr * 144 + (16 * s4 + 8 * hh) * 2);
        sc = __builtin_amdgcn_mfma_f32_32x32x16_bf16(a, bq, sc, 0, 0, 0);
      }
#pragma unroll
      for (int rr = 0; rr < 4; ++rr) {
        float val = w == 0 ? sc[rr] : (w == 1 ? sc[4 + rr] : (w == 2 ? sc[8 + rr] : sc[12 + rr]));
        const int i = rr + 8 * w + 4 * hh;
        val = (fr <= i) ? val : 0.f;
        *(bfu*)(smem + GL_PS + i * 80 + fr * 2) = f2bf(val);
      }
      __syncthreads();
#pragma unroll
      for (int r = 0; r < 16; ++r) o[r] = 0.f;
    }
    {
      const int dvc = 32 * w + fr;
      bf16x8 vb0 = *(const bf16x8*)(smem + GL_VT + dvc * 80 + (8 * hh) * 2);
      bf16x8 vb1 = *(const bf16x8*)(smem + GL_VT + dvc * 80 + (16 + 8 * hh) * 2);
      if (!STATE_ONLY) {
        bf16x8 pa0 = *(const bf16x8*)(smem + GL_PS + fr * 80 + (8 * hh) * 2);
        bf16x8 pa1 = *(const bf16x8*)(smem + GL_PS + fr * 80 + (16 + 8 * hh) * 2);
        o = __builtin_amdgcn_mfma_f32_32x32x16_bf16(pa0, vb0, o, 0, 0, 0);
        o = __builtin_amdgcn_mfma_f32_32x32x16_bf16(pa1, vb1, o, 0, 0, 0);
#pragma unroll
        for (int s4 = 0; s4 < 4; ++s4) {
          bf16x8 a = *(const bf16x8*)(smem + GL_QS + fr * 144 + (16 * s4 + 8 * hh) * 2);
          bf16x8 sb = *(const bf16x8*)(smem + GL_ST + dvc * 144 + (16 * s4 + 8 * hh) * 2);
          o = __builtin_amdgcn_mfma_f32_32x32x16_bf16(a, sb, o, 0, 0, 0);
        }
      }
#pragma unroll
      for (int mt = 0; mt < 2; ++mt) {
        f32x16 U;
#pragma unroll
        for (int r = 0; r < 16; ++r) U[r] = 0.f;
        bf16x8 ka0 = *(const bf16x8*)(smem + GL_KHT + (32 * mt + fr) * 80 + (8 * hh) * 2);
        bf16x8 ka1 = *(const bf16x8*)(smem + GL_KHT + (32 * mt + fr) * 80 + (16 + 8 * hh) * 2);
        U = __builtin_amdgcn_mfma_f32_32x32x16_bf16(ka0, vb0, U, 0, 0, 0);
        U = __builtin_amdgcn_mfma_f32_32x32x16_bf16(ka1, vb1, U, 0, 0, 0);
#pragma unroll
        for (int q = 0; q < 4; ++q) {
          const float4 av = *(const float4*)(sAv + 32 * mt + 8 * q + 4 * hh);
          S[mt][4 * q + 0] = av.x * S[mt][4 * q + 0] + U[4 * q + 0];
          S[mt][4 * q + 1] = av.y * S[mt][4 * q + 1] + U[4 * q + 1];
          S[mt][4 * q + 2] = av.z * S[mt][4 * q + 2] + U[4 * q + 2];
          S[mt][4 * q + 3] = av.w * S[mt][4 * q + 3] + U[4 * q + 3];
          if (!STATE_ONLY) {
            uint2 pk;
            pk.x = pack2(S[mt][4 * q], S[mt][4 * q + 1]);
            pk.y = pack2(S[mt][4 * q + 2], S[mt][4 * q + 3]);
            *(uint2*)(smem + GL_ST + dvc * 144 + (32 * mt + 8 * q + 4 * hh) * 2) = pk;
          }
        }
      }
      if (!STATE_ONLY) {
#pragma unroll
        for (int r = 0; r < 16; ++r) sOs[((r & 3) + 8 * (r >> 2) + 4 * hh) * 132 + dvc] = o[r];
      }
    }
    __syncthreads();
    if (!STATE_ONLY) {
      const int t = tid >> 3, part = tid & 7;
      const int tau = dir == 0 ? t : 31 - t;
      const size_t tok = (size_t)(ctok0 + t);
      float ov[16];
#pragma unroll
      for (int q = 0; q < 4; ++q) {
        const float4 x = *(const float4*)(sOs + tau * 132 + part * 16 + 4 * q);
        ov[4 * q] = x.x; ov[4 * q + 1] = x.y; ov[4 * q + 2] = x.z; ov[4 * q + 3] = x.w;
      }
      float* tp = p.tmp_gla + tok * 512 + hd * 128 + part * 16;
      if (dir == 1) {
#pragma unroll
        for (int q = 0; q < 4; ++q) *(float4*)(tp + 4 * q) = make_float4(ov[4 * q], ov[4 * q + 1], ov[4 * q + 2], ov[4 * q + 3]);
      } else {
        float ss = 0.f;
#pragma unroll
        for (int q = 0; q < 4; ++q) {
          const float4 x = et[q];
          ov[4 * q] += x.x; ov[4 * q + 1] += x.y; ov[4 * q + 2] += x.z; ov[4 * q + 3] += x.w;
        }
#pragma unroll
        for (int e = 0; e < 16; ++e) ss += ov[e] * ov[e];
        ss += __shfl_xor(ss, 1); ss += __shfl_xor(ss, 2); ss += __shfl_xor(ss, 4);
        const float rs = rsqrtf(ss * (1.f / 128.f) + EPS);
        const float* gn = p.gla_norm_g + l * 512 + hd * 128 + part * 16;
        float gt[16];
        unpack8(eg0, *(float(*)[8])&gt[0]);
        unpack8(eg1, *(float(*)[8])&gt[8]);
        float res[16];
#pragma unroll
        for (int e = 0; e < 16; ++e) res[e] = ov[e] * rs * gn[e] * siluf_(gt[e]);
        bfu* yp = p.yb + tok * 512 + hd * 128 + part * 16;
        *(uint4*)yp = pack8(*(float(*)[8])&res[0]);
        *(uint4*)(yp + 8) = pack8(*(float(*)[8])&res[8]);
      }
    }
  }
  const int dvc = 32 * w + fr;
  if (STATE_ONLY) {
    const size_t ci = (size_t)(((b * 8 + sidx) * 4 + hd) * 2 + dir);
    float* sl = p.gla_sloc + ci * 8192;
#pragma unroll
    for (int mt = 0; mt < 2; ++mt)
#pragma unroll
      for (int r = 0; r < 16; ++r) sl[(32 * mt + (r & 3) + 8 * (r >> 2) + 4 * hh) * 128 + dvc] = S[mt][r];
    if (tq == 0) p.gla_aseg[ci * 64 + dk] = __expf(bsum);
  } else if (prompt) {
    float* op = p.out + OUT_GLA + ((size_t)(((b * 2 + l) * 2 + dir) * 4 + hd)) * 8192;
#pragma unroll
    for (int mt = 0; mt < 2; ++mt)
#pragma unroll
      for (int r = 0; r < 16; ++r) op[(32 * mt + (r & 3) + 8 * (r >> 2) + 4 * hh) * 128 + dvc] = S[mt][r];
  }
  __syncthreads();
}

DI void phase_gla_pass1(const Params& p, int l, char* smem) {
  for (int it = NVB - 1 - VBID; it < 256; it += NVB) {
    const int dir = it & 1, hd = (it >> 1) & 3, seg = 16 + (it >> 3);
    gla_chain<true>(p, l, smem, seg, hd, dir);
  }
}
DI void phase_gla_main(const Params& p, int l, char* smem) {
  for (int it = NVB - 1 - VBID; it < 192; it += NVB) {
    const int hd = it & 3, seg = it >> 2;
    gla_chain<false>(p, l, smem, seg, hd, 1);
    gla_chain<false>(p, l, smem, seg, hd, 0);
  }
}

DI void phase_merge(const Params& p, int l, char* smem) {
  const bfu* WA = p.w_paT + (size_t)l * 1024 * 512;
  const bfu* WB = p.w_pbT + (size_t)l * 1024 * 512;
  for (int iter = 0;; ++iter) {
    int mt, nt;
    if (!tile256(iter, 4, mt, nt)) break;
    const int m0 = mt * 256, n0 = nt * 256;
    f32x4 acc[2][2][4][2];
    acc256_zero(acc);
    gemm256(p.ya, 512, WA, 512, 512, m0, n0, (bfu*)smem, acc);
    EPI256({
      float ma[8], o[8];
      unpack8(*(const uint4*)(p.proj + (size_t)(m0 + row) * PW + OFF_MA + n0 + c0), ma);
      _Pragma("unroll") for (int e = 0; e < 8; ++e) o[e] = sigmoidf_(ma[e]) * v[e];
      *(uint4*)(p.merged + (size_t)(m0 + row) * D + n0 + c0) = pack8(o);
    })
    acc256_zero(acc);
    gemm256(p.yb, 512, WB, 512, 512, m0, n0, (bfu*)smem, acc);
    EPI256({
      float mb[8], o[8], pr[8];
      unpack8(*(const uint4*)(p.proj + (size_t)(m0 + row) * PW + OFF_MB + n0 + c0), mb);
      uint4* mp = (uint4*)(p.merged + (size_t)(m0 + row) * D + n0 + c0);
      unpack8(*mp, pr);
      _Pragma("unroll") for (int e = 0; e < 8; ++e) o[e] = pr[e] + sigmoidf_(mb[e]) * v[e];
      *mp = pack8(o);
    })
  }
}

DI void phase_out(const Params& p, int l, char* smem) {
  const bfu* W = p.w_oT + (size_t)l * 1024 * 1024;
  for (int iter = 0;; ++iter) {
    int mt, nt;
    if (!tile256(iter, 4, mt, nt)) break;
    const int m0 = mt * 256, n0 = nt * 256;
    f32x4 acc[2][2][4][2];
    acc256_zero(acc);
    gemm256(p.merged, D, W, 1024, 1024, m0, n0, (bfu*)smem, acc);
    const float* gate = p.mod + (size_t)(l * 5 + cond_of_tok(m0)) * 3072 + 2048;
    EPI256({
      float* xp = p.out + (size_t)(m0 + row) * D + n0 + c0;
      const float* gp = gate + n0 + c0;
      float4 x0 = *(const float4*)xp, x1 = *(const float4*)(xp + 4);
      const float4 g0 = *(const float4*)gp, g1 = *(const float4*)(gp + 4);
      x0.x += g0.x * v[0]; x0.y += g0.y * v[1]; x0.z += g0.z * v[2]; x0.w += g0.w * v[3];
      x1.x += g1.x * v[4]; x1.y += g1.y * v[5]; x1.z += g1.z * v[6]; x1.w += g1.w * v[7];
      *(float4*)xp = x0; *(float4*)(xp + 4) = x1;
    })
  }
}

DI void phase_final(const Params& p) {
  const int tid = tid_(), lane = tid & 63, w = tid >> 6;
  for (int it = VBID; it < NTOK / 4; it += NVB) {
    const int tok = it * 4 + w;
    float* xs = p.out + (size_t)tok * D;
    float4 v[4];
#pragma unroll
    for (int i = 0; i < 4; ++i) v[i] = *(const float4*)(xs + lane * 4 + 256 * i);
    float ss = 0.f;
#pragma unroll
    for (int i = 0; i < 4; ++i) ss += v[i].x * v[i].x + v[i].y * v[i].y + v[i].z * v[i].z + v[i].w * v[i].w;
    ss = wave_sum(ss);
    const float rstd = rsqrtf(ss * (1.f / 1024.f) + EPS);
#pragma unroll
    for (int i = 0; i < 4; ++i) {
      float4 g = *(const float4*)(p.final_g + lane * 4 + 256 * i);
      float4 o;
      o.x = v[i].x * rstd * g.x; o.y = v[i].y * rstd * g.y; o.z = v[i].z * rstd * g.z; o.w = v[i].w * rstd * g.w;
      *(float4*)(xs + lane * 4 + 256 * i) = o;
    }
  }
}

__global__ void __launch_bounds__(512, 2) k_mega(Params p) {
  extern __shared__ __attribute__((aligned(16))) char smem_all[];
  cg::grid_group grid = cg::this_grid();
  char* smem = smem_all;
#define smh (smem_all + VHALF * 65536)
  phase_prep(p, smh);
  phase_s5_gen(p, 0, smh);
  grid.sync();
  for (int l = 0; l < 2; ++l) {
    phase_h(p, l);
    grid.sync();
    phase_gemm_in(p, l, smem);
    grid.sync();
    phase_s5_e(p, smh);
    phase_gla_pass1(p, l, smh);
    grid.sync();
    phase_s5_scan(p, l);
    phase_gla_main(p, l, smh);
    grid.sync();
    phase_s5_y(p, l, smh);
    grid.sync();
    phase_glu(p, l, smh);
    if (l == 0) phase_s5_gen(p, 1, smh);
    grid.sync();
    phase_merge(p, l, smem);
    grid.sync();
    phase_out(p, l, smem);
    grid.sync();
  }
  phase_final(p);
}

extern "C" void kernel_launch(void* const* d_in, const int* in_sizes, int n_in, void* d_out, int out_size,
                              void* d_ws, size_t ws_size, hipStream_t stream) {
  Params p{};
  const float* const* in = (const float* const*)d_in;
  p.x_prompt = in[0]; p.x_sample = in[1]; p.c = in[2]; p.st_re = in[3]; p.st_im = in[4]; p.st_gla = in[5];
  p.c_ctx = in[6]; p.norm_g = in[7]; p.w_mod = in[8]; p.b_mod = in[9]; p.w_in = in[10]; p.wg_up = in[11];
  p.bg = in[12]; p.gla_norm_g = in[13]; p.lam_re = in[14]; p.lam_im = in[15]; p.log_dt = in[16];
  p.b_re = in[17]; p.b_im = in[18]; p.c_re = in[19]; p.c_im = in[20]; p.s5_d = in[21]; p.w_glu = in[22];
  p.b_glu = in[23]; p.w_pa = in[24]; p.w_pb = in[25]; p.w_o = in[26]; p.final_g = in[27];
  p.out = (float*)d_out;
  char* ws = (char*)d_ws;
  size_t off = 0;
  auto take = [&](size_t bytes) { char* r = ws + off; off += (bytes + 255) & ~(size_t)255; return r; };
  p.w_inT = (bfu*)take((size_t)2 * DINP * LDH * 2);
  p.w_gluT = (bfu*)take((size_t)2 * 512 * 512 * 2);
  p.w_paT = (bfu*)take((size_t)2 * 1024 * 512 * 2);
  p.w_pbT = (bfu*)take((size_t)2 * 1024 * 512 * 2);
  p.w_oT = (bfu*)take((size_t)2 * 1024 * 1024 * 2);
  p.mod = (float*)take((size_t)2 * 5 * 3072 * 4);
  p.pos_r = (float*)take((size_t)32 * 512 * 4);
  p.pos_c = (float*)take((size_t)64 * 512 * 4);
  p.h = (bfu*)take((size_t)NTOK * LDH * 2);
  p.proj = (bfu*)take((size_t)NTOK * PW * 2);
  p.ys5 = (bfu*)take((size_t)NTOK * 512 * 2);
  p.ya = (bfu*)take((size_t)NTOK * 512 * 2);
  p.yb = (bfu*)take((size_t)NTOK * 512 * 2);
  p.merged = (bfu*)take((size_t)NTOK * D * 2);
  p.tmp_s5 = nullptr;
  p.ebuf = (float*)p.merged;
  p.carry = (bfu*)((char*)p.merged + (size_t)32 * NCHUNK * 256 * 4);
  p.ug = (bfu*)take((size_t)32 * NTOK * 16 * 2);
  p.opMG = (bfu*)take((size_t)32 * 512 * 768 * 2);
  p.opE = (bfu*)take((size_t)32 * 256 * 512 * 2);
  p.gla_sloc = (float*)p.ys5;
  p.gla_aseg = (float*)((char*)p.ys5 + (size_t)256 * 8192 * 4);
  if (off > ws_size) fprintf(stderr, "workspace too small: %zu > %zu\n", off, ws_size);
  p.tmp_gla = (float*)p.h;
  constexpr size_t kLds = 131072;
  static int grid_blocks = 0;
  if (!grid_blocks) {
    int dev = 0, cus = 0, per_cu = 0;
    hipGetDevice(&dev);
    hipDeviceGetAttribute(&cus, hipDeviceAttributeMultiprocessorCount, dev);
    hipFuncSetAttribute((const void*)k_mega, hipFuncAttributeMaxDynamicSharedMemorySize, (int)kLds);
    hipOccupancyMaxActiveBlocksPerMultiprocessor(&per_cu, k_mega, 512, kLds);
    if (per_cu > 1) per_cu = 1;
    grid_blocks = cus * per_cu;
    if (grid_blocks % 8 != 0 || grid_blocks <= 0) fprintf(stderr, "unexpected grid %d\n", grid_blocks);
  }
  void* args[] = {&p};
  hipError_t e = hipLaunchCooperativeKernel((void*)k_mega, dim3(grid_blocks), dim3(512), args, kLds, stream);
  if (e != hipSuccess) fprintf(stderr, "cooperative launch failed: %s (grid %d)\n", hipGetErrorString(e), grid_blocks);
}
```

```cpp
#include <hip/hip_runtime.h>
#include <hip/hip_cooperative_groups.h>
#include <stdint.h>
#include <math.h>
#include <stdio.h>
namespace cg = cooperative_groups;

#ifndef REP_PREP
#define REP_PREP 0
#endif
#ifndef REP_GIN
#define REP_GIN 0
#endif
#ifndef REP_X1
#define REP_X1 0
#endif
#ifndef REP_X2
#define REP_X2 0
#endif
#ifndef REP_Y
#define REP_Y 0
#endif
#ifndef REP_MERGE
#define REP_MERGE 0
#endif
#ifndef REP_SYNC
#define REP_SYNC 0
#endif
#ifndef ONE_LAUNCH
#define ONE_LAUNCH 1
#endif

typedef unsigned short bfu;
typedef __attribute__((ext_vector_type(8))) short bf16x8;
typedef __attribute__((ext_vector_type(16))) float f32x16;
typedef __attribute__((ext_vector_type(2))) __bf16 bf2_t;
typedef __attribute__((ext_vector_type(2))) float f2_t;

#define DI __device__ __forceinline__

constexpr int D = 1024;
constexpr int NTOK = 12288;
constexpr int NPROMPT = 4096;
constexpr int DIN = 4624;
constexpr int DINP = 4864;
constexpr int LDH = 1088;
constexpr int PW = 4112;
constexpr int OFF_GA = 0, OFF_Q = 512, OFF_K = 768, OFF_V = 1024, OFF_GB = 1536, OFF_GL = 2048,
              OFF_MA = 2064, OFF_MB = 3088;
constexpr int NCHUNK = NTOK / 32;
constexpr size_t OUT_RE = (size_t)NTOK * D;
constexpr size_t OUT_IM = OUT_RE + 131072;
constexpr size_t OUT_GLA = OUT_IM + 131072;
constexpr float EPS = 1e-6f;

struct Params {
  const float *x_prompt, *x_sample, *c, *st_re, *st_im, *st_gla, *c_ctx, *norm_g, *w_mod, *b_mod, *w_in,
      *wg_up, *bg, *gla_norm_g, *lam_re, *lam_im, *log_dt, *b_re, *b_im, *c_re, *c_im, *s5_d, *w_glu,
      *b_glu, *w_pa, *w_pb, *w_o, *final_g;
  float* out;
  bfu *w_inT, *w_gluT, *w_paT, *w_pbT, *w_oT;
  float *mod, *pos_r, *pos_c, *tmp_s5, *tmp_gla;
  bfu *h, *proj, *ys5, *ya, *yb, *merged;
  bfu *ug, *opMG, *opE, *carry;
  float *ebuf, *gla_sloc, *gla_aseg;
  unsigned* bar;
};

DI int tid_() { int t = threadIdx.x & 255; asm volatile("" : "+v"(t)); return t; }
#define VHALF ((int)__builtin_amdgcn_readfirstlane((int)(threadIdx.x >> 8)))
#define VBID ((int)(blockIdx.x * 2 + VHALF))
#define NVB ((int)(gridDim.x * 2))
#define VXCD ((int)(blockIdx.x & 7))
#define VJ ((int)((blockIdx.x >> 3) * 2 + VHALF))
#define VNLOC ((int)((gridDim.x >> 3) * 2))
DI float bf2f(bfu v) { return __uint_as_float(((unsigned)v) << 16); }
DI bfu f2bf(float x) { __bf16 b = (__bf16)x; return __builtin_bit_cast(unsigned short, b); }
DI unsigned pack2(float lo, float hi) {
  f2_t v = {lo, hi};
  bf2_t w = __builtin_convertvector(v, bf2_t);
  return __builtin_bit_cast(unsigned, w);
}
DI float sigmoidf_(float x) { return 1.f / (1.f + __expf(-x)); }
DI float siluf_(float x) { return x / (1.f + __expf(-x)); }
DI float geluf_(float x) {
  float u = 0.7978845608028654f * (x + 0.044715f * x * x * x);
  float t = 1.f - 2.f / (__expf(2.f * u) + 1.f);
  return 0.5f * x * (1.f + t);
}
DI float wave_sum(float v) {
#pragma unroll
  for (int o = 32; o >= 1; o >>= 1) v += __shfl_xor(v, o);
  return v;
}
DI int cond_of_tok(int tok) { return tok < NPROMPT ? 0 : 1 + ((tok - NPROMPT) >> 11); }

DI void transpose_tile(const float* __restrict__ src, int K, int N, bfu* __restrict__ dst, int kt, int nt,
                       float* sm, int ldd = 0) {
  if (ldd == 0) ldd = K;
  const int tid = tid_(), c = tid & 63, r4 = tid >> 6;
  const int k0 = kt * 64, n0 = nt * 64;
#pragma unroll 4
  for (int i = 0; i < 16; ++i) {
    int k = i * 4 + r4, n = n0 + c;
    sm[k * 65 + c] = (n < N) ? src[(size_t)(k0 + k) * N + n] : 0.f;
  }
  __syncthreads();
#pragma unroll 4
  for (int i = 0; i < 16; ++i) {
    int n = i * 4 + r4;
    dst[(size_t)(n0 + n) * ldd + k0 + c] = f2bf(sm[c * 65 + n]);
  }
  __syncthreads();
}

DI void phase_prep(const Params& p, char* smem) {
  float* sm = (float*)smem;
  const int tid = tid_();
  for (int it = VBID; it < 96; it += NVB) {
    const int l = it / 48, jb = it % 48;
    float* ssil = sm;
    float* sred = sm + 5 * 1024;
    for (int idx = tid; idx < 5120; idx += 256) {
      int ci = idx >> 10, k = idx & 1023;
      float cv = (ci == 0) ? p.c_ctx[k] : p.c[(ci - 1) * 1024 + k];
      ssil[idx] = cv / (1.f + expf(-cv));
    }
    __syncthreads();
    const int jj = tid & 63, kq = tid >> 6;
    const int j = jb * 64 + jj;
    float acc[5] = {0.f, 0.f, 0.f, 0.f, 0.f};
    const float* wp = p.w_mod + ((size_t)l * 1024 + kq * 256) * 3072 + j;
#pragma unroll 8
    for (int k = 0; k < 256; ++k) {
      float w = wp[(size_t)k * 3072];
#pragma unroll
      for (int ci = 0; ci < 5; ++ci) acc[ci] += ssil[ci * 1024 + kq * 256 + k] * w;
    }
#pragma unroll
    for (int ci = 0; ci < 5; ++ci) sred[(kq * 5 + ci) * 64 + jj] = acc[ci];
    __syncthreads();
    for (int idx = tid; idx < 320; idx += 256) {
      int ci = idx >> 6, j2 = idx & 63;
      float s = p.b_mod[l * 3072 + jb * 64 + j2];
#pragma unroll
      for (int q = 0; q < 4; ++q) s += sred[(q * 5 + ci) * 64 + j2];
      p.mod[(size_t)(l * 5 + ci) * 3072 + jb * 64 + j2] = s;
    }
    __syncthreads();
  }
  for (int idx = VBID * 256 + tid; idx < 96 * 512; idx += NVB * 256) {
    int r = idx >> 9, i = idx & 511;
    int pos = r < 32 ? r : r - 32;
    int q = i & 255;
    double f = exp(-log(10000.0) * (double)q / 256.0);
    double ang = (double)pos * f;
    float v = (float)((i < 256) ? sin(ang) : cos(ang));
    if (r < 32) p.pos_r[r * 512 + i] = v; else p.pos_c[(r - 32) * 512 + i] = v;
  }
  for (int it = VBID; it < 3584; it += NVB) {
    int l = it / 1792, r = it % 1792;
    if (r < 1216) {
      transpose_tile(p.w_in + (size_t)l * 1024 * DIN, 1024, DIN, p.w_inT + (size_t)l * DINP * LDH, r % 16, r / 16, sm, LDH);
    } else if (r < 1280) {
      r -= 1216;
      transpose_tile(p.w_glu + (size_t)l * 512 * 512, 512, 512, p.w_gluT + (size_t)l * 512 * 512, r % 8, r / 8, sm);
    } else if (r < 1408) {
      r -= 1280;
      transpose_tile(p.w_pa + (size_t)l * 512 * 1024, 512, 1024, p.w_paT + (size_t)l * 1024 * 512, r % 8, r / 8, sm);
    } else if (r < 1536) {
      r -= 1408;
      transpose_tile(p.w_pb + (size_t)l * 512 * 1024, 512, 1024, p.w_pbT + (size_t)l * 1024 * 512, r % 8, r / 8, sm);
    } else {
      r -= 1536;
      transpose_tile(p.w_o + (size_t)l * 1024 * 1024, 1024, 1024, p.w_oT + (size_t)l * 1024 * 1024, r % 16, r / 16, sm);
    }
  }
}

DI void phase_h(const Params& p, int l) {
  const int tid = tid_(), lane = tid & 63, w = tid >> 6;
  for (int it = VBID; it < NTOK / 4; it += NVB) {
    const int tok = it * 4 + w;
    float4 v[4];
    float* xs = p.out + (size_t)tok * D;
    if (l == 0) {
      const float* src = tok < NPROMPT ? p.x_prompt + (size_t)tok * D : p.x_sample + (size_t)(tok - NPROMPT) * D;
#pragma unroll
      for (int i = 0; i < 4; ++i) v[i] = *(const float4*)(src + lane * 4 + 256 * i);
      if (tok >= NPROMPT) {
        int t = (tok - NPROMPT) & 2047, row = t >> 6, col = t & 63;
#pragma unroll
        for (int i = 0; i < 4; ++i) {
          int d = lane * 4 + 256 * i;
          const float* pe = d < 512 ? p.pos_r + row * 512 + d : p.pos_c + col * 512 + (d - 512);
          float4 e = *(const float4*)pe;
          v[i].x += e.x; v[i].y += e.y; v[i].z += e.z; v[i].w += e.w;
        }
      }
#pragma unroll
      for (int i = 0; i < 4; ++i) *(float4*)(xs + lane * 4 + 256 * i) = v[i];
    } else {
#pragma unroll
      for (int i = 0; i < 4; ++i) v[i] = *(const float4*)(xs + lane * 4 + 256 * i);
    }
    float ss = 0.f;
#pragma unroll
    for (int i = 0; i < 4; ++i) ss += v[i].x * v[i].x + v[i].y * v[i].y + v[i].z * v[i].z + v[i].w * v[i].w;
    ss = wave_sum(ss);
    const float rstd = rsqrtf(ss * (1.f / 1024.f) + EPS);
    const float* md = p.mod + (size_t)(l * 5 + cond_of_tok(tok)) * 3072;
    const float* ng = p.norm_g + l * 1024;
#pragma unroll
    for (int i = 0; i < 4; ++i) {
      int d = lane * 4 + 256 * i;
      float4 g = *(const float4*)(ng + d);
      float4 sh = *(const float4*)(md + d);
      float4 sc = *(const float4*)(md + 1024 + d);
      float a0 = v[i].x * rstd * g.x * (1.f + sc.x) + sh.x;
      float a1 = v[i].y * rstd * g.y * (1.f + sc.y) + sh.y;
      float a2 = v[i].z * rstd * g.z * (1.f + sc.z) + sh.z;
      float a3 = v[i].w * rstd * g.w * (1.f + sc.w) + sh.w;
      uint2 o; o.x = pack2(a0, a1); o.y = pack2(a2, a3);
      *(uint2*)(p.h + (size_t)tok * LDH + d) = o;
    }
  }
}

DI void gemm_core(const bfu* __restrict__ A, int lda, const bfu* __restrict__ B, int ldb, int K, char* smem,
                  f32x16 (&acc)[2][2]) {
  const int tid = tid_(), lane = tid & 63, w = tid >> 6, wm = w >> 1, wn = w & 1;
  const int c8 = tid & 7, r0 = tid >> 3;
  const bfu* ga = A + (size_t)r0 * lda + c8 * 8;
  const bfu* gb = B + (size_t)r0 * ldb + c8 * 8;
  const int st_off = r0 * 128 + ((c8 ^ ((r0 >> 1) & 7)) * 16);
  const int fr = lane & 31, hh = lane >> 5, fsw = (fr >> 1) & 7;
  const int a_base = (wm * 64 + fr) * 128;
  const int b_base = 16384 + (wn * 64 + fr) * 128;
  uint4 ra[4], rb[4];
#pragma unroll
  for (int i = 0; i < 4; ++i) {
    ra[i] = *(const uint4*)(ga + (size_t)i * 32 * lda);
    rb[i] = *(const uint4*)(gb + (size_t)i * 32 * ldb);
  }
#pragma unroll
  for (int i = 0; i < 4; ++i) {
    *(uint4*)(smem + st_off + i * 4096) = ra[i];
    *(uint4*)(smem + 16384 + st_off + i * 4096) = rb[i];
  }
  __syncthreads();
  const int KT = K >> 6;
#define GEMM_COMPUTE(cur)                                                                  \
  _Pragma("unroll") for (int s = 0; s < 4; ++s) {                                          \
    const int co = ((2 * s + hh) ^ fsw) * 16;                                              \
    bf16x8 a0 = *(const bf16x8*)((cur) + a_base + co);                                     \
    bf16x8 a1 = *(const bf16x8*)((cur) + a_base + 4096 + co);                              \
    bf16x8 b0 = *(const bf16x8*)((cur) + b_base + co);                                     \
    bf16x8 b1 = *(const bf16x8*)((cur) + b_base + 4096 + co);                              \
    acc[0][0] = __builtin_amdgcn_mfma_f32_32x32x16_bf16(a0, b0, acc[0][0], 0, 0, 0);       \
    acc[0][1] = __builtin_amdgcn_mfma_f32_32x32x16_bf16(a0, b1, acc[0][1], 0, 0, 0);       \
    acc[1][0] = __builtin_amdgcn_mfma_f32_32x32x16_bf16(a1, b0, acc[1][0], 0, 0, 0);       \
    acc[1][1] = __builtin_amdgcn_mfma_f32_32x32x16_bf16(a1, b1, acc[1][1], 0, 0, 0);       \
  }
#define GEMM_LOAD()                                                                        \
  _Pragma("unroll") for (int i = 0; i < 4; ++i) {                                          \
    ra[i] = *(const uint4*)(ga + (size_t)i * 32 * lda);                                    \
    rb[i] = *(const uint4*)(gb + (size_t)i * 32 * ldb);                                    \
  }
#define GEMM_STORE(buf)                                                                    \
  _Pragma("unroll") for (int i = 0; i < 4; ++i) {                                          \
    *(uint4*)((buf) + st_off + i * 4096) = ra[i];                                          \
    *(uint4*)((buf) + 16384 + st_off + i * 4096) = rb[i];                                  \
  }
#pragma unroll 1
  for (int kt = 0; kt < KT; kt += 2) {
    ga += 64; gb += 64;
    GEMM_LOAD()
    __builtin_amdgcn_sched_barrier(0);
    GEMM_COMPUTE(smem)
    __builtin_amdgcn_sched_barrier(0);
    GEMM_STORE(smem + 32768)
    __syncthreads();
    const int adv = (kt + 2 < KT) ? 64 : 0;
    ga += adv; gb += adv;
    GEMM_LOAD()
    __builtin_amdgcn_sched_barrier(0);
    GEMM_COMPUTE(smem + 32768)
    __builtin_amdgcn_sched_barrier(0);
    GEMM_STORE(smem)
    __syncthreads();
  }
}

DI void acc_zero(f32x16 (&acc)[2][2]) {
#pragma unroll
  for (int i = 0; i < 2; ++i)
#pragma unroll
    for (int j = 0; j < 2; ++j)
#pragma unroll
      for (int r = 0; r < 16; ++r) acc[i][j][r] = 0.f;
}

DI void acc_to_lds(const f32x16 (&acc)[2][2], char* smem) {
  float* sf = (float*)smem;
  const int tid = tid_(), lane = tid & 63, w = tid >> 6;
  const int rb = (w >> 1) * 64 + 4 * (lane >> 5), cb = (w & 1) * 64 + (lane & 31);
#pragma unroll
  for (int i = 0; i < 2; ++i)
#pragma unroll
    for (int j = 0; j < 2; ++j)
#pragma unroll
      for (int r = 0; r < 16; ++r)
        sf[(rb + i * 32 + (r & 3) + 8 * (r >> 2)) * 128 + cb + j * 32] = acc[i][j][r];
}
DI void unpack8(const uint4 v, float (&f)[8]) {
  f[0] = __uint_as_float(v.x << 16); f[1] = __uint_as_float(v.x & 0xffff0000u);
  f[2] = __uint_as_float(v.y << 16); f[3] = __uint_as_float(v.y & 0xffff0000u);
  f[4] = __uint_as_float(v.z << 16); f[5] = __uint_as_float(v.z & 0xffff0000u);
  f[6] = __uint_as_float(v.w << 16); f[7] = __uint_as_float(v.w & 0xffff0000u);
}
DI uint4 pack8(const float (&f)[8]) {
  uint4 o;
  o.x = pack2(f[0], f[1]); o.y = pack2(f[2], f[3]); o.z = pack2(f[4], f[5]); o.w = pack2(f[6], f[7]);
  return o;
}
#define EPI_LDS(...)                                                             \
  {                                                                              \
    acc_to_lds(acc, smem);                                                       \
    __syncthreads();                                                             \
    _Pragma("unroll 1") for (int it_ = 0; it_ < 8; ++it_) {                      \
      const int row = (tid_() >> 4) + 16 * it_;                             \
      const int c0 = (tid_() & 15) * 8;                                     \
      float v[8];                                                                \
      {                                                                          \
        const float4 t0 = *(const float4*)(smem + (row * 128 + c0) * 4);         \
        const float4 t1 = *(const float4*)(smem + (row * 128 + c0 + 4) * 4);     \
        v[0] = t0.x; v[1] = t0.y; v[2] = t0.z; v[3] = t0.w;                      \
        v[4] = t1.x; v[5] = t1.y; v[6] = t1.z; v[7] = t1.w;                      \
      }                                                                          \
      __VA_ARGS__                                                                \
    }                                                                            \
    __syncthreads();                                                             \
  }

typedef __attribute__((ext_vector_type(4))) float f32x4;
constexpr int G_BK = 64, G_HALF = 128, G_HT = G_HALF * G_BK;
DI int g_lds_byte(int r, int c) {
  int st = (r >> 4) * 2 + (c >> 5), rr = r & 15, cc = c & 31, ob = rr * 64 + cc * 2;
  return st * 1024 + (ob ^ (((ob >> 9) & 1) << 5));
}
DI void g_stage_rc(int b, int& R, int& C) {
  int st = b / 1024, sb = b % 1024, swz = sb ^ (((sb >> 9) & 1) << 5);
  R = (st >> 1) * 16 + swz / 64; C = (st & 1) * 32 + (swz % 64) / 2;
}
DI const char* g_uniform(const char* ptr) {
  unsigned long long u = (unsigned long long)ptr;
  unsigned lo = __builtin_amdgcn_readfirstlane((unsigned)u), hi = __builtin_amdgcn_readfirstlane((unsigned)(u >> 32));
  return (const char*)(((unsigned long long)hi << 32) | lo);
}
DI void gemm256(const bfu* __restrict__ A, int lda, const bfu* __restrict__ Bt, int ldb, int K, int brow, int bcol,
                bfu* shm, f32x4 (&acc)[2][2][4][2]) {
#define G_SA(b, h) (shm + ((b) * 2 + (h)) * G_HT)
#define G_SB(b, h) (shm + (4 + (b) * 2 + (h)) * G_HT)
#define G_STAGE(P, BASE, LD, br, kt)                                                                   \
  do {                                                                                                 \
    const char* _u = g_uniform((const char*)((BASE) + ((long)(br) * (LD) + (long)(kt) * G_BK)));       \
    __builtin_amdgcn_global_load_lds((const unsigned*)(_u + soff_b),                                   \
        (__attribute__((address_space(3))) unsigned*)((char*)(P) + ldst), 16, 0, 0);                   \
    __builtin_amdgcn_global_load_lds((const unsigned*)(_u + 128 * (long)(LD) + soff_b),                \
        (__attribute__((address_space(3))) unsigned*)((char*)(P) + ldst + 8192), 16, 0, 0);            \
  } while (0)
#define G_LDA(dst, b, h) for (int m = 0; m < 4; ++m) for (int k = 0; k < 2; ++k) \
    dst[m][k] = *reinterpret_cast<const bf16x8*>((char*)G_SA(b, h) + a_rd + m * 2048 + k * 1024)
#define G_LDB(dst, b, h) for (int n = 0; n < 2; ++n) for (int k = 0; k < 2; ++k) \
    dst[n][k] = *reinterpret_cast<const bf16x8*>((char*)G_SB(b, h) + b_rd + n * 2048 + k * 1024)
#define G_MMA(ai, bj, At, Bt_)                                                                         \
  do {                                                                                                 \
    __builtin_amdgcn_s_setprio(1);                                                                     \
    for (int m = 0; m < 4; ++m) for (int n = 0; n < 2; ++n) for (int k = 0; k < 2; ++k)                \
      acc[ai][bj][m][n] = __builtin_amdgcn_mfma_f32_16x16x32_bf16(At[m][k], Bt_[n][k], acc[ai][bj][m][n], 0, 0, 0); \
    __builtin_amdgcn_s_setprio(0);                                                                     \
  } while (0)
#define G_WAIT_V(n) asm volatile("s_waitcnt vmcnt(" #n ")" ::: "memory")
#define G_WAIT_L(n) asm volatile("s_waitcnt lgkmcnt(" #n ")" ::: "memory")
#define G_BAR __builtin_amdgcn_s_barrier()
#define G_SCHED __builtin_amdgcn_sched_barrier(0)
  int t512 = threadIdx.x; asm volatile("" : "+v"(t512));
  const int wid = __builtin_amdgcn_readfirstlane(t512 >> 6), lane = t512 & 63, wr = wid >> 2, wc = wid & 3, fr = lane & 15, fq = lane >> 4;
  const int ldst = t512 * 16;
  unsigned soff_b;
  {
    int R0, C0;
    g_stage_rc(ldst, R0, C0);
    soff_b = (unsigned)(R0 * lda + C0) * 2u;
  }
  const int lane_off = (fr * 64 + fq * 16) ^ ((fr >> 3) << 5);
  const int a_rd = wr * 8192 + lane_off, b_rd = wc * 4096 + lane_off;
  bf16x8 At[4][2], B0[2][2], B1[2][2];
  const int nt = K / G_BK;
  G_STAGE(G_SB(0, 0), Bt, ldb, bcol, 0); G_STAGE(G_SA(0, 0), A, lda, brow, 0);
  G_STAGE(G_SB(0, 1), Bt, ldb, bcol + G_HALF, 0); G_STAGE(G_SA(0, 1), A, lda, brow + G_HALF, 0);
  if (wr == 1) G_BAR;
  G_WAIT_V(4); G_BAR;
  G_STAGE(G_SB(1, 0), Bt, ldb, bcol, 1); G_STAGE(G_SA(1, 0), A, lda, brow, 1); G_STAGE(G_SB(1, 1), Bt, ldb, bcol + G_HALF, 1);
  G_WAIT_V(6); G_BAR;
#pragma unroll 1
  for (int t = 0; t < nt - 2; t += 2) {
    G_LDB(B0, 0, 0); G_SCHED; G_LDA(At, 0, 0); G_STAGE(G_SA(1, 1), A, lda, brow + G_HALF, t + 1);
    G_WAIT_L(8); G_BAR; G_WAIT_L(0); G_MMA(0, 0, At, B0); G_BAR; G_SCHED;
    G_LDB(B1, 0, 1); G_STAGE(G_SB(0, 0), Bt, ldb, bcol, t + 2);
    G_BAR; G_WAIT_L(0); G_MMA(0, 1, At, B1); G_BAR;
    G_LDA(At, 0, 1); G_STAGE(G_SA(0, 0), A, lda, brow, t + 2);
    G_BAR; G_WAIT_L(0); G_MMA(1, 0, At, B0); G_BAR; G_SCHED;
    G_STAGE(G_SB(0, 1), Bt, ldb, bcol + G_HALF, t + 2);
    G_WAIT_V(6); G_BAR; G_MMA(1, 1, At, B1); G_BAR;
    G_LDB(B0, 1, 0); G_SCHED; G_LDA(At, 1, 0); G_STAGE(G_SA(0, 1), A, lda, brow + G_HALF, t + 2);
    G_WAIT_L(8); G_BAR; G_WAIT_L(0); G_MMA(0, 0, At, B0); G_BAR; G_SCHED;
    G_LDB(B1, 1, 1); G_STAGE(G_SB(1, 0), Bt, ldb, bcol, t + 3);
    G_BAR; G_WAIT_L(0); G_MMA(0, 1, At, B1); G_BAR;
    G_LDA(At, 1, 1); G_STAGE(G_SA(1, 0), A, lda, brow, t + 3);
    G_BAR; G_WAIT_L(0); G_MMA(1, 0, At, B0); G_BAR; G_SCHED;
    G_STAGE(G_SB(1, 1), Bt, ldb, bcol + G_HALF, t + 3);
    G_WAIT_V(6); G_BAR; G_MMA(1, 1, At, B1); G_BAR;
  }
  { G_LDB(B0, 0, 0); G_LDA(At, 0, 0); G_STAGE(G_SA(1, 1), A, lda, brow + G_HALF, nt - 1);
    G_BAR; G_WAIT_L(0); G_MMA(0, 0, At, B0); G_BAR;
    G_LDB(B1, 0, 1); G_BAR; G_WAIT_L(0); G_MMA(0, 1, At, B1); G_BAR;
    G_LDA(At, 0, 1); G_WAIT_V(4); G_BAR; G_WAIT_L(0); G_MMA(1, 0, At, B0); G_MMA(1, 1, At, B1); G_BAR; }
  { G_LDB(B0, 1, 0); G_LDA(At, 1, 0); G_WAIT_V(2); G_BAR; G_WAIT_L(0); G_MMA(0, 0, At, B0); G_BAR;
    G_LDB(B1, 1, 1); G_WAIT_V(0); G_BAR; G_WAIT_L(0); G_MMA(0, 1, At, B1); G_BAR;
    G_LDA(At, 1, 1); G_BAR; G_WAIT_L(0); G_MMA(1, 0, At, B0); G_MMA(1, 1, At, B1); G_BAR; }
  if (wr == 0) G_BAR;
}
DI void acc256_zero(f32x4 (&acc)[2][2][4][2]) {
#pragma unroll
  for (int a = 0; a < 2; ++a)
#pragma unroll
    for (int b = 0; b < 2; ++b)
#pragma unroll
      for (int m = 0; m < 4; ++m)
#pragma unroll
        for (int n = 0; n < 2; ++n) acc[a][b][m][n] = (f32x4){0.f, 0.f, 0.f, 0.f};
}
#define EPI256(...)                                                                                   \
  {                                                                                                    \
    int t512_ = threadIdx.x; asm volatile("" : "+v"(t512_));     \
    const int wid_ = t512_ >> 6, lane_ = t512_ & 63, wr_ = wid_ >> 2, wc_ = wid_ & 3,                  \
              fr_ = lane_ & 15, fq_ = lane_ >> 4;                                                      \
    float* sf_ = (float*)smem;                                                                         \
    _Pragma("unroll") for (int ai_ = 0; ai_ < 2; ++ai_) {                                              \
      __syncthreads();                                                                                 \
      _Pragma("unroll") for (int bj_ = 0; bj_ < 2; ++bj_)                                              \
      _Pragma("unroll") for (int m_ = 0; m_ < 4; ++m_)                                                 \
      _Pragma("unroll") for (int n_ = 0; n_ < 2; ++n_)                                                 \
      _Pragma("unroll") for (int j_ = 0; j_ < 4; ++j_)                                                 \
        sf_[(wr_ * 64 + m_ * 16 + fq_ * 4 + j_) * 256 + ((bj_ * 128 + wc_ * 32 + n_ * 16 + fr_) ^ (fq_ << 4))] = \
            acc[ai_][bj_][m_][n_][j_];                                                                 \
      __syncthreads();                                                                                 \
      _Pragma("unroll 1") for (int it_ = 0; it_ < 8; ++it_) {                                          \
        const int idx_ = t512_ + 512 * it_;                                                            \
        const int rl_ = idx_ >> 5, c0 = (idx_ & 31) * 8;                                               \
        const int row = ai_ * 128 + rl_;                                                               \
        float v[8];                                                                                    \
        {                                                                                              \
          const float* sp_ = sf_ + rl_ * 256 + (c0 ^ (((rl_ >> 2) & 3) << 4));                          \
          const float4 t0 = *(const float4*)sp_; const float4 t1 = *(const float4*)(sp_ + 4);          \
          v[0] = t0.x; v[1] = t0.y; v[2] = t0.z; v[3] = t0.w;                                          \
          v[4] = t1.x; v[5] = t1.y; v[6] = t1.z; v[7] = t1.w;                                          \
        }                                                                                              \
        __VA_ARGS__                                                                                    \
      }                                                                                                \
    }                                                                                                  \
    __syncthreads();                                                                                   \
  }

template <int MT, int NT, int BH>
DI bool xcd_tile(int iter, int& mt, int& nt) {
  constexpr int MPX = MT / 8, TPX = MPX * NT;
  const int xcd = VXCD, j = VJ, nloc = VNLOC;
  const int q = j + iter * nloc;
  if (q >= TPX) return false;
  const int band = q / (BH * NT), r = q % (BH * NT);
  nt = r / BH;
  mt = xcd * MPX + band * BH + (r % BH);
  return true;
}

DI bool tile256(int iter, int NT, int& mt, int& nt) {
  const int xcd = blockIdx.x & 7, j = blockIdx.x >> 3, nloc = gridDim.x >> 3;
  const int q = j + iter * nloc;
  if (q >= 6 * NT) return false;
  nt = q / 6; mt = xcd * 6 + q % 6;
  return true;
}
DI void phase_gemm_in(const Params& p, int l, char* smem) {
  const bfu* W = p.w_inT + (size_t)l * DINP * LDH;
  for (int iter = 0;; ++iter) {
    int mt, nt;
    if (!tile256(iter, 19, mt, nt)) break;
    f32x4 acc[2][2][4][2];
    acc256_zero(acc);
    gemm256(p.h, LDH, W, LDH, 1024, mt * 256, nt * 256, (bfu*)smem, acc);
    const int m0 = mt * 256, n0 = nt * 256;
    EPI256({
      const int n = n0 + c0;
      if (n < 512) *(uint4*)(p.ug + ((size_t)(n >> 4) * NTOK + (m0 + row)) * 16 + (n & 15)) = pack8(v);
      else if (n < DIN) *(uint4*)(p.proj + (size_t)(m0 + row) * PW + (n - 512)) = pack8(v);
    })
  }
}

DI void s5_gen_item(const Params& p, int l, int item, char* smem) {
  const int tid = tid_();
  const int g = item >> 3, r = item & 7;
  float* sBr = (float*)smem;
  float* sBi = sBr + 2048;
  float* sCr = sBi + 2048;
  float* sCi = sCr + 1024;
  float* sAK = sCi + 1024;
  float* sAE = sAK + 1024;
  float* sAG = sAE + 1024;
  float* sK = sAG + 1024;
  bfu* E = p.opE + (size_t)g * 256 * 512;
  bfu* MG = p.opMG + (size_t)g * 512 * 768;
  __syncthreads();
  if (tid < 128) {
    const int d = tid >> 6, pp = tid & 63;
    const size_t pi = ((size_t)(l * 2 + d) * 32 + g) * 64 + pp;
    const float lr = p.lam_re[pi], li = p.lam_im[pi];
    const float dt = expf(p.log_dt[(l * 2 + d) * 32 + g]);
    const float mag = expf(lr * dt);
    float sn, cs;
    sincosf(li * dt, &sn, &cs);
    const float are = mag * cs, aim = mag * sn;
    const float nr = are - 1.f, ni = aim, den = lr * lr + li * li;
    const float kr = (nr * lr + ni * li) / den, ki = (ni * lr - nr * li) / den;
#pragma unroll
    for (int c = 0; c < 16; ++c) {
      float br = p.b_re[((size_t)(l * 32 + g) * 64 + pp) * 16 + c];
      float bi = p.b_im[((size_t)(l * 32 + g) * 64 + pp) * 16 + c];
      sBr[(d * 64 + pp) * 16 + c] = kr * br - ki * bi;
      sBi[(d * 64 + pp) * 16 + c] = kr * bi + ki * br;
    }
#pragma unroll
    for (int q = 0; q < 4; ++q) {
      const int t = 4 * r + q;
      const int nK = t;
      const int nE = d == 0 ? 31 - t : t;
      const int nG = d == 0 ? t + 1 : 32 - t;
      float m, s_, c_;
      m = expf(lr * dt * (float)nK); sincosf(li * dt * (float)nK, &s_, &c_);
      sAK[((d * 4 + q) * 64 + pp) * 2] = m * c_; sAK[((d * 4 + q) * 64 + pp) * 2 + 1] = m * s_;
      m = expf(lr * dt * (float)nE); sincosf(li * dt * (float)nE, &s_, &c_);
      sAE[((d * 4 + q) * 64 + pp) * 2] = m * c_; sAE[((d * 4 + q) * 64 + pp) * 2 + 1] = m * s_;
      m = expf(lr * dt * (float)nG); sincosf(li * dt * (float)nG, &s_, &c_);
      sAG[((d * 4 + q) * 64 + pp) * 2] = m * c_; sAG[((d * 4 + q) * 64 + pp) * 2 + 1] = m * s_;
    }
  } else {
    for (int idx = tid - 128; idx < 1024; idx += 128) {
      sCr[idx] = p.c_re[(size_t)(l * 32 + g) * 1024 + idx];
      sCi[idx] = p.c_im[(size_t)(l * 32 + g) * 1024 + idx];
    }
  }
  __syncthreads();
  for (int idx = tid; idx < 256 * 64; idx += 256) {
    const int row = idx >> 6, cc = idx & 63, q = cc >> 4, c = cc & 15;
    const int part = row >> 6, pp = row & 63, d = part >> 1;
    const float ar = sAE[((d * 4 + q) * 64 + pp) * 2], ai = sAE[((d * 4 + q) * 64 + pp) * 2 + 1];
    const float br = sBr[(d * 64 + pp) * 16 + c], bi = sBi[(d * 64 + pp) * 16 + c];
    const float v = (part & 1) ? (ar * bi + ai * br) : (ar * br - ai * bi);
    E[(size_t)row * 512 + (4 * r + q) * 16 + c] = f2bf(v);
  }
  for (int idx = tid; idx < 64 * 256; idx += 256) {
    const int rr = idx >> 8, col = idx & 255, q = rr >> 4, c = rr & 15;
    const int part = col >> 6, pp = col & 63, d = part >> 1;
    const float ar = sAG[((d * 4 + q) * 64 + pp) * 2], ai = sAG[((d * 4 + q) * 64 + pp) * 2 + 1];
    const float cr = sCr[c * 64 + pp], ci = sCi[c * 64 + pp];
    const float v = (part & 1) ? -(cr * ai + ci * ar) : (cr * ar - ci * ai);
    MG[(size_t)((4 * r + q) * 16 + c) * 768 + 512 + col] = f2bf(v);
  }
  {
    const int d = tid >> 7, q = (tid >> 5) & 3, c = (tid >> 1) & 15, ch = tid & 1;
    float acc[8];
#pragma unroll
    for (int e = 0; e < 8; ++e) acc[e] = 0.f;
    for (int pp = 0; pp < 64; ++pp) {
      const float ar = sAK[((d * 4 + q) * 64 + pp) * 2], ai = sAK[((d * 4 + q) * 64 + pp) * 2 + 1];
      const float cr = sCr[c * 64 + pp], ci = sCi[c * 64 + pp];
      const float wr = cr * ar - ci * ai, wi = cr * ai + ci * ar;
#pragma unroll
      for (int e = 0; e < 8; ++e)
        acc[e] += wr * sBr[(d * 64 + pp) * 16 + ch * 8 + e] - wi * sBi[(d * 64 + pp) * 16 + ch * 8 + e];
    }
#pragma unroll
    for (int e = 0; e < 8; ++e) sK[((d * 4 + q) * 16 + c) * 16 + ch * 8 + e] = acc[e];
  }
  __syncthreads();
  for (int idx = tid; idx < 8192; idx += 256) {
    const int ch = idx & 1, c = (idx >> 1) & 15, tp = (idx >> 5) & 31, q = (idx >> 10) & 3, d = idx >> 12;
    const int tau = 4 * r + q;
    int sp;
    bool valid;
    if (d == 0) { sp = tp - tau; valid = sp >= 0; } else { sp = tp + tau; valid = (sp <= 31) && (tau > 0); }
    if (valid) {
      float v[8];
#pragma unroll
      for (int e = 0; e < 8; ++e) {
        float x = sK[((d * 4 + q) * 16 + c) * 16 + ch * 8 + e];
        if (tau == 0) x += sK[((1 * 4 + q) * 16 + c) * 16 + ch * 8 + e];
        v[e] = x;
      }
      *(uint4*)(MG + (size_t)(tp * 16 + c) * 768 + sp * 16 + ch * 8) = pack8(v);
    }
  }
  __syncthreads();
}

DI void phase_s5_gen(const Params& p, int l, char* smem) {
  for (int it = NVB - 1 - VBID; it < 256; it += NVB) s5_gen_item(p, l, it, smem);
}

DI void phase_s5_e(const Params& p, char* smem) {
  for (int q = VJ; q < 24; q += VNLOC) {
    const int g = VXCD * 4 + q / 6, r6 = q % 6, mt = r6 >> 1, nt = r6 & 1;
    f32x16 acc[2][2];
    acc_zero(acc);
    gemm_core(p.ug + ((size_t)g * NCHUNK + mt * 128) * 512, 512, p.opE + ((size_t)g * 256 + nt * 128) * 512, 512, 512,
              smem, acc);
    EPI_LDS({
      float* dst = p.ebuf + ((size_t)g * NCHUNK + mt * 128 + row) * 256 + nt * 128 + c0;
      *(float4*)dst = make_float4(v[0], v[1], v[2], v[3]);
      *(float4*)(dst + 4) = make_float4(v[4], v[5], v[6], v[7]);
    })
  }
}

DI void phase_s5_scan(const Params& p, int l) {
  const int tid = tid_();
  for (int it = VBID; it < 320; it += NVB) {
    const int wi = it * 2 + (tid >> 7);
    const int dir = (tid >> 6) & 1, pp = tid & 63;
    int chunk0, n, b, g;
    bool prompt;
    if (wi < 128) { b = wi >> 5; g = wi & 31; chunk0 = (NPROMPT + b * 2048) >> 5; n = 64; prompt = false; }
    else { int q = wi - 128; b = q >> 5; g = q & 31; chunk0 = (b * 256) >> 5; n = 8; prompt = true; }
    const size_t pi = ((size_t)(l * 2 + dir) * 32 + g) * 64 + pp;
    const float lr = p.lam_re[pi], li = p.lam_im[pi];
    const float dt = expf(p.log_dt[(l * 2 + dir) * 32 + g]);
    const float mag = expf(lr * dt * 32.f);
    float sn, cs;
    sincosf(li * dt * 32.f, &sn, &cs);
    const float are = mag * cs, aim = mag * sn;
    float hre = 0.f, him = 0.f;
    if (!prompt) {
      size_t si = ((size_t)((b * 2 + l) * 2 + dir)) * 2048 + g * 64 + pp;
      hre = p.st_re[si]; him = p.st_im[si];
    }
    const float* eb = p.ebuf + ((size_t)g * NCHUNK + chunk0) * 256 + dir * 128 + pp;
    bfu* cb = p.carry + ((size_t)g * NCHUNK + chunk0) * 256 + dir * 128 + pp;
    for (int k0 = 0; k0 < n; k0 += 8) {
      float er[8], ei[8];
#pragma unroll
      for (int j = 0; j < 8; ++j) {
        const int k = dir == 0 ? k0 + j : n - 1 - (k0 + j);
        er[j] = eb[(size_t)k * 256];
        ei[j] = eb[(size_t)k * 256 + 64];
      }
#pragma unroll
      for (int j = 0; j < 8; ++j) {
        const int k = dir == 0 ? k0 + j : n - 1 - (k0 + j);
        cb[(size_t)k * 256] = f2bf(hre);
        cb[(size_t)k * 256 + 64] = f2bf(him);
        const float nre = are * hre - aim * him + er[j];
        const float nim = are * him + aim * hre + ei[j];
        hre = nre; him = nim;
      }
    }
    if (prompt) {
      size_t oi = ((size_t)((b * 2 + l) * 2 + dir)) * 2048 + g * 64 + pp;
      p.out[OUT_RE + oi] = hre;
      p.out[OUT_IM + oi] = him;
    }
  }
}

DI void phase_s5_y(const Params& p, int l, char* smem) {
  for (int q = VJ; q < 48; q += VNLOC) {
    const int g = VXCD * 4 + q / 12, r12 = q % 12, mt = r12 >> 2, nt = r12 & 3;
    f32x16 acc[2][2];
    acc_zero(acc);
    const bfu* Bm = p.opMG + ((size_t)g * 512 + nt * 128) * 768;
    gemm_core(p.ug + ((size_t)g * NCHUNK + mt * 128) * 512, 512, Bm, 768, 512, smem, acc);
    gemm_core(p.carry + ((size_t)g * NCHUNK + mt * 128) * 256, 256, Bm + 512, 768, 256, smem, acc);
    EPI_LDS({
      const int chunk = mt * 128 + row, nn = nt * 128 + c0, tp = nn >> 4, c = nn & 15;
      const int tok = chunk * 32 + tp;
      float u[8], o[8];
      unpack8(*(const uint4*)(p.ug + ((size_t)g * NTOK + tok) * 16 + c), u);
      const float* dsk = p.s5_d + l * 512 + g * 16 + c;
      _Pragma("unroll") for (int e = 0; e < 8; ++e) o[e] = geluf_(v[e] + dsk[e] * u[e]);
      *(uint4*)(p.ys5 + (size_t)tok * 512 + g * 16 + c) = pack8(o);
    })
  }
}

DI void phase_glu(const Params& p, int l, char* smem) {
  const bfu* W = p.w_gluT + (size_t)l * 512 * 512;
  for (int iter = 0;; ++iter) {
    int mt, nt;
    if (!xcd_tile<96, 4, 12>(iter, mt, nt)) break;
    f32x16 acc[2][2];
    acc_zero(acc);
    gemm_core(p.ys5 + (size_t)mt * 128 * 512, 512, W + (size_t)nt * 128 * 512, 512, 512, smem, acc);
    const int m0 = mt * 128, n0 = nt * 128;
    EPI_LDS({
      const int n = n0 + c0;
      const size_t tk = (size_t)(m0 + row);
      float y[8], ga[8], o[8];
      unpack8(*(const uint4*)(p.ys5 + tk * 512 + n), y);
      unpack8(*(const uint4*)(p.proj + tk * PW + OFF_GA + n), ga);
      const float* bg = p.b_glu + l * 512 + n;
      _Pragma("unroll") for (int e = 0; e < 8; ++e) o[e] = y[e] * sigmoidf_(v[e] + bg[e]) * siluf_(ga[e]);
      *(uint4*)(p.ya + tk * 512 + n) = pack8(o);
    })
  }
}

constexpr int GL_QS = 0;
constexpr int GL_KS = GL_QS + 32 * 144;
constexpr int GL_KHT = GL_KS + 32 * 144;
constexpr int GL_VT = GL_KHT + 64 * 80;
constexpr int GL_PS = GL_VT + 128 * 80;
constexpr int GL_ST = GL_PS + 32 * 80;
constexpr int GL_AV = GL_ST + 128 * 144;
constexpr int GL_TOT = GL_AV + 256;
constexpr int GL_OS = GL_TOT + 1024;
static_assert(GL_OS + 32 * 132 * 4 <= 65536, "gla lds");

DI void gla_segment_info(int seg, int& tok_base, bool& prompt, int& b, int& sidx) {
  if (seg < 16) { prompt = true; b = seg; sidx = 0; tok_base = seg * 256; }
  else { int q = seg - 16; prompt = false; b = q >> 3; sidx = q & 7; tok_base = NPROMPT + b * 2048 + sidx * 256; }
}

template <bool STATE_ONLY>
DI void gla_chain(const Params& p, int l, char* smem, int seg, int hd, int dir) {
  const int tid = tid_(), lane = tid & 63, w = tid >> 6;
  const int fr = lane & 31, hh = lane >> 5;
  int tok_base, b, sidx;
  bool prompt;
  gla_segment_info(seg, tok_base, prompt, b, sidx);
  const int dk = tid & 63, tq = tid >> 6;
  const int dvl = tid & 127, th = tid >> 7;
  float wg[16];
#pragma unroll
  for (int q = 0; q < 16; ++q) wg[q] = p.wg_up[((size_t)(l * 2 + dir) * 16 + q) * 256 + hd * 64 + dk];
  const float bgv = p.bg[(l * 2 + dir) * 256 + hd * 64 + dk];
  float* sAv = (float*)(smem + GL_AV);
  float* sTot = (float*)(smem + GL_TOT);
  float* sOs = (float*)(smem + GL_OS);

  f32x16 S[2];
  {
    const int dvc = 32 * w + fr;
    if (STATE_ONLY || prompt) {
#pragma unroll
      for (int mt = 0; mt < 2; ++mt)
#pragma unroll
        for (int r = 0; r < 16; ++r) S[mt][r] = 0.f;
    } else {
      const float* sp = p.st_gla + ((size_t)(((b * 2 + l) * 2 + dir) * 4 + hd)) * 8192;
#pragma unroll
      for (int mt = 0; mt < 2; ++mt)
#pragma unroll
        for (int r = 0; r < 16; ++r) S[mt][r] = sp[(32 * mt + (r & 3) + 8 * (r >> 2) + 4 * hh) * 128 + dvc];
      const int nprev = dir == 0 ? sidx : 7 - sidx;
      for (int q = 0; q < nprev; ++q) {
        const int sprev = dir == 0 ? q : 7 - q;
        const size_t ci = (size_t)(((b * 8 + sprev) * 4 + hd) * 2 + dir);
        const float* sl = p.gla_sloc + ci * 8192;
        const float* al = p.gla_aseg + ci * 64;
#pragma unroll
        for (int mt = 0; mt < 2; ++mt)
#pragma unroll
          for (int r = 0; r < 16; ++r) {
            const int dkk = 32 * mt + (r & 3) + 8 * (r >> 2) + 4 * hh;
            S[mt][r] = al[dkk] * S[mt][r] + sl[dkk * 128 + dvc];
          }
      }
    }
  }
  float bsum = 0.f;
  __syncthreads();
  if (!STATE_ONLY) {
    const int dvc = 32 * w + fr;
#pragma unroll
    for (int mt = 0; mt < 2; ++mt)
#pragma unroll
      for (int q = 0; q < 4; ++q) {
        uint2 pk;
        pk.x = pack2(S[mt][4 * q], S[mt][4 * q + 1]);
        pk.y = pack2(S[mt][4 * q + 2], S[mt][4 * q + 3]);
        *(uint2*)(smem + GL_ST + dvc * 144 + (32 * mt + 8 * q + 4 * hh) * 2) = pk;
      }
  }

  uint4 rq = make_uint4(0, 0, 0, 0), rk = rq, rv0 = rq, rv1 = rq, rgl = rq;
#define GLA_ISSUE(nn)                                                                                         \
  {                                                                                                           \
    const int cn_ = dir == 0 ? (nn) : 7 - (nn);                                                               \
    const int c0_ = tok_base + cn_ * 32;                                                                      \
    const int tA = dir == 0 ? (tid >> 3) : 31 - (tid >> 3);                                                   \
    const bfu* prA = p.proj + (size_t)(c0_ + tA) * PW + hd * 64 + (tid & 7) * 8;                              \
    if (!STATE_ONLY) rq = *(const uint4*)(prA + OFF_Q);                                                       \
    rk = *(const uint4*)(prA + OFF_K);                                                                        \
    const int tV0 = dir == 0 ? (tid >> 4) : 31 - (tid >> 4);                                                  \
    const int tV1 = dir == 0 ? (tid >> 4) + 16 : 15 - (tid >> 4);                                             \
    rv0 = *(const uint4*)(p.proj + (size_t)(c0_ + tV0) * PW + OFF_V + hd * 128 + (tid & 15) * 8);             \
    rv1 = *(const uint4*)(p.proj + (size_t)(c0_ + tV1) * PW + OFF_V + hd * 128 + (tid & 15) * 8);             \
    if (tid < 64) {                                                                                           \
      const int tG = dir == 0 ? (tid >> 1) : 31 - (tid >> 1);                                                 \
      rgl = *(const uint4*)(p.proj + (size_t)(c0_ + tG) * PW + OFF_GL + (tid & 1) * 8);                       \
    }                                                                                                         \
  }
  GLA_ISSUE(0)
  char* rawQ = smem + GL_OS;
  char* rawK = smem + GL_OS + 4096;
  char* rawV = smem + GL_OS + 8192;
  char* rawG = smem + GL_PS;

#pragma unroll 1
  for (int n = 0; n < 8; ++n) {
    const int cn = dir == 0 ? n : 7 - n;
    const int ctok0 = tok_base + cn * 32;
    __syncthreads();
    if (!STATE_ONLY) *(uint4*)(rawQ + (tid >> 3) * 128 + (tid & 7) * 16) = rq;
    *(uint4*)(rawK + (tid >> 3) * 128 + (tid & 7) * 16) = rk;
    *(uint4*)(rawV + (tid >> 4) * 256 + (tid & 15) * 16) = rv0;
    *(uint4*)(rawV + ((tid >> 4) + 16) * 256 + (tid & 15) * 16) = rv1;
    if (tid < 64) *(uint4*)(rawG + (tid >> 1) * 32 + (tid & 1) * 16) = rgl;
    if (n + 1 < 8) GLA_ISSUE(n + 1)
    uint4 eg0 = make_uint4(0, 0, 0, 0), eg1 = eg0;
    float4 et[4];
    if (!STATE_ONLY) {
      const size_t tokE = (size_t)(ctok0 + (tid >> 3));
      const bfu* gp = p.proj + tokE * PW + OFF_GB + hd * 128 + (tid & 7) * 16;
      if (dir == 0) {
        eg0 = *(const uint4*)gp; eg1 = *(const uint4*)(gp + 8);
        const float* tp = p.tmp_gla + tokE * 512 + hd * 128 + (tid & 7) * 16;
#pragma unroll
        for (int q = 0; q < 4; ++q) et[q] = *(const float4*)(tp + 4 * q);
      }
    }
    __syncthreads();
    float qv[8], kv[8], bl[8];
    {
      float run = 0.f;
#pragma unroll
      for (int i = 0; i < 8; ++i) {
        const int tau = tq * 8 + i;
        if (!STATE_ONLY) qv[i] = bf2f(*(const bfu*)(rawQ + tau * 128 + dk * 2)) * 0.125f;
        kv[i] = bf2f(*(const bfu*)(rawK + tau * 128 + dk * 2));
        float gl[16];
        unpack8(*(const uint4*)(rawG + tau * 32), *(float(*)[8])&gl[0]);
        unpack8(*(const uint4*)(rawG + tau * 32 + 16), *(float(*)[8])&gl[8]);
        float lg = bgv;
#pragma unroll
        for (int q = 0; q < 16; ++q) lg += gl[q] * wg[q];
        const float ls = fminf(lg, 0.f) - __logf(1.f + __expf(-fabsf(lg)));
        run += ls * (1.f / 16.f);
        bl[i] = run;
      }
      sTot[tq * 64 + dk] = run;
    }
    {
      unsigned pk[8];
#pragma unroll
      for (int i = 0; i < 8; ++i) {
        const int tau0 = th * 16 + 2 * i;
        const unsigned lo = *(const bfu*)(rawV + tau0 * 256 + dvl * 2);
        const unsigned hi = *(const bfu*)(rawV + (tau0 + 1) * 256 + dvl * 2);
        pk[i] = lo | (hi << 16);
      }
      *(uint4*)(smem + GL_VT + dvl * 80 + th * 32) = make_uint4(pk[0], pk[1], pk[2], pk[3]);
      *(uint4*)(smem + GL_VT + dvl * 80 + th * 32 + 16) = make_uint4(pk[4], pk[5], pk[6], pk[7]);
    }
    __syncthreads();
    {
      float off = 0.f, total = 0.f;
#pragma unroll
      for (int q = 0; q < 4; ++q) {
        const float tv = sTot[q * 64 + dk];
        total += tv;
        off += (q < tq) ? tv : 0.f;
      }
      unsigned kh[4];
      float khv[8];
#pragma unroll
      for (int i = 0; i < 8; ++i) {
        const float bb = off + bl[i];
        const int tau = tq * 8 + i;
        if (!STATE_ONLY) {
          *(bfu*)(smem + GL_QS + tau * 144 + dk * 2) = f2bf(qv[i] * __expf(bb));
          *(bfu*)(smem + GL_KS + tau * 144 + dk * 2) = f2bf(kv[i] * __expf(-bb));
        }
        khv[i] = kv[i] * __expf(total - bb);
      }
#pragma unroll
      for (int i = 0; i < 4; ++i) kh[i] = pack2(khv[2 * i], khv[2 * i + 1]);
      *(uint4*)(smem + GL_KHT + dk * 80 + tq * 16) = make_uint4(kh[0], kh[1], kh[2], kh[3]);
      if (tq == 0) { sAv[dk] = __expf(total); bsum += total; }
    }
    __syncthreads();
    f32x16 o;
    if (!STATE_ONLY) {
      f32x16 sc;
#pragma unroll
      for (int r = 0; r < 16; ++r) sc[r] = 0.f;
#pragma unroll
      for (int s4 = 0; s4 < 4; ++s4) {
        bf16x8 a = *(const bf16x8*)(smem + GL_QS + fr * 144 + (16 * s4 + 8 * hh) * 2);
        bf16x8 bq = *(const bf16x8*)(smem + GL_KS + fr * 144 + (16 * s4 + 8 * hh) * 2);
        sc = __builtin_amdgcn_mfma_f32_32x32x16_bf16(a, bq, sc, 0, 0, 0);
      }
#pragma unroll
      for (int rr = 0; rr < 4; ++rr) {
        float val = w == 0 ? sc[rr] : (w == 1 ? sc[4 + rr] : (w == 2 ? sc[8 + rr] : sc[12 + rr]));
        const int i = rr + 8 * w + 4 * hh;
        val = (fr <= i) ? val : 0.f;
        *(bfu*)(smem + GL_PS + i * 80 + fr * 2) = f2bf(val);
      }
      __syncthreads();
#pragma unroll
      for (int r = 0; r < 16; ++r) o[r] = 0.f;
    }
    {
      const int dvc = 32 * w + fr;
      bf16x8 vb0 = *(const bf16x8*)(smem + GL_VT + dvc * 80 + (8 * hh) * 2);
      bf16x8 vb1 = *(const bf16x8*)(smem + GL_VT + dvc * 80 + (16 + 8 * hh) * 2);
      if (!STATE_ONLY) {
        bf16x8 pa0 = *(const bf16x8*)(smem + GL_PS + fr * 80 + (8 * hh) * 2);
        bf16x8 pa1 = *(const bf16x8*)(smem + GL_PS + fr * 80 + (16 + 8 * hh) * 2);
        o = __builtin_amdgcn_mfma_f32_32x32x16_bf16(pa0, vb0, o, 0, 0, 0);
        o = __builtin_amdgcn_mfma_f32_32x32x16_bf16(pa1, vb1, o, 0, 0, 0);
#pragma unroll
        for (int s4 = 0; s4 < 4; ++s4) {
          bf16x8 a = *(const bf16x8*)(smem + GL_QS + fr * 144 + (16 * s4 + 8 * hh) * 2);
          bf16x8 sb = *(const bf16x8*)(smem + GL_ST + dvc * 144 + (16 * s4 + 8 * hh) * 2);
          o = __builtin_amdgcn_mfma_f32_32x32x16_bf16(a, sb, o, 0, 0, 0);
        }
      }
#pragma unroll
      for (int mt = 0; mt < 2; ++mt) {
        f32x16 U;
#pragma unroll
        for (int r = 0; r < 16; ++r) U[r] = 0.f;
        bf16x8 ka0 = *(const bf16x8*)(smem + GL_KHT + (32 * mt + fr) * 80 + (8 * hh) * 2);
        bf16x8 ka1 = *(const bf16x8*)(smem + GL_KHT + (32 * mt + fr) * 80 + (16 + 8 * hh) * 2);
        U = __builtin_amdgcn_mfma_f32_32x32x16_bf16(ka0, vb0, U, 0, 0, 0);
        U = __builtin_amdgcn_mfma_f32_32x32x16_bf16(ka1, vb1, U, 0, 0, 0);
#pragma unroll
        for (int q = 0; q < 4; ++q) {
          const float4 av = *(const float4*)(sAv + 32 * mt + 8 * q + 4 * hh);
          S[mt][4 * q + 0] = av.x * S[mt][4 * q + 0] + U[4 * q + 0];
          S[mt][4 * q + 1] = av.y * S[mt][4 * q + 1] + U[4 * q + 1];
          S[mt][4 * q + 2] = av.z * S[mt][4 * q + 2] + U[4 * q + 2];
          S[mt][4 * q + 3] = av.w * S[mt][4 * q + 3] + U[4 * q + 3];
          if (!STATE_ONLY) {
            uint2 pk;
            pk.x = pack2(S[mt][4 * q], S[mt][4 * q + 1]);
            pk.y = pack2(S[mt][4 * q + 2], S[mt][4 * q + 3]);
            *(uint2*)(smem + GL_ST + dvc * 144 + (32 * mt + 8 * q + 4 * hh) * 2) = pk;
          }
        }
      }
      if (!STATE_ONLY) {
#pragma unroll
        for (int r = 0; r < 16; ++r) sOs[((r & 3) + 8 * (r >> 2) + 4 * hh) * 132 + dvc] = o[r];
      }
    }
    __syncthreads();
    if (!STATE_ONLY) {
      const int t = tid >> 3, part = tid & 7;
      const int tau = dir == 0 ? t : 31 - t;
      const size_t tok = (size_t)(ctok0 + t);
      float ov[16];
#pragma unroll
      for (int q = 0; q < 4; ++q) {
        const float4 x = *(const float4*)(sOs + tau * 132 + part * 16 + 4 * q);
        ov[4 * q] = x.x; ov[4 * q + 1] = x.y; ov[4 * q + 2] = x.z; ov[4 * q + 3] = x.w;
      }
      float* tp = p.tmp_gla + tok * 512 + hd * 128 + part * 16;
      if (dir == 1) {
#pragma unroll
        for (int q = 0; q < 4; ++q) *(float4*)(tp + 4 * q) = make_float4(ov[4 * q], ov[4 * q + 1], ov[4 * q + 2], ov[4 * q + 3]);
      } else {
        float ss = 0.f;
#pragma unroll
        for (int q = 0; q < 4; ++q) {
          const float4 x = et[q];
          ov[4 * q] += x.x; ov[4 * q + 1] += x.y; ov[4 * q + 2] += x.z; ov[4 * q + 3] += x.w;
        }
#pragma unroll
        for (int e = 0; e < 16; ++e) ss += ov[e] * ov[e];
        ss += __shfl_xor(ss, 1); ss += __shfl_xor(ss, 2); ss += __shfl_xor(ss, 4);
        const float rs = rsqrtf(ss * (1.f / 128.f) + EPS);
        const float* gn = p.gla_norm_g + l * 512 + hd * 128 + part * 16;
        float gt[16];
        unpack8(eg0, *(float(*)[8])&gt[0]);
        unpack8(eg1, *(float(*)[8])&gt[8]);
        float res[16];
#pragma unroll
        for (int e = 0; e < 16; ++e) res[e] = ov[e] * rs * gn[e] * siluf_(gt[e]);
        bfu* yp = p.yb + tok * 512 + hd * 128 + part * 16;
        *(uint4*)yp = pack8(*(float(*)[8])&res[0]);
        *(uint4*)(yp + 8) = pack8(*(float(*)[8])&res[8]);
      }
    }
  }
  const int dvc = 32 * w + fr;
  if (STATE_ONLY) {
    const size_t ci = (size_t)(((b * 8 + sidx) * 4 + hd) * 2 + dir);
    float* sl = p.gla_sloc + ci * 8192;
#pragma unroll
    for (int mt = 0; mt < 2; ++mt)
#pragma unroll
      for (int r = 0; r < 16; ++r) sl[(32 * mt + (r & 3) + 8 * (r >> 2) + 4 * hh) * 128 + dvc] = S[mt][r];
    if (tq == 0) p.gla_aseg[ci * 64 + dk] = __expf(bsum);
  } else if (prompt) {
    float* op = p.out + OUT_GLA + ((size_t)(((b * 2 + l) * 2 + dir) * 4 + hd)) * 8192;
#pragma unroll
    for (int mt = 0; mt < 2; ++mt)
#pragma unroll
      for (int r = 0; r < 16; ++r) op[(32 * mt + (r & 3) + 8 * (r >> 2) + 4 * hh) * 128 + dvc] = S[mt][r];
  }
  __syncthreads();
}

DI void phase_gla_pass1(const Params& p, int l, char* smem) {
  for (int it = NVB - 1 - VBID; it < 256; it += NVB) {
    const int dir = it & 1, hd = (it >> 1) & 3, seg = 16 + (it >> 3);
    gla_chain<true>(p, l, smem, seg, hd, dir);
  }
}
DI void phase_gla_main(const Params& p, int l, char* smem) {
  for (int it = NVB - 1 - VBID; it < 192; it += NVB) {
    const int hd = it & 3, seg = it >> 2;
    gla_chain<false>(p, l, smem, seg, hd, 1);
    gla_chain<false>(p, l, smem, seg, hd, 0);
  }
}

DI void phase_merge(const Params& p, int l, char* smem) {
  const bfu* WA = p.w_paT + (size_t)l * 1024 * 512;
  const bfu* WB = p.w_pbT + (size_t)l * 1024 * 512;
  for (int iter = 0;; ++iter) {
    int mt, nt;
    if (!tile256(iter, 4, mt, nt)) break;
    const int m0 = mt * 256, n0 = nt * 256;
    f32x4 acc[2][2][4][2];
    acc256_zero(acc);
    gemm256(p.ya, 512, WA, 512, 512, m0, n0, (bfu*)smem, acc);
    EPI256({
      float ma[8], o[8];
      unpack8(*(const uint4*)(p.proj + (size_t)(m0 + row) * PW + OFF_MA + n0 + c0), ma);
      _Pragma("unroll") for (int e = 0; e < 8; ++e) o[e] = sigmoidf_(ma[e]) * v[e];
      *(uint4*)(p.merged + (size_t)(m0 + row) * D + n0 + c0) = pack8(o);
    })
    acc256_zero(acc);
    gemm256(p.yb, 512, WB, 512, 512, m0, n0, (bfu*)smem, acc);
    EPI256({
      float mb[8], o[8], pr[8];
      unpack8(*(const uint4*)(p.proj + (size_t)(m0 + row) * PW + OFF_MB + n0 + c0), mb);
      uint4* mp = (uint4*)(p.merged + (size_t)(m0 + row) * D + n0 + c0);
      unpack8(*mp, pr);
      _Pragma("unroll") for (int e = 0; e < 8; ++e) o[e] = pr[e] + sigmoidf_(mb[e]) * v[e];
      *mp = pack8(o);
    })
  }
}

DI void phase_out(const Params& p, int l, char* smem) {
  const bfu* W = p.w_oT + (size_t)l * 1024 * 1024;
  for (int iter = 0;; ++iter) {
    int mt, nt;
    if (!tile256(iter, 4, mt, nt)) break;
    const int m0 = mt * 256, n0 = nt * 256;
    f32x4 acc[2][2][4][2];
    acc256_zero(acc);
    gemm256(p.merged, D, W, 1024, 1024, m0, n0, (bfu*)smem, acc);
    const float* gate = p.mod + (size_t)(l * 5 + cond_of_tok(m0)) * 3072 + 2048;
    EPI256({
      float* xp = p.out + (size_t)(m0 + row) * D + n0 + c0;
      const float* gp = gate + n0 + c0;
      float4 x0 = *(const float4*)xp, x1 = *(const float4*)(xp + 4);
      const float4 g0 = *(const float4*)gp, g1 = *(const float4*)(gp + 4);
      x0.x += g0.x * v[0]; x0.y += g0.y * v[1]; x0.z += g0.z * v[2]; x0.w += g0.w * v[3];
      x1.x += g1.x * v[4]; x1.y += g1.y * v[5]; x1.z += g1.z * v[6]; x1.w += g1.w * v[7];
      *(float4*)xp = x0; *(float4*)(xp + 4) = x1;
    })
  }
}

DI void phase_final(const Params& p) {
  const int tid = tid_(), lane = tid & 63, w = tid >> 6;
  for (int it = VBID; it < NTOK / 4; it += NVB) {
    const int tok = it * 4 + w;
    float* xs = p.out + (size_t)tok * D;
    float4 v[4];
#pragma unroll
    for (int i = 0; i < 4; ++i) v[i] = *(const float4*)(xs + lane * 4 + 256 * i);
    float ss = 0.f;
#pragma unroll
    for (int i = 0; i < 4; ++i) ss += v[i].x * v[i].x + v[i].y * v[i].y + v[i].z * v[i].z + v[i].w * v[i].w;
    ss = wave_sum(ss);
    const float rstd = rsqrtf(ss * (1.f / 1024.f) + EPS);
#pragma unroll
    for (int i = 0; i < 4; ++i) {
      float4 g = *(const float4*)(p.final_g + lane * 4 + 256 * i);
      float4 o;
      o.x = v[i].x * rstd * g.x; o.y = v[i].y * rstd * g.y; o.z = v[i].z * rstd * g.z; o.w = v[i].w * rstd * g.w;
      *(float4*)(xs + lane * 4 + 256 * i) = o;
    }
  }
}

#define XB_TMO      128
#define XB_XCNT(j)  (256  + 64 * (j))
#define XB_XSUB(j)  (1280 + 64 * (j))
#define XB_XGEN(j)  (2304 + 64 * (j))
#define XB_TOP      3328
#define XB_TOPGEN   3392
#define XCD_BAR_WORDS 3456
#define XB_SPIN_CAP (1u << 18)
#define LAS __attribute__((address_space(3)))
DI unsigned xb_ld(unsigned* p) { return __hip_atomic_load(p, __ATOMIC_RELAXED, __HIP_MEMORY_SCOPE_AGENT); }
DI unsigned xb_add(unsigned* p, unsigned v) { return __hip_atomic_fetch_add(p, v, __ATOMIC_RELAXED, __HIP_MEMORY_SCOPE_AGENT); }
DI unsigned xb_xcc_id() { return (unsigned)__builtin_amdgcn_s_getreg((3 << 11) | 20) & 0xFu; }
#define XB_SPIN(cond, bar) do { unsigned _sp = 0; while (cond) { __builtin_amdgcn_s_sleep(1); \
    if ((++_sp & 255u) == 0u) { if (xb_ld(&(bar)[XB_TMO])) break; if (_sp > XB_SPIN_CAP) { atomicAdd(&(bar)[XB_TMO], 1u); break; } } } } while (0)
struct XcdBarrier { unsigned* bar; unsigned x; volatile LAS unsigned* st; };
DI XcdBarrier xcd_barrier_post(unsigned* bar, volatile LAS unsigned* st) {
  XcdBarrier b; b.bar = bar; b.x = xb_xcc_id(); b.st = st;
  if (threadIdx.x == 0) (void)xb_add(&bar[XB_XCNT(b.x)], 1u);
  return b;
}
DI void xcd_barrier_complete(unsigned* bar, unsigned x, unsigned& nloc, unsigned& nx) {
  const unsigned G = gridDim.x * gridDim.y * gridDim.z;
  unsigned sum, cnt, mine, sp = 0u;
  for (;;) {
    sum = 0u; cnt = 0u; mine = 0u;
#pragma unroll
    for (unsigned j = 0; j < 16; ++j) { const unsigned c = xb_ld(&bar[XB_XCNT(j)]); sum += c; cnt += (c > 0u) ? 1u : 0u; mine = (j == x) ? c : mine; }
    if (sum == G) break;
    __builtin_amdgcn_s_sleep(1);
    if ((++sp & 255u) == 0u) { if (xb_ld(&bar[XB_TMO])) break; if (sp > XB_SPIN_CAP) { atomicAdd(&bar[XB_TMO], 1u); break; } }
  }
  nloc = mine > 0u ? mine : 1u; nx = cnt > 0u ? cnt : 1u;
}
DI void xcd_barrier(const XcdBarrier& b) {
  asm volatile("s_waitcnt vmcnt(0)" ::: "memory");
  __syncthreads();
  if (threadIdx.x == 0) {
    unsigned* bar = b.bar;
    __builtin_amdgcn_s_waitcnt(0);
    unsigned nloc = b.st[0], nx = b.st[1];
    if (nloc == 0u) { xcd_barrier_complete(bar, b.x, nloc, nx); b.st[0] = nloc; b.st[1] = nx; }
    const unsigned old = xb_add(&bar[XB_XSUB(b.x)], 1u);
    const unsigned gen = old / nloc;
    if (old + 1u == (gen + 1u) * nloc) {
      __builtin_amdgcn_fence(__ATOMIC_RELEASE, "agent");
      asm volatile("s_waitcnt vmcnt(0)" ::: "memory");
      const unsigned og = xb_add(&bar[XB_TOP], 1u);
      const unsigned tg = og / nx;
      if (og + 1u == (tg + 1u) * nx) xb_add(&bar[XB_TOPGEN], 1u);
      else XB_SPIN(xb_ld(&bar[XB_TOPGEN]) == tg, bar);
      __builtin_amdgcn_fence(__ATOMIC_ACQUIRE, "agent");
      xb_add(&bar[XB_XGEN(b.x)], 1u);
      asm volatile("s_waitcnt vmcnt(0)" ::: "memory");
    } else {
      XB_SPIN(xb_ld(&bar[XB_XGEN(b.x)]) == gen, bar);
      __builtin_amdgcn_fence(__ATOMIC_ACQUIRE, "agent");
      asm volatile("s_waitcnt vmcnt(0)" ::: "memory");
    }
  }
  __syncthreads();
}

#ifndef REP_SYNC
#define REP_SYNC 0
#endif
__global__ void __launch_bounds__(512, 2) k_mega(Params p) {
  extern __shared__ __attribute__((aligned(16))) char smem_all[];
  cg::grid_group grid = cg::this_grid();
  char* smem = smem_all;
#define smh (smem_all + VHALF * 65536)
  volatile LAS unsigned* xst = (volatile LAS unsigned*)(smem_all + 131072);
  if (threadIdx.x < 4) xst[threadIdx.x] = 0u;
  __syncthreads();
  XcdBarrier xb = xcd_barrier_post(p.bar, xst);
#define GSYNC() xcd_barrier(xb)
  phase_prep(p, smh);
  phase_s5_gen(p, 0, smh);
  grid.sync();
  for (int l = 0; l < 2; ++l) {
    phase_h(p, l);
    GSYNC();
    phase_gemm_in(p, l, smem);
    GSYNC();
    phase_s5_e(p, smh);
    phase_gla_pass1(p, l, smh);
    GSYNC();
    phase_s5_scan(p, l);
    phase_gla_main(p, l, smh);
    GSYNC();
    phase_s5_y(p, l, smh);
    GSYNC();
    phase_glu(p, l, smh);
    if (l == 0) phase_s5_gen(p, 1, smh);
    GSYNC();
    phase_merge(p, l, smem);
    GSYNC();
    phase_out(p, l, smem);
    GSYNC();
    for (int rep = 0; rep < REP_SYNC; ++rep) GSYNC();
  }
  phase_final(p);
}

extern "C" void kernel_launch(void* const* d_in, const int* in_sizes, int n_in, void* d_out, int out_size,
                              void* d_ws, size_t ws_size, hipStream_t stream) {
  Params p{};
  const float* const* in = (const float* const*)d_in;
  p.x_prompt = in[0]; p.x_sample = in[1]; p.c = in[2]; p.st_re = in[3]; p.st_im = in[4]; p.st_gla = in[5];
  p.c_ctx = in[6]; p.norm_g = in[7]; p.w_mod = in[8]; p.b_mod = in[9]; p.w_in = in[10]; p.wg_up = in[11];
  p.bg = in[12]; p.gla_norm_g = in[13]; p.lam_re = in[14]; p.lam_im = in[15]; p.log_dt = in[16];
  p.b_re = in[17]; p.b_im = in[18]; p.c_re = in[19]; p.c_im = in[20]; p.s5_d = in[21]; p.w_glu = in[22];
  p.b_glu = in[23]; p.w_pa = in[24]; p.w_pb = in[25]; p.w_o = in[26]; p.final_g = in[27];
  p.out = (float*)d_out;
  char* ws = (char*)d_ws;
  size_t off = 0;
  auto take = [&](size_t bytes) { char* r = ws + off; off += (bytes + 255) & ~(size_t)255; return r; };
  p.w_inT = (bfu*)take((size_t)2 * DINP * LDH * 2);
  p.w_gluT = (bfu*)take((size_t)2 * 512 * 512 * 2);
  p.w_paT = (bfu*)take((size_t)2 * 1024 * 512 * 2);
  p.w_pbT = (bfu*)take((size_t)2 * 1024 * 512 * 2);
  p.w_oT = (bfu*)take((size_t)2 * 1024 * 1024 * 2);
  p.mod = (float*)take((size_t)2 * 5 * 3072 * 4);
  p.pos_r = (float*)take((size_t)32 * 512 * 4);
  p.pos_c = (float*)take((size_t)64 * 512 * 4);
  p.h = (bfu*)take((size_t)NTOK * LDH * 2);
  p.proj = (bfu*)take((size_t)NTOK * PW * 2);
  p.ys5 = (bfu*)take((size_t)NTOK * 512 * 2);
  p.ya = (bfu*)take((size_t)NTOK * 512 * 2);
  p.yb = (bfu*)take((size_t)NTOK * 512 * 2);
  p.merged = (bfu*)take((size_t)NTOK * D * 2);
  p.tmp_s5 = nullptr;
  p.ebuf = (float*)p.merged;
  p.carry = (bfu*)((char*)p.merged + (size_t)32 * NCHUNK * 256 * 4);
  p.ug = (bfu*)take((size_t)32 * NTOK * 16 * 2);
  p.opMG = (bfu*)take((size_t)32 * 512 * 768 * 2);
  p.opE = (bfu*)take((size_t)32 * 256 * 512 * 2);
  p.gla_sloc = (float*)p.ys5;
  p.gla_aseg = (float*)((char*)p.ys5 + (size_t)256 * 8192 * 4);
  if (off > ws_size) fprintf(stderr, "workspace too small: %zu > %zu\n", off, ws_size);
  p.bar = (unsigned*)take((size_t)XCD_BAR_WORDS * 4);
  p.tmp_gla = (float*)p.h;
  constexpr size_t kLds = 131072 + 16;
  static int grid_blocks = 0;
  if (!grid_blocks) {
    int dev = 0, cus = 0, per_cu = 0;
    hipGetDevice(&dev);
    hipDeviceGetAttribute(&cus, hipDeviceAttributeMultiprocessorCount, dev);
    hipFuncSetAttribute((const void*)k_mega, hipFuncAttributeMaxDynamicSharedMemorySize, (int)kLds);
    hipOccupancyMaxActiveBlocksPerMultiprocessor(&per_cu, k_mega, 512, kLds);
    if (per_cu > 1) per_cu = 1;
    grid_blocks = cus * per_cu;
    if (grid_blocks % 8 != 0 || grid_blocks <= 0) fprintf(stderr, "unexpected grid %d\n", grid_blocks);
  }
  hipMemsetAsync(p.bar, 0, (size_t)XCD_BAR_WORDS * 4, stream);
  void* args[] = {&p};
  hipError_t e = hipLaunchCooperativeKernel((void*)k_mega, dim3(grid_blocks), dim3(512), args, kLds, stream);
  if (e != hipSuccess) fprintf(stderr, "cooperative launch failed: %s (grid %d)\n", hipGetErrorString(e), grid_blocks);
}
```

```cpp
#include <hip/hip_runtime.h>
#include <hip/hip_cooperative_groups.h>
#include <stdint.h>
#include <math.h>
#include <stdio.h>
namespace cg = cooperative_groups;

#ifndef REP_PREP
#define REP_PREP 0
#endif
#ifndef REP_GIN
#define REP_GIN 0
#endif
#ifndef REP_X1
#define REP_X1 0
#endif
#ifndef REP_X2
#define REP_X2 0
#endif
#ifndef REP_Y
#define REP_Y 0
#endif
#ifndef REP_MERGE
#define REP_MERGE 0
#endif
#ifndef REP_SYNC
#define REP_SYNC 0
#endif
#ifndef ONE_LAUNCH
#define ONE_LAUNCH 1
#endif

typedef unsigned short bfu;
typedef __attribute__((ext_vector_type(8))) short bf16x8;
typedef __attribute__((ext_vector_type(16))) float f32x16;
typedef __attribute__((ext_vector_type(2))) __bf16 bf2_t;
typedef __attribute__((ext_vector_type(2))) float f2_t;

#define DI __device__ __forceinline__

constexpr int D = 1024;
constexpr int NTOK = 12288;
constexpr int NPROMPT = 4096;
constexpr int DIN = 4624;
constexpr int DINP = 4864;
constexpr int LDH = 1088;
constexpr int PW = 4112;
constexpr int OFF_GA = 0, OFF_Q = 512, OFF_K = 768, OFF_V = 1024, OFF_GB = 1536, OFF_GL = 2048,
              OFF_MA = 2064, OFF_MB = 3088;
constexpr int NCHUNK = NTOK / 32;
constexpr size_t OUT_RE = (size_t)NTOK * D;
constexpr size_t OUT_IM = OUT_RE + 131072;
constexpr size_t OUT_GLA = OUT_IM + 131072;
constexpr float EPS = 1e-6f;

struct Params {
  const float *x_prompt, *x_sample, *c, *st_re, *st_im, *st_gla, *c_ctx, *norm_g, *w_mod, *b_mod, *w_in,
      *wg_up, *bg, *gla_norm_g, *lam_re, *lam_im, *log_dt, *b_re, *b_im, *c_re, *c_im, *s5_d, *w_glu,
      *b_glu, *w_pa, *w_pb, *w_o, *final_g;
  float* out;
  bfu *w_inT, *w_gluT, *w_paT, *w_pbT, *w_oT;
  float *mod, *pos_r, *pos_c, *tmp_s5, *tmp_gla;
  bfu *h, *proj, *ys5, *ya, *yb, *merged;
  bfu *ug, *opMG, *opE, *carry;
  float *ebuf, *gla_sloc, *gla_aseg;
  unsigned* bar;
};

DI int tid_() { int t = threadIdx.x & 255; asm volatile("" : "+v"(t)); return t; }
#define VHALF ((int)__builtin_amdgcn_readfirstlane((int)(threadIdx.x >> 8)))
#define VBID ((int)(blockIdx.x * 2 + VHALF))
#define NVB ((int)(gridDim.x * 2))
#define VXCD ((int)(blockIdx.x & 7))
#define VJ ((int)((blockIdx.x >> 3) * 2 + VHALF))
#define VNLOC ((int)((gridDim.x >> 3) * 2))
DI float bf2f(bfu v) { return __uint_as_float(((unsigned)v) << 16); }
DI bfu f2bf(float x) { __bf16 b = (__bf16)x; return __builtin_bit_cast(unsigned short, b); }
DI unsigned pack2(float lo, float hi) {
  f2_t v = {lo, hi};
  bf2_t w = __builtin_convertvector(v, bf2_t);
  return __builtin_bit_cast(unsigned, w);
}
DI float sigmoidf_(float x) { return 1.f / (1.f + __expf(-x)); }
DI float siluf_(float x) { return x / (1.f + __expf(-x)); }
DI float geluf_(float x) {
  float u = 0.7978845608028654f * (x + 0.044715f * x * x * x);
  float t = 1.f - 2.f / (__expf(2.f * u) + 1.f);
  return 0.5f * x * (1.f + t);
}
DI float wave_sum(float v) {
#pragma unroll
  for (int o = 32; o >= 1; o >>= 1) v += __shfl_xor(v, o);
  return v;
}
DI int cond_of_tok(int tok) { return tok < NPROMPT ? 0 : 1 + ((tok - NPROMPT) >> 11); }

DI void transpose_tile(const float* __restrict__ src, int K, int N, bfu* __restrict__ dst, int kt, int nt,
                       float* sm, int ldd = 0) {
  if (ldd == 0) ldd = K;
  const int tid = tid_(), c = tid & 63, r4 = tid >> 6;
  const int k0 = kt * 64, n0 = nt * 64;
#pragma unroll 4
  for (int i = 0; i < 16; ++i) {
    int k = i * 4 + r4, n = n0 + c;
    sm[k * 65 + c] = (n < N) ? src[(size_t)(k0 + k) * N + n] : 0.f;
  }
  __syncthreads();
#pragma unroll 4
  for (int i = 0; i < 16; ++i) {
    int n = i * 4 + r4;
    dst[(size_t)(n0 + n) * ldd + k0 + c] = f2bf(sm[c * 65 + n]);
  }
  __syncthreads();
}

DI void phase_prep(const Params& p, char* smem) {
  float* sm = (float*)smem;
  const int tid = tid_();
  for (int it = VBID; it < 96; it += NVB) {
    const int l = it / 48, jb = it % 48;
    float* ssil = sm;
    float* sred = sm + 5 * 1024;
    for (int idx = tid; idx < 5120; idx += 256) {
      int ci = idx >> 10, k = idx & 1023;
      float cv = (ci == 0) ? p.c_ctx[k] : p.c[(ci - 1) * 1024 + k];
      ssil[idx] = cv / (1.f + expf(-cv));
    }
    __syncthreads();
    const int jj = tid & 63, kq = tid >> 6;
    const int j = jb * 64 + jj;
    float acc[5] = {0.f, 0.f, 0.f, 0.f, 0.f};
    const float* wp = p.w_mod + ((size_t)l * 1024 + kq * 256) * 3072 + j;
#pragma unroll 8
    for (int k = 0; k < 256; ++k) {
      float w = wp[(size_t)k * 3072];
#pragma unroll
      for (int ci = 0; ci < 5; ++ci) acc[ci] += ssil[ci * 1024 + kq * 256 + k] * w;
    }
#pragma unroll
    for (int ci = 0; ci < 5; ++ci) sred[(kq * 5 + ci) * 64 + jj] = acc[ci];
    __syncthreads();
    for (int idx = tid; idx < 320; idx += 256) {
      int ci = idx >> 6, j2 = idx & 63;
      float s = p.b_mod[l * 3072 + jb * 64 + j2];
#pragma unroll
      for (int q = 0; q < 4; ++q) s += sred[(q * 5 + ci) * 64 + j2];
      p.mod[(size_t)(l * 5 + ci) * 3072 + jb * 64 + j2] = s;
    }
    __syncthreads();
  }
  for (int idx = VBID * 256 + tid; idx < 96 * 512; idx += NVB * 256) {
    int r = idx >> 9, i = idx & 511;
    int pos = r < 32 ? r : r - 32;
    int q = i & 255;
    double f = exp(-log(10000.0) * (double)q / 256.0);
    double ang = (double)pos * f;
    float v = (float)((i < 256) ? sin(ang) : cos(ang));
    if (r < 32) p.pos_r[r * 512 + i] = v; else p.pos_c[(r - 32) * 512 + i] = v;
  }
  for (int it = VBID; it < 3584; it += NVB) {
    int l = it / 1792, r = it % 1792;
    if (r < 1216) {
      transpose_tile(p.w_in + (size_t)l * 1024 * DIN, 1024, DIN, p.w_inT + (size_t)l * DINP * LDH, r % 16, r / 16, sm, LDH);
    } else if (r < 1280) {
      r -= 1216;
      transpose_tile(p.w_glu + (size_t)l * 512 * 512, 512, 512, p.w_gluT + (size_t)l * 512 * 512, r % 8, r / 8, sm);
    } else if (r < 1408) {
      r -= 1280;
      transpose_tile(p.w_pa + (size_t)l * 512 * 1024, 512, 1024, p.w_paT + (size_t)l * 1024 * 512, r % 8, r / 8, sm);
    } else if (r < 1536) {
      r -= 1408;
      transpose_tile(p.w_pb + (size_t)l * 512 * 1024, 512, 1024, p.w_pbT + (size_t)l * 1024 * 512, r % 8, r / 8, sm);
    } else {
      r -= 1536;
      transpose_tile(p.w_o + (size_t)l * 1024 * 1024, 1024, 1024, p.w_oT + (size_t)l * 1024 * 1024, r % 16, r / 16, sm);
    }
  }
}

DI void phase_h(const Params& p, int l) {
  const int tid = tid_(), lane = tid & 63, w = tid >> 6;
  for (int it = VBID; it < NTOK / 4; it += NVB) {
    const int tok = it * 4 + w;
    float4 v[4];
    float* xs = p.out + (size_t)tok * D;
    if (l == 0) {
      const float* src = tok < NPROMPT ? p.x_prompt + (size_t)tok * D : p.x_sample + (size_t)(tok - NPROMPT) * D;
#pragma unroll
      for (int i = 0; i < 4; ++i) v[i] = *(const float4*)(src + lane * 4 + 256 * i);
      if (tok >= NPROMPT) {
        int t = (tok - NPROMPT) & 2047, row = t >> 6, col = t & 63;
#pragma unroll
        for (int i = 0; i < 4; ++i) {
          int d = lane * 4 + 256 * i;
          const float* pe = d < 512 ? p.pos_r + row * 512 + d : p.pos_c + col * 512 + (d - 512);
          float4 e = *(const float4*)pe;
          v[i].x += e.x; v[i].y += e.y; v[i].z += e.z; v[i].w += e.w;
        }
      }
#pragma unroll
      for (int i = 0; i < 4; ++i) *(float4*)(xs + lane * 4 + 256 * i) = v[i];
    } else {
#pragma unroll
      for (int i = 0; i < 4; ++i) v[i] = *(const float4*)(xs + lane * 4 + 256 * i);
    }
    float ss = 0.f;
#pragma unroll
    for (int i = 0; i < 4; ++i) ss += v[i].x * v[i].x + v[i].y * v[i].y + v[i].z * v[i].z + v[i].w * v[i].w;
    ss = wave_sum(ss);
    const float rstd = rsqrtf(ss * (1.f / 1024.f) + EPS);
    const float* md = p.mod + (size_t)(l * 5 + cond_of_tok(tok)) * 3072;
    const float* ng = p.norm_g + l * 1024;
#pragma unroll
    for (int i = 0; i < 4; ++i) {
      int d = lane * 4 + 256 * i;
      float4 g = *(const float4*)(ng + d);
      float4 sh = *(const float4*)(md + d);
      float4 sc = *(const float4*)(md + 1024 + d);
      float a0 = v[i].x * rstd * g.x * (1.f + sc.x) + sh.x;
      float a1 = v[i].y * rstd * g.y * (1.f + sc.y) + sh.y;
      float a2 = v[i].z * rstd * g.z * (1.f + sc.z) + sh.z;
      float a3 = v[i].w * rstd * g.w * (1.f + sc.w) + sh.w;
      uint2 o; o.x = pack2(a0, a1); o.y = pack2(a2, a3);
      *(uint2*)(p.h + (size_t)tok * LDH + d) = o;
    }
  }
}

DI void gemm_core(const bfu* __restrict__ A, int lda, const bfu* __restrict__ B, int ldb, int K, char* smem,
                  f32x16 (&acc)[2][2]) {
  const int tid = tid_(), lane = tid & 63, w = tid >> 6, wm = w >> 1, wn = w & 1;
  const int c8 = tid & 7, r0 = tid >> 3;
  const bfu* ga = A + (size_t)r0 * lda + c8 * 8;
  const bfu* gb = B + (size_t)r0 * ldb + c8 * 8;
  const int st_off = r0 * 128 + ((c8 ^ ((r0 >> 1) & 7)) * 16);
  const int fr = lane & 31, hh = lane >> 5, fsw = (fr >> 1) & 7;
  const int a_base = (wm * 64 + fr) * 128;
  const int b_base = 16384 + (wn * 64 + fr) * 128;
  uint4 ra0, ra1, ra2, ra3, rb0, rb1, rb2, rb3, qa0, qa1, qa2, qa3, qb0, qb1, qb2, qb3;
  const int KT = K >> 6;
#define GEMM_LOADT(RA, RB, tile)                                                           \
  {                                                                                        \
    const int t_ = (tile) < KT ? (tile) : KT - 1;                                          \
    const bfu* ga_ = ga + t_ * 64; const bfu* gb_ = gb + t_ * 64;                          \
    RA##0 = *(const uint4*)(ga_);                        RB##0 = *(const uint4*)(gb_);                        \
    RA##1 = *(const uint4*)(ga_ + (size_t)32 * lda);     RB##1 = *(const uint4*)(gb_ + (size_t)32 * ldb);     \
    RA##2 = *(const uint4*)(ga_ + (size_t)64 * lda);     RB##2 = *(const uint4*)(gb_ + (size_t)64 * ldb);     \
    RA##3 = *(const uint4*)(ga_ + (size_t)96 * lda);     RB##3 = *(const uint4*)(gb_ + (size_t)96 * ldb);     \
  }
#define GEMM_STORET(buf, RA, RB)                                                           \
  {                                                                                        \
    *(uint4*)((buf) + st_off) = RA##0;          *(uint4*)((buf) + 16384 + st_off) = RB##0;          \
    *(uint4*)((buf) + st_off + 4096) = RA##1;   *(uint4*)((buf) + 16384 + st_off + 4096) = RB##1;   \
    *(uint4*)((buf) + st_off + 8192) = RA##2;   *(uint4*)((buf) + 16384 + st_off + 8192) = RB##2;   \
    *(uint4*)((buf) + st_off + 12288) = RA##3;  *(uint4*)((buf) + 16384 + st_off + 12288) = RB##3;  \
  }
#define GEMM_COMPUTE(cur)                                                                  \
  _Pragma("unroll") for (int s = 0; s < 4; ++s) {                                          \
    const int co = ((2 * s + hh) ^ fsw) * 16;                                              \
    bf16x8 a0 = *(const bf16x8*)((cur) + a_base + co);                                     \
    bf16x8 a1 = *(const bf16x8*)((cur) + a_base + 4096 + co);                              \
    bf16x8 b0 = *(const bf16x8*)((cur) + b_base + co);                                     \
    bf16x8 b1 = *(const bf16x8*)((cur) + b_base + 4096 + co);                              \
    acc[0][0] = __builtin_amdgcn_mfma_f32_32x32x16_bf16(a0, b0, acc[0][0], 0, 0, 0);       \
    acc[0][1] = __builtin_amdgcn_mfma_f32_32x32x16_bf16(a0, b1, acc[0][1], 0, 0, 0);       \
    acc[1][0] = __builtin_amdgcn_mfma_f32_32x32x16_bf16(a1, b0, acc[1][0], 0, 0, 0);       \
    acc[1][1] = __builtin_amdgcn_mfma_f32_32x32x16_bf16(a1, b1, acc[1][1], 0, 0, 0);       \
  }
  GEMM_LOADT(ra, rb, 0)
  GEMM_LOADT(qa, qb, 1)
  GEMM_STORET(smem, ra, rb)
  __syncthreads();
#pragma unroll 1
  for (int kt = 0; kt < KT; kt += 2) {
    GEMM_LOADT(ra, rb, kt + 2)
    __builtin_amdgcn_sched_barrier(0);
    GEMM_COMPUTE(smem)
    __builtin_amdgcn_sched_barrier(0);
    GEMM_STORET(smem + 32768, qa, qb)
    __syncthreads();
    GEMM_LOADT(qa, qb, kt + 3)
    __builtin_amdgcn_sched_barrier(0);
    GEMM_COMPUTE(smem + 32768)
    __builtin_amdgcn_sched_barrier(0);
    GEMM_STORET(smem, ra, rb)
    __syncthreads();
  }
}

DI void acc_zero(f32x16 (&acc)[2][2]) {
#pragma unroll
  for (int i = 0; i < 2; ++i)
#pragma unroll
    for (int j = 0; j < 2; ++j)
#pragma unroll
      for (int r = 0; r < 16; ++r) acc[i][j][r] = 0.f;
}

DI void acc_to_lds(const f32x16 (&acc)[2][2], char* smem) {
  float* sf = (float*)smem;
  const int tid = tid_(), lane = tid & 63, w = tid >> 6;
  const int rb = (w >> 1) * 64 + 4 * (lane >> 5), cb = (w & 1) * 64 + (lane & 31);
#pragma unroll
  for (int i = 0; i < 2; ++i)
#pragma unroll
    for (int j = 0; j < 2; ++j)
#pragma unroll
      for (int r = 0; r < 16; ++r)
        sf[(rb + i * 32 + (r & 3) + 8 * (r >> 2)) * 128 + cb + j * 32] = acc[i][j][r];
}
DI void unpack8(const uint4 v, float (&f)[8]) {
  f[0] = __uint_as_float(v.x << 16); f[1] = __uint_as_float(v.x & 0xffff0000u);
  f[2] = __uint_as_float(v.y << 16); f[3] = __uint_as_float(v.y & 0xffff0000u);
  f[4] = __uint_as_float(v.z << 16); f[5] = __uint_as_float(v.z & 0xffff0000u);
  f[6] = __uint_as_float(v.w << 16); f[7] = __uint_as_float(v.w & 0xffff0000u);
}
DI uint4 pack8(const float (&f)[8]) {
  uint4 o;
  o.x = pack2(f[0], f[1]); o.y = pack2(f[2], f[3]); o.z = pack2(f[4], f[5]); o.w = pack2(f[6], f[7]);
  return o;
}
#define EPI_LDS(...)                                                             \
  {                                                                              \
    acc_to_lds(acc, smem);                                                       \
    __syncthreads();                                                             \
    _Pragma("unroll 1") for (int it_ = 0; it_ < 8; ++it_) {                      \
      const int row = (tid_() >> 4) + 16 * it_;                             \
      const int c0 = (tid_() & 15) * 8;                                     \
      float v[8];                                                                \
      {                                                                          \
        const float4 t0 = *(const float4*)(smem + (row * 128 + c0) * 4);         \
        const float4 t1 = *(const float4*)(smem + (row * 128 + c0 + 4) * 4);     \
        v[0] = t0.x; v[1] = t0.y; v[2] = t0.z; v[3] = t0.w;                      \
        v[4] = t1.x; v[5] = t1.y; v[6] = t1.z; v[7] = t1.w;                      \
      }                                                                          \
      __VA_ARGS__                                                                \
    }                                                                            \
    __syncthreads();                                                             \
  }

typedef __attribute__((ext_vector_type(4))) float f32x4;
constexpr int G_BK = 64, G_HALF = 128, G_HT = G_HALF * G_BK;
DI int g_lds_byte(int r, int c) {
  int st = (r >> 4) * 2 + (c >> 5), rr = r & 15, cc = c & 31, ob = rr * 64 + cc * 2;
  return st * 1024 + (ob ^ (((ob >> 9) & 1) << 5));
}
DI void g_stage_rc(int b, int& R, int& C) {
  int st = b / 1024, sb = b % 1024, swz = sb ^ (((sb >> 9) & 1) << 5);
  R = (st >> 1) * 16 + swz / 64; C = (st & 1) * 32 + (swz % 64) / 2;
}
DI const char* g_uniform(const char* ptr) {
  unsigned long long u = (unsigned long long)ptr;
  unsigned lo = __builtin_amdgcn_readfirstlane((unsigned)u), hi = __builtin_amdgcn_readfirstlane((unsigned)(u >> 32));
  return (const char*)(((unsigned long long)hi << 32) | lo);
}
DI void gemm256(const bfu* __restrict__ A, int lda, const bfu* __restrict__ Bt, int ldb, int K, int brow, int bcol,
                bfu* shm, f32x4 (&acc)[2][2][4][2]) {
#define G_SA(b, h) (shm + ((b) * 2 + (h)) * G_HT)
#define G_SB(b, h) (shm + (4 + (b) * 2 + (h)) * G_HT)
#define G_STAGE(P, BASE, LD, br, kt)                                                                   \
  do {                                                                                                 \
    const char* _u = g_uniform((const char*)((BASE) + ((long)(br) * (LD) + (long)(kt) * G_BK)));       \
    __builtin_amdgcn_global_load_lds((const unsigned*)(_u + soff_b),                                   \
        (__attribute__((address_space(3))) unsigned*)((char*)(P) + ldst), 16, 0, 0);                   \
    __builtin_amdgcn_global_load_lds((const unsigned*)(_u + 128 * (long)(LD) + soff_b),                \
        (__attribute__((address_space(3))) unsigned*)((char*)(P) + ldst + 8192), 16, 0, 0);            \
  } while (0)
#define G_LDA(dst, b, h) for (int m = 0; m < 4; ++m) for (int k = 0; k < 2; ++k) \
    dst[m][k] = *reinterpret_cast<const bf16x8*>((char*)G_SA(b, h) + a_rd + m * 2048 + k * 1024)
#define G_LDB(dst, b, h) for (int n = 0; n < 2; ++n) for (int k = 0; k < 2; ++k) \
    dst[n][k] = *reinterpret_cast<const bf16x8*>((char*)G_SB(b, h) + b_rd + n * 2048 + k * 1024)
#define G_MMA(ai, bj, At, Bt_)                                                                         \
  do {                                                                                                 \
    __builtin_amdgcn_s_setprio(1);                                                                     \
    for (int m = 0; m < 4; ++m) for (int n = 0; n < 2; ++n) for (int k = 0; k < 2; ++k)                \
      acc[ai][bj][m][n] = __builtin_amdgcn_mfma_f32_16x16x32_bf16(At[m][k], Bt_[n][k], acc[ai][bj][m][n], 0, 0, 0); \
    __builtin_amdgcn_s_setprio(0);                                                                     \
  } while (0)
#define G_WAIT_V(n) asm volatile("s_waitcnt vmcnt(" #n ")" ::: "memory")
#define G_WAIT_L(n) asm volatile("s_waitcnt lgkmcnt(" #n ")" ::: "memory")
#define G_BAR __builtin_amdgcn_s_barrier()
#define G_SCHED __builtin_amdgcn_sched_barrier(0)
  int t512 = threadIdx.x; asm volatile("" : "+v"(t512));
  const int wid = __builtin_amdgcn_readfirstlane(t512 >> 6), lane = t512 & 63, wr = wid >> 2, wc = wid & 3, fr = lane & 15, fq = lane >> 4;
  const int ldst = t512 * 16;
  unsigned soff_b;
  {
    int R0, C0;
    g_stage_rc(ldst, R0, C0);
    soff_b = (unsigned)(R0 * lda + C0) * 2u;
  }
  const int lane_off = (fr * 64 + fq * 16) ^ ((fr >> 3) << 5);
  const int a_rd = wr * 8192 + lane_off, b_rd = wc * 4096 + lane_off;
  bf16x8 At[4][2], B0[2][2], B1[2][2];
  const int nt = K / G_BK;
  G_STAGE(G_SB(0, 0), Bt, ldb, bcol, 0); G_STAGE(G_SA(0, 0), A, lda, brow, 0);
  G_STAGE(G_SB(0, 1), Bt, ldb, bcol + G_HALF, 0); G_STAGE(G_SA(0, 1), A, lda, brow + G_HALF, 0);
  if (wr == 1) G_BAR;
  G_WAIT_V(4); G_BAR;
  G_STAGE(G_SB(1, 0), Bt, ldb, bcol, 1); G_STAGE(G_SA(1, 0), A, lda, brow, 1); G_STAGE(G_SB(1, 1), Bt, ldb, bcol + G_HALF, 1);
  G_WAIT_V(6); G_BAR;
#pragma unroll 1
  for (int t = 0; t < nt - 2; t += 2) {
    G_LDB(B0, 0, 0); G_SCHED; G_LDA(At, 0, 0); G_STAGE(G_SA(1, 1), A, lda, brow + G_HALF, t + 1);
    G_WAIT_L(8); G_BAR; G_WAIT_L(0); G_MMA(0, 0, At, B0); G_BAR; G_SCHED;
    G_LDB(B1, 0, 1); G_STAGE(G_SB(0, 0), Bt, ldb, bcol, t + 2);
    G_BAR; G_WAIT_L(0); G_MMA(0, 1, At, B1); G_BAR;
    G_LDA(At, 0, 1); G_STAGE(G_SA(0, 0), A, lda, brow, t + 2);
    G_BAR; G_WAIT_L(0); G_MMA(1, 0, At, B0); G_BAR; G_SCHED;
    G_STAGE(G_SB(0, 1), Bt, ldb, bcol + G_HALF, t + 2);
    G_WAIT_V(6); G_BAR; G_MMA(1, 1, At, B1); G_BAR;
    G_LDB(B0, 1, 0); G_SCHED; G_LDA(At, 1, 0); G_STAGE(G_SA(0, 1), A, lda, brow + G_HALF, t + 2);
    G_WAIT_L(8); G_BAR; G_WAIT_L(0); G_MMA(0, 0, At, B0); G_BAR; G_SCHED;
    G_LDB(B1, 1, 1); G_STAGE(G_SB(1, 0), Bt, ldb, bcol, t + 3);
    G_BAR; G_WAIT_L(0); G_MMA(0, 1, At, B1); G_BAR;
    G_LDA(At, 1, 1); G_STAGE(G_SA(1, 0), A, lda, brow, t + 3);
    G_BAR; G_WAIT_L(0); G_MMA(1, 0, At, B0); G_BAR; G_SCHED;
    G_STAGE(G_SB(1, 1), Bt, ldb, bcol + G_HALF, t + 3);
    G_WAIT_V(6); G_BAR; G_MMA(1, 1, At, B1); G_BAR;
  }
  { G_LDB(B0, 0, 0); G_LDA(At, 0, 0); G_STAGE(G_SA(1, 1), A, lda, brow + G_HALF, nt - 1);
    G_BAR; G_WAIT_L(0); G_MMA(0, 0, At, B0); G_BAR;
    G_LDB(B1, 0, 1); G_BAR; G_WAIT_L(0); G_MMA(0, 1, At, B1); G_BAR;
    G_LDA(At, 0, 1); G_WAIT_V(4); G_BAR; G_WAIT_L(0); G_MMA(1, 0, At, B0); G_MMA(1, 1, At, B1); G_BAR; }
  { G_LDB(B0, 1, 0); G_LDA(At, 1, 0); G_WAIT_V(2); G_BAR; G_WAIT_L(0); G_MMA(0, 0, At, B0); G_BAR;
    G_LDB(B1, 1, 1); G_WAIT_V(0); G_BAR; G_WAIT_L(0); G_MMA(0, 1, At, B1); G_BAR;
    G_LDA(At, 1, 1); G_BAR; G_WAIT_L(0); G_MMA(1, 0, At, B0); G_MMA(1, 1, At, B1); G_BAR; }
  if (wr == 0) G_BAR;
}
DI void acc256_zero(f32x4 (&acc)[2][2][4][2]) {
#pragma unroll
  for (int a = 0; a < 2; ++a)
#pragma unroll
    for (int b = 0; b < 2; ++b)
#pragma unroll
      for (int m = 0; m < 4; ++m)
#pragma unroll
        for (int n = 0; n < 2; ++n) acc[a][b][m][n] = (f32x4){0.f, 0.f, 0.f, 0.f};
}
#define EPI256(...)                                                                                   \
  {                                                                                                    \
    int t512_ = threadIdx.x; asm volatile("" : "+v"(t512_));     \
    const int wid_ = t512_ >> 6, lane_ = t512_ & 63, wr_ = wid_ >> 2, wc_ = wid_ & 3,                  \
              fr_ = lane_ & 15, fq_ = lane_ >> 4;                                                      \
    float* sf_ = (float*)smem;                                                                         \
    _Pragma("unroll") for (int ai_ = 0; ai_ < 2; ++ai_) {                                              \
      __syncthreads();                                                                                 \
      _Pragma("unroll") for (int bj_ = 0; bj_ < 2; ++bj_)                                              \
      _Pragma("unroll") for (int m_ = 0; m_ < 4; ++m_)                                                 \
      _Pragma("unroll") for (int n_ = 0; n_ < 2; ++n_)                                                 \
      _Pragma("unroll") for (int j_ = 0; j_ < 4; ++j_)                                                 \
        sf_[(wr_ * 64 + m_ * 16 + fq_ * 4 + j_) * 256 + ((bj_ * 128 + wc_ * 32 + n_ * 16 + fr_) ^ (fq_ << 4))] = \
            acc[ai_][bj_][m_][n_][j_];                                                                 \
      __syncthreads();                                                                                 \
      _Pragma("unroll 1") for (int it_ = 0; it_ < 8; ++it_) {                                          \
        const int idx_ = t512_ + 512 * it_;                                                            \
        const int rl_ = idx_ >> 5, c0 = (idx_ & 31) * 8;                                               \
        const int row = ai_ * 128 + rl_;                                                               \
        float v[8];                                                                                    \
        {                                                                                              \
          const float* sp_ = sf_ + rl_ * 256 + (c0 ^ (((rl_ >> 2) & 3) << 4));                          \
          const float4 t0 = *(const float4*)sp_; const float4 t1 = *(const float4*)(sp_ + 4);          \
          v[0] = t0.x; v[1] = t0.y; v[2] = t0.z; v[3] = t0.w;                                          \
          v[4] = t1.x; v[5] = t1.y; v[6] = t1.z; v[7] = t1.w;                                          \
        }                                                                                              \
        __VA_ARGS__                                                                                    \
      }                                                                                                \
    }                                                                                                  \
    __syncthreads();                                                                                   \
  }

template <int MT, int NT, int BH>
DI bool xcd_tile(int iter, int& mt, int& nt) {
  constexpr int MPX = MT / 8, TPX = MPX * NT;
  const int xcd = VXCD, j = VJ, nloc = VNLOC;
  const int q = j + iter * nloc;
  if (q >= TPX) return false;
  const int band = q / (BH * NT), r = q % (BH * NT);
  nt = r / BH;
  mt = xcd * MPX + band * BH + (r % BH);
  return true;
}

DI bool tile256(int iter, int NT, int& mt, int& nt) {
  const int xcd = blockIdx.x & 7, j = blockIdx.x >> 3, nloc = gridDim.x >> 3;
  const int q = j + iter * nloc;
  if (q >= 6 * NT) return false;
  nt = q / 6; mt = xcd * 6 + q % 6;
  return true;
}
DI void phase_gemm_in(const Params& p, int l, char* smem) {
  const bfu* W = p.w_inT + (size_t)l * DINP * LDH;
  for (int iter = 0;; ++iter) {
    int mt, nt;
    if (!tile256(iter, 19, mt, nt)) break;
    f32x4 acc[2][2][4][2];
    acc256_zero(acc);
    gemm256(p.h, LDH, W, LDH, 1024, mt * 256, nt * 256, (bfu*)smem, acc);
    const int m0 = mt * 256, n0 = nt * 256;
    EPI256({
      const int n = n0 + c0;
      if (n < 512) *(uint4*)(p.ug + ((size_t)(n >> 4) * NTOK + (m0 + row)) * 16 + (n & 15)) = pack8(v);
      else if (n < DIN) *(uint4*)(p.proj + (size_t)(m0 + row) * PW + (n - 512)) = pack8(v);
    })
  }
}

DI void s5_gen_item(const Params& p, int l, int item, char* smem) {
  const int tid = tid_();
  const int g = item >> 3, r = item & 7;
  float* sBr = (float*)smem;
  float* sBi = sBr + 2048;
  float* sCr = sBi + 2048;
  float* sCi = sCr + 1024;
  float* sAK = sCi + 1024;
  float* sAE = sAK + 1024;
  float* sAG = sAE + 1024;
  float* sK = sAG + 1024;
  bfu* E = p.opE + (size_t)g * 256 * 512;
  bfu* MG = p.opMG + (size_t)g * 512 * 768;
  __syncthreads();
  if (tid < 128) {
    const int d = tid >> 6, pp = tid & 63;
    const size_t pi = ((size_t)(l * 2 + d) * 32 + g) * 64 + pp;
    const float lr = p.lam_re[pi], li = p.lam_im[pi];
    const float dt = expf(p.log_dt[(l * 2 + d) * 32 + g]);
    const float mag = expf(lr * dt);
    float sn, cs;
    sincosf(li * dt, &sn, &cs);
    const float are = mag * cs, aim = mag * sn;
    const float nr = are - 1.f, ni = aim, den = lr * lr + li * li;
    const float kr = (nr * lr + ni * li) / den, ki = (ni * lr - nr * li) / den;
#pragma unroll
    for (int c = 0; c < 16; ++c) {
      float br = p.b_re[((size_t)(l * 32 + g) * 64 + pp) * 16 + c];
      float bi = p.b_im[((size_t)(l * 32 + g) * 64 + pp) * 16 + c];
      sBr[(d * 64 + pp) * 16 + c] = kr * br - ki * bi;
      sBi[(d * 64 + pp) * 16 + c] = kr * bi + ki * br;
    }
#pragma unroll
    for (int q = 0; q < 4; ++q) {
      const int t = 4 * r + q;
      const int nK = t;
      const int nE = d == 0 ? 31 - t : t;
      const int nG = d == 0 ? t + 1 : 32 - t;
      float m, s_, c_;
      m = expf(lr * dt * (float)nK); sincosf(li * dt * (float)nK, &s_, &c_);
      sAK[((d * 4 + q) * 64 + pp) * 2] = m * c_; sAK[((d * 4 + q) * 64 + pp) * 2 + 1] = m * s_;
      m = expf(lr * dt * (float)nE); sincosf(li * dt * (float)nE, &s_, &c_);
      sAE[((d * 4 + q) * 64 + pp) * 2] = m * c_; sAE[((d * 4 + q) * 64 + pp) * 2 + 1] = m * s_;
      m = expf(lr * dt * (float)nG); sincosf(li * dt * (float)nG, &s_, &c_);
      sAG[((d * 4 + q) * 64 + pp) * 2] = m * c_; sAG[((d * 4 + q) * 64 + pp) * 2 + 1] = m * s_;
    }
  } else {
    for (int idx = tid - 128; idx < 1024; idx += 128) {
      sCr[idx] = p.c_re[(size_t)(l * 32 + g) * 1024 + idx];
      sCi[idx] = p.c_im[(size_t)(l * 32 + g) * 1024 + idx];
    }
  }
  __syncthreads();
  for (int idx = tid; idx < 256 * 64; idx += 256) {
    const int row = idx >> 6, cc = idx & 63, q = cc >> 4, c = cc & 15;
    const int part = row >> 6, pp = row & 63, d = part >> 1;
    const float ar = sAE[((d * 4 + q) * 64 + pp) * 2], ai = sAE[((d * 4 + q) * 64 + pp) * 2 + 1];
    const float br = sBr[(d * 64 + pp) * 16 + c], bi = sBi[(d * 64 + pp) * 16 + c];
    const float v = (part & 1) ? (ar * bi + ai * br) : (ar * br - ai * bi);
    E[(size_t)row * 512 + (4 * r + q) * 16 + c] = f2bf(v);
  }
  for (int idx = tid; idx < 64 * 256; idx += 256) {
    const int rr = idx >> 8, col = idx & 255, q = rr >> 4, c = rr & 15;
    const int part = col >> 6, pp = col & 63, d = part >> 1;
    const float ar = sAG[((d * 4 + q) * 64 + pp) * 2], ai = sAG[((d * 4 + q) * 64 + pp) * 2 + 1];
    const float cr = sCr[c * 64 + pp], ci = sCi[c * 64 + pp];
    const float v = (part & 1) ? -(cr * ai + ci * ar) : (cr * ar - ci * ai);
    MG[(size_t)((4 * r + q) * 16 + c) * 768 + 512 + col] = f2bf(v);
  }
  {
    const int d = tid >> 7, q = (tid >> 5) & 3, c = (tid >> 1) & 15, ch = tid & 1;
    float acc[8];
#pragma unroll
    for (int e = 0; e < 8; ++e) acc[e] = 0.f;
    for (int pp = 0; pp < 64; ++pp) {
      const float ar = sAK[((d * 4 + q) * 64 + pp) * 2], ai = sAK[((d * 4 + q) * 64 + pp) * 2 + 1];
      const float cr = sCr[c * 64 + pp], ci = sCi[c * 64 + pp];
      const float wr = cr * ar - ci * ai, wi = cr * ai + ci * ar;
#pragma unroll
      for (int e = 0; e < 8; ++e)
        acc[e] += wr * sBr[(d * 64 + pp) * 16 + ch * 8 + e] - wi * sBi[(d * 64 + pp) * 16 + ch * 8 + e];
    }
#pragma unroll
    for (int e = 0; e < 8; ++e) sK[((d * 4 + q) * 16 + c) * 16 + ch * 8 + e] = acc[e];
  }
  __syncthreads();
  for (int idx = tid; idx < 8192; idx += 256) {
    const int ch = idx & 1, c = (idx >> 1) & 15, tp = (idx >> 5) & 31, q = (idx >> 10) & 3, d = idx >> 12;
    const int tau = 4 * r + q;
    int sp;
    bool valid;
    if (d == 0) { sp = tp - tau; valid = sp >= 0; } else { sp = tp + tau; valid = (sp <= 31) && (tau > 0); }
    if (valid) {
      float v[8];
#pragma unroll
      for (int e = 0; e < 8; ++e) {
        float x = sK[((d * 4 + q) * 16 + c) * 16 + ch * 8 + e];
        if (tau == 0) x += sK[((1 * 4 + q) * 16 + c) * 16 + ch * 8 + e];
        v[e] = x;
      }
      *(uint4*)(MG + (size_t)(tp * 16 + c) * 768 + sp * 16 + ch * 8) = pack8(v);
    }
  }
  __syncthreads();
}

DI void phase_s5_gen(const Params& p, int l, char* smem) {
  for (int it = NVB - 1 - VBID; it < 256; it += NVB) s5_gen_item(p, l, it, smem);
}

DI void phase_s5_e(const Params& p, char* smem) {
  for (int q = VJ; q < 24; q += VNLOC) {
    const int g = VXCD * 4 + q / 6, r6 = q % 6, mt = r6 >> 1, nt = r6 & 1;
    f32x16 acc[2][2];
    acc_zero(acc);
    gemm_core(p.ug + ((size_t)g * NCHUNK + mt * 128) * 512, 512, p.opE + ((size_t)g * 256 + nt * 128) * 512, 512, 512,
              smem, acc);
    EPI_LDS({
      float* dst = p.ebuf + ((size_t)g * NCHUNK + mt * 128 + row) * 256 + nt * 128 + c0;
      *(float4*)dst = make_float4(v[0], v[1], v[2], v[3]);
      *(float4*)(dst + 4) = make_float4(v[4], v[5], v[6], v[7]);
    })
  }
}

DI void phase_s5_scan(const Params& p, int l) {
  const int tid = tid_();
  for (int it = VBID; it < 320; it += NVB) {
    const int wi = it * 2 + (tid >> 7);
    const int dir = (tid >> 6) & 1, pp = tid & 63;
    int chunk0, n, b, g;
    bool prompt;
    if (wi < 128) { b = wi >> 5; g = wi & 31; chunk0 = (NPROMPT + b * 2048) >> 5; n = 64; prompt = false; }
    else { int q = wi - 128; b = q >> 5; g = q & 31; chunk0 = (b * 256) >> 5; n = 8; prompt = true; }
    const size_t pi = ((size_t)(l * 2 + dir) * 32 + g) * 64 + pp;
    const float lr = p.lam_re[pi], li = p.lam_im[pi];
    const float dt = expf(p.log_dt[(l * 2 + dir) * 32 + g]);
    const float mag = expf(lr * dt * 32.f);
    float sn, cs;
    sincosf(li * dt * 32.f, &sn, &cs);
    const float are = mag * cs, aim = mag * sn;
    float hre = 0.f, him = 0.f;
    if (!prompt) {
      size_t si = ((size_t)((b * 2 + l) * 2 + dir)) * 2048 + g * 64 + pp;
      hre = p.st_re[si]; him = p.st_im[si];
    }
    const float* eb = p.ebuf + ((size_t)g * NCHUNK + chunk0) * 256 + dir * 128 + pp;
    bfu* cb = p.carry + ((size_t)g * NCHUNK + chunk0) * 256 + dir * 128 + pp;
    for (int k0 = 0; k0 < n; k0 += 8) {
      float er[8], ei[8];
#pragma unroll
      for (int j = 0; j < 8; ++j) {
        const int k = dir == 0 ? k0 + j : n - 1 - (k0 + j);
        er[j] = eb[(size_t)k * 256];
        ei[j] = eb[(size_t)k * 256 + 64];
      }
#pragma unroll
      for (int j = 0; j < 8; ++j) {
        const int k = dir == 0 ? k0 + j : n - 1 - (k0 + j);
        cb[(size_t)k * 256] = f2bf(hre);
        cb[(size_t)k * 256 + 64] = f2bf(him);
        const float nre = are * hre - aim * him + er[j];
        const float nim = are * him + aim * hre + ei[j];
        hre = nre; him = nim;
      }
    }
    if (prompt) {
      size_t oi = ((size_t)((b * 2 + l) * 2 + dir)) * 2048 + g * 64 + pp;
      p.out[OUT_RE + oi] = hre;
      p.out[OUT_IM + oi] = him;
    }
  }
}

DI void phase_s5_y(const Params& p, int l, char* smem) {
  for (int q = VJ; q < 48; q += VNLOC) {
    const int g = VXCD * 4 + q / 12, r12 = q % 12, mt = r12 >> 2, nt = r12 & 3;
    f32x16 acc[2][2];
    acc_zero(acc);
    const bfu* Bm = p.opMG + ((size_t)g * 512 + nt * 128) * 768;
    gemm_core(p.ug + ((size_t)g * NCHUNK + mt * 128) * 512, 512, Bm, 768, 512, smem, acc);
    gemm_core(p.carry + ((size_t)g * NCHUNK + mt * 128) * 256, 256, Bm + 512, 768, 256, smem, acc);
    EPI_LDS({
      const int chunk = mt * 128 + row, nn = nt * 128 + c0, tp = nn >> 4, c = nn & 15;
      const int tok = chunk * 32 + tp;
      float u[8], o[8];
      unpack8(*(const uint4*)(p.ug + ((size_t)g * NTOK + tok) * 16 + c), u);
      const float* dsk = p.s5_d + l * 512 + g * 16 + c;
      _Pragma("unroll") for (int e = 0; e < 8; ++e) o[e] = geluf_(v[e] + dsk[e] * u[e]);
      *(uint4*)(p.ys5 + (size_t)tok * 512 + g * 16 + c) = pack8(o);
    })
  }
}

DI void phase_glu(const Params& p, int l, char* smem) {
  const bfu* W = p.w_gluT + (size_t)l * 512 * 512;
  for (int iter = 0;; ++iter) {
    int mt, nt;
    if (!xcd_tile<96, 4, 12>(iter, mt, nt)) break;
    f32x16 acc[2][2];
    acc_zero(acc);
    gemm_core(p.ys5 + (size_t)mt * 128 * 512, 512, W + (size_t)nt * 128 * 512, 512, 512, smem, acc);
    const int m0 = mt * 128, n0 = nt * 128;
    EPI_LDS({
      const int n = n0 + c0;
      const size_t tk = (size_t)(m0 + row);
      float y[8], ga[8], o[8];
      unpack8(*(const uint4*)(p.ys5 + tk * 512 + n), y);
      unpack8(*(const uint4*)(p.proj + tk * PW + OFF_GA + n), ga);
      const float* bg = p.b_glu + l * 512 + n;
      _Pragma("unroll") for (int e = 0; e < 8; ++e) o[e] = y[e] * sigmoidf_(v[e] + bg[e]) * siluf_(ga[e]);
      *(uint4*)(p.ya + tk * 512 + n) = pack8(o);
    })
  }
}

constexpr int GL_QS = 0;
constexpr int GL_KS = GL_QS + 32 * 144;
constexpr int GL_KHT = GL_KS + 32 * 144;
constexpr int GL_VT = GL_KHT + 64 * 80;
constexpr int GL_PS = GL_VT + 128 * 80;
constexpr int GL_ST = GL_PS + 32 * 80;
constexpr int GL_AV = GL_ST + 128 * 144;
constexpr int GL_TOT = GL_AV + 256;
constexpr int GL_OS = GL_TOT + 1024;
static_assert(GL_OS + 32 * 132 * 4 <= 65536, "gla lds");

DI void gla_segment_info(int seg, int& tok_base, bool& prompt, int& b, int& sidx) {
  if (seg < 16) { prompt = true; b = seg; sidx = 0; tok_base = seg * 256; }
  else { int q = seg - 16; prompt = false; b = q >> 3; sidx = q & 7; tok_base = NPROMPT + b * 2048 + sidx * 256; }
}

template <bool STATE_ONLY>
DI void gla_chain(const Params& p, int l, char* smem, int seg, int hd, int dir) {
  const int tid = tid_(), lane = tid & 63, w = tid >> 6;
  const int fr = lane & 31, hh = lane >> 5;
  int tok_base, b, sidx;
  bool prompt;
  gla_segment_info(seg, tok_base, prompt, b, sidx);
  const int dk = tid & 63, tq = tid >> 6;
  const int dvl = tid & 127, th = tid >> 7;
  float wg[16];
#pragma unroll
  for (int q = 0; q < 16; ++q) wg[q] = p.wg_up[((size_t)(l * 2 + dir) * 16 + q) * 256 + hd * 64 + dk];
  const float bgv = p.bg[(l * 2 + dir) * 256 + hd * 64 + dk];
  float* sAv = (float*)(smem + GL_AV);
  float* sTot = (float*)(smem + GL_TOT);
  float* sOs = (float*)(smem + GL_OS);

  f32x16 S[2];
  {
    const int dvc = 32 * w + fr;
    if (STATE_ONLY || prompt) {
#pragma unroll
      for (int mt = 0; mt < 2; ++mt)
#pragma unroll
        for (int r = 0; r < 16; ++r) S[mt][r] = 0.f;
    } else {
      const float* sp = p.st_gla + ((size_t)(((b * 2 + l) * 2 + dir) * 4 + hd)) * 8192;
#pragma unroll
      for (int mt = 0; mt < 2; ++mt)
#pragma unroll
        for (int r = 0; r < 16; ++r) S[mt][r] = sp[(32 * mt + (r & 3) + 8 * (r >> 2) + 4 * hh) * 128 + dvc];
      const int nprev = dir == 0 ? sidx : 7 - sidx;
      for (int q = 0; q < nprev; ++q) {
        const int sprev = dir == 0 ? q : 7 - q;
        const size_t ci = (size_t)(((b * 8 + sprev) * 4 + hd) * 2 + dir);
        const float* sl = p.gla_sloc + ci * 8192;
        const float* al = p.gla_aseg + ci * 64;
#pragma unroll
        for (int mt = 0; mt < 2; ++mt)
#pragma unroll
          for (int r = 0; r < 16; ++r) {
            const int dkk = 32 * mt + (r & 3) + 8 * (r >> 2) + 4 * hh;
            S[mt][r] = al[dkk] * S[mt][r] + sl[dkk * 128 + dvc];
          }
      }
    }
  }
  float bsum = 0.f;
  __syncthreads();
  if (!STATE_ONLY) {
    const int dvc = 32 * w + fr;
#pragma unroll
    for (int mt = 0; mt < 2; ++mt)
#pragma unroll
      for (int q = 0; q < 4; ++q) {
        uint2 pk;
        pk.x = pack2(S[mt][4 * q], S[mt][4 * q + 1]);
        pk.y = pack2(S[mt][4 * q + 2], S[mt][4 * q + 3]);
        *(uint2*)(smem + GL_ST + dvc * 144 + (32 * mt + 8 * q + 4 * hh) * 2) = pk;
      }
  }

  uint4 rq = make_uint4(0, 0, 0, 0), rk = rq, rv0 = rq, rv1 = rq, rgl = rq;
#define GLA_ISSUE(nn)                                                                                         \
  {                                                                                                           \
    const int cn_ = dir == 0 ? (nn) : 7 - (nn);                                                               \
    const int c0_ = tok_base + cn_ * 32;                                                                      \
    const int tA = dir == 0 ? (tid >> 3) : 31 - (tid >> 3);                                                   \
    const bfu* prA = p.proj + (size_t)(c0_ + tA) * PW + hd * 64 + (tid & 7) * 8;                              \
    if (!STATE_ONLY) rq = *(const uint4*)(prA + OFF_Q);                                                       \
    rk = *(const uint4*)(prA + OFF_K);                                                                        \
    const int tV0 = dir == 0 ? (tid >> 4) : 31 - (tid >> 4);                                                  \
    const int tV1 = dir == 0 ? (tid >> 4) + 16 : 15 - (tid >> 4);                                             \
    rv0 = *(const uint4*)(p.proj + (size_t)(c0_ + tV0) * PW + OFF_V + hd * 128 + (tid & 15) * 8);             \
    rv1 = *(const uint4*)(p.proj + (size_t)(c0_ + tV1) * PW + OFF_V + hd * 128 + (tid & 15) * 8);             \
    if (tid < 64) {                                                                                           \
      const int tG = dir == 0 ? (tid >> 1) : 31 - (tid >> 1);                                                 \
      rgl = *(const uint4*)(p.proj + (size_t)(c0_ + tG) * PW + OFF_GL + (tid & 1) * 8);                       \
    }                                                                                                         \
  }
  GLA_ISSUE(0)
  char* rawQ = smem + GL_OS;
  char* rawK = smem + GL_OS + 4096;
  char* rawV = smem + GL_OS + 8192;
  char* rawG = smem + GL_PS;

#pragma unroll 1
  for (int n = 0; n < 8; ++n) {
    const int cn = dir == 0 ? n : 7 - n;
    const int ctok0 = tok_base + cn * 32;
    __syncthreads();
    if (!STATE_ONLY) *(uint4*)(rawQ + (tid >> 3) * 128 + (tid & 7) * 16) = rq;
    *(uint4*)(rawK + (tid >> 3) * 128 + (tid & 7) * 16) = rk;
    *(uint4*)(rawV + (tid >> 4) * 256 + (tid & 15) * 16) = rv0;
    *(uint4*)(rawV + ((tid >> 4) + 16) * 256 + (tid & 15) * 16) = rv1;
    if (tid < 64) *(uint4*)(rawG + (tid >> 1) * 32 + (tid & 1) * 16) = rgl;
    if (n + 1 < 8) GLA_ISSUE(n + 1)
    uint4 eg0 = make_uint4(0, 0, 0, 0), eg1 = eg0;
    float4 et[4];
    if (!STATE_ONLY) {
      const size_t tokE = (size_t)(ctok0 + (tid >> 3));
      const bfu* gp = p.proj + tokE * PW + OFF_GB + hd * 128 + (tid & 7) * 16;
      if (dir == 0) {
        eg0 = *(const uint4*)gp; eg1 = *(const uint4*)(gp + 8);
        const float* tp = p.tmp_gla + tokE * 512 + hd * 128 + (tid & 7) * 16;
#pragma unroll
        for (int q = 0; q < 4; ++q) et[q] = *(const float4*)(tp + 4 * q);
      }
    }
    __syncthreads();
    float qv[8], kv[8], bl[8];
    {
      float run = 0.f;
#pragma unroll
      for (int i = 0; i < 8; ++i) {
        const int tau = tq * 8 + i;
        if (!STATE_ONLY) qv[i] = bf2f(*(const bfu*)(rawQ + tau * 128 + dk * 2)) * 0.125f;
        kv[i] = bf2f(*(const bfu*)(rawK + tau * 128 + dk * 2));
        float gl[16];
        unpack8(*(const uint4*)(rawG + tau * 32), *(float(*)[8])&gl[0]);
        unpack8(*(const uint4*)(rawG + tau * 32 + 16), *(float(*)[8])&gl[8]);
        float lg = bgv;
#pragma unroll
        for (int q = 0; q < 16; ++q) lg += gl[q] * wg[q];
        const float ls = fminf(lg, 0.f) - __logf(1.f + __expf(-fabsf(lg)));
        run += ls * (1.f / 16.f);
        bl[i] = run;
      }
      sTot[tq * 64 + dk] = run;
    }
    {
      unsigned pk[8];
#pragma unroll
      for (int i = 0; i < 8; ++i) {
        const int tau0 = th * 16 + 2 * i;
        const unsigned lo = *(const bfu*)(rawV + tau0 * 256 + dvl * 2);
        const unsigned hi = *(const bfu*)(rawV + (tau0 + 1) * 256 + dvl * 2);
        pk[i] = lo | (hi << 16);
      }
      *(uint4*)(smem + GL_VT + dvl * 80 + th * 32) = make_uint4(pk[0], pk[1], pk[2], pk[3]);
      *(uint4*)(smem + GL_VT + dvl * 80 + th * 32 + 16) = make_uint4(pk[4], pk[5], pk[6], pk[7]);
    }
    __syncthreads();
    {
      float off = 0.f, total = 0.f;
#pragma unroll
      for (int q = 0; q < 4; ++q) {
        const float tv = sTot[q * 64 + dk];
        total += tv;
        off += (q < tq) ? tv : 0.f;
      }
      unsigned kh[4];
      float khv[8];
#pragma unroll
      for (int i = 0; i < 8; ++i) {
        const float bb = off + bl[i];
        const int tau = tq * 8 + i;
        if (!STATE_ONLY) {
          *(bfu*)(smem + GL_QS + tau * 144 + dk * 2) = f2bf(qv[i] * __expf(bb));
          *(bfu*)(smem + GL_KS + tau * 144 + dk * 2) = f2bf(kv[i] * __expf(-bb));
        }
        khv[i] = kv[i] * __expf(total - bb);
      }
#pragma unroll
      for (int i = 0; i < 4; ++i) kh[i] = pack2(khv[2 * i], khv[2 * i + 1]);
      *(uint4*)(smem + GL_KHT + dk * 80 + tq * 16) = make_uint4(kh[0], kh[1], kh[2], kh[3]);
      if (tq == 0) { sAv[dk] = __expf(total); bsum += total; }
    }
    __syncthreads();
    f32x16 o;
    if (!STATE_ONLY) {
      f32x16 sc;
#pragma unroll
      for (int r = 0; r < 16; ++r) sc[r] = 0.f;
#pragma unroll
      for (int s4 = 0; s4 < 4; ++s4) {
        bf16x8 a = *(const bf16x8*)(smem + GL_QS + fr * 144 + (16 * s4 + 8 * hh) * 2);
        bf16x8 bq = *(const bf16x8*)(smem + GL_KS + fr * 144 + (16 * s4 + 8 * hh) * 2);
        sc = __builtin_amdgcn_mfma_f32_32x32x16_bf16(a, bq, sc, 0, 0, 0);
      }
#pragma unroll
      for (int rr = 0; rr < 4; ++rr) {
        float val = w == 0 ? sc[rr] : (w == 1 ? sc[4 + rr] : (w == 2 ? sc[8 + rr] : sc[12 + rr]));
        const int i = rr + 8 * w + 4 * hh;
        val = (fr <= i) ? val : 0.f;
        *(bfu*)(smem + GL_PS + i * 80 + fr * 2) = f2bf(val);
      }
      __syncthreads();
#pragma unroll
      for (int r = 0; r < 16; ++r) o[r] = 0.f;
    }
    {
      const int dvc = 32 * w + fr;
      bf16x8 vb0 = *(const bf16x8*)(smem + GL_VT + dvc * 80 + (8 * hh) * 2);
      bf16x8 vb1 = *(const bf16x8*)(smem + GL_VT + dvc * 80 + (16 + 8 * hh) * 2);
      if (!STATE_ONLY) {
        bf16x8 pa0 = *(const bf16x8*)(smem + GL_PS + fr * 80 + (8 * hh) * 2);
        bf16x8 pa1 = *(const bf16x8*)(smem + GL_PS + fr * 80 + (16 + 8 * hh) * 2);
        o = __builtin_amdgcn_mfma_f32_32x32x16_bf16(pa0, vb0, o, 0, 0, 0);
        o = __builtin_amdgcn_mfma_f32_32x32x16_bf16(pa1, vb1, o, 0, 0, 0);
#pragma unroll
        for (int s4 = 0; s4 < 4; ++s4) {
          bf16x8 a = *(const bf16x8*)(smem + GL_QS + fr * 144 + (16 * s4 + 8 * hh) * 2);
          bf16x8 sb = *(const bf16x8*)(smem + GL_ST + dvc * 144 + (16 * s4 + 8 * hh) * 2);
          o = __builtin_amdgcn_mfma_f32_32x32x16_bf16(a, sb, o, 0, 0, 0);
        }
      }
#pragma unroll
      for (int mt = 0; mt < 2; ++mt) {
        f32x16 U;
#pragma unroll
        for (int r = 0; r < 16; ++r) U[r] = 0.f;
        bf16x8 ka0 = *(const bf16x8*)(smem + GL_KHT + (32 * mt + fr) * 80 + (8 * hh) * 2);
        bf16x8 ka1 = *(const bf16x8*)(smem + GL_KHT + (32 * mt + fr) * 80 + (16 + 8 * hh) * 2);
        U = __builtin_amdgcn_mfma_f32_32x32x16_bf16(ka0, vb0, U, 0, 0, 0);
        U = __builtin_amdgcn_mfma_f32_32x32x16_bf16(ka1, vb1, U, 0, 0, 0);
#pragma unroll
        for (int q = 0; q < 4; ++q) {
          const float4 av = *(const float4*)(sAv + 32 * mt + 8 * q + 4 * hh);
          S[mt][4 * q + 0] = av.x * S[mt][4 * q + 0] + U[4 * q + 0];
          S[mt][4 * q + 1] = av.y * S[mt][4 * q + 1] + U[4 * q + 1];
          S[mt][4 * q + 2] = av.z * S[mt][4 * q + 2] + U[4 * q + 2];
          S[mt][4 * q + 3] = av.w * S[mt][4 * q + 3] + U[4 * q + 3];
          if (!STATE_ONLY) {
            uint2 pk;
            pk.x = pack2(S[mt][4 * q], S[mt][4 * q + 1]);
            pk.y = pack2(S[mt][4 * q + 2], S[mt][4 * q + 3]);
            *(uint2*)(smem + GL_ST + dvc * 144 + (32 * mt + 8 * q + 4 * hh) * 2) = pk;
          }
        }
      }
      if (!STATE_ONLY) {
#pragma unroll
        for (int r = 0; r < 16; ++r) sOs[((r & 3) + 8 * (r >> 2) + 4 * hh) * 132 + dvc] = o[r];
      }
    }
    __syncthreads();
    if (!STATE_ONLY) {
      const int t = tid >> 3, part = tid & 7;
      const int tau = dir == 0 ? t : 31 - t;
      const size_t tok = (size_t)(ctok0 + t);
      float ov[16];
#pragma unroll
      for (int q = 0; q < 4; ++q) {
        const float4 x = *(const float4*)(sOs + tau * 132 + part * 16 + 4 * q);
        ov[4 * q] = x.x; ov[4 * q + 1] = x.y; ov[4 * q + 2] = x.z; ov[4 * q + 3] = x.w;
      }
      float* tp = p.tmp_gla + tok * 512 + hd * 128 + part * 16;
      if (dir == 1) {
#pragma unroll
        for (int q = 0; q < 4; ++q) *(float4*)(tp + 4 * q) = make_float4(ov[4 * q], ov[4 * q + 1], ov[4 * q + 2], ov[4 * q + 3]);
      } else {
        float ss = 0.f;
#pragma unroll
        for (int q = 0; q < 4; ++q) {
          const float4 x = et[q];
          ov[4 * q] += x.x; ov[4 * q + 1] += x.y; ov[4 * q + 2] += x.z; ov[4 * q + 3] += x.w;
        }
#pragma unroll
        for (int e = 0; e < 16; ++e) ss += ov[e] * ov[e];
        ss += __shfl_xor(ss, 1); ss += __shfl_xor(ss, 2); ss += __shfl_xor(ss, 4);
        const float rs = rsqrtf(ss * (1.f / 128.f) + EPS);
        const float* gn = p.gla_norm_g + l * 512 + hd * 128 + part * 16;
        float gt[16];
        unpack8(eg0, *(float(*)[8])&gt[0]);
        unpack8(eg1, *(float(*)[8])&gt[8]);
        float res[16];
#pragma unroll
        for (int e = 0; e < 16; ++e) res[e] = ov[e] * rs * gn[e] * siluf_(gt[e]);
        bfu* yp = p.yb + tok * 512 + hd * 128 + part * 16;
        *(uint4*)yp = pack8(*(float(*)[8])&res[0]);
        *(uint4*)(yp + 8) = pack8(*(float(*)[8])&res[8]);
      }
    }
  }
  const int dvc = 32 * w + fr;
  if (STATE_ONLY) {
    const size_t ci = (size_t)(((b * 8 + sidx) * 4 + hd) * 2 + dir);
    float* sl = p.gla_sloc + ci * 8192;
#pragma unroll
    for (int mt = 0; mt < 2; ++mt)
#pragma unroll
      for (int r = 0; r < 16; ++r) sl[(32 * mt + (r & 3) + 8 * (r >> 2) + 4 * hh) * 128 + dvc] = S[mt][r];
    if (tq == 0) p.gla_aseg[ci * 64 + dk] = __expf(bsum);
  } else if (prompt) {
    float* op = p.out + OUT_GLA + ((size_t)(((b * 2 + l) * 2 + dir) * 4 + hd)) * 8192;
#pragma unroll
    for (int mt = 0; mt < 2; ++mt)
#pragma unroll
      for (int r = 0; r < 16; ++r) op[(32 * mt + (r & 3) + 8 * (r >> 2) + 4 * hh) * 128 + dvc] = S[mt][r];
  }
  __syncthreads();
}

DI void phase_gla_pass1(const Params& p, int l, char* smem) {
  for (int it = NVB - 1 - VBID; it < 256; it += NVB) {
    const int dir = it & 1, hd = (it >> 1) & 3, seg = 16 + (it >> 3);
    gla_chain<true>(p, l, smem, seg, hd, dir);
  }
}
DI void phase_gla_main(const Params& p, int l, char* smem) {
  for (int it = NVB - 1 - VBID; it < 192; it += NVB) {
    const int hd = it & 3, seg = it >> 2;
    gla_chain<false>(p, l, smem, seg, hd, 1);
    gla_chain<false>(p, l, smem, seg, hd, 0);
  }
}

DI void phase_merge(const Params& p, int l, char* smem) {
  const bfu* WA = p.w_paT + (size_t)l * 1024 * 512;
  const bfu* WB = p.w_pbT + (size_t)l * 1024 * 512;
  for (int iter = 0;; ++iter) {
    int mt, nt;
    if (!tile256(iter, 4, mt, nt)) break;
    const int m0 = mt * 256, n0 = nt * 256;
    f32x4 acc[2][2][4][2];
    acc256_zero(acc);
    gemm256(p.ya, 512, WA, 512, 512, m0, n0, (bfu*)smem, acc);
    EPI256({
      float ma[8], o[8];
      unpack8(*(const uint4*)(p.proj + (size_t)(m0 + row) * PW + OFF_MA + n0 + c0), ma);
      _Pragma("unroll") for (int e = 0; e < 8; ++e) o[e] = sigmoidf_(ma[e]) * v[e];
      *(uint4*)(p.merged + (size_t)(m0 + row) * D + n0 + c0) = pack8(o);
    })
    acc256_zero(acc);
    gemm256(p.yb, 512, WB, 512, 512, m0, n0, (bfu*)smem, acc);
    EPI256({
      float mb[8], o[8], pr[8];
      unpack8(*(const uint4*)(p.proj + (size_t)(m0 + row) * PW + OFF_MB + n0 + c0), mb);
      uint4* mp = (uint4*)(p.merged + (size_t)(m0 + row) * D + n0 + c0);
      unpack8(*mp, pr);
      _Pragma("unroll") for (int e = 0; e < 8; ++e) o[e] = pr[e] + sigmoidf_(mb[e]) * v[e];
      *mp = pack8(o);
    })
  }
}

DI void phase_out(const Params& p, int l, char* smem) {
  const bfu* W = p.w_oT + (size_t)l * 1024 * 1024;
  for (int iter = 0;; ++iter) {
    int mt, nt;
    if (!tile256(iter, 4, mt, nt)) break;
    const int m0 = mt * 256, n0 = nt * 256;
    f32x4 acc[2][2][4][2];
    acc256_zero(acc);
    gemm256(p.merged, D, W, 1024, 1024, m0, n0, (bfu*)smem, acc);
    const float* gate = p.mod + (size_t)(l * 5 + cond_of_tok(m0)) * 3072 + 2048;
    EPI256({
      float* xp = p.out + (size_t)(m0 + row) * D + n0 + c0;
      const float* gp = gate + n0 + c0;
      float4 x0 = *(const float4*)xp, x1 = *(const float4*)(xp + 4);
      const float4 g0 = *(const float4*)gp, g1 = *(const float4*)(gp + 4);
      x0.x += g0.x * v[0]; x0.y += g0.y * v[1]; x0.z += g0.z * v[2]; x0.w += g0.w * v[3];
      x1.x += g1.x * v[4]; x1.y += g1.y * v[5]; x1.z += g1.z * v[6]; x1.w += g1.w * v[7];
      *(float4*)xp = x0; *(float4*)(xp + 4) = x1;
    })
  }
}

DI void phase_final(const Params& p) {
  const int tid = tid_(), lane = tid & 63, w = tid >> 6;
  for (int it = VBID; it < NTOK / 4; it += NVB) {
    const int tok = it * 4 + w;
    float* xs = p.out + (size_t)tok * D;
    float4 v[4];
#pragma unroll
    for (int i = 0; i < 4; ++i) v[i] = *(const float4*)(xs + lane * 4 + 256 * i);
    float ss = 0.f;
#pragma unroll
    for (int i = 0; i < 4; ++i) ss += v[i].x * v[i].x + v[i].y * v[i].y + v[i].z * v[i].z + v[i].w * v[i].w;
    ss = wave_sum(ss);
    const float rstd = rsqrtf(ss * (1.f / 1024.f) + EPS);
#pragma unroll
    for (int i = 0; i < 4; ++i) {
      float4 g = *(const float4*)(p.final_g + lane * 4 + 256 * i);
      float4 o;
      o.x = v[i].x * rstd * g.x; o.y = v[i].y * rstd * g.y; o.z = v[i].z * rstd * g.z; o.w = v[i].w * rstd * g.w;
      *(float4*)(xs + lane * 4 + 256 * i) = o;
    }
  }
}

#define XB_TMO      128
#define XB_XCNT(j)  (256  + 64 * (j))
#define XB_XSUB(j)  (1280 + 64 * (j))
#define XB_XGEN(j)  (2304 + 64 * (j))
#define XB_TOP      3328
#define XB_TOPGEN   3392
#define XCD_BAR_WORDS 3456
#define XB_SPIN_CAP (1u << 18)
#define LAS __attribute__((address_space(3)))
DI unsigned xb_ld(unsigned* p) { return __hip_atomic_load(p, __ATOMIC_RELAXED, __HIP_MEMORY_SCOPE_AGENT); }
DI unsigned xb_add(unsigned* p, unsigned v) { return __hip_atomic_fetch_add(p, v, __ATOMIC_RELAXED, __HIP_MEMORY_SCOPE_AGENT); }
DI unsigned xb_xcc_id() { return (unsigned)__builtin_amdgcn_s_getreg((3 << 11) | 20) & 0xFu; }
#define XB_SPIN(cond, bar) do { unsigned _sp = 0; while (cond) { __builtin_amdgcn_s_sleep(1); \
    if ((++_sp & 255u) == 0u) { if (xb_ld(&(bar)[XB_TMO])) break; if (_sp > XB_SPIN_CAP) { atomicAdd(&(bar)[XB_TMO], 1u); break; } } } } while (0)
struct XcdBarrier { unsigned* bar; unsigned x; volatile LAS unsigned* st; };
DI XcdBarrier xcd_barrier_post(unsigned* bar, volatile LAS unsigned* st) {
  XcdBarrier b; b.bar = bar; b.x = xb_xcc_id(); b.st = st;
  if (threadIdx.x == 0) (void)xb_add(&bar[XB_XCNT(b.x)], 1u);
  return b;
}
DI void xcd_barrier_complete(unsigned* bar, unsigned x, unsigned& nloc, unsigned& nx) {
  const unsigned G = gridDim.x * gridDim.y * gridDim.z;
  unsigned sum, cnt, mine, sp = 0u;
  for (;;) {
    sum = 0u; cnt = 0u; mine = 0u;
#pragma unroll
    for (unsigned j = 0; j < 16; ++j) { const unsigned c = xb_ld(&bar[XB_XCNT(j)]); sum += c; cnt += (c > 0u) ? 1u : 0u; mine = (j == x) ? c : mine; }
    if (sum == G) break;
    __builtin_amdgcn_s_sleep(1);
    if ((++sp & 255u) == 0u) { if (xb_ld(&bar[XB_TMO])) break; if (sp > XB_SPIN_CAP) { atomicAdd(&bar[XB_TMO], 1u); break; } }
  }
  nloc = mine > 0u ? mine : 1u; nx = cnt > 0u ? cnt : 1u;
}
DI void xcd_barrier(const XcdBarrier& b) {
  asm volatile("s_waitcnt vmcnt(0)" ::: "memory");
  __syncthreads();
  if (threadIdx.x == 0) {
    unsigned* bar = b.bar;
    __builtin_amdgcn_s_waitcnt(0);
    unsigned nloc = b.st[0], nx = b.st[1];
    if (nloc == 0u) { xcd_barrier_complete(bar, b.x, nloc, nx); b.st[0] = nloc; b.st[1] = nx; }
    const unsigned old = xb_add(&bar[XB_XSUB(b.x)], 1u);
    const unsigned gen = old / nloc;
    if (old + 1u == (gen + 1u) * nloc) {
      __builtin_amdgcn_fence(__ATOMIC_RELEASE, "agent");
      asm volatile("s_waitcnt vmcnt(0)" ::: "memory");
      const unsigned og = xb_add(&bar[XB_TOP], 1u);
      const unsigned tg = og / nx;
      if (og + 1u == (tg + 1u) * nx) xb_add(&bar[XB_TOPGEN], 1u);
      else XB_SPIN(xb_ld(&bar[XB_TOPGEN]) == tg, bar);
      __builtin_amdgcn_fence(__ATOMIC_ACQUIRE, "agent");
      xb_add(&bar[XB_XGEN(b.x)], 1u);
      asm volatile("s_waitcnt vmcnt(0)" ::: "memory");
    } else {
      XB_SPIN(xb_ld(&bar[XB_XGEN(b.x)]) == gen, bar);
      __builtin_amdgcn_fence(__ATOMIC_ACQUIRE, "agent");
      asm volatile("s_waitcnt vmcnt(0)" ::: "memory");
    }
  }
  __syncthreads();
}

#ifndef REP_SYNC
#define REP_SYNC 0
#endif
__global__ void __launch_bounds__(512, 2) k_mega(Params p) {
  extern __shared__ __attribute__((aligned(16))) char smem_all[];
  cg::grid_group grid = cg::this_grid();
  char* smem = smem_all;
#define smh (smem_all + VHALF * 65536)
  volatile LAS unsigned* xst = (volatile LAS unsigned*)(smem_all + 131072);
  if (threadIdx.x < 4) xst[threadIdx.x] = 0u;
  __syncthreads();
  XcdBarrier xb = xcd_barrier_post(p.bar, xst);
#define GSYNC() xcd_barrier(xb)
  phase_prep(p, smh);
  phase_s5_gen(p, 0, smh);
  grid.sync();
  for (int l = 0; l < 2; ++l) {
    phase_h(p, l);
    GSYNC();
    phase_gemm_in(p, l, smem);
    GSYNC();
    phase_s5_e(p, smh);
    phase_gla_pass1(p, l, smh);
    GSYNC();
    phase_s5_scan(p, l);
    phase_gla_main(p, l, smh);
    GSYNC();
    phase_s5_y(p, l, smh);
    GSYNC();
    phase_glu(p, l, smh);
    GSYNC();
    phase_merge(p, l, smem);
    if (l == 0 && (blockIdx.x >> 3) >= 24) {
      const int hb = (int)((((blockIdx.x >> 3) - 24) * 8 + (blockIdx.x & 7)) * 2) + VHALF;
      s5_gen_item(p, 1, hb, smh);
      s5_gen_item(p, 1, hb + 128, smh);
    }
    GSYNC();
    phase_out(p, l, smem);
    GSYNC();
    for (int rep = 0; rep < REP_SYNC; ++rep) GSYNC();
  }
  phase_final(p);
}

extern "C" void kernel_launch(void* const* d_in, const int* in_sizes, int n_in, void* d_out, int out_size,
                              void* d_ws, size_t ws_size, hipStream_t stream) {
  Params p{};
  const float* const* in = (const float* const*)d_in;
  p.x_prompt = in[0]; p.x_sample = in[1]; p.c = in[2]; p.st_re = in[3]; p.st_im = in[4]; p.st_gla = in[5];
  p.c_ctx = in[6]; p.norm_g = in[7]; p.w_mod = in[8]; p.b_mod = in[9]; p.w_in = in[10]; p.wg_up = in[11];
  p.bg = in[12]; p.gla_norm_g = in[13]; p.lam_re = in[14]; p.lam_im = in[15]; p.log_dt = in[16];
  p.b_re = in[17]; p.b_im = in[18]; p.c_re = in[19]; p.c_im = in[20]; p.s5_d = in[21]; p.w_glu = in[22];
  p.b_glu = in[23]; p.w_pa = in[24]; p.w_pb = in[25]; p.w_o = in[26]; p.final_g = in[27];
  p.out = (float*)d_out;
  char* ws = (char*)d_ws;
  size_t off = 0;
  auto take = [&](size_t bytes) { char* r = ws + off; off += (bytes + 255) & ~(size_t)255; return r; };
  p.w_inT = (bfu*)take((size_t)2 * DINP * LDH * 2);
  p.w_gluT = (bfu*)take((size_t)2 * 512 * 512 * 2);
  p.w_paT = (bfu*)take((size_t)2 * 1024 * 512 * 2);
  p.w_pbT = (bfu*)take((size_t)2 * 1024 * 512 * 2);
  p.w_oT = (bfu*)take((size_t)2 * 1024 * 1024 * 2);
  p.mod = (float*)take((size_t)2 * 5 * 3072 * 4);
  p.pos_r = (float*)take((size_t)32 * 512 * 4);
  p.pos_c = (float*)take((size_t)64 * 512 * 4);
  p.h = (bfu*)take((size_t)NTOK * LDH * 2);
  p.proj = (bfu*)take((size_t)NTOK * PW * 2);
  p.ys5 = (bfu*)take((size_t)NTOK * 512 * 2);
  p.ya = (bfu*)take((size_t)NTOK * 512 * 2);
  p.yb = (bfu*)take((size_t)NTOK * 512 * 2);
  p.merged = (bfu*)take((size_t)NTOK * D * 2);
  p.tmp_s5 = nullptr;
  p.ebuf = (float*)p.merged;
  p.carry = (bfu*)((char*)p.merged + (size_t)32 * NCHUNK * 256 * 4);
  p.ug = (bfu*)take((size_t)32 * NTOK * 16 * 2);
  p.opMG = (bfu*)take((size_t)32 * 512 * 768 * 2);
  p.opE = (bfu*)take((size_t)32 * 256 * 512 * 2);
  p.gla_sloc = (float*)p.ys5;
  p.gla_aseg = (float*)((char*)p.ys5 + (size_t)256 * 8192 * 4);
  if (off > ws_size) fprintf(stderr, "workspace too small: %zu > %zu\n", off, ws_size);
  p.bar = (unsigned*)take((size_t)XCD_BAR_WORDS * 4);
  p.tmp_gla = (float*)p.h;
  constexpr size_t kLds = 131072 + 16;
  static int grid_blocks = 0;
  if (!grid_blocks) {
    int dev = 0, cus = 0, per_cu = 0;
    hipGetDevice(&dev);
    hipDeviceGetAttribute(&cus, hipDeviceAttributeMultiprocessorCount, dev);
    hipFuncSetAttribute((const void*)k_mega, hipFuncAttributeMaxDynamicSharedMemorySize, (int)kLds);
    hipOccupancyMaxActiveBlocksPerMultiprocessor(&per_cu, k_mega, 512, kLds);
    if (per_cu > 1) per_cu = 1;
    grid_blocks = cus * per_cu;
    if (grid_blocks % 8 != 0 || grid_blocks <= 0) fprintf(stderr, "unexpected grid %d\n", grid_blocks);
  }
  hipMemsetAsync(p.bar, 0, (size_t)XCD_BAR_WORDS * 4, stream);
  void* args[] = {&p};
  hipError_t e = hipLaunchCooperativeKernel((void*)k_mega, dim3(grid_blocks), dim3(512), args, kLds, stream);
  if (e != hipSuccess) fprintf(stderr, "cooperative launch failed: %s (grid %d)\n", hipGetErrorString(e), grid_blocks);
}
```

```cpp
#include <hip/hip_runtime.h>
#include <hip/hip_cooperative_groups.h>
#include <stdint.h>
#include <math.h>
#include <stdio.h>
namespace cg = cooperative_groups;

#ifndef REP_PREP
#define REP_PREP 0
#endif
#ifndef REP_GIN
#define REP_GIN 0
#endif
#ifndef REP_X1
#define REP_X1 0
#endif
#ifndef REP_X2
#define REP_X2 0
#endif
#ifndef REP_Y
#define REP_Y 0
#endif
#ifndef REP_MERGE
#define REP_MERGE 0
#endif
#ifndef REP_SYNC
#define REP_SYNC 0
#endif
#ifndef ONE_LAUNCH
#define ONE_LAUNCH 1
#endif

typedef unsigned short bfu;
typedef __attribute__((ext_vector_type(8))) short bf16x8;
typedef __attribute__((ext_vector_type(16))) float f32x16;
typedef __attribute__((ext_vector_type(2))) __bf16 bf2_t;
typedef __attribute__((ext_vector_type(2))) float f2_t;

#define DI __device__ __forceinline__

constexpr int D = 1024;
constexpr int NTOK = 12288;
constexpr int NPROMPT = 4096;
constexpr int DIN = 4624;
constexpr int DINP = 4864;
constexpr int LDH = 1088;
constexpr int PW = 4112;
constexpr int OFF_GA = 0, OFF_Q = 512, OFF_K = 768, OFF_V = 1024, OFF_GB = 1536, OFF_GL = 2048,
              OFF_MA = 2064, OFF_MB = 3088;
constexpr int NCHUNK = NTOK / 32;
constexpr size_t OUT_RE = (size_t)NTOK * D;
constexpr size_t OUT_IM = OUT_RE + 131072;
constexpr size_t OUT_GLA = OUT_IM + 131072;
constexpr float EPS = 1e-6f;

struct Params {
  const float *x_prompt, *x_sample, *c, *st_re, *st_im, *st_gla, *c_ctx, *norm_g, *w_mod, *b_mod, *w_in,
      *wg_up, *bg, *gla_norm_g, *lam_re, *lam_im, *log_dt, *b_re, *b_im, *c_re, *c_im, *s5_d, *w_glu,
      *b_glu, *w_pa, *w_pb, *w_o, *final_g;
  float* out;
  bfu *w_inT, *w_gluT, *w_paT, *w_pbT, *w_oT;
  float *mod, *pos_r, *pos_c, *tmp_s5, *tmp_gla;
  bfu *h, *proj, *ys5, *ya, *yb, *merged;
  bfu *ug, *opMG, *opE, *carry;
  float *ebuf, *gla_sloc, *gla_aseg;
  unsigned* bar;
  bfu* gla_o;
};

DI int tid_() { int t = threadIdx.x & 255; asm volatile("" : "+v"(t)); return t; }
#define VHALF ((int)__builtin_amdgcn_readfirstlane((int)(threadIdx.x >> 8)))
#define VBID ((int)(blockIdx.x * 2 + VHALF))
#define NVB ((int)(gridDim.x * 2))
#define VXCD ((int)(blockIdx.x & 7))
#define VJ ((int)((blockIdx.x >> 3) * 2 + VHALF))
#define VNLOC ((int)((gridDim.x >> 3) * 2))
DI float bf2f(bfu v) { return __uint_as_float(((unsigned)v) << 16); }
DI bfu f2bf(float x) { __bf16 b = (__bf16)x; return __builtin_bit_cast(unsigned short, b); }
DI unsigned pack2(float lo, float hi) {
  f2_t v = {lo, hi};
  bf2_t w = __builtin_convertvector(v, bf2_t);
  return __builtin_bit_cast(unsigned, w);
}
DI float sigmoidf_(float x) { return 1.f / (1.f + __expf(-x)); }
DI float siluf_(float x) { return x / (1.f + __expf(-x)); }
DI float geluf_(float x) {
  float u = 0.7978845608028654f * (x + 0.044715f * x * x * x);
  float t = 1.f - 2.f / (__expf(2.f * u) + 1.f);
  return 0.5f * x * (1.f + t);
}
DI float wave_sum(float v) {
#pragma unroll
  for (int o = 32; o >= 1; o >>= 1) v += __shfl_xor(v, o);
  return v;
}
DI int cond_of_tok(int tok) { return tok < NPROMPT ? 0 : 1 + ((tok - NPROMPT) >> 11); }

DI void transpose_tile(const float* __restrict__ src, int K, int N, bfu* __restrict__ dst, int kt, int nt,
                       float* sm, int ldd = 0) {
  if (ldd == 0) ldd = K;
  const int tid = tid_(), c = tid & 63, r4 = tid >> 6;
  const int k0 = kt * 64, n0 = nt * 64;
#pragma unroll 4
  for (int i = 0; i < 16; ++i) {
    int k = i * 4 + r4, n = n0 + c;
    sm[k * 65 + c] = (n < N) ? src[(size_t)(k0 + k) * N + n] : 0.f;
  }
  __syncthreads();
#pragma unroll 4
  for (int i = 0; i < 16; ++i) {
    int n = i * 4 + r4;
    dst[(size_t)(n0 + n) * ldd + k0 + c] = f2bf(sm[c * 65 + n]);
  }
  __syncthreads();
}

DI void phase_prep(const Params& p, char* smem) {
  float* sm = (float*)smem;
  const int tid = tid_();
  for (int it = VBID; it < 96; it += NVB) {
    const int l = it / 48, jb = it % 48;
    float* ssil = sm;
    float* sred = sm + 5 * 1024;
    for (int idx = tid; idx < 5120; idx += 256) {
      int ci = idx >> 10, k = idx & 1023;
      float cv = (ci == 0) ? p.c_ctx[k] : p.c[(ci - 1) * 1024 + k];
      ssil[idx] = cv / (1.f + expf(-cv));
    }
    __syncthreads();
    const int jj = tid & 63, kq = tid >> 6;
    const int j = jb * 64 + jj;
    float acc[5] = {0.f, 0.f, 0.f, 0.f, 0.f};
    const float* wp = p.w_mod + ((size_t)l * 1024 + kq * 256) * 3072 + j;
#pragma unroll 8
    for (int k = 0; k < 256; ++k) {
      float w = wp[(size_t)k * 3072];
#pragma unroll
      for (int ci = 0; ci < 5; ++ci) acc[ci] += ssil[ci * 1024 + kq * 256 + k] * w;
    }
#pragma unroll
    for (int ci = 0; ci < 5; ++ci) sred[(kq * 5 + ci) * 64 + jj] = acc[ci];
    __syncthreads();
    for (int idx = tid; idx < 320; idx += 256) {
      int ci = idx >> 6, j2 = idx & 63;
      float s = p.b_mod[l * 3072 + jb * 64 + j2];
#pragma unroll
      for (int q = 0; q < 4; ++q) s += sred[(q * 5 + ci) * 64 + j2];
      p.mod[(size_t)(l * 5 + ci) * 3072 + jb * 64 + j2] = s;
    }
    __syncthreads();
  }
  for (int idx = VBID * 256 + tid; idx < 96 * 512; idx += NVB * 256) {
    int r = idx >> 9, i = idx & 511;
    int pos = r < 32 ? r : r - 32;
    int q = i & 255;
    double f = exp(-log(10000.0) * (double)q / 256.0);
    double ang = (double)pos * f;
    float v = (float)((i < 256) ? sin(ang) : cos(ang));
    if (r < 32) p.pos_r[r * 512 + i] = v; else p.pos_c[(r - 32) * 512 + i] = v;
  }
  for (int it = VBID; it < 3584; it += NVB) {
    int l = it / 1792, r = it % 1792;
    if (r < 1216) {
      transpose_tile(p.w_in + (size_t)l * 1024 * DIN, 1024, DIN, p.w_inT + (size_t)l * DINP * LDH, r % 16, r / 16, sm, LDH);
    } else if (r < 1280) {
      r -= 1216;
      transpose_tile(p.w_glu + (size_t)l * 512 * 512, 512, 512, p.w_gluT + (size_t)l * 512 * 512, r % 8, r / 8, sm);
    } else if (r < 1408) {
      r -= 1280;
      transpose_tile(p.w_pa + (size_t)l * 512 * 1024, 512, 1024, p.w_paT + (size_t)l * 1024 * 512, r % 8, r / 8, sm);
    } else if (r < 1536) {
      r -= 1408;
      transpose_tile(p.w_pb + (size_t)l * 512 * 1024, 512, 1024, p.w_pbT + (size_t)l * 1024 * 512, r % 8, r / 8, sm);
    } else {
      r -= 1536;
      transpose_tile(p.w_o + (size_t)l * 1024 * 1024, 1024, 1024, p.w_oT + (size_t)l * 1024 * 1024, r % 16, r / 16, sm);
    }
  }
}

DI void phase_h(const Params& p, int l) {
  const int tid = tid_(), lane = tid & 63, w = tid >> 6;
  for (int it = VBID; it < NTOK / 4; it += NVB) {
    const int tok = it * 4 + w;
    float4 v[4];
    float* xs = p.out + (size_t)tok * D;
    if (l == 0) {
      const float* src = tok < NPROMPT ? p.x_prompt + (size_t)tok * D : p.x_sample + (size_t)(tok - NPROMPT) * D;
#pragma unroll
      for (int i = 0; i < 4; ++i) v[i] = *(const float4*)(src + lane * 4 + 256 * i);
      if (tok >= NPROMPT) {
        int t = (tok - NPROMPT) & 2047, row = t >> 6, col = t & 63;
#pragma unroll
        for (int i = 0; i < 4; ++i) {
          int d = lane * 4 + 256 * i;
          const float* pe = d < 512 ? p.pos_r + row * 512 + d : p.pos_c + col * 512 + (d - 512);
          float4 e = *(const float4*)pe;
          v[i].x += e.x; v[i].y += e.y; v[i].z += e.z; v[i].w += e.w;
        }
      }
#pragma unroll
      for (int i = 0; i < 4; ++i) *(float4*)(xs + lane * 4 + 256 * i) = v[i];
    } else {
#pragma unroll
      for (int i = 0; i < 4; ++i) v[i] = *(const float4*)(xs + lane * 4 + 256 * i);
    }
    float ss = 0.f;
#pragma unroll
    for (int i = 0; i < 4; ++i) ss += v[i].x * v[i].x + v[i].y * v[i].y + v[i].z * v[i].z + v[i].w * v[i].w;
    ss = wave_sum(ss);
    const float rstd = rsqrtf(ss * (1.f / 1024.f) + EPS);
    const float* md = p.mod + (size_t)(l * 5 + cond_of_tok(tok)) * 3072;
    const float* ng = p.norm_g + l * 1024;
#pragma unroll
    for (int i = 0; i < 4; ++i) {
      int d = lane * 4 + 256 * i;
      float4 g = *(const float4*)(ng + d);
      float4 sh = *(const float4*)(md + d);
      float4 sc = *(const float4*)(md + 1024 + d);
      float a0 = v[i].x * rstd * g.x * (1.f + sc.x) + sh.x;
      float a1 = v[i].y * rstd * g.y * (1.f + sc.y) + sh.y;
      float a2 = v[i].z * rstd * g.z * (1.f + sc.z) + sh.z;
      float a3 = v[i].w * rstd * g.w * (1.f + sc.w) + sh.w;
      uint2 o; o.x = pack2(a0, a1); o.y = pack2(a2, a3);
      *(uint2*)(p.h + (size_t)tok * LDH + d) = o;
    }
  }
}

DI void gemm_core(const bfu* __restrict__ A, int lda, const bfu* __restrict__ B, int ldb, int K, char* smem,
                  f32x16 (&acc)[2][2]) {
  const int tid = tid_(), lane = tid & 63, w = tid >> 6, wm = w >> 1, wn = w & 1;
  const int c8 = tid & 7, r0 = tid >> 3;
  const bfu* ga = A + (size_t)r0 * lda + c8 * 8;
  const bfu* gb = B + (size_t)r0 * ldb + c8 * 8;
  const int st_off = r0 * 128 + ((c8 ^ ((r0 >> 1) & 7)) * 16);
  const int fr = lane & 31, hh = lane >> 5, fsw = (fr >> 1) & 7;
  const int a_base = (wm * 64 + fr) * 128;
  const int b_base = 16384 + (wn * 64 + fr) * 128;
  uint4 ra0, ra1, ra2, ra3, rb0, rb1, rb2, rb3, qa0, qa1, qa2, qa3, qb0, qb1, qb2, qb3;
  const int KT = K >> 6;
#define GEMM_LOADT(RA, RB, tile)                                                           \
  {                                                                                        \
    const int t_ = (tile) < KT ? (tile) : KT - 1;                                          \
    const bfu* ga_ = ga + t_ * 64; const bfu* gb_ = gb + t_ * 64;                          \
    RA##0 = *(const uint4*)(ga_);                        RB##0 = *(const uint4*)(gb_);                        \
    RA##1 = *(const uint4*)(ga_ + (size_t)32 * lda);     RB##1 = *(const uint4*)(gb_ + (size_t)32 * ldb);     \
    RA##2 = *(const uint4*)(ga_ + (size_t)64 * lda);     RB##2 = *(const uint4*)(gb_ + (size_t)64 * ldb);     \
    RA##3 = *(const uint4*)(ga_ + (size_t)96 * lda);     RB##3 = *(const uint4*)(gb_ + (size_t)96 * ldb);     \
  }
#define GEMM_STORET(buf, RA, RB)                                                           \
  {                                                                                        \
    *(uint4*)((buf) + st_off) = RA##0;          *(uint4*)((buf) + 16384 + st_off) = RB##0;          \
    *(uint4*)((buf) + st_off + 4096) = RA##1;   *(uint4*)((buf) + 16384 + st_off + 4096) = RB##1;   \
    *(uint4*)((buf) + st_off + 8192) = RA##2;   *(uint4*)((buf) + 16384 + st_off + 8192) = RB##2;   \
    *(uint4*)((buf) + st_off + 12288) = RA##3;  *(uint4*)((buf) + 16384 + st_off + 12288) = RB##3;  \
  }
#define GEMM_COMPUTE(cur)                                                                  \
  _Pragma("unroll") for (int s = 0; s < 4; ++s) {                                          \
    const int co = ((2 * s + hh) ^ fsw) * 16;                                              \
    bf16x8 a0 = *(const bf16x8*)((cur) + a_base + co);                                     \
    bf16x8 a1 = *(const bf16x8*)((cur) + a_base + 4096 + co);                              \
    bf16x8 b0 = *(const bf16x8*)((cur) + b_base + co);                                     \
    bf16x8 b1 = *(const bf16x8*)((cur) + b_base + 4096 + co);                              \
    acc[0][0] = __builtin_amdgcn_mfma_f32_32x32x16_bf16(a0, b0, acc[0][0], 0, 0, 0);       \
    acc[0][1] = __builtin_amdgcn_mfma_f32_32x32x16_bf16(a0, b1, acc[0][1], 0, 0, 0);       \
    acc[1][0] = __builtin_amdgcn_mfma_f32_32x32x16_bf16(a1, b0, acc[1][0], 0, 0, 0);       \
    acc[1][1] = __builtin_amdgcn_mfma_f32_32x32x16_bf16(a1, b1, acc[1][1], 0, 0, 0);       \
  }
  GEMM_LOADT(ra, rb, 0)
  GEMM_LOADT(qa, qb, 1)
  GEMM_STORET(smem, ra, rb)
  __syncthreads();
#pragma unroll 1
  for (int kt = 0; kt < KT; kt += 2) {
    GEMM_LOADT(ra, rb, kt + 2)
    __builtin_amdgcn_sched_barrier(0);
    GEMM_COMPUTE(smem)
    __builtin_amdgcn_sched_barrier(0);
    GEMM_STORET(smem + 32768, qa, qb)
    __syncthreads();
    GEMM_LOADT(qa, qb, kt + 3)
    __builtin_amdgcn_sched_barrier(0);
    GEMM_COMPUTE(smem + 32768)
    __builtin_amdgcn_sched_barrier(0);
    GEMM_STORET(smem, ra, rb)
    __syncthreads();
  }
}

DI void acc_zero(f32x16 (&acc)[2][2]) {
#pragma unroll
  for (int i = 0; i < 2; ++i)
#pragma unroll
    for (int j = 0; j < 2; ++j)
#pragma unroll
      for (int r = 0; r < 16; ++r) acc[i][j][r] = 0.f;
}

DI void acc_to_lds(const f32x16 (&acc)[2][2], char* smem) {
  float* sf = (float*)smem;
  const int tid = tid_(), lane = tid & 63, w = tid >> 6;
  const int rb = (w >> 1) * 64 + 4 * (lane >> 5), cb = (w & 1) * 64 + (lane & 31);
#pragma unroll
  for (int i = 0; i < 2; ++i)
#pragma unroll
    for (int j = 0; j < 2; ++j)
#pragma unroll
      for (int r = 0; r < 16; ++r)
        sf[(rb + i * 32 + (r & 3) + 8 * (r >> 2)) * 128 + cb + j * 32] = acc[i][j][r];
}
DI void unpack8(const uint4 v, float (&f)[8]) {
  f[0] = __uint_as_float(v.x << 16); f[1] = __uint_as_float(v.x & 0xffff0000u);
  f[2] = __uint_as_float(v.y << 16); f[3] = __uint_as_float(v.y & 0xffff0000u);
  f[4] = __uint_as_float(v.z << 16); f[5] = __uint_as_float(v.z & 0xffff0000u);
  f[6] = __uint_as_float(v.w << 16); f[7] = __uint_as_float(v.w & 0xffff0000u);
}
DI uint4 pack8(const float (&f)[8]) {
  uint4 o;
  o.x = pack2(f[0], f[1]); o.y = pack2(f[2], f[3]); o.z = pack2(f[4], f[5]); o.w = pack2(f[6], f[7]);
  return o;
}
#define EPI_LDS(...)                                                             \
  {                                                                              \
    acc_to_lds(acc, smem);                                                       \
    __syncthreads();                                                             \
    _Pragma("unroll 1") for (int it_ = 0; it_ < 8; ++it_) {                      \
      const int row = (tid_() >> 4) + 16 * it_;                             \
      const int c0 = (tid_() & 15) * 8;                                     \
      float v[8];                                                                \
      {                                                                          \
        const float4 t0 = *(const float4*)(smem + (row * 128 + c0) * 4);         \
        const float4 t1 = *(const float4*)(smem + (row * 128 + c0 + 4) * 4);     \
        v[0] = t0.x; v[1] = t0.y; v[2] = t0.z; v[3] = t0.w;                      \
        v[4] = t1.x; v[5] = t1.y; v[6] = t1.z; v[7] = t1.w;                      \
      }                                                                          \
      __VA_ARGS__                                                                \
    }                                                                            \
    __syncthreads();                                                             \
  }

typedef __attribute__((ext_vector_type(4))) float f32x4;
constexpr int G_BK = 64, G_HALF = 128, G_HT = G_HALF * G_BK;
DI int g_lds_byte(int r, int c) {
  int st = (r >> 4) * 2 + (c >> 5), rr = r & 15, cc = c & 31, ob = rr * 64 + cc * 2;
  return st * 1024 + (ob ^ (((ob >> 9) & 1) << 5));
}
DI void g_stage_rc(int b, int& R, int& C) {
  int st = b / 1024, sb = b % 1024, swz = sb ^ (((sb >> 9) & 1) << 5);
  R = (st >> 1) * 16 + swz / 64; C = (st & 1) * 32 + (swz % 64) / 2;
}
DI const char* g_uniform(const char* ptr) {
  unsigned long long u = (unsigned long long)ptr;
  unsigned lo = __builtin_amdgcn_readfirstlane((unsigned)u), hi = __builtin_amdgcn_readfirstlane((unsigned)(u >> 32));
  return (const char*)(((unsigned long long)hi << 32) | lo);
}
DI void gemm256(const bfu* __restrict__ A, int lda, const bfu* __restrict__ Bt, int ldb, int K, int brow, int bcol,
                bfu* shm, f32x4 (&acc)[2][2][4][2]) {
#define G_SA(b, h) (shm + ((b) * 2 + (h)) * G_HT)
#define G_SB(b, h) (shm + (4 + (b) * 2 + (h)) * G_HT)
#define G_STAGE(P, BASE, LD, br, kt)                                                                   \
  do {                                                                                                 \
    const char* _u = g_uniform((const char*)((BASE) + ((long)(br) * (LD) + (long)(kt) * G_BK)));       \
    __builtin_amdgcn_global_load_lds((const unsigned*)(_u + soff_b),                                   \
        (__attribute__((address_space(3))) unsigned*)((char*)(P) + ldst), 16, 0, 0);                   \
    __builtin_amdgcn_global_load_lds((const unsigned*)(_u + 128 * (long)(LD) + soff_b),                \
        (__attribute__((address_space(3))) unsigned*)((char*)(P) + ldst + 8192), 16, 0, 0);            \
  } while (0)
#define G_LDA(dst, b, h) for (int m = 0; m < 4; ++m) for (int k = 0; k < 2; ++k) \
    dst[m][k] = *reinterpret_cast<const bf16x8*>((char*)G_SA(b, h) + a_rd + m * 2048 + k * 1024)
#define G_LDB(dst, b, h) for (int n = 0; n < 2; ++n) for (int k = 0; k < 2; ++k) \
    dst[n][k] = *reinterpret_cast<const bf16x8*>((char*)G_SB(b, h) + b_rd + n * 2048 + k * 1024)
#define G_MMA(ai, bj, At, Bt_)                                                                         \
  do {                                                                                                 \
    __builtin_amdgcn_s_setprio(1);                                                                     \
    for (int m = 0; m < 4; ++m) for (int n = 0; n < 2; ++n) for (int k = 0; k < 2; ++k)                \
      acc[ai][bj][m][n] = __builtin_amdgcn_mfma_f32_16x16x32_bf16(At[m][k], Bt_[n][k], acc[ai][bj][m][n], 0, 0, 0); \
    __builtin_amdgcn_s_setprio(0);                                                                     \
  } while (0)
#define G_WAIT_V(n) asm volatile("s_waitcnt vmcnt(" #n ")" ::: "memory")
#define G_WAIT_L(n) asm volatile("s_waitcnt lgkmcnt(" #n ")" ::: "memory")
#define G_BAR __builtin_amdgcn_s_barrier()
#define G_SCHED __builtin_amdgcn_sched_barrier(0)
  int t512 = threadIdx.x; asm volatile("" : "+v"(t512));
  const int wid = __builtin_amdgcn_readfirstlane(t512 >> 6), lane = t512 & 63, wr = wid >> 2, wc = wid & 3, fr = lane & 15, fq = lane >> 4;
  const int ldst = t512 * 16;
  unsigned soff_b;
  {
    int R0, C0;
    g_stage_rc(ldst, R0, C0);
    soff_b = (unsigned)(R0 * lda + C0) * 2u;
  }
  const int lane_off = (fr * 64 + fq * 16) ^ ((fr >> 3) << 5);
  const int a_rd = wr * 8192 + lane_off, b_rd = wc * 4096 + lane_off;
  bf16x8 At[4][2], B0[2][2], B1[2][2];
  const int nt = K / G_BK;
  G_STAGE(G_SB(0, 0), Bt, ldb, bcol, 0); G_STAGE(G_SA(0, 0), A, lda, brow, 0);
  G_STAGE(G_SB(0, 1), Bt, ldb, bcol + G_HALF, 0); G_STAGE(G_SA(0, 1), A, lda, brow + G_HALF, 0);
  if (wr == 1) G_BAR;
  G_WAIT_V(4); G_BAR;
  G_STAGE(G_SB(1, 0), Bt, ldb, bcol, 1); G_STAGE(G_SA(1, 0), A, lda, brow, 1); G_STAGE(G_SB(1, 1), Bt, ldb, bcol + G_HALF, 1);
  G_WAIT_V(6); G_BAR;
#pragma unroll 1
  for (int t = 0; t < nt - 2; t += 2) {
    G_LDB(B0, 0, 0); G_SCHED; G_LDA(At, 0, 0); G_STAGE(G_SA(1, 1), A, lda, brow + G_HALF, t + 1);
    G_WAIT_L(8); G_BAR; G_WAIT_L(0); G_MMA(0, 0, At, B0); G_BAR; G_SCHED;
    G_LDB(B1, 0, 1); G_STAGE(G_SB(0, 0), Bt, ldb, bcol, t + 2);
    G_BAR; G_WAIT_L(0); G_MMA(0, 1, At, B1); G_BAR;
    G_LDA(At, 0, 1); G_STAGE(G_SA(0, 0), A, lda, brow, t + 2);
    G_BAR; G_WAIT_L(0); G_MMA(1, 0, At, B0); G_BAR; G_SCHED;
    G_STAGE(G_SB(0, 1), Bt, ldb, bcol + G_HALF, t + 2);
    G_WAIT_V(6); G_BAR; G_MMA(1, 1, At, B1); G_BAR;
    G_LDB(B0, 1, 0); G_SCHED; G_LDA(At, 1, 0); G_STAGE(G_SA(0, 1), A, lda, brow + G_HALF, t + 2);
    G_WAIT_L(8); G_BAR; G_WAIT_L(0); G_MMA(0, 0, At, B0); G_BAR; G_SCHED;
    G_LDB(B1, 1, 1); G_STAGE(G_SB(1, 0), Bt, ldb, bcol, t + 3);
    G_BAR; G_WAIT_L(0); G_MMA(0, 1, At, B1); G_BAR;
    G_LDA(At, 1, 1); G_STAGE(G_SA(1, 0), A, lda, brow, t + 3);
    G_BAR; G_WAIT_L(0); G_MMA(1, 0, At, B0); G_BAR; G_SCHED;
    G_STAGE(G_SB(1, 1), Bt, ldb, bcol + G_HALF, t + 3);
    G_WAIT_V(6); G_BAR; G_MMA(1, 1, At, B1); G_BAR;
  }
  { G_LDB(B0, 0, 0); G_LDA(At, 0, 0); G_STAGE(G_SA(1, 1), A, lda, brow + G_HALF, nt - 1);
    G_BAR; G_WAIT_L(0); G_MMA(0, 0, At, B0); G_BAR;
    G_LDB(B1, 0, 1); G_BAR; G_WAIT_L(0); G_MMA(0, 1, At, B1); G_BAR;
    G_LDA(At, 0, 1); G_WAIT_V(4); G_BAR; G_WAIT_L(0); G_MMA(1, 0, At, B0); G_MMA(1, 1, At, B1); G_BAR; }
  { G_LDB(B0, 1, 0); G_LDA(At, 1, 0); G_WAIT_V(2); G_BAR; G_WAIT_L(0); G_MMA(0, 0, At, B0); G_BAR;
    G_LDB(B1, 1, 1); G_WAIT_V(0); G_BAR; G_WAIT_L(0); G_MMA(0, 1, At, B1); G_BAR;
    G_LDA(At, 1, 1); G_BAR; G_WAIT_L(0); G_MMA(1, 0, At, B0); G_MMA(1, 1, At, B1); G_BAR; }
  if (wr == 0) G_BAR;
}
DI void acc256_zero(f32x4 (&acc)[2][2][4][2]) {
#pragma unroll
  for (int a = 0; a < 2; ++a)
#pragma unroll
    for (int b = 0; b < 2; ++b)
#pragma unroll
      for (int m = 0; m < 4; ++m)
#pragma unroll
        for (int n = 0; n < 2; ++n) acc[a][b][m][n] = (f32x4){0.f, 0.f, 0.f, 0.f};
}
#define EPI256(...)                                                                                   \
  {                                                                                                    \
    int t512_ = threadIdx.x; asm volatile("" : "+v"(t512_));     \
    const int wid_ = t512_ >> 6, lane_ = t512_ & 63, wr_ = wid_ >> 2, wc_ = wid_ & 3,                  \
              fr_ = lane_ & 15, fq_ = lane_ >> 4;                                                      \
    float* sf_ = (float*)smem;                                                                         \
    _Pragma("unroll") for (int ai_ = 0; ai_ < 2; ++ai_) {                                              \
      __syncthreads();                                                                                 \
      _Pragma("unroll") for (int bj_ = 0; bj_ < 2; ++bj_)                                              \
      _Pragma("unroll") for (int m_ = 0; m_ < 4; ++m_)                                                 \
      _Pragma("unroll") for (int n_ = 0; n_ < 2; ++n_)                                                 \
      _Pragma("unroll") for (int j_ = 0; j_ < 4; ++j_)                                                 \
        sf_[(wr_ * 64 + m_ * 16 + fq_ * 4 + j_) * 256 + ((bj_ * 128 + wc_ * 32 + n_ * 16 + fr_) ^ (fq_ << 4))] = \
            acc[ai_][bj_][m_][n_][j_];                                                                 \
      __syncthreads();                                                                                 \
      _Pragma("unroll 1") for (int it_ = 0; it_ < 8; ++it_) {                                          \
        const int idx_ = t512_ + 512 * it_;                                                            \
        const int rl_ = idx_ >> 5, c0 = (idx_ & 31) * 8;                                               \
        const int row = ai_ * 128 + rl_;                                                               \
        float v[8];                                                                                    \
        {                                                                                              \
          const float* sp_ = sf_ + rl_ * 256 + (c0 ^ (((rl_ >> 2) & 3) << 4));                          \
          const float4 t0 = *(const float4*)sp_; const float4 t1 = *(const float4*)(sp_ + 4);          \
          v[0] = t0.x; v[1] = t0.y; v[2] = t0.z; v[3] = t0.w;                                          \
          v[4] = t1.x; v[5] = t1.y; v[6] = t1.z; v[7] = t1.w;                                          \
        }                                                                                              \
        __VA_ARGS__                                                                                    \
      }                                                                                                \
    }                                                                                                  \
    __syncthreads();                                                                                   \
  }

template <int MT, int NT, int BH>
DI bool xcd_tile(int iter, int& mt, int& nt) {
  constexpr int MPX = MT / 8, TPX = MPX * NT;
  const int xcd = VXCD, j = VJ, nloc = VNLOC;
  const int q = j + iter * nloc;
  if (q >= TPX) return false;
  const int band = q / (BH * NT), r = q % (BH * NT);
  nt = r / BH;
  mt = xcd * MPX + band * BH + (r % BH);
  return true;
}

DI bool tile256(int iter, int NT, int& mt, int& nt) {
  const int xcd = blockIdx.x & 7, j = blockIdx.x >> 3, nloc = gridDim.x >> 3;
  const int q = j + iter * nloc;
  if (q >= 6 * NT) return false;
  nt = q / 6; mt = xcd * 6 + q % 6;
  return true;
}
DI void phase_gemm_in(const Params& p, int l, char* smem) {
  const bfu* W = p.w_inT + (size_t)l * DINP * LDH;
  for (int iter = 0;; ++iter) {
    int mt, nt;
    if (!tile256(iter, 19, mt, nt)) break;
    f32x4 acc[2][2][4][2];
    acc256_zero(acc);
    gemm256(p.h, LDH, W, LDH, 1024, mt * 256, nt * 256, (bfu*)smem, acc);
    const int m0 = mt * 256, n0 = nt * 256;
    EPI256({
      const int n = n0 + c0;
      if (n < 512) *(uint4*)(p.ug + ((size_t)(n >> 4) * NTOK + (m0 + row)) * 16 + (n & 15)) = pack8(v);
      else if (n < DIN) *(uint4*)(p.proj + (size_t)(m0 + row) * PW + (n - 512)) = pack8(v);
    })
  }
}

DI void s5_gen_item(const Params& p, int l, int item, char* smem) {
  const int tid = tid_();
  const int g = item >> 3, r = item & 7;
  float* sBr = (float*)smem;
  float* sBi = sBr + 2048;
  float* sCr = sBi + 2048;
  float* sCi = sCr + 1024;
  float* sAK = sCi + 1024;
  float* sAE = sAK + 1024;
  float* sAG = sAE + 1024;
  float* sK = sAG + 1024;
  bfu* E = p.opE + (size_t)g * 256 * 512;
  bfu* MG = p.opMG + (size_t)g * 512 * 768;
  __syncthreads();
  if (tid < 128) {
    const int d = tid >> 6, pp = tid & 63;
    const size_t pi = ((size_t)(l * 2 + d) * 32 + g) * 64 + pp;
    const float lr = p.lam_re[pi], li = p.lam_im[pi];
    const float dt = expf(p.log_dt[(l * 2 + d) * 32 + g]);
    const float mag = expf(lr * dt);
    float sn, cs;
    sincosf(li * dt, &sn, &cs);
    const float are = mag * cs, aim = mag * sn;
    const float nr = are - 1.f, ni = aim, den = lr * lr + li * li;
    const float kr = (nr * lr + ni * li) / den, ki = (ni * lr - nr * li) / den;
#pragma unroll
    for (int c = 0; c < 16; ++c) {
      float br = p.b_re[((size_t)(l * 32 + g) * 64 + pp) * 16 + c];
      float bi = p.b_im[((size_t)(l * 32 + g) * 64 + pp) * 16 + c];
      sBr[(d * 64 + pp) * 16 + c] = kr * br - ki * bi;
      sBi[(d * 64 + pp) * 16 + c] = kr * bi + ki * br;
    }
#pragma unroll
    for (int q = 0; q < 4; ++q) {
      const int t = 4 * r + q;
      const int nK = t;
      const int nE = d == 0 ? 31 - t : t;
      const int nG = d == 0 ? t + 1 : 32 - t;
      float m, s_, c_;
      m = expf(lr * dt * (float)nK); sincosf(li * dt * (float)nK, &s_, &c_);
      sAK[((d * 4 + q) * 64 + pp) * 2] = m * c_; sAK[((d * 4 + q) * 64 + pp) * 2 + 1] = m * s_;
      m = expf(lr * dt * (float)nE); sincosf(li * dt * (float)nE, &s_, &c_);
      sAE[((d * 4 + q) * 64 + pp) * 2] = m * c_; sAE[((d * 4 + q) * 64 + pp) * 2 + 1] = m * s_;
      m = expf(lr * dt * (float)nG); sincosf(li * dt * (float)nG, &s_, &c_);
      sAG[((d * 4 + q) * 64 + pp) * 2] = m * c_; sAG[((d * 4 + q) * 64 + pp) * 2 + 1] = m * s_;
    }
  } else {
    for (int idx = tid - 128; idx < 1024; idx += 128) {
      sCr[idx] = p.c_re[(size_t)(l * 32 + g) * 1024 + idx];
      sCi[idx] = p.c_im[(size_t)(l * 32 + g) * 1024 + idx];
    }
  }
  __syncthreads();
  for (int idx = tid; idx < 256 * 64; idx += 256) {
    const int row = idx >> 6, cc = idx & 63, q = cc >> 4, c = cc & 15;
    const int part = row >> 6, pp = row & 63, d = part >> 1;
    const float ar = sAE[((d * 4 + q) * 64 + pp) * 2], ai = sAE[((d * 4 + q) * 64 + pp) * 2 + 1];
    const float br = sBr[(d * 64 + pp) * 16 + c], bi = sBi[(d * 64 + pp) * 16 + c];
    const float v = (part & 1) ? (ar * bi + ai * br) : (ar * br - ai * bi);
    E[(size_t)row * 512 + (4 * r + q) * 16 + c] = f2bf(v);
  }
  for (int idx = tid; idx < 64 * 256; idx += 256) {
    const int rr = idx >> 8, col = idx & 255, q = rr >> 4, c = rr & 15;
    const int part = col >> 6, pp = col & 63, d = part >> 1;
    const float ar = sAG[((d * 4 + q) * 64 + pp) * 2], ai = sAG[((d * 4 + q) * 64 + pp) * 2 + 1];
    const float cr = sCr[c * 64 + pp], ci = sCi[c * 64 + pp];
    const float v = (part & 1) ? -(cr * ai + ci * ar) : (cr * ar - ci * ai);
    MG[(size_t)((4 * r + q) * 16 + c) * 768 + 512 + col] = f2bf(v);
  }
  {
    const int d = tid >> 7, q = (tid >> 5) & 3, c = (tid >> 1) & 15, ch = tid & 1;
    float acc[8];
#pragma unroll
    for (int e = 0; e < 8; ++e) acc[e] = 0.f;
    for (int pp = 0; pp < 64; ++pp) {
      const float ar = sAK[((d * 4 + q) * 64 + pp) * 2], ai = sAK[((d * 4 + q) * 64 + pp) * 2 + 1];
      const float cr = sCr[c * 64 + pp], ci = sCi[c * 64 + pp];
      const float wr = cr * ar - ci * ai, wi = cr * ai + ci * ar;
#pragma unroll
      for (int e = 0; e < 8; ++e)
        acc[e] += wr * sBr[(d * 64 + pp) * 16 + ch * 8 + e] - wi * sBi[(d * 64 + pp) * 16 + ch * 8 + e];
    }
#pragma unroll
    for (int e = 0; e < 8; ++e) sK[((d * 4 + q) * 16 + c) * 16 + ch * 8 + e] = acc[e];
  }
  __syncthreads();
  for (int idx = tid; idx < 8192; idx += 256) {
    const int ch = idx & 1, c = (idx >> 1) & 15, tp = (idx >> 5) & 31, q = (idx >> 10) & 3, d = idx >> 12;
    const int tau = 4 * r + q;
    int sp;
    bool valid;
    if (d == 0) { sp = tp - tau; valid = sp >= 0; } else { sp = tp + tau; valid = (sp <= 31) && (tau > 0); }
    if (valid) {
      float v[8];
#pragma unroll
      for (int e = 0; e < 8; ++e) {
        float x = sK[((d * 4 + q) * 16 + c) * 16 + ch * 8 + e];
        if (tau == 0) x += sK[((1 * 4 + q) * 16 + c) * 16 + ch * 8 + e];
        v[e] = x;
      }
      *(uint4*)(MG + (size_t)(tp * 16 + c) * 768 + sp * 16 + ch * 8) = pack8(v);
    }
  }
  __syncthreads();
}

DI void phase_s5_gen(const Params& p, int l, char* smem) {
  for (int it = NVB - 1 - VBID; it < 256; it += NVB) s5_gen_item(p, l, it, smem);
}

DI void phase_s5_e(const Params& p, char* smem) {
  for (int q = VJ; q < 24; q += VNLOC) {
    const int g = VXCD * 4 + q / 6, r6 = q % 6, mt = r6 >> 1, nt = r6 & 1;
    f32x16 acc[2][2];
    acc_zero(acc);
    gemm_core(p.ug + ((size_t)g * NCHUNK + mt * 128) * 512, 512, p.opE + ((size_t)g * 256 + nt * 128) * 512, 512, 512,
              smem, acc);
    EPI_LDS({
      float* dst = p.ebuf + ((size_t)g * NCHUNK + mt * 128 + row) * 256 + nt * 128 + c0;
      *(float4*)dst = make_float4(v[0], v[1], v[2], v[3]);
      *(float4*)(dst + 4) = make_float4(v[4], v[5], v[6], v[7]);
    })
  }
}

DI void phase_s5_scan(const Params& p, int l) {
  const int tid = tid_();
  for (int it = VBID; it < 320; it += NVB) {
    const int wi = it * 2 + (tid >> 7);
    const int dir = (tid >> 6) & 1, pp = tid & 63;
    int chunk0, n, b, g;
    bool prompt;
    if (wi < 128) { b = wi >> 5; g = wi & 31; chunk0 = (NPROMPT + b * 2048) >> 5; n = 64; prompt = false; }
    else { int q = wi - 128; b = q >> 5; g = q & 31; chunk0 = (b * 256) >> 5; n = 8; prompt = true; }
    const size_t pi = ((size_t)(l * 2 + dir) * 32 + g) * 64 + pp;
    const float lr = p.lam_re[pi], li = p.lam_im[pi];
    const float dt = expf(p.log_dt[(l * 2 + dir) * 32 + g]);
    const float mag = expf(lr * dt * 32.f);
    float sn, cs;
    sincosf(li * dt * 32.f, &sn, &cs);
    const float are = mag * cs, aim = mag * sn;
    float hre = 0.f, him = 0.f;
    if (!prompt) {
      size_t si = ((size_t)((b * 2 + l) * 2 + dir)) * 2048 + g * 64 + pp;
      hre = p.st_re[si]; him = p.st_im[si];
    }
    const float* eb = p.ebuf + ((size_t)g * NCHUNK + chunk0) * 256 + dir * 128 + pp;
    bfu* cb = p.carry + ((size_t)g * NCHUNK + chunk0) * 256 + dir * 128 + pp;
    for (int k0 = 0; k0 < n; k0 += 8) {
      float er[8], ei[8];
#pragma unroll
      for (int j = 0; j < 8; ++j) {
        const int k = dir == 0 ? k0 + j : n - 1 - (k0 + j);
        er[j] = eb[(size_t)k * 256];
        ei[j] = eb[(size_t)k * 256 + 64];
      }
#pragma unroll
      for (int j = 0; j < 8; ++j) {
        const int k = dir == 0 ? k0 + j : n - 1 - (k0 + j);
        cb[(size_t)k * 256] = f2bf(hre);
        cb[(size_t)k * 256 + 64] = f2bf(him);
        const float nre = are * hre - aim * him + er[j];
        const float nim = are * him + aim * hre + ei[j];
        hre = nre; him = nim;
      }
    }
    if (prompt) {
      size_t oi = ((size_t)((b * 2 + l) * 2 + dir)) * 2048 + g * 64 + pp;
      p.out[OUT_RE + oi] = hre;
      p.out[OUT_IM + oi] = him;
    }
  }
}

DI void phase_s5_y(const Params& p, int l, char* smem) {
  for (int q = VJ; q < 48; q += VNLOC) {
    const int g = VXCD * 4 + q / 12, r12 = q % 12, mt = r12 >> 2, nt = r12 & 3;
    f32x16 acc[2][2];
    acc_zero(acc);
    const bfu* Bm = p.opMG + ((size_t)g * 512 + nt * 128) * 768;
    gemm_core(p.ug + ((size_t)g * NCHUNK + mt * 128) * 512, 512, Bm, 768, 512, smem, acc);
    gemm_core(p.carry + ((size_t)g * NCHUNK + mt * 128) * 256, 256, Bm + 512, 768, 256, smem, acc);
    EPI_LDS({
      const int chunk = mt * 128 + row, nn = nt * 128 + c0, tp = nn >> 4, c = nn & 15;
      const int tok = chunk * 32 + tp;
      float u[8], o[8];
      unpack8(*(const uint4*)(p.ug + ((size_t)g * NTOK + tok) * 16 + c), u);
      const float* dsk = p.s5_d + l * 512 + g * 16 + c;
      _Pragma("unroll") for (int e = 0; e < 8; ++e) o[e] = geluf_(v[e] + dsk[e] * u[e]);
      *(uint4*)(p.ys5 + (size_t)tok * 512 + g * 16 + c) = pack8(o);
    })
  }
}

DI void phase_glu(const Params& p, int l, char* smem) {
  const bfu* W = p.w_gluT + (size_t)l * 512 * 512;
  for (int iter = 0;; ++iter) {
    int mt, nt;
    if (!xcd_tile<96, 4, 12>(iter, mt, nt)) break;
    f32x16 acc[2][2];
    acc_zero(acc);
    gemm_core(p.ys5 + (size_t)mt * 128 * 512, 512, W + (size_t)nt * 128 * 512, 512, 512, smem, acc);
    const int m0 = mt * 128, n0 = nt * 128;
    EPI_LDS({
      const int n = n0 + c0;
      const size_t tk = (size_t)(m0 + row);
      float y[8], ga[8], o[8];
      unpack8(*(const uint4*)(p.ys5 + tk * 512 + n), y);
      unpack8(*(const uint4*)(p.proj + tk * PW + OFF_GA + n), ga);
      const float* bg = p.b_glu + l * 512 + n;
      _Pragma("unroll") for (int e = 0; e < 8; ++e) o[e] = y[e] * sigmoidf_(v[e] + bg[e]) * siluf_(ga[e]);
      *(uint4*)(p.ya + tk * 512 + n) = pack8(o);
    })
  }
}

constexpr int GL_QS = 0;
constexpr int GL_KS = GL_QS + 32 * 144;
constexpr int GL_KHT = GL_KS + 32 * 144;
constexpr int GL_VT = GL_KHT + 64 * 80;
constexpr int GL_PS = GL_VT + 128 * 80;
constexpr int GL_ST = GL_PS + 32 * 80;
constexpr int GL_AV = GL_ST + 128 * 144;
constexpr int GL_TOT = GL_AV + 256;
constexpr int GL_OS = GL_TOT + 1024;
static_assert(GL_OS + 32 * 132 * 4 <= 65536, "gla lds");

DI void gla_segment_info(int seg, int& tok_base, bool& prompt, int& b, int& sidx) {
  if (seg < 16) { prompt = true; b = seg; sidx = 0; tok_base = seg * 256; }
  else { int q = seg - 16; prompt = false; b = q >> 3; sidx = q & 7; tok_base = NPROMPT + b * 2048 + sidx * 256; }
}

template <bool STATE_ONLY>
DI void gla_chain(const Params& p, int l, char* smem, int seg, int hd, int dir) {
  const int tid = tid_(), lane = tid & 63, w = tid >> 6;
  const int fr = lane & 31, hh = lane >> 5;
  int tok_base, b, sidx;
  bool prompt;
  gla_segment_info(seg, tok_base, prompt, b, sidx);
  const int dk = tid & 63, tq = tid >> 6;
  const int dvl = tid & 127, th = tid >> 7;
  float wg[16];
#pragma unroll
  for (int q = 0; q < 16; ++q) wg[q] = p.wg_up[((size_t)(l * 2 + dir) * 16 + q) * 256 + hd * 64 + dk];
  const float bgv = p.bg[(l * 2 + dir) * 256 + hd * 64 + dk];
  float* sAv = (float*)(smem + GL_AV);
  float* sTot = (float*)(smem + GL_TOT);
  float* sOs = (float*)(smem + GL_OS);

  f32x16 S[2];
  {
    const int dvc = 32 * w + fr;
    if (STATE_ONLY || prompt) {
#pragma unroll
      for (int mt = 0; mt < 2; ++mt)
#pragma unroll
        for (int r = 0; r < 16; ++r) S[mt][r] = 0.f;
    } else {
      const float* sp = p.st_gla + ((size_t)(((b * 2 + l) * 2 + dir) * 4 + hd)) * 8192;
#pragma unroll
      for (int mt = 0; mt < 2; ++mt)
#pragma unroll
        for (int r = 0; r < 16; ++r) S[mt][r] = sp[(32 * mt + (r & 3) + 8 * (r >> 2) + 4 * hh) * 128 + dvc];
      const int nprev = dir == 0 ? sidx : 7 - sidx;
      for (int q = 0; q < nprev; ++q) {
        const int sprev = dir == 0 ? q : 7 - q;
        const size_t ci = (size_t)(((b * 8 + sprev) * 4 + hd) * 2 + dir);
        const float* sl = p.gla_sloc + ci * 8192;
        const float* al = p.gla_aseg + ci * 64;
#pragma unroll
        for (int mt = 0; mt < 2; ++mt)
#pragma unroll
          for (int r = 0; r < 16; ++r) {
            const int dkk = 32 * mt + (r & 3) + 8 * (r >> 2) + 4 * hh;
            S[mt][r] = al[dkk] * S[mt][r] + sl[dkk * 128 + dvc];
          }
      }
    }
  }
  float bsum = 0.f;
  __syncthreads();
  if (!STATE_ONLY) {
    const int dvc = 32 * w + fr;
#pragma unroll
    for (int mt = 0; mt < 2; ++mt)
#pragma unroll
      for (int q = 0; q < 4; ++q) {
        uint2 pk;
        pk.x = pack2(S[mt][4 * q], S[mt][4 * q + 1]);
        pk.y = pack2(S[mt][4 * q + 2], S[mt][4 * q + 3]);
        *(uint2*)(smem + GL_ST + dvc * 144 + (32 * mt + 8 * q + 4 * hh) * 2) = pk;
      }
  }

  uint4 rq = make_uint4(0, 0, 0, 0), rk = rq, rv0 = rq, rv1 = rq, rgl = rq;
#define GLA_ISSUE(nn)                                                                                         \
  {                                                                                                           \
    const int cn_ = dir == 0 ? (nn) : 7 - (nn);                                                               \
    const int c0_ = tok_base + cn_ * 32;                                                                      \
    const int tA = dir == 0 ? (tid >> 3) : 31 - (tid >> 3);                                                   \
    const bfu* prA = p.proj + (size_t)(c0_ + tA) * PW + hd * 64 + (tid & 7) * 8;                              \
    if (!STATE_ONLY) rq = *(const uint4*)(prA + OFF_Q);                                                       \
    rk = *(const uint4*)(prA + OFF_K);                                                                        \
    const int tV0 = dir == 0 ? (tid >> 4) : 31 - (tid >> 4);                                                  \
    const int tV1 = dir == 0 ? (tid >> 4) + 16 : 15 - (tid >> 4);                                             \
    rv0 = *(const uint4*)(p.proj + (size_t)(c0_ + tV0) * PW + OFF_V + hd * 128 + (tid & 15) * 8);             \
    rv1 = *(const uint4*)(p.proj + (size_t)(c0_ + tV1) * PW + OFF_V + hd * 128 + (tid & 15) * 8);             \
    if (tid < 64) {                                                                                           \
      const int tG = dir == 0 ? (tid >> 1) : 31 - (tid >> 1);                                                 \
      rgl = *(const uint4*)(p.proj + (size_t)(c0_ + tG) * PW + OFF_GL + (tid & 1) * 8);                       \
    }                                                                                                         \
  }
  GLA_ISSUE(0)
  char* rawQ = smem + GL_OS;
  char* rawK = smem + GL_OS + 4096;
  char* rawV = smem + GL_OS + 8192;
  char* rawG = smem + GL_PS;

#pragma unroll 1
  for (int n = 0; n < 8; ++n) {
    const int cn = dir == 0 ? n : 7 - n;
    const int ctok0 = tok_base + cn * 32;
    __syncthreads();
    if (!STATE_ONLY) *(uint4*)(rawQ + (tid >> 3) * 128 + (tid & 7) * 16) = rq;
    *(uint4*)(rawK + (tid >> 3) * 128 + (tid & 7) * 16) = rk;
    *(uint4*)(rawV + (tid >> 4) * 256 + (tid & 15) * 16) = rv0;
    *(uint4*)(rawV + ((tid >> 4) + 16) * 256 + (tid & 15) * 16) = rv1;
    if (tid < 64) *(uint4*)(rawG + (tid >> 1) * 32 + (tid & 1) * 16) = rgl;
    if (n + 1 < 8) GLA_ISSUE(n + 1)
    __syncthreads();
    float qv[8], kv[8], bl[8];
    {
      float run = 0.f;
#pragma unroll
      for (int i = 0; i < 8; ++i) {
        const int tau = tq * 8 + i;
        if (!STATE_ONLY) qv[i] = bf2f(*(const bfu*)(rawQ + tau * 128 + dk * 2)) * 0.125f;
        kv[i] = bf2f(*(const bfu*)(rawK + tau * 128 + dk * 2));
        float gl[16];
        unpack8(*(const uint4*)(rawG + tau * 32), *(float(*)[8])&gl[0]);
        unpack8(*(const uint4*)(rawG + tau * 32 + 16), *(float(*)[8])&gl[8]);
        float lg = bgv;
#pragma unroll
        for (int q = 0; q < 16; ++q) lg += gl[q] * wg[q];
        const float ls = fminf(lg, 0.f) - __logf(1.f + __expf(-fabsf(lg)));
        run += ls * (1.f / 16.f);
        bl[i] = run;
      }
      sTot[tq * 64 + dk] = run;
    }
    {
      unsigned pk[8];
#pragma unroll
      for (int i = 0; i < 8; ++i) {
        const int tau0 = th * 16 + 2 * i;
        const unsigned lo = *(const bfu*)(rawV + tau0 * 256 + dvl * 2);
        const unsigned hi = *(const bfu*)(rawV + (tau0 + 1) * 256 + dvl * 2);
        pk[i] = lo | (hi << 16);
      }
      *(uint4*)(smem + GL_VT + dvl * 80 + th * 32) = make_uint4(pk[0], pk[1], pk[2], pk[3]);
      *(uint4*)(smem + GL_VT + dvl * 80 + th * 32 + 16) = make_uint4(pk[4], pk[5], pk[6], pk[7]);
    }
    __syncthreads();
    {
      float off = 0.f, total = 0.f;
#pragma unroll
      for (int q = 0; q < 4; ++q) {
        const float tv = sTot[q * 64 + dk];
        total += tv;
        off += (q < tq) ? tv : 0.f;
      }
      unsigned kh[4];
      float khv[8];
#pragma unroll
      for (int i = 0; i < 8; ++i) {
        const float bb = off + bl[i];
        const int tau = tq * 8 + i;
        if (!STATE_ONLY) {
          *(bfu*)(smem + GL_QS + tau * 144 + dk * 2) = f2bf(qv[i] * __expf(bb));
          *(bfu*)(smem + GL_KS + tau * 144 + dk * 2) = f2bf(kv[i] * __expf(-bb));
        }
        khv[i] = kv[i] * __expf(total - bb);
      }
#pragma unroll
      for (int i = 0; i < 4; ++i) kh[i] = pack2(khv[2 * i], khv[2 * i + 1]);
      *(uint4*)(smem + GL_KHT + dk * 80 + tq * 16) = make_uint4(kh[0], kh[1], kh[2], kh[3]);
      if (tq == 0) { sAv[dk] = __expf(total); bsum += total; }
    }
    __syncthreads();
    f32x16 o;
    if (!STATE_ONLY) {
      f32x16 sc;
#pragma unroll
      for (int r = 0; r < 16; ++r) sc[r] = 0.f;
#pragma unroll
      for (int s4 = 0; s4 < 4; ++s4) {
        bf16x8 a = *(const bf16x8*)(smem + GL_QS + fr * 144 + (16 * s4 + 8 * hh) * 2);
        bf16x8 bq = *(const bf16x8*)(smem + GL_KS + fr * 144 + (16 * s4 + 8 * hh) * 2);
        sc = __builtin_amdgcn_mfma_f32_32x32x16_bf16(a, bq, sc, 0, 0, 0);
      }
#pragma unroll
      for (int rr = 0; rr < 4; ++rr) {
        float val = w == 0 ? sc[rr] : (w == 1 ? sc[4 + rr] : (w == 2 ? sc[8 + rr] : sc[12 + rr]));
        const int i = rr + 8 * w + 4 * hh;
        val = (fr <= i) ? val : 0.f;
        *(bfu*)(smem + GL_PS + i * 80 + fr * 2) = f2bf(val);
      }
      __syncthreads();
#pragma unroll
      for (int r = 0; r < 16; ++r) o[r] = 0.f;
    }
    {
      const int dvc = 32 * w + fr;
      bf16x8 vb0 = *(const bf16x8*)(smem + GL_VT + dvc * 80 + (8 * hh) * 2);
      bf16x8 vb1 = *(const bf16x8*)(smem + GL_VT + dvc * 80 + (16 + 8 * hh) * 2);
      if (!STATE_ONLY) {
        bf16x8 pa0 = *(const bf16x8*)(smem + GL_PS + fr * 80 + (8 * hh) * 2);
        bf16x8 pa1 = *(const bf16x8*)(smem + GL_PS + fr * 80 + (16 + 8 * hh) * 2);
        o = __builtin_amdgcn_mfma_f32_32x32x16_bf16(pa0, vb0, o, 0, 0, 0);
        o = __builtin_amdgcn_mfma_f32_32x32x16_bf16(pa1, vb1, o, 0, 0, 0);
#pragma unroll
        for (int s4 = 0; s4 < 4; ++s4) {
          bf16x8 a = *(const bf16x8*)(smem + GL_QS + fr * 144 + (16 * s4 + 8 * hh) * 2);
          bf16x8 sb = *(const bf16x8*)(smem + GL_ST + dvc * 144 + (16 * s4 + 8 * hh) * 2);
          o = __builtin_amdgcn_mfma_f32_32x32x16_bf16(a, sb, o, 0, 0, 0);
        }
      }
#pragma unroll
      for (int mt = 0; mt < 2; ++mt) {
        f32x16 U;
#pragma unroll
        for (int r = 0; r < 16; ++r) U[r] = 0.f;
        bf16x8 ka0 = *(const bf16x8*)(smem + GL_KHT + (32 * mt + fr) * 80 + (8 * hh) * 2);
        bf16x8 ka1 = *(const bf16x8*)(smem + GL_KHT + (32 * mt + fr) * 80 + (16 + 8 * hh) * 2);
        U = __builtin_amdgcn_mfma_f32_32x32x16_bf16(ka0, vb0, U, 0, 0, 0);
        U = __builtin_amdgcn_mfma_f32_32x32x16_bf16(ka1, vb1, U, 0, 0, 0);
#pragma unroll
        for (int q = 0; q < 4; ++q) {
          const float4 av = *(const float4*)(sAv + 32 * mt + 8 * q + 4 * hh);
          S[mt][4 * q + 0] = av.x * S[mt][4 * q + 0] + U[4 * q + 0];
          S[mt][4 * q + 1] = av.y * S[mt][4 * q + 1] + U[4 * q + 1];
          S[mt][4 * q + 2] = av.z * S[mt][4 * q + 2] + U[4 * q + 2];
          S[mt][4 * q + 3] = av.w * S[mt][4 * q + 3] + U[4 * q + 3];
          if (!STATE_ONLY) {
            uint2 pk;
            pk.x = pack2(S[mt][4 * q], S[mt][4 * q + 1]);
            pk.y = pack2(S[mt][4 * q + 2], S[mt][4 * q + 3]);
            *(uint2*)(smem + GL_ST + dvc * 144 + (32 * mt + 8 * q + 4 * hh) * 2) = pk;
          }
        }
      }
      if (!STATE_ONLY) {
#pragma unroll
        for (int r = 0; r < 16; ++r) sOs[((r & 3) + 8 * (r >> 2) + 4 * hh) * 132 + dvc] = o[r];
      }
    }
    __syncthreads();
    if (!STATE_ONLY) {
      const int t = tid >> 3, part = tid & 7;
      const int tau = dir == 0 ? t : 31 - t;
      const size_t tok = (size_t)(ctok0 + t);
      float ov[16];
#pragma unroll
      for (int q = 0; q < 4; ++q) {
        const float4 x = *(const float4*)(sOs + tau * 132 + part * 16 + 4 * q);
        ov[4 * q] = x.x; ov[4 * q + 1] = x.y; ov[4 * q + 2] = x.z; ov[4 * q + 3] = x.w;
      }
      bfu* op = p.gla_o + ((size_t)dir * NTOK + tok) * 512 + hd * 128 + part * 16;
      *(uint4*)op = pack8(*(float(*)[8])&ov[0]);
      *(uint4*)(op + 8) = pack8(*(float(*)[8])&ov[8]);
    }
  }
  const int dvc = 32 * w + fr;
  if (STATE_ONLY) {
    const size_t ci = (size_t)(((b * 8 + sidx) * 4 + hd) * 2 + dir);
    float* sl = p.gla_sloc + ci * 8192;
#pragma unroll
    for (int mt = 0; mt < 2; ++mt)
#pragma unroll
      for (int r = 0; r < 16; ++r) sl[(32 * mt + (r & 3) + 8 * (r >> 2) + 4 * hh) * 128 + dvc] = S[mt][r];
    if (tq == 0) p.gla_aseg[ci * 64 + dk] = __expf(bsum);
  } else if (prompt) {
    float* op = p.out + OUT_GLA + ((size_t)(((b * 2 + l) * 2 + dir) * 4 + hd)) * 8192;
#pragma unroll
    for (int mt = 0; mt < 2; ++mt)
#pragma unroll
      for (int r = 0; r < 16; ++r) op[(32 * mt + (r & 3) + 8 * (r >> 2) + 4 * hh) * 128 + dvc] = S[mt][r];
  }
  __syncthreads();
}

DI void phase_gla_pass1(const Params& p, int l, char* smem) {
  for (int it = NVB - 1 - VBID; it < 256; it += NVB) {
    const int dir = it & 1, hd = (it >> 1) & 3, seg = 16 + (it >> 3);
    gla_chain<true>(p, l, smem, seg, hd, dir);
  }
}
DI void phase_gla_main(const Params& p, int l, char* smem) {
  for (int it = NVB - 1 - VBID; it < 384; it += NVB) {
    const int dir = it & 1, hd = (it >> 1) & 3, seg = it >> 3;
    gla_chain<false>(p, l, smem, seg, hd, dir);
  }
}
DI void phase_gla_norm(const Params& p, int l) {
  const int tid = tid_(), lane = tid & 63, w = tid >> 6;
  for (int it = VBID; it < NTOK / 4; it += NVB) {
    const int tok = it * 4 + w;
    float a[8], b[8], gt[8], res[8];
    unpack8(*(const uint4*)(p.gla_o + (size_t)tok * 512 + lane * 8), a);
    unpack8(*(const uint4*)(p.gla_o + ((size_t)NTOK + tok) * 512 + lane * 8), b);
    unpack8(*(const uint4*)(p.proj + (size_t)tok * PW + OFF_GB + lane * 8), gt);
    float ss = 0.f;
#pragma unroll
    for (int e = 0; e < 8; ++e) { a[e] += b[e]; ss += a[e] * a[e]; }
    ss += __shfl_xor(ss, 1); ss += __shfl_xor(ss, 2); ss += __shfl_xor(ss, 4); ss += __shfl_xor(ss, 8);
    const float rs = rsqrtf(ss * (1.f / 128.f) + EPS);
    const float* g = p.gla_norm_g + l * 512 + lane * 8;
#pragma unroll
    for (int e = 0; e < 8; ++e) res[e] = a[e] * rs * g[e] * siluf_(gt[e]);
    *(uint4*)(p.yb + (size_t)tok * 512 + lane * 8) = pack8(res);
  }
}

DI void phase_merge(const Params& p, int l, char* smem) {
  const bfu* WA = p.w_paT + (size_t)l * 1024 * 512;
  const bfu* WB = p.w_pbT + (size_t)l * 1024 * 512;
  for (int iter = 0;; ++iter) {
    int mt, nt;
    if (!tile256(iter, 4, mt, nt)) break;
    const int m0 = mt * 256, n0 = nt * 256;
    f32x4 acc[2][2][4][2];
    acc256_zero(acc);
    gemm256(p.ya, 512, WA, 512, 512, m0, n0, (bfu*)smem, acc);
    EPI256({
      float ma[8], o[8];
      unpack8(*(const uint4*)(p.proj + (size_t)(m0 + row) * PW + OFF_MA + n0 + c0), ma);
      _Pragma("unroll") for (int e = 0; e < 8; ++e) o[e] = sigmoidf_(ma[e]) * v[e];
      *(uint4*)(p.merged + (size_t)(m0 + row) * D + n0 + c0) = pack8(o);
    })
    acc256_zero(acc);
    gemm256(p.yb, 512, WB, 512, 512, m0, n0, (bfu*)smem, acc);
    EPI256({
      float mb[8], o[8], pr[8];
      unpack8(*(const uint4*)(p.proj + (size_t)(m0 + row) * PW + OFF_MB + n0 + c0), mb);
      uint4* mp = (uint4*)(p.merged + (size_t)(m0 + row) * D + n0 + c0);
      unpack8(*mp, pr);
      _Pragma("unroll") for (int e = 0; e < 8; ++e) o[e] = pr[e] + sigmoidf_(mb[e]) * v[e];
      *mp = pack8(o);
    })
  }
}

DI void phase_out(const Params& p, int l, char* smem) {
  const bfu* W = p.w_oT + (size_t)l * 1024 * 1024;
  for (int iter = 0;; ++iter) {
    int mt, nt;
    if (!tile256(iter, 4, mt, nt)) break;
    const int m0 = mt * 256, n0 = nt * 256;
    f32x4 acc[2][2][4][2];
    acc256_zero(acc);
    gemm256(p.merged, D, W, 1024, 1024, m0, n0, (bfu*)smem, acc);
    const float* gate = p.mod + (size_t)(l * 5 + cond_of_tok(m0)) * 3072 + 2048;
    EPI256({
      float* xp = p.out + (size_t)(m0 + row) * D + n0 + c0;
      const float* gp = gate + n0 + c0;
      float4 x0 = *(const float4*)xp, x1 = *(const float4*)(xp + 4);
      const float4 g0 = *(const float4*)gp, g1 = *(const float4*)(gp + 4);
      x0.x += g0.x * v[0]; x0.y += g0.y * v[1]; x0.z += g0.z * v[2]; x0.w += g0.w * v[3];
      x1.x += g1.x * v[4]; x1.y += g1.y * v[5]; x1.z += g1.z * v[6]; x1.w += g1.w * v[7];
      *(float4*)xp = x0; *(float4*)(xp + 4) = x1;
    })
  }
}

DI void phase_final(const Params& p) {
  const int tid = tid_(), lane = tid & 63, w = tid >> 6;
  for (int it = VBID; it < NTOK / 4; it += NVB) {
    const int tok = it * 4 + w;
    float* xs = p.out + (size_t)tok * D;
    float4 v[4];
#pragma unroll
    for (int i = 0; i < 4; ++i) v[i] = *(const float4*)(xs + lane * 4 + 256 * i);
    float ss = 0.f;
#pragma unroll
    for (int i = 0; i < 4; ++i) ss += v[i].x * v[i].x + v[i].y * v[i].y + v[i].z * v[i].z + v[i].w * v[i].w;
    ss = wave_sum(ss);
    const float rstd = rsqrtf(ss * (1.f / 1024.f) + EPS);
#pragma unroll
    for (int i = 0; i < 4; ++i) {
      float4 g = *(const float4*)(p.final_g + lane * 4 + 256 * i);
      float4 o;
      o.x = v[i].x * rstd * g.x; o.y = v[i].y * rstd * g.y; o.z = v[i].z * rstd * g.z; o.w = v[i].w * rstd * g.w;
      *(float4*)(xs + lane * 4 + 256 * i) = o;
    }
  }
}

#define XB_TMO      128
#define XB_XCNT(j)  (256  + 64 * (j))
#define XB_XSUB(j)  (1280 + 64 * (j))
#define XB_XGEN(j)  (2304 + 64 * (j))
#define XB_TOP      3328
#define XB_TOPGEN   3392
#define XCD_BAR_WORDS 3456
#define XB_SPIN_CAP (1u << 18)
#define LAS __attribute__((address_space(3)))
DI unsigned xb_ld(unsigned* p) { return __hip_atomic_load(p, __ATOMIC_RELAXED, __HIP_MEMORY_SCOPE_AGENT); }
DI unsigned xb_add(unsigned* p, unsigned v) { return __hip_atomic_fetch_add(p, v, __ATOMIC_RELAXED, __HIP_MEMORY_SCOPE_AGENT); }
DI unsigned xb_xcc_id() { return (unsigned)__builtin_amdgcn_s_getreg((3 << 11) | 20) & 0xFu; }
#define XB_SPIN(cond, bar) do { unsigned _sp = 0; while (cond) { __builtin_amdgcn_s_sleep(1); \
    if ((++_sp & 255u) == 0u) { if (xb_ld(&(bar)[XB_TMO])) break; if (_sp > XB_SPIN_CAP) { atomicAdd(&(bar)[XB_TMO], 1u); break; } } } } while (0)
struct XcdBarrier { unsigned* bar; unsigned x; volatile LAS unsigned* st; };
DI XcdBarrier xcd_barrier_post(unsigned* bar, volatile LAS unsigned* st) {
  XcdBarrier b; b.bar = bar; b.x = xb_xcc_id(); b.st = st;
  if (threadIdx.x == 0) (void)xb_add(&bar[XB_XCNT(b.x)], 1u);
  return b;
}
DI void xcd_barrier_complete(unsigned* bar, unsigned x, unsigned& nloc, unsigned& nx) {
  const unsigned G = gridDim.x * gridDim.y * gridDim.z;
  unsigned sum, cnt, mine, sp = 0u;
  for (;;) {
    sum = 0u; cnt = 0u; mine = 0u;
#pragma unroll
    for (unsigned j = 0; j < 16; ++j) { const unsigned c = xb_ld(&bar[XB_XCNT(j)]); sum += c; cnt += (c > 0u) ? 1u : 0u; mine = (j == x) ? c : mine; }
    if (sum == G) break;
    __builtin_amdgcn_s_sleep(1);
    if ((++sp & 255u) == 0u) { if (xb_ld(&bar[XB_TMO])) break; if (sp > XB_SPIN_CAP) { atomicAdd(&bar[XB_TMO], 1u); break; } }
  }
  nloc = mine > 0u ? mine : 1u; nx = cnt > 0u ? cnt : 1u;
}
DI void xcd_barrier(const XcdBarrier& b) {
  asm volatile("s_waitcnt vmcnt(0)" ::: "memory");
  __syncthreads();
  if (threadIdx.x == 0) {
    unsigned* bar = b.bar;
    __builtin_amdgcn_s_waitcnt(0);
    unsigned nloc = b.st[0], nx = b.st[1];
    if (nloc == 0u) { xcd_barrier_complete(bar, b.x, nloc, nx); b.st[0] = nloc; b.st[1] = nx; }
    const unsigned old = xb_add(&bar[XB_XSUB(b.x)], 1u);
    const unsigned gen = old / nloc;
    if (old + 1u == (gen + 1u) * nloc) {
      __builtin_amdgcn_fence(__ATOMIC_RELEASE, "agent");
      asm volatile("s_waitcnt vmcnt(0)" ::: "memory");
      const unsigned og = xb_add(&bar[XB_TOP], 1u);
      const unsigned tg = og / nx;
      if (og + 1u == (tg + 1u) * nx) xb_add(&bar[XB_TOPGEN], 1u);
      else XB_SPIN(xb_ld(&bar[XB_TOPGEN]) == tg, bar);
      __builtin_amdgcn_fence(__ATOMIC_ACQUIRE, "agent");
      xb_add(&bar[XB_XGEN(b.x)], 1u);
      asm volatile("s_waitcnt vmcnt(0)" ::: "memory");
    } else {
      XB_SPIN(xb_ld(&bar[XB_XGEN(b.x)]) == gen, bar);
      __builtin_amdgcn_fence(__ATOMIC_ACQUIRE, "agent");
      asm volatile("s_waitcnt vmcnt(0)" ::: "memory");
    }
  }
  __syncthreads();
}

#ifndef REP_SYNC
#define REP_SYNC 0
#endif
__global__ void __launch_bounds__(512, 2) k_mega(Params p) {
  extern __shared__ __attribute__((aligned(16))) char smem_all[];
  cg::grid_group grid = cg::this_grid();
  char* smem = smem_all;
#define smh (smem_all + VHALF * 65536)
  volatile LAS unsigned* xst = (volatile LAS unsigned*)(smem_all + 131072);
  if (threadIdx.x < 4) xst[threadIdx.x] = 0u;
  __syncthreads();
  XcdBarrier xb = xcd_barrier_post(p.bar, xst);
#define GSYNC() xcd_barrier(xb)
  phase_prep(p, smh);
  phase_s5_gen(p, 0, smh);
  grid.sync();
  for (int l = 0; l < 2; ++l) {
    phase_h(p, l);
    GSYNC();
    phase_gemm_in(p, l, smem);
    GSYNC();
    phase_s5_e(p, smh);
    phase_gla_pass1(p, l, smh);
    GSYNC();
    phase_s5_scan(p, l);
    phase_gla_main(p, l, smh);
    GSYNC();
    phase_s5_y(p, l, smh);
    phase_gla_norm(p, l);
    GSYNC();
    phase_glu(p, l, smh);
    GSYNC();
    phase_merge(p, l, smem);
    if (l == 0 && (blockIdx.x >> 3) >= 24) {
      const int hb = (int)((((blockIdx.x >> 3) - 24) * 8 + (blockIdx.x & 7)) * 2) + VHALF;
      s5_gen_item(p, 1, hb, smh);
      s5_gen_item(p, 1, hb + 128, smh);
    }
    GSYNC();
    phase_out(p, l, smem);
    GSYNC();
    for (int rep = 0; rep < REP_SYNC; ++rep) GSYNC();
  }
  phase_final(p);
}

extern "C" void kernel_launch(void* const* d_in, const int* in_sizes, int n_in, void* d_out, int out_size,
                              void* d_ws, size_t ws_size, hipStream_t stream) {
  Params p{};
  const float* const* in = (const float* const*)d_in;
  p.x_prompt = in[0]; p.x_sample = in[1]; p.c = in[2]; p.st_re = in[3]; p.st_im = in[4]; p.st_gla = in[5];
  p.c_ctx = in[6]; p.norm_g = in[7]; p.w_mod = in[8]; p.b_mod = in[9]; p.w_in = in[10]; p.wg_up = in[11];
  p.bg = in[12]; p.gla_norm_g = in[13]; p.lam_re = in[14]; p.lam_im = in[15]; p.log_dt = in[16];
  p.b_re = in[17]; p.b_im = in[18]; p.c_re = in[19]; p.c_im = in[20]; p.s5_d = in[21]; p.w_glu = in[22];
  p.b_glu = in[23]; p.w_pa = in[24]; p.w_pb = in[25]; p.w_o = in[26]; p.final_g = in[27];
  p.out = (float*)d_out;
  char* ws = (char*)d_ws;
  size_t off = 0;
  auto take = [&](size_t bytes) { char* r = ws + off; off += (bytes + 255) & ~(size_t)255; return r; };
  p.w_inT = (bfu*)take((size_t)2 * DINP * LDH * 2);
  p.w_gluT = (bfu*)take((size_t)2 * 512 * 512 * 2);
  p.w_paT = (bfu*)take((size_t)2 * 1024 * 512 * 2);
  p.w_pbT = (bfu*)take((size_t)2 * 1024 * 512 * 2);
  p.w_oT = (bfu*)take((size_t)2 * 1024 * 1024 * 2);
  p.mod = (float*)take((size_t)2 * 5 * 3072 * 4);
  p.pos_r = (float*)take((size_t)32 * 512 * 4);
  p.pos_c = (float*)take((size_t)64 * 512 * 4);
  p.h = (bfu*)take((size_t)NTOK * LDH * 2);
  p.proj = (bfu*)take((size_t)NTOK * PW * 2);
  p.ys5 = (bfu*)take((size_t)NTOK * 512 * 2);
  p.ya = (bfu*)take((size_t)NTOK * 512 * 2);
  p.yb = (bfu*)take((size_t)NTOK * 512 * 2);
  p.merged = (bfu*)take((size_t)NTOK * D * 2);
  p.tmp_s5 = nullptr;
  p.ebuf = (float*)p.merged;
  p.carry = (bfu*)((char*)p.merged + (size_t)32 * NCHUNK * 256 * 4);
  p.ug = (bfu*)take((size_t)32 * NTOK * 16 * 2);
  p.opMG = (bfu*)take((size_t)32 * 512 * 768 * 2);
  p.opE = (bfu*)take((size_t)32 * 256 * 512 * 2);
  p.gla_sloc = (float*)p.ys5;
  p.gla_aseg = (float*)((char*)p.ys5 + (size_t)256 * 8192 * 4);
  if (off > ws_size) fprintf(stderr, "workspace too small: %zu > %zu\n", off, ws_size);
  p.bar = (unsigned*)take((size_t)XCD_BAR_WORDS * 4);
  p.gla_o = (bfu*)p.h;
  p.tmp_gla = (float*)p.h;
  constexpr size_t kLds = 131072 + 16;
  static int grid_blocks = 0;
  if (!grid_blocks) {
    int dev = 0, cus = 0, per_cu = 0;
    hipGetDevice(&dev);
    hipDeviceGetAttribute(&cus, hipDeviceAttributeMultiprocessorCount, dev);
    hipFuncSetAttribute((const void*)k_mega, hipFuncAttributeMaxDynamicSharedMemorySize, (int)kLds);
    hipOccupancyMaxActiveBlocksPerMultiprocessor(&per_cu, k_mega, 512, kLds);
    if (per_cu > 1) per_cu = 1;
    grid_blocks = cus * per_cu;
    if (grid_blocks % 8 != 0 || grid_blocks <= 0) fprintf(stderr, "unexpected grid %d\n", grid_blocks);
  }
  hipMemsetAsync(p.bar, 0, (size_t)XCD_BAR_WORDS * 4, stream);
  void* args[] = {&p};
  hipError_t e = hipLaunchCooperativeKernel((void*)k_mega, dim3(grid_blocks), dim3(512), args, kLds, stream);
  if (e != hipSuccess) fprintf(stderr, "cooperative launch failed: %s (grid %d)\n", hipGetErrorString(e), grid_blocks);
}
```

```cpp
#include <hip/hip_runtime.h>
#include <hip/hip_cooperative_groups.h>
#include <stdint.h>
#include <math.h>
#include <stdio.h>
namespace cg = cooperative_groups;

#ifndef REP_PREP
#define REP_PREP 0
#endif
#ifndef REP_GIN
#define REP_GIN 0
#endif
#ifndef REP_X1
#define REP_X1 0
#endif
#ifndef REP_X2
#define REP_X2 0
#endif
#ifndef REP_Y
#define REP_Y 0
#endif
#ifndef REP_MERGE
#define REP_MERGE 0
#endif
#ifndef REP_SYNC
#define REP_SYNC 0
#endif
#ifndef ONE_LAUNCH
#define ONE_LAUNCH 1
#endif

typedef unsigned short bfu;
typedef __attribute__((ext_vector_type(8))) short bf16x8;
typedef __attribute__((ext_vector_type(16))) float f32x16;
typedef __attribute__((ext_vector_type(2))) __bf16 bf2_t;
typedef __attribute__((ext_vector_type(2))) float f2_t;

#define DI __device__ __forceinline__

constexpr int D = 1024;
constexpr int NTOK = 12288;
constexpr int NPROMPT = 4096;
constexpr int DIN = 4624;
constexpr int DINP = 4864;
constexpr int LDH = 1088;
constexpr int PW = 4112;
constexpr int OFF_GA = 0, OFF_Q = 512, OFF_K = 768, OFF_V = 1024, OFF_GB = 1536, OFF_GL = 2048,
              OFF_MA = 2064, OFF_MB = 3088;
constexpr int NCHUNK = NTOK / 32;
constexpr size_t OUT_RE = (size_t)NTOK * D;
constexpr size_t OUT_IM = OUT_RE + 131072;
constexpr size_t OUT_GLA = OUT_IM + 131072;
constexpr float EPS = 1e-6f;

struct Params {
  const float *x_prompt, *x_sample, *c, *st_re, *st_im, *st_gla, *c_ctx, *norm_g, *w_mod, *b_mod, *w_in,
      *wg_up, *bg, *gla_norm_g, *lam_re, *lam_im, *log_dt, *b_re, *b_im, *c_re, *c_im, *s5_d, *w_glu,
      *b_glu, *w_pa, *w_pb, *w_o, *final_g;
  float* out;
  bfu *w_inT, *w_gluT, *w_paT, *w_pbT, *w_oT;
  float *mod, *pos_r, *pos_c, *tmp_s5, *tmp_gla;
  bfu *h, *proj, *ys5, *ya, *yb, *merged;
  bfu *ug, *opMG, *opE, *carry;
  float *ebuf, *gla_sloc, *gla_aseg;
  unsigned* bar;
  bfu* gla_o;
};

DI int tid_() { int t = threadIdx.x & 255; asm volatile("" : "+v"(t)); return t; }
#define VHALF ((int)__builtin_amdgcn_readfirstlane((int)(threadIdx.x >> 8)))
#define VBID ((int)(blockIdx.x * 2 + VHALF))
#define NVB ((int)(gridDim.x * 2))
#define VXCD ((int)(blockIdx.x & 7))
#define VJ ((int)((blockIdx.x >> 3) * 2 + VHALF))
#define VNLOC ((int)((gridDim.x >> 3) * 2))
DI float bf2f(bfu v) { return __uint_as_float(((unsigned)v) << 16); }
DI bfu f2bf(float x) { __bf16 b = (__bf16)x; return __builtin_bit_cast(unsigned short, b); }
DI unsigned pack2(float lo, float hi) {
  f2_t v = {lo, hi};
  bf2_t w = __builtin_convertvector(v, bf2_t);
  return __builtin_bit_cast(unsigned, w);
}
DI float sigmoidf_(float x) { return 1.f / (1.f + __expf(-x)); }
DI float siluf_(float x) { return x / (1.f + __expf(-x)); }
DI float geluf_(float x) {
  float u = 0.7978845608028654f * (x + 0.044715f * x * x * x);
  float t = 1.f - 2.f / (__expf(2.f * u) + 1.f);
  return 0.5f * x * (1.f + t);
}
DI float wave_sum(float v) {
#pragma unroll
  for (int o = 32; o >= 1; o >>= 1) v += __shfl_xor(v, o);
  return v;
}
DI int cond_of_tok(int tok) { return tok < NPROMPT ? 0 : 1 + ((tok - NPROMPT) >> 11); }

DI void transpose_tile(const float* __restrict__ src, int K, int N, bfu* __restrict__ dst, int kt, int nt,
                       float* sm, int ldd = 0) {
  if (ldd == 0) ldd = K;
  const int tid = tid_(), c = tid & 63, r4 = tid >> 6;
  const int k0 = kt * 64, n0 = nt * 64;
#pragma unroll 4
  for (int i = 0; i < 16; ++i) {
    int k = i * 4 + r4, n = n0 + c;
    sm[k * 65 + c] = (n < N) ? src[(size_t)(k0 + k) * N + n] : 0.f;
  }
  __syncthreads();
#pragma unroll 4
  for (int i = 0; i < 16; ++i) {
    int n = i * 4 + r4;
    dst[(size_t)(n0 + n) * ldd + k0 + c] = f2bf(sm[c * 65 + n]);
  }
  __syncthreads();
}

DI void phase_prep(const Params& p, char* smem) {
  float* sm = (float*)smem;
  const int tid = tid_();
  for (int it = VBID; it < 96; it += NVB) {
    const int l = it / 48, jb = it % 48;
    float* ssil = sm;
    float* sred = sm + 5 * 1024;
    for (int idx = tid; idx < 5120; idx += 256) {
      int ci = idx >> 10, k = idx & 1023;
      float cv = (ci == 0) ? p.c_ctx[k] : p.c[(ci - 1) * 1024 + k];
      ssil[idx] = cv / (1.f + expf(-cv));
    }
    __syncthreads();
    const int jj = tid & 63, kq = tid >> 6;
    const int j = jb * 64 + jj;
    float acc[5] = {0.f, 0.f, 0.f, 0.f, 0.f};
    const float* wp = p.w_mod + ((size_t)l * 1024 + kq * 256) * 3072 + j;
#pragma unroll 8
    for (int k = 0; k < 256; ++k) {
      float w = wp[(size_t)k * 3072];
#pragma unroll
      for (int ci = 0; ci < 5; ++ci) acc[ci] += ssil[ci * 1024 + kq * 256 + k] * w;
    }
#pragma unroll
    for (int ci = 0; ci < 5; ++ci) sred[(kq * 5 + ci) * 64 + jj] = acc[ci];
    __syncthreads();
    for (int idx = tid; idx < 320; idx += 256) {
      int ci = idx >> 6, j2 = idx & 63;
      float s = p.b_mod[l * 3072 + jb * 64 + j2];
#pragma unroll
      for (int q = 0; q < 4; ++q) s += sred[(q * 5 + ci) * 64 + j2];
      p.mod[(size_t)(l * 5 + ci) * 3072 + jb * 64 + j2] = s;
    }
    __syncthreads();
  }
  for (int idx = VBID * 256 + tid; idx < 96 * 512; idx += NVB * 256) {
    int r = idx >> 9, i = idx & 511;
    int pos = r < 32 ? r : r - 32;
    int q = i & 255;
    double f = exp(-log(10000.0) * (double)q / 256.0);
    double ang = (double)pos * f;
    float v = (float)((i < 256) ? sin(ang) : cos(ang));
    if (r < 32) p.pos_r[r * 512 + i] = v; else p.pos_c[(r - 32) * 512 + i] = v;
  }
  for (int it = VBID; it < 3584; it += NVB) {
    int l = it / 1792, r = it % 1792;
    if (r < 1216) {
      transpose_tile(p.w_in + (size_t)l * 1024 * DIN, 1024, DIN, p.w_inT + (size_t)l * DINP * LDH, r % 16, r / 16, sm, LDH);
    } else if (r < 1280) {
      r -= 1216;
      transpose_tile(p.w_glu + (size_t)l * 512 * 512, 512, 512, p.w_gluT + (size_t)l * 512 * 512, r % 8, r / 8, sm);
    } else if (r < 1408) {
      r -= 1280;
      transpose_tile(p.w_pa + (size_t)l * 512 * 1024, 512, 1024, p.w_paT + (size_t)l * 1024 * 512, r % 8, r / 8, sm);
    } else if (r < 1536) {
      r -= 1408;
      transpose_tile(p.w_pb + (size_t)l * 512 * 1024, 512, 1024, p.w_pbT + (size_t)l * 1024 * 512, r % 8, r / 8, sm);
    } else {
      r -= 1536;
      transpose_tile(p.w_o + (size_t)l * 1024 * 1024, 1024, 1024, p.w_oT + (size_t)l * 1024 * 1024, r % 16, r / 16, sm);
    }
  }
}

DI void phase_h(const Params& p, int l) {
  const int tid = tid_(), lane = tid & 63, w = tid >> 6;
  for (int it = VBID; it < NTOK / 4; it += NVB) {
    const int tok = it * 4 + w;
    float4 v[4];
    float* xs = p.out + (size_t)tok * D;
    if (l == 0) {
      const float* src = tok < NPROMPT ? p.x_prompt + (size_t)tok * D : p.x_sample + (size_t)(tok - NPROMPT) * D;
#pragma unroll
      for (int i = 0; i < 4; ++i) v[i] = *(const float4*)(src + lane * 4 + 256 * i);
      if (tok >= NPROMPT) {
        int t = (tok - NPROMPT) & 2047, row = t >> 6, col = t & 63;
#pragma unroll
        for (int i = 0; i < 4; ++i) {
          int d = lane * 4 + 256 * i;
          const float* pe = d < 512 ? p.pos_r + row * 512 + d : p.pos_c + col * 512 + (d - 512);
          float4 e = *(const float4*)pe;
          v[i].x += e.x; v[i].y += e.y; v[i].z += e.z; v[i].w += e.w;
        }
      }
#pragma unroll
      for (int i = 0; i < 4; ++i) *(float4*)(xs + lane * 4 + 256 * i) = v[i];
    } else {
#pragma unroll
      for (int i = 0; i < 4; ++i) v[i] = *(const float4*)(xs + lane * 4 + 256 * i);
    }
    float ss = 0.f;
#pragma unroll
    for (int i = 0; i < 4; ++i) ss += v[i].x * v[i].x + v[i].y * v[i].y + v[i].z * v[i].z + v[i].w * v[i].w;
    ss = wave_sum(ss);
    const float rstd = rsqrtf(ss * (1.f / 1024.f) + EPS);
    const float* md = p.mod + (size_t)(l * 5 + cond_of_tok(tok)) * 3072;
    const float* ng = p.norm_g + l * 1024;
#pragma unroll
    for (int i = 0; i < 4; ++i) {
      int d = lane * 4 + 256 * i;
      float4 g = *(const float4*)(ng + d);
      float4 sh = *(const float4*)(md + d);
      float4 sc = *(const float4*)(md + 1024 + d);
      float a0 = v[i].x * rstd * g.x * (1.f + sc.x) + sh.x;
      float a1 = v[i].y * rstd * g.y * (1.f + sc.y) + sh.y;
      float a2 = v[i].z * rstd * g.z * (1.f + sc.z) + sh.z;
      float a3 = v[i].w * rstd * g.w * (1.f + sc.w) + sh.w;
      uint2 o; o.x = pack2(a0, a1); o.y = pack2(a2, a3);
      *(uint2*)(p.h + (size_t)tok * LDH + d) = o;
    }
  }
}

DI void gemm_core(const bfu* __restrict__ A, int lda, const bfu* __restrict__ B, int ldb, int K, char* smem,
                  f32x16 (&acc)[2][2]) {
  const int tid = tid_(), lane = tid & 63, w = tid >> 6, wm = w >> 1, wn = w & 1;
  const int c8 = tid & 7, r0 = tid >> 3;
  const bfu* ga = A + (size_t)r0 * lda + c8 * 8;
  const bfu* gb = B + (size_t)r0 * ldb + c8 * 8;
  const int st_off = r0 * 128 + ((c8 ^ ((r0 >> 1) & 7)) * 16);
  const int fr = lane & 31, hh = lane >> 5, fsw = (fr >> 1) & 7;
  const int a_base = (wm * 64 + fr) * 128;
  const int b_base = 16384 + (wn * 64 + fr) * 128;
  uint4 ra0, ra1, ra2, ra3, rb0, rb1, rb2, rb3, qa0, qa1, qa2, qa3, qb0, qb1, qb2, qb3;
  const int KT = K >> 6;
#define GEMM_LOADT(RA, RB, tile)                                                           \
  {                                                                                        \
    const int t_ = (tile) < KT ? (tile) : KT - 1;                                          \
    const bfu* ga_ = ga + t_ * 64; const bfu* gb_ = gb + t_ * 64;                          \
    RA##0 = *(const uint4*)(ga_);                        RB##0 = *(const uint4*)(gb_);                        \
    RA##1 = *(const uint4*)(ga_ + (size_t)32 * lda);     RB##1 = *(const uint4*)(gb_ + (size_t)32 * ldb);     \
    RA##2 = *(const uint4*)(ga_ + (size_t)64 * lda);     RB##2 = *(const uint4*)(gb_ + (size_t)64 * ldb);     \
    RA##3 = *(const uint4*)(ga_ + (size_t)96 * lda);     RB##3 = *(const uint4*)(gb_ + (size_t)96 * ldb);     \
  }
#define GEMM_STORET(buf, RA, RB)                                                           \
  {                                                                                        \
    *(uint4*)((buf) + st_off) = RA##0;          *(uint4*)((buf) + 16384 + st_off) = RB##0;          \
    *(uint4*)((buf) + st_off + 4096) = RA##1;   *(uint4*)((buf) + 16384 + st_off + 4096) = RB##1;   \
    *(uint4*)((buf) + st_off + 8192) = RA##2;   *(uint4*)((buf) + 16384 + st_off + 8192) = RB##2;   \
    *(uint4*)((buf) + st_off + 12288) = RA##3;  *(uint4*)((buf) + 16384 + st_off + 12288) = RB##3;  \
  }
#define GEMM_COMPUTE(cur)                                                                  \
  _Pragma("unroll") for (int s = 0; s < 4; ++s) {                                          \
    const int co = ((2 * s + hh) ^ fsw) * 16;                                              \
    bf16x8 a0 = *(const bf16x8*)((cur) + a_base + co);                                     \
    bf16x8 a1 = *(const bf16x8*)((cur) + a_base + 4096 + co);                              \
    bf16x8 b0 = *(const bf16x8*)((cur) + b_base + co);                                     \
    bf16x8 b1 = *(const bf16x8*)((cur) + b_base + 4096 + co);                              \
    acc[0][0] = __builtin_amdgcn_mfma_f32_32x32x16_bf16(a0, b0, acc[0][0], 0, 0, 0);       \
    acc[0][1] = __builtin_amdgcn_mfma_f32_32x32x16_bf16(a0, b1, acc[0][1], 0, 0, 0);       \
    acc[1][0] = __builtin_amdgcn_mfma_f32_32x32x16_bf16(a1, b0, acc[1][0], 0, 0, 0);       \
    acc[1][1] = __builtin_amdgcn_mfma_f32_32x32x16_bf16(a1, b1, acc[1][1], 0, 0, 0);       \
  }
  GEMM_LOADT(ra, rb, 0)
  GEMM_LOADT(qa, qb, 1)
  GEMM_STORET(smem, ra, rb)
  __syncthreads();
#pragma unroll 1
  for (int kt = 0; kt < KT; kt += 2) {
    GEMM_LOADT(ra, rb, kt + 2)
    __builtin_amdgcn_sched_barrier(0);
    GEMM_COMPUTE(smem)
    __builtin_amdgcn_sched_barrier(0);
    GEMM_STORET(smem + 32768, qa, qb)
    __syncthreads();
    GEMM_LOADT(qa, qb, kt + 3)
    __builtin_amdgcn_sched_barrier(0);
    GEMM_COMPUTE(smem + 32768)
    __builtin_amdgcn_sched_barrier(0);
    GEMM_STORET(smem, ra, rb)
    __syncthreads();
  }
}

DI void acc_zero(f32x16 (&acc)[2][2]) {
#pragma unroll
  for (int i = 0; i < 2; ++i)
#pragma unroll
    for (int j = 0; j < 2; ++j)
#pragma unroll
      for (int r = 0; r < 16; ++r) acc[i][j][r] = 0.f;
}

DI void acc_to_lds(const f32x16 (&acc)[2][2], char* smem) {
  float* sf = (float*)smem;
  const int tid = tid_(), lane = tid & 63, w = tid >> 6;
  const int rb = (w >> 1) * 64 + 4 * (lane >> 5), cb = (w & 1) * 64 + (lane & 31);
#pragma unroll
  for (int i = 0; i < 2; ++i)
#pragma unroll
    for (int j = 0; j < 2; ++j)
#pragma unroll
      for (int r = 0; r < 16; ++r)
        sf[(rb + i * 32 + (r & 3) + 8 * (r >> 2)) * 128 + cb + j * 32] = acc[i][j][r];
}
DI void unpack8(const uint4 v, float (&f)[8]) {
  f[0] = __uint_as_float(v.x << 16); f[1] = __uint_as_float(v.x & 0xffff0000u);
  f[2] = __uint_as_float(v.y << 16); f[3] = __uint_as_float(v.y & 0xffff0000u);
  f[4] = __uint_as_float(v.z << 16); f[5] = __uint_as_float(v.z & 0xffff0000u);
  f[6] = __uint_as_float(v.w << 16); f[7] = __uint_as_float(v.w & 0xffff0000u);
}
DI uint4 pack8(const float (&f)[8]) {
  uint4 o;
  o.x = pack2(f[0], f[1]); o.y = pack2(f[2], f[3]); o.z = pack2(f[4], f[5]); o.w = pack2(f[6], f[7]);
  return o;
}
#define EPI_LDS(...)                                                             \
  {                                                                              \
    acc_to_lds(acc, smem);                                                       \
    __syncthreads();                                                             \
    _Pragma("unroll 1") for (int it_ = 0; it_ < 8; ++it_) {                      \
      const int row = (tid_() >> 4) + 16 * it_;                             \
      const int c0 = (tid_() & 15) * 8;                                     \
      float v[8];                                                                \
      {                                                                          \
        const float4 t0 = *(const float4*)(smem + (row * 128 + c0) * 4);         \
        const float4 t1 = *(const float4*)(smem + (row * 128 + c0 + 4) * 4);     \
        v[0] = t0.x; v[1] = t0.y; v[2] = t0.z; v[3] = t0.w;                      \
        v[4] = t1.x; v[5] = t1.y; v[6] = t1.z; v[7] = t1.w;                      \
      }                                                                          \
      __VA_ARGS__                                                                \
    }                                                                            \
    __syncthreads();                                                             \
  }

typedef __attribute__((ext_vector_type(4))) float f32x4;
constexpr int G_BK = 64, G_HALF = 128, G_HT = G_HALF * G_BK;
DI int g_lds_byte(int r, int c) {
  int st = (r >> 4) * 2 + (c >> 5), rr = r & 15, cc = c & 31, ob = rr * 64 + cc * 2;
  return st * 1024 + (ob ^ (((ob >> 9) & 1) << 5));
}
DI void g_stage_rc(int b, int& R, int& C) {
  int st = b / 1024, sb = b % 1024, swz = sb ^ (((sb >> 9) & 1) << 5);
  R = (st >> 1) * 16 + swz / 64; C = (st & 1) * 32 + (swz % 64) / 2;
}
DI const char* g_uniform(const char* ptr) {
  unsigned long long u = (unsigned long long)ptr;
  unsigned lo = __builtin_amdgcn_readfirstlane((unsigned)u), hi = __builtin_amdgcn_readfirstlane((unsigned)(u >> 32));
  return (const char*)(((unsigned long long)hi << 32) | lo);
}
DI void gemm256(const bfu* __restrict__ A, int lda, const bfu* __restrict__ Bt, int ldb, int K, int brow, int bcol,
                bfu* shm, f32x4 (&acc)[2][2][4][2]) {
#define G_SA(b, h) (shm + ((b) * 2 + (h)) * G_HT)
#define G_SB(b, h) (shm + (4 + (b) * 2 + (h)) * G_HT)
#define G_STAGE(P, BASE, LD, br, kt)                                                                   \
  do {                                                                                                 \
    const char* _u = g_uniform((const char*)((BASE) + ((long)(br) * (LD) + (long)(kt) * G_BK)));       \
    __builtin_amdgcn_global_load_lds((const unsigned*)(_u + soff_b),                                   \
        (__attribute__((address_space(3))) unsigned*)((char*)(P) + ldst), 16, 0, 0);                   \
    __builtin_amdgcn_global_load_lds((const unsigned*)(_u + 128 * (long)(LD) + soff_b),                \
        (__attribute__((address_space(3))) unsigned*)((char*)(P) + ldst + 8192), 16, 0, 0);            \
  } while (0)
#define G_LDA(dst, b, h) for (int m = 0; m < 4; ++m) for (int k = 0; k < 2; ++k) \
    dst[m][k] = *reinterpret_cast<const bf16x8*>((char*)G_SA(b, h) + a_rd + m * 2048 + k * 1024)
#define G_LDB(dst, b, h) for (int n = 0; n < 2; ++n) for (int k = 0; k < 2; ++k) \
    dst[n][k] = *reinterpret_cast<const bf16x8*>((char*)G_SB(b, h) + b_rd + n * 2048 + k * 1024)
#define G_MMA(ai, bj, At, Bt_)                                                                         \
  do {                                                                                                 \
    __builtin_amdgcn_s_setprio(1);                                                                     \
    for (int m = 0; m < 4; ++m) for (int n = 0; n < 2; ++n) for (int k = 0; k < 2; ++k)                \
      acc[ai][bj][m][n] = __builtin_amdgcn_mfma_f32_16x16x32_bf16(At[m][k], Bt_[n][k], acc[ai][bj][m][n], 0, 0, 0); \
    __builtin_amdgcn_s_setprio(0);                                                                     \
  } while (0)
#define G_WAIT_V(n) asm volatile("s_waitcnt vmcnt(" #n ")" ::: "memory")
#define G_WAIT_L(n) asm volatile("s_waitcnt lgkmcnt(" #n ")" ::: "memory")
#define G_BAR __builtin_amdgcn_s_barrier()
#define G_SCHED __builtin_amdgcn_sched_barrier(0)
  int t512 = threadIdx.x; asm volatile("" : "+v"(t512));
  const int wid = __builtin_amdgcn_readfirstlane(t512 >> 6), lane = t512 & 63, wr = wid >> 2, wc = wid & 3, fr = lane & 15, fq = lane >> 4;
  const int ldst = t512 * 16;
  unsigned soff_b;
  {
    int R0, C0;
    g_stage_rc(ldst, R0, C0);
    soff_b = (unsigned)(R0 * lda + C0) * 2u;
  }
  const int lane_off = (fr * 64 + fq * 16) ^ ((fr >> 3) << 5);
  const int a_rd = wr * 8192 + lane_off, b_rd = wc * 4096 + lane_off;
  bf16x8 At[4][2], B0[2][2], B1[2][2];
  const int nt = K / G_BK;
  G_STAGE(G_SB(0, 0), Bt, ldb, bcol, 0); G_STAGE(G_SA(0, 0), A, lda, brow, 0);
  G_STAGE(G_SB(0, 1), Bt, ldb, bcol + G_HALF, 0); G_STAGE(G_SA(0, 1), A, lda, brow + G_HALF, 0);
  if (wr == 1) G_BAR;
  G_WAIT_V(4); G_BAR;
  G_STAGE(G_SB(1, 0), Bt, ldb, bcol, 1); G_STAGE(G_SA(1, 0), A, lda, brow, 1); G_STAGE(G_SB(1, 1), Bt, ldb, bcol + G_HALF, 1);
  G_WAIT_V(6); G_BAR;
#pragma unroll 1
  for (int t = 0; t < nt - 2; t += 2) {
    G_LDB(B0, 0, 0); G_SCHED; G_LDA(At, 0, 0); G_STAGE(G_SA(1, 1), A, lda, brow + G_HALF, t + 1);
    G_WAIT_L(8); G_BAR; G_WAIT_L(0); G_MMA(0, 0, At, B0); G_BAR; G_SCHED;
    G_LDB(B1, 0, 1); G_STAGE(G_SB(0, 0), Bt, ldb, bcol, t + 2);
    G_BAR; G_WAIT_L(0); G_MMA(0, 1, At, B1); G_BAR;
    G_LDA(At, 0, 1); G_STAGE(G_SA(0, 0), A, lda, brow, t + 2);
    G_BAR; G_WAIT_L(0); G_MMA(1, 0, At, B0); G_BAR; G_SCHED;
    G_STAGE(G_SB(0, 1), Bt, ldb, bcol + G_HALF, t + 2);
    G_WAIT_V(6); G_BAR; G_MMA(1, 1, At, B1); G_BAR;
    G_LDB(B0, 1, 0); G_SCHED; G_LDA(At, 1, 0); G_STAGE(G_SA(0, 1), A, lda, brow + G_HALF, t + 2);
    G_WAIT_L(8); G_BAR; G_WAIT_L(0); G_MMA(0, 0, At, B0); G_BAR; G_SCHED;
    G_LDB(B1, 1, 1); G_STAGE(G_SB(1, 0), Bt, ldb, bcol, t + 3);
    G_BAR; G_WAIT_L(0); G_MMA(0, 1, At, B1); G_BAR;
    G_LDA(At, 1, 1); G_STAGE(G_SA(1, 0), A, lda, brow, t + 3);
    G_BAR; G_WAIT_L(0); G_MMA(1, 0, At, B0); G_BAR; G_SCHED;
    G_STAGE(G_SB(1, 1), Bt, ldb, bcol + G_HALF, t + 3);
    G_WAIT_V(6); G_BAR; G_MMA(1, 1, At, B1); G_BAR;
  }
  { G_LDB(B0, 0, 0); G_LDA(At, 0, 0); G_STAGE(G_SA(1, 1), A, lda, brow + G_HALF, nt - 1);
    G_BAR; G_WAIT_L(0); G_MMA(0, 0, At, B0); G_BAR;
    G_LDB(B1, 0, 1); G_BAR; G_WAIT_L(0); G_MMA(0, 1, At, B1); G_BAR;
    G_LDA(At, 0, 1); G_WAIT_V(4); G_BAR; G_WAIT_L(0); G_MMA(1, 0, At, B0); G_MMA(1, 1, At, B1); G_BAR; }
  { G_LDB(B0, 1, 0); G_LDA(At, 1, 0); G_WAIT_V(2); G_BAR; G_WAIT_L(0); G_MMA(0, 0, At, B0); G_BAR;
    G_LDB(B1, 1, 1); G_WAIT_V(0); G_BAR; G_WAIT_L(0); G_MMA(0, 1, At, B1); G_BAR;
    G_LDA(At, 1, 1); G_BAR; G_WAIT_L(0); G_MMA(1, 0, At, B0); G_MMA(1, 1, At, B1); G_BAR; }
  if (wr == 0) G_BAR;
}
DI void acc256_zero(f32x4 (&acc)[2][2][4][2]) {
#pragma unroll
  for (int a = 0; a < 2; ++a)
#pragma unroll
    for (int b = 0; b < 2; ++b)
#pragma unroll
      for (int m = 0; m < 4; ++m)
#pragma unroll
        for (int n = 0; n < 2; ++n) acc[a][b][m][n] = (f32x4){0.f, 0.f, 0.f, 0.f};
}
#define EPI256(...)                                                                                   \
  {                                                                                                    \
    int t512_ = threadIdx.x; asm volatile("" : "+v"(t512_));     \
    const int wid_ = t512_ >> 6, lane_ = t512_ & 63, wr_ = wid_ >> 2, wc_ = wid_ & 3,                  \
              fr_ = lane_ & 15, fq_ = lane_ >> 4;                                                      \
    float* sf_ = (float*)smem;                                                                         \
    _Pragma("unroll") for (int ai_ = 0; ai_ < 2; ++ai_) {                                              \
      __syncthreads();                                                                                 \
      _Pragma("unroll") for (int bj_ = 0; bj_ < 2; ++bj_)                                              \
      _Pragma("unroll") for (int m_ = 0; m_ < 4; ++m_)                                                 \
      _Pragma("unroll") for (int n_ = 0; n_ < 2; ++n_)                                                 \
      _Pragma("unroll") for (int j_ = 0; j_ < 4; ++j_)                                                 \
        sf_[(wr_ * 64 + m_ * 16 + fq_ * 4 + j_) * 256 + ((bj_ * 128 + wc_ * 32 + n_ * 16 + fr_) ^ (fq_ << 4))] = \
            acc[ai_][bj_][m_][n_][j_];                                                                 \
      __syncthreads();                                                                                 \
      _Pragma("unroll 1") for (int it_ = 0; it_ < 8; ++it_) {                                          \
        const int idx_ = t512_ + 512 * it_;                                                            \
        const int rl_ = idx_ >> 5, c0 = (idx_ & 31) * 8;                                               \
        const int row = ai_ * 128 + rl_;                                                               \
        float v[8];                                                                                    \
        {                                                                                              \
          const float* sp_ = sf_ + rl_ * 256 + (c0 ^ (((rl_ >> 2) & 3) << 4));                          \
          const float4 t0 = *(const float4*)sp_; const float4 t1 = *(const float4*)(sp_ + 4);          \
          v[0] = t0.x; v[1] = t0.y; v[2] = t0.z; v[3] = t0.w;                                          \
          v[4] = t1.x; v[5] = t1.y; v[6] = t1.z; v[7] = t1.w;                                          \
        }                                                                                              \
        __VA_ARGS__                                                                                    \
      }                                                                                                \
    }                                                                                                  \
    __syncthreads();                                                                                   \
  }

template <int MT, int NT, int BH>
DI bool xcd_tile(int iter, int& mt, int& nt) {
  constexpr int MPX = MT / 8, TPX = MPX * NT;
  const int xcd = VXCD, j = VJ, nloc = VNLOC;
  const int q = j + iter * nloc;
  if (q >= TPX) return false;
  const int band = q / (BH * NT), r = q % (BH * NT);
  nt = r / BH;
  mt = xcd * MPX + band * BH + (r % BH);
  return true;
}

DI bool tile256(int iter, int NT, int& mt, int& nt) {
  const int xcd = blockIdx.x & 7, j = blockIdx.x >> 3, nloc = gridDim.x >> 3;
  const int q = j + iter * nloc;
  if (q >= 6 * NT) return false;
  nt = q / 6; mt = xcd * 6 + q % 6;
  return true;
}
DI void phase_gemm_in(const Params& p, int l, char* smem) {
  const bfu* W = p.w_inT + (size_t)l * DINP * LDH;
  for (int iter = 0;; ++iter) {
    int mt, nt;
    if (!tile256(iter, 19, mt, nt)) break;
    f32x4 acc[2][2][4][2];
    acc256_zero(acc);
    gemm256(p.h, LDH, W, LDH, 1024, mt * 256, nt * 256, (bfu*)smem, acc);
    const int m0 = mt * 256, n0 = nt * 256;
    EPI256({
      const int n = n0 + c0;
      if (n < 512) *(uint4*)(p.ug + ((size_t)(n >> 4) * NTOK + (m0 + row)) * 16 + (n & 15)) = pack8(v);
      else if (n < DIN) *(uint4*)(p.proj + (size_t)(m0 + row) * PW + (n - 512)) = pack8(v);
    })
  }
}

DI void s5_gen_item(const Params& p, int l, int item, char* smem) {
  const int tid = tid_();
  const int g = item >> 3, r = item & 7;
  float* sBr = (float*)smem;
  float* sBi = sBr + 2048;
  float* sCr = sBi + 2048;
  float* sCi = sCr + 1024;
  float* sAK = sCi + 1024;
  float* sAE = sAK + 1024;
  float* sAG = sAE + 1024;
  float* sK = sAG + 1024;
  bfu* E = p.opE + (size_t)g * 256 * 512;
  bfu* MG = p.opMG + (size_t)g * 512 * 768;
  __syncthreads();
  if (tid < 128) {
    const int d = tid >> 6, pp = tid & 63;
    const size_t pi = ((size_t)(l * 2 + d) * 32 + g) * 64 + pp;
    const float lr = p.lam_re[pi], li = p.lam_im[pi];
    const float dt = expf(p.log_dt[(l * 2 + d) * 32 + g]);
    const float mag = expf(lr * dt);
    float sn, cs;
    sincosf(li * dt, &sn, &cs);
    const float are = mag * cs, aim = mag * sn;
    const float nr = are - 1.f, ni = aim, den = lr * lr + li * li;
    const float kr = (nr * lr + ni * li) / den, ki = (ni * lr - nr * li) / den;
#pragma unroll
    for (int c = 0; c < 16; ++c) {
      float br = p.b_re[((size_t)(l * 32 + g) * 64 + pp) * 16 + c];
      float bi = p.b_im[((size_t)(l * 32 + g) * 64 + pp) * 16 + c];
      sBr[(d * 64 + pp) * 16 + c] = kr * br - ki * bi;
      sBi[(d * 64 + pp) * 16 + c] = kr * bi + ki * br;
    }
#pragma unroll
    for (int q = 0; q < 4; ++q) {
      const int t = 4 * r + q;
      const int nK = t;
      const int nE = d == 0 ? 31 - t : t;
      const int nG = d == 0 ? t + 1 : 32 - t;
      float m, s_, c_;
      m = expf(lr * dt * (float)nK); sincosf(li * dt * (float)nK, &s_, &c_);
      sAK[((d * 4 + q) * 64 + pp) * 2] = m * c_; sAK[((d * 4 + q) * 64 + pp) * 2 + 1] = m * s_;
      m = expf(lr * dt * (float)nE); sincosf(li * dt * (float)nE, &s_, &c_);
      sAE[((d * 4 + q) * 64 + pp) * 2] = m * c_; sAE[((d * 4 + q) * 64 + pp) * 2 + 1] = m * s_;
      m = expf(lr * dt * (float)nG); sincosf(li * dt * (float)nG, &s_, &c_);
      sAG[((d * 4 + q) * 64 + pp) * 2] = m * c_; sAG[((d * 4 + q) * 64 + pp) * 2 + 1] = m * s_;
    }
  } else {
    for (int idx = tid - 128; idx < 1024; idx += 128) {
      sCr[idx] = p.c_re[(size_t)(l * 32 + g) * 1024 + idx];
      sCi[idx] = p.c_im[(size_t)(l * 32 + g) * 1024 + idx];
    }
  }
  __syncthreads();
  for (int idx = tid; idx < 256 * 64; idx += 256) {
    const int row = idx >> 6, cc = idx & 63, q = cc >> 4, c = cc & 15;
    const int part = row >> 6, pp = row & 63, d = part >> 1;
    const float ar = sAE[((d * 4 + q) * 64 + pp) * 2], ai = sAE[((d * 4 + q) * 64 + pp) * 2 + 1];
    const float br = sBr[(d * 64 + pp) * 16 + c], bi = sBi[(d * 64 + pp) * 16 + c];
    const float v = (part & 1) ? (ar * bi + ai * br) : (ar * br - ai * bi);
    E[(size_t)row * 512 + (4 * r + q) * 16 + c] = f2bf(v);
  }
  for (int idx = tid; idx < 64 * 256; idx += 256) {
    const int rr = idx >> 8, col = idx & 255, q = rr >> 4, c = rr & 15;
    const int part = col >> 6, pp = col & 63, d = part >> 1;
    const float ar = sAG[((d * 4 + q) * 64 + pp) * 2], ai = sAG[((d * 4 + q) * 64 + pp) * 2 + 1];
    const float cr = sCr[c * 64 + pp], ci = sCi[c * 64 + pp];
    const float v = (part & 1) ? -(cr * ai + ci * ar) : (cr * ar - ci * ai);
    MG[(size_t)((4 * r + q) * 16 + c) * 768 + 512 + col] = f2bf(v);
  }
  {
    const int d = tid >> 7, q = (tid >> 5) & 3, c = (tid >> 1) & 15, ch = tid & 1;
    float acc[8];
#pragma unroll
    for (int e = 0; e < 8; ++e) acc[e] = 0.f;
    for (int pp = 0; pp < 64; ++pp) {
      const float ar = sAK[((d * 4 + q) * 64 + pp) * 2], ai = sAK[((d * 4 + q) * 64 + pp) * 2 + 1];
      const float cr = sCr[c * 64 + pp], ci = sCi[c * 64 + pp];
      const float wr = cr * ar - ci * ai, wi = cr * ai + ci * ar;
#pragma unroll
      for (int e = 0; e < 8; ++e)
        acc[e] += wr * sBr[(d * 64 + pp) * 16 + ch * 8 + e] - wi * sBi[(d * 64 + pp) * 16 + ch * 8 + e];
    }
#pragma unroll
    for (int e = 0; e < 8; ++e) sK[((d * 4 + q) * 16 + c) * 16 + ch * 8 + e] = acc[e];
  }
  __syncthreads();
  for (int idx = tid; idx < 8192; idx += 256) {
    const int ch = idx & 1, c = (idx >> 1) & 15, tp = (idx >> 5) & 31, q = (idx >> 10) & 3, d = idx >> 12;
    const int tau = 4 * r + q;
    int sp;
    bool valid;
    if (d == 0) { sp = tp - tau; valid = sp >= 0; } else { sp = tp + tau; valid = (sp <= 31) && (tau > 0); }
    if (valid) {
      float v[8];
#pragma unroll
      for (int e = 0; e < 8; ++e) {
        float x = sK[((d * 4 + q) * 16 + c) * 16 + ch * 8 + e];
        if (tau == 0) x += sK[((1 * 4 + q) * 16 + c) * 16 + ch * 8 + e];
        v[e] = x;
      }
      *(uint4*)(MG + (size_t)(tp * 16 + c) * 768 + sp * 16 + ch * 8) = pack8(v);
    }
  }
  __syncthreads();
}

DI void phase_s5_gen(const Params& p, int l, char* smem) {
  for (int it = NVB - 1 - VBID; it < 256; it += NVB) s5_gen_item(p, l, it, smem);
}

DI void phase_s5_e(const Params& p, char* smem) {
  for (int q = VJ; q < 24; q += VNLOC) {
    const int g = VXCD * 4 + q / 6, r6 = q % 6, mt = r6 >> 1, nt = r6 & 1;
    f32x16 acc[2][2];
    acc_zero(acc);
    gemm_core(p.ug + ((size_t)g * NCHUNK + mt * 128) * 512, 512, p.opE + ((size_t)g * 256 + nt * 128) * 512, 512, 512,
              smem, acc);
    EPI_LDS({
      float* dst = p.ebuf + ((size_t)g * NCHUNK + mt * 128 + row) * 256 + nt * 128 + c0;
      *(float4*)dst = make_float4(v[0], v[1], v[2], v[3]);
      *(float4*)(dst + 4) = make_float4(v[4], v[5], v[6], v[7]);
    })
  }
}

DI void phase_s5_scan(const Params& p, int l) {
  const int tid = tid_();
  for (int it = VBID; it < 320; it += NVB) {
    const int wi = it * 2 + (tid >> 7);
    const int dir = (tid >> 6) & 1, pp = tid & 63;
    int chunk0, n, b, g;
    bool prompt;
    if (wi < 128) { b = wi >> 5; g = wi & 31; chunk0 = (NPROMPT + b * 2048) >> 5; n = 64; prompt = false; }
    else { int q = wi - 128; b = q >> 5; g = q & 31; chunk0 = (b * 256) >> 5; n = 8; prompt = true; }
    const size_t pi = ((size_t)(l * 2 + dir) * 32 + g) * 64 + pp;
    const float lr = p.lam_re[pi], li = p.lam_im[pi];
    const float dt = expf(p.log_dt[(l * 2 + dir) * 32 + g]);
    const float mag = expf(lr * dt * 32.f);
    float sn, cs;
    sincosf(li * dt * 32.f, &sn, &cs);
    const float are = mag * cs, aim = mag * sn;
    float hre = 0.f, him = 0.f;
    if (!prompt) {
      size_t si = ((size_t)((b * 2 + l) * 2 + dir)) * 2048 + g * 64 + pp;
      hre = p.st_re[si]; him = p.st_im[si];
    }
    const float* eb = p.ebuf + ((size_t)g * NCHUNK + chunk0) * 256 + dir * 128 + pp;
    bfu* cb = p.carry + ((size_t)g * NCHUNK + chunk0) * 256 + dir * 128 + pp;
    for (int k0 = 0; k0 < n; k0 += 8) {
      float er[8], ei[8];
#pragma unroll
      for (int j = 0; j < 8; ++j) {
        const int k = dir == 0 ? k0 + j : n - 1 - (k0 + j);
        er[j] = eb[(size_t)k * 256];
        ei[j] = eb[(size_t)k * 256 + 64];
      }
#pragma unroll
      for (int j = 0; j < 8; ++j) {
        const int k = dir == 0 ? k0 + j : n - 1 - (k0 + j);
        cb[(size_t)k * 256] = f2bf(hre);
        cb[(size_t)k * 256 + 64] = f2bf(him);
        const float nre = are * hre - aim * him + er[j];
        const float nim = are * him + aim * hre + ei[j];
        hre = nre; him = nim;
      }
    }
    if (prompt) {
      size_t oi = ((size_t)((b * 2 + l) * 2 + dir)) * 2048 + g * 64 + pp;
      p.out[OUT_RE + oi] = hre;
      p.out[OUT_IM + oi] = him;
    }
  }
}

DI void phase_s5_y(const Params& p, int l, char* smem) {
  for (int q = VJ; q < 48; q += VNLOC) {
    const int g = VXCD * 4 + q / 12, r12 = q % 12, mt = r12 >> 2, nt = r12 & 3;
    f32x16 acc[2][2];
    acc_zero(acc);
    const bfu* Bm = p.opMG + ((size_t)g * 512 + nt * 128) * 768;
    gemm_core(p.ug + ((size_t)g * NCHUNK + mt * 128) * 512, 512, Bm, 768, 512, smem, acc);
    gemm_core(p.carry + ((size_t)g * NCHUNK + mt * 128) * 256, 256, Bm + 512, 768, 256, smem, acc);
    EPI_LDS({
      const int chunk = mt * 128 + row, nn = nt * 128 + c0, tp = nn >> 4, c = nn & 15;
      const int tok = chunk * 32 + tp;
      float u[8], o[8];
      unpack8(*(const uint4*)(p.ug + ((size_t)g * NTOK + tok) * 16 + c), u);
      const float* dsk = p.s5_d + l * 512 + g * 16 + c;
      _Pragma("unroll") for (int e = 0; e < 8; ++e) o[e] = geluf_(v[e] + dsk[e] * u[e]);
      *(uint4*)(p.ys5 + (size_t)tok * 512 + g * 16 + c) = pack8(o);
    })
  }
}

DI void phase_glu(const Params& p, int l, char* smem) {
  const bfu* W = p.w_gluT + (size_t)l * 512 * 512;
  for (int iter = 0;; ++iter) {
    int mt, nt;
    if (!xcd_tile<96, 4, 12>(iter, mt, nt)) break;
    f32x16 acc[2][2];
    acc_zero(acc);
    gemm_core(p.ys5 + (size_t)mt * 128 * 512, 512, W + (size_t)nt * 128 * 512, 512, 512, smem, acc);
    const int m0 = mt * 128, n0 = nt * 128;
    EPI_LDS({
      const int n = n0 + c0;
      const size_t tk = (size_t)(m0 + row);
      float y[8], ga[8], o[8];
      unpack8(*(const uint4*)(p.ys5 + tk * 512 + n), y);
      unpack8(*(const uint4*)(p.proj + tk * PW + OFF_GA + n), ga);
      const float* bg = p.b_glu + l * 512 + n;
      _Pragma("unroll") for (int e = 0; e < 8; ++e) o[e] = y[e] * sigmoidf_(v[e] + bg[e]) * siluf_(ga[e]);
      *(uint4*)(p.ya + tk * 512 + n) = pack8(o);
    })
  }
}

constexpr int GL_QS = 0;
constexpr int GL_KS = GL_QS + 32 * 144;
constexpr int GL_KHT = GL_KS + 32 * 144;
constexpr int GL_VT = GL_KHT + 64 * 80;
constexpr int GL_PS = GL_VT + 128 * 80;
constexpr int GL_ST = GL_PS + 32 * 80;
constexpr int GL_AV = GL_ST + 128 * 144;
constexpr int GL_TOT = GL_AV + 256;
constexpr int GL_OS = GL_TOT + 1024;
static_assert(GL_OS + 32 * 132 * 4 <= 65536, "gla lds");

DI void gla_segment_info(int seg, int& tok_base, bool& prompt, int& b, int& sidx) {
  if (seg < 16) { prompt = true; b = seg; sidx = 0; tok_base = seg * 256; }
  else { int q = seg - 16; prompt = false; b = q >> 3; sidx = q & 7; tok_base = NPROMPT + b * 2048 + sidx * 256; }
}

template <bool STATE_ONLY>
DI void gla_chain(const Params& p, int l, char* smem, int seg, int hd, int dir) {
  const int tid = tid_(), lane = tid & 63, w = tid >> 6;
  const int fr = lane & 31, hh = lane >> 5;
  int tok_base, b, sidx;
  bool prompt;
  gla_segment_info(seg, tok_base, prompt, b, sidx);
  const int dk = tid & 63, tq = tid >> 6;
  const int dvl = tid & 127, th = tid >> 7;
  float wg[16];
#pragma unroll
  for (int q = 0; q < 16; ++q) wg[q] = p.wg_up[((size_t)(l * 2 + dir) * 16 + q) * 256 + hd * 64 + dk];
  const float bgv = p.bg[(l * 2 + dir) * 256 + hd * 64 + dk];
  float* sAv = (float*)(smem + GL_AV);
  float* sTot = (float*)(smem + GL_TOT);
  float* sOs = (float*)(smem + GL_OS);

  f32x16 S[2];
  {
    const int dvc = 32 * w + fr;
    if (STATE_ONLY || prompt) {
#pragma unroll
      for (int mt = 0; mt < 2; ++mt)
#pragma unroll
        for (int r = 0; r < 16; ++r) S[mt][r] = 0.f;
    } else {
      const float* sp = p.st_gla + ((size_t)(((b * 2 + l) * 2 + dir) * 4 + hd)) * 8192;
#pragma unroll
      for (int mt = 0; mt < 2; ++mt)
#pragma unroll
        for (int r = 0; r < 16; ++r) S[mt][r] = sp[(32 * mt + (r & 3) + 8 * (r >> 2) + 4 * hh) * 128 + dvc];
      const int nprev = dir == 0 ? sidx : 7 - sidx;
      for (int q = 0; q < nprev; ++q) {
        const int sprev = dir == 0 ? q : 7 - q;
        const size_t ci = (size_t)(((b * 8 + sprev) * 4 + hd) * 2 + dir);
        const float* sl = p.gla_sloc + ci * 8192;
        const float* al = p.gla_aseg + ci * 64;
#pragma unroll
        for (int mt = 0; mt < 2; ++mt)
#pragma unroll
          for (int r = 0; r < 16; ++r) {
            const int dkk = 32 * mt + (r & 3) + 8 * (r >> 2) + 4 * hh;
            S[mt][r] = al[dkk] * S[mt][r] + sl[dkk * 128 + dvc];
          }
      }
    }
  }
  float bsum = 0.f;
  __syncthreads();
  if (!STATE_ONLY) {
    const int dvc = 32 * w + fr;
#pragma unroll
    for (int mt = 0; mt < 2; ++mt)
#pragma unroll
      for (int q = 0; q < 4; ++q) {
        uint2 pk;
        pk.x = pack2(S[mt][4 * q], S[mt][4 * q + 1]);
        pk.y = pack2(S[mt][4 * q + 2], S[mt][4 * q + 3]);
        *(uint2*)(smem + GL_ST + dvc * 144 + (32 * mt + 8 * q + 4 * hh) * 2) = pk;
      }
  }

  uint4 rq = make_uint4(0, 0, 0, 0), rk = rq, rv0 = rq, rv1 = rq, rgl = rq;
#define GLA_ISSUE(nn)                                                                                         \
  {                                                                                                           \
    const int cn_ = dir == 0 ? (nn) : 7 - (nn);                                                               \
    const int c0_ = tok_base + cn_ * 32;                                                                      \
    const int tA = dir == 0 ? (tid >> 3) : 31 - (tid >> 3);                                                   \
    const bfu* prA = p.proj + (size_t)(c0_ + tA) * PW + hd * 64 + (tid & 7) * 8;                              \
    if (!STATE_ONLY) rq = *(const uint4*)(prA + OFF_Q);                                                       \
    rk = *(const uint4*)(prA + OFF_K);                                                                        \
    const int tV0 = dir == 0 ? (tid >> 4) : 31 - (tid >> 4);                                                  \
    const int tV1 = dir == 0 ? (tid >> 4) + 16 : 15 - (tid >> 4);                                             \
    rv0 = *(const uint4*)(p.proj + (size_t)(c0_ + tV0) * PW + OFF_V + hd * 128 + (tid & 15) * 8);             \
    rv1 = *(const uint4*)(p.proj + (size_t)(c0_ + tV1) * PW + OFF_V + hd * 128 + (tid & 15) * 8);             \
    if (tid < 64) {                                                                                           \
      const int tG = dir == 0 ? (tid >> 1) : 31 - (tid >> 1);                                                 \
      rgl = *(const uint4*)(p.proj + (size_t)(c0_ + tG) * PW + OFF_GL + (tid & 1) * 8);                       \
    }                                                                                                         \
  }
  GLA_ISSUE(0)
  char* rawQ = smem + GL_OS;
  char* rawK = smem + GL_OS + 4096;
  char* rawV = smem + GL_OS + 8192;
  char* rawG = smem + GL_PS;

#pragma unroll 1
  for (int n = 0; n < 8; ++n) {
    const int cn = dir == 0 ? n : 7 - n;
    const int ctok0 = tok_base + cn * 32;
    __syncthreads();
    if (!STATE_ONLY) *(uint4*)(rawQ + (tid >> 3) * 128 + (tid & 7) * 16) = rq;
    *(uint4*)(rawK + (tid >> 3) * 128 + (tid & 7) * 16) = rk;
    *(uint4*)(rawV + (tid >> 4) * 256 + (tid & 15) * 16) = rv0;
    *(uint4*)(rawV + ((tid >> 4) + 16) * 256 + (tid & 15) * 16) = rv1;
    if (tid < 64) *(uint4*)(rawG + (tid >> 1) * 32 + (tid & 1) * 16) = rgl;
    if (n + 1 < 8) GLA_ISSUE(n + 1)
    __syncthreads();
    float qv[8], kv[8], bl[8];
    {
      float run = 0.f;
#pragma unroll
      for (int i = 0; i < 8; ++i) {
        const int tau = tq * 8 + i;
        if (!STATE_ONLY) qv[i] = bf2f(*(const bfu*)(rawQ + tau * 128 + dk * 2)) * 0.125f;
        kv[i] = bf2f(*(const bfu*)(rawK + tau * 128 + dk * 2));
        float gl[16];
        unpack8(*(const uint4*)(rawG + tau * 32), *(float(*)[8])&gl[0]);
        unpack8(*(const uint4*)(rawG + tau * 32 + 16), *(float(*)[8])&gl[8]);
        float lg = bgv;
#pragma unroll
        for (int q = 0; q < 16; ++q) lg += gl[q] * wg[q];
        const float ls = fminf(lg, 0.f) - __logf(1.f + __expf(-fabsf(lg)));
        run += ls * (1.f / 16.f);
        bl[i] = run;
      }
      sTot[tq * 64 + dk] = run;
    }
    {
      unsigned pk[8];
#pragma unroll
      for (int i = 0; i < 8; ++i) {
        const int tau0 = th * 16 + 2 * i;
        const unsigned lo = *(const bfu*)(rawV + tau0 * 256 + dvl * 2);
        const unsigned hi = *(const bfu*)(rawV + (tau0 + 1) * 256 + dvl * 2);
        pk[i] = lo | (hi << 16);
      }
      *(uint4*)(smem + GL_VT + dvl * 80 + th * 32) = make_uint4(pk[0], pk[1], pk[2], pk[3]);
      *(uint4*)(smem + GL_VT + dvl * 80 + th * 32 + 16) = make_uint4(pk[4], pk[5], pk[6], pk[7]);
    }
    __syncthreads();
    {
      float off = 0.f, total = 0.f;
#pragma unroll
      for (int q = 0; q < 4; ++q) {
        const float tv = sTot[q * 64 + dk];
        total += tv;
        off += (q < tq) ? tv : 0.f;
      }
      unsigned kh[4];
      float khv[8];
#pragma unroll
      for (int i = 0; i < 8; ++i) {
        const float bb = off + bl[i];
        const int tau = tq * 8 + i;
        if (!STATE_ONLY) {
          *(bfu*)(smem + GL_QS + tau * 144 + dk * 2) = f2bf(qv[i] * __expf(bb));
          *(bfu*)(smem + GL_KS + tau * 144 + dk * 2) = f2bf(kv[i] * __expf(-bb));
        }
        khv[i] = kv[i] * __expf(total - bb);
      }
#pragma unroll
      for (int i = 0; i < 4; ++i) kh[i] = pack2(khv[2 * i], khv[2 * i + 1]);
      *(uint4*)(smem + GL_KHT + dk * 80 + tq * 16) = make_uint4(kh[0], kh[1], kh[2], kh[3]);
      if (tq == 0) { sAv[dk] = __expf(total); bsum += total; }
    }
    __syncthreads();
    f32x16 o;
    if (!STATE_ONLY) {
      f32x16 sc;
#pragma unroll
      for (int r = 0; r < 16; ++r) sc[r] = 0.f;
#pragma unroll
      for (int s4 = 0; s4 < 4; ++s4) {
        bf16x8 a = *(const bf16x8*)(smem + GL_QS + fr * 144 + (16 * s4 + 8 * hh) * 2);
        bf16x8 bq = *(const bf16x8*)(smem + GL_KS + fr * 144 + (16 * s4 + 8 * hh) * 2);
        sc = __builtin_amdgcn_mfma_f32_32x32x16_bf16(a, bq, sc, 0, 0, 0);
      }
#pragma unroll
      for (int rr = 0; rr < 4; ++rr) {
        float val = w == 0 ? sc[rr] : (w == 1 ? sc[4 + rr] : (w == 2 ? sc[8 + rr] : sc[12 + rr]));
        const int i = rr + 8 * w + 4 * hh;
        val = (fr <= i) ? val : 0.f;
        *(bfu*)(smem + GL_PS + i * 80 + fr * 2) = f2bf(val);
      }
      __syncthreads();
#pragma unroll
      for (int r = 0; r < 16; ++r) o[r] = 0.f;
    }
    {
      const int dvc = 32 * w + fr;
      bf16x8 vb0 = *(const bf16x8*)(smem + GL_VT + dvc * 80 + (8 * hh) * 2);
      bf16x8 vb1 = *(const bf16x8*)(smem + GL_VT + dvc * 80 + (16 + 8 * hh) * 2);
      if (!STATE_ONLY) {
        bf16x8 pa0 = *(const bf16x8*)(smem + GL_PS + fr * 80 + (8 * hh) * 2);
        bf16x8 pa1 = *(const bf16x8*)(smem + GL_PS + fr * 80 + (16 + 8 * hh) * 2);
        o = __builtin_amdgcn_mfma_f32_32x32x16_bf16(pa0, vb0, o, 0, 0, 0);
        o = __builtin_amdgcn_mfma_f32_32x32x16_bf16(pa1, vb1, o, 0, 0, 0);
#pragma unroll
        for (int s4 = 0; s4 < 4; ++s4) {
          bf16x8 a = *(const bf16x8*)(smem + GL_QS + fr * 144 + (16 * s4 + 8 * hh) * 2);
          bf16x8 sb = *(const bf16x8*)(smem + GL_ST + dvc * 144 + (16 * s4 + 8 * hh) * 2);
          o = __builtin_amdgcn_mfma_f32_32x32x16_bf16(a, sb, o, 0, 0, 0);
        }
      }
#pragma unroll
      for (int mt = 0; mt < 2; ++mt) {
        f32x16 U;
#pragma unroll
        for (int r = 0; r < 16; ++r) U[r] = 0.f;
        bf16x8 ka0 = *(const bf16x8*)(smem + GL_KHT + (32 * mt + fr) * 80 + (8 * hh) * 2);
        bf16x8 ka1 = *(const bf16x8*)(smem + GL_KHT + (32 * mt + fr) * 80 + (16 + 8 * hh) * 2);
        U = __builtin_amdgcn_mfma_f32_32x32x16_bf16(ka0, vb0, U, 0, 0, 0);
        U = __builtin_amdgcn_mfma_f32_32x32x16_bf16(ka1, vb1, U, 0, 0, 0);
#pragma unroll
        for (int q = 0; q < 4; ++q) {
          const float4 av = *(const float4*)(sAv + 32 * mt + 8 * q + 4 * hh);
          S[mt][4 * q + 0] = av.x * S[mt][4 * q + 0] + U[4 * q + 0];
          S[mt][4 * q + 1] = av.y * S[mt][4 * q + 1] + U[4 * q + 1];
          S[mt][4 * q + 2] = av.z * S[mt][4 * q + 2] + U[4 * q + 2];
          S[mt][4 * q + 3] = av.w * S[mt][4 * q + 3] + U[4 * q + 3];
          if (!STATE_ONLY) {
            uint2 pk;
            pk.x = pack2(S[mt][4 * q], S[mt][4 * q + 1]);
            pk.y = pack2(S[mt][4 * q + 2], S[mt][4 * q + 3]);
            *(uint2*)(smem + GL_ST + dvc * 144 + (32 * mt + 8 * q + 4 * hh) * 2) = pk;
          }
        }
      }
      if (!STATE_ONLY) {
#pragma unroll
        for (int r = 0; r < 16; ++r) sOs[((r & 3) + 8 * (r >> 2) + 4 * hh) * 132 + dvc] = o[r];
      }
    }
    __syncthreads();
    if (!STATE_ONLY) {
      const int t = tid >> 3, part = tid & 7;
      const int tau = dir == 0 ? t : 31 - t;
      const size_t tok = (size_t)(ctok0 + t);
      float ov[16];
#pragma unroll
      for (int q = 0; q < 4; ++q) {
        const float4 x = *(const float4*)(sOs + tau * 132 + part * 16 + 4 * q);
        ov[4 * q] = x.x; ov[4 * q + 1] = x.y; ov[4 * q + 2] = x.z; ov[4 * q + 3] = x.w;
      }
      bfu* op = p.gla_o + ((size_t)dir * NTOK + tok) * 512 + hd * 128 + part * 16;
      *(uint4*)op = pack8(*(float(*)[8])&ov[0]);
      *(uint4*)(op + 8) = pack8(*(float(*)[8])&ov[8]);
    }
  }
  const int dvc = 32 * w + fr;
  if (STATE_ONLY) {
    const size_t ci = (size_t)(((b * 8 + sidx) * 4 + hd) * 2 + dir);
    float* sl = p.gla_sloc + ci * 8192;
#pragma unroll
    for (int mt = 0; mt < 2; ++mt)
#pragma unroll
      for (int r = 0; r < 16; ++r) sl[(32 * mt + (r & 3) + 8 * (r >> 2) + 4 * hh) * 128 + dvc] = S[mt][r];
    if (tq == 0) p.gla_aseg[ci * 64 + dk] = __expf(bsum);
  } else if (prompt) {
    float* op = p.out + OUT_GLA + ((size_t)(((b * 2 + l) * 2 + dir) * 4 + hd)) * 8192;
#pragma unroll
    for (int mt = 0; mt < 2; ++mt)
#pragma unroll
      for (int r = 0; r < 16; ++r) op[(32 * mt + (r & 3) + 8 * (r >> 2) + 4 * hh) * 128 + dvc] = S[mt][r];
  }
  __syncthreads();
}

DI void phase_gla_pass1(const Params& p, int l, char* smem) {
  for (int it = NVB - 1 - VBID; it < 256; it += NVB) {
    const int dir = it & 1, hd = (it >> 1) & 3, seg = 16 + (it >> 3);
    gla_chain<true>(p, l, smem, seg, hd, dir);
  }
}
DI void phase_gla_main(const Params& p, int l, char* smem) {
  for (int it = NVB - 1 - VBID; it < 384; it += NVB) {
    const int dir = it & 1, hd = (it >> 1) & 3, seg = it >> 3;
    gla_chain<false>(p, l, smem, seg, hd, dir);
  }
}
DI void phase_gla_norm(const Params& p, int l) {
  const int tid = tid_(), lane = tid & 63, w = tid >> 6;
  for (int it = VBID; it < NTOK / 4; it += NVB) {
    const int tok = it * 4 + w;
    float a[8], b[8], gt[8], res[8];
    unpack8(*(const uint4*)(p.gla_o + (size_t)tok * 512 + lane * 8), a);
    unpack8(*(const uint4*)(p.gla_o + ((size_t)NTOK + tok) * 512 + lane * 8), b);
    unpack8(*(const uint4*)(p.proj + (size_t)tok * PW + OFF_GB + lane * 8), gt);
    float ss = 0.f;
#pragma unroll
    for (int e = 0; e < 8; ++e) { a[e] += b[e]; ss += a[e] * a[e]; }
    ss += __shfl_xor(ss, 1); ss += __shfl_xor(ss, 2); ss += __shfl_xor(ss, 4); ss += __shfl_xor(ss, 8);
    const float rs = rsqrtf(ss * (1.f / 128.f) + EPS);
    const float* g = p.gla_norm_g + l * 512 + lane * 8;
#pragma unroll
    for (int e = 0; e < 8; ++e) res[e] = a[e] * rs * g[e] * siluf_(gt[e]);
    *(uint4*)(p.yb + (size_t)tok * 512 + lane * 8) = pack8(res);
  }
}

DI void phase_merge(const Params& p, int l, char* smem) {
  const bfu* WA = p.w_paT + (size_t)l * 1024 * 512;
  const bfu* WB = p.w_pbT + (size_t)l * 1024 * 512;
  for (int iter = 0;; ++iter) {
    int mt, nt;
    if (!tile256(iter, 4, mt, nt)) break;
    const int m0 = mt * 256, n0 = nt * 256;
    f32x4 acc[2][2][4][2];
    acc256_zero(acc);
    gemm256(p.ya, 512, WA, 512, 512, m0, n0, (bfu*)smem, acc);
    EPI256({
      float ma[8], o[8];
      unpack8(*(const uint4*)(p.proj + (size_t)(m0 + row) * PW + OFF_MA + n0 + c0), ma);
      _Pragma("unroll") for (int e = 0; e < 8; ++e) o[e] = sigmoidf_(ma[e]) * v[e];
      *(uint4*)(p.merged + (size_t)(m0 + row) * D + n0 + c0) = pack8(o);
    })
    acc256_zero(acc);
    gemm256(p.yb, 512, WB, 512, 512, m0, n0, (bfu*)smem, acc);
    EPI256({
      float mb[8], o[8], pr[8];
      unpack8(*(const uint4*)(p.proj + (size_t)(m0 + row) * PW + OFF_MB + n0 + c0), mb);
      uint4* mp = (uint4*)(p.merged + (size_t)(m0 + row) * D + n0 + c0);
      unpack8(*mp, pr);
      _Pragma("unroll") for (int e = 0; e < 8; ++e) o[e] = pr[e] + sigmoidf_(mb[e]) * v[e];
      *mp = pack8(o);
    })
  }
}

DI void phase_out(const Params& p, int l, char* smem) {
  const bfu* W = p.w_oT + (size_t)l * 1024 * 1024;
  for (int iter = 0;; ++iter) {
    int mt, nt;
    if (!tile256(iter, 4, mt, nt)) break;
    const int m0 = mt * 256, n0 = nt * 256;
    f32x4 acc[2][2][4][2];
    acc256_zero(acc);
    gemm256(p.merged, D, W, 1024, 1024, m0, n0, (bfu*)smem, acc);
    const float* gate = p.mod + (size_t)(l * 5 + cond_of_tok(m0)) * 3072 + 2048;
    EPI256({
      float* xp = p.out + (size_t)(m0 + row) * D + n0 + c0;
      const float* gp = gate + n0 + c0;
      float4 x0 = *(const float4*)xp, x1 = *(const float4*)(xp + 4);
      const float4 g0 = *(const float4*)gp, g1 = *(const float4*)(gp + 4);
      x0.x += g0.x * v[0]; x0.y += g0.y * v[1]; x0.z += g0.z * v[2]; x0.w += g0.w * v[3];
      x1.x += g1.x * v[4]; x1.y += g1.y * v[5]; x1.z += g1.z * v[6]; x1.w += g1.w * v[7];
      *(float4*)xp = x0; *(float4*)(xp + 4) = x1;
    })
  }
}

DI void phase_final(const Params& p) {
  const int tid = tid_(), lane = tid & 63, w = tid >> 6;
  for (int it = VBID; it < NTOK / 4; it += NVB) {
    const int tok = it * 4 + w;
    float* xs = p.out + (size_t)tok * D;
    float4 v[4];
#pragma unroll
    for (int i = 0; i < 4; ++i) v[i] = *(const float4*)(xs + lane * 4 + 256 * i);
    float ss = 0.f;
#pragma unroll
    for (int i = 0; i < 4; ++i) ss += v[i].x * v[i].x + v[i].y * v[i].y + v[i].z * v[i].z + v[i].w * v[i].w;
    ss = wave_sum(ss);
    const float rstd = rsqrtf(ss * (1.f / 1024.f) + EPS);
#pragma unroll
    for (int i = 0; i < 4; ++i) {
      float4 g = *(const float4*)(p.final_g + lane * 4 + 256 * i);
      float4 o;
      o.x = v[i].x * rstd * g.x; o.y = v[i].y * rstd * g.y; o.z = v[i].z * rstd * g.z; o.w = v[i].w * rstd * g.w;
      *(float4*)(xs + lane * 4 + 256 * i) = o;
    }
  }
}

#define XB_TMO      128
#define XB_XCNT(j)  (256  + 64 * (j))
#define XB_XSUB(j)  (1280 + 64 * (j))
#define XB_XGEN(j)  (2304 + 64 * (j))
#define XB_TOP      3328
#define XB_TOPGEN   3392
#define XCD_BAR_WORDS 3456
#define XB_SPIN_CAP (1u << 18)
#define LAS __attribute__((address_space(3)))
DI unsigned xb_ld(unsigned* p) { return __hip_atomic_load(p, __ATOMIC_RELAXED, __HIP_MEMORY_SCOPE_AGENT); }
DI unsigned xb_add(unsigned* p, unsigned v) { return __hip_atomic_fetch_add(p, v, __ATOMIC_RELAXED, __HIP_MEMORY_SCOPE_AGENT); }
DI unsigned xb_xcc_id() { return (unsigned)__builtin_amdgcn_s_getreg((3 << 11) | 20) & 0xFu; }
#define XB_SPIN(cond, bar) do { unsigned _sp = 0; while (cond) { __builtin_amdgcn_s_sleep(1); \
    if ((++_sp & 255u) == 0u) { if (xb_ld(&(bar)[XB_TMO])) break; if (_sp > XB_SPIN_CAP) { atomicAdd(&(bar)[XB_TMO], 1u); break; } } } } while (0)
struct XcdBarrier { unsigned* bar; unsigned x; volatile LAS unsigned* st; };
DI XcdBarrier xcd_barrier_post(unsigned* bar, volatile LAS unsigned* st) {
  XcdBarrier b; b.bar = bar; b.x = xb_xcc_id(); b.st = st;
  if (threadIdx.x == 0) (void)xb_add(&bar[XB_XCNT(b.x)], 1u);
  return b;
}
DI void xcd_barrier_complete(unsigned* bar, unsigned x, unsigned& nloc, unsigned& nx) {
  const unsigned G = gridDim.x * gridDim.y * gridDim.z;
  unsigned sum, cnt, mine, sp = 0u;
  for (;;) {
    sum = 0u; cnt = 0u; mine = 0u;
#pragma unroll
    for (unsigned j = 0; j < 16; ++j) { const unsigned c = xb_ld(&bar[XB_XCNT(j)]); sum += c; cnt += (c > 0u) ? 1u : 0u; mine = (j == x) ? c : mine; }
    if (sum == G) break;
    __builtin_amdgcn_s_sleep(1);
    if ((++sp & 255u) == 0u) { if (xb_ld(&bar[XB_TMO])) break; if (sp > XB_SPIN_CAP) { atomicAdd(&bar[XB_TMO], 1u); break; } }
  }
  nloc = mine > 0u ? mine : 1u; nx = cnt > 0u ? cnt : 1u;
}
DI void xcd_barrier(const XcdBarrier& b) {
  asm volatile("s_waitcnt vmcnt(0)" ::: "memory");
  __syncthreads();
  if (threadIdx.x == 0) {
    unsigned* bar = b.bar;
    __builtin_amdgcn_s_waitcnt(0);
    unsigned nloc = b.st[0], nx = b.st[1];
    if (nloc == 0u) { xcd_barrier_complete(bar, b.x, nloc, nx); b.st[0] = nloc; b.st[1] = nx; }
    const unsigned old = xb_add(&bar[XB_XSUB(b.x)], 1u);
    const unsigned gen = old / nloc;
    if (old + 1u == (gen + 1u) * nloc) {
      __builtin_amdgcn_fence(__ATOMIC_RELEASE, "agent");
      asm volatile("s_waitcnt vmcnt(0)" ::: "memory");
      const unsigned og = xb_add(&bar[XB_TOP], 1u);
      const unsigned tg = og / nx;
      if (og + 1u == (tg + 1u) * nx) xb_add(&bar[XB_TOPGEN], 1u);
      else XB_SPIN(xb_ld(&bar[XB_TOPGEN]) == tg, bar);
      __builtin_amdgcn_fence(__ATOMIC_ACQUIRE, "agent");
      xb_add(&bar[XB_XGEN(b.x)], 1u);
      asm volatile("s_waitcnt vmcnt(0)" ::: "memory");
    } else {
      XB_SPIN(xb_ld(&bar[XB_XGEN(b.x)]) == gen, bar);
      __builtin_amdgcn_fence(__ATOMIC_ACQUIRE, "agent");
      asm volatile("s_waitcnt vmcnt(0)" ::: "memory");
    }
  }
  __syncthreads();
}

#ifndef REP_SYNC
#define REP_SYNC 0
#endif
__global__ void __launch_bounds__(512, 2) k_mega(Params p) {
  extern __shared__ __attribute__((aligned(16))) char smem_all[];
  cg::grid_group grid = cg::this_grid();
  char* smem = smem_all;
#define smh (smem_all + VHALF * 65536)
  volatile LAS unsigned* xst = (volatile LAS unsigned*)(smem_all + 131072);
  if (threadIdx.x < 4) xst[threadIdx.x] = 0u;
  __syncthreads();
  XcdBarrier xb = xcd_barrier_post(p.bar, xst);
#define GSYNC() xcd_barrier(xb)
  phase_prep(p, smh);
  phase_s5_gen(p, 0, smh);
  GSYNC();
  if (p.bar == nullptr) grid.sync();
  for (int l = 0; l < 2; ++l) {
    phase_h(p, l);
    GSYNC();
    phase_gemm_in(p, l, smem);
    GSYNC();
    phase_s5_e(p, smh);
    phase_gla_pass1(p, l, smh);
    GSYNC();
    phase_s5_scan(p, l);
    phase_gla_main(p, l, smh);
    GSYNC();
    phase_s5_y(p, l, smh);
    phase_gla_norm(p, l);
    GSYNC();
    phase_glu(p, l, smh);
    GSYNC();
    phase_merge(p, l, smem);
    if (l == 0 && (blockIdx.x >> 3) >= 24) {
      const int hb = (int)((((blockIdx.x >> 3) - 24) * 8 + (blockIdx.x & 7)) * 2) + VHALF;
      s5_gen_item(p, 1, hb, smh);
    }
    GSYNC();
    phase_out(p, l, smem);
    if (l == 0 && (blockIdx.x >> 3) >= 24) {
      const int hb = (int)((((blockIdx.x >> 3) - 24) * 8 + (blockIdx.x & 7)) * 2) + VHALF;
      s5_gen_item(p, 1, hb + 128, smh);
    }
    GSYNC();
    for (int rep = 0; rep < REP_SYNC; ++rep) GSYNC();
  }
  phase_final(p);
}

extern "C" void kernel_launch(void* const* d_in, const int* in_sizes, int n_in, void* d_out, int out_size,
                              void* d_ws, size_t ws_size, hipStream_t stream) {
  Params p{};
  const float* const* in = (const float* const*)d_in;
  p.x_prompt = in[0]; p.x_sample = in[1]; p.c = in[2]; p.st_re = in[3]; p.st_im = in[4]; p.st_gla = in[5];
  p.c_ctx = in[6]; p.norm_g = in[7]; p.w_mod = in[8]; p.b_mod = in[9]; p.w_in = in[10]; p.wg_up = in[11];
  p.bg = in[12]; p.gla_norm_g = in[13]; p.lam_re = in[14]; p.lam_im = in[15]; p.log_dt = in[16];
  p.b_re = in[17]; p.b_im = in[18]; p.c_re = in[19]; p.c_im = in[20]; p.s5_d = in[21]; p.w_glu = in[22];
  p.b_glu = in[23]; p.w_pa = in[24]; p.w_pb = in[25]; p.w_o = in[26]; p.final_g = in[27];
  p.out = (float*)d_out;
  char* ws = (char*)d_ws;
  size_t off = 0;
  auto take = [&](size_t bytes) { char* r = ws + off; off += (bytes + 255) & ~(size_t)255; return r; };
  p.w_inT = (bfu*)take((size_t)2 * DINP * LDH * 2);
  p.w_gluT = (bfu*)take((size_t)2 * 512 * 512 * 2);
  p.w_paT = (bfu*)take((size_t)2 * 1024 * 512 * 2);
  p.w_pbT = (bfu*)take((size_t)2 * 1024 * 512 * 2);
  p.w_oT = (bfu*)take((size_t)2 * 1024 * 1024 * 2);
  p.mod = (float*)take((size_t)2 * 5 * 3072 * 4);
  p.pos_r = (float*)take((size_t)32 * 512 * 4);
  p.pos_c = (float*)take((size_t)64 * 512 * 4);
  p.h = (bfu*)take((size_t)NTOK * LDH * 2);
  p.proj = (bfu*)take((size_t)NTOK * PW * 2);
  p.ys5 = (bfu*)take((size_t)NTOK * 512 * 2);
  p.ya = (bfu*)take((size_t)NTOK * 512 * 2);
  p.yb = (bfu*)take((size_t)NTOK * 512 * 2);
  p.merged = (bfu*)take((size_t)NTOK * D * 2);
  p.tmp_s5 = nullptr;
  p.ebuf = (float*)p.merged;
  p.carry = (bfu*)((char*)p.merged + (size_t)32 * NCHUNK * 256 * 4);
  p.ug = (bfu*)take((size_t)32 * NTOK * 16 * 2);
  p.opMG = (bfu*)take((size_t)32 * 512 * 768 * 2);
  p.opE = (bfu*)take((size_t)32 * 256 * 512 * 2);
  p.gla_sloc = (float*)p.ys5;
  p.gla_aseg = (float*)((char*)p.ys5 + (size_t)256 * 8192 * 4);
  if (off > ws_size) fprintf(stderr, "workspace too small: %zu > %zu\n", off, ws_size);
  p.bar = (unsigned*)take((size_t)XCD_BAR_WORDS * 4);
  p.gla_o = (bfu*)p.h;
  p.tmp_gla = (float*)p.h;
  constexpr size_t kLds = 131072 + 16;
  static int grid_blocks = 0;
  if (!grid_blocks) {
    int dev = 0, cus = 0, per_cu = 0;
    hipGetDevice(&dev);
    hipDeviceGetAttribute(&cus, hipDeviceAttributeMultiprocessorCount, dev);
    hipFuncSetAttribute((const void*)k_mega, hipFuncAttributeMaxDynamicSharedMemorySize, (int)kLds);
    hipOccupancyMaxActiveBlocksPerMultiprocessor(&per_cu, k_mega, 512, kLds);
    if (per_cu > 1) per_cu = 1;
    grid_blocks = cus * per_cu;
    if (grid_blocks % 8 != 0 || grid_blocks <= 0) fprintf(stderr, "unexpected grid %d\n", grid_blocks);
  }
  hipMemsetAsync(p.bar, 0, (size_t)XCD_BAR_WORDS * 4, stream);
  void* args[] = {&p};
  hipError_t e = hipLaunchCooperativeKernel((void*)k_mega, dim3(grid_blocks), dim3(512), args, kLds, stream);
  if (e != hipSuccess) fprintf(stderr, "cooperative launch failed: %s (grid %d)\n", hipGetErrorString(e), grid_blocks);
}
```

```cpp
#include <hip/hip_runtime.h>
#include <hip/hip_cooperative_groups.h>
#include <stdint.h>
#include <math.h>
#include <stdio.h>
namespace cg = cooperative_groups;

#ifndef REP_PREP
#define REP_PREP 0
#endif
#ifndef REP_GIN
#define REP_GIN 0
#endif
#ifndef REP_X1
#define REP_X1 0
#endif
#ifndef REP_X2
#define REP_X2 0
#endif
#ifndef REP_Y
#define REP_Y 0
#endif
#ifndef REP_MERGE
#define REP_MERGE 0
#endif
#ifndef REP_SYNC
#define REP_SYNC 0
#endif
#ifndef ONE_LAUNCH
#define ONE_LAUNCH 1
#endif

typedef unsigned short bfu;
typedef __attribute__((ext_vector_type(8))) short bf16x8;
typedef __attribute__((ext_vector_type(16))) float f32x16;
typedef __attribute__((ext_vector_type(2))) __bf16 bf2_t;
typedef __attribute__((ext_vector_type(2))) float f2_t;

#define DI __device__ __forceinline__

constexpr int D = 1024;
constexpr int NTOK = 12288;
constexpr int NPROMPT = 4096;
constexpr int DIN = 4624;
constexpr int DINP = 4864;
constexpr int LDH = 1088;
constexpr int PW = 4112;
constexpr int OFF_GA = 0, OFF_Q = 512, OFF_K = 768, OFF_V = 1024, OFF_GB = 1536, OFF_GL = 2048,
              OFF_MA = 2064, OFF_MB = 3088;
constexpr int NCHUNK = NTOK / 32;
constexpr size_t OUT_RE = (size_t)NTOK * D;
constexpr size_t OUT_IM = OUT_RE + 131072;
constexpr size_t OUT_GLA = OUT_IM + 131072;
constexpr float EPS = 1e-6f;
constexpr int MODH = 2 * 5 * 3072;

struct Params {
  const float *x_prompt, *x_sample, *c, *st_re, *st_im, *st_gla, *c_ctx, *norm_g, *w_mod, *b_mod, *w_in,
      *wg_up, *bg, *gla_norm_g, *lam_re, *lam_im, *log_dt, *b_re, *b_im, *c_re, *c_im, *s5_d, *w_glu,
      *b_glu, *w_pa, *w_pb, *w_o, *final_g;
  float* out;
  bfu *w_inT, *w_gluT, *w_paT, *w_pbT, *w_oT;
  float *mod, *pos_r, *pos_c, *tmp_s5, *tmp_gla;
  bfu *h, *proj, *ys5, *ya, *yb, *merged;
  bfu *ug, *opMG, *opE, *carry;
  float *ebuf, *gla_sloc, *gla_aseg;
  unsigned* bar;
  bfu* gla_o;
};

DI int tid_() { int t = threadIdx.x & 255; asm volatile("" : "+v"(t)); return t; }
#define VHALF ((int)__builtin_amdgcn_readfirstlane((int)(threadIdx.x >> 8)))
#define VBID ((int)(blockIdx.x * 2 + VHALF))
#define NVB ((int)(gridDim.x * 2))
#define VXCD ((int)(blockIdx.x & 7))
#define VJ ((int)((blockIdx.x >> 3) * 2 + VHALF))
#define VNLOC ((int)((gridDim.x >> 3) * 2))
DI float bf2f(bfu v) { return __uint_as_float(((unsigned)v) << 16); }
DI bfu f2bf(float x) { __bf16 b = (__bf16)x; return __builtin_bit_cast(unsigned short, b); }
DI unsigned pack2(float lo, float hi) {
  f2_t v = {lo, hi};
  bf2_t w = __builtin_convertvector(v, bf2_t);
  return __builtin_bit_cast(unsigned, w);
}
DI float sigmoidf_(float x) { return 1.f / (1.f + __expf(-x)); }
DI float siluf_(float x) { return x / (1.f + __expf(-x)); }
DI float geluf_(float x) {
  float u = 0.7978845608028654f * (x + 0.044715f * x * x * x);
  float t = 1.f - 2.f / (__expf(2.f * u) + 1.f);
  return 0.5f * x * (1.f + t);
}
DI float wave_sum(float v) {
#pragma unroll
  for (int o = 32; o >= 1; o >>= 1) v += __shfl_xor(v, o);
  return v;
}
DI void unpack8(const uint4 v, float (&f)[8]) {
  f[0] = __uint_as_float(v.x << 16); f[1] = __uint_as_float(v.x & 0xffff0000u);
  f[2] = __uint_as_float(v.y << 16); f[3] = __uint_as_float(v.y & 0xffff0000u);
  f[4] = __uint_as_float(v.z << 16); f[5] = __uint_as_float(v.z & 0xffff0000u);
  f[6] = __uint_as_float(v.w << 16); f[7] = __uint_as_float(v.w & 0xffff0000u);
}
DI uint4 pack8(const float (&f)[8]) {
  uint4 o;
  o.x = pack2(f[0], f[1]); o.y = pack2(f[2], f[3]); o.z = pack2(f[4], f[5]); o.w = pack2(f[6], f[7]);
  return o;
}
DI int cond_of_tok(int tok) { return tok < NPROMPT ? 0 : 1 + ((tok - NPROMPT) >> 11); }

DI void transpose_tile(const float* __restrict__ src, int K, int N, bfu* __restrict__ dst, int kt, int nt,
                       float* sm, int ldd = 0) {
  if (ldd == 0) ldd = K;
  const int tid = tid_(), c = tid & 63, r4 = tid >> 6;
  const int k0 = kt * 64, n0 = nt * 64;
  float v[16];
  const bool inb = (n0 + c) < N;
#pragma unroll
  for (int i = 0; i < 16; ++i) v[i] = inb ? src[(size_t)(k0 + i * 4 + r4) * N + n0 + c] : 0.f;
#pragma unroll
  for (int i = 0; i < 16; ++i) sm[(i * 4 + r4) * 65 + c] = v[i];
  __syncthreads();
  {
    const int n = tid >> 2, kc = tid & 3;
    float o[16];
#pragma unroll
    for (int i = 0; i < 16; ++i) o[i] = sm[(kc * 16 + i) * 65 + n];
    bfu* dp = dst + (size_t)(n0 + n) * ldd + k0 + kc * 16;
    *(uint4*)dp = pack8(*(float(*)[8])&o[0]);
    *(uint4*)(dp + 8) = pack8(*(float(*)[8])&o[8]);
  }
  __syncthreads();
}

DI void phase_prep(const Params& p, char* smem) {
  float* sm = (float*)smem;
  const int tid = tid_();
  for (int it = VBID; it < 192; it += NVB) {
    const int kh = it & 1, jb = (it >> 1) % 48, l = it / 96;
    float* ssil = sm;
    float* sred = sm + 5 * 512;
    for (int idx = tid; idx < 2560; idx += 256) {
      int ci = idx >> 9, k = (idx & 511) + kh * 512;
      float cv = (ci == 0) ? p.c_ctx[k] : p.c[(ci - 1) * 1024 + k];
      ssil[idx] = cv / (1.f + expf(-cv));
    }
    __syncthreads();
    const int jj = tid & 63, kq = tid >> 6;
    const int j = jb * 64 + jj;
    float acc[5] = {0.f, 0.f, 0.f, 0.f, 0.f};
    const float* wp = p.w_mod + ((size_t)l * 1024 + kh * 512 + kq * 128) * 3072 + j;
#pragma unroll 16
    for (int k = 0; k < 128; ++k) {
      float w = wp[(size_t)k * 3072];
#pragma unroll
      for (int ci = 0; ci < 5; ++ci) acc[ci] += ssil[ci * 512 + kq * 128 + k] * w;
    }
#pragma unroll
    for (int ci = 0; ci < 5; ++ci) sred[(kq * 5 + ci) * 64 + jj] = acc[ci];
    __syncthreads();
    for (int idx = tid; idx < 320; idx += 256) {
      int ci = idx >> 6, j2 = idx & 63;
      float sv = kh == 0 ? p.b_mod[l * 3072 + jb * 64 + j2] : 0.f;
#pragma unroll
      for (int q = 0; q < 4; ++q) sv += sred[(q * 5 + ci) * 64 + j2];
      p.mod[((size_t)(kh * 2 + l) * 5 + ci) * 3072 + jb * 64 + j2] = sv;
    }
    __syncthreads();
  }
  for (int idx = VBID * 256 + tid; idx < 96 * 512; idx += NVB * 256) {
    int r = idx >> 9, i = idx & 511;
    int pos = r < 32 ? r : r - 32;
    int q = i & 255;
    double f = exp(-log(10000.0) * (double)q / 256.0);
    double ang = (double)pos * f;
    float v = (float)((i < 256) ? sin(ang) : cos(ang));
    if (r < 32) p.pos_r[r * 512 + i] = v; else p.pos_c[(r - 32) * 512 + i] = v;
  }
  for (int it = VBID; it < 3584; it += NVB) {
    int l = it / 1792, r = it % 1792;
    if (r < 1216) {
      transpose_tile(p.w_in + (size_t)l * 1024 * DIN, 1024, DIN, p.w_inT + (size_t)l * DINP * LDH, r % 16, r / 16, sm, LDH);
    } else if (r < 1280) {
      r -= 1216;
      transpose_tile(p.w_glu + (size_t)l * 512 * 512, 512, 512, p.w_gluT + (size_t)l * 512 * 512, r % 8, r / 8, sm);
    } else if (r < 1408) {
      r -= 1280;
      transpose_tile(p.w_pa + (size_t)l * 512 * 1024, 512, 1024, p.w_paT + (size_t)l * 1024 * 512, r % 8, r / 8, sm);
    } else if (r < 1536) {
      r -= 1408;
      transpose_tile(p.w_pb + (size_t)l * 512 * 1024, 512, 1024, p.w_pbT + (size_t)l * 1024 * 512, r % 8, r / 8, sm);
    } else {
      r -= 1536;
      transpose_tile(p.w_o + (size_t)l * 1024 * 1024, 1024, 1024, p.w_oT + (size_t)l * 1024 * 1024, r % 16, r / 16, sm);
    }
  }
}

DI void phase_h(const Params& p, int l) {
  const int tid = tid_(), lane = tid & 63, w = tid >> 6;
  for (int it = VBID; it < NTOK / 4; it += NVB) {
    const int tok = it * 4 + w;
    float4 v[4];
    float* xs = p.out + (size_t)tok * D;
    if (l == 0) {
      const float* src = tok < NPROMPT ? p.x_prompt + (size_t)tok * D : p.x_sample + (size_t)(tok - NPROMPT) * D;
#pragma unroll
      for (int i = 0; i < 4; ++i) v[i] = *(const float4*)(src + lane * 4 + 256 * i);
      if (tok >= NPROMPT) {
        int t = (tok - NPROMPT) & 2047, row = t >> 6, col = t & 63;
#pragma unroll
        for (int i = 0; i < 4; ++i) {
          int d = lane * 4 + 256 * i;
          const float* pe = d < 512 ? p.pos_r + row * 512 + d : p.pos_c + col * 512 + (d - 512);
          float4 e = *(const float4*)pe;
          v[i].x += e.x; v[i].y += e.y; v[i].z += e.z; v[i].w += e.w;
        }
      }
#pragma unroll
      for (int i = 0; i < 4; ++i) *(float4*)(xs + lane * 4 + 256 * i) = v[i];
    } else {
#pragma unroll
      for (int i = 0; i < 4; ++i) v[i] = *(const float4*)(xs + lane * 4 + 256 * i);
    }
    float ss = 0.f;
#pragma unroll
    for (int i = 0; i < 4; ++i) ss += v[i].x * v[i].x + v[i].y * v[i].y + v[i].z * v[i].z + v[i].w * v[i].w;
    ss = wave_sum(ss);
    const float rstd = rsqrtf(ss * (1.f / 1024.f) + EPS);
    const float* md = p.mod + (size_t)(l * 5 + cond_of_tok(tok)) * 3072;
    const float* ng = p.norm_g + l * 1024;
#pragma unroll
    for (int i = 0; i < 4; ++i) {
      int d = lane * 4 + 256 * i;
      float4 g = *(const float4*)(ng + d);
      float4 sh = *(const float4*)(md + d);
      float4 sc = *(const float4*)(md + 1024 + d);
      {
        const float4 sh1 = *(const float4*)(md + MODH + d);
        const float4 sc1 = *(const float4*)(md + MODH + 1024 + d);
        sh.x += sh1.x; sh.y += sh1.y; sh.z += sh1.z; sh.w += sh1.w;
        sc.x += sc1.x; sc.y += sc1.y; sc.z += sc1.z; sc.w += sc1.w;
      }
      float a0 = v[i].x * rstd * g.x * (1.f + sc.x) + sh.x;
      float a1 = v[i].y * rstd * g.y * (1.f + sc.y) + sh.y;
      float a2 = v[i].z * rstd * g.z * (1.f + sc.z) + sh.z;
      float a3 = v[i].w * rstd * g.w * (1.f + sc.w) + sh.w;
      uint2 o; o.x = pack2(a0, a1); o.y = pack2(a2, a3);
      *(uint2*)(p.h + (size_t)tok * LDH + d) = o;
    }
  }
}

DI void gemm_core(const bfu* __restrict__ A, int lda, const bfu* __restrict__ B, int ldb, int K, char* smem,
                  f32x16 (&acc)[2][2]) {
  const int tid = tid_(), lane = tid & 63, w = tid >> 6, wm = w >> 1, wn = w & 1;
  const int c8 = tid & 7, r0 = tid >> 3;
  const bfu* ga = A + (size_t)r0 * lda + c8 * 8;
  const bfu* gb = B + (size_t)r0 * ldb + c8 * 8;
  const int st_off = r0 * 128 + ((c8 ^ ((r0 >> 1) & 7)) * 16);
  const int fr = lane & 31, hh = lane >> 5, fsw = (fr >> 1) & 7;
  const int a_base = (wm * 64 + fr) * 128;
  const int b_base = 16384 + (wn * 64 + fr) * 128;
  uint4 ra0, ra1, ra2, ra3, rb0, rb1, rb2, rb3, qa0, qa1, qa2, qa3, qb0, qb1, qb2, qb3;
  const int KT = K >> 6;
#define GEMM_LOADT(RA, RB, tile)                                                           \
  {                                                                                        \
    const int t_ = (tile) < KT ? (tile) : KT - 1;                                          \
    const bfu* ga_ = ga + t_ * 64; const bfu* gb_ = gb + t_ * 64;                          \
    RA##0 = *(const uint4*)(ga_);                        RB##0 = *(const uint4*)(gb_);                        \
    RA##1 = *(const uint4*)(ga_ + (size_t)32 * lda);     RB##1 = *(const uint4*)(gb_ + (size_t)32 * ldb);     \
    RA##2 = *(const uint4*)(ga_ + (size_t)64 * lda);     RB##2 = *(const uint4*)(gb_ + (size_t)64 * ldb);     \
    RA##3 = *(const uint4*)(ga_ + (size_t)96 * lda);     RB##3 = *(const uint4*)(gb_ + (size_t)96 * ldb);     \
  }
#define GEMM_STORET(buf, RA, RB)                                                           \
  {                                                                                        \
    *(uint4*)((buf) + st_off) = RA##0;          *(uint4*)((buf) + 16384 + st_off) = RB##0;          \
    *(uint4*)((buf) + st_off + 4096) = RA##1;   *(uint4*)((buf) + 16384 + st_off + 4096) = RB##1;   \
    *(uint4*)((buf) + st_off + 8192) = RA##2;   *(uint4*)((buf) + 16384 + st_off + 8192) = RB##2;   \
    *(uint4*)((buf) + st_off + 12288) = RA##3;  *(uint4*)((buf) + 16384 + st_off + 12288) = RB##3;  \
  }
#define GEMM_COMPUTE(cur)                                                                  \
  _Pragma("unroll") for (int s = 0; s < 4; ++s) {                                          \
    const int co = ((2 * s + hh) ^ fsw) * 16;                                              \
    bf16x8 a0 = *(const bf16x8*)((cur) + a_base + co);                                     \
    bf16x8 a1 = *(const bf16x8*)((cur) + a_base + 4096 + co);                              \
    bf16x8 b0 = *(const bf16x8*)((cur) + b_base + co);                                     \
    bf16x8 b1 = *(const bf16x8*)((cur) + b_base + 4096 + co);                              \
    acc[0][0] = __builtin_amdgcn_mfma_f32_32x32x16_bf16(a0, b0, acc[0][0], 0, 0, 0);       \
    acc[0][1] = __builtin_amdgcn_mfma_f32_32x32x16_bf16(a0, b1, acc[0][1], 0, 0, 0);       \
    acc[1][0] = __builtin_amdgcn_mfma_f32_32x32x16_bf16(a1, b0, acc[1][0], 0, 0, 0);       \
    acc[1][1] = __builtin_amdgcn_mfma_f32_32x32x16_bf16(a1, b1, acc[1][1], 0, 0, 0);       \
  }
  GEMM_LOADT(ra, rb, 0)
  GEMM_LOADT(qa, qb, 1)
  GEMM_STORET(smem, ra, rb)
  __syncthreads();
#pragma unroll 1
  for (int kt = 0; kt < KT; kt += 2) {
    GEMM_LOADT(ra, rb, kt + 2)
    __builtin_amdgcn_sched_barrier(0);
    GEMM_COMPUTE(smem)
    __builtin_amdgcn_sched_barrier(0);
    GEMM_STORET(smem + 32768, qa, qb)
    __syncthreads();
    GEMM_LOADT(qa, qb, kt + 3)
    __builtin_amdgcn_sched_barrier(0);
    GEMM_COMPUTE(smem + 32768)
    __builtin_amdgcn_sched_barrier(0);
    GEMM_STORET(smem, ra, rb)
    __syncthreads();
  }
}

DI void acc_zero(f32x16 (&acc)[2][2]) {
#pragma unroll
  for (int i = 0; i < 2; ++i)
#pragma unroll
    for (int j = 0; j < 2; ++j)
#pragma unroll
      for (int r = 0; r < 16; ++r) acc[i][j][r] = 0.f;
}

DI void acc_to_lds(const f32x16 (&acc)[2][2], char* smem) {
  float* sf = (float*)smem;
  const int tid = tid_(), lane = tid & 63, w = tid >> 6;
  const int rb = (w >> 1) * 64 + 4 * (lane >> 5), cb = (w & 1) * 64 + (lane & 31);
#pragma unroll
  for (int i = 0; i < 2; ++i)
#pragma unroll
    for (int j = 0; j < 2; ++j)
#pragma unroll
      for (int r = 0; r < 16; ++r)
        sf[(rb + i * 32 + (r & 3) + 8 * (r >> 2)) * 128 + cb + j * 32] = acc[i][j][r];
}
#define EPI_LDS(...)                                                             \
  {                                                                              \
    acc_to_lds(acc, smem);                                                       \
    __syncthreads();                                                             \
    _Pragma("unroll 1") for (int it_ = 0; it_ < 8; ++it_) {                      \
      const int row = (tid_() >> 4) + 16 * it_;                             \
      const int c0 = (tid_() & 15) * 8;                                     \
      float v[8];                                                                \
      {                                                                          \
        const float4 t0 = *(const float4*)(smem + (row * 128 + c0) * 4);         \
        const float4 t1 = *(const float4*)(smem + (row * 128 + c0 + 4) * 4);     \
        v[0] = t0.x; v[1] = t0.y; v[2] = t0.z; v[3] = t0.w;                      \
        v[4] = t1.x; v[5] = t1.y; v[6] = t1.z; v[7] = t1.w;                      \
      }                                                                          \
      __VA_ARGS__                                                                \
    }                                                                            \
    __syncthreads();                                                             \
  }

typedef __attribute__((ext_vector_type(4))) float f32x4;
constexpr int G_BK = 64, G_HALF = 128, G_HT = G_HALF * G_BK;
DI int g_lds_byte(int r, int c) {
  int st = (r >> 4) * 2 + (c >> 5), rr = r & 15, cc = c & 31, ob = rr * 64 + cc * 2;
  return st * 1024 + (ob ^ (((ob >> 9) & 1) << 5));
}
DI void g_stage_rc(int b, int& R, int& C) {
  int st = b / 1024, sb = b % 1024, swz = sb ^ (((sb >> 9) & 1) << 5);
  R = (st >> 1) * 16 + swz / 64; C = (st & 1) * 32 + (swz % 64) / 2;
}
DI const char* g_uniform(const char* ptr) {
  unsigned long long u = (unsigned long long)ptr;
  unsigned lo = __builtin_amdgcn_readfirstlane((unsigned)u), hi = __builtin_amdgcn_readfirstlane((unsigned)(u >> 32));
  return (const char*)(((unsigned long long)hi << 32) | lo);
}
DI void gemm256(const bfu* __restrict__ A, int lda, const bfu* __restrict__ Bt, int ldb, int K, int brow, int bcol,
                bfu* shm, f32x4 (&acc)[2][2][4][2]) {
#define G_SA(b, h) (shm + ((b) * 2 + (h)) * G_HT)
#define G_SB(b, h) (shm + (4 + (b) * 2 + (h)) * G_HT)
#define G_STAGE(P, BASE, LD, br, kt)                                                                   \
  do {                                                                                                 \
    const char* _u = g_uniform((const char*)((BASE) + ((long)(br) * (LD) + (long)(kt) * G_BK)));       \
    __builtin_amdgcn_global_load_lds((const unsigned*)(_u + soff_b),                                   \
        (__attribute__((address_space(3))) unsigned*)((char*)(P) + ldst), 16, 0, 0);                   \
    __builtin_amdgcn_global_load_lds((const unsigned*)(_u + 128 * (long)(LD) + soff_b),                \
        (__attribute__((address_space(3))) unsigned*)((char*)(P) + ldst + 8192), 16, 0, 0);            \
  } while (0)
#define G_LDA(dst, b, h) for (int m = 0; m < 4; ++m) for (int k = 0; k < 2; ++k) \
    dst[m][k] = *reinterpret_cast<const bf16x8*>((char*)G_SA(b, h) + a_rd + m * 2048 + k * 1024)
#define G_LDB(dst, b, h) for (int n = 0; n < 2; ++n) for (int k = 0; k < 2; ++k) \
    dst[n][k] = *reinterpret_cast<const bf16x8*>((char*)G_SB(b, h) + b_rd + n * 2048 + k * 1024)
#define G_MMA(ai, bj, At, Bt_)                                                                         \
  do {                                                                                                 \
    __builtin_amdgcn_s_setprio(1);                                                                     \
    for (int m = 0; m < 4; ++m) for (int n = 0; n < 2; ++n) for (int k = 0; k < 2; ++k)                \
      acc[ai][bj][m][n] = __builtin_amdgcn_mfma_f32_16x16x32_bf16(At[m][k], Bt_[n][k], acc[ai][bj][m][n], 0, 0, 0); \
    __builtin_amdgcn_s_setprio(0);                                                                     \
  } while (0)
#define G_WAIT_V(n) asm volatile("s_waitcnt vmcnt(" #n ")" ::: "memory")
#define G_WAIT_L(n) asm volatile("s_waitcnt lgkmcnt(" #n ")" ::: "memory")
#define G_BAR __builtin_amdgcn_s_barrier()
#define G_SCHED __builtin_amdgcn_sched_barrier(0)
  int t512 = threadIdx.x; asm volatile("" : "+v"(t512));
  const int wid = __builtin_amdgcn_readfirstlane(t512 >> 6), lane = t512 & 63, wr = wid >> 2, wc = wid & 3, fr = lane & 15, fq = lane >> 4;
  const int ldst = t512 * 16;
  unsigned soff_b;
  {
    int R0, C0;
    g_stage_rc(ldst, R0, C0);
    soff_b = (unsigned)(R0 * lda + C0) * 2u;
  }
  const int lane_off = (fr * 64 + fq * 16) ^ ((fr >> 3) << 5);
  const int a_rd = wr * 8192 + lane_off, b_rd = wc * 4096 + lane_off;
  bf16x8 At[4][2], B0[2][2], B1[2][2];
  const int nt = K / G_BK;
  G_STAGE(G_SB(0, 0), Bt, ldb, bcol, 0); G_STAGE(G_SA(0, 0), A, lda, brow, 0);
  G_STAGE(G_SB(0, 1), Bt, ldb, bcol + G_HALF, 0); G_STAGE(G_SA(0, 1), A, lda, brow + G_HALF, 0);
  if (wr == 1) G_BAR;
  G_WAIT_V(4); G_BAR;
  G_STAGE(G_SB(1, 0), Bt, ldb, bcol, 1); G_STAGE(G_SA(1, 0), A, lda, brow, 1); G_STAGE(G_SB(1, 1), Bt, ldb, bcol + G_HALF, 1);
  G_WAIT_V(6); G_BAR;
#pragma unroll 1
  for (int t = 0; t < nt - 2; t += 2) {
    G_LDB(B0, 0, 0); G_SCHED; G_LDA(At, 0, 0); G_STAGE(G_SA(1, 1), A, lda, brow + G_HALF, t + 1);
    G_WAIT_L(8); G_BAR; G_WAIT_L(0); G_MMA(0, 0, At, B0); G_BAR; G_SCHED;
    G_LDB(B1, 0, 1); G_STAGE(G_SB(0, 0), Bt, ldb, bcol, t + 2);
    G_BAR; G_WAIT_L(0); G_MMA(0, 1, At, B1); G_BAR;
    G_LDA(At, 0, 1); G_STAGE(G_SA(0, 0), A, lda, brow, t + 2);
    G_BAR; G_WAIT_L(0); G_MMA(1, 0, At, B0); G_BAR; G_SCHED;
    G_STAGE(G_SB(0, 1), Bt, ldb, bcol + G_HALF, t + 2);
    G_WAIT_V(6); G_BAR; G_MMA(1, 1, At, B1); G_BAR;
    G_LDB(B0, 1, 0); G_SCHED; G_LDA(At, 1, 0); G_STAGE(G_SA(0, 1), A, lda, brow + G_HALF, t + 2);
    G_WAIT_L(8); G_BAR; G_WAIT_L(0); G_MMA(0, 0, At, B0); G_BAR; G_SCHED;
    G_LDB(B1, 1, 1); G_STAGE(G_SB(1, 0), Bt, ldb, bcol, t + 3);
    G_BAR; G_WAIT_L(0); G_MMA(0, 1, At, B1); G_BAR;
    G_LDA(At, 1, 1); G_STAGE(G_SA(1, 0), A, lda, brow, t + 3);
    G_BAR; G_WAIT_L(0); G_MMA(1, 0, At, B0); G_BAR; G_SCHED;
    G_STAGE(G_SB(1, 1), Bt, ldb, bcol + G_HALF, t + 3);
    G_WAIT_V(6); G_BAR; G_MMA(1, 1, At, B1); G_BAR;
  }
  { G_LDB(B0, 0, 0); G_LDA(At, 0, 0); G_STAGE(G_SA(1, 1), A, lda, brow + G_HALF, nt - 1);
    G_BAR; G_WAIT_L(0); G_MMA(0, 0, At, B0); G_BAR;
    G_LDB(B1, 0, 1); G_BAR; G_WAIT_L(0); G_MMA(0, 1, At, B1); G_BAR;
    G_LDA(At, 0, 1); G_WAIT_V(4); G_BAR; G_WAIT_L(0); G_MMA(1, 0, At, B0); G_MMA(1, 1, At, B1); G_BAR; }
  { G_LDB(B0, 1, 0); G_LDA(At, 1, 0); G_WAIT_V(2); G_BAR; G_WAIT_L(0); G_MMA(0, 0, At, B0); G_BAR;
    G_LDB(B1, 1, 1); G_WAIT_V(0); G_BAR; G_WAIT_L(0); G_MMA(0, 1, At, B1); G_BAR;
    G_LDA(At, 1, 1); G_BAR; G_WAIT_L(0); G_MMA(1, 0, At, B0); G_MMA(1, 1, At, B1); G_BAR; }
  if (wr == 0) G_BAR;
}
DI void acc256_zero(f32x4 (&acc)[2][2][4][2]) {
#pragma unroll
  for (int a = 0; a < 2; ++a)
#pragma unroll
    for (int b = 0; b < 2; ++b)
#pragma unroll
      for (int m = 0; m < 4; ++m)
#pragma unroll
        for (int n = 0; n < 2; ++n) acc[a][b][m][n] = (f32x4){0.f, 0.f, 0.f, 0.f};
}
#define EPI256(...)                                                                                   \
  {                                                                                                    \
    int t512_ = threadIdx.x; asm volatile("" : "+v"(t512_));     \
    const int wid_ = t512_ >> 6, lane_ = t512_ & 63, wr_ = wid_ >> 2, wc_ = wid_ & 3,                  \
              fr_ = lane_ & 15, fq_ = lane_ >> 4;                                                      \
    float* sf_ = (float*)smem;                                                                         \
    _Pragma("unroll") for (int ai_ = 0; ai_ < 2; ++ai_) {                                              \
      __syncthreads();                                                                                 \
      _Pragma("unroll") for (int bj_ = 0; bj_ < 2; ++bj_)                                              \
      _Pragma("unroll") for (int m_ = 0; m_ < 4; ++m_)                                                 \
      _Pragma("unroll") for (int n_ = 0; n_ < 2; ++n_)                                                 \
      _Pragma("unroll") for (int j_ = 0; j_ < 4; ++j_)                                                 \
        sf_[(wr_ * 64 + m_ * 16 + fq_ * 4 + j_) * 256 + ((bj_ * 128 + wc_ * 32 + n_ * 16 + fr_) ^ (fq_ << 4))] = \
            acc[ai_][bj_][m_][n_][j_];                                                                 \
      __syncthreads();                                                                                 \
      _Pragma("unroll 1") for (int it_ = 0; it_ < 8; ++it_) {                                          \
        const int idx_ = t512_ + 512 * it_;                                                            \
        const int rl_ = idx_ >> 5, c0 = (idx_ & 31) * 8;                                               \
        const int row = ai_ * 128 + rl_;                                                               \
        float v[8];                                                                                    \
        {                                                                                              \
          const float* sp_ = sf_ + rl_ * 256 + (c0 ^ (((rl_ >> 2) & 3) << 4));                          \
          const float4 t0 = *(const float4*)sp_; const float4 t1 = *(const float4*)(sp_ + 4);          \
          v[0] = t0.x; v[1] = t0.y; v[2] = t0.z; v[3] = t0.w;                                          \
          v[4] = t1.x; v[5] = t1.y; v[6] = t1.z; v[7] = t1.w;                                          \
        }                                                                                              \
        __VA_ARGS__                                                                                    \
      }                                                                                                \
    }                                                                                                  \
    __syncthreads();                                                                                   \
  }

template <int MT, int NT, int BH>
DI bool xcd_tile(int iter, int& mt, int& nt) {
  constexpr int MPX = MT / 8, TPX = MPX * NT;
  const int xcd = VXCD, j = VJ, nloc = VNLOC;
  const int q = j + iter * nloc;
  if (q >= TPX) return false;
  const int band = q / (BH * NT), r = q % (BH * NT);
  nt = r / BH;
  mt = xcd * MPX + band * BH + (r % BH);
  return true;
}

DI bool tile256(int iter, int NT, int& mt, int& nt) {
  const int xcd = blockIdx.x & 7, j = blockIdx.x >> 3, nloc = gridDim.x >> 3;
  const int q = j + iter * nloc;
  if (q >= 6 * NT) return false;
  nt = q / 6; mt = xcd * 6 + q % 6;
  return true;
}
DI void phase_gemm_in(const Params& p, int l, char* smem) {
  const bfu* W = p.w_inT + (size_t)l * DINP * LDH;
  for (int iter = 0;; ++iter) {
    int mt, nt;
    if (!tile256(iter, 19, mt, nt)) break;
    f32x4 acc[2][2][4][2];
    acc256_zero(acc);
    gemm256(p.h, LDH, W, LDH, 1024, mt * 256, nt * 256, (bfu*)smem, acc);
    const int m0 = mt * 256, n0 = nt * 256;
    EPI256({
      const int n = n0 + c0;
      if (n < 512) *(uint4*)(p.ug + ((size_t)(n >> 4) * NTOK + (m0 + row)) * 16 + (n & 15)) = pack8(v);
      else if (n < DIN) *(uint4*)(p.proj + (size_t)(m0 + row) * PW + (n - 512)) = pack8(v);
    })
  }
}

DI void s5_gen_item(const Params& p, int l, int item, char* smem) {
  const int tid = tid_();
  const int g = item >> 3, r = item & 7;
  float* sBr = (float*)smem;
  float* sBi = sBr + 2048;
  float* sCr = sBi + 2048;
  float* sCi = sCr + 1024;
  float* sAK = sCi + 1024;
  float* sAE = sAK + 1024;
  float* sAG = sAE + 1024;
  float* sK = sAG + 1024;
  bfu* E = p.opE + (size_t)g * 256 * 512;
  bfu* MG = p.opMG + (size_t)g * 512 * 768;
  __syncthreads();
  if (tid < 128) {
    const int d = tid >> 6, pp = tid & 63;
    const size_t pi = ((size_t)(l * 2 + d) * 32 + g) * 64 + pp;
    const float lr = p.lam_re[pi], li = p.lam_im[pi];
    const float dt = expf(p.log_dt[(l * 2 + d) * 32 + g]);
    const float mag = expf(lr * dt);
    float sn, cs;
    sincosf(li * dt, &sn, &cs);
    const float are = mag * cs, aim = mag * sn;
    const float nr = are - 1.f, ni = aim, den = lr * lr + li * li;
    const float kr = (nr * lr + ni * li) / den, ki = (ni * lr - nr * li) / den;
#pragma unroll
    for (int c = 0; c < 16; ++c) {
      float br = p.b_re[((size_t)(l * 32 + g) * 64 + pp) * 16 + c];
      float bi = p.b_im[((size_t)(l * 32 + g) * 64 + pp) * 16 + c];
      sBr[(d * 64 + pp) * 16 + c] = kr * br - ki * bi;
      sBi[(d * 64 + pp) * 16 + c] = kr * bi + ki * br;
    }
#pragma unroll
    for (int q = 0; q < 4; ++q) {
      const int t = 4 * r + q;
      const int nK = t;
      const int nE = d == 0 ? 31 - t : t;
      const int nG = d == 0 ? t + 1 : 32 - t;
      float m, s_, c_;
      m = expf(lr * dt * (float)nK); sincosf(li * dt * (float)nK, &s_, &c_);
      sAK[((d * 4 + q) * 64 + pp) * 2] = m * c_; sAK[((d * 4 + q) * 64 + pp) * 2 + 1] = m * s_;
      m = expf(lr * dt * (float)nE); sincosf(li * dt * (float)nE, &s_, &c_);
      sAE[((d * 4 + q) * 64 + pp) * 2] = m * c_; sAE[((d * 4 + q) * 64 + pp) * 2 + 1] = m * s_;
      m = expf(lr * dt * (float)nG); sincosf(li * dt * (float)nG, &s_, &c_);
      sAG[((d * 4 + q) * 64 + pp) * 2] = m * c_; sAG[((d * 4 + q) * 64 + pp) * 2 + 1] = m * s_;
    }
  } else {
    for (int idx = tid - 128; idx < 1024; idx += 128) {
      sCr[idx] = p.c_re[(size_t)(l * 32 + g) * 1024 + idx];
      sCi[idx] = p.c_im[(size_t)(l * 32 + g) * 1024 + idx];
    }
  }
  __syncthreads();
  for (int idx = tid; idx < 256 * 64; idx += 256) {
    const int row = idx >> 6, cc = idx & 63, q = cc >> 4, c = cc & 15;
    const int part = row >> 6, pp = row & 63, d = part >> 1;
    const float ar = sAE[((d * 4 + q) * 64 + pp) * 2], ai = sAE[((d * 4 + q) * 64 + pp) * 2 + 1];
    const float br = sBr[(d * 64 + pp) * 16 + c], bi = sBi[(d * 64 + pp) * 16 + c];
    const float v = (part & 1) ? (ar * bi + ai * br) : (ar * br - ai * bi);
    E[(size_t)row * 512 + (4 * r + q) * 16 + c] = f2bf(v);
  }
  for (int idx = tid; idx < 64 * 256; idx += 256) {
    const int rr = idx >> 8, col = idx & 255, q = rr >> 4, c = rr & 15;
    const int part = col >> 6, pp = col & 63, d = part >> 1;
    const float ar = sAG[((d * 4 + q) * 64 + pp) * 2], ai = sAG[((d * 4 + q) * 64 + pp) * 2 + 1];
    const float cr = sCr[c * 64 + pp], ci = sCi[c * 64 + pp];
    const float v = (part & 1) ? -(cr * ai + ci * ar) : (cr * ar - ci * ai);
    MG[(size_t)((4 * r + q) * 16 + c) * 768 + 512 + col] = f2bf(v);
  }
  {
    const int d = tid >> 7, q = (tid >> 5) & 3, c = (tid >> 1) & 15, ch = tid & 1;
    float acc[8];
#pragma unroll
    for (int e = 0; e < 8; ++e) acc[e] = 0.f;
    for (int pp = 0; pp < 64; ++pp) {
      const float ar = sAK[((d * 4 + q) * 64 + pp) * 2], ai = sAK[((d * 4 + q) * 64 + pp) * 2 + 1];
      const float cr = sCr[c * 64 + pp], ci = sCi[c * 64 + pp];
      const float wr = cr * ar - ci * ai, wi = cr * ai + ci * ar;
#pragma unroll
      for (int e = 0; e < 8; ++e)
        acc[e] += wr * sBr[(d * 64 + pp) * 16 + ch * 8 + e] - wi * sBi[(d * 64 + pp) * 16 + ch * 8 + e];
    }
#pragma unroll
    for (int e = 0; e < 8; ++e) sK[((d * 4 + q) * 16 + c) * 16 + ch * 8 + e] = acc[e];
  }
  __syncthreads();
  for (int idx = tid; idx < 8192; idx += 256) {
    const int ch = idx & 1, c = (idx >> 1) & 15, tp = (idx >> 5) & 31, q = (idx >> 10) & 3, d = idx >> 12;
    const int tau = 4 * r + q;
    int sp;
    bool valid;
    if (d == 0) { sp = tp - tau; valid = sp >= 0; } else { sp = tp + tau; valid = (sp <= 31) && (tau > 0); }
    if (valid) {
      float v[8];
#pragma unroll
      for (int e = 0; e < 8; ++e) {
        float x = sK[((d * 4 + q) * 16 + c) * 16 + ch * 8 + e];
        if (tau == 0) x += sK[((1 * 4 + q) * 16 + c) * 16 + ch * 8 + e];
        v[e] = x;
      }
      *(uint4*)(MG + (size_t)(tp * 16 + c) * 768 + sp * 16 + ch * 8) = pack8(v);
    }
  }
  __syncthreads();
}

DI void phase_s5_gen(const Params& p, int l, char* smem) {
  for (int it = NVB - 1 - VBID; it < 256; it += NVB) s5_gen_item(p, l, it, smem);
}

DI void phase_s5_e(const Params& p, char* smem) {
  for (int q = VJ; q < 24; q += VNLOC) {
    const int g = VXCD * 4 + q / 6, r6 = q % 6, mt = r6 >> 1, nt = r6 & 1;
    f32x16 acc[2][2];
    acc_zero(acc);
    gemm_core(p.ug + ((size_t)g * NCHUNK + mt * 128) * 512, 512, p.opE + ((size_t)g * 256 + nt * 128) * 512, 512, 512,
              smem, acc);
    EPI_LDS({
      float* dst = p.ebuf + ((size_t)g * NCHUNK + mt * 128 + row) * 256 + nt * 128 + c0;
      *(float4*)dst = make_float4(v[0], v[1], v[2], v[3]);
      *(float4*)(dst + 4) = make_float4(v[4], v[5], v[6], v[7]);
    })
  }
}

DI void phase_s5_scan(const Params& p, int l) {
  const int tid = tid_();
  for (int it = VBID; it < 320; it += NVB) {
    const int wi = it * 2 + (tid >> 7);
    const int dir = (tid >> 6) & 1, pp = tid & 63;
    int chunk0, n, b, g;
    bool prompt;
    if (wi < 128) { b = wi >> 5; g = wi & 31; chunk0 = (NPROMPT + b * 2048) >> 5; n = 64; prompt = false; }
    else { int q = wi - 128; b = q >> 5; g = q & 31; chunk0 = (b * 256) >> 5; n = 8; prompt = true; }
    const size_t pi = ((size_t)(l * 2 + dir) * 32 + g) * 64 + pp;
    const float lr = p.lam_re[pi], li = p.lam_im[pi];
    const float dt = expf(p.log_dt[(l * 2 + dir) * 32 + g]);
    const float mag = expf(lr * dt * 32.f);
    float sn, cs;
    sincosf(li * dt * 32.f, &sn, &cs);
    const float are = mag * cs, aim = mag * sn;
    float hre = 0.f, him = 0.f;
    if (!prompt) {
      size_t si = ((size_t)((b * 2 + l) * 2 + dir)) * 2048 + g * 64 + pp;
      hre = p.st_re[si]; him = p.st_im[si];
    }
    const float* eb = p.ebuf + ((size_t)g * NCHUNK + chunk0) * 256 + dir * 128 + pp;
    bfu* cb = p.carry + ((size_t)g * NCHUNK + chunk0) * 256 + dir * 128 + pp;
    for (int k0 = 0; k0 < n; k0 += 8) {
      float er[8], ei[8];
#pragma unroll
      for (int j = 0; j < 8; ++j) {
        const int k = dir == 0 ? k0 + j : n - 1 - (k0 + j);
        er[j] = eb[(size_t)k * 256];
        ei[j] = eb[(size_t)k * 256 + 64];
      }
#pragma unroll
      for (int j = 0; j < 8; ++j) {
        const int k = dir == 0 ? k0 + j : n - 1 - (k0 + j);
        cb[(size_t)k * 256] = f2bf(hre);
        cb[(size_t)k * 256 + 64] = f2bf(him);
        const float nre = are * hre - aim * him + er[j];
        const float nim = are * him + aim * hre + ei[j];
        hre = nre; him = nim;
      }
    }
    if (prompt) {
      size_t oi = ((size_t)((b * 2 + l) * 2 + dir)) * 2048 + g * 64 + pp;
      p.out[OUT_RE + oi] = hre;
      p.out[OUT_IM + oi] = him;
    }
  }
}

DI void phase_s5_y(const Params& p, int l, char* smem) {
  for (int q = VJ; q < 48; q += VNLOC) {
    const int g = VXCD * 4 + q / 12, r12 = q % 12, mt = r12 >> 2, nt = r12 & 3;
    f32x16 acc[2][2];
    acc_zero(acc);
    const bfu* Bm = p.opMG + ((size_t)g * 512 + nt * 128) * 768;
    gemm_core(p.ug + ((size_t)g * NCHUNK + mt * 128) * 512, 512, Bm, 768, 512, smem, acc);
    gemm_core(p.carry + ((size_t)g * NCHUNK + mt * 128) * 256, 256, Bm + 512, 768, 256, smem, acc);
    EPI_LDS({
      const int chunk = mt * 128 + row, nn = nt * 128 + c0, tp = nn >> 4, c = nn & 15;
      const int tok = chunk * 32 + tp;
      float u[8], o[8];
      unpack8(*(const uint4*)(p.ug + ((size_t)g * NTOK + tok) * 16 + c), u);
      const float* dsk = p.s5_d + l * 512 + g * 16 + c;
      _Pragma("unroll") for (int e = 0; e < 8; ++e) o[e] = geluf_(v[e] + dsk[e] * u[e]);
      *(uint4*)(p.ys5 + (size_t)tok * 512 + g * 16 + c) = pack8(o);
    })
  }
}

DI void phase_glu(const Params& p, int l, char* smem) {
  const bfu* W = p.w_gluT + (size_t)l * 512 * 512;
  for (int iter = 0;; ++iter) {
    int mt, nt;
    if (!xcd_tile<96, 4, 12>(iter, mt, nt)) break;
    f32x16 acc[2][2];
    acc_zero(acc);
    gemm_core(p.ys5 + (size_t)mt * 128 * 512, 512, W + (size_t)nt * 128 * 512, 512, 512, smem, acc);
    const int m0 = mt * 128, n0 = nt * 128;
    EPI_LDS({
      const int n = n0 + c0;
      const size_t tk = (size_t)(m0 + row);
      float y[8], ga[8], o[8];
      unpack8(*(const uint4*)(p.ys5 + tk * 512 + n), y);
      unpack8(*(const uint4*)(p.proj + tk * PW + OFF_GA + n), ga);
      const float* bg = p.b_glu + l * 512 + n;
      _Pragma("unroll") for (int e = 0; e < 8; ++e) o[e] = y[e] * sigmoidf_(v[e] + bg[e]) * siluf_(ga[e]);
      *(uint4*)(p.ya + tk * 512 + n) = pack8(o);
    })
  }
}

constexpr int GL_QS = 0;
constexpr int GL_KS = GL_QS + 32 * 144;
constexpr int GL_KHT = GL_KS + 32 * 144;
constexpr int GL_VT = GL_KHT + 64 * 80;
constexpr int GL_PS = GL_VT + 128 * 80;
constexpr int GL_ST = GL_PS + 32 * 80;
constexpr int GL_AV = GL_ST + 128 * 144;
constexpr int GL_TOT = GL_AV + 256;
constexpr int GL_OS = GL_TOT + 1024;
static_assert(GL_OS + 32 * 132 * 4 <= 65536, "gla lds");

DI void gla_segment_info(int seg, int& tok_base, bool& prompt, int& b, int& sidx) {
  if (seg < 16) { prompt = true; b = seg; sidx = 0; tok_base = seg * 256; }
  else { int q = seg - 16; prompt = false; b = q >> 3; sidx = q & 7; tok_base = NPROMPT + b * 2048 + sidx * 256; }
}

template <bool STATE_ONLY>
DI void gla_chain(const Params& p, int l, char* smem, int seg, int hd, int dir) {
  const int tid = tid_(), lane = tid & 63, w = tid >> 6;
  const int fr = lane & 31, hh = lane >> 5;
  int tok_base, b, sidx;
  bool prompt;
  gla_segment_info(seg, tok_base, prompt, b, sidx);
  const int dk = tid & 63, tq = tid >> 6;
  const int dvl = tid & 127, th = tid >> 7;
  float wg[16];
#pragma unroll
  for (int q = 0; q < 16; ++q) wg[q] = p.wg_up[((size_t)(l * 2 + dir) * 16 + q) * 256 + hd * 64 + dk];
  const float bgv = p.bg[(l * 2 + dir) * 256 + hd * 64 + dk];
  float* sAv = (float*)(smem + GL_AV);
  float* sTot = (float*)(smem + GL_TOT);
  float* sOs = (float*)(smem + GL_OS);

  f32x16 S[2];
  {
    const int dvc = 32 * w + fr;
    if (STATE_ONLY || prompt) {
#pragma unroll
      for (int mt = 0; mt < 2; ++mt)
#pragma unroll
        for (int r = 0; r < 16; ++r) S[mt][r] = 0.f;
    } else {
      const float* sp = p.st_gla + ((size_t)(((b * 2 + l) * 2 + dir) * 4 + hd)) * 8192;
#pragma unroll
      for (int mt = 0; mt < 2; ++mt)
#pragma unroll
        for (int r = 0; r < 16; ++r) S[mt][r] = sp[(32 * mt + (r & 3) + 8 * (r >> 2) + 4 * hh) * 128 + dvc];
      const int nprev = dir == 0 ? sidx : 7 - sidx;
      for (int q = 0; q < nprev; ++q) {
        const int sprev = dir == 0 ? q : 7 - q;
        const size_t ci = (size_t)(((b * 8 + sprev) * 4 + hd) * 2 + dir);
        const float* sl = p.gla_sloc + ci * 8192;
        const float* al = p.gla_aseg + ci * 64;
#pragma unroll
        for (int mt = 0; mt < 2; ++mt)
#pragma unroll
          for (int r = 0; r < 16; ++r) {
            const int dkk = 32 * mt + (r & 3) + 8 * (r >> 2) + 4 * hh;
            S[mt][r] = al[dkk] * S[mt][r] + sl[dkk * 128 + dvc];
          }
      }
    }
  }
  float bsum = 0.f;
  __syncthreads();
  if (!STATE_ONLY) {
    const int dvc = 32 * w + fr;
#pragma unroll
    for (int mt = 0; mt < 2; ++mt)
#pragma unroll
      for (int q = 0; q < 4; ++q) {
        uint2 pk;
        pk.x = pack2(S[mt][4 * q], S[mt][4 * q + 1]);
        pk.y = pack2(S[mt][4 * q + 2], S[mt][4 * q + 3]);
        *(uint2*)(smem + GL_ST + dvc * 144 + (32 * mt + 8 * q + 4 * hh) * 2) = pk;
      }
  }

  uint4 rq = make_uint4(0, 0, 0, 0), rk = rq, rv0 = rq, rv1 = rq, rgl = rq;
#define GLA_ISSUE(nn)                                                                                         \
  {                                                                                                           \
    const int cn_ = dir == 0 ? (nn) : 7 - (nn);                                                               \
    const int c0_ = tok_base + cn_ * 32;                                                                      \
    const int tA = dir == 0 ? (tid >> 3) : 31 - (tid >> 3);                                                   \
    const bfu* prA = p.proj + (size_t)(c0_ + tA) * PW + hd * 64 + (tid & 7) * 8;                              \
    if (!STATE_ONLY) rq = *(const uint4*)(prA + OFF_Q);                                                       \
    rk = *(const uint4*)(prA + OFF_K);                                                                        \
    const int tV0 = dir == 0 ? (tid >> 4) : 31 - (tid >> 4);                                                  \
    const int tV1 = dir == 0 ? (tid >> 4) + 16 : 15 - (tid >> 4);                                             \
    rv0 = *(const uint4*)(p.proj + (size_t)(c0_ + tV0) * PW + OFF_V + hd * 128 + (tid & 15) * 8);             \
    rv1 = *(const uint4*)(p.proj + (size_t)(c0_ + tV1) * PW + OFF_V + hd * 128 + (tid & 15) * 8);             \
    if (tid < 64) {                                                                                           \
      const int tG = dir == 0 ? (tid >> 1) : 31 - (tid >> 1);                                                 \
      rgl = *(const uint4*)(p.proj + (size_t)(c0_ + tG) * PW + OFF_GL + (tid & 1) * 8);                       \
    }                                                                                                         \
  }
  GLA_ISSUE(0)
  char* rawQ = smem + GL_OS;
  char* rawK = smem + GL_OS + 4096;
  char* rawV = smem + GL_OS + 8192;
  char* rawG = smem + GL_PS;

#pragma unroll 1
  for (int n = 0; n < 8; ++n) {
    const int cn = dir == 0 ? n : 7 - n;
    const int ctok0 = tok_base + cn * 32;
    __syncthreads();
    if (!STATE_ONLY) *(uint4*)(rawQ + (tid >> 3) * 128 + (tid & 7) * 16) = rq;
    *(uint4*)(rawK + (tid >> 3) * 128 + (tid & 7) * 16) = rk;
    *(uint4*)(rawV + (tid >> 4) * 256 + (tid & 15) * 16) = rv0;
    *(uint4*)(rawV + ((tid >> 4) + 16) * 256 + (tid & 15) * 16) = rv1;
    if (tid < 64) *(uint4*)(rawG + (tid >> 1) * 32 + (tid & 1) * 16) = rgl;
    if (n + 1 < 8) GLA_ISSUE(n + 1)
    __syncthreads();
    float qv[8], kv[8], bl[8];
    {
      float run = 0.f;
#pragma unroll
      for (int i = 0; i < 8; ++i) {
        const int tau = tq * 8 + i;
        if (!STATE_ONLY) qv[i] = bf2f(*(const bfu*)(rawQ + tau * 128 + dk * 2)) * 0.125f;
        kv[i] = bf2f(*(const bfu*)(rawK + tau * 128 + dk * 2));
        float gl[16];
        unpack8(*(const uint4*)(rawG + tau * 32), *(float(*)[8])&gl[0]);
        unpack8(*(const uint4*)(rawG + tau * 32 + 16), *(float(*)[8])&gl[8]);
        float lg = bgv;
#pragma unroll
        for (int q = 0; q < 16; ++q) lg += gl[q] * wg[q];
        const float ls = fminf(lg, 0.f) - __logf(1.f + __expf(-fabsf(lg)));
        run += ls * (1.f / 16.f);
        bl[i] = run;
      }
      sTot[tq * 64 + dk] = run;
    }
    {
      unsigned pk[8];
#pragma unroll
      for (int i = 0; i < 8; ++i) {
        const int tau0 = th * 16 + 2 * i;
        const unsigned lo = *(const bfu*)(rawV + tau0 * 256 + dvl * 2);
        const unsigned hi = *(const bfu*)(rawV + (tau0 + 1) * 256 + dvl * 2);
        pk[i] = lo | (hi << 16);
      }
      *(uint4*)(smem + GL_VT + dvl * 80 + th * 32) = make_uint4(pk[0], pk[1], pk[2], pk[3]);
      *(uint4*)(smem + GL_VT + dvl * 80 + th * 32 + 16) = make_uint4(pk[4], pk[5], pk[6], pk[7]);
    }
    __syncthreads();
    {
      float off = 0.f, total = 0.f;
#pragma unroll
      for (int q = 0; q < 4; ++q) {
        const float tv = sTot[q * 64 + dk];
        total += tv;
        off += (q < tq) ? tv : 0.f;
      }
      unsigned kh[4];
      float khv[8];
#pragma unroll
      for (int i = 0; i < 8; ++i) {
        const float bb = off + bl[i];
        const int tau = tq * 8 + i;
        if (!STATE_ONLY) {
          *(bfu*)(smem + GL_QS + tau * 144 + dk * 2) = f2bf(qv[i] * __expf(bb));
          *(bfu*)(smem + GL_KS + tau * 144 + dk * 2) = f2bf(kv[i] * __expf(-bb));
        }
        khv[i] = kv[i] * __expf(total - bb);
      }
#pragma unroll
      for (int i = 0; i < 4; ++i) kh[i] = pack2(khv[2 * i], khv[2 * i + 1]);
      *(uint4*)(smem + GL_KHT + dk * 80 + tq * 16) = make_uint4(kh[0], kh[1], kh[2], kh[3]);
      if (tq == 0) { sAv[dk] = __expf(total); bsum += total; }
    }
    __syncthreads();
    f32x16 o;
    if (!STATE_ONLY) {
      f32x16 sc;
#pragma unroll
      for (int r = 0; r < 16; ++r) sc[r] = 0.f;
#pragma unroll
      for (int s4 = 0; s4 < 4; ++s4) {
        bf16x8 a = *(const bf16x8*)(smem + GL_QS + fr * 144 + (16 * s4 + 8 * hh) * 2);
        bf16x8 bq = *(const bf16x8*)(smem + GL_KS + fr * 144 + (16 * s4 + 8 * hh) * 2);
        sc = __builtin_amdgcn_mfma_f32_32x32x16_bf16(a, bq, sc, 0, 0, 0);
      }
#pragma unroll
      for (int rr = 0; rr < 4; ++rr) {
        float val = w == 0 ? sc[rr] : (w == 1 ? sc[4 + rr] : (w == 2 ? sc[8 + rr] : sc[12 + rr]));
        const int i = rr + 8 * w + 4 * hh;
        val = (fr <= i) ? val : 0.f;
        *(bfu*)(smem + GL_PS + i * 80 + fr * 2) = f2bf(val);
      }
      __syncthreads();
#pragma unroll
      for (int r = 0; r < 16; ++r) o[r] = 0.f;
    }
    {
      const int dvc = 32 * w + fr;
      bf16x8 vb0 = *(const bf16x8*)(smem + GL_VT + dvc * 80 + (8 * hh) * 2);
      bf16x8 vb1 = *(const bf16x8*)(smem + GL_VT + dvc * 80 + (16 + 8 * hh) * 2);
      if (!STATE_ONLY) {
        bf16x8 pa0 = *(const bf16x8*)(smem + GL_PS + fr * 80 + (8 * hh) * 2);
        bf16x8 pa1 = *(const bf16x8*)(smem + GL_PS + fr * 80 + (16 + 8 * hh) * 2);
        o = __builtin_amdgcn_mfma_f32_32x32x16_bf16(pa0, vb0, o, 0, 0, 0);
        o = __builtin_amdgcn_mfma_f32_32x32x16_bf16(pa1, vb1, o, 0, 0, 0);
#pragma unroll
        for (int s4 = 0; s4 < 4; ++s4) {
          bf16x8 a = *(const bf16x8*)(smem + GL_QS + fr * 144 + (16 * s4 + 8 * hh) * 2);
          bf16x8 sb = *(const bf16x8*)(smem + GL_ST + dvc * 144 + (16 * s4 + 8 * hh) * 2);
          o = __builtin_amdgcn_mfma_f32_32x32x16_bf16(a, sb, o, 0, 0, 0);
        }
      }
#pragma unroll
      for (int mt = 0; mt < 2; ++mt) {
        f32x16 U;
#pragma unroll
        for (int r = 0; r < 16; ++r) U[r] = 0.f;
        bf16x8 ka0 = *(const bf16x8*)(smem + GL_KHT + (32 * mt + fr) * 80 + (8 * hh) * 2);
        bf16x8 ka1 = *(const bf16x8*)(smem + GL_KHT + (32 * mt + fr) * 80 + (16 + 8 * hh) * 2);
        U = __builtin_amdgcn_mfma_f32_32x32x16_bf16(ka0, vb0, U, 0, 0, 0);
        U = __builtin_amdgcn_mfma_f32_32x32x16_bf16(ka1, vb1, U, 0, 0, 0);
#pragma unroll
        for (int q = 0; q < 4; ++q) {
          const float4 av = *(const float4*)(sAv + 32 * mt + 8 * q + 4 * hh);
          S[mt][4 * q + 0] = av.x * S[mt][4 * q + 0] + U[4 * q + 0];
          S[mt][4 * q + 1] = av.y * S[mt][4 * q + 1] + U[4 * q + 1];
          S[mt][4 * q + 2] = av.z * S[mt][4 * q + 2] + U[4 * q + 2];
          S[mt][4 * q + 3] = av.w * S[mt][4 * q + 3] + U[4 * q + 3];
          if (!STATE_ONLY) {
            uint2 pk;
            pk.x = pack2(S[mt][4 * q], S[mt][4 * q + 1]);
            pk.y = pack2(S[mt][4 * q + 2], S[mt][4 * q + 3]);
            *(uint2*)(smem + GL_ST + dvc * 144 + (32 * mt + 8 * q + 4 * hh) * 2) = pk;
          }
        }
      }
      if (!STATE_ONLY) {
#pragma unroll
        for (int r = 0; r < 16; ++r) sOs[((r & 3) + 8 * (r >> 2) + 4 * hh) * 132 + dvc] = o[r];
      }
    }
    __syncthreads();
    if (!STATE_ONLY) {
      const int t = tid >> 3, part = tid & 7;
      const int tau = dir == 0 ? t : 31 - t;
      const size_t tok = (size_t)(ctok0 + t);
      float ov[16];
#pragma unroll
      for (int q = 0; q < 4; ++q) {
        const float4 x = *(const float4*)(sOs + tau * 132 + part * 16 + 4 * q);
        ov[4 * q] = x.x; ov[4 * q + 1] = x.y; ov[4 * q + 2] = x.z; ov[4 * q + 3] = x.w;
      }
      bfu* op = p.gla_o + ((size_t)dir * NTOK + tok) * 512 + hd * 128 + part * 16;
      *(uint4*)op = pack8(*(float(*)[8])&ov[0]);
      *(uint4*)(op + 8) = pack8(*(float(*)[8])&ov[8]);
    }
  }
  const int dvc = 32 * w + fr;
  if (STATE_ONLY) {
    const size_t ci = (size_t)(((b * 8 + sidx) * 4 + hd) * 2 + dir);
    float* sl = p.gla_sloc + ci * 8192;
#pragma unroll
    for (int mt = 0; mt < 2; ++mt)
#pragma unroll
      for (int r = 0; r < 16; ++r) sl[(32 * mt + (r & 3) + 8 * (r >> 2) + 4 * hh) * 128 + dvc] = S[mt][r];
    if (tq == 0) p.gla_aseg[ci * 64 + dk] = __expf(bsum);
  } else if (prompt) {
    float* op = p.out + OUT_GLA + ((size_t)(((b * 2 + l) * 2 + dir) * 4 + hd)) * 8192;
#pragma unroll
    for (int mt = 0; mt < 2; ++mt)
#pragma unroll
      for (int r = 0; r < 16; ++r) op[(32 * mt + (r & 3) + 8 * (r >> 2) + 4 * hh) * 128 + dvc] = S[mt][r];
  }
  __syncthreads();
}

DI void phase_gla_pass1(const Params& p, int l, char* smem) {
  for (int it = NVB - 1 - VBID; it < 256; it += NVB) {
    const int dir = it & 1, hd = (it >> 1) & 3, seg = 16 + (it >> 3);
    gla_chain<true>(p, l, smem, seg, hd, dir);
  }
}
DI void phase_gla_main(const Params& p, int l, char* smem) {
  for (int it = NVB - 1 - VBID; it < 384; it += NVB) {
    const int dir = it & 1, hd = (it >> 1) & 3, seg = it >> 3;
    gla_chain<false>(p, l, smem, seg, hd, dir);
  }
}
DI void phase_gla_norm(const Params& p, int l) {
  const int tid = tid_(), lane = tid & 63, w = tid >> 6;
  for (int it = VBID; it < NTOK / 4; it += NVB) {
    const int tok = it * 4 + w;
    float a[8], b[8], gt[8], res[8];
    unpack8(*(const uint4*)(p.gla_o + (size_t)tok * 512 + lane * 8), a);
    unpack8(*(const uint4*)(p.gla_o + ((size_t)NTOK + tok) * 512 + lane * 8), b);
    unpack8(*(const uint4*)(p.proj + (size_t)tok * PW + OFF_GB + lane * 8), gt);
    float ss = 0.f;
#pragma unroll
    for (int e = 0; e < 8; ++e) { a[e] += b[e]; ss += a[e] * a[e]; }
    ss += __shfl_xor(ss, 1); ss += __shfl_xor(ss, 2); ss += __shfl_xor(ss, 4); ss += __shfl_xor(ss, 8);
    const float rs = rsqrtf(ss * (1.f / 128.f) + EPS);
    const float* g = p.gla_norm_g + l * 512 + lane * 8;
#pragma unroll
    for (int e = 0; e < 8; ++e) res[e] = a[e] * rs * g[e] * siluf_(gt[e]);
    *(uint4*)(p.yb + (size_t)tok * 512 + lane * 8) = pack8(res);
  }
}

DI void phase_merge(const Params& p, int l, char* smem) {
  const bfu* WA = p.w_paT + (size_t)l * 1024 * 512;
  const bfu* WB = p.w_pbT + (size_t)l * 1024 * 512;
  for (int iter = 0;; ++iter) {
    int mt, nt;
    if (!tile256(iter, 4, mt, nt)) break;
    const int m0 = mt * 256, n0 = nt * 256;
    f32x4 acc[2][2][4][2];
    acc256_zero(acc);
    gemm256(p.ya, 512, WA, 512, 512, m0, n0, (bfu*)smem, acc);
    EPI256({
      float ma[8], o[8];
      unpack8(*(const uint4*)(p.proj + (size_t)(m0 + row) * PW + OFF_MA + n0 + c0), ma);
      _Pragma("unroll") for (int e = 0; e < 8; ++e) o[e] = sigmoidf_(ma[e]) * v[e];
      *(uint4*)(p.merged + (size_t)(m0 + row) * D + n0 + c0) = pack8(o);
    })
    acc256_zero(acc);
    gemm256(p.yb, 512, WB, 512, 512, m0, n0, (bfu*)smem, acc);
    EPI256({
      float mb[8], o[8], pr[8];
      unpack8(*(const uint4*)(p.proj + (size_t)(m0 + row) * PW + OFF_MB + n0 + c0), mb);
      uint4* mp = (uint4*)(p.merged + (size_t)(m0 + row) * D + n0 + c0);
      unpack8(*mp, pr);
      _Pragma("unroll") for (int e = 0; e < 8; ++e) o[e] = pr[e] + sigmoidf_(mb[e]) * v[e];
      *mp = pack8(o);
    })
  }
}

DI void phase_out(const Params& p, int l, char* smem) {
  const bfu* W = p.w_oT + (size_t)l * 1024 * 1024;
  for (int iter = 0;; ++iter) {
    int mt, nt;
    if (!tile256(iter, 4, mt, nt)) break;
    const int m0 = mt * 256, n0 = nt * 256;
    f32x4 acc[2][2][4][2];
    acc256_zero(acc);
    gemm256(p.merged, D, W, 1024, 1024, m0, n0, (bfu*)smem, acc);
    const float* gate = p.mod + (size_t)(l * 5 + cond_of_tok(m0)) * 3072 + 2048;
    EPI256({
      float* xp = p.out + (size_t)(m0 + row) * D + n0 + c0;
      const float* gp = gate + n0 + c0;
      float4 x0 = *(const float4*)xp, x1 = *(const float4*)(xp + 4);
      float4 g0 = *(const float4*)gp, g1 = *(const float4*)(gp + 4);
      {
        const float4 h0 = *(const float4*)(gp + MODH), h1 = *(const float4*)(gp + MODH + 4);
        g0.x += h0.x; g0.y += h0.y; g0.z += h0.z; g0.w += h0.w;
        g1.x += h1.x; g1.y += h1.y; g1.z += h1.z; g1.w += h1.w;
      }
      x0.x += g0.x * v[0]; x0.y += g0.y * v[1]; x0.z += g0.z * v[2]; x0.w += g0.w * v[3];
      x1.x += g1.x * v[4]; x1.y += g1.y * v[5]; x1.z += g1.z * v[6]; x1.w += g1.w * v[7];
      *(float4*)xp = x0; *(float4*)(xp + 4) = x1;
    })
  }
}

DI void phase_final(const Params& p) {
  const int tid = tid_(), lane = tid & 63, w = tid >> 6;
  for (int it = VBID; it < NTOK / 4; it += NVB) {
    const int tok = it * 4 + w;
    float* xs = p.out + (size_t)tok * D;
    float4 v[4];
#pragma unroll
    for (int i = 0; i < 4; ++i) v[i] = *(const float4*)(xs + lane * 4 + 256 * i);
    float ss = 0.f;
#pragma unroll
    for (int i = 0; i < 4; ++i) ss += v[i].x * v[i].x + v[i].y * v[i].y + v[i].z * v[i].z + v[i].w * v[i].w;
    ss = wave_sum(ss);
    const float rstd = rsqrtf(ss * (1.f / 1024.f) + EPS);
#pragma unroll
    for (int i = 0; i < 4; ++i) {
      float4 g = *(const float4*)(p.final_g + lane * 4 + 256 * i);
      float4 o;
      o.x = v[i].x * rstd * g.x; o.y = v[i].y * rstd * g.y; o.z = v[i].z * rstd * g.z; o.w = v[i].w * rstd * g.w;
      *(float4*)(xs + lane * 4 + 256 * i) = o;
    }
  }
}

#define XB_TMO      128
#define XB_XCNT(j)  (256  + 64 * (j))
#define XB_XSUB(j)  (1280 + 64 * (j))
#define XB_XGEN(j)  (2304 + 64 * (j))
#define XB_TOP      3328
#define XB_TOPGEN   3392
#define XCD_BAR_WORDS 3456
#define XB_SPIN_CAP (1u << 18)
#define LAS __attribute__((address_space(3)))
DI unsigned xb_ld(unsigned* p) { return __hip_atomic_load(p, __ATOMIC_RELAXED, __HIP_MEMORY_SCOPE_AGENT); }
DI unsigned xb_add(unsigned* p, unsigned v) { return __hip_atomic_fetch_add(p, v, __ATOMIC_RELAXED, __HIP_MEMORY_SCOPE_AGENT); }
DI unsigned xb_xcc_id() { return (unsigned)__builtin_amdgcn_s_getreg((3 << 11) | 20) & 0xFu; }
#define XB_SPIN(cond, bar) do { unsigned _sp = 0; while (cond) { __builtin_amdgcn_s_sleep(1); \
    if ((++_sp & 255u) == 0u) { if (xb_ld(&(bar)[XB_TMO])) break; if (_sp > XB_SPIN_CAP) { atomicAdd(&(bar)[XB_TMO], 1u); break; } } } } while (0)
struct XcdBarrier { unsigned* bar; unsigned x; volatile LAS unsigned* st; };
DI XcdBarrier xcd_barrier_post(unsigned* bar, volatile LAS unsigned* st) {
  XcdBarrier b; b.bar = bar; b.x = xb_xcc_id(); b.st = st;
  if (threadIdx.x == 0) (void)xb_add(&bar[XB_XCNT(b.x)], 1u);
  return b;
}
DI void xcd_barrier_complete(unsigned* bar, unsigned x, unsigned& nloc, unsigned& nx) {
  const unsigned G = gridDim.x * gridDim.y * gridDim.z;
  unsigned sum, cnt, mine, sp = 0u;
  for (;;) {
    sum = 0u; cnt = 0u; mine = 0u;
#pragma unroll
    for (unsigned j = 0; j < 16; ++j) { const unsigned c = xb_ld(&bar[XB_XCNT(j)]); sum += c; cnt += (c > 0u) ? 1u : 0u; mine = (j == x) ? c : mine; }
    if (sum == G) break;
    __builtin_amdgcn_s_sleep(1);
    if ((++sp & 255u) == 0u) { if (xb_ld(&bar[XB_TMO])) break; if (sp > XB_SPIN_CAP) { atomicAdd(&bar[XB_TMO], 1u); break; } }
  }
  nloc = mine > 0u ? mine : 1u; nx = cnt > 0u ? cnt : 1u;
}
DI void xcd_barrier(const XcdBarrier& b) {
  asm volatile("s_waitcnt vmcnt(0)" ::: "memory");
  __syncthreads();
  if (threadIdx.x == 0) {
    unsigned* bar = b.bar;
    __builtin_amdgcn_s_waitcnt(0);
    unsigned nloc = b.st[0], nx = b.st[1];
    if (nloc == 0u) { xcd_barrier_complete(bar, b.x, nloc, nx); b.st[0] = nloc; b.st[1] = nx; }
    const unsigned old = xb_add(&bar[XB_XSUB(b.x)], 1u);
    const unsigned gen = old / nloc;
    if (old + 1u == (gen + 1u) * nloc) {
      __builtin_amdgcn_fence(__ATOMIC_RELEASE, "agent");
      asm volatile("s_waitcnt vmcnt(0)" ::: "memory");
      const unsigned og = xb_add(&bar[XB_TOP], 1u);
      const unsigned tg = og / nx;
      if (og + 1u == (tg + 1u) * nx) xb_add(&bar[XB_TOPGEN], 1u);
      else XB_SPIN(xb_ld(&bar[XB_TOPGEN]) == tg, bar);
      __builtin_amdgcn_fence(__ATOMIC_ACQUIRE, "agent");
      xb_add(&bar[XB_XGEN(b.x)], 1u);
      asm volatile("s_waitcnt vmcnt(0)" ::: "memory");
    } else {
      XB_SPIN(xb_ld(&bar[XB_XGEN(b.x)]) == gen, bar);
      __builtin_amdgcn_fence(__ATOMIC_ACQUIRE, "agent");
      asm volatile("s_waitcnt vmcnt(0)" ::: "memory");
    }
  }
  __syncthreads();
}

#ifndef REP_SYNC
#define REP_SYNC 0
#endif
__global__ void __launch_bounds__(512, 2) k_mega(Params p) {
  extern __shared__ __attribute__((aligned(16))) char smem_all[];
  cg::grid_group grid = cg::this_grid();
  char* smem = smem_all;
#define smh (smem_all + VHALF * 65536)
  volatile LAS unsigned* xst = (volatile LAS unsigned*)(smem_all + 131072);
  if (threadIdx.x < 4) xst[threadIdx.x] = 0u;
  __syncthreads();
  XcdBarrier xb = xcd_barrier_post(p.bar, xst);
#define GSYNC() xcd_barrier(xb)
  phase_prep(p, smh);
  phase_s5_gen(p, 0, smh);
  GSYNC();
  if (p.bar == nullptr) grid.sync();
  for (int l = 0; l < 2; ++l) {
    phase_h(p, l);
    GSYNC();
    phase_gemm_in(p, l, smem);
    GSYNC();
    phase_s5_e(p, smh);
    phase_gla_pass1(p, l, smh);
    GSYNC();
    phase_s5_scan(p, l);
    phase_gla_main(p, l, smh);
    GSYNC();
    phase_s5_y(p, l, smh);
    phase_gla_norm(p, l);
    GSYNC();
    phase_glu(p, l, smh);
    GSYNC();
    phase_merge(p, l, smem);
    if (l == 0 && (blockIdx.x >> 3) >= 24) {
      const int hb = (int)((((blockIdx.x >> 3) - 24) * 8 + (blockIdx.x & 7)) * 2) + VHALF;
      s5_gen_item(p, 1, hb, smh);
    }
    GSYNC();
    phase_out(p, l, smem);
    if (l == 0 && (blockIdx.x >> 3) >= 24) {
      const int hb = (int)((((blockIdx.x >> 3) - 24) * 8 + (blockIdx.x & 7)) * 2) + VHALF;
      s5_gen_item(p, 1, hb + 128, smh);
    }
    GSYNC();
    for (int rep = 0; rep < REP_SYNC; ++rep) GSYNC();
  }
  phase_final(p);
}

extern "C" void kernel_launch(void* const* d_in, const int* in_sizes, int n_in, void* d_out, int out_size,
                              void* d_ws, size_t ws_size, hipStream_t stream) {
  Params p{};
  const float* const* in = (const float* const*)d_in;
  p.x_prompt = in[0]; p.x_sample = in[1]; p.c = in[2]; p.st_re = in[3]; p.st_im = in[4]; p.st_gla = in[5];
  p.c_ctx = in[6]; p.norm_g = in[7]; p.w_mod = in[8]; p.b_mod = in[9]; p.w_in = in[10]; p.wg_up = in[11];
  p.bg = in[12]; p.gla_norm_g = in[13]; p.lam_re = in[14]; p.lam_im = in[15]; p.log_dt = in[16];
  p.b_re = in[17]; p.b_im = in[18]; p.c_re = in[19]; p.c_im = in[20]; p.s5_d = in[21]; p.w_glu = in[22];
  p.b_glu = in[23]; p.w_pa = in[24]; p.w_pb = in[25]; p.w_o = in[26]; p.final_g = in[27];
  p.out = (float*)d_out;
  char* ws = (char*)d_ws;
  size_t off = 0;
  auto take = [&](size_t bytes) { char* r = ws + off; off += (bytes + 255) & ~(size_t)255; return r; };
  p.w_inT = (bfu*)take((size_t)2 * DINP * LDH * 2);
  p.w_gluT = (bfu*)take((size_t)2 * 512 * 512 * 2);
  p.w_paT = (bfu*)take((size_t)2 * 1024 * 512 * 2);
  p.w_pbT = (bfu*)take((size_t)2 * 1024 * 512 * 2);
  p.w_oT = (bfu*)take((size_t)2 * 1024 * 1024 * 2);
  p.pos_r = (float*)take((size_t)32 * 512 * 4);
  p.pos_c = (float*)take((size_t)64 * 512 * 4);
  p.h = (bfu*)take((size_t)NTOK * LDH * 2);
  p.proj = (bfu*)take((size_t)NTOK * PW * 2);
  p.ys5 = (bfu*)take((size_t)NTOK * 512 * 2);
  p.ya = (bfu*)take((size_t)NTOK * 512 * 2);
  p.yb = (bfu*)take((size_t)NTOK * 512 * 2);
  p.merged = (bfu*)take((size_t)NTOK * D * 2);
  p.tmp_s5 = nullptr;
  p.ebuf = (float*)p.merged;
  p.carry = (bfu*)((char*)p.merged + (size_t)32 * NCHUNK * 256 * 4);
  p.ug = (bfu*)take((size_t)32 * NTOK * 16 * 2);
  p.opMG = (bfu*)take((size_t)32 * 512 * 768 * 2);
  p.opE = (bfu*)take((size_t)32 * 256 * 512 * 2);
  p.gla_sloc = (float*)p.ys5;
  p.gla_aseg = (float*)((char*)p.ys5 + (size_t)256 * 8192 * 4);
  if (off > ws_size) fprintf(stderr, "workspace too small: %zu > %zu\n", off, ws_size);
  p.bar = (unsigned*)take((size_t)XCD_BAR_WORDS * 4);
  p.mod = (float*)take((size_t)2 * 2 * 5 * 3072 * 4);
  p.gla_o = (bfu*)p.h;
  p.tmp_gla = (float*)p.h;
  constexpr size_t kLds = 131072 + 16;
  static int grid_blocks = 0;
  if (!grid_blocks) {
    int dev = 0, cus = 0, per_cu = 0;
    hipGetDevice(&dev);
    hipDeviceGetAttribute(&cus, hipDeviceAttributeMultiprocessorCount, dev);
    hipFuncSetAttribute((const void*)k_mega, hipFuncAttributeMaxDynamicSharedMemorySize, (int)kLds);
    hipOccupancyMaxActiveBlocksPerMultiprocessor(&per_cu, k_mega, 512, kLds);
    if (per_cu > 1) per_cu = 1;
    grid_blocks = cus * per_cu;
    if (grid_blocks % 8 != 0 || grid_blocks <= 0) fprintf(stderr, "unexpected grid %d\n", grid_blocks);
  }
  hipMemsetAsync(p.bar, 0, (size_t)XCD_BAR_WORDS * 4, stream);
  void* args[] = {&p};
  hipError_t e = hipLaunchCooperativeKernel((void*)k_mega, dim3(grid_blocks), dim3(512), args, kLds, stream);
  if (e != hipSuccess) fprintf(stderr, "cooperative launch failed: %s (grid %d)\n", hipGetErrorString(e), grid_blocks);
}
```

```cpp
#include <hip/hip_runtime.h>
#include <hip/hip_cooperative_groups.h>
#include <stdint.h>
#include <math.h>
#include <stdio.h>
namespace cg = cooperative_groups;

#ifndef REP_PREP
#define REP_PREP 0
#endif
#ifndef REP_GIN
#define REP_GIN 0
#endif
#ifndef REP_X1
#define REP_X1 0
#endif
#ifndef REP_X2
#define REP_X2 0
#endif
#ifndef REP_Y
#define REP_Y 0
#endif
#ifndef REP_MERGE
#define REP_MERGE 0
#endif
#ifndef REP_SYNC
#define REP_SYNC 0
#endif
#ifndef ONE_LAUNCH
#define ONE_LAUNCH 1
#endif

typedef unsigned short bfu;
typedef __attribute__((ext_vector_type(8))) short bf16x8;
typedef __attribute__((ext_vector_type(16))) float f32x16;
typedef __attribute__((ext_vector_type(2))) __bf16 bf2_t;
typedef __attribute__((ext_vector_type(2))) float f2_t;

#define DI __device__ __forceinline__

constexpr int D = 1024;
constexpr int NTOK = 12288;
constexpr int NPROMPT = 4096;
constexpr int DIN = 4624;
constexpr int DINP = 4864;
constexpr int LDH = 1088;
constexpr int PW = 4112;
constexpr int OFF_GA = 0, OFF_Q = 512, OFF_K = 768, OFF_V = 1024, OFF_GB = 1536, OFF_GL = 2048,
              OFF_MA = 2064, OFF_MB = 3088;
constexpr int NCHUNK = NTOK / 32;
constexpr size_t OUT_RE = (size_t)NTOK * D;
constexpr size_t OUT_IM = OUT_RE + 131072;
constexpr size_t OUT_GLA = OUT_IM + 131072;
constexpr float EPS = 1e-6f;
constexpr int MODH = 2 * 5 * 3072;

struct Params {
  const float *x_prompt, *x_sample, *c, *st_re, *st_im, *st_gla, *c_ctx, *norm_g, *w_mod, *b_mod, *w_in,
      *wg_up, *bg, *gla_norm_g, *lam_re, *lam_im, *log_dt, *b_re, *b_im, *c_re, *c_im, *s5_d, *w_glu,
      *b_glu, *w_pa, *w_pb, *w_o, *final_g;
  float* out;
  bfu *w_inT, *w_gluT, *w_paT, *w_pbT, *w_oT;
  float *mod, *pos_r, *pos_c, *tmp_s5, *tmp_gla;
  bfu *h, *proj, *ys5, *ya, *yb, *merged;
  bfu *ug, *opMG, *opE, *carry;
  float *ebuf, *gla_sloc, *gla_aseg;
  unsigned* bar;
  bfu* gla_o;
};

DI int tid_() { int t = threadIdx.x & 255; asm volatile("" : "+v"(t)); return t; }
#define VHALF ((int)__builtin_amdgcn_readfirstlane((int)(threadIdx.x >> 8)))
#define VBID ((int)(blockIdx.x * 2 + VHALF))
#define NVB ((int)(gridDim.x * 2))
#define VXCD ((int)(blockIdx.x & 7))
#define VJ ((int)((blockIdx.x >> 3) * 2 + VHALF))
#define VNLOC ((int)((gridDim.x >> 3) * 2))
DI float bf2f(bfu v) { return __uint_as_float(((unsigned)v) << 16); }
DI bfu f2bf(float x) { __bf16 b = (__bf16)x; return __builtin_bit_cast(unsigned short, b); }
DI unsigned pack2(float lo, float hi) {
  f2_t v = {lo, hi};
  bf2_t w = __builtin_convertvector(v, bf2_t);
  return __builtin_bit_cast(unsigned, w);
}
DI float sigmoidf_(float x) { return 1.f / (1.f + __expf(-x)); }
DI float siluf_(float x) { return x / (1.f + __expf(-x)); }
DI float geluf_(float x) {
  float u = 0.7978845608028654f * (x + 0.044715f * x * x * x);
  float t = 1.f - 2.f / (__expf(2.f * u) + 1.f);
  return 0.5f * x * (1.f + t);
}
DI float wave_sum(float v) {
#pragma unroll
  for (int o = 32; o >= 1; o >>= 1) v += __shfl_xor(v, o);
  return v;
}
DI void unpack8(const uint4 v, float (&f)[8]) {
  f[0] = __uint_as_float(v.x << 16); f[1] = __uint_as_float(v.x & 0xffff0000u);
  f[2] = __uint_as_float(v.y << 16); f[3] = __uint_as_float(v.y & 0xffff0000u);
  f[4] = __uint_as_float(v.z << 16); f[5] = __uint_as_float(v.z & 0xffff0000u);
  f[6] = __uint_as_float(v.w << 16); f[7] = __uint_as_float(v.w & 0xffff0000u);
}
DI uint4 pack8(const float (&f)[8]) {
  uint4 o;
  o.x = pack2(f[0], f[1]); o.y = pack2(f[2], f[3]); o.z = pack2(f[4], f[5]); o.w = pack2(f[6], f[7]);
  return o;
}
DI int cond_of_tok(int tok) { return tok < NPROMPT ? 0 : 1 + ((tok - NPROMPT) >> 11); }

DI void transpose_tile(const float* __restrict__ src, int K, int N, bfu* __restrict__ dst, int kt, int nt,
                       float* sm, int ldd = 0) {
  if (ldd == 0) ldd = K;
  const int tid = tid_(), c = tid & 63, r4 = tid >> 6;
  const int k0 = kt * 64, n0 = nt * 64;
  float v[16];
  const bool inb = (n0 + c) < N;
#pragma unroll
  for (int i = 0; i < 16; ++i) v[i] = inb ? src[(size_t)(k0 + i * 4 + r4) * N + n0 + c] : 0.f;
#pragma unroll
  for (int i = 0; i < 16; ++i) sm[(i * 4 + r4) * 65 + c] = v[i];
  __syncthreads();
  {
    const int n = tid >> 2, kc = tid & 3;
    float o[16];
#pragma unroll
    for (int i = 0; i < 16; ++i) o[i] = sm[(kc * 16 + i) * 65 + n];
    bfu* dp = dst + (size_t)(n0 + n) * ldd + k0 + kc * 16;
    *(uint4*)dp = pack8(*(float(*)[8])&o[0]);
    *(uint4*)(dp + 8) = pack8(*(float(*)[8])&o[8]);
  }
  __syncthreads();
}

DI void phase_prep(const Params& p, char* smem) {
  float* sm = (float*)smem;
  const int tid = tid_();
  for (int it = VBID; it < 192; it += NVB) {
    const int kh = it & 1, jb = (it >> 1) % 48, l = it / 96;
    float* ssil = sm;
    float* sred = sm + 5 * 512;
    for (int idx = tid; idx < 2560; idx += 256) {
      int ci = idx >> 9, k = (idx & 511) + kh * 512;
      float cv = (ci == 0) ? p.c_ctx[k] : p.c[(ci - 1) * 1024 + k];
      ssil[idx] = cv / (1.f + expf(-cv));
    }
    __syncthreads();
    const int jj = tid & 63, kq = tid >> 6;
    const int j = jb * 64 + jj;
    float acc[5] = {0.f, 0.f, 0.f, 0.f, 0.f};
    const float* wp = p.w_mod + ((size_t)l * 1024 + kh * 512 + kq * 128) * 3072 + j;
#pragma unroll 16
    for (int k = 0; k < 128; ++k) {
      float w = wp[(size_t)k * 3072];
#pragma unroll
      for (int ci = 0; ci < 5; ++ci) acc[ci] += ssil[ci * 512 + kq * 128 + k] * w;
    }
#pragma unroll
    for (int ci = 0; ci < 5; ++ci) sred[(kq * 5 + ci) * 64 + jj] = acc[ci];
    __syncthreads();
    for (int idx = tid; idx < 320; idx += 256) {
      int ci = idx >> 6, j2 = idx & 63;
      float sv = kh == 0 ? p.b_mod[l * 3072 + jb * 64 + j2] : 0.f;
#pragma unroll
      for (int q = 0; q < 4; ++q) sv += sred[(q * 5 + ci) * 64 + j2];
      p.mod[((size_t)(kh * 2 + l) * 5 + ci) * 3072 + jb * 64 + j2] = sv;
    }
    __syncthreads();
  }
  for (int idx = VBID * 256 + tid; idx < 96 * 512; idx += NVB * 256) {
    int r = idx >> 9, i = idx & 511;
    int pos = r < 32 ? r : r - 32;
    int q = i & 255;
    double f = exp(-log(10000.0) * (double)q / 256.0);
    double ang = (double)pos * f;
    float v = (float)((i < 256) ? sin(ang) : cos(ang));
    if (r < 32) p.pos_r[r * 512 + i] = v; else p.pos_c[(r - 32) * 512 + i] = v;
  }
  for (int it = VBID; it < 3584; it += NVB) {
    int l = it / 1792, r = it % 1792;
    if (r < 1216) {
      transpose_tile(p.w_in + (size_t)l * 1024 * DIN, 1024, DIN, p.w_inT + (size_t)l * DINP * LDH, r % 16, r / 16, sm, LDH);
    } else if (r < 1280) {
      r -= 1216;
      transpose_tile(p.w_glu + (size_t)l * 512 * 512, 512, 512, p.w_gluT + (size_t)l * 512 * 512, r % 8, r / 8, sm);
    } else if (r < 1408) {
      r -= 1280;
      transpose_tile(p.w_pa + (size_t)l * 512 * 1024, 512, 1024, p.w_paT + (size_t)l * 1024 * 512, r % 8, r / 8, sm);
    } else if (r < 1536) {
      r -= 1408;
      transpose_tile(p.w_pb + (size_t)l * 512 * 1024, 512, 1024, p.w_pbT + (size_t)l * 1024 * 512, r % 8, r / 8, sm);
    } else {
      r -= 1536;
      transpose_tile(p.w_o + (size_t)l * 1024 * 1024, 1024, 1024, p.w_oT + (size_t)l * 1024 * 1024, r % 16, r / 16, sm);
    }
  }
}

DI void phase_h(const Params& p, int l) {
  const int tid = tid_(), lane = tid & 63, w = tid >> 6;
  for (int it = VBID; it < NTOK / 4; it += NVB) {
    const int tok = it * 4 + w;
    float4 v[4];
    float* xs = p.out + (size_t)tok * D;
    if (l == 0) {
      const float* src = tok < NPROMPT ? p.x_prompt + (size_t)tok * D : p.x_sample + (size_t)(tok - NPROMPT) * D;
#pragma unroll
      for (int i = 0; i < 4; ++i) v[i] = *(const float4*)(src + lane * 4 + 256 * i);
      if (tok >= NPROMPT) {
        int t = (tok - NPROMPT) & 2047, row = t >> 6, col = t & 63;
#pragma unroll
        for (int i = 0; i < 4; ++i) {
          int d = lane * 4 + 256 * i;
          const float* pe = d < 512 ? p.pos_r + row * 512 + d : p.pos_c + col * 512 + (d - 512);
          float4 e = *(const float4*)pe;
          v[i].x += e.x; v[i].y += e.y; v[i].z += e.z; v[i].w += e.w;
        }
      }
#pragma unroll
      for (int i = 0; i < 4; ++i) *(float4*)(xs + lane * 4 + 256 * i) = v[i];
    } else {
#pragma unroll
      for (int i = 0; i < 4; ++i) v[i] = *(const float4*)(xs + lane * 4 + 256 * i);
    }
    float ss = 0.f;
#pragma unroll
    for (int i = 0; i < 4; ++i) ss += v[i].x * v[i].x + v[i].y * v[i].y + v[i].z * v[i].z + v[i].w * v[i].w;
    ss = wave_sum(ss);
    const float rstd = rsqrtf(ss * (1.f / 1024.f) + EPS);
    const float* md = p.mod + (size_t)(l * 5 + cond_of_tok(tok)) * 3072;
    const float* ng = p.norm_g + l * 1024;
#pragma unroll
    for (int i = 0; i < 4; ++i) {
      int d = lane * 4 + 256 * i;
      float4 g = *(const float4*)(ng + d);
      float4 sh = *(const float4*)(md + d);
      float4 sc = *(const float4*)(md + 1024 + d);
      {
        const float4 sh1 = *(const float4*)(md + MODH + d);
        const float4 sc1 = *(const float4*)(md + MODH + 1024 + d);
        sh.x += sh1.x; sh.y += sh1.y; sh.z += sh1.z; sh.w += sh1.w;
        sc.x += sc1.x; sc.y += sc1.y; sc.z += sc1.z; sc.w += sc1.w;
      }
      float a0 = v[i].x * rstd * g.x * (1.f + sc.x) + sh.x;
      float a1 = v[i].y * rstd * g.y * (1.f + sc.y) + sh.y;
      float a2 = v[i].z * rstd * g.z * (1.f + sc.z) + sh.z;
      float a3 = v[i].w * rstd * g.w * (1.f + sc.w) + sh.w;
      uint2 o; o.x = pack2(a0, a1); o.y = pack2(a2, a3);
      *(uint2*)(p.h + (size_t)tok * LDH + d) = o;
    }
  }
}

DI void gemm_core(const bfu* __restrict__ A, int lda, const bfu* __restrict__ B, int ldb, int K, char* smem,
                  f32x16 (&acc)[2][2]) {
  const int tid = tid_(), lane = tid & 63, w = tid >> 6, wm = w >> 1, wn = w & 1;
  const int c8 = tid & 7, r0 = tid >> 3;
  const bfu* ga = A + (size_t)r0 * lda + c8 * 8;
  const bfu* gb = B + (size_t)r0 * ldb + c8 * 8;
  const int st_off = r0 * 128 + ((c8 ^ ((r0 >> 1) & 7)) * 16);
  const int fr = lane & 31, hh = lane >> 5, fsw = (fr >> 1) & 7;
  const int a_base = (wm * 64 + fr) * 128;
  const int b_base = 16384 + (wn * 64 + fr) * 128;
  uint4 ra0, ra1, ra2, ra3, rb0, rb1, rb2, rb3, qa0, qa1, qa2, qa3, qb0, qb1, qb2, qb3;
  const int KT = K >> 6;
#define GEMM_LOADT(RA, RB, tile)                                                           \
  {                                                                                        \
    const int t_ = (tile) < KT ? (tile) : KT - 1;                                          \
    const bfu* ga_ = ga + t_ * 64; const bfu* gb_ = gb + t_ * 64;                          \
    RA##0 = *(const uint4*)(ga_);                        RB##0 = *(const uint4*)(gb_);                        \
    RA##1 = *(const uint4*)(ga_ + (size_t)32 * lda);     RB##1 = *(const uint4*)(gb_ + (size_t)32 * ldb);     \
    RA##2 = *(const uint4*)(ga_ + (size_t)64 * lda);     RB##2 = *(const uint4*)(gb_ + (size_t)64 * ldb);     \
    RA##3 = *(const uint4*)(ga_ + (size_t)96 * lda);     RB##3 = *(const uint4*)(gb_ + (size_t)96 * ldb);     \
  }
#define GEMM_STORET(buf, RA, RB)                                                           \
  {                                                                                        \
    *(uint4*)((buf) + st_off) = RA##0;          *(uint4*)((buf) + 16384 + st_off) = RB##0;          \
    *(uint4*)((buf) + st_off + 4096) = RA##1;   *(uint4*)((buf) + 16384 + st_off + 4096) = RB##1;   \
    *(uint4*)((buf) + st_off + 8192) = RA##2;   *(uint4*)((buf) + 16384 + st_off + 8192) = RB##2;   \
    *(uint4*)((buf) + st_off + 12288) = RA##3;  *(uint4*)((buf) + 16384 + st_off + 12288) = RB##3;  \
  }
#define GEMM_COMPUTE(cur)                                                                  \
  _Pragma("unroll") for (int s = 0; s < 4; ++s) {                                          \
    const int co = ((2 * s + hh) ^ fsw) * 16;                                              \
    bf16x8 a0 = *(const bf16x8*)((cur) + a_base + co);                                     \
    bf16x8 a1 = *(const bf16x8*)((cur) + a_base + 4096 + co);                              \
    bf16x8 b0 = *(const bf16x8*)((cur) + b_base + co);                                     \
    bf16x8 b1 = *(const bf16x8*)((cur) + b_base + 4096 + co);                              \
    acc[0][0] = __builtin_amdgcn_mfma_f32_32x32x16_bf16(a0, b0, acc[0][0], 0, 0, 0);       \
    acc[0][1] = __builtin_amdgcn_mfma_f32_32x32x16_bf16(a0, b1, acc[0][1], 0, 0, 0);       \
    acc[1][0] = __builtin_amdgcn_mfma_f32_32x32x16_bf16(a1, b0, acc[1][0], 0, 0, 0);       \
    acc[1][1] = __builtin_amdgcn_mfma_f32_32x32x16_bf16(a1, b1, acc[1][1], 0, 0, 0);       \
  }
  GEMM_LOADT(ra, rb, 0)
  GEMM_LOADT(qa, qb, 1)
  GEMM_STORET(smem, ra, rb)
  __syncthreads();
#pragma unroll 1
  for (int kt = 0; kt < KT; kt += 2) {
    GEMM_LOADT(ra, rb, kt + 2)
    __builtin_amdgcn_sched_barrier(0);
    GEMM_COMPUTE(smem)
    __builtin_amdgcn_sched_barrier(0);
    GEMM_STORET(smem + 32768, qa, qb)
    __syncthreads();
    GEMM_LOADT(qa, qb, kt + 3)
    __builtin_amdgcn_sched_barrier(0);
    GEMM_COMPUTE(smem + 32768)
    __builtin_amdgcn_sched_barrier(0);
    GEMM_STORET(smem, ra, rb)
    __syncthreads();
  }
}

DI void acc_zero(f32x16 (&acc)[2][2]) {
#pragma unroll
  for (int i = 0; i < 2; ++i)
#pragma unroll
    for (int j = 0; j < 2; ++j)
#pragma unroll
      for (int r = 0; r < 16; ++r) acc[i][j][r] = 0.f;
}

DI void acc_to_lds(const f32x16 (&acc)[2][2], char* smem) {
  float* sf = (float*)smem;
  const int tid = tid_(), lane = tid & 63, w = tid >> 6;
  const int rb = (w >> 1) * 64 + 4 * (lane >> 5), cb = (w & 1) * 64 + (lane & 31);
#pragma unroll
  for (int i = 0; i < 2; ++i)
#pragma unroll
    for (int j = 0; j < 2; ++j)
#pragma unroll
      for (int r = 0; r < 16; ++r)
        sf[(rb + i * 32 + (r & 3) + 8 * (r >> 2)) * 128 + cb + j * 32] = acc[i][j][r];
}
#define EPI_LDS(...)                                                             \
  {                                                                              \
    acc_to_lds(acc, smem);                                                       \
    __syncthreads();                                                             \
    _Pragma("unroll 1") for (int it_ = 0; it_ < 8; ++it_) {                      \
      const int row = (tid_() >> 4) + 16 * it_;                             \
      const int c0 = (tid_() & 15) * 8;                                     \
      float v[8];                                                                \
      {                                                                          \
        const float4 t0 = *(const float4*)(smem + (row * 128 + c0) * 4);         \
        const float4 t1 = *(const float4*)(smem + (row * 128 + c0 + 4) * 4);     \
        v[0] = t0.x; v[1] = t0.y; v[2] = t0.z; v[3] = t0.w;                      \
        v[4] = t1.x; v[5] = t1.y; v[6] = t1.z; v[7] = t1.w;                      \
      }                                                                          \
      __VA_ARGS__                                                                \
    }                                                                            \
    __syncthreads();                                                             \
  }

typedef __attribute__((ext_vector_type(4))) float f32x4;
constexpr int G_BK = 64, G_HALF = 128, G_HT = G_HALF * G_BK;
DI int g_lds_byte(int r, int c) {
  int st = (r >> 4) * 2 + (c >> 5), rr = r & 15, cc = c & 31, ob = rr * 64 + cc * 2;
  return st * 1024 + (ob ^ (((ob >> 9) & 1) << 5));
}
DI void g_stage_rc(int b, int& R, int& C) {
  int st = b / 1024, sb = b % 1024, swz = sb ^ (((sb >> 9) & 1) << 5);
  R = (st >> 1) * 16 + swz / 64; C = (st & 1) * 32 + (swz % 64) / 2;
}
DI const char* g_uniform(const char* ptr) {
  unsigned long long u = (unsigned long long)ptr;
  unsigned lo = __builtin_amdgcn_readfirstlane((unsigned)u), hi = __builtin_amdgcn_readfirstlane((unsigned)(u >> 32));
  return (const char*)(((unsigned long long)hi << 32) | lo);
}
DI void gemm256(const bfu* __restrict__ A, int lda, const bfu* __restrict__ Bt, int ldb, int K, int brow, int bcol,
                bfu* shm, f32x4 (&acc)[2][2][4][2]) {
#define G_SA(b, h) (shm + ((b) * 2 + (h)) * G_HT)
#define G_SB(b, h) (shm + (4 + (b) * 2 + (h)) * G_HT)
#define G_STAGE(P, BASE, LD, br, kt)                                                                   \
  do {                                                                                                 \
    const char* _u = g_uniform((const char*)((BASE) + ((long)(br) * (LD) + (long)(kt) * G_BK)));       \
    __builtin_amdgcn_global_load_lds((const unsigned*)(_u + soff_b),                                   \
        (__attribute__((address_space(3))) unsigned*)((char*)(P) + ldst), 16, 0, 0);                   \
    __builtin_amdgcn_global_load_lds((const unsigned*)(_u + 128 * (long)(LD) + soff_b),                \
        (__attribute__((address_space(3))) unsigned*)((char*)(P) + ldst + 8192), 16, 0, 0);            \
  } while (0)
#define G_LDA(dst, b, h) for (int m = 0; m < 4; ++m) for (int k = 0; k < 2; ++k) \
    dst[m][k] = *reinterpret_cast<const bf16x8*>((char*)G_SA(b, h) + a_rd + m * 2048 + k * 1024)
#define G_LDB(dst, b, h) for (int n = 0; n < 2; ++n) for (int k = 0; k < 2; ++k) \
    dst[n][k] = *reinterpret_cast<const bf16x8*>((char*)G_SB(b, h) + b_rd + n * 2048 + k * 1024)
#define G_MMA(ai, bj, At, Bt_)                                                                         \
  do {                                                                                                 \
    __builtin_amdgcn_s_setprio(1);                                                                     \
    for (int m = 0; m < 4; ++m) for (int n = 0; n < 2; ++n) for (int k = 0; k < 2; ++k)                \
      acc[ai][bj][m][n] = __builtin_amdgcn_mfma_f32_16x16x32_bf16(At[m][k], Bt_[n][k], acc[ai][bj][m][n], 0, 0, 0); \
    __builtin_amdgcn_s_setprio(0);                                                                     \
  } while (0)
#define G_WAIT_V(n) asm volatile("s_waitcnt vmcnt(" #n ")" ::: "memory")
#define G_WAIT_L(n) asm volatile("s_waitcnt lgkmcnt(" #n ")" ::: "memory")
#define G_BAR __builtin_amdgcn_s_barrier()
#define G_SCHED __builtin_amdgcn_sched_barrier(0)
  int t512 = threadIdx.x; asm volatile("" : "+v"(t512));
  const int wid = __builtin_amdgcn_readfirstlane(t512 >> 6), lane = t512 & 63, wr = wid >> 2, wc = wid & 3, fr = lane & 15, fq = lane >> 4;
  const int ldst = t512 * 16;
  unsigned soff_b;
  {
    int R0, C0;
    g_stage_rc(ldst, R0, C0);
    soff_b = (unsigned)(R0 * lda + C0) * 2u;
  }
  const int lane_off = (fr * 64 + fq * 16) ^ ((fr >> 3) << 5);
  const int a_rd = wr * 8192 + lane_off, b_rd = wc * 4096 + lane_off;
  bf16x8 At[4][2], B0[2][2], B1[2][2];
  const int nt = K / G_BK;
  G_STAGE(G_SB(0, 0), Bt, ldb, bcol, 0); G_STAGE(G_SA(0, 0), A, lda, brow, 0);
  G_STAGE(G_SB(0, 1), Bt, ldb, bcol + G_HALF, 0); G_STAGE(G_SA(0, 1), A, lda, brow + G_HALF, 0);
  if (wr == 1) G_BAR;
  G_WAIT_V(4); G_BAR;
  G_STAGE(G_SB(1, 0), Bt, ldb, bcol, 1); G_STAGE(G_SA(1, 0), A, lda, brow, 1); G_STAGE(G_SB(1, 1), Bt, ldb, bcol + G_HALF, 1);
  G_WAIT_V(6); G_BAR;
#pragma unroll 1
  for (int t = 0; t < nt - 2; t += 2) {
    G_LDB(B0, 0, 0); G_SCHED; G_LDA(At, 0, 0); G_STAGE(G_SA(1, 1), A, lda, brow + G_HALF, t + 1);
    G_WAIT_L(8); G_BAR; G_WAIT_L(0); G_MMA(0, 0, At, B0); G_BAR; G_SCHED;
    G_LDB(B1, 0, 1); G_STAGE(G_SB(0, 0), Bt, ldb, bcol, t + 2);
    G_BAR; G_WAIT_L(0); G_MMA(0, 1, At, B1); G_BAR;
    G_LDA(At, 0, 1); G_STAGE(G_SA(0, 0), A, lda, brow, t + 2);
    G_BAR; G_WAIT_L(0); G_MMA(1, 0, At, B0); G_BAR; G_SCHED;
    G_STAGE(G_SB(0, 1), Bt, ldb, bcol + G_HALF, t + 2);
    G_WAIT_V(6); G_BAR; G_MMA(1, 1, At, B1); G_BAR;
    G_LDB(B0, 1, 0); G_SCHED; G_LDA(At, 1, 0); G_STAGE(G_SA(0, 1), A, lda, brow + G_HALF, t + 2);
    G_WAIT_L(8); G_BAR; G_WAIT_L(0); G_MMA(0, 0, At, B0); G_BAR; G_SCHED;
    G_LDB(B1, 1, 1); G_STAGE(G_SB(1, 0), Bt, ldb, bcol, t + 3);
    G_BAR; G_WAIT_L(0); G_MMA(0, 1, At, B1); G_BAR;
    G_LDA(At, 1, 1); G_STAGE(G_SA(1, 0), A, lda, brow, t + 3);
    G_BAR; G_WAIT_L(0); G_MMA(1, 0, At, B0); G_BAR; G_SCHED;
    G_STAGE(G_SB(1, 1), Bt, ldb, bcol + G_HALF, t + 3);
    G_WAIT_V(6); G_BAR; G_MMA(1, 1, At, B1); G_BAR;
  }
  { G_LDB(B0, 0, 0); G_LDA(At, 0, 0); G_STAGE(G_SA(1, 1), A, lda, brow + G_HALF, nt - 1);
    G_BAR; G_WAIT_L(0); G_MMA(0, 0, At, B0); G_BAR;
    G_LDB(B1, 0, 1); G_BAR; G_WAIT_L(0); G_MMA(0, 1, At, B1); G_BAR;
    G_LDA(At, 0, 1); G_WAIT_V(4); G_BAR; G_WAIT_L(0); G_MMA(1, 0, At, B0); G_MMA(1, 1, At, B1); G_BAR; }
  { G_LDB(B0, 1, 0); G_LDA(At, 1, 0); G_WAIT_V(2); G_BAR; G_WAIT_L(0); G_MMA(0, 0, At, B0); G_BAR;
    G_LDB(B1, 1, 1); G_WAIT_V(0); G_BAR; G_WAIT_L(0); G_MMA(0, 1, At, B1); G_BAR;
    G_LDA(At, 1, 1); G_BAR; G_WAIT_L(0); G_MMA(1, 0, At, B0); G_MMA(1, 1, At, B1); G_BAR; }
  if (wr == 0) G_BAR;
}
DI void acc256_zero(f32x4 (&acc)[2][2][4][2]) {
#pragma unroll
  for (int a = 0; a < 2; ++a)
#pragma unroll
    for (int b = 0; b < 2; ++b)
#pragma unroll
      for (int m = 0; m < 4; ++m)
#pragma unroll
        for (int n = 0; n < 2; ++n) acc[a][b][m][n] = (f32x4){0.f, 0.f, 0.f, 0.f};
}
#define EPI_NOPRE
#define EPI256P(PRE, ...)                                                                              \
  {                                                                                                    \
    int t512_ = threadIdx.x; asm volatile("" : "+v"(t512_));     \
    const int wid_ = t512_ >> 6, lane_ = t512_ & 63, wr_ = wid_ >> 2, wc_ = wid_ & 3,                  \
              fr_ = lane_ & 15, fq_ = lane_ >> 4;                                                      \
    float* sf_ = (float*)smem;                                                                         \
    _Pragma("unroll") for (int ai_ = 0; ai_ < 2; ++ai_) {                                              \
      _Pragma("unroll") for (int it_ = 0; it_ < 8; ++it_) {     \
        const int idx_ = t512_ + 512 * it_;                                                            \
        const int rl_ = idx_ >> 5, c0 = (idx_ & 31) * 8;                                               \
        const int row = ai_ * 128 + rl_;                                                               \
        (void)rl_; (void)c0; (void)row;                                                                \
        PRE                                                                                            \
      }                                                                                                \
      __builtin_amdgcn_sched_barrier(0);              \
      __syncthreads();                                                                                 \
      _Pragma("unroll") for (int bj_ = 0; bj_ < 2; ++bj_)                                              \
      _Pragma("unroll") for (int m_ = 0; m_ < 4; ++m_)                                                 \
      _Pragma("unroll") for (int n_ = 0; n_ < 2; ++n_)                                                 \
      _Pragma("unroll") for (int j_ = 0; j_ < 4; ++j_)                                                 \
        sf_[(wr_ * 64 + m_ * 16 + fq_ * 4 + j_) * 256 + ((bj_ * 128 + wc_ * 32 + n_ * 16 + fr_) ^ (fq_ << 4))] = \
            acc[ai_][bj_][m_][n_][j_];                                                                 \
      __syncthreads();                                                                                 \
      _Pragma("unroll") for (int it_ = 0; it_ < 8; ++it_) {                                            \
        const int idx_ = t512_ + 512 * it_;                                                            \
        const int rl_ = idx_ >> 5, c0 = (idx_ & 31) * 8;                                               \
        const int row = ai_ * 128 + rl_;                                                               \
        float v[8];                                                                                    \
        {                                                                                              \
          const float* sp_ = sf_ + rl_ * 256 + (c0 ^ (((rl_ >> 2) & 3) << 4));                          \
          const float4 t0 = *(const float4*)sp_; const float4 t1 = *(const float4*)(sp_ + 4);          \
          v[0] = t0.x; v[1] = t0.y; v[2] = t0.z; v[3] = t0.w;                                          \
          v[4] = t1.x; v[5] = t1.y; v[6] = t1.z; v[7] = t1.w;                                          \
        }                                                                                              \
        __VA_ARGS__                                                                                    \
      }                                                                                                \
    }                                                                                                  \
    __syncthreads();                                                                                   \
  }
#define EPI256(...) EPI256P(EPI_NOPRE, __VA_ARGS__)

template <int MT, int NT, int BH>
DI bool xcd_tile(int iter, int& mt, int& nt) {
  constexpr int MPX = MT / 8, TPX = MPX * NT;
  const int xcd = VXCD, j = VJ, nloc = VNLOC;
  const int q = j + iter * nloc;
  if (q >= TPX) return false;
  const int band = q / (BH * NT), r = q % (BH * NT);
  nt = r / BH;
  mt = xcd * MPX + band * BH + (r % BH);
  return true;
}

DI bool tile256(int iter, int NT, int& mt, int& nt) {
  const int xcd = blockIdx.x & 7, j = blockIdx.x >> 3, nloc = gridDim.x >> 3;
  const int q = j + iter * nloc;
  if (q >= 6 * NT) return false;
  nt = q / 6; mt = xcd * 6 + q % 6;
  return true;
}
DI void phase_gemm_in(const Params& p, int l, char* smem) {
  const bfu* W = p.w_inT + (size_t)l * DINP * LDH;
  for (int iter = 0;; ++iter) {
    int mt, nt;
    if (!tile256(iter, 19, mt, nt)) break;
    f32x4 acc[2][2][4][2];
    acc256_zero(acc);
    gemm256(p.h, LDH, W, LDH, 1024, mt * 256, nt * 256, (bfu*)smem, acc);
    const int m0 = mt * 256, n0 = nt * 256;
    EPI256({
      const int n = n0 + c0;
      if (n < 512) *(uint4*)(p.ug + ((size_t)(n >> 4) * NTOK + (m0 + row)) * 16 + (n & 15)) = pack8(v);
      else if (n < DIN) *(uint4*)(p.proj + (size_t)(m0 + row) * PW + (n - 512)) = pack8(v);
    })
  }
}

DI void s5_gen_item(const Params& p, int l, int item, char* smem) {
  const int tid = tid_();
  const int g = item >> 3, r = item & 7;
  float* sBr = (float*)smem;
  float* sBi = sBr + 2048;
  float* sCr = sBi + 2048;
  float* sCi = sCr + 1024;
  float* sAK = sCi + 1024;
  float* sAE = sAK + 1024;
  float* sAG = sAE + 1024;
  float* sK = sAG + 1024;
  bfu* E = p.opE + (size_t)g * 256 * 512;
  bfu* MG = p.opMG + (size_t)g * 512 * 768;
  __syncthreads();
  if (tid < 128) {
    const int d = tid >> 6, pp = tid & 63;
    const size_t pi = ((size_t)(l * 2 + d) * 32 + g) * 64 + pp;
    const float lr = p.lam_re[pi], li = p.lam_im[pi];
    const float dt = expf(p.log_dt[(l * 2 + d) * 32 + g]);
    const float mag = expf(lr * dt);
    float sn, cs;
    sincosf(li * dt, &sn, &cs);
    const float are = mag * cs, aim = mag * sn;
    const float nr = are - 1.f, ni = aim, den = lr * lr + li * li;
    const float kr = (nr * lr + ni * li) / den, ki = (ni * lr - nr * li) / den;
#pragma unroll
    for (int c = 0; c < 16; ++c) {
      float br = p.b_re[((size_t)(l * 32 + g) * 64 + pp) * 16 + c];
      float bi = p.b_im[((size_t)(l * 32 + g) * 64 + pp) * 16 + c];
      sBr[(d * 64 + pp) * 16 + c] = kr * br - ki * bi;
      sBi[(d * 64 + pp) * 16 + c] = kr * bi + ki * br;
    }
#pragma unroll
    for (int q = 0; q < 4; ++q) {
      const int t = 4 * r + q;
      const int nK = t;
      const int nE = d == 0 ? 31 - t : t;
      const int nG = d == 0 ? t + 1 : 32 - t;
      float m, s_, c_;
      m = expf(lr * dt * (float)nK); sincosf(li * dt * (float)nK, &s_, &c_);
      sAK[((d * 4 + q) * 64 + pp) * 2] = m * c_; sAK[((d * 4 + q) * 64 + pp) * 2 + 1] = m * s_;
      m = expf(lr * dt * (float)nE); sincosf(li * dt * (float)nE, &s_, &c_);
      sAE[((d * 4 + q) * 64 + pp) * 2] = m * c_; sAE[((d * 4 + q) * 64 + pp) * 2 + 1] = m * s_;
      m = expf(lr * dt * (float)nG); sincosf(li * dt * (float)nG, &s_, &c_);
      sAG[((d * 4 + q) * 64 + pp) * 2] = m * c_; sAG[((d * 4 + q) * 64 + pp) * 2 + 1] = m * s_;
    }
  } else {
    for (int idx = tid - 128; idx < 1024; idx += 128) {
      sCr[idx] = p.c_re[(size_t)(l * 32 + g) * 1024 + idx];
      sCi[idx] = p.c_im[(size_t)(l * 32 + g) * 1024 + idx];
    }
  }
  __syncthreads();
  for (int idx = tid; idx < 256 * 64; idx += 256) {
    const int row = idx >> 6, cc = idx & 63, q = cc >> 4, c = cc & 15;
    const int part = row >> 6, pp = row & 63, d = part >> 1;
    const float ar = sAE[((d * 4 + q) * 64 + pp) * 2], ai = sAE[((d * 4 + q) * 64 + pp) * 2 + 1];
    const float br = sBr[(d * 64 + pp) * 16 + c], bi = sBi[(d * 64 + pp) * 16 + c];
    const float v = (part & 1) ? (ar * bi + ai * br) : (ar * br - ai * bi);
    E[(size_t)row * 512 + (4 * r + q) * 16 + c] = f2bf(v);
  }
  for (int idx = tid; idx < 64 * 256; idx += 256) {
    const int rr = idx >> 8, col = idx & 255, q = rr >> 4, c = rr & 15;
    const int part = col >> 6, pp = col & 63, d = part >> 1;
    const float ar = sAG[((d * 4 + q) * 64 + pp) * 2], ai = sAG[((d * 4 + q) * 64 + pp) * 2 + 1];
    const float cr = sCr[c * 64 + pp], ci = sCi[c * 64 + pp];
    const float v = (part & 1) ? -(cr * ai + ci * ar) : (cr * ar - ci * ai);
    MG[(size_t)((4 * r + q) * 16 + c) * 768 + 512 + col] = f2bf(v);
  }
  {
    const int d = tid >> 7, q = (tid >> 5) & 3, c = (tid >> 1) & 15, ch = tid & 1;
    float acc[8];
#pragma unroll
    for (int e = 0; e < 8; ++e) acc[e] = 0.f;
    for (int pp = 0; pp < 64; ++pp) {
      const float ar = sAK[((d * 4 + q) * 64 + pp) * 2], ai = sAK[((d * 4 + q) * 64 + pp) * 2 + 1];
      const float cr = sCr[c * 64 + pp], ci = sCi[c * 64 + pp];
      const float wr = cr * ar - ci * ai, wi = cr * ai + ci * ar;
#pragma unroll
      for (int e = 0; e < 8; ++e)
        acc[e] += wr * sBr[(d * 64 + pp) * 16 + ch * 8 + e] - wi * sBi[(d * 64 + pp) * 16 + ch * 8 + e];
    }
#pragma unroll
    for (int e = 0; e < 8; ++e) sK[((d * 4 + q) * 16 + c) * 16 + ch * 8 + e] = acc[e];
  }
  __syncthreads();
  for (int idx = tid; idx < 8192; idx += 256) {
    const int ch = idx & 1, c = (idx >> 1) & 15, tp = (idx >> 5) & 31, q = (idx >> 10) & 3, d = idx >> 12;
    const int tau = 4 * r + q;
    int sp;
    bool valid;
    if (d == 0) { sp = tp - tau; valid = sp >= 0; } else { sp = tp + tau; valid = (sp <= 31) && (tau > 0); }
    if (valid) {
      float v[8];
#pragma unroll
      for (int e = 0; e < 8; ++e) {
        float x = sK[((d * 4 + q) * 16 + c) * 16 + ch * 8 + e];
        if (tau == 0) x += sK[((1 * 4 + q) * 16 + c) * 16 + ch * 8 + e];
        v[e] = x;
      }
      *(uint4*)(MG + (size_t)(tp * 16 + c) * 768 + sp * 16 + ch * 8) = pack8(v);
    }
  }
  __syncthreads();
}

DI void phase_s5_gen(const Params& p, int l, char* smem) {
  for (int it = NVB - 1 - VBID; it < 256; it += NVB) s5_gen_item(p, l, it, smem);
}

DI void phase_s5_e(const Params& p, char* smem) {
  for (int q = VJ; q < 24; q += VNLOC) {
    const int g = VXCD * 4 + q / 6, r6 = q % 6, mt = r6 >> 1, nt = r6 & 1;
    f32x16 acc[2][2];
    acc_zero(acc);
    gemm_core(p.ug + ((size_t)g * NCHUNK + mt * 128) * 512, 512, p.opE + ((size_t)g * 256 + nt * 128) * 512, 512, 512,
              smem, acc);
    EPI_LDS({
      float* dst = p.ebuf + ((size_t)g * NCHUNK + mt * 128 + row) * 256 + nt * 128 + c0;
      *(float4*)dst = make_float4(v[0], v[1], v[2], v[3]);
      *(float4*)(dst + 4) = make_float4(v[4], v[5], v[6], v[7]);
    })
  }
}

DI void phase_s5_scan(const Params& p, int l) {
  const int tid = tid_();
  for (int it = VBID; it < 320; it += NVB) {
    const int wi = it * 2 + (tid >> 7);
    const int dir = (tid >> 6) & 1, pp = tid & 63;
    int chunk0, n, b, g;
    bool prompt;
    if (wi < 128) { b = wi >> 5; g = wi & 31; chunk0 = (NPROMPT + b * 2048) >> 5; n = 64; prompt = false; }
    else { int q = wi - 128; b = q >> 5; g = q & 31; chunk0 = (b * 256) >> 5; n = 8; prompt = true; }
    const size_t pi = ((size_t)(l * 2 + dir) * 32 + g) * 64 + pp;
    const float lr = p.lam_re[pi], li = p.lam_im[pi];
    const float dt = expf(p.log_dt[(l * 2 + dir) * 32 + g]);
    const float mag = expf(lr * dt * 32.f);
    float sn, cs;
    sincosf(li * dt * 32.f, &sn, &cs);
    const float are = mag * cs, aim = mag * sn;
    float hre = 0.f, him = 0.f;
    if (!prompt) {
      size_t si = ((size_t)((b * 2 + l) * 2 + dir)) * 2048 + g * 64 + pp;
      hre = p.st_re[si]; him = p.st_im[si];
    }
    const float* eb = p.ebuf + ((size_t)g * NCHUNK + chunk0) * 256 + dir * 128 + pp;
    bfu* cb = p.carry + ((size_t)g * NCHUNK + chunk0) * 256 + dir * 128 + pp;
    for (int k0 = 0; k0 < n; k0 += 8) {
      float er[8], ei[8];
#pragma unroll
      for (int j = 0; j < 8; ++j) {
        const int k = dir == 0 ? k0 + j : n - 1 - (k0 + j);
        er[j] = eb[(size_t)k * 256];
        ei[j] = eb[(size_t)k * 256 + 64];
      }
#pragma unroll
      for (int j = 0; j < 8; ++j) {
        const int k = dir == 0 ? k0 + j : n - 1 - (k0 + j);
        cb[(size_t)k * 256] = f2bf(hre);
        cb[(size_t)k * 256 + 64] = f2bf(him);
        const float nre = are * hre - aim * him + er[j];
        const float nim = are * him + aim * hre + ei[j];
        hre = nre; him = nim;
      }
    }
    if (prompt) {
      size_t oi = ((size_t)((b * 2 + l) * 2 + dir)) * 2048 + g * 64 + pp;
      p.out[OUT_RE + oi] = hre;
      p.out[OUT_IM + oi] = him;
    }
  }
}

DI void phase_s5_y(const Params& p, int l, char* smem) {
  for (int q = VJ; q < 48; q += VNLOC) {
    const int g = VXCD * 4 + q / 12, r12 = q % 12, mt = r12 >> 2, nt = r12 & 3;
    f32x16 acc[2][2];
    acc_zero(acc);
    const bfu* Bm = p.opMG + ((size_t)g * 512 + nt * 128) * 768;
    gemm_core(p.ug + ((size_t)g * NCHUNK + mt * 128) * 512, 512, Bm, 768, 512, smem, acc);
    gemm_core(p.carry + ((size_t)g * NCHUNK + mt * 128) * 256, 256, Bm + 512, 768, 256, smem, acc);
    EPI_LDS({
      const int chunk = mt * 128 + row, nn = nt * 128 + c0, tp = nn >> 4, c = nn & 15;
      const int tok = chunk * 32 + tp;
      float u[8], o[8];
      unpack8(*(const uint4*)(p.ug + ((size_t)g * NTOK + tok) * 16 + c), u);
      const float* dsk = p.s5_d + l * 512 + g * 16 + c;
      _Pragma("unroll") for (int e = 0; e < 8; ++e) o[e] = geluf_(v[e] + dsk[e] * u[e]);
      *(uint4*)(p.ys5 + (size_t)tok * 512 + g * 16 + c) = pack8(o);
    })
  }
}

DI void phase_glu(const Params& p, int l, char* smem) {
  const bfu* W = p.w_gluT + (size_t)l * 512 * 512;
  for (int iter = 0;; ++iter) {
    int mt, nt;
    if (!xcd_tile<96, 4, 12>(iter, mt, nt)) break;
    f32x16 acc[2][2];
    acc_zero(acc);
    gemm_core(p.ys5 + (size_t)mt * 128 * 512, 512, W + (size_t)nt * 128 * 512, 512, 512, smem, acc);
    const int m0 = mt * 128, n0 = nt * 128;
    EPI_LDS({
      const int n = n0 + c0;
      const size_t tk = (size_t)(m0 + row);
      float y[8], ga[8], o[8];
      unpack8(*(const uint4*)(p.ys5 + tk * 512 + n), y);
      unpack8(*(const uint4*)(p.proj + tk * PW + OFF_GA + n), ga);
      const float* bg = p.b_glu + l * 512 + n;
      _Pragma("unroll") for (int e = 0; e < 8; ++e) o[e] = y[e] * sigmoidf_(v[e] + bg[e]) * siluf_(ga[e]);
      *(uint4*)(p.ya + tk * 512 + n) = pack8(o);
    })
  }
}

constexpr int GL_QS = 0;
constexpr int GL_KS = GL_QS + 32 * 144;
constexpr int GL_KHT = GL_KS + 32 * 144;
constexpr int GL_VT = GL_KHT + 64 * 80;
constexpr int GL_PS = GL_VT + 128 * 80;
constexpr int GL_ST = GL_PS + 32 * 80;
constexpr int GL_AV = GL_ST + 128 * 144;
constexpr int GL_TOT = GL_AV + 256;
constexpr int GL_OS = GL_TOT + 1024;
static_assert(GL_OS + 32 * 132 * 4 <= 65536, "gla lds");

DI void gla_segment_info(int seg, int& tok_base, bool& prompt, int& b, int& sidx) {
  if (seg < 16) { prompt = true; b = seg; sidx = 0; tok_base = seg * 256; }
  else { int q = seg - 16; prompt = false; b = q >> 3; sidx = q & 7; tok_base = NPROMPT + b * 2048 + sidx * 256; }
}

template <bool STATE_ONLY>
DI void gla_chain(const Params& p, int l, char* smem, int seg, int hd, int dir) {
  const int tid = tid_(), lane = tid & 63, w = tid >> 6;
  const int fr = lane & 31, hh = lane >> 5;
  int tok_base, b, sidx;
  bool prompt;
  gla_segment_info(seg, tok_base, prompt, b, sidx);
  const int dk = tid & 63, tq = tid >> 6;
  const int dvl = tid & 127, th = tid >> 7;
  float wg[16];
#pragma unroll
  for (int q = 0; q < 16; ++q) wg[q] = p.wg_up[((size_t)(l * 2 + dir) * 16 + q) * 256 + hd * 64 + dk];
  const float bgv = p.bg[(l * 2 + dir) * 256 + hd * 64 + dk];
  float* sAv = (float*)(smem + GL_AV);
  float* sTot = (float*)(smem + GL_TOT);
  float* sOs = (float*)(smem + GL_OS);

  f32x16 S[2];
  {
    const int dvc = 32 * w + fr;
    if (STATE_ONLY || prompt) {
#pragma unroll
      for (int mt = 0; mt < 2; ++mt)
#pragma unroll
        for (int r = 0; r < 16; ++r) S[mt][r] = 0.f;
    } else {
      const float* sp = p.st_gla + ((size_t)(((b * 2 + l) * 2 + dir) * 4 + hd)) * 8192;
#pragma unroll
      for (int mt = 0; mt < 2; ++mt)
#pragma unroll
        for (int r = 0; r < 16; ++r) S[mt][r] = sp[(32 * mt + (r & 3) + 8 * (r >> 2) + 4 * hh) * 128 + dvc];
      const int nprev = dir == 0 ? sidx : 7 - sidx;
      if (nprev > 0) {
        f32x16 cs[2], ns[2];
        float4 ca[8], na[8];
#define GLA_SEG_LOAD(SS, AA, qq)                                                                       \
        {                                                                                              \
          const int sprev_ = dir == 0 ? (qq) : 7 - (qq);                                               \
          const size_t ci_ = (size_t)(((b * 8 + sprev_) * 4 + hd) * 2 + dir);                          \
          const float* sl_ = p.gla_sloc + ci_ * 8192 + dvc;                                            \
          const float* al_ = p.gla_aseg + ci_ * 64 + 4 * hh;                                           \
          _Pragma("unroll") for (int mt = 0; mt < 2; ++mt)                                             \
          _Pragma("unroll") for (int r = 0; r < 16; ++r)                                               \
            SS[mt][r] = sl_[(32 * mt + (r & 3) + 8 * (r >> 2) + 4 * hh) * 128];                        \
          _Pragma("unroll") for (int i = 0; i < 8; ++i) AA[i] = *(const float4*)(al_ + 8 * i);         \
        }
        GLA_SEG_LOAD(cs, ca, 0)
#pragma unroll 1
        for (int q = 0; q < nprev; ++q) {
          if (q + 1 < nprev) GLA_SEG_LOAD(ns, na, q + 1)
#pragma unroll
          for (int mt = 0; mt < 2; ++mt)
#pragma unroll
            for (int qq = 0; qq < 4; ++qq) {
              const float4 av = ca[mt * 4 + qq];
              S[mt][4 * qq + 0] = av.x * S[mt][4 * qq + 0] + cs[mt][4 * qq + 0];
              S[mt][4 * qq + 1] = av.y * S[mt][4 * qq + 1] + cs[mt][4 * qq + 1];
              S[mt][4 * qq + 2] = av.z * S[mt][4 * qq + 2] + cs[mt][4 * qq + 2];
              S[mt][4 * qq + 3] = av.w * S[mt][4 * qq + 3] + cs[mt][4 * qq + 3];
            }
          cs[0] = ns[0]; cs[1] = ns[1];
#pragma unroll
          for (int i = 0; i < 8; ++i) ca[i] = na[i];
        }
      }
    }
  }
  float bsum = 0.f;
  __syncthreads();
  if (!STATE_ONLY) {
    const int dvc = 32 * w + fr;
#pragma unroll
    for (int mt = 0; mt < 2; ++mt)
#pragma unroll
      for (int q = 0; q < 4; ++q) {
        uint2 pk;
        pk.x = pack2(S[mt][4 * q], S[mt][4 * q + 1]);
        pk.y = pack2(S[mt][4 * q + 2], S[mt][4 * q + 3]);
        *(uint2*)(smem + GL_ST + dvc * 144 + (32 * mt + 8 * q + 4 * hh) * 2) = pk;
      }
  }

  uint4 rq = make_uint4(0, 0, 0, 0), rk = rq, rv0 = rq, rv1 = rq, rgl = rq;
#define GLA_ISSUE(nn)                                                                                         \
  {                                                                                                           \
    const int cn_ = dir == 0 ? (nn) : 7 - (nn);                                                               \
    const int c0_ = tok_base + cn_ * 32;                                                                      \
    const int tA = dir == 0 ? (tid >> 3) : 31 - (tid >> 3);                                                   \
    const bfu* prA = p.proj + (size_t)(c0_ + tA) * PW + hd * 64 + (tid & 7) * 8;                              \
    if (!STATE_ONLY) rq = *(const uint4*)(prA + OFF_Q);                                                       \
    rk = *(const uint4*)(prA + OFF_K);                                                                        \
    const int tV0 = dir == 0 ? (tid >> 4) : 31 - (tid >> 4);                                                  \
    const int tV1 = dir == 0 ? (tid >> 4) + 16 : 15 - (tid >> 4);                                             \
    rv0 = *(const uint4*)(p.proj + (size_t)(c0_ + tV0) * PW + OFF_V + hd * 128 + (tid & 15) * 8);             \
    rv1 = *(const uint4*)(p.proj + (size_t)(c0_ + tV1) * PW + OFF_V + hd * 128 + (tid & 15) * 8);             \
    if (tid < 64) {                                                                                           \
      const int tG = dir == 0 ? (tid >> 1) : 31 - (tid >> 1);                                                 \
      rgl = *(const uint4*)(p.proj + (size_t)(c0_ + tG) * PW + OFF_GL + (tid & 1) * 8);                       \
    }                                                                                                         \
  }
  GLA_ISSUE(0)
  char* rawQ = smem + GL_OS;
  char* rawK = smem + GL_OS + 4096;
  char* rawV = smem + GL_OS + 8192;
  char* rawG = smem + GL_PS;

#pragma unroll 1
  for (int n = 0; n < 8; ++n) {
    const int cn = dir == 0 ? n : 7 - n;
    const int ctok0 = tok_base + cn * 32;
    __syncthreads();
    if (!STATE_ONLY) *(uint4*)(rawQ + (tid >> 3) * 128 + (tid & 7) * 16) = rq;
    *(uint4*)(rawK + (tid >> 3) * 128 + (tid & 7) * 16) = rk;
    *(uint4*)(rawV + (tid >> 4) * 256 + (tid & 15) * 16) = rv0;
    *(uint4*)(rawV + ((tid >> 4) + 16) * 256 + (tid & 15) * 16) = rv1;
    if (tid < 64) *(uint4*)(rawG + (tid >> 1) * 32 + (tid & 1) * 16) = rgl;
    if (n + 1 < 8) GLA_ISSUE(n + 1)
    __syncthreads();
    float qv[8], kv[8], bl[8];
    {
      float run = 0.f;
#pragma unroll
      for (int i = 0; i < 8; ++i) {
        const int tau = tq * 8 + i;
        if (!STATE_ONLY) qv[i] = bf2f(*(const bfu*)(rawQ + tau * 128 + dk * 2)) * 0.125f;
        kv[i] = bf2f(*(const bfu*)(rawK + tau * 128 + dk * 2));
        float gl[16];
        unpack8(*(const uint4*)(rawG + tau * 32), *(float(*)[8])&gl[0]);
        unpack8(*(const uint4*)(rawG + tau * 32 + 16), *(float(*)[8])&gl[8]);
        float lg = bgv;
#pragma unroll
        for (int q = 0; q < 16; ++q) lg += gl[q] * wg[q];
        const float ls = fminf(lg, 0.f) - __logf(1.f + __expf(-fabsf(lg)));
        run += ls * (1.f / 16.f);
        bl[i] = run;
      }
      sTot[tq * 64 + dk] = run;
    }
    {
      unsigned pk[8];
#pragma unroll
      for (int i = 0; i < 8; ++i) {
        const int tau0 = th * 16 + 2 * i;
        const unsigned lo = *(const bfu*)(rawV + tau0 * 256 + dvl * 2);
        const unsigned hi = *(const bfu*)(rawV + (tau0 + 1) * 256 + dvl * 2);
        pk[i] = lo | (hi << 16);
      }
      *(uint4*)(smem + GL_VT + dvl * 80 + th * 32) = make_uint4(pk[0], pk[1], pk[2], pk[3]);
      *(uint4*)(smem + GL_VT + dvl * 80 + th * 32 + 16) = make_uint4(pk[4], pk[5], pk[6], pk[7]);
    }
    __syncthreads();
    {
      float off = 0.f, total = 0.f;
#pragma unroll
      for (int q = 0; q < 4; ++q) {
        const float tv = sTot[q * 64 + dk];
        total += tv;
        off += (q < tq) ? tv : 0.f;
      }
      unsigned kh[4];
      float khv[8];
#pragma unroll
      for (int i = 0; i < 8; ++i) {
        const float bb = off + bl[i];
        const int tau = tq * 8 + i;
        if (!STATE_ONLY) {
          *(bfu*)(smem + GL_QS + tau * 144 + dk * 2) = f2bf(qv[i] * __expf(bb));
          *(bfu*)(smem + GL_KS + tau * 144 + dk * 2) = f2bf(kv[i] * __expf(-bb));
        }
        khv[i] = kv[i] * __expf(total - bb);
      }
#pragma unroll
      for (int i = 0; i < 4; ++i) kh[i] = pack2(khv[2 * i], khv[2 * i + 1]);
      *(uint4*)(smem + GL_KHT + dk * 80 + tq * 16) = make_uint4(kh[0], kh[1], kh[2], kh[3]);
      if (tq == 0) { sAv[dk] = __expf(total); bsum += total; }
    }
    __syncthreads();
    f32x16 o;
    if (!STATE_ONLY) {
      f32x16 sc;
#pragma unroll
      for (int r = 0; r < 16; ++r) sc[r] = 0.f;
#pragma unroll
      for (int s4 = 0; s4 < 4; ++s4) {
        bf16x8 a = *(const bf16x8*)(smem + GL_QS + fr * 144 + (16 * s4 + 8 * hh) * 2);
        bf16x8 bq = *(const bf16x8*)(smem + GL_KS + fr * 144 + (16 * s4 + 8 * hh) * 2);
        sc = __builtin_amdgcn_mfma_f32_32x32x16_bf16(a, bq, sc, 0, 0, 0);
      }
#pragma unroll
      for (int rr = 0; rr < 4; ++rr) {
        float val = w == 0 ? sc[rr] : (w == 1 ? sc[4 + rr] : (w == 2 ? sc[8 + rr] : sc[12 + rr]));
        const int i = rr + 8 * w + 4 * hh;
        val = (fr <= i) ? val : 0.f;
        *(bfu*)(smem + GL_PS + i * 80 + fr * 2) = f2bf(val);
      }
      __syncthreads();
#pragma unroll
      for (int r = 0; r < 16; ++r) o[r] = 0.f;
    }
    {
      const int dvc = 32 * w + fr;
      bf16x8 vb0 = *(const bf16x8*)(smem + GL_VT + dvc * 80 + (8 * hh) * 2);
      bf16x8 vb1 = *(const bf16x8*)(smem + GL_VT + dvc * 80 + (16 + 8 * hh) * 2);
      if (!STATE_ONLY) {
        bf16x8 pa0 = *(const bf16x8*)(smem + GL_PS + fr * 80 + (8 * hh) * 2);
        bf16x8 pa1 = *(const bf16x8*)(smem + GL_PS + fr * 80 + (16 + 8 * hh) * 2);
        o = __builtin_amdgcn_mfma_f32_32x32x16_bf16(pa0, vb0, o, 0, 0, 0);
        o = __builtin_amdgcn_mfma_f32_32x32x16_bf16(pa1, vb1, o, 0, 0, 0);
#pragma unroll
        for (int s4 = 0; s4 < 4; ++s4) {
          bf16x8 a = *(const bf16x8*)(smem + GL_QS + fr * 144 + (16 * s4 + 8 * hh) * 2);
          bf16x8 sb = *(const bf16x8*)(smem + GL_ST + dvc * 144 + (16 * s4 + 8 * hh) * 2);
          o = __builtin_amdgcn_mfma_f32_32x32x16_bf16(a, sb, o, 0, 0, 0);
        }
      }
#pragma unroll
      for (int mt = 0; mt < 2; ++mt) {
        f32x16 U;
#pragma unroll
        for (int r = 0; r < 16; ++r) U[r] = 0.f;
        bf16x8 ka0 = *(const bf16x8*)(smem + GL_KHT + (32 * mt + fr) * 80 + (8 * hh) * 2);
        bf16x8 ka1 = *(const bf16x8*)(smem + GL_KHT + (32 * mt + fr) * 80 + (16 + 8 * hh) * 2);
        U = __builtin_amdgcn_mfma_f32_32x32x16_bf16(ka0, vb0, U, 0, 0, 0);
        U = __builtin_amdgcn_mfma_f32_32x32x16_bf16(ka1, vb1, U, 0, 0, 0);
#pragma unroll
        for (int q = 0; q < 4; ++q) {
          const float4 av = *(const float4*)(sAv + 32 * mt + 8 * q + 4 * hh);
          S[mt][4 * q + 0] = av.x * S[mt][4 * q + 0] + U[4 * q + 0];
          S[mt][4 * q + 1] = av.y * S[mt][4 * q + 1] + U[4 * q + 1];
          S[mt][4 * q + 2] = av.z * S[mt][4 * q + 2] + U[4 * q + 2];
          S[mt][4 * q + 3] = av.w * S[mt][4 * q + 3] + U[4 * q + 3];
          if (!STATE_ONLY) {
            uint2 pk;
            pk.x = pack2(S[mt][4 * q], S[mt][4 * q + 1]);
            pk.y = pack2(S[mt][4 * q + 2], S[mt][4 * q + 3]);
            *(uint2*)(smem + GL_ST + dvc * 144 + (32 * mt + 8 * q + 4 * hh) * 2) = pk;
          }
        }
      }
      if (!STATE_ONLY) {
#pragma unroll
        for (int r = 0; r < 16; ++r) sOs[((r & 3) + 8 * (r >> 2) + 4 * hh) * 132 + dvc] = o[r];
      }
    }
    __syncthreads();
    if (!STATE_ONLY) {
      const int t = tid >> 3, part = tid & 7;
      const int tau = dir == 0 ? t : 31 - t;
      const size_t tok = (size_t)(ctok0 + t);
      float ov[16];
#pragma unroll
      for (int q = 0; q < 4; ++q) {
        const float4 x = *(const float4*)(sOs + tau * 132 + part * 16 + 4 * q);
        ov[4 * q] = x.x; ov[4 * q + 1] = x.y; ov[4 * q + 2] = x.z; ov[4 * q + 3] = x.w;
      }
      bfu* op = p.gla_o + ((size_t)dir * NTOK + tok) * 512 + hd * 128 + part * 16;
      *(uint4*)op = pack8(*(float(*)[8])&ov[0]);
      *(uint4*)(op + 8) = pack8(*(float(*)[8])&ov[8]);
    }
  }
  const int dvc = 32 * w + fr;
  if (STATE_ONLY) {
    const size_t ci = (size_t)(((b * 8 + sidx) * 4 + hd) * 2 + dir);
    float* sl = p.gla_sloc + ci * 8192;
#pragma unroll
    for (int mt = 0; mt < 2; ++mt)
#pragma unroll
      for (int r = 0; r < 16; ++r) sl[(32 * mt + (r & 3) + 8 * (r >> 2) + 4 * hh) * 128 + dvc] = S[mt][r];
    if (tq == 0) p.gla_aseg[ci * 64 + dk] = __expf(bsum);
  } else if (prompt) {
    float* op = p.out + OUT_GLA + ((size_t)(((b * 2 + l) * 2 + dir) * 4 + hd)) * 8192;
#pragma unroll
    for (int mt = 0; mt < 2; ++mt)
#pragma unroll
      for (int r = 0; r < 16; ++r) op[(32 * mt + (r & 3) + 8 * (r >> 2) + 4 * hh) * 128 + dvc] = S[mt][r];
  }
  __syncthreads();
}

DI void phase_gla_pass1(const Params& p, int l, char* smem) {
  for (int it = NVB - 1 - VBID; it < 256; it += NVB) {
    const int dir = it & 1, hd = (it >> 1) & 3, seg = 16 + (it >> 3);
    gla_chain<true>(p, l, smem, seg, hd, dir);
  }
}
DI void phase_gla_main(const Params& p, int l, char* smem) {
  for (int it = NVB - 1 - VBID; it < 384; it += NVB) {
    const int dir = it & 1, hd = (it >> 1) & 3, seg = it >> 3;
    gla_chain<false>(p, l, smem, seg, hd, dir);
  }
}
DI void phase_gla_norm(const Params& p, int l) {
  const int tid = tid_(), lane = tid & 63, w = tid >> 6;
  for (int it = VBID; it < NTOK / 4; it += NVB) {
    const int tok = it * 4 + w;
    float a[8], b[8], gt[8], res[8];
    unpack8(*(const uint4*)(p.gla_o + (size_t)tok * 512 + lane * 8), a);
    unpack8(*(const uint4*)(p.gla_o + ((size_t)NTOK + tok) * 512 + lane * 8), b);
    unpack8(*(const uint4*)(p.proj + (size_t)tok * PW + OFF_GB + lane * 8), gt);
    float ss = 0.f;
#pragma unroll
    for (int e = 0; e < 8; ++e) { a[e] += b[e]; ss += a[e] * a[e]; }
    ss += __shfl_xor(ss, 1); ss += __shfl_xor(ss, 2); ss += __shfl_xor(ss, 4); ss += __shfl_xor(ss, 8);
    const float rs = rsqrtf(ss * (1.f / 128.f) + EPS);
    const float* g = p.gla_norm_g + l * 512 + lane * 8;
#pragma unroll
    for (int e = 0; e < 8; ++e) res[e] = a[e] * rs * g[e] * siluf_(gt[e]);
    *(uint4*)(p.yb + (size_t)tok * 512 + lane * 8) = pack8(res);
  }
}

DI void phase_merge(const Params& p, int l, char* smem) {
  const bfu* WA = p.w_paT + (size_t)l * 1024 * 512;
  const bfu* WB = p.w_pbT + (size_t)l * 1024 * 512;
  for (int iter = 0;; ++iter) {
    int mt, nt;
    if (!tile256(iter, 4, mt, nt)) break;
    const int m0 = mt * 256, n0 = nt * 256;
    f32x4 acc[2][2][4][2];
    acc256_zero(acc);
    gemm256(p.ya, 512, WA, 512, 512, m0, n0, (bfu*)smem, acc);
    uint4 pg[8], pq[8];
#define MERGE_PRE1 pg[it_] = *(const uint4*)(p.proj + (size_t)(m0 + row) * PW + OFF_MA + n0 + c0);
#define MERGE_PRE2 pg[it_] = *(const uint4*)(p.proj + (size_t)(m0 + row) * PW + OFF_MB + n0 + c0); \
                   pq[it_] = *(const uint4*)(p.merged + (size_t)(m0 + row) * D + n0 + c0);
    EPI256P(MERGE_PRE1, {
      float ma[8], o[8];
      unpack8(pg[it_], ma);
      _Pragma("unroll") for (int e = 0; e < 8; ++e) o[e] = sigmoidf_(ma[e]) * v[e];
      *(uint4*)(p.merged + (size_t)(m0 + row) * D + n0 + c0) = pack8(o);
    })
    acc256_zero(acc);
    gemm256(p.yb, 512, WB, 512, 512, m0, n0, (bfu*)smem, acc);
    EPI256P(MERGE_PRE2, {
      float mb[8], o[8], pr[8];
      unpack8(pg[it_], mb);
      uint4* mp = (uint4*)(p.merged + (size_t)(m0 + row) * D + n0 + c0);
      unpack8(pq[it_], pr);
      _Pragma("unroll") for (int e = 0; e < 8; ++e) o[e] = pr[e] + sigmoidf_(mb[e]) * v[e];
      *mp = pack8(o);
    })
  }
}

DI void phase_out(const Params& p, int l, char* smem) {
  const bfu* W = p.w_oT + (size_t)l * 1024 * 1024;
  for (int iter = 0;; ++iter) {
    int mt, nt;
    if (!tile256(iter, 4, mt, nt)) break;
    const int m0 = mt * 256, n0 = nt * 256;
    f32x4 acc[2][2][4][2];
    acc256_zero(acc);
    gemm256(p.merged, D, W, 1024, 1024, m0, n0, (bfu*)smem, acc);
    const float* gate = p.mod + (size_t)(l * 5 + cond_of_tok(m0)) * 3072 + 2048;
    float4 px0[8], px1[8];
#define OUT_PRE px0[it_] = *(const float4*)(p.out + (size_t)(m0 + row) * D + n0 + c0); \
                px1[it_] = *(const float4*)(p.out + (size_t)(m0 + row) * D + n0 + c0 + 4);
    EPI256P(OUT_PRE, {
      float* xp = p.out + (size_t)(m0 + row) * D + n0 + c0;
      const float* gp = gate + n0 + c0;
      float4 x0 = px0[it_], x1 = px1[it_];
      float4 g0 = *(const float4*)gp, g1 = *(const float4*)(gp + 4);
      {
        const float4 h0 = *(const float4*)(gp + MODH), h1 = *(const float4*)(gp + MODH + 4);
        g0.x += h0.x; g0.y += h0.y; g0.z += h0.z; g0.w += h0.w;
        g1.x += h1.x; g1.y += h1.y; g1.z += h1.z; g1.w += h1.w;
      }
      x0.x += g0.x * v[0]; x0.y += g0.y * v[1]; x0.z += g0.z * v[2]; x0.w += g0.w * v[3];
      x1.x += g1.x * v[4]; x1.y += g1.y * v[5]; x1.z += g1.z * v[6]; x1.w += g1.w * v[7];
      *(float4*)xp = x0; *(float4*)(xp + 4) = x1;
    })
  }
}

DI void phase_final(const Params& p) {
  const int tid = tid_(), lane = tid & 63, w = tid >> 6;
  for (int it = VBID; it < NTOK / 4; it += NVB) {
    const int tok = it * 4 + w;
    float* xs = p.out + (size_t)tok * D;
    float4 v[4];
#pragma unroll
    for (int i = 0; i < 4; ++i) v[i] = *(const float4*)(xs + lane * 4 + 256 * i);
    float ss = 0.f;
#pragma unroll
    for (int i = 0; i < 4; ++i) ss += v[i].x * v[i].x + v[i].y * v[i].y + v[i].z * v[i].z + v[i].w * v[i].w;
    ss = wave_sum(ss);
    const float rstd = rsqrtf(ss * (1.f / 1024.f) + EPS);
#pragma unroll
    for (int i = 0; i < 4; ++i) {
      float4 g = *(const float4*)(p.final_g + lane * 4 + 256 * i);
      float4 o;
      o.x = v[i].x * rstd * g.x; o.y = v[i].y * rstd * g.y; o.z = v[i].z * rstd * g.z; o.w = v[i].w * rstd * g.w;
      *(float4*)(xs + lane * 4 + 256 * i) = o;
    }
  }
}

#define XB_TMO      128
#define XB_XCNT(j)  (256  + 64 * (j))
#define XB_XSUB(j)  (1280 + 64 * (j))
#define XB_XGEN(j)  (2304 + 64 * (j))
#define XB_TOP      3328
#define XB_TOPGEN   3392
#define XCD_BAR_WORDS 3456
#define XB_SPIN_CAP (1u << 18)
#define LAS __attribute__((address_space(3)))
DI unsigned xb_ld(unsigned* p) { return __hip_atomic_load(p, __ATOMIC_RELAXED, __HIP_MEMORY_SCOPE_AGENT); }
DI unsigned xb_add(unsigned* p, unsigned v) { return __hip_atomic_fetch_add(p, v, __ATOMIC_RELAXED, __HIP_MEMORY_SCOPE_AGENT); }
DI unsigned xb_xcc_id() { return (unsigned)__builtin_amdgcn_s_getreg((3 << 11) | 20) & 0xFu; }
#define XB_SPIN(cond, bar) do { unsigned _sp = 0; while (cond) { __builtin_amdgcn_s_sleep(1); \
    if ((++_sp & 255u) == 0u) { if (xb_ld(&(bar)[XB_TMO])) break; if (_sp > XB_SPIN_CAP) { atomicAdd(&(bar)[XB_TMO], 1u); break; } } } } while (0)
struct XcdBarrier { unsigned* bar; unsigned x; volatile LAS unsigned* st; };
DI XcdBarrier xcd_barrier_post(unsigned* bar, volatile LAS unsigned* st) {
  XcdBarrier b; b.bar = bar; b.x = xb_xcc_id(); b.st = st;
  if (threadIdx.x == 0) (void)xb_add(&bar[XB_XCNT(b.x)], 1u);
  return b;
}
DI void xcd_barrier_complete(unsigned* bar, unsigned x, unsigned& nloc, unsigned& nx) {
  const unsigned G = gridDim.x * gridDim.y * gridDim.z;
  unsigned sum, cnt, mine, sp = 0u;
  for (;;) {
    sum = 0u; cnt = 0u; mine = 0u;
#pragma unroll
    for (unsigned j = 0; j < 16; ++j) { const unsigned c = xb_ld(&bar[XB_XCNT(j)]); sum += c; cnt += (c > 0u) ? 1u : 0u; mine = (j == x) ? c : mine; }
    if (sum == G) break;
    __builtin_amdgcn_s_sleep(1);
    if ((++sp & 255u) == 0u) { if (xb_ld(&bar[XB_TMO])) break; if (sp > XB_SPIN_CAP) { atomicAdd(&bar[XB_TMO], 1u); break; } }
  }
  nloc = mine > 0u ? mine : 1u; nx = cnt > 0u ? cnt : 1u;
}
DI void xcd_barrier(const XcdBarrier& b) {
  asm volatile("s_waitcnt vmcnt(0)" ::: "memory");
  __syncthreads();
  if (threadIdx.x == 0) {
    unsigned* bar = b.bar;
    __builtin_amdgcn_s_waitcnt(0);
    unsigned nloc = b.st[0], nx = b.st[1];
    if (nloc == 0u) { xcd_barrier_complete(bar, b.x, nloc, nx); b.st[0] = nloc; b.st[1] = nx; }
    const unsigned old = xb_add(&bar[XB_XSUB(b.x)], 1u);
    const unsigned gen = old / nloc;
    if (old + 1u == (gen + 1u) * nloc) {
      __builtin_amdgcn_fence(__ATOMIC_RELEASE, "agent");
      asm volatile("s_waitcnt vmcnt(0)" ::: "memory");
      const unsigned og = xb_add(&bar[XB_TOP], 1u);
      const unsigned tg = og / nx;
      if (og + 1u == (tg + 1u) * nx) xb_add(&bar[XB_TOPGEN], 1u);
      else XB_SPIN(xb_ld(&bar[XB_TOPGEN]) == tg, bar);
      __builtin_amdgcn_fence(__ATOMIC_ACQUIRE, "agent");
      xb_add(&bar[XB_XGEN(b.x)], 1u);
      asm volatile("s_waitcnt vmcnt(0)" ::: "memory");
    } else {
      XB_SPIN(xb_ld(&bar[XB_XGEN(b.x)]) == gen, bar);
      __builtin_amdgcn_fence(__ATOMIC_ACQUIRE, "agent");
      asm volatile("s_waitcnt vmcnt(0)" ::: "memory");
    }
  }
  __syncthreads();
}

#ifndef REP_SYNC
#define REP_SYNC 0
#endif
__global__ void __launch_bounds__(512, 2) k_mega(Params p) {
  extern __shared__ __attribute__((aligned(16))) char smem_all[];
  cg::grid_group grid = cg::this_grid();
  char* smem = smem_all;
#define smh (smem_all + VHALF * 65536)
  volatile LAS unsigned* xst = (volatile LAS unsigned*)(smem_all + 131072);
  if (threadIdx.x < 4) xst[threadIdx.x] = 0u;
  __syncthreads();
  XcdBarrier xb = xcd_barrier_post(p.bar, xst);
#define GSYNC() xcd_barrier(xb)
  phase_prep(p, smh);
  phase_s5_gen(p, 0, smh);
  GSYNC();
  if (p.bar == nullptr) grid.sync();
  for (int l = 0; l < 2; ++l) {
    phase_h(p, l);
    GSYNC();
    phase_gemm_in(p, l, smem);
    GSYNC();
    phase_s5_e(p, smh);
    phase_gla_pass1(p, l, smh);
    GSYNC();
    phase_s5_scan(p, l);
    phase_gla_main(p, l, smh);
    GSYNC();
    phase_s5_y(p, l, smh);
    phase_gla_norm(p, l);
    GSYNC();
    phase_glu(p, l, smh);
    GSYNC();
    phase_merge(p, l, smem);
    if (l == 0 && (blockIdx.x >> 3) >= 24) {
      const int hb = (int)((((blockIdx.x >> 3) - 24) * 8 + (blockIdx.x & 7)) * 2) + VHALF;
      s5_gen_item(p, 1, hb, smh);
    }
    GSYNC();
    phase_out(p, l, smem);
    if (l == 0 && (blockIdx.x >> 3) >= 24) {
      const int hb = (int)((((blockIdx.x >> 3) - 24) * 8 + (blockIdx.x & 7)) * 2) + VHALF;
      s5_gen_item(p, 1, hb + 128, smh);
    }
    GSYNC();
    for (int rep = 0; rep < REP_SYNC; ++rep) GSYNC();
  }
  phase_final(p);
}

extern "C" void kernel_launch(void* const* d_in, const int* in_sizes, int n_in, void* d_out, int out_size,
                              void* d_ws, size_t ws_size, hipStream_t stream) {
  Params p{};
  const float* const* in = (const float* const*)d_in;
  p.x_prompt = in[0]; p.x_sample = in[1]; p.c = in[2]; p.st_re = in[3]; p.st_im = in[4]; p.st_gla = in[5];
  p.c_ctx = in[6]; p.norm_g = in[7]; p.w_mod = in[8]; p.b_mod = in[9]; p.w_in = in[10]; p.wg_up = in[11];
  p.bg = in[12]; p.gla_norm_g = in[13]; p.lam_re = in[14]; p.lam_im = in[15]; p.log_dt = in[16];
  p.b_re = in[17]; p.b_im = in[18]; p.c_re = in[19]; p.c_im = in[20]; p.s5_d = in[21]; p.w_glu = in[22];
  p.b_glu = in[23]; p.w_pa = in[24]; p.w_pb = in[25]; p.w_o = in[26]; p.final_g = in[27];
  p.out = (float*)d_out;
  char* ws = (char*)d_ws;
  size_t off = 0;
  auto take = [&](size_t bytes) { char* r = ws + off; off += (bytes + 255) & ~(size_t)255; return r; };
  p.w_inT = (bfu*)take((size_t)2 * DINP * LDH * 2);
  p.w_gluT = (bfu*)take((size_t)2 * 512 * 512 * 2);
  p.w_paT = (bfu*)take((size_t)2 * 1024 * 512 * 2);
  p.w_pbT = (bfu*)take((size_t)2 * 1024 * 512 * 2);
  p.w_oT = (bfu*)take((size_t)2 * 1024 * 1024 * 2);
  p.pos_r = (float*)take((size_t)32 * 512 * 4);
  p.pos_c = (float*)take((size_t)64 * 512 * 4);
  p.h = (bfu*)take((size_t)NTOK * LDH * 2);
  p.proj = (bfu*)take((size_t)NTOK * PW * 2);
  p.ys5 = (bfu*)take((size_t)NTOK * 512 * 2);
  p.ya = (bfu*)take((size_t)NTOK * 512 * 2);
  p.yb = (bfu*)take((size_t)NTOK * 512 * 2);
  p.merged = (bfu*)take((size_t)NTOK * D * 2);
  p.tmp_s5 = nullptr;
  p.ebuf = (float*)p.merged;
  p.carry = (bfu*)((char*)p.merged + (size_t)32 * NCHUNK * 256 * 4);
  p.ug = (bfu*)take((size_t)32 * NTOK * 16 * 2);
  p.opMG = (bfu*)take((size_t)32 * 512 * 768 * 2);
  p.opE = (bfu*)take((size_t)32 * 256 * 512 * 2);
  p.gla_sloc = (float*)p.ys5;
  p.gla_aseg = (float*)((char*)p.ys5 + (size_t)256 * 8192 * 4);
  if (off > ws_size) fprintf(stderr, "workspace too small: %zu > %zu\n", off, ws_size);
  p.bar = (unsigned*)take((size_t)XCD_BAR_WORDS * 4);
  p.mod = (float*)take((size_t)2 * 2 * 5 * 3072 * 4);
  p.gla_o = (bfu*)p.h;
  p.tmp_gla = (float*)p.h;
  constexpr size_t kLds = 131072 + 16;
  static int grid_blocks = 0;
  if (!grid_blocks) {
    int dev = 0, cus = 0, per_cu = 0;
    hipGetDevice(&dev);
    hipDeviceGetAttribute(&cus, hipDeviceAttributeMultiprocessorCount, dev);
    hipFuncSetAttribute((const void*)k_mega, hipFuncAttributeMaxDynamicSharedMemorySize, (int)kLds);
    hipOccupancyMaxActiveBlocksPerMultiprocessor(&per_cu, k_mega, 512, kLds);
    if (per_cu > 1) per_cu = 1;
    grid_blocks = cus * per_cu;
    if (grid_blocks % 8 != 0 || grid_blocks <= 0) fprintf(stderr, "unexpected grid %d\n", grid_blocks);
  }
  hipMemsetAsync(p.bar, 0, (size_t)XCD_BAR_WORDS * 4, stream);
  void* args[] = {&p};
  hipError_t e = hipLaunchCooperativeKernel((void*)k_mega, dim3(grid_blocks), dim3(512), args, kLds, stream);
  if (e != hipSuccess) fprintf(stderr, "cooperative launch failed: %s (grid %d)\n", hipGetErrorString(e), grid_blocks);
}
```

```cpp
#include <hip/hip_runtime.h>
#include <hip/hip_cooperative_groups.h>
#include <stdint.h>
#include <math.h>
#include <stdio.h>
namespace cg = cooperative_groups;

#ifndef REP_PREP
#define REP_PREP 0
#endif
#ifndef REP_GIN
#define REP_GIN 0
#endif
#ifndef REP_X1
#define REP_X1 0
#endif
#ifndef REP_X2
#define REP_X2 0
#endif
#ifndef REP_Y
#define REP_Y 0
#endif
#ifndef REP_MERGE
#define REP_MERGE 0
#endif
#ifndef REP_SYNC
#define REP_SYNC 0
#endif
#ifndef ONE_LAUNCH
#define ONE_LAUNCH 1
#endif

typedef unsigned short bfu;
typedef __attribute__((ext_vector_type(8))) short bf16x8;
typedef __attribute__((ext_vector_type(16))) float f32x16;
typedef __attribute__((ext_vector_type(2))) __bf16 bf2_t;
typedef __attribute__((ext_vector_type(2))) float f2_t;

#define DI __device__ __forceinline__

constexpr int D = 1024;
constexpr int NTOK = 12288;
constexpr int NPROMPT = 4096;
constexpr int DIN = 4624;
constexpr int DINP = 4864;
constexpr int LDH = 1088;
constexpr int PW = 4112;
constexpr int OFF_GA = 0, OFF_Q = 512, OFF_K = 768, OFF_V = 1024, OFF_GB = 1536, OFF_GL = 2048,
              OFF_MA = 2064, OFF_MB = 3088;
constexpr int NCHUNK = NTOK / 32;
constexpr size_t OUT_RE = (size_t)NTOK * D;
constexpr size_t OUT_IM = OUT_RE + 131072;
constexpr size_t OUT_GLA = OUT_IM + 131072;
constexpr float EPS = 1e-6f;
constexpr int MODH = 2 * 5 * 3072;

struct Params {
  const float *x_prompt, *x_sample, *c, *st_re, *st_im, *st_gla, *c_ctx, *norm_g, *w_mod, *b_mod, *w_in,
      *wg_up, *bg, *gla_norm_g, *lam_re, *lam_im, *log_dt, *b_re, *b_im, *c_re, *c_im, *s5_d, *w_glu,
      *b_glu, *w_pa, *w_pb, *w_o, *final_g;
  float* out;
  bfu *w_inT, *w_gluT, *w_paT, *w_pbT, *w_oT;
  float *mod, *pos_r, *pos_c, *tmp_s5, *tmp_gla;
  bfu *h, *proj, *ys5, *ya, *yb, *merged;
  bfu *ug, *opMG, *opE, *carry;
  float *ebuf, *gla_sloc, *gla_aseg;
  unsigned* bar;
  bfu* gla_o;
};

DI int tid_() { int t = threadIdx.x & 255; asm volatile("" : "+v"(t)); return t; }
#define VHALF ((int)__builtin_amdgcn_readfirstlane((int)(threadIdx.x >> 8)))
#define VBID ((int)(blockIdx.x * 2 + VHALF))
#define NVB ((int)(gridDim.x * 2))
#define VXCD ((int)(blockIdx.x & 7))
#define VJ ((int)((blockIdx.x >> 3) * 2 + VHALF))
#define VNLOC ((int)((gridDim.x >> 3) * 2))
DI float bf2f(bfu v) { return __uint_as_float(((unsigned)v) << 16); }
DI bfu f2bf(float x) { __bf16 b = (__bf16)x; return __builtin_bit_cast(unsigned short, b); }
DI unsigned pack2(float lo, float hi) {
  f2_t v = {lo, hi};
  bf2_t w = __builtin_convertvector(v, bf2_t);
  return __builtin_bit_cast(unsigned, w);
}
DI float exp2f_(float x) { return __builtin_amdgcn_exp2f(x); }
DI float sigmoidf_(float x) { return __builtin_amdgcn_rcpf(1.f + exp2f_(-1.44269504f * x)); }
DI float siluf_(float x) { return x * sigmoidf_(x); }
DI float geluf_(float x) {
  float u = 0.7978845608028654f * (x + 0.044715f * x * x * x);
  float t = 1.f - 2.f * __builtin_amdgcn_rcpf(exp2f_(2.88539008f * u) + 1.f);
  return 0.5f * x * (1.f + t);
}
DI float logsigmoidf_(float x) {
  return fminf(x, 0.f) - 0.69314718f * __builtin_amdgcn_logf(1.f + exp2f_(-1.44269504f * fabsf(x)));
}
DI float wave_sum(float v) {
#pragma unroll
  for (int o = 32; o >= 1; o >>= 1) v += __shfl_xor(v, o);
  return v;
}
DI void unpack8(const uint4 v, float (&f)[8]) {
  f[0] = __uint_as_float(v.x << 16); f[1] = __uint_as_float(v.x & 0xffff0000u);
  f[2] = __uint_as_float(v.y << 16); f[3] = __uint_as_float(v.y & 0xffff0000u);
  f[4] = __uint_as_float(v.z << 16); f[5] = __uint_as_float(v.z & 0xffff0000u);
  f[6] = __uint_as_float(v.w << 16); f[7] = __uint_as_float(v.w & 0xffff0000u);
}
DI uint4 pack8(const float (&f)[8]) {
  uint4 o;
  o.x = pack2(f[0], f[1]); o.y = pack2(f[2], f[3]); o.z = pack2(f[4], f[5]); o.w = pack2(f[6], f[7]);
  return o;
}
DI int cond_of_tok(int tok) { return tok < NPROMPT ? 0 : 1 + ((tok - NPROMPT) >> 11); }

DI void transpose_tile(const float* __restrict__ src, int K, int N, bfu* __restrict__ dst, int kt, int nt,
                       float* sm, int ldd = 0) {
  if (ldd == 0) ldd = K;
  const int tid = tid_(), c = tid & 63, r4 = tid >> 6;
  const int k0 = kt * 64, n0 = nt * 64;
  float v[16];
  const bool inb = (n0 + c) < N;
#pragma unroll
  for (int i = 0; i < 16; ++i) v[i] = inb ? src[(size_t)(k0 + i * 4 + r4) * N + n0 + c] : 0.f;
#pragma unroll
  for (int i = 0; i < 16; ++i) sm[(i * 4 + r4) * 65 + c] = v[i];
  __syncthreads();
  {
    const int n = tid >> 2, kc = tid & 3;
    float o[16];
#pragma unroll
    for (int i = 0; i < 16; ++i) o[i] = sm[(kc * 16 + i) * 65 + n];
    bfu* dp = dst + (size_t)(n0 + n) * ldd + k0 + kc * 16;
    *(uint4*)dp = pack8(*(float(*)[8])&o[0]);
    *(uint4*)(dp + 8) = pack8(*(float(*)[8])&o[8]);
  }
  __syncthreads();
}

DI void phase_prep(const Params& p, char* smem) {
  float* sm = (float*)smem;
  const int tid = tid_();
  for (int it = VBID; it < 192; it += NVB) {
    const int kh = it & 1, jb = (it >> 1) % 48, l = it / 96;
    float* ssil = sm;
    float* sred = sm + 5 * 512;
    for (int idx = tid; idx < 2560; idx += 256) {
      int ci = idx >> 9, k = (idx & 511) + kh * 512;
      float cv = (ci == 0) ? p.c_ctx[k] : p.c[(ci - 1) * 1024 + k];
      ssil[idx] = cv / (1.f + expf(-cv));
    }
    __syncthreads();
    const int jj = tid & 63, kq = tid >> 6;
    const int j = jb * 64 + jj;
    float acc[5] = {0.f, 0.f, 0.f, 0.f, 0.f};
    const float* wp = p.w_mod + ((size_t)l * 1024 + kh * 512 + kq * 128) * 3072 + j;
#pragma unroll 16
    for (int k = 0; k < 128; ++k) {
      float w = wp[(size_t)k * 3072];
#pragma unroll
      for (int ci = 0; ci < 5; ++ci) acc[ci] += ssil[ci * 512 + kq * 128 + k] * w;
    }
#pragma unroll
    for (int ci = 0; ci < 5; ++ci) sred[(kq * 5 + ci) * 64 + jj] = acc[ci];
    __syncthreads();
    for (int idx = tid; idx < 320; idx += 256) {
      int ci = idx >> 6, j2 = idx & 63;
      float sv = kh == 0 ? p.b_mod[l * 3072 + jb * 64 + j2] : 0.f;
#pragma unroll
      for (int q = 0; q < 4; ++q) sv += sred[(q * 5 + ci) * 64 + j2];
      p.mod[((size_t)(kh * 2 + l) * 5 + ci) * 3072 + jb * 64 + j2] = sv;
    }
    __syncthreads();
  }
  for (int idx = VBID * 256 + tid; idx < 96 * 512; idx += NVB * 256) {
    int r = idx >> 9, i = idx & 511;
    int pos = r < 32 ? r : r - 32;
    int q = i & 255;
    double f = exp(-log(10000.0) * (double)q / 256.0);
    double ang = (double)pos * f;
    float v = (float)((i < 256) ? sin(ang) : cos(ang));
    if (r < 32) p.pos_r[r * 512 + i] = v; else p.pos_c[(r - 32) * 512 + i] = v;
  }
  for (int it = VBID; it < 3584; it += NVB) {
    int l = it / 1792, r = it % 1792;
    if (r < 1216) {
      transpose_tile(p.w_in + (size_t)l * 1024 * DIN, 1024, DIN, p.w_inT + (size_t)l * DINP * LDH, r % 16, r / 16, sm, LDH);
    } else if (r < 1280) {
      r -= 1216;
      transpose_tile(p.w_glu + (size_t)l * 512 * 512, 512, 512, p.w_gluT + (size_t)l * 512 * 512, r % 8, r / 8, sm);
    } else if (r < 1408) {
      r -= 1280;
      transpose_tile(p.w_pa + (size_t)l * 512 * 1024, 512, 1024, p.w_paT + (size_t)l * 1024 * 512, r % 8, r / 8, sm);
    } else if (r < 1536) {
      r -= 1408;
      transpose_tile(p.w_pb + (size_t)l * 512 * 1024, 512, 1024, p.w_pbT + (size_t)l * 1024 * 512, r % 8, r / 8, sm);
    } else {
      r -= 1536;
      transpose_tile(p.w_o + (size_t)l * 1024 * 1024, 1024, 1024, p.w_oT + (size_t)l * 1024 * 1024, r % 16, r / 16, sm);
    }
  }
}

DI void phase_h(const Params& p, int l) {
  const int tid = tid_(), lane = tid & 63, w = tid >> 6;
  for (int it = VBID; it < NTOK / 4; it += NVB) {
    const int tok = it * 4 + w;
    float4 v[4];
    float* xs = p.out + (size_t)tok * D;
    if (l == 0) {
      const float* src = tok < NPROMPT ? p.x_prompt + (size_t)tok * D : p.x_sample + (size_t)(tok - NPROMPT) * D;
#pragma unroll
      for (int i = 0; i < 4; ++i) v[i] = *(const float4*)(src + lane * 4 + 256 * i);
      if (tok >= NPROMPT) {
        int t = (tok - NPROMPT) & 2047, row = t >> 6, col = t & 63;
#pragma unroll
        for (int i = 0; i < 4; ++i) {
          int d = lane * 4 + 256 * i;
          const float* pe = d < 512 ? p.pos_r + row * 512 + d : p.pos_c + col * 512 + (d - 512);
          float4 e = *(const float4*)pe;
          v[i].x += e.x; v[i].y += e.y; v[i].z += e.z; v[i].w += e.w;
        }
      }
#pragma unroll
      for (int i = 0; i < 4; ++i) *(float4*)(xs + lane * 4 + 256 * i) = v[i];
    } else {
#pragma unroll
      for (int i = 0; i < 4; ++i) v[i] = *(const float4*)(xs + lane * 4 + 256 * i);
    }
    float ss = 0.f;
#pragma unroll
    for (int i = 0; i < 4; ++i) ss += v[i].x * v[i].x + v[i].y * v[i].y + v[i].z * v[i].z + v[i].w * v[i].w;
    ss = wave_sum(ss);
    const float rstd = rsqrtf(ss * (1.f / 1024.f) + EPS);
    const float* md = p.mod + (size_t)(l * 5 + cond_of_tok(tok)) * 3072;
    const float* ng = p.norm_g + l * 1024;
#pragma unroll
    for (int i = 0; i < 4; ++i) {
      int d = lane * 4 + 256 * i;
      float4 g = *(const float4*)(ng + d);
      float4 sh = *(const float4*)(md + d);
      float4 sc = *(const float4*)(md + 1024 + d);
      {
        const float4 sh1 = *(const float4*)(md + MODH + d);
        const float4 sc1 = *(const float4*)(md + MODH + 1024 + d);
        sh.x += sh1.x; sh.y += sh1.y; sh.z += sh1.z; sh.w += sh1.w;
        sc.x += sc1.x; sc.y += sc1.y; sc.z += sc1.z; sc.w += sc1.w;
      }
      float a0 = v[i].x * rstd * g.x * (1.f + sc.x) + sh.x;
      float a1 = v[i].y * rstd * g.y * (1.f + sc.y) + sh.y;
      float a2 = v[i].z * rstd * g.z * (1.f + sc.z) + sh.z;
      float a3 = v[i].w * rstd * g.w * (1.f + sc.w) + sh.w;
      uint2 o; o.x = pack2(a0, a1); o.y = pack2(a2, a3);
      *(uint2*)(p.h + (size_t)tok * LDH + d) = o;
    }
  }
}

DI void gemm_core(const bfu* __restrict__ A, int lda, const bfu* __restrict__ B, int ldb, int K, char* smem,
                  f32x16 (&acc)[2][2]) {
  const int tid = tid_(), lane = tid & 63, w = tid >> 6, wm = w >> 1, wn = w & 1;
  const int c8 = tid & 7, r0 = tid >> 3;
  const bfu* ga = A + (size_t)r0 * lda + c8 * 8;
  const bfu* gb = B + (size_t)r0 * ldb + c8 * 8;
  const int st_off = r0 * 128 + ((c8 ^ ((r0 >> 1) & 7)) * 16);
  const int fr = lane & 31, hh = lane >> 5, fsw = (fr >> 1) & 7;
  const int a_base = (wm * 64 + fr) * 128;
  const int b_base = 16384 + (wn * 64 + fr) * 128;
  uint4 ra0, ra1, ra2, ra3, rb0, rb1, rb2, rb3, qa0, qa1, qa2, qa3, qb0, qb1, qb2, qb3;
  const int KT = K >> 6;
#define GEMM_LOADT(RA, RB, tile)                                                           \
  {                                                                                        \
    const int t_ = (tile) < KT ? (tile) : KT - 1;                                          \
    const bfu* ga_ = ga + t_ * 64; const bfu* gb_ = gb + t_ * 64;                          \
    RA##0 = *(const uint4*)(ga_);                        RB##0 = *(const uint4*)(gb_);                        \
    RA##1 = *(const uint4*)(ga_ + (size_t)32 * lda);     RB##1 = *(const uint4*)(gb_ + (size_t)32 * ldb);     \
    RA##2 = *(const uint4*)(ga_ + (size_t)64 * lda);     RB##2 = *(const uint4*)(gb_ + (size_t)64 * ldb);     \
    RA##3 = *(const uint4*)(ga_ + (size_t)96 * lda);     RB##3 = *(const uint4*)(gb_ + (size_t)96 * ldb);     \
  }
#define GEMM_STORET(buf, RA, RB)                                                           \
  {                                                                                        \
    *(uint4*)((buf) + st_off) = RA##0;          *(uint4*)((buf) + 16384 + st_off) = RB##0;          \
    *(uint4*)((buf) + st_off + 4096) = RA##1;   *(uint4*)((buf) + 16384 + st_off + 4096) = RB##1;   \
    *(uint4*)((buf) + st_off + 8192) = RA##2;   *(uint4*)((buf) + 16384 + st_off + 8192) = RB##2;   \
    *(uint4*)((buf) + st_off + 12288) = RA##3;  *(uint4*)((buf) + 16384 + st_off + 12288) = RB##3;  \
  }
#define GEMM_COMPUTE(cur)                                                                  \
  _Pragma("unroll") for (int s = 0; s < 4; ++s) {                                          \
    const int co = ((2 * s + hh) ^ fsw) * 16;                                              \
    bf16x8 a0 = *(const bf16x8*)((cur) + a_base + co);                                     \
    bf16x8 a1 = *(const bf16x8*)((cur) + a_base + 4096 + co);                              \
    bf16x8 b0 = *(const bf16x8*)((cur) + b_base + co);                                     \
    bf16x8 b1 = *(const bf16x8*)((cur) + b_base + 4096 + co);                              \
    acc[0][0] = __builtin_amdgcn_mfma_f32_32x32x16_bf16(a0, b0, acc[0][0], 0, 0, 0);       \
    acc[0][1] = __builtin_amdgcn_mfma_f32_32x32x16_bf16(a0, b1, acc[0][1], 0, 0, 0);       \
    acc[1][0] = __builtin_amdgcn_mfma_f32_32x32x16_bf16(a1, b0, acc[1][0], 0, 0, 0);       \
    acc[1][1] = __builtin_amdgcn_mfma_f32_32x32x16_bf16(a1, b1, acc[1][1], 0, 0, 0);       \
  }
  GEMM_LOADT(ra, rb, 0)
  GEMM_LOADT(qa, qb, 1)
  GEMM_STORET(smem, ra, rb)
  __syncthreads();
#pragma unroll 1
  for (int kt = 0; kt < KT; kt += 2) {
    GEMM_LOADT(ra, rb, kt + 2)
    __builtin_amdgcn_sched_barrier(0);
    GEMM_COMPUTE(smem)
    __builtin_amdgcn_sched_barrier(0);
    GEMM_STORET(smem + 32768, qa, qb)
    __syncthreads();
    GEMM_LOADT(qa, qb, kt + 3)
    __builtin_amdgcn_sched_barrier(0);
    GEMM_COMPUTE(smem + 32768)
    __builtin_amdgcn_sched_barrier(0);
    GEMM_STORET(smem, ra, rb)
    __syncthreads();
  }
}

DI void acc_zero(f32x16 (&acc)[2][2]) {
#pragma unroll
  for (int i = 0; i < 2; ++i)
#pragma unroll
    for (int j = 0; j < 2; ++j)
#pragma unroll
      for (int r = 0; r < 16; ++r) acc[i][j][r] = 0.f;
}

DI void acc_to_lds(const f32x16 (&acc)[2][2], char* smem) {
  float* sf = (float*)smem;
  const int tid = tid_(), lane = tid & 63, w = tid >> 6;
  const int rb = (w >> 1) * 64 + 4 * (lane >> 5), cb = (w & 1) * 64 + (lane & 31);
#pragma unroll
  for (int i = 0; i < 2; ++i)
#pragma unroll
    for (int j = 0; j < 2; ++j)
#pragma unroll
      for (int r = 0; r < 16; ++r)
        sf[(rb + i * 32 + (r & 3) + 8 * (r >> 2)) * 128 + cb + j * 32] = acc[i][j][r];
}
#define EPI_LDS(...)                                                             \
  {                                                                              \
    acc_to_lds(acc, smem);                                                       \
    __syncthreads();                                                             \
    _Pragma("unroll 1") for (int it_ = 0; it_ < 8; ++it_) {                      \
      const int row = (tid_() >> 4) + 16 * it_;                             \
      const int c0 = (tid_() & 15) * 8;                                     \
      float v[8];                                                                \
      {                                                                          \
        const float4 t0 = *(const float4*)(smem + (row * 128 + c0) * 4);         \
        const float4 t1 = *(const float4*)(smem + (row * 128 + c0 + 4) * 4);     \
        v[0] = t0.x; v[1] = t0.y; v[2] = t0.z; v[3] = t0.w;                      \
        v[4] = t1.x; v[5] = t1.y; v[6] = t1.z; v[7] = t1.w;                      \
      }                                                                          \
      __VA_ARGS__                                                                \
    }                                                                            \
    __syncthreads();                                                             \
  }

typedef __attribute__((ext_vector_type(4))) float f32x4;
constexpr int G_BK = 64, G_HALF = 128, G_HT = G_HALF * G_BK;
DI int g_lds_byte(int r, int c) {
  int st = (r >> 4) * 2 + (c >> 5), rr = r & 15, cc = c & 31, ob = rr * 64 + cc * 2;
  return st * 1024 + (ob ^ (((ob >> 9) & 1) << 5));
}
DI void g_stage_rc(int b, int& R, int& C) {
  int st = b / 1024, sb = b % 1024, swz = sb ^ (((sb >> 9) & 1) << 5);
  R = (st >> 1) * 16 + swz / 64; C = (st & 1) * 32 + (swz % 64) / 2;
}
DI const char* g_uniform(const char* ptr) {
  unsigned long long u = (unsigned long long)ptr;
  unsigned lo = __builtin_amdgcn_readfirstlane((unsigned)u), hi = __builtin_amdgcn_readfirstlane((unsigned)(u >> 32));
  return (const char*)(((unsigned long long)hi << 32) | lo);
}
DI void gemm256(const bfu* __restrict__ A, int lda, const bfu* __restrict__ Bt, int ldb, int K, int brow, int bcol,
                bfu* shm, f32x4 (&acc)[2][2][4][2]) {
#define G_SA(b, h) (shm + ((b) * 2 + (h)) * G_HT)
#define G_SB(b, h) (shm + (4 + (b) * 2 + (h)) * G_HT)
#define G_STAGE(P, BASE, LD, br, kt)                                                                   \
  do {                                                                                                 \
    const char* _u = g_uniform((const char*)((BASE) + ((long)(br) * (LD) + (long)(kt) * G_BK)));       \
    __builtin_amdgcn_global_load_lds((const unsigned*)(_u + soff_b),                                   \
        (__attribute__((address_space(3))) unsigned*)((char*)(P) + ldst), 16, 0, 0);                   \
    __builtin_amdgcn_global_load_lds((const unsigned*)(_u + 128 * (long)(LD) + soff_b),                \
        (__attribute__((address_space(3))) unsigned*)((char*)(P) + ldst + 8192), 16, 0, 0);            \
  } while (0)
#define G_LDA(dst, b, h) for (int m = 0; m < 4; ++m) for (int k = 0; k < 2; ++k) \
    dst[m][k] = *reinterpret_cast<const bf16x8*>((char*)G_SA(b, h) + a_rd + m * 2048 + k * 1024)
#define G_LDB(dst, b, h) for (int n = 0; n < 2; ++n) for (int k = 0; k < 2; ++k) \
    dst[n][k] = *reinterpret_cast<const bf16x8*>((char*)G_SB(b, h) + b_rd + n * 2048 + k * 1024)
#define G_MMA(ai, bj, At, Bt_)                                                                         \
  do {                                                                                                 \
    __builtin_amdgcn_s_setprio(1);                                                                     \
    for (int m = 0; m < 4; ++m) for (int n = 0; n < 2; ++n) for (int k = 0; k < 2; ++k)                \
      acc[ai][bj][m][n] = __builtin_amdgcn_mfma_f32_16x16x32_bf16(At[m][k], Bt_[n][k], acc[ai][bj][m][n], 0, 0, 0); \
    __builtin_amdgcn_s_setprio(0);                                                                     \
  } while (0)
#define G_WAIT_V(n) asm volatile("s_waitcnt vmcnt(" #n ")" ::: "memory")
#define G_WAIT_L(n) asm volatile("s_waitcnt lgkmcnt(" #n ")" ::: "memory")
#define G_BAR __builtin_amdgcn_s_barrier()
#define G_SCHED __builtin_amdgcn_sched_barrier(0)
  int t512 = threadIdx.x; asm volatile("" : "+v"(t512));
  const int wid = __builtin_amdgcn_readfirstlane(t512 >> 6), lane = t512 & 63, wr = wid >> 2, wc = wid & 3, fr = lane & 15, fq = lane >> 4;
  const int ldst = t512 * 16;
  unsigned soff_b;
  {
    int R0, C0;
    g_stage_rc(ldst, R0, C0);
    soff_b = (unsigned)(R0 * lda + C0) * 2u;
  }
  const int lane_off = (fr * 64 + fq * 16) ^ ((fr >> 3) << 5);
  const int a_rd = wr * 8192 + lane_off, b_rd = wc * 4096 + lane_off;
  bf16x8 At[4][2], B0[2][2], B1[2][2];
  const int nt = K / G_BK;
  G_STAGE(G_SB(0, 0), Bt, ldb, bcol, 0); G_STAGE(G_SA(0, 0), A, lda, brow, 0);
  G_STAGE(G_SB(0, 1), Bt, ldb, bcol + G_HALF, 0); G_STAGE(G_SA(0, 1), A, lda, brow + G_HALF, 0);
  if (wr == 1) G_BAR;
  G_WAIT_V(4); G_BAR;
  G_STAGE(G_SB(1, 0), Bt, ldb, bcol, 1); G_STAGE(G_SA(1, 0), A, lda, brow, 1); G_STAGE(G_SB(1, 1), Bt, ldb, bcol + G_HALF, 1);
  G_WAIT_V(6); G_BAR;
#pragma unroll 1
  for (int t = 0; t < nt - 2; t += 2) {
    G_LDB(B0, 0, 0); G_SCHED; G_LDA(At, 0, 0); G_STAGE(G_SA(1, 1), A, lda, brow + G_HALF, t + 1);
    G_WAIT_L(8); G_BAR; G_WAIT_L(0); G_MMA(0, 0, At, B0); G_BAR; G_SCHED;
    G_LDB(B1, 0, 1); G_STAGE(G_SB(0, 0), Bt, ldb, bcol, t + 2);
    G_BAR; G_WAIT_L(0); G_MMA(0, 1, At, B1); G_BAR;
    G_LDA(At, 0, 1); G_STAGE(G_SA(0, 0), A, lda, brow, t + 2);
    G_BAR; G_WAIT_L(0); G_MMA(1, 0, At, B0); G_BAR; G_SCHED;
    G_STAGE(G_SB(0, 1), Bt, ldb, bcol + G_HALF, t + 2);
    G_WAIT_V(6); G_BAR; G_MMA(1, 1, At, B1); G_BAR;
    G_LDB(B0, 1, 0); G_SCHED; G_LDA(At, 1, 0); G_STAGE(G_SA(0, 1), A, lda, brow + G_HALF, t + 2);
    G_WAIT_L(8); G_BAR; G_WAIT_L(0); G_MMA(0, 0, At, B0); G_BAR; G_SCHED;
    G_LDB(B1, 1, 1); G_STAGE(G_SB(1, 0), Bt, ldb, bcol, t + 3);
    G_BAR; G_WAIT_L(0); G_MMA(0, 1, At, B1); G_BAR;
    G_LDA(At, 1, 1); G_STAGE(G_SA(1, 0), A, lda, brow, t + 3);
    G_BAR; G_WAIT_L(0); G_MMA(1, 0, At, B0); G_BAR; G_SCHED;
    G_STAGE(G_SB(1, 1), Bt, ldb, bcol + G_HALF, t + 3);
    G_WAIT_V(6); G_BAR; G_MMA(1, 1, At, B1); G_BAR;
  }
  { G_LDB(B0, 0, 0); G_LDA(At, 0, 0); G_STAGE(G_SA(1, 1), A, lda, brow + G_HALF, nt - 1);
    G_BAR; G_WAIT_L(0); G_MMA(0, 0, At, B0); G_BAR;
    G_LDB(B1, 0, 1); G_BAR; G_WAIT_L(0); G_MMA(0, 1, At, B1); G_BAR;
    G_LDA(At, 0, 1); G_WAIT_V(4); G_BAR; G_WAIT_L(0); G_MMA(1, 0, At, B0); G_MMA(1, 1, At, B1); G_BAR; }
  { G_LDB(B0, 1, 0); G_LDA(At, 1, 0); G_WAIT_V(2); G_BAR; G_WAIT_L(0); G_MMA(0, 0, At, B0); G_BAR;
    G_LDB(B1, 1, 1); G_WAIT_V(0); G_BAR; G_WAIT_L(0); G_MMA(0, 1, At, B1); G_BAR;
    G_LDA(At, 1, 1); G_BAR; G_WAIT_L(0); G_MMA(1, 0, At, B0); G_MMA(1, 1, At, B1); G_BAR; }
  if (wr == 0) G_BAR;
}
DI void acc256_zero(f32x4 (&acc)[2][2][4][2]) {
#pragma unroll
  for (int a = 0; a < 2; ++a)
#pragma unroll
    for (int b = 0; b < 2; ++b)
#pragma unroll
      for (int m = 0; m < 4; ++m)
#pragma unroll
        for (int n = 0; n < 2; ++n) acc[a][b][m][n] = (f32x4){0.f, 0.f, 0.f, 0.f};
}
#define EPI_NOPRE
#define EPI256P(PRE, ...)                                                                              \
  {                                                                                                    \
    int t512_ = threadIdx.x; asm volatile("" : "+v"(t512_));     \
    const int wid_ = t512_ >> 6, lane_ = t512_ & 63, wr_ = wid_ >> 2, wc_ = wid_ & 3,                  \
              fr_ = lane_ & 15, fq_ = lane_ >> 4;                                                      \
    float* sf_ = (float*)smem;                                                                         \
    _Pragma("unroll") for (int ai_ = 0; ai_ < 2; ++ai_) {                                              \
      _Pragma("unroll") for (int it_ = 0; it_ < 8; ++it_) {     \
        const int idx_ = t512_ + 512 * it_;                                                            \
        const int rl_ = idx_ >> 5, c0 = (idx_ & 31) * 8;                                               \
        const int row = ai_ * 128 + rl_;                                                               \
        (void)rl_; (void)c0; (void)row;                                                                \
        PRE                                                                                            \
      }                                                                                                \
      __builtin_amdgcn_sched_barrier(0);              \
      __syncthreads();                                                                                 \
      _Pragma("unroll") for (int bj_ = 0; bj_ < 2; ++bj_)                                              \
      _Pragma("unroll") for (int m_ = 0; m_ < 4; ++m_)                                                 \
      _Pragma("unroll") for (int n_ = 0; n_ < 2; ++n_)                                                 \
      _Pragma("unroll") for (int j_ = 0; j_ < 4; ++j_)                                                 \
        sf_[(wr_ * 64 + m_ * 16 + fq_ * 4 + j_) * 256 + ((bj_ * 128 + wc_ * 32 + n_ * 16 + fr_) ^ (fq_ << 4))] = \
            acc[ai_][bj_][m_][n_][j_];                                                                 \
      __syncthreads();                                                                                 \
      _Pragma("unroll") for (int it_ = 0; it_ < 8; ++it_) {                                            \
        const int idx_ = t512_ + 512 * it_;                                                            \
        const int rl_ = idx_ >> 5, c0 = (idx_ & 31) * 8;                                               \
        const int row = ai_ * 128 + rl_;                                                               \
        float v[8];                                                                                    \
        {                                                                                              \
          const float* sp_ = sf_ + rl_ * 256 + (c0 ^ (((rl_ >> 2) & 3) << 4));                          \
          const float4 t0 = *(const float4*)sp_; const float4 t1 = *(const float4*)(sp_ + 4);          \
          v[0] = t0.x; v[1] = t0.y; v[2] = t0.z; v[3] = t0.w;                                          \
          v[4] = t1.x; v[5] = t1.y; v[6] = t1.z; v[7] = t1.w;                                          \
        }                                                                                              \
        __VA_ARGS__                                                                                    \
      }                                                                                                \
    }                                                                                                  \
    __syncthreads();                                                                                   \
  }
#define EPI256(...) EPI256P(EPI_NOPRE, __VA_ARGS__)

template <int MT, int NT, int BH>
DI bool xcd_tile(int iter, int& mt, int& nt) {
  constexpr int MPX = MT / 8, TPX = MPX * NT;
  const int xcd = VXCD, j = VJ, nloc = VNLOC;
  const int q = j + iter * nloc;
  if (q >= TPX) return false;
  const int band = q / (BH * NT), r = q % (BH * NT);
  nt = r / BH;
  mt = xcd * MPX + band * BH + (r % BH);
  return true;
}

DI bool tile256(int iter, int NT, int& mt, int& nt) {
  const int xcd = blockIdx.x & 7, j = blockIdx.x >> 3, nloc = gridDim.x >> 3;
  const int q = j + iter * nloc;
  if (q >= 6 * NT) return false;
  nt = q / 6; mt = xcd * 6 + q % 6;
  return true;
}
DI void phase_gemm_in(const Params& p, int l, char* smem) {
  const bfu* W = p.w_inT + (size_t)l * DINP * LDH;
  for (int iter = 0;; ++iter) {
    int mt, nt;
    if (!tile256(iter, 19, mt, nt)) break;
    f32x4 acc[2][2][4][2];
    acc256_zero(acc);
    gemm256(p.h, LDH, W, LDH, 1024, mt * 256, nt * 256, (bfu*)smem, acc);
    const int m0 = mt * 256, n0 = nt * 256;
    EPI256({
      const int n = n0 + c0;
      if (n < 512) *(uint4*)(p.ug + ((size_t)(n >> 4) * NTOK + (m0 + row)) * 16 + (n & 15)) = pack8(v);
      else if (n < DIN) *(uint4*)(p.proj + (size_t)(m0 + row) * PW + (n - 512)) = pack8(v);
    })
  }
}

DI void s5_gen_item(const Params& p, int l, int item, char* smem) {
  const int tid = tid_();
  const int g = item >> 3, r = item & 7;
  float* sBr = (float*)smem;
  float* sBi = sBr + 2048;
  float* sCr = sBi + 2048;
  float* sCi = sCr + 1024;
  float* sAK = sCi + 1024;
  float* sAE = sAK + 1024;
  float* sAG = sAE + 1024;
  float* sK = sAG + 1024;
  bfu* E = p.opE + (size_t)g * 256 * 512;
  bfu* MG = p.opMG + (size_t)g * 512 * 768;
  __syncthreads();
  if (tid < 128) {
    const int d = tid >> 6, pp = tid & 63;
    const size_t pi = ((size_t)(l * 2 + d) * 32 + g) * 64 + pp;
    const float lr = p.lam_re[pi], li = p.lam_im[pi];
    const float dt = expf(p.log_dt[(l * 2 + d) * 32 + g]);
    const float mag = expf(lr * dt);
    float sn, cs;
    sincosf(li * dt, &sn, &cs);
    const float are = mag * cs, aim = mag * sn;
    const float nr = are - 1.f, ni = aim, den = lr * lr + li * li;
    const float kr = (nr * lr + ni * li) / den, ki = (ni * lr - nr * li) / den;
#pragma unroll
    for (int c = 0; c < 16; ++c) {
      float br = p.b_re[((size_t)(l * 32 + g) * 64 + pp) * 16 + c];
      float bi = p.b_im[((size_t)(l * 32 + g) * 64 + pp) * 16 + c];
      sBr[(d * 64 + pp) * 16 + c] = kr * br - ki * bi;
      sBi[(d * 64 + pp) * 16 + c] = kr * bi + ki * br;
    }
#pragma unroll
    for (int q = 0; q < 4; ++q) {
      const int t = 4 * r + q;
      const int nK = t;
      const int nE = d == 0 ? 31 - t : t;
      const int nG = d == 0 ? t + 1 : 32 - t;
      float m, s_, c_;
      m = expf(lr * dt * (float)nK); sincosf(li * dt * (float)nK, &s_, &c_);
      sAK[((d * 4 + q) * 64 + pp) * 2] = m * c_; sAK[((d * 4 + q) * 64 + pp) * 2 + 1] = m * s_;
      m = expf(lr * dt * (float)nE); sincosf(li * dt * (float)nE, &s_, &c_);
      sAE[((d * 4 + q) * 64 + pp) * 2] = m * c_; sAE[((d * 4 + q) * 64 + pp) * 2 + 1] = m * s_;
      m = expf(lr * dt * (float)nG); sincosf(li * dt * (float)nG, &s_, &c_);
      sAG[((d * 4 + q) * 64 + pp) * 2] = m * c_; sAG[((d * 4 + q) * 64 + pp) * 2 + 1] = m * s_;
    }
  } else {
    for (int idx = tid - 128; idx < 1024; idx += 128) {
      sCr[idx] = p.c_re[(size_t)(l * 32 + g) * 1024 + idx];
      sCi[idx] = p.c_im[(size_t)(l * 32 + g) * 1024 + idx];
    }
  }
  __syncthreads();
  for (int idx = tid; idx < 256 * 64; idx += 256) {
    const int row = idx >> 6, cc = idx & 63, q = cc >> 4, c = cc & 15;
    const int part = row >> 6, pp = row & 63, d = part >> 1;
    const float ar = sAE[((d * 4 + q) * 64 + pp) * 2], ai = sAE[((d * 4 + q) * 64 + pp) * 2 + 1];
    const float br = sBr[(d * 64 + pp) * 16 + c], bi = sBi[(d * 64 + pp) * 16 + c];
    const float v = (part & 1) ? (ar * bi + ai * br) : (ar * br - ai * bi);
    E[(size_t)row * 512 + (4 * r + q) * 16 + c] = f2bf(v);
  }
  for (int idx = tid; idx < 64 * 256; idx += 256) {
    const int rr = idx >> 8, col = idx & 255, q = rr >> 4, c = rr & 15;
    const int part = col >> 6, pp = col & 63, d = part >> 1;
    const float ar = sAG[((d * 4 + q) * 64 + pp) * 2], ai = sAG[((d * 4 + q) * 64 + pp) * 2 + 1];
    const float cr = sCr[c * 64 + pp], ci = sCi[c * 64 + pp];
    const float v = (part & 1) ? -(cr * ai + ci * ar) : (cr * ar - ci * ai);
    MG[(size_t)((4 * r + q) * 16 + c) * 768 + 512 + col] = f2bf(v);
  }
  {
    const int d = tid >> 7, q = (tid >> 5) & 3, c = (tid >> 1) & 15, ch = tid & 1;
    float acc[8];
#pragma unroll
    for (int e = 0; e < 8; ++e) acc[e] = 0.f;
    for (int pp = 0; pp < 64; ++pp) {
      const float ar = sAK[((d * 4 + q) * 64 + pp) * 2], ai = sAK[((d * 4 + q) * 64 + pp) * 2 + 1];
      const float cr = sCr[c * 64 + pp], ci = sCi[c * 64 + pp];
      const float wr = cr * ar - ci * ai, wi = cr * ai + ci * ar;
#pragma unroll
      for (int e = 0; e < 8; ++e)
        acc[e] += wr * sBr[(d * 64 + pp) * 16 + ch * 8 + e] - wi * sBi[(d * 64 + pp) * 16 + ch * 8 + e];
    }
#pragma unroll
    for (int e = 0; e < 8; ++e) sK[((d * 4 + q) * 16 + c) * 16 + ch * 8 + e] = acc[e];
  }
  __syncthreads();
  for (int idx = tid; idx < 8192; idx += 256) {
    const int ch = idx & 1, c = (idx >> 1) & 15, tp = (idx >> 5) & 31, q = (idx >> 10) & 3, d = idx >> 12;
    const int tau = 4 * r + q;
    int sp;
    bool valid;
    if (d == 0) { sp = tp - tau; valid = sp >= 0; } else { sp = tp + tau; valid = (sp <= 31) && (tau > 0); }
    if (valid) {
      float v[8];
#pragma unroll
      for (int e = 0; e < 8; ++e) {
        float x = sK[((d * 4 + q) * 16 + c) * 16 + ch * 8 + e];
        if (tau == 0) x += sK[((1 * 4 + q) * 16 + c) * 16 + ch * 8 + e];
        v[e] = x;
      }
      *(uint4*)(MG + (size_t)(tp * 16 + c) * 768 + sp * 16 + ch * 8) = pack8(v);
    }
  }
  __syncthreads();
}

DI void phase_s5_gen(const Params& p, int l, char* smem) {
  for (int it = NVB - 1 - VBID; it < 256; it += NVB) s5_gen_item(p, l, it, smem);
}

DI void phase_s5_e(const Params& p, char* smem) {
  for (int q = VJ; q < 24; q += VNLOC) {
    const int g = VXCD * 4 + q / 6, r6 = q % 6, mt = r6 >> 1, nt = r6 & 1;
    f32x16 acc[2][2];
    acc_zero(acc);
    gemm_core(p.ug + ((size_t)g * NCHUNK + mt * 128) * 512, 512, p.opE + ((size_t)g * 256 + nt * 128) * 512, 512, 512,
              smem, acc);
    EPI_LDS({
      float* dst = p.ebuf + ((size_t)g * NCHUNK + mt * 128 + row) * 256 + nt * 128 + c0;
      *(float4*)dst = make_float4(v[0], v[1], v[2], v[3]);
      *(float4*)(dst + 4) = make_float4(v[4], v[5], v[6], v[7]);
    })
  }
}

DI void phase_s5_scan(const Params& p, int l) {
  const int tid = tid_();
  for (int it = VBID; it < 320; it += NVB) {
    const int wi = it * 2 + (tid >> 7);
    const int dir = (tid >> 6) & 1, pp = tid & 63;
    int chunk0, n, b, g;
    bool prompt;
    if (wi < 128) { b = wi >> 5; g = wi & 31; chunk0 = (NPROMPT + b * 2048) >> 5; n = 64; prompt = false; }
    else { int q = wi - 128; b = q >> 5; g = q & 31; chunk0 = (b * 256) >> 5; n = 8; prompt = true; }
    const size_t pi = ((size_t)(l * 2 + dir) * 32 + g) * 64 + pp;
    const float lr = p.lam_re[pi], li = p.lam_im[pi];
    const float dt = expf(p.log_dt[(l * 2 + dir) * 32 + g]);
    const float mag = expf(lr * dt * 32.f);
    float sn, cs;
    sincosf(li * dt * 32.f, &sn, &cs);
    const float are = mag * cs, aim = mag * sn;
    float hre = 0.f, him = 0.f;
    if (!prompt) {
      size_t si = ((size_t)((b * 2 + l) * 2 + dir)) * 2048 + g * 64 + pp;
      hre = p.st_re[si]; him = p.st_im[si];
    }
    const float* eb = p.ebuf + ((size_t)g * NCHUNK + chunk0) * 256 + dir * 128 + pp;
    bfu* cb = p.carry + ((size_t)g * NCHUNK + chunk0) * 256 + dir * 128 + pp;
    for (int k0 = 0; k0 < n; k0 += 8) {
      float er[8], ei[8];
#pragma unroll
      for (int j = 0; j < 8; ++j) {
        const int k = dir == 0 ? k0 + j : n - 1 - (k0 + j);
        er[j] = eb[(size_t)k * 256];
        ei[j] = eb[(size_t)k * 256 + 64];
      }
#pragma unroll
      for (int j = 0; j < 8; ++j) {
        const int k = dir == 0 ? k0 + j : n - 1 - (k0 + j);
        cb[(size_t)k * 256] = f2bf(hre);
        cb[(size_t)k * 256 + 64] = f2bf(him);
        const float nre = are * hre - aim * him + er[j];
        const float nim = are * him + aim * hre + ei[j];
        hre = nre; him = nim;
      }
    }
    if (prompt) {
      size_t oi = ((size_t)((b * 2 + l) * 2 + dir)) * 2048 + g * 64 + pp;
      p.out[OUT_RE + oi] = hre;
      p.out[OUT_IM + oi] = him;
    }
  }
}

DI void phase_s5_y(const Params& p, int l, char* smem) {
  for (int q = VJ; q < 48; q += VNLOC) {
    const int g = VXCD * 4 + q / 12, r12 = q % 12, mt = r12 >> 2, nt = r12 & 3;
    f32x16 acc[2][2];
    acc_zero(acc);
    const bfu* Bm = p.opMG + ((size_t)g * 512 + nt * 128) * 768;
    gemm_core(p.ug + ((size_t)g * NCHUNK + mt * 128) * 512, 512, Bm, 768, 512, smem, acc);
    gemm_core(p.carry + ((size_t)g * NCHUNK + mt * 128) * 256, 256, Bm + 512, 768, 256, smem, acc);
    EPI_LDS({
      const int chunk = mt * 128 + row, nn = nt * 128 + c0, tp = nn >> 4, c = nn & 15;
      const int tok = chunk * 32 + tp;
      float u[8], o[8];
      unpack8(*(const uint4*)(p.ug + ((size_t)g * NTOK + tok) * 16 + c), u);
      const float* dsk = p.s5_d + l * 512 + g * 16 + c;
      _Pragma("unroll") for (int e = 0; e < 8; ++e) o[e] = geluf_(v[e] + dsk[e] * u[e]);
      *(uint4*)(p.ys5 + (size_t)tok * 512 + g * 16 + c) = pack8(o);
    })
  }
}

DI void phase_glu(const Params& p, int l, char* smem) {
  const bfu* W = p.w_gluT + (size_t)l * 512 * 512;
  for (int iter = 0;; ++iter) {
    int mt, nt;
    if (!xcd_tile<96, 4, 12>(iter, mt, nt)) break;
    f32x16 acc[2][2];
    acc_zero(acc);
    gemm_core(p.ys5 + (size_t)mt * 128 * 512, 512, W + (size_t)nt * 128 * 512, 512, 512, smem, acc);
    const int m0 = mt * 128, n0 = nt * 128;
    EPI_LDS({
      const int n = n0 + c0;
      const size_t tk = (size_t)(m0 + row);
      float y[8], ga[8], o[8];
      unpack8(*(const uint4*)(p.ys5 + tk * 512 + n), y);
      unpack8(*(const uint4*)(p.proj + tk * PW + OFF_GA + n), ga);
      const float* bg = p.b_glu + l * 512 + n;
      _Pragma("unroll") for (int e = 0; e < 8; ++e) o[e] = y[e] * sigmoidf_(v[e] + bg[e]) * siluf_(ga[e]);
      *(uint4*)(p.ya + tk * 512 + n) = pack8(o);
    })
  }
}

constexpr int GL_QS = 0;
constexpr int GL_KS = GL_QS + 32 * 144;
constexpr int GL_KHT = GL_KS + 32 * 144;
constexpr int GL_VT = GL_KHT + 64 * 80;
constexpr int GL_PS = GL_VT + 128 * 80;
constexpr int GL_ST = GL_PS + 32 * 80;
constexpr int GL_AV = GL_ST + 128 * 144;
constexpr int GL_TOT = GL_AV + 256;
constexpr int GL_OS = GL_TOT + 1024;
static_assert(GL_OS + 32 * 132 * 4 <= 65536, "gla lds");

DI void gla_segment_info(int seg, int& tok_base, bool& prompt, int& b, int& sidx) {
  if (seg < 16) { prompt = true; b = seg; sidx = 0; tok_base = seg * 256; }
  else { int q = seg - 16; prompt = false; b = q >> 3; sidx = q & 7; tok_base = NPROMPT + b * 2048 + sidx * 256; }
}

template <bool STATE_ONLY>
DI void gla_chain(const Params& p, int l, char* smem, int seg, int hd, int dir) {
  const int tid = tid_(), lane = tid & 63, w = tid >> 6;
  const int fr = lane & 31, hh = lane >> 5;
  int tok_base, b, sidx;
  bool prompt;
  gla_segment_info(seg, tok_base, prompt, b, sidx);
  const int dk = tid & 63, tq = tid >> 6;
  const int dvl = tid & 127, th = tid >> 7;
  const int jw = w & 1, thw = w >> 1, dkm = 32 * jw + fr;
  bf16x8 wgB;
  {
    unsigned wp[4];
#pragma unroll
    for (int e = 0; e < 4; ++e) {
      const float w0 = p.wg_up[((size_t)(l * 2 + dir) * 16 + 8 * hh + 2 * e) * 256 + hd * 64 + dkm];
      const float w1 = p.wg_up[((size_t)(l * 2 + dir) * 16 + 8 * hh + 2 * e + 1) * 256 + hd * 64 + dkm];
      wp[e] = pack2(w0, w1);
    }
    wgB = __builtin_bit_cast(bf16x8, make_uint4(wp[0], wp[1], wp[2], wp[3]));
  }
  const float bgv = p.bg[(l * 2 + dir) * 256 + hd * 64 + dkm];
  float* sAv = (float*)(smem + GL_AV);
  float* sTot = (float*)(smem + GL_TOT);
  float* sOs = (float*)(smem + GL_OS);

  f32x16 S[2];
  {
    const int dvc = 32 * w + fr;
    if (STATE_ONLY || prompt) {
#pragma unroll
      for (int mt = 0; mt < 2; ++mt)
#pragma unroll
        for (int r = 0; r < 16; ++r) S[mt][r] = 0.f;
    } else {
      const float* sp = p.st_gla + ((size_t)(((b * 2 + l) * 2 + dir) * 4 + hd)) * 8192;
#pragma unroll
      for (int mt = 0; mt < 2; ++mt)
#pragma unroll
        for (int r = 0; r < 16; ++r) S[mt][r] = sp[(32 * mt + (r & 3) + 8 * (r >> 2) + 4 * hh) * 128 + dvc];
      const int nprev = dir == 0 ? sidx : 7 - sidx;
      if (nprev > 0) {
        f32x16 cs[2], ns[2];
        float4 ca[8], na[8];
#define GLA_SEG_LOAD(SS, AA, qq)                                                                       \
        {                                                                                              \
          const int sprev_ = dir == 0 ? (qq) : 7 - (qq);                                               \
          const size_t ci_ = (size_t)(((b * 8 + sprev_) * 4 + hd) * 2 + dir);                          \
          const float* sl_ = p.gla_sloc + ci_ * 8192 + dvc;                                            \
          const float* al_ = p.gla_aseg + ci_ * 64 + 4 * hh;                                           \
          _Pragma("unroll") for (int mt = 0; mt < 2; ++mt)                                             \
          _Pragma("unroll") for (int r = 0; r < 16; ++r)                                               \
            SS[mt][r] = sl_[(32 * mt + (r & 3) + 8 * (r >> 2) + 4 * hh) * 128];                        \
          _Pragma("unroll") for (int i = 0; i < 8; ++i) AA[i] = *(const float4*)(al_ + 8 * i);         \
        }
        GLA_SEG_LOAD(cs, ca, 0)
#pragma unroll 1
        for (int q = 0; q < nprev; ++q) {
          if (q + 1 < nprev) GLA_SEG_LOAD(ns, na, q + 1)
#pragma unroll
          for (int mt = 0; mt < 2; ++mt)
#pragma unroll
            for (int qq = 0; qq < 4; ++qq) {
              const float4 av = ca[mt * 4 + qq];
              S[mt][4 * qq + 0] = av.x * S[mt][4 * qq + 0] + cs[mt][4 * qq + 0];
              S[mt][4 * qq + 1] = av.y * S[mt][4 * qq + 1] + cs[mt][4 * qq + 1];
              S[mt][4 * qq + 2] = av.z * S[mt][4 * qq + 2] + cs[mt][4 * qq + 2];
              S[mt][4 * qq + 3] = av.w * S[mt][4 * qq + 3] + cs[mt][4 * qq + 3];
            }
          cs[0] = ns[0]; cs[1] = ns[1];
#pragma unroll
          for (int i = 0; i < 8; ++i) ca[i] = na[i];
        }
      }
    }
  }
  float bsum = 0.f;
  __syncthreads();
  if (!STATE_ONLY) {
    const int dvc = 32 * w + fr;
#pragma unroll
    for (int mt = 0; mt < 2; ++mt)
#pragma unroll
      for (int q = 0; q < 4; ++q) {
        uint2 pk;
        pk.x = pack2(S[mt][4 * q], S[mt][4 * q + 1]);
        pk.y = pack2(S[mt][4 * q + 2], S[mt][4 * q + 3]);
        *(uint2*)(smem + GL_ST + dvc * 144 + (32 * mt + 8 * q + 4 * hh) * 2) = pk;
      }
  }

  uint4 rq = make_uint4(0, 0, 0, 0), rk = rq, rv0 = rq, rv1 = rq, rgl = rq;
#define GLA_ISSUE(nn)                                                                                         \
  {                                                                                                           \
    const int cn_ = dir == 0 ? (nn) : 7 - (nn);                                                               \
    const int c0_ = tok_base + cn_ * 32;                                                                      \
    const int tA = dir == 0 ? (tid >> 3) : 31 - (tid >> 3);                                                   \
    const bfu* prA = p.proj + (size_t)(c0_ + tA) * PW + hd * 64 + (tid & 7) * 8;                              \
    if (!STATE_ONLY) rq = *(const uint4*)(prA + OFF_Q);                                                       \
    rk = *(const uint4*)(prA + OFF_K);                                                                        \
    const int tV0 = dir == 0 ? (tid >> 4) : 31 - (tid >> 4);                                                  \
    const int tV1 = dir == 0 ? (tid >> 4) + 16 : 15 - (tid >> 4);                                             \
    rv0 = *(const uint4*)(p.proj + (size_t)(c0_ + tV0) * PW + OFF_V + hd * 128 + (tid & 15) * 8);             \
    rv1 = *(const uint4*)(p.proj + (size_t)(c0_ + tV1) * PW + OFF_V + hd * 128 + (tid & 15) * 8);             \
    if (tid < 64) {                                                                                           \
      const int tG = dir == 0 ? (tid >> 1) : 31 - (tid >> 1);                                                 \
      rgl = *(const uint4*)(p.proj + (size_t)(c0_ + tG) * PW + OFF_GL + (tid & 1) * 8);                       \
    }                                                                                                         \
  }
  GLA_ISSUE(0)
  char* rawQ = smem + GL_OS;
  char* rawK = smem + GL_OS + 4096;
  char* rawV = smem + GL_OS + 8192;
  char* rawG = smem + GL_PS;

#pragma unroll 1
  for (int n = 0; n < 8; ++n) {
    const int cn = dir == 0 ? n : 7 - n;
    const int ctok0 = tok_base + cn * 32;
    __syncthreads();
    if (!STATE_ONLY) *(uint4*)(rawQ + (tid >> 3) * 128 + (tid & 7) * 16) = rq;
    *(uint4*)(rawK + (tid >> 3) * 128 + (tid & 7) * 16) = rk;
    *(uint4*)(rawV + (tid >> 4) * 256 + (tid & 15) * 16) = rv0;
    *(uint4*)(rawV + ((tid >> 4) + 16) * 256 + (tid & 15) * 16) = rv1;
    if (tid < 64) *(uint4*)(rawG + (tid >> 1) * 32 + (tid & 1) * 16) = rgl;
    if (n + 1 < 8) GLA_ISSUE(n + 1)
    __syncthreads();
    {
      f32x16 lg;
#pragma unroll
      for (int r = 0; r < 16; ++r) lg[r] = 0.f;
      const bf16x8 ga = *(const bf16x8*)(rawG + fr * 32 + hh * 16);
      lg = __builtin_amdgcn_mfma_f32_32x32x16_bf16(ga, wgB, lg, 0, 0, 0);
      float ls[16], gsum[4], psum[4];
#pragma unroll
      for (int r = 0; r < 16; ++r) {
        const float x = lg[r] + bgv;
        ls[r] = logsigmoidf_(x) * (1.f / 16.f);
      }
#pragma unroll
      for (int q = 0; q < 4; ++q) {
        gsum[q] = ls[4 * q] + ls[4 * q + 1] + ls[4 * q + 2] + ls[4 * q + 3];
        psum[q] = __shfl_xor(gsum[q], 32);
      }
      float off[4], run = 0.f;
#pragma unroll
      for (int q = 0; q < 4; ++q) {
        off[q] = run + (hh ? psum[q] : 0.f);
        run += gsum[q] + psum[q];
      }
      const float total = run;
#pragma unroll
      for (int qq = 0; qq < 2; ++qq) {
        float khv[4];
        float acc_b = 0.f;
#pragma unroll
        for (int i = 0; i < 4; ++i) {
          const float lsv = thw == 0 ? ls[4 * qq + i] : ls[8 + 4 * qq + i];
          const float offv = thw == 0 ? off[qq] : off[2 + qq];
          acc_b += lsv;
          const float bb = offv + acc_b;
          const int tau = 16 * thw + 8 * qq + 4 * hh + i;
          const float kvv = bf2f(*(const bfu*)(rawK + tau * 128 + dkm * 2));
          if (!STATE_ONLY) {
            const float qvv = bf2f(*(const bfu*)(rawQ + tau * 128 + dkm * 2)) * 0.125f;
            *(bfu*)(smem + GL_QS + tau * 144 + dkm * 2) = f2bf(qvv * __expf(bb));
            *(bfu*)(smem + GL_KS + tau * 144 + dkm * 2) = f2bf(kvv * __expf(-bb));
          }
          khv[i] = kvv * __expf(total - bb);
        }
        uint2 kh; kh.x = pack2(khv[0], khv[1]); kh.y = pack2(khv[2], khv[3]);
        *(uint2*)(smem + GL_KHT + dkm * 80 + (16 * thw + 8 * qq + 4 * hh) * 2) = kh;
      }
      if (thw == 0 && hh == 0) { sAv[dkm] = __expf(total); bsum += total; }
    }
    {
      unsigned pk[8];
#pragma unroll
      for (int i = 0; i < 8; ++i) {
        const int tau0 = th * 16 + 2 * i;
        const unsigned lo = *(const bfu*)(rawV + tau0 * 256 + dvl * 2);
        const unsigned hi = *(const bfu*)(rawV + (tau0 + 1) * 256 + dvl * 2);
        pk[i] = lo | (hi << 16);
      }
      *(uint4*)(smem + GL_VT + dvl * 80 + th * 32) = make_uint4(pk[0], pk[1], pk[2], pk[3]);
      *(uint4*)(smem + GL_VT + dvl * 80 + th * 32 + 16) = make_uint4(pk[4], pk[5], pk[6], pk[7]);
    }
    __syncthreads();
    f32x16 o;
    if (!STATE_ONLY) {
      f32x16 sc;
#pragma unroll
      for (int r = 0; r < 16; ++r) sc[r] = 0.f;
#pragma unroll
      for (int s4 = 0; s4 < 4; ++s4) {
        bf16x8 a = *(const bf16x8*)(smem + GL_QS + fr * 144 + (16 * s4 + 8 * hh) * 2);
        bf16x8 bq = *(const bf16x8*)(smem + GL_KS + fr * 144 + (16 * s4 + 8 * hh) * 2);
        sc = __builtin_amdgcn_mfma_f32_32x32x16_bf16(a, bq, sc, 0, 0, 0);
      }
#pragma unroll
      for (int rr = 0; rr < 4; ++rr) {
        float val = w == 0 ? sc[rr] : (w == 1 ? sc[4 + rr] : (w == 2 ? sc[8 + rr] : sc[12 + rr]));
        const int i = rr + 8 * w + 4 * hh;
        val = (fr <= i) ? val : 0.f;
        *(bfu*)(smem + GL_PS + i * 80 + fr * 2) = f2bf(val);
      }
      __syncthreads();
#pragma unroll
      for (int r = 0; r < 16; ++r) o[r] = 0.f;
    }
    {
      const int dvc = 32 * w + fr;
      bf16x8 vb0 = *(const bf16x8*)(smem + GL_VT + dvc * 80 + (8 * hh) * 2);
      bf16x8 vb1 = *(const bf16x8*)(smem + GL_VT + dvc * 80 + (16 + 8 * hh) * 2);
      if (!STATE_ONLY) {
        bf16x8 pa0 = *(const bf16x8*)(smem + GL_PS + fr * 80 + (8 * hh) * 2);
        bf16x8 pa1 = *(const bf16x8*)(smem + GL_PS + fr * 80 + (16 + 8 * hh) * 2);
        o = __builtin_amdgcn_mfma_f32_32x32x16_bf16(pa0, vb0, o, 0, 0, 0);
        o = __builtin_amdgcn_mfma_f32_32x32x16_bf16(pa1, vb1, o, 0, 0, 0);
#pragma unroll
        for (int s4 = 0; s4 < 4; ++s4) {
          bf16x8 a = *(const bf16x8*)(smem + GL_QS + fr * 144 + (16 * s4 + 8 * hh) * 2);
          bf16x8 sb = *(const bf16x8*)(smem + GL_ST + dvc * 144 + (16 * s4 + 8 * hh) * 2);
          o = __builtin_amdgcn_mfma_f32_32x32x16_bf16(a, sb, o, 0, 0, 0);
        }
      }
#pragma unroll
      for (int mt = 0; mt < 2; ++mt) {
        f32x16 U;
#pragma unroll
        for (int r = 0; r < 16; ++r) U[r] = 0.f;
        bf16x8 ka0 = *(const bf16x8*)(smem + GL_KHT + (32 * mt + fr) * 80 + (8 * hh) * 2);
        bf16x8 ka1 = *(const bf16x8*)(smem + GL_KHT + (32 * mt + fr) * 80 + (16 + 8 * hh) * 2);
        U = __builtin_amdgcn_mfma_f32_32x32x16_bf16(ka0, vb0, U, 0, 0, 0);
        U = __builtin_amdgcn_mfma_f32_32x32x16_bf16(ka1, vb1, U, 0, 0, 0);
#pragma unroll
        for (int q = 0; q < 4; ++q) {
          const float4 av = *(const float4*)(sAv + 32 * mt + 8 * q + 4 * hh);
          S[mt][4 * q + 0] = av.x * S[mt][4 * q + 0] + U[4 * q + 0];
          S[mt][4 * q + 1] = av.y * S[mt][4 * q + 1] + U[4 * q + 1];
          S[mt][4 * q + 2] = av.z * S[mt][4 * q + 2] + U[4 * q + 2];
          S[mt][4 * q + 3] = av.w * S[mt][4 * q + 3] + U[4 * q + 3];
          if (!STATE_ONLY) {
            uint2 pk;
            pk.x = pack2(S[mt][4 * q], S[mt][4 * q + 1]);
            pk.y = pack2(S[mt][4 * q + 2], S[mt][4 * q + 3]);
            *(uint2*)(smem + GL_ST + dvc * 144 + (32 * mt + 8 * q + 4 * hh) * 2) = pk;
          }
        }
      }
      if (!STATE_ONLY) {
#pragma unroll
        for (int r = 0; r < 16; ++r) sOs[((r & 3) + 8 * (r >> 2) + 4 * hh) * 132 + dvc] = o[r];
      }
    }
    __syncthreads();
    if (!STATE_ONLY) {
      const int t = tid >> 3, part = tid & 7;
      const int tau = dir == 0 ? t : 31 - t;
      const size_t tok = (size_t)(ctok0 + t);
      float ov[16];
#pragma unroll
      for (int q = 0; q < 4; ++q) {
        const float4 x = *(const float4*)(sOs + tau * 132 + part * 16 + 4 * q);
        ov[4 * q] = x.x; ov[4 * q + 1] = x.y; ov[4 * q + 2] = x.z; ov[4 * q + 3] = x.w;
      }
      bfu* op = p.gla_o + ((size_t)dir * NTOK + tok) * 512 + hd * 128 + part * 16;
      *(uint4*)op = pack8(*(float(*)[8])&ov[0]);
      *(uint4*)(op + 8) = pack8(*(float(*)[8])&ov[8]);
    }
  }
  const int dvc = 32 * w + fr;
  if (STATE_ONLY) {
    const size_t ci = (size_t)(((b * 8 + sidx) * 4 + hd) * 2 + dir);
    float* sl = p.gla_sloc + ci * 8192;
#pragma unroll
    for (int mt = 0; mt < 2; ++mt)
#pragma unroll
      for (int r = 0; r < 16; ++r) sl[(32 * mt + (r & 3) + 8 * (r >> 2) + 4 * hh) * 128 + dvc] = S[mt][r];
    if (thw == 0 && hh == 0) p.gla_aseg[ci * 64 + dkm] = __expf(bsum);
  } else if (prompt) {
    float* op = p.out + OUT_GLA + ((size_t)(((b * 2 + l) * 2 + dir) * 4 + hd)) * 8192;
#pragma unroll
    for (int mt = 0; mt < 2; ++mt)
#pragma unroll
      for (int r = 0; r < 16; ++r) op[(32 * mt + (r & 3) + 8 * (r >> 2) + 4 * hh) * 128 + dvc] = S[mt][r];
  }
  __syncthreads();
}

DI void phase_gla_pass1(const Params& p, int l, char* smem) {
  for (int it = NVB - 1 - VBID; it < 256; it += NVB) {
    const int dir = it & 1, hd = (it >> 1) & 3, seg = 16 + (it >> 3);
    gla_chain<true>(p, l, smem, seg, hd, dir);
  }
}
DI void phase_gla_main(const Params& p, int l, char* smem) {
  for (int it = NVB - 1 - VBID; it < 384; it += NVB) {
    const int dir = it & 1, hd = (it >> 1) & 3, seg = it >> 3;
    gla_chain<false>(p, l, smem, seg, hd, dir);
  }
}
DI void phase_gla_norm(const Params& p, int l) {
  const int tid = tid_(), lane = tid & 63, w = tid >> 6;
  for (int it = VBID; it < NTOK / 4; it += NVB) {
    const int tok = it * 4 + w;
    float a[8], b[8], gt[8], res[8];
    unpack8(*(const uint4*)(p.gla_o + (size_t)tok * 512 + lane * 8), a);
    unpack8(*(const uint4*)(p.gla_o + ((size_t)NTOK + tok) * 512 + lane * 8), b);
    unpack8(*(const uint4*)(p.proj + (size_t)tok * PW + OFF_GB + lane * 8), gt);
    float ss = 0.f;
#pragma unroll
    for (int e = 0; e < 8; ++e) { a[e] += b[e]; ss += a[e] * a[e]; }
    ss += __shfl_xor(ss, 1); ss += __shfl_xor(ss, 2); ss += __shfl_xor(ss, 4); ss += __shfl_xor(ss, 8);
    const float rs = rsqrtf(ss * (1.f / 128.f) + EPS);
    const float* g = p.gla_norm_g + l * 512 + lane * 8;
#pragma unroll
    for (int e = 0; e < 8; ++e) res[e] = a[e] * rs * g[e] * siluf_(gt[e]);
    *(uint4*)(p.yb + (size_t)tok * 512 + lane * 8) = pack8(res);
  }
}

DI void phase_merge(const Params& p, int l, char* smem) {
  const bfu* WA = p.w_paT + (size_t)l * 1024 * 512;
  const bfu* WB = p.w_pbT + (size_t)l * 1024 * 512;
  for (int iter = 0;; ++iter) {
    int mt, nt;
    if (!tile256(iter, 4, mt, nt)) break;
    const int m0 = mt * 256, n0 = nt * 256;
    f32x4 acc[2][2][4][2];
    acc256_zero(acc);
    gemm256(p.ya, 512, WA, 512, 512, m0, n0, (bfu*)smem, acc);
    uint4 pg[8], pq[8];
#define MERGE_PRE1 pg[it_] = *(const uint4*)(p.proj + (size_t)(m0 + row) * PW + OFF_MA + n0 + c0);
#define MERGE_PRE2 pg[it_] = *(const uint4*)(p.proj + (size_t)(m0 + row) * PW + OFF_MB + n0 + c0); \
                   pq[it_] = *(const uint4*)(p.merged + (size_t)(m0 + row) * D + n0 + c0);
    EPI256P(MERGE_PRE1, {
      float ma[8], o[8];
      unpack8(pg[it_], ma);
      _Pragma("unroll") for (int e = 0; e < 8; ++e) o[e] = sigmoidf_(ma[e]) * v[e];
      *(uint4*)(p.merged + (size_t)(m0 + row) * D + n0 + c0) = pack8(o);
    })
    acc256_zero(acc);
    gemm256(p.yb, 512, WB, 512, 512, m0, n0, (bfu*)smem, acc);
    EPI256P(MERGE_PRE2, {
      float mb[8], o[8], pr[8];
      unpack8(pg[it_], mb);
      uint4* mp = (uint4*)(p.merged + (size_t)(m0 + row) * D + n0 + c0);
      unpack8(pq[it_], pr);
      _Pragma("unroll") for (int e = 0; e < 8; ++e) o[e] = pr[e] + sigmoidf_(mb[e]) * v[e];
      *mp = pack8(o);
    })
  }
}

DI void phase_out(const Params& p, int l, char* smem) {
  const bfu* W = p.w_oT + (size_t)l * 1024 * 1024;
  for (int iter = 0;; ++iter) {
    int mt, nt;
    if (!tile256(iter, 4, mt, nt)) break;
    const int m0 = mt * 256, n0 = nt * 256;
    f32x4 acc[2][2][4][2];
    acc256_zero(acc);
    gemm256(p.merged, D, W, 1024, 1024, m0, n0, (bfu*)smem, acc);
    const float* gate = p.mod + (size_t)(l * 5 + cond_of_tok(m0)) * 3072 + 2048;
    float4 px0[8], px1[8];
#define OUT_PRE px0[it_] = *(const float4*)(p.out + (size_t)(m0 + row) * D + n0 + c0); \
                px1[it_] = *(const float4*)(p.out + (size_t)(m0 + row) * D + n0 + c0 + 4);
    EPI256P(OUT_PRE, {
      float* xp = p.out + (size_t)(m0 + row) * D + n0 + c0;
      const float* gp = gate + n0 + c0;
      float4 x0 = px0[it_], x1 = px1[it_];
      float4 g0 = *(const float4*)gp, g1 = *(const float4*)(gp + 4);
      {
        const float4 h0 = *(const float4*)(gp + MODH), h1 = *(const float4*)(gp + MODH + 4);
        g0.x += h0.x; g0.y += h0.y; g0.z += h0.z; g0.w += h0.w;
        g1.x += h1.x; g1.y += h1.y; g1.z += h1.z; g1.w += h1.w;
      }
      x0.x += g0.x * v[0]; x0.y += g0.y * v[1]; x0.z += g0.z * v[2]; x0.w += g0.w * v[3];
      x1.x += g1.x * v[4]; x1.y += g1.y * v[5]; x1.z += g1.z * v[6]; x1.w += g1.w * v[7];
      *(float4*)xp = x0; *(float4*)(xp + 4) = x1;
    })
  }
}

DI void phase_final(const Params& p) {
  const int tid = tid_(), lane = tid & 63, w = tid >> 6;
  for (int it = VBID; it < NTOK / 4; it += NVB) {
    const int tok = it * 4 + w;
    float* xs = p.out + (size_t)tok * D;
    float4 v[4];
#pragma unroll
    for (int i = 0; i < 4; ++i) v[i] = *(const float4*)(xs + lane * 4 + 256 * i);
    float ss = 0.f;
#pragma unroll
    for (int i = 0; i < 4; ++i) ss += v[i].x * v[i].x + v[i].y * v[i].y + v[i].z * v[i].z + v[i].w * v[i].w;
    ss = wave_sum(ss);
    const float rstd = rsqrtf(ss * (1.f / 1024.f) + EPS);
#pragma unroll
    for (int i = 0; i < 4; ++i) {
      float4 g = *(const float4*)(p.final_g + lane * 4 + 256 * i);
      float4 o;
      o.x = v[i].x * rstd * g.x; o.y = v[i].y * rstd * g.y; o.z = v[i].z * rstd * g.z; o.w = v[i].w * rstd * g.w;
      *(float4*)(xs + lane * 4 + 256 * i) = o;
    }
  }
}

#define XB_TMO      128
#define XB_XCNT(j)  (256  + 64 * (j))
#define XB_XSUB(j)  (1280 + 64 * (j))
#define XB_XGEN(j)  (2304 + 64 * (j))
#define XB_TOP      3328
#define XB_TOPGEN   3392
#define XCD_BAR_WORDS 3456
#define XB_SPIN_CAP (1u << 18)
#define LAS __attribute__((address_space(3)))
DI unsigned xb_ld(unsigned* p) { return __hip_atomic_load(p, __ATOMIC_RELAXED, __HIP_MEMORY_SCOPE_AGENT); }
DI unsigned xb_add(unsigned* p, unsigned v) { return __hip_atomic_fetch_add(p, v, __ATOMIC_RELAXED, __HIP_MEMORY_SCOPE_AGENT); }
DI unsigned xb_xcc_id() { return (unsigned)__builtin_amdgcn_s_getreg((3 << 11) | 20) & 0xFu; }
#define XB_SPIN(cond, bar) do { unsigned _sp = 0; while (cond) { __builtin_amdgcn_s_sleep(1); \
    if ((++_sp & 255u) == 0u) { if (xb_ld(&(bar)[XB_TMO])) break; if (_sp > XB_SPIN_CAP) { atomicAdd(&(bar)[XB_TMO], 1u); break; } } } } while (0)
struct XcdBarrier { unsigned* bar; unsigned x; volatile LAS unsigned* st; };
DI XcdBarrier xcd_barrier_post(unsigned* bar, volatile LAS unsigned* st) {
  XcdBarrier b; b.bar = bar; b.x = xb_xcc_id(); b.st = st;
  if (threadIdx.x == 0) (void)xb_add(&bar[XB_XCNT(b.x)], 1u);
  return b;
}
DI void xcd_barrier_complete(unsigned* bar, unsigned x, unsigned& nloc, unsigned& nx) {
  const unsigned G = gridDim.x * gridDim.y * gridDim.z;
  unsigned sum, cnt, mine, sp = 0u;
  for (;;) {
    sum = 0u; cnt = 0u; mine = 0u;
#pragma unroll
    for (unsigned j = 0; j < 16; ++j) { const unsigned c = xb_ld(&bar[XB_XCNT(j)]); sum += c; cnt += (c > 0u) ? 1u : 0u; mine = (j == x) ? c : mine; }
    if (sum == G) break;
    __builtin_amdgcn_s_sleep(1);
    if ((++sp & 255u) == 0u) { if (xb_ld(&bar[XB_TMO])) break; if (sp > XB_SPIN_CAP) { atomicAdd(&bar[XB_TMO], 1u); break; } }
  }
  nloc = mine > 0u ? mine : 1u; nx = cnt > 0u ? cnt : 1u;
}
DI void xcd_barrier(const XcdBarrier& b) {
  asm volatile("s_waitcnt vmcnt(0)" ::: "memory");
  __syncthreads();
  if (threadIdx.x == 0) {
    unsigned* bar = b.bar;
    __builtin_amdgcn_s_waitcnt(0);
    unsigned nloc = b.st[0], nx = b.st[1];
    if (nloc == 0u) { xcd_barrier_complete(bar, b.x, nloc, nx); b.st[0] = nloc; b.st[1] = nx; }
    const unsigned old = xb_add(&bar[XB_XSUB(b.x)], 1u);
    const unsigned gen = old / nloc;
    if (old + 1u == (gen + 1u) * nloc) {
      __builtin_amdgcn_fence(__ATOMIC_RELEASE, "agent");
      asm volatile("s_waitcnt vmcnt(0)" ::: "memory");
      const unsigned og = xb_add(&bar[XB_TOP], 1u);
      const unsigned tg = og / nx;
      if (og + 1u == (tg + 1u) * nx) xb_add(&bar[XB_TOPGEN], 1u);
      else XB_SPIN(xb_ld(&bar[XB_TOPGEN]) == tg, bar);
      __builtin_amdgcn_fence(__ATOMIC_ACQUIRE, "agent");
      xb_add(&bar[XB_XGEN(b.x)], 1u);
      asm volatile("s_waitcnt vmcnt(0)" ::: "memory");
    } else {
      XB_SPIN(xb_ld(&bar[XB_XGEN(b.x)]) == gen, bar);
      __builtin_amdgcn_fence(__ATOMIC_ACQUIRE, "agent");
      asm volatile("s_waitcnt vmcnt(0)" ::: "memory");
    }
  }
  __syncthreads();
}

#ifndef REP_SYNC
#define REP_SYNC 0
#endif
__global__ void __launch_bounds__(512, 2) k_mega(Params p) {
  extern __shared__ __attribute__((aligned(16))) char smem_all[];
  cg::grid_group grid = cg::this_grid();
  char* smem = smem_all;
#define smh (smem_all + VHALF * 65536)
  volatile LAS unsigned* xst = (volatile LAS unsigned*)(smem_all + 131072);
  if (threadIdx.x < 4) xst[threadIdx.x] = 0u;
  __syncthreads();
  XcdBarrier xb = xcd_barrier_post(p.bar, xst);
#define GSYNC() xcd_barrier(xb)
  phase_prep(p, smh);
  phase_s5_gen(p, 0, smh);
  GSYNC();
  if (p.bar == nullptr) grid.sync();
  for (int l = 0; l < 2; ++l) {
    phase_h(p, l);
    GSYNC();
    phase_gemm_in(p, l, smem);
    GSYNC();
    phase_s5_e(p, smh);
    phase_gla_pass1(p, l, smh);
    GSYNC();
    phase_s5_scan(p, l);
    phase_gla_main(p, l, smh);
    GSYNC();
    phase_s5_y(p, l, smh);
    phase_gla_norm(p, l);
    GSYNC();
    phase_glu(p, l, smh);
    GSYNC();
    phase_merge(p, l, smem);
    if (l == 0 && (blockIdx.x >> 3) >= 24) {
      const int hb = (int)((((blockIdx.x >> 3) - 24) * 8 + (blockIdx.x & 7)) * 2) + VHALF;
      s5_gen_item(p, 1, hb, smh);
    }
    GSYNC();
    phase_out(p, l, smem);
    if (l == 0 && (blockIdx.x >> 3) >= 24) {
      const int hb = (int)((((blockIdx.x >> 3) - 24) * 8 + (blockIdx.x & 7)) * 2) + VHALF;
      s5_gen_item(p, 1, hb + 128, smh);
    }
    GSYNC();
    for (int rep = 0; rep < REP_SYNC; ++rep) GSYNC();
  }
  phase_final(p);
}

extern "C" void kernel_launch(void* const* d_in, const int* in_sizes, int n_in, void* d_out, int out_size,
                              void* d_ws, size_t ws_size, hipStream_t stream) {
  Params p{};
  const float* const* in = (const float* const*)d_in;
  p.x_prompt = in[0]; p.x_sample = in[1]; p.c = in[2]; p.st_re = in[3]; p.st_im = in[4]; p.st_gla = in[5];
  p.c_ctx = in[6]; p.norm_g = in[7]; p.w_mod = in[8]; p.b_mod = in[9]; p.w_in = in[10]; p.wg_up = in[11];
  p.bg = in[12]; p.gla_norm_g = in[13]; p.lam_re = in[14]; p.lam_im = in[15]; p.log_dt = in[16];
  p.b_re = in[17]; p.b_im = in[18]; p.c_re = in[19]; p.c_im = in[20]; p.s5_d = in[21]; p.w_glu = in[22];
  p.b_glu = in[23]; p.w_pa = in[24]; p.w_pb = in[25]; p.w_o = in[26]; p.final_g = in[27];
  p.out = (float*)d_out;
  char* ws = (char*)d_ws;
  size_t off = 0;
  auto take = [&](size_t bytes) { char* r = ws + off; off += (bytes + 255) & ~(size_t)255; return r; };
  p.w_inT = (bfu*)take((size_t)2 * DINP * LDH * 2);
  p.w_gluT = (bfu*)take((size_t)2 * 512 * 512 * 2);
  p.w_paT = (bfu*)take((size_t)2 * 1024 * 512 * 2);
  p.w_pbT = (bfu*)take((size_t)2 * 1024 * 512 * 2);
  p.w_oT = (bfu*)take((size_t)2 * 1024 * 1024 * 2);
  p.pos_r = (float*)take((size_t)32 * 512 * 4);
  p.pos_c = (float*)take((size_t)64 * 512 * 4);
  p.h = (bfu*)take((size_t)NTOK * LDH * 2);
  p.proj = (bfu*)take((size_t)NTOK * PW * 2);
  p.ys5 = (bfu*)take((size_t)NTOK * 512 * 2);
  p.ya = (bfu*)take((size_t)NTOK * 512 * 2);
  p.yb = (bfu*)take((size_t)NTOK * 512 * 2);
  p.merged = (bfu*)take((size_t)NTOK * D * 2);
  p.tmp_s5 = nullptr;
  p.ebuf = (float*)p.merged;
  p.carry = (bfu*)((char*)p.merged + (size_t)32 * NCHUNK * 256 * 4);
  p.ug = (bfu*)take((size_t)32 * NTOK * 16 * 2);
  p.opMG = (bfu*)take((size_t)32 * 512 * 768 * 2);
  p.opE = (bfu*)take((size_t)32 * 256 * 512 * 2);
  p.gla_sloc = (float*)p.ys5;
  p.gla_aseg = (float*)((char*)p.ys5 + (size_t)256 * 8192 * 4);
  if (off > ws_size) fprintf(stderr, "workspace too small: %zu > %zu\n", off, ws_size);
  p.bar = (unsigned*)take((size_t)XCD_BAR_WORDS * 4);
  p.mod = (float*)take((size_t)2 * 2 * 5 * 3072 * 4);
  p.gla_o = (bfu*)p.h;
  p.tmp_gla = (float*)p.h;
  constexpr size_t kLds = 131072 + 16;
  static int grid_blocks = 0;
  if (!grid_blocks) {
    int dev = 0, cus = 0, per_cu = 0;
    hipGetDevice(&dev);
    hipDeviceGetAttribute(&cus, hipDeviceAttributeMultiprocessorCount, dev);
    hipFuncSetAttribute((const void*)k_mega, hipFuncAttributeMaxDynamicSharedMemorySize, (int)kLds);
    hipOccupancyMaxActiveBlocksPerMultiprocessor(&per_cu, k_mega, 512, kLds);
    if (per_cu > 1) per_cu = 1;
    grid_blocks = cus * per_cu;
    if (grid_blocks % 8 != 0 || grid_blocks <= 0) fprintf(stderr, "unexpected grid %d\n", grid_blocks);
  }
  hipMemsetAsync(p.bar, 0, (size_t)XCD_BAR_WORDS * 4, stream);
  void* args[] = {&p};
  hipError_t e = hipLaunchCooperativeKernel((void*)k_mega, dim3(grid_blocks), dim3(512), args, kLds, stream);
  if (e != hipSuccess) fprintf(stderr, "cooperative launch failed: %s (grid %d)\n", hipGetErrorString(e), grid_blocks);
}
```

```cpp
#include <hip/hip_runtime.h>
#include <hip/hip_cooperative_groups.h>
#include <stdint.h>
#include <math.h>
#include <stdio.h>
namespace cg = cooperative_groups;

#ifndef REP_PREP
#define REP_PREP 0
#endif
#ifndef REP_GIN
#define REP_GIN 0
#endif
#ifndef REP_X1
#define REP_X1 0
#endif
#ifndef REP_X2
#define REP_X2 0
#endif
#ifndef REP_Y
#define REP_Y 0
#endif
#ifndef REP_MERGE
#define REP_MERGE 0
#endif
#ifndef REP_SYNC
#define REP_SYNC 0
#endif
#ifndef ONE_LAUNCH
#define ONE_LAUNCH 1
#endif

typedef unsigned short bfu;
typedef __attribute__((ext_vector_type(8))) short bf16x8;
typedef __attribute__((ext_vector_type(16))) float f32x16;
typedef __attribute__((ext_vector_type(2))) __bf16 bf2_t;
typedef __attribute__((ext_vector_type(2))) float f2_t;

#define DI __device__ __forceinline__

constexpr int D = 1024;
constexpr int NTOK = 12288;
constexpr int NPROMPT = 4096;
constexpr int DIN = 4624;
constexpr int DINP = 4864;
constexpr int LDH = 1088;
constexpr int PW = 4112;
constexpr int OFF_GA = 0, OFF_Q = 512, OFF_K = 768, OFF_V = 1024, OFF_GB = 1536, OFF_GL = 2048,
              OFF_MA = 2064, OFF_MB = 3088;
constexpr int NCHUNK = NTOK / 32;
constexpr size_t OUT_RE = (size_t)NTOK * D;
constexpr size_t OUT_IM = OUT_RE + 131072;
constexpr size_t OUT_GLA = OUT_IM + 131072;
constexpr float EPS = 1e-6f;
constexpr int MODH = 2 * 5 * 3072;

struct Params {
  const float *x_prompt, *x_sample, *c, *st_re, *st_im, *st_gla, *c_ctx, *norm_g, *w_mod, *b_mod, *w_in,
      *wg_up, *bg, *gla_norm_g, *lam_re, *lam_im, *log_dt, *b_re, *b_im, *c_re, *c_im, *s5_d, *w_glu,
      *b_glu, *w_pa, *w_pb, *w_o, *final_g;
  float* out;
  bfu *w_inT, *w_gluT, *w_paT, *w_pbT, *w_oT;
  float *mod, *pos_r, *pos_c, *tmp_s5, *tmp_gla;
  bfu *h, *proj, *ys5, *ya, *yb, *merged;
  bfu *ug, *opMG, *opE, *carry;
  float *ebuf, *gla_sloc, *gla_aseg;
  unsigned* bar;
  bfu* gla_o;
};

DI int tid_() { int t = threadIdx.x & 255; asm volatile("" : "+v"(t)); return t; }
#define VHALF ((int)__builtin_amdgcn_readfirstlane((int)(threadIdx.x >> 8)))
#define VBID ((int)(blockIdx.x * 2 + VHALF))
#define NVB ((int)(gridDim.x * 2))
#define VXCD ((int)(blockIdx.x & 7))
#define VJ ((int)((blockIdx.x >> 3) * 2 + VHALF))
#define VNLOC ((int)((gridDim.x >> 3) * 2))
DI float bf2f(bfu v) { return __uint_as_float(((unsigned)v) << 16); }
DI bfu f2bf(float x) { __bf16 b = (__bf16)x; return __builtin_bit_cast(unsigned short, b); }
DI unsigned pack2(float lo, float hi) {
  f2_t v = {lo, hi};
  bf2_t w = __builtin_convertvector(v, bf2_t);
  return __builtin_bit_cast(unsigned, w);
}
DI float exp2f_(float x) { return __builtin_amdgcn_exp2f(x); }
DI float sigmoidf_(float x) { return __builtin_amdgcn_rcpf(1.f + exp2f_(-1.44269504f * x)); }
DI float siluf_(float x) { return x * sigmoidf_(x); }
DI float geluf_(float x) {
  float u = 0.7978845608028654f * (x + 0.044715f * x * x * x);
  float t = 1.f - 2.f * __builtin_amdgcn_rcpf(exp2f_(2.88539008f * u) + 1.f);
  return 0.5f * x * (1.f + t);
}
DI float logsigmoidf_(float x) {
  return fminf(x, 0.f) - 0.69314718f * __builtin_amdgcn_logf(1.f + exp2f_(-1.44269504f * fabsf(x)));
}
DI float wave_sum(float v) {
#pragma unroll
  for (int o = 32; o >= 1; o >>= 1) v += __shfl_xor(v, o);
  return v;
}
DI void unpack8(const uint4 v, float (&f)[8]) {
  f[0] = __uint_as_float(v.x << 16); f[1] = __uint_as_float(v.x & 0xffff0000u);
  f[2] = __uint_as_float(v.y << 16); f[3] = __uint_as_float(v.y & 0xffff0000u);
  f[4] = __uint_as_float(v.z << 16); f[5] = __uint_as_float(v.z & 0xffff0000u);
  f[6] = __uint_as_float(v.w << 16); f[7] = __uint_as_float(v.w & 0xffff0000u);
}
DI uint4 pack8(const float (&f)[8]) {
  uint4 o;
  o.x = pack2(f[0], f[1]); o.y = pack2(f[2], f[3]); o.z = pack2(f[4], f[5]); o.w = pack2(f[6], f[7]);
  return o;
}
DI int cond_of_tok(int tok) { return tok < NPROMPT ? 0 : 1 + ((tok - NPROMPT) >> 11); }

DI void transpose_tile(const float* __restrict__ src, int K, int N, bfu* __restrict__ dst, int kt, int nt,
                       float* sm, int ldd = 0) {
  if (ldd == 0) ldd = K;
  const int tid = tid_(), c = tid & 63, r4 = tid >> 6;
  const int k0 = kt * 64, n0 = nt * 64;
  float v[16];
  const bool inb = (n0 + c) < N;
#pragma unroll
  for (int i = 0; i < 16; ++i) v[i] = inb ? src[(size_t)(k0 + i * 4 + r4) * N + n0 + c] : 0.f;
#pragma unroll
  for (int i = 0; i < 16; ++i) sm[(i * 4 + r4) * 65 + c] = v[i];
  __syncthreads();
  {
    const int n = tid >> 2, kc = tid & 3;
    float o[16];
#pragma unroll
    for (int i = 0; i < 16; ++i) o[i] = sm[(kc * 16 + i) * 65 + n];
    bfu* dp = dst + (size_t)(n0 + n) * ldd + k0 + kc * 16;
    *(uint4*)dp = pack8(*(float(*)[8])&o[0]);
    *(uint4*)(dp + 8) = pack8(*(float(*)[8])&o[8]);
  }
  __syncthreads();
}

DI void phase_prep(const Params& p, char* smem) {
  float* sm = (float*)smem;
  const int tid = tid_();
  for (int it = VBID; it < 192; it += NVB) {
    const int kh = it & 1, jb = (it >> 1) % 48, l = it / 96;
    float* ssil = sm;
    float* sred = sm + 5 * 512;
    for (int idx = tid; idx < 2560; idx += 256) {
      int ci = idx >> 9, k = (idx & 511) + kh * 512;
      float cv = (ci == 0) ? p.c_ctx[k] : p.c[(ci - 1) * 1024 + k];
      ssil[idx] = cv / (1.f + expf(-cv));
    }
    __syncthreads();
    const int jj = tid & 63, kq = tid >> 6;
    const int j = jb * 64 + jj;
    float acc[5] = {0.f, 0.f, 0.f, 0.f, 0.f};
    const float* wp = p.w_mod + ((size_t)l * 1024 + kh * 512 + kq * 128) * 3072 + j;
#pragma unroll 16
    for (int k = 0; k < 128; ++k) {
      float w = wp[(size_t)k * 3072];
#pragma unroll
      for (int ci = 0; ci < 5; ++ci) acc[ci] += ssil[ci * 512 + kq * 128 + k] * w;
    }
#pragma unroll
    for (int ci = 0; ci < 5; ++ci) sred[(kq * 5 + ci) * 64 + jj] = acc[ci];
    __syncthreads();
    for (int idx = tid; idx < 320; idx += 256) {
      int ci = idx >> 6, j2 = idx & 63;
      float sv = kh == 0 ? p.b_mod[l * 3072 + jb * 64 + j2] : 0.f;
#pragma unroll
      for (int q = 0; q < 4; ++q) sv += sred[(q * 5 + ci) * 64 + j2];
      p.mod[((size_t)(kh * 2 + l) * 5 + ci) * 3072 + jb * 64 + j2] = sv;
    }
    __syncthreads();
  }
  for (int idx = VBID * 256 + tid; idx < 96 * 512; idx += NVB * 256) {
    int r = idx >> 9, i = idx & 511;
    int pos = r < 32 ? r : r - 32;
    int q = i & 255;
    double f = exp(-log(10000.0) * (double)q / 256.0);
    double ang = (double)pos * f;
    float v = (float)((i < 256) ? sin(ang) : cos(ang));
    if (r < 32) p.pos_r[r * 512 + i] = v; else p.pos_c[(r - 32) * 512 + i] = v;
  }
  for (int it = VBID; it < 3584; it += NVB) {
    int l = it / 1792, r = it % 1792;
    if (r < 1216) {
      transpose_tile(p.w_in + (size_t)l * 1024 * DIN, 1024, DIN, p.w_inT + (size_t)l * DINP * LDH, r % 16, r / 16, sm, LDH);
    } else if (r < 1280) {
      r -= 1216;
      transpose_tile(p.w_glu + (size_t)l * 512 * 512, 512, 512, p.w_gluT + (size_t)l * 512 * 512, r % 8, r / 8, sm);
    } else if (r < 1408) {
      r -= 1280;
      transpose_tile(p.w_pa + (size_t)l * 512 * 1024, 512, 1024, p.w_paT + (size_t)l * 1024 * 512, r % 8, r / 8, sm);
    } else if (r < 1536) {
      r -= 1408;
      transpose_tile(p.w_pb + (size_t)l * 512 * 1024, 512, 1024, p.w_pbT + (size_t)l * 1024 * 512, r % 8, r / 8, sm);
    } else {
      r -= 1536;
      transpose_tile(p.w_o + (size_t)l * 1024 * 1024, 1024, 1024, p.w_oT + (size_t)l * 1024 * 1024, r % 16, r / 16, sm);
    }
  }
}

DI void phase_h(const Params& p, int l) {
  const int tid = tid_(), lane = tid & 63, w = tid >> 6;
  for (int it = VBID; it < NTOK / 4; it += NVB) {
    const int tok = it * 4 + w;
    float4 v[4];
    float* xs = p.out + (size_t)tok * D;
    if (l == 0) {
      const float* src = tok < NPROMPT ? p.x_prompt + (size_t)tok * D : p.x_sample + (size_t)(tok - NPROMPT) * D;
#pragma unroll
      for (int i = 0; i < 4; ++i) v[i] = *(const float4*)(src + lane * 4 + 256 * i);
      if (tok >= NPROMPT) {
        int t = (tok - NPROMPT) & 2047, row = t >> 6, col = t & 63;
#pragma unroll
        for (int i = 0; i < 4; ++i) {
          int d = lane * 4 + 256 * i;
          const float* pe = d < 512 ? p.pos_r + row * 512 + d : p.pos_c + col * 512 + (d - 512);
          float4 e = *(const float4*)pe;
          v[i].x += e.x; v[i].y += e.y; v[i].z += e.z; v[i].w += e.w;
        }
      }
#pragma unroll
      for (int i = 0; i < 4; ++i) *(float4*)(xs + lane * 4 + 256 * i) = v[i];
    } else {
#pragma unroll
      for (int i = 0; i < 4; ++i) v[i] = *(const float4*)(xs + lane * 4 + 256 * i);
    }
    float ss = 0.f;
#pragma unroll
    for (int i = 0; i < 4; ++i) ss += v[i].x * v[i].x + v[i].y * v[i].y + v[i].z * v[i].z + v[i].w * v[i].w;
    ss = wave_sum(ss);
    const float rstd = rsqrtf(ss * (1.f / 1024.f) + EPS);
    const float* md = p.mod + (size_t)(l * 5 + cond_of_tok(tok)) * 3072;
    const float* ng = p.norm_g + l * 1024;
#pragma unroll
    for (int i = 0; i < 4; ++i) {
      int d = lane * 4 + 256 * i;
      float4 g = *(const float4*)(ng + d);
      float4 sh = *(const float4*)(md + d);
      float4 sc = *(const float4*)(md + 1024 + d);
      {
        const float4 sh1 = *(const float4*)(md + MODH + d);
        const float4 sc1 = *(const float4*)(md + MODH + 1024 + d);
        sh.x += sh1.x; sh.y += sh1.y; sh.z += sh1.z; sh.w += sh1.w;
        sc.x += sc1.x; sc.y += sc1.y; sc.z += sc1.z; sc.w += sc1.w;
      }
      float a0 = v[i].x * rstd * g.x * (1.f + sc.x) + sh.x;
      float a1 = v[i].y * rstd * g.y * (1.f + sc.y) + sh.y;
      float a2 = v[i].z * rstd * g.z * (1.f + sc.z) + sh.z;
      float a3 = v[i].w * rstd * g.w * (1.f + sc.w) + sh.w;
      uint2 o; o.x = pack2(a0, a1); o.y = pack2(a2, a3);
      *(uint2*)(p.h + (size_t)tok * LDH + d) = o;
    }
  }
}

DI void gemm_core(const bfu* A, int lda, const bfu* __restrict__ B, int ldb, int K, char* smem,
                  f32x16 (&acc)[2][2], const bfu* A2, int lda2, int K2) {
  const int tid = tid_(), lane = tid & 63, w = tid >> 6, wm = w >> 1, wn = w & 1;
  const int c8 = tid & 7, r0 = tid >> 3;
  const bfu* ga = A + (size_t)r0 * lda + c8 * 8;
  const bfu* gb = B + (size_t)r0 * ldb + c8 * 8;
  const int st_off = r0 * 128 + ((c8 ^ ((r0 >> 1) & 7)) * 16);
  const int fr = lane & 31, hh = lane >> 5, fsw = (fr >> 1) & 7;
  const int a_base = (wm * 64 + fr) * 128;
  const int b_base = 16384 + (wn * 64 + fr) * 128;
  uint4 ra0, ra1, ra2, ra3, rb0, rb1, rb2, rb3, qa0, qa1, qa2, qa3, qb0, qb1, qb2, qb3;
  const int KT1 = K >> 6, KT = (K + K2) >> 6;
  const bfu* ga2 = A2 + (size_t)r0 * lda2 + c8 * 8;
#define GEMM_LOADT(RA, RB, tile)                                                           \
  {                                                                                        \
    const int t_ = (tile) < KT ? (tile) : KT - 1;                                          \
    const bool s2_ = t_ >= KT1;                                                            \
    const bfu* ga_ = s2_ ? ga2 + (t_ - KT1) * 64 : ga + t_ * 64;                           \
    const size_t la_ = s2_ ? (size_t)lda2 : (size_t)lda;                                   \
    const bfu* gb_ = gb + t_ * 64;                                                         \
    RA##0 = *(const uint4*)(ga_);                 RB##0 = *(const uint4*)(gb_);                        \
    RA##1 = *(const uint4*)(ga_ + 32 * la_);      RB##1 = *(const uint4*)(gb_ + (size_t)32 * ldb);     \
    RA##2 = *(const uint4*)(ga_ + 64 * la_);      RB##2 = *(const uint4*)(gb_ + (size_t)64 * ldb);     \
    RA##3 = *(const uint4*)(ga_ + 96 * la_);      RB##3 = *(const uint4*)(gb_ + (size_t)96 * ldb);     \
  }
#define GEMM_STORET(buf, RA, RB)                                                           \
  {                                                                                        \
    *(uint4*)((buf) + st_off) = RA##0;          *(uint4*)((buf) + 16384 + st_off) = RB##0;          \
    *(uint4*)((buf) + st_off + 4096) = RA##1;   *(uint4*)((buf) + 16384 + st_off + 4096) = RB##1;   \
    *(uint4*)((buf) + st_off + 8192) = RA##2;   *(uint4*)((buf) + 16384 + st_off + 8192) = RB##2;   \
    *(uint4*)((buf) + st_off + 12288) = RA##3;  *(uint4*)((buf) + 16384 + st_off + 12288) = RB##3;  \
  }
#define GEMM_COMPUTE(cur)                                                                  \
  _Pragma("unroll") for (int s = 0; s < 4; ++s) {                                          \
    const int co = ((2 * s + hh) ^ fsw) * 16;                                              \
    bf16x8 a0 = *(const bf16x8*)((cur) + a_base + co);                                     \
    bf16x8 a1 = *(const bf16x8*)((cur) + a_base + 4096 + co);                              \
    bf16x8 b0 = *(const bf16x8*)((cur) + b_base + co);                                     \
    bf16x8 b1 = *(const bf16x8*)((cur) + b_base + 4096 + co);                              \
    acc[0][0] = __builtin_amdgcn_mfma_f32_32x32x16_bf16(a0, b0, acc[0][0], 0, 0, 0);       \
    acc[0][1] = __builtin_amdgcn_mfma_f32_32x32x16_bf16(a0, b1, acc[0][1], 0, 0, 0);       \
    acc[1][0] = __builtin_amdgcn_mfma_f32_32x32x16_bf16(a1, b0, acc[1][0], 0, 0, 0);       \
    acc[1][1] = __builtin_amdgcn_mfma_f32_32x32x16_bf16(a1, b1, acc[1][1], 0, 0, 0);       \
  }
  GEMM_LOADT(ra, rb, 0)
  GEMM_LOADT(qa, qb, 1)
  GEMM_STORET(smem, ra, rb)
  __syncthreads();
#pragma unroll 1
  for (int kt = 0; kt < KT; kt += 2) {
    GEMM_LOADT(ra, rb, kt + 2)
    __builtin_amdgcn_sched_barrier(0);
    GEMM_COMPUTE(smem)
    __builtin_amdgcn_sched_barrier(0);
    GEMM_STORET(smem + 32768, qa, qb)
    __syncthreads();
    GEMM_LOADT(qa, qb, kt + 3)
    __builtin_amdgcn_sched_barrier(0);
    GEMM_COMPUTE(smem + 32768)
    __builtin_amdgcn_sched_barrier(0);
    GEMM_STORET(smem, ra, rb)
    __syncthreads();
  }
}

DI void acc_zero(f32x16 (&acc)[2][2]) {
#pragma unroll
  for (int i = 0; i < 2; ++i)
#pragma unroll
    for (int j = 0; j < 2; ++j)
#pragma unroll
      for (int r = 0; r < 16; ++r) acc[i][j][r] = 0.f;
}

DI void acc_to_lds(const f32x16 (&acc)[2][2], char* smem) {
  float* sf = (float*)smem;
  const int tid = tid_(), lane = tid & 63, w = tid >> 6;
  const int rb = (w >> 1) * 64 + 4 * (lane >> 5), cb = (w & 1) * 64 + (lane & 31);
#pragma unroll
  for (int i = 0; i < 2; ++i)
#pragma unroll
    for (int j = 0; j < 2; ++j)
#pragma unroll
      for (int r = 0; r < 16; ++r)
        sf[(rb + i * 32 + (r & 3) + 8 * (r >> 2)) * 128 + cb + j * 32] = acc[i][j][r];
}
#define EPI_LDS(...)                                                             \
  {                                                                              \
    acc_to_lds(acc, smem);                                                       \
    __syncthreads();                                                             \
    _Pragma("unroll 1") for (int it_ = 0; it_ < 8; ++it_) {                      \
      const int row = (tid_() >> 4) + 16 * it_;                             \
      const int c0 = (tid_() & 15) * 8;                                     \
      float v[8];                                                                \
      {                                                                          \
        const float4 t0 = *(const float4*)(smem + (row * 128 + c0) * 4);         \
        const float4 t1 = *(const float4*)(smem + (row * 128 + c0 + 4) * 4);     \
        v[0] = t0.x; v[1] = t0.y; v[2] = t0.z; v[3] = t0.w;                      \
        v[4] = t1.x; v[5] = t1.y; v[6] = t1.z; v[7] = t1.w;                      \
      }                                                                          \
      __VA_ARGS__                                                                \
    }                                                                            \
    __syncthreads();                                                             \
  }

typedef __attribute__((ext_vector_type(4))) float f32x4;
constexpr int G_BK = 64, G_HALF = 128, G_HT = G_HALF * G_BK;
DI int g_lds_byte(int r, int c) {
  int st = (r >> 4) * 2 + (c >> 5), rr = r & 15, cc = c & 31, ob = rr * 64 + cc * 2;
  return st * 1024 + (ob ^ (((ob >> 9) & 1) << 5));
}
DI void g_stage_rc(int b, int& R, int& C) {
  int st = b / 1024, sb = b % 1024, swz = sb ^ (((sb >> 9) & 1) << 5);
  R = (st >> 1) * 16 + swz / 64; C = (st & 1) * 32 + (swz % 64) / 2;
}
DI const char* g_uniform(const char* ptr) {
  unsigned long long u = (unsigned long long)ptr;
  unsigned lo = __builtin_amdgcn_readfirstlane((unsigned)u), hi = __builtin_amdgcn_readfirstlane((unsigned)(u >> 32));
  return (const char*)(((unsigned long long)hi << 32) | lo);
}
DI void gemm256(const bfu* __restrict__ A, int lda, const bfu* __restrict__ Bt, int ldb, int K, int brow, int bcol,
                bfu* shm, f32x4 (&acc)[2][2][4][2]) {
#define G_SA(b, h) (shm + ((b) * 2 + (h)) * G_HT)
#define G_SB(b, h) (shm + (4 + (b) * 2 + (h)) * G_HT)
#define G_STAGE(P, BASE, LD, br, kt)                                                                   \
  do {                                                                                                 \
    const char* _u = g_uniform((const char*)((BASE) + ((long)(br) * (LD) + (long)(kt) * G_BK)));       \
    __builtin_amdgcn_global_load_lds((const unsigned*)(_u + soff_b),                                   \
        (__attribute__((address_space(3))) unsigned*)((char*)(P) + ldst), 16, 0, 0);                   \
    __builtin_amdgcn_global_load_lds((const unsigned*)(_u + 128 * (long)(LD) + soff_b),                \
        (__attribute__((address_space(3))) unsigned*)((char*)(P) + ldst + 8192), 16, 0, 0);            \
  } while (0)
#define G_LDA(dst, b, h) for (int m = 0; m < 4; ++m) for (int k = 0; k < 2; ++k) \
    dst[m][k] = *reinterpret_cast<const bf16x8*>((char*)G_SA(b, h) + a_rd + m * 2048 + k * 1024)
#define G_LDB(dst, b, h) for (int n = 0; n < 2; ++n) for (int k = 0; k < 2; ++k) \
    dst[n][k] = *reinterpret_cast<const bf16x8*>((char*)G_SB(b, h) + b_rd + n * 2048 + k * 1024)
#define G_MMA(ai, bj, At, Bt_)                                                                         \
  do {                                                                                                 \
    __builtin_amdgcn_s_setprio(1);                                                                     \
    for (int m = 0; m < 4; ++m) for (int n = 0; n < 2; ++n) for (int k = 0; k < 2; ++k)                \
      acc[ai][bj][m][n] = __builtin_amdgcn_mfma_f32_16x16x32_bf16(At[m][k], Bt_[n][k], acc[ai][bj][m][n], 0, 0, 0); \
    __builtin_amdgcn_s_setprio(0);                                                                     \
  } while (0)
#define G_WAIT_V(n) asm volatile("s_waitcnt vmcnt(" #n ")" ::: "memory")
#define G_WAIT_L(n) asm volatile("s_waitcnt lgkmcnt(" #n ")" ::: "memory")
#define G_BAR __builtin_amdgcn_s_barrier()
#define G_SCHED __builtin_amdgcn_sched_barrier(0)
  int t512 = threadIdx.x; asm volatile("" : "+v"(t512));
  const int wid = __builtin_amdgcn_readfirstlane(t512 >> 6), lane = t512 & 63, wr = wid >> 2, wc = wid & 3, fr = lane & 15, fq = lane >> 4;
  const int ldst = t512 * 16;
  unsigned soff_b;
  {
    int R0, C0;
    g_stage_rc(ldst, R0, C0);
    soff_b = (unsigned)(R0 * lda + C0) * 2u;
  }
  const int lane_off = (fr * 64 + fq * 16) ^ ((fr >> 3) << 5);
  const int a_rd = wr * 8192 + lane_off, b_rd = wc * 4096 + lane_off;
  bf16x8 At[4][2], B0[2][2], B1[2][2];
  const int nt = K / G_BK;
  G_STAGE(G_SB(0, 0), Bt, ldb, bcol, 0); G_STAGE(G_SA(0, 0), A, lda, brow, 0);
  G_STAGE(G_SB(0, 1), Bt, ldb, bcol + G_HALF, 0); G_STAGE(G_SA(0, 1), A, lda, brow + G_HALF, 0);
  if (wr == 1) G_BAR;
  G_WAIT_V(4); G_BAR;
  G_STAGE(G_SB(1, 0), Bt, ldb, bcol, 1); G_STAGE(G_SA(1, 0), A, lda, brow, 1); G_STAGE(G_SB(1, 1), Bt, ldb, bcol + G_HALF, 1);
  G_WAIT_V(6); G_BAR;
#pragma unroll 1
  for (int t = 0; t < nt - 2; t += 2) {
    G_LDB(B0, 0, 0); G_SCHED; G_LDA(At, 0, 0); G_STAGE(G_SA(1, 1), A, lda, brow + G_HALF, t + 1);
    G_WAIT_L(8); G_BAR; G_WAIT_L(0); G_MMA(0, 0, At, B0); G_BAR; G_SCHED;
    G_LDB(B1, 0, 1); G_STAGE(G_SB(0, 0), Bt, ldb, bcol, t + 2);
    G_BAR; G_WAIT_L(0); G_MMA(0, 1, At, B1); G_BAR;
    G_LDA(At, 0, 1); G_STAGE(G_SA(0, 0), A, lda, brow, t + 2);
    G_BAR; G_WAIT_L(0); G_MMA(1, 0, At, B0); G_BAR; G_SCHED;
    G_STAGE(G_SB(0, 1), Bt, ldb, bcol + G_HALF, t + 2);
    G_WAIT_V(6); G_BAR; G_MMA(1, 1, At, B1); G_BAR;
    G_LDB(B0, 1, 0); G_SCHED; G_LDA(At, 1, 0); G_STAGE(G_SA(0, 1), A, lda, brow + G_HALF, t + 2);
    G_WAIT_L(8); G_BAR; G_WAIT_L(0); G_MMA(0, 0, At, B0); G_BAR; G_SCHED;
    G_LDB(B1, 1, 1); G_STAGE(G_SB(1, 0), Bt, ldb, bcol, t + 3);
    G_BAR; G_WAIT_L(0); G_MMA(0, 1, At, B1); G_BAR;
    G_LDA(At, 1, 1); G_STAGE(G_SA(1, 0), A, lda, brow, t + 3);
    G_BAR; G_WAIT_L(0); G_MMA(1, 0, At, B0); G_BAR; G_SCHED;
    G_STAGE(G_SB(1, 1), Bt, ldb, bcol + G_HALF, t + 3);
    G_WAIT_V(6); G_BAR; G_MMA(1, 1, At, B1); G_BAR;
  }
  { G_LDB(B0, 0, 0); G_LDA(At, 0, 0); G_STAGE(G_SA(1, 1), A, lda, brow + G_HALF, nt - 1);
    G_BAR; G_WAIT_L(0); G_MMA(0, 0, At, B0); G_BAR;
    G_LDB(B1, 0, 1); G_BAR; G_WAIT_L(0); G_MMA(0, 1, At, B1); G_BAR;
    G_LDA(At, 0, 1); G_WAIT_V(4); G_BAR; G_WAIT_L(0); G_MMA(1, 0, At, B0); G_MMA(1, 1, At, B1); G_BAR; }
  { G_LDB(B0, 1, 0); G_LDA(At, 1, 0); G_WAIT_V(2); G_BAR; G_WAIT_L(0); G_MMA(0, 0, At, B0); G_BAR;
    G_LDB(B1, 1, 1); G_WAIT_V(0); G_BAR; G_WAIT_L(0); G_MMA(0, 1, At, B1); G_BAR;
    G_LDA(At, 1, 1); G_BAR; G_WAIT_L(0); G_MMA(1, 0, At, B0); G_MMA(1, 1, At, B1); G_BAR; }
  if (wr == 0) G_BAR;
}
DI void acc256_zero(f32x4 (&acc)[2][2][4][2]) {
#pragma unroll
  for (int a = 0; a < 2; ++a)
#pragma unroll
    for (int b = 0; b < 2; ++b)
#pragma unroll
      for (int m = 0; m < 4; ++m)
#pragma unroll
        for (int n = 0; n < 2; ++n) acc[a][b][m][n] = (f32x4){0.f, 0.f, 0.f, 0.f};
}
#define EPI_NOPRE
#define EPI256P(PRE, ...)                                                                              \
  {                                                                                                    \
    int t512_ = threadIdx.x; asm volatile("" : "+v"(t512_));     \
    const int wid_ = t512_ >> 6, lane_ = t512_ & 63, wr_ = wid_ >> 2, wc_ = wid_ & 3,                  \
              fr_ = lane_ & 15, fq_ = lane_ >> 4;                                                      \
    float* sf_ = (float*)smem;                                                                         \
    _Pragma("unroll") for (int ai_ = 0; ai_ < 2; ++ai_) {                                              \
      _Pragma("unroll") for (int it_ = 0; it_ < 8; ++it_) {     \
        const int idx_ = t512_ + 512 * it_;                                                            \
        const int rl_ = idx_ >> 5, c0 = (idx_ & 31) * 8;                                               \
        const int row = ai_ * 128 + rl_;                                                               \
        (void)rl_; (void)c0; (void)row;                                                                \
        PRE                                                                                            \
      }                                                                                                \
      __builtin_amdgcn_sched_barrier(0);              \
      __syncthreads();                                                                                 \
      _Pragma("unroll") for (int bj_ = 0; bj_ < 2; ++bj_)                                              \
      _Pragma("unroll") for (int m_ = 0; m_ < 4; ++m_)                                                 \
      _Pragma("unroll") for (int n_ = 0; n_ < 2; ++n_)                                                 \
      _Pragma("unroll") for (int j_ = 0; j_ < 4; ++j_)                                                 \
        sf_[(wr_ * 64 + m_ * 16 + fq_ * 4 + j_) * 256 + ((bj_ * 128 + wc_ * 32 + n_ * 16 + fr_) ^ (fq_ << 4))] = \
            acc[ai_][bj_][m_][n_][j_];                                                                 \
      __syncthreads();                                                                                 \
      _Pragma("unroll") for (int it_ = 0; it_ < 8; ++it_) {                                            \
        const int idx_ = t512_ + 512 * it_;                                                            \
        const int rl_ = idx_ >> 5, c0 = (idx_ & 31) * 8;                                               \
        const int row = ai_ * 128 + rl_;                                                               \
        float v[8];                                                                                    \
        {                                                                                              \
          const float* sp_ = sf_ + rl_ * 256 + (c0 ^ (((rl_ >> 2) & 3) << 4));                          \
          const float4 t0 = *(const float4*)sp_; const float4 t1 = *(const float4*)(sp_ + 4);          \
          v[0] = t0.x; v[1] = t0.y; v[2] = t0.z; v[3] = t0.w;                                          \
          v[4] = t1.x; v[5] = t1.y; v[6] = t1.z; v[7] = t1.w;                                          \
        }                                                                                              \
        __VA_ARGS__                                                                                    \
      }                                                                                                \
    }                                                                                                  \
    __syncthreads();                                                                                   \
  }
#define EPI256(...) EPI256P(EPI_NOPRE, __VA_ARGS__)

template <int MT, int NT, int BH>
DI bool xcd_tile(int iter, int& mt, int& nt) {
  constexpr int MPX = MT / 8, TPX = MPX * NT;
  const int xcd = VXCD, j = VJ, nloc = VNLOC;
  const int q = j + iter * nloc;
  if (q >= TPX) return false;
  const int band = q / (BH * NT), r = q % (BH * NT);
  nt = r / BH;
  mt = xcd * MPX + band * BH + (r % BH);
  return true;
}

DI bool tile256(int iter, int NT, int& mt, int& nt) {
  const int xcd = blockIdx.x & 7, j = blockIdx.x >> 3, nloc = gridDim.x >> 3;
  const int q = j + iter * nloc;
  if (q >= 6 * NT) return false;
  nt = q / 6; mt = xcd * 6 + q % 6;
  return true;
}
DI void phase_gemm_in(const Params& p, int l, char* smem) {
  const bfu* W = p.w_inT + (size_t)l * DINP * LDH;
  for (int iter = 0;; ++iter) {
    int mt, nt;
    if (!tile256(iter, 19, mt, nt)) break;
    f32x4 acc[2][2][4][2];
    acc256_zero(acc);
    gemm256(p.h, LDH, W, LDH, 1024, mt * 256, nt * 256, (bfu*)smem, acc);
    const int m0 = mt * 256, n0 = nt * 256;
    EPI256({
      const int n = n0 + c0;
      if (n < 512) *(uint4*)(p.ug + ((size_t)(n >> 4) * NTOK + (m0 + row)) * 16 + (n & 15)) = pack8(v);
      else if (n < DIN) *(uint4*)(p.proj + (size_t)(m0 + row) * PW + (n - 512)) = pack8(v);
    })
  }
}

DI void s5_gen_item(const Params& p, int l, int item, char* smem) {
  const int tid = tid_();
  const int g = item >> 3, r = item & 7;
  float* sBr = (float*)smem;
  float* sBi = sBr + 2048;
  float* sCr = sBi + 2048;
  float* sCi = sCr + 1024;
  float* sAK = sCi + 1024;
  float* sAE = sAK + 1024;
  float* sAG = sAE + 1024;
  float* sK = sAG + 1024;
  bfu* E = p.opE + (size_t)g * 256 * 512;
  bfu* MG = p.opMG + (size_t)g * 512 * 768;
  __syncthreads();
  if (tid < 128) {
    const int d = tid >> 6, pp = tid & 63;
    const size_t pi = ((size_t)(l * 2 + d) * 32 + g) * 64 + pp;
    const float lr = p.lam_re[pi], li = p.lam_im[pi];
    const float dt = expf(p.log_dt[(l * 2 + d) * 32 + g]);
    const float mag = expf(lr * dt);
    float sn, cs;
    sincosf(li * dt, &sn, &cs);
    const float are = mag * cs, aim = mag * sn;
    const float nr = are - 1.f, ni = aim, den = lr * lr + li * li;
    const float kr = (nr * lr + ni * li) / den, ki = (ni * lr - nr * li) / den;
#pragma unroll
    for (int c = 0; c < 16; ++c) {
      float br = p.b_re[((size_t)(l * 32 + g) * 64 + pp) * 16 + c];
      float bi = p.b_im[((size_t)(l * 32 + g) * 64 + pp) * 16 + c];
      sBr[(d * 64 + pp) * 16 + c] = kr * br - ki * bi;
      sBi[(d * 64 + pp) * 16 + c] = kr * bi + ki * br;
    }
#pragma unroll
    for (int q = 0; q < 4; ++q) {
      const int t = 4 * r + q;
      const int nK = t;
      const int nE = d == 0 ? 31 - t : t;
      const int nG = d == 0 ? t + 1 : 32 - t;
      float m, s_, c_;
      m = expf(lr * dt * (float)nK); sincosf(li * dt * (float)nK, &s_, &c_);
      sAK[((d * 4 + q) * 64 + pp) * 2] = m * c_; sAK[((d * 4 + q) * 64 + pp) * 2 + 1] = m * s_;
      m = expf(lr * dt * (float)nE); sincosf(li * dt * (float)nE, &s_, &c_);
      sAE[((d * 4 + q) * 64 + pp) * 2] = m * c_; sAE[((d * 4 + q) * 64 + pp) * 2 + 1] = m * s_;
      m = expf(lr * dt * (float)nG); sincosf(li * dt * (float)nG, &s_, &c_);
      sAG[((d * 4 + q) * 64 + pp) * 2] = m * c_; sAG[((d * 4 + q) * 64 + pp) * 2 + 1] = m * s_;
    }
  } else {
    for (int idx = tid - 128; idx < 1024; idx += 128) {
      sCr[idx] = p.c_re[(size_t)(l * 32 + g) * 1024 + idx];
      sCi[idx] = p.c_im[(size_t)(l * 32 + g) * 1024 + idx];
    }
  }
  __syncthreads();
  for (int idx = tid; idx < 256 * 64; idx += 256) {
    const int row = idx >> 6, cc = idx & 63, q = cc >> 4, c = cc & 15;
    const int part = row >> 6, pp = row & 63, d = part >> 1;
    const float ar = sAE[((d * 4 + q) * 64 + pp) * 2], ai = sAE[((d * 4 + q) * 64 + pp) * 2 + 1];
    const float br = sBr[(d * 64 + pp) * 16 + c], bi = sBi[(d * 64 + pp) * 16 + c];
    const float v = (part & 1) ? (ar * bi + ai * br) : (ar * br - ai * bi);
    E[(size_t)row * 512 + (4 * r + q) * 16 + c] = f2bf(v);
  }
  for (int idx = tid; idx < 64 * 256; idx += 256) {
    const int rr = idx >> 8, col = idx & 255, q = rr >> 4, c = rr & 15;
    const int part = col >> 6, pp = col & 63, d = part >> 1;
    const float ar = sAG[((d * 4 + q) * 64 + pp) * 2], ai = sAG[((d * 4 + q) * 64 + pp) * 2 + 1];
    const float cr = sCr[c * 64 + pp], ci = sCi[c * 64 + pp];
    const float v = (part & 1) ? -(cr * ai + ci * ar) : (cr * ar - ci * ai);
    MG[(size_t)((4 * r + q) * 16 + c) * 768 + 512 + col] = f2bf(v);
  }
  {
    const int d = tid >> 7, q = (tid >> 5) & 3, c = (tid >> 1) & 15, ch = tid & 1;
    float acc[8];
#pragma unroll
    for (int e = 0; e < 8; ++e) acc[e] = 0.f;
    for (int pp = 0; pp < 64; ++pp) {
      const float ar = sAK[((d * 4 + q) * 64 + pp) * 2], ai = sAK[((d * 4 + q) * 64 + pp) * 2 + 1];
      const float cr = sCr[c * 64 + pp], ci = sCi[c * 64 + pp];
      const float wr = cr * ar - ci * ai, wi = cr * ai + ci * ar;
#pragma unroll
      for (int e = 0; e < 8; ++e)
        acc[e] += wr * sBr[(d * 64 + pp) * 16 + ch * 8 + e] - wi * sBi[(d * 64 + pp) * 16 + ch * 8 + e];
    }
#pragma unroll
    for (int e = 0; e < 8; ++e) sK[((d * 4 + q) * 16 + c) * 16 + ch * 8 + e] = acc[e];
  }
  __syncthreads();
  for (int idx = tid; idx < 8192; idx += 256) {
    const int ch = idx & 1, c = (idx >> 1) & 15, tp = (idx >> 5) & 31, q = (idx >> 10) & 3, d = idx >> 12;
    const int tau = 4 * r + q;
    int sp;
    bool valid;
    if (d == 0) { sp = tp - tau; valid = sp >= 0; } else { sp = tp + tau; valid = (sp <= 31) && (tau > 0); }
    if (valid) {
      float v[8];
#pragma unroll
      for (int e = 0; e < 8; ++e) {
        float x = sK[((d * 4 + q) * 16 + c) * 16 + ch * 8 + e];
        if (tau == 0) x += sK[((1 * 4 + q) * 16 + c) * 16 + ch * 8 + e];
        v[e] = x;
      }
      *(uint4*)(MG + (size_t)(tp * 16 + c) * 768 + sp * 16 + ch * 8) = pack8(v);
    }
  }
  __syncthreads();
}

DI void phase_s5_gen(const Params& p, int l, char* smem) {
  for (int it = NVB - 1 - VBID; it < 256; it += NVB) s5_gen_item(p, l, it, smem);
}

DI void phase_s5_e(const Params& p, char* smem) {
  for (int q = VJ; q < 24; q += VNLOC) {
    const int g = VXCD * 4 + q / 6, r6 = q % 6, mt = r6 >> 1, nt = r6 & 1;
    f32x16 acc[2][2];
    acc_zero(acc);
    gemm_core(p.ug + ((size_t)g * NCHUNK + mt * 128) * 512, 512, p.opE + ((size_t)g * 256 + nt * 128) * 512, 512, 512,
              smem, acc, p.ug, 512, 0);
    EPI_LDS({
      float* dst = p.ebuf + ((size_t)g * NCHUNK + mt * 128 + row) * 256 + nt * 128 + c0;
      *(float4*)dst = make_float4(v[0], v[1], v[2], v[3]);
      *(float4*)(dst + 4) = make_float4(v[4], v[5], v[6], v[7]);
    })
  }
}

DI void phase_s5_scan(const Params& p, int l) {
  const int tid = tid_();
  for (int it = VBID; it < 320; it += NVB) {
    const int wi = it * 2 + (tid >> 7);
    const int dir = (tid >> 6) & 1, pp = tid & 63;
    int chunk0, n, b, g;
    bool prompt;
    if (wi < 128) { b = wi >> 5; g = wi & 31; chunk0 = (NPROMPT + b * 2048) >> 5; n = 64; prompt = false; }
    else { int q = wi - 128; b = q >> 5; g = q & 31; chunk0 = (b * 256) >> 5; n = 8; prompt = true; }
    const size_t pi = ((size_t)(l * 2 + dir) * 32 + g) * 64 + pp;
    const float lr = p.lam_re[pi], li = p.lam_im[pi];
    const float dt = expf(p.log_dt[(l * 2 + dir) * 32 + g]);
    const float mag = expf(lr * dt * 32.f);
    float sn, cs;
    sincosf(li * dt * 32.f, &sn, &cs);
    const float are = mag * cs, aim = mag * sn;
    float hre = 0.f, him = 0.f;
    if (!prompt) {
      size_t si = ((size_t)((b * 2 + l) * 2 + dir)) * 2048 + g * 64 + pp;
      hre = p.st_re[si]; him = p.st_im[si];
    }
    const float* eb = p.ebuf + ((size_t)g * NCHUNK + chunk0) * 256 + dir * 128 + pp;
    bfu* cb = p.carry + ((size_t)g * NCHUNK + chunk0) * 256 + dir * 128 + pp;
    for (int k0 = 0; k0 < n; k0 += 8) {
      float er[8], ei[8];
#pragma unroll
      for (int j = 0; j < 8; ++j) {
        const int k = dir == 0 ? k0 + j : n - 1 - (k0 + j);
        er[j] = eb[(size_t)k * 256];
        ei[j] = eb[(size_t)k * 256 + 64];
      }
#pragma unroll
      for (int j = 0; j < 8; ++j) {
        const int k = dir == 0 ? k0 + j : n - 1 - (k0 + j);
        cb[(size_t)k * 256] = f2bf(hre);
        cb[(size_t)k * 256 + 64] = f2bf(him);
        const float nre = are * hre - aim * him + er[j];
        const float nim = are * him + aim * hre + ei[j];
        hre = nre; him = nim;
      }
    }
    if (prompt) {
      size_t oi = ((size_t)((b * 2 + l) * 2 + dir)) * 2048 + g * 64 + pp;
      p.out[OUT_RE + oi] = hre;
      p.out[OUT_IM + oi] = him;
    }
  }
}

DI void phase_s5_y(const Params& p, int l, char* smem) {
  for (int q = VJ; q < 48; q += VNLOC) {
    const int g = VXCD * 4 + q / 12, r12 = q % 12, mt = r12 >> 2, nt = r12 & 3;
    f32x16 acc[2][2];
    acc_zero(acc);
    const bfu* Bm = p.opMG + ((size_t)g * 512 + nt * 128) * 768;
    gemm_core(p.ug + ((size_t)g * NCHUNK + mt * 128) * 512, 512, Bm, 768, 512, smem, acc,
              p.carry + ((size_t)g * NCHUNK + mt * 128) * 256, 256, 256);
    EPI_LDS({
      const int chunk = mt * 128 + row, nn = nt * 128 + c0, tp = nn >> 4, c = nn & 15;
      const int tok = chunk * 32 + tp;
      float u[8], o[8];
      unpack8(*(const uint4*)(p.ug + ((size_t)g * NTOK + tok) * 16 + c), u);
      const float* dsk = p.s5_d + l * 512 + g * 16 + c;
      _Pragma("unroll") for (int e = 0; e < 8; ++e) o[e] = geluf_(v[e] + dsk[e] * u[e]);
      *(uint4*)(p.ys5 + (size_t)tok * 512 + g * 16 + c) = pack8(o);
    })
  }
}

DI void phase_glu(const Params& p, int l, char* smem) {
  const bfu* W = p.w_gluT + (size_t)l * 512 * 512;
  for (int iter = 0;; ++iter) {
    int mt, nt;
    if (!xcd_tile<96, 4, 12>(iter, mt, nt)) break;
    f32x16 acc[2][2];
    acc_zero(acc);
    gemm_core(p.ys5 + (size_t)mt * 128 * 512, 512, W + (size_t)nt * 128 * 512, 512, 512, smem, acc, p.ys5, 512, 0);
    const int m0 = mt * 128, n0 = nt * 128;
    EPI_LDS({
      const int n = n0 + c0;
      const size_t tk = (size_t)(m0 + row);
      float y[8], ga[8], o[8];
      unpack8(*(const uint4*)(p.ys5 + tk * 512 + n), y);
      unpack8(*(const uint4*)(p.proj + tk * PW + OFF_GA + n), ga);
      const float* bg = p.b_glu + l * 512 + n;
      _Pragma("unroll") for (int e = 0; e < 8; ++e) o[e] = y[e] * sigmoidf_(v[e] + bg[e]) * siluf_(ga[e]);
      *(uint4*)(p.ya + tk * 512 + n) = pack8(o);
    })
  }
}

constexpr int GL_QS = 0;
constexpr int GL_KS = GL_QS + 32 * 144;
constexpr int GL_KHT = GL_KS + 32 * 144;
constexpr int GL_VT = GL_KHT + 64 * 80;
constexpr int GL_PS = GL_VT + 128 * 80;
constexpr int GL_ST = GL_PS + 32 * 80;
constexpr int GL_AV = GL_ST + 128 * 144;
constexpr int GL_TOT = GL_AV + 256;
constexpr int GL_OS = GL_TOT + 1024;
static_assert(GL_OS + 32 * 132 * 4 <= 65536, "gla lds");

DI void gla_segment_info(int seg, int& tok_base, bool& prompt, int& b, int& sidx) {
  if (seg < 16) { prompt = true; b = seg; sidx = 0; tok_base = seg * 256; }
  else { int q = seg - 16; prompt = false; b = q >> 3; sidx = q & 7; tok_base = NPROMPT + b * 2048 + sidx * 256; }
}

template <bool STATE_ONLY>
DI void gla_chain(const Params& p, int l, char* smem, int seg, int hd, int dir) {
  const int tid = tid_(), lane = tid & 63, w = tid >> 6;
  const int fr = lane & 31, hh = lane >> 5;
  int tok_base, b, sidx;
  bool prompt;
  gla_segment_info(seg, tok_base, prompt, b, sidx);
  const int dk = tid & 63, tq = tid >> 6;
  const int dvl = tid & 127, th = tid >> 7;
  const int jw = w & 1, thw = w >> 1, dkm = 32 * jw + fr;
  bf16x8 wgB;
  {
    unsigned wp[4];
#pragma unroll
    for (int e = 0; e < 4; ++e) {
      const float w0 = p.wg_up[((size_t)(l * 2 + dir) * 16 + 8 * hh + 2 * e) * 256 + hd * 64 + dkm];
      const float w1 = p.wg_up[((size_t)(l * 2 + dir) * 16 + 8 * hh + 2 * e + 1) * 256 + hd * 64 + dkm];
      wp[e] = pack2(w0, w1);
    }
    wgB = __builtin_bit_cast(bf16x8, make_uint4(wp[0], wp[1], wp[2], wp[3]));
  }
  const float bgv = p.bg[(l * 2 + dir) * 256 + hd * 64 + dkm];
  float* sAv = (float*)(smem + GL_AV);
  float* sTot = (float*)(smem + GL_TOT);
  float* sOs = (float*)(smem + GL_OS);

  f32x16 S[2];
  {
    const int dvc = 32 * w + fr;
    if (STATE_ONLY || prompt) {
#pragma unroll
      for (int mt = 0; mt < 2; ++mt)
#pragma unroll
        for (int r = 0; r < 16; ++r) S[mt][r] = 0.f;
    } else {
      const float* sp = p.st_gla + ((size_t)(((b * 2 + l) * 2 + dir) * 4 + hd)) * 8192;
#pragma unroll
      for (int mt = 0; mt < 2; ++mt)
#pragma unroll
        for (int r = 0; r < 16; ++r) S[mt][r] = sp[(32 * mt + (r & 3) + 8 * (r >> 2) + 4 * hh) * 128 + dvc];
      const int nprev = dir == 0 ? sidx : 7 - sidx;
      if (nprev > 0) {
        f32x16 cs[2], ns[2];
        float4 ca[8], na[8];
#define GLA_SEG_LOAD(SS, AA, qq)                                                                       \
        {                                                                                              \
          const int sprev_ = dir == 0 ? (qq) : 7 - (qq);                                               \
          const size_t ci_ = (size_t)(((b * 8 + sprev_) * 4 + hd) * 2 + dir);                          \
          const float* sl_ = p.gla_sloc + ci_ * 8192 + dvc;                                            \
          const float* al_ = p.gla_aseg + ci_ * 64 + 4 * hh;                                           \
          _Pragma("unroll") for (int mt = 0; mt < 2; ++mt)                                             \
          _Pragma("unroll") for (int r = 0; r < 16; ++r)                                               \
            SS[mt][r] = sl_[(32 * mt + (r & 3) + 8 * (r >> 2) + 4 * hh) * 128];                        \
          _Pragma("unroll") for (int i = 0; i < 8; ++i) AA[i] = *(const float4*)(al_ + 8 * i);         \
        }
        GLA_SEG_LOAD(cs, ca, 0)
#pragma unroll 1
        for (int q = 0; q < nprev; ++q) {
          if (q + 1 < nprev) GLA_SEG_LOAD(ns, na, q + 1)
#pragma unroll
          for (int mt = 0; mt < 2; ++mt)
#pragma unroll
            for (int qq = 0; qq < 4; ++qq) {
              const float4 av = ca[mt * 4 + qq];
              S[mt][4 * qq + 0] = av.x * S[mt][4 * qq + 0] + cs[mt][4 * qq + 0];
              S[mt][4 * qq + 1] = av.y * S[mt][4 * qq + 1] + cs[mt][4 * qq + 1];
              S[mt][4 * qq + 2] = av.z * S[mt][4 * qq + 2] + cs[mt][4 * qq + 2];
              S[mt][4 * qq + 3] = av.w * S[mt][4 * qq + 3] + cs[mt][4 * qq + 3];
            }
          cs[0] = ns[0]; cs[1] = ns[1];
#pragma unroll
          for (int i = 0; i < 8; ++i) ca[i] = na[i];
        }
      }
    }
  }
  float bsum = 0.f;
  __syncthreads();
  if (!STATE_ONLY) {
    const int dvc = 32 * w + fr;
#pragma unroll
    for (int mt = 0; mt < 2; ++mt)
#pragma unroll
      for (int q = 0; q < 4; ++q) {
        uint2 pk;
        pk.x = pack2(S[mt][4 * q], S[mt][4 * q + 1]);
        pk.y = pack2(S[mt][4 * q + 2], S[mt][4 * q + 3]);
        *(uint2*)(smem + GL_ST + dvc * 144 + (32 * mt + 8 * q + 4 * hh) * 2) = pk;
      }
  }

  uint4 rq = make_uint4(0, 0, 0, 0), rk = rq, rv0 = rq, rv1 = rq, rgl = rq;
#define GLA_ISSUE(nn)                                                                                         \
  {                                                                                                           \
    const int cn_ = dir == 0 ? (nn) : 7 - (nn);                                                               \
    const int c0_ = tok_base + cn_ * 32;                                                                      \
    const int tA = dir == 0 ? (tid >> 3) : 31 - (tid >> 3);                                                   \
    const bfu* prA = p.proj + (size_t)(c0_ + tA) * PW + hd * 64 + (tid & 7) * 8;                              \
    if (!STATE_ONLY) rq = *(const uint4*)(prA + OFF_Q);                                                       \
    rk = *(const uint4*)(prA + OFF_K);                                                                        \
    const int tV0 = dir == 0 ? (tid >> 4) : 31 - (tid >> 4);                                                  \
    const int tV1 = dir == 0 ? (tid >> 4) + 16 : 15 - (tid >> 4);                                             \
    rv0 = *(const uint4*)(p.proj + (size_t)(c0_ + tV0) * PW + OFF_V + hd * 128 + (tid & 15) * 8);             \
    rv1 = *(const uint4*)(p.proj + (size_t)(c0_ + tV1) * PW + OFF_V + hd * 128 + (tid & 15) * 8);             \
    if (tid < 64) {                                                                                           \
      const int tG = dir == 0 ? (tid >> 1) : 31 - (tid >> 1);                                                 \
      rgl = *(const uint4*)(p.proj + (size_t)(c0_ + tG) * PW + OFF_GL + (tid & 1) * 8);                       \
    }                                                                                                         \
  }
  GLA_ISSUE(0)
  char* rawQ = smem + GL_OS;
  char* rawK = smem + GL_OS + 4096;
  char* rawV = smem + GL_OS + 8192;
  char* rawG = smem + GL_PS;

#pragma unroll 1
  for (int n = 0; n < 8; ++n) {
    const int cn = dir == 0 ? n : 7 - n;
    const int ctok0 = tok_base + cn * 32;
    __syncthreads();
    if (!STATE_ONLY) *(uint4*)(rawQ + (tid >> 3) * 128 + (tid & 7) * 16) = rq;
    *(uint4*)(rawK + (tid >> 3) * 128 + (tid & 7) * 16) = rk;
    *(uint4*)(rawV + (tid >> 4) * 256 + (tid & 15) * 16) = rv0;
    *(uint4*)(rawV + ((tid >> 4) + 16) * 256 + (tid & 15) * 16) = rv1;
    if (tid < 64) *(uint4*)(rawG + (tid >> 1) * 32 + (tid & 1) * 16) = rgl;
    if (n + 1 < 8) GLA_ISSUE(n + 1)
    __syncthreads();
    {
      f32x16 lg;
#pragma unroll
      for (int r = 0; r < 16; ++r) lg[r] = 0.f;
      const bf16x8 ga = *(const bf16x8*)(rawG + fr * 32 + hh * 16);
      lg = __builtin_amdgcn_mfma_f32_32x32x16_bf16(ga, wgB, lg, 0, 0, 0);
      float ls[16], gsum[4], psum[4];
#pragma unroll
      for (int r = 0; r < 16; ++r) {
        const float x = lg[r] + bgv;
        ls[r] = logsigmoidf_(x) * (1.f / 16.f);
      }
#pragma unroll
      for (int q = 0; q < 4; ++q) {
        gsum[q] = ls[4 * q] + ls[4 * q + 1] + ls[4 * q + 2] + ls[4 * q + 3];
        psum[q] = __shfl_xor(gsum[q], 32);
      }
      float off[4], run = 0.f;
#pragma unroll
      for (int q = 0; q < 4; ++q) {
        off[q] = run + (hh ? psum[q] : 0.f);
        run += gsum[q] + psum[q];
      }
      const float total = run;
#pragma unroll
      for (int qq = 0; qq < 2; ++qq) {
        float khv[4];
        float acc_b = 0.f;
#pragma unroll
        for (int i = 0; i < 4; ++i) {
          const float lsv = thw == 0 ? ls[4 * qq + i] : ls[8 + 4 * qq + i];
          const float offv = thw == 0 ? off[qq] : off[2 + qq];
          acc_b += lsv;
          const float bb = offv + acc_b;
          const int tau = 16 * thw + 8 * qq + 4 * hh + i;
          const float kvv = bf2f(*(const bfu*)(rawK + tau * 128 + dkm * 2));
          if (!STATE_ONLY) {
            const float qvv = bf2f(*(const bfu*)(rawQ + tau * 128 + dkm * 2)) * 0.125f;
            *(bfu*)(smem + GL_QS + tau * 144 + dkm * 2) = f2bf(qvv * __expf(bb));
            *(bfu*)(smem + GL_KS + tau * 144 + dkm * 2) = f2bf(kvv * __expf(-bb));
          }
          khv[i] = kvv * __expf(total - bb);
        }
        uint2 kh; kh.x = pack2(khv[0], khv[1]); kh.y = pack2(khv[2], khv[3]);
        *(uint2*)(smem + GL_KHT + dkm * 80 + (16 * thw + 8 * qq + 4 * hh) * 2) = kh;
      }
      if (thw == 0 && hh == 0) { sAv[dkm] = __expf(total); bsum += total; }
    }
    {
      unsigned pk[8];
#pragma unroll
      for (int i = 0; i < 8; ++i) {
        const int tau0 = th * 16 + 2 * i;
        const unsigned lo = *(const bfu*)(rawV + tau0 * 256 + dvl * 2);
        const unsigned hi = *(const bfu*)(rawV + (tau0 + 1) * 256 + dvl * 2);
        pk[i] = lo | (hi << 16);
      }
      *(uint4*)(smem + GL_VT + dvl * 80 + th * 32) = make_uint4(pk[0], pk[1], pk[2], pk[3]);
      *(uint4*)(smem + GL_VT + dvl * 80 + th * 32 + 16) = make_uint4(pk[4], pk[5], pk[6], pk[7]);
    }
    __syncthreads();
    f32x16 o;
    if (!STATE_ONLY) {
      f32x16 sc;
#pragma unroll
      for (int r = 0; r < 16; ++r) sc[r] = 0.f;
#pragma unroll
      for (int s4 = 0; s4 < 4; ++s4) {
        bf16x8 a = *(const bf16x8*)(smem + GL_QS + fr * 144 + (16 * s4 + 8 * hh) * 2);
        bf16x8 bq = *(const bf16x8*)(smem + GL_KS + fr * 144 + (16 * s4 + 8 * hh) * 2);
        sc = __builtin_amdgcn_mfma_f32_32x32x16_bf16(a, bq, sc, 0, 0, 0);
      }
#pragma unroll
      for (int rr = 0; rr < 4; ++rr) {
        float val = w == 0 ? sc[rr] : (w == 1 ? sc[4 + rr] : (w == 2 ? sc[8 + rr] : sc[12 + rr]));
        const int i = rr + 8 * w + 4 * hh;
        val = (fr <= i) ? val : 0.f;
        *(bfu*)(smem + GL_PS + i * 80 + fr * 2) = f2bf(val);
      }
      __syncthreads();
#pragma unroll
      for (int r = 0; r < 16; ++r) o[r] = 0.f;
    }
    {
      const int dvc = 32 * w + fr;
      bf16x8 vb0 = *(const bf16x8*)(smem + GL_VT + dvc * 80 + (8 * hh) * 2);
      bf16x8 vb1 = *(const bf16x8*)(smem + GL_VT + dvc * 80 + (16 + 8 * hh) * 2);
      if (!STATE_ONLY) {
        bf16x8 pa0 = *(const bf16x8*)(smem + GL_PS + fr * 80 + (8 * hh) * 2);
        bf16x8 pa1 = *(const bf16x8*)(smem + GL_PS + fr * 80 + (16 + 8 * hh) * 2);
        o = __builtin_amdgcn_mfma_f32_32x32x16_bf16(pa0, vb0, o, 0, 0, 0);
        o = __builtin_amdgcn_mfma_f32_32x32x16_bf16(pa1, vb1, o, 0, 0, 0);
#pragma unroll
        for (int s4 = 0; s4 < 4; ++s4) {
          bf16x8 a = *(const bf16x8*)(smem + GL_QS + fr * 144 + (16 * s4 + 8 * hh) * 2);
          bf16x8 sb = *(const bf16x8*)(smem + GL_ST + dvc * 144 + (16 * s4 + 8 * hh) * 2);
          o = __builtin_amdgcn_mfma_f32_32x32x16_bf16(a, sb, o, 0, 0, 0);
        }
      }
#pragma unroll
      for (int mt = 0; mt < 2; ++mt) {
        f32x16 U;
#pragma unroll
        for (int r = 0; r < 16; ++r) U[r] = 0.f;
        bf16x8 ka0 = *(const bf16x8*)(smem + GL_KHT + (32 * mt + fr) * 80 + (8 * hh) * 2);
        bf16x8 ka1 = *(const bf16x8*)(smem + GL_KHT + (32 * mt + fr) * 80 + (16 + 8 * hh) * 2);
        U = __builtin_amdgcn_mfma_f32_32x32x16_bf16(ka0, vb0, U, 0, 0, 0);
        U = __builtin_amdgcn_mfma_f32_32x32x16_bf16(ka1, vb1, U, 0, 0, 0);
#pragma unroll
        for (int q = 0; q < 4; ++q) {
          const float4 av = *(const float4*)(sAv + 32 * mt + 8 * q + 4 * hh);
          S[mt][4 * q + 0] = av.x * S[mt][4 * q + 0] + U[4 * q + 0];
          S[mt][4 * q + 1] = av.y * S[mt][4 * q + 1] + U[4 * q + 1];
          S[mt][4 * q + 2] = av.z * S[mt][4 * q + 2] + U[4 * q + 2];
          S[mt][4 * q + 3] = av.w * S[mt][4 * q + 3] + U[4 * q + 3];
          if (!STATE_ONLY) {
            uint2 pk;
            pk.x = pack2(S[mt][4 * q], S[mt][4 * q + 1]);
            pk.y = pack2(S[mt][4 * q + 2], S[mt][4 * q + 3]);
            *(uint2*)(smem + GL_ST + dvc * 144 + (32 * mt + 8 * q + 4 * hh) * 2) = pk;
          }
        }
      }
      if (!STATE_ONLY) {
#pragma unroll
        for (int r = 0; r < 16; ++r) sOs[((r & 3) + 8 * (r >> 2) + 4 * hh) * 132 + dvc] = o[r];
      }
    }
    __syncthreads();
    if (!STATE_ONLY) {
      const int t = tid >> 3, part = tid & 7;
      const int tau = dir == 0 ? t : 31 - t;
      const size_t tok = (size_t)(ctok0 + t);
      float ov[16];
#pragma unroll
      for (int q = 0; q < 4; ++q) {
        const float4 x = *(const float4*)(sOs + tau * 132 + part * 16 + 4 * q);
        ov[4 * q] = x.x; ov[4 * q + 1] = x.y; ov[4 * q + 2] = x.z; ov[4 * q + 3] = x.w;
      }
      bfu* op = p.gla_o + ((size_t)dir * NTOK + tok) * 512 + hd * 128 + part * 16;
      *(uint4*)op = pack8(*(float(*)[8])&ov[0]);
      *(uint4*)(op + 8) = pack8(*(float(*)[8])&ov[8]);
    }
  }
  const int dvc = 32 * w + fr;
  if (STATE_ONLY) {
    const size_t ci = (size_t)(((b * 8 + sidx) * 4 + hd) * 2 + dir);
    float* sl = p.gla_sloc + ci * 8192;
#pragma unroll
    for (int mt = 0; mt < 2; ++mt)
#pragma unroll
      for (int r = 0; r < 16; ++r) sl[(32 * mt + (r & 3) + 8 * (r >> 2) + 4 * hh) * 128 + dvc] = S[mt][r];
    if (thw == 0 && hh == 0) p.gla_aseg[ci * 64 + dkm] = __expf(bsum);
  } else if (prompt) {
    float* op = p.out + OUT_GLA + ((size_t)(((b * 2 + l) * 2 + dir) * 4 + hd)) * 8192;
#pragma unroll
    for (int mt = 0; mt < 2; ++mt)
#pragma unroll
      for (int r = 0; r < 16; ++r) op[(32 * mt + (r & 3) + 8 * (r >> 2) + 4 * hh) * 128 + dvc] = S[mt][r];
  }
  __syncthreads();
}

DI void phase_gla_pass1(const Params& p, int l, char* smem) {
  for (int it = NVB - 1 - VBID; it < 256; it += NVB) {
    const int dir = it & 1, hd = (it >> 1) & 3, seg = 16 + (it >> 3);
    gla_chain<true>(p, l, smem, seg, hd, dir);
  }
}
DI void phase_gla_main(const Params& p, int l, char* smem) {
  for (int it = NVB - 1 - VBID; it < 384; it += NVB) {
    const int dir = it & 1, hd = (it >> 1) & 3, seg = it >> 3;
    gla_chain<false>(p, l, smem, seg, hd, dir);
  }
}
DI void phase_gla_norm(const Params& p, int l, int part) {
  const int tid = tid_(), lane = tid & 63, w = tid >> 6;
  const int ib = (VJ - 48) * 8 + VXCD;
  for (int it = part * (NTOK / 8) + (VJ >= 48 ? ib : NTOK); it < (part + 1) * (NTOK / 8); it += 128) {
    const int tok = it * 4 + w;
    float a[8], b[8], gt[8], res[8];
    unpack8(*(const uint4*)(p.gla_o + (size_t)tok * 512 + lane * 8), a);
    unpack8(*(const uint4*)(p.gla_o + ((size_t)NTOK + tok) * 512 + lane * 8), b);
    unpack8(*(const uint4*)(p.proj + (size_t)tok * PW + OFF_GB + lane * 8), gt);
    float ss = 0.f;
#pragma unroll
    for (int e = 0; e < 8; ++e) { a[e] += b[e]; ss += a[e] * a[e]; }
    ss += __shfl_xor(ss, 1); ss += __shfl_xor(ss, 2); ss += __shfl_xor(ss, 4); ss += __shfl_xor(ss, 8);
    const float rs = rsqrtf(ss * (1.f / 128.f) + EPS);
    const float* g = p.gla_norm_g + l * 512 + lane * 8;
#pragma unroll
    for (int e = 0; e < 8; ++e) res[e] = a[e] * rs * g[e] * siluf_(gt[e]);
    *(uint4*)(p.yb + (size_t)tok * 512 + lane * 8) = pack8(res);
  }
}

DI void phase_merge(const Params& p, int l, char* smem) {
  const bfu* WA = p.w_paT + (size_t)l * 1024 * 512;
  const bfu* WB = p.w_pbT + (size_t)l * 1024 * 512;
  for (int iter = 0;; ++iter) {
    int mt, nt;
    if (!tile256(iter, 4, mt, nt)) break;
    const int m0 = mt * 256, n0 = nt * 256;
    f32x4 acc[2][2][4][2];
    acc256_zero(acc);
    gemm256(p.ya, 512, WA, 512, 512, m0, n0, (bfu*)smem, acc);
    uint4 pg[8], pq[8];
#define MERGE_PRE1 pg[it_] = *(const uint4*)(p.proj + (size_t)(m0 + row) * PW + OFF_MA + n0 + c0);
#define MERGE_PRE2 pg[it_] = *(const uint4*)(p.proj + (size_t)(m0 + row) * PW + OFF_MB + n0 + c0); \
                   pq[it_] = *(const uint4*)(p.merged + (size_t)(m0 + row) * D + n0 + c0);
    EPI256P(MERGE_PRE1, {
      float ma[8], o[8];
      unpack8(pg[it_], ma);
      _Pragma("unroll") for (int e = 0; e < 8; ++e) o[e] = sigmoidf_(ma[e]) * v[e];
      *(uint4*)(p.merged + (size_t)(m0 + row) * D + n0 + c0) = pack8(o);
    })
    acc256_zero(acc);
    gemm256(p.yb, 512, WB, 512, 512, m0, n0, (bfu*)smem, acc);
    EPI256P(MERGE_PRE2, {
      float mb[8], o[8], pr[8];
      unpack8(pg[it_], mb);
      uint4* mp = (uint4*)(p.merged + (size_t)(m0 + row) * D + n0 + c0);
      unpack8(pq[it_], pr);
      _Pragma("unroll") for (int e = 0; e < 8; ++e) o[e] = pr[e] + sigmoidf_(mb[e]) * v[e];
      *mp = pack8(o);
    })
  }
}

DI void phase_out(const Params& p, int l, char* smem) {
  const bfu* W = p.w_oT + (size_t)l * 1024 * 1024;
  for (int iter = 0;; ++iter) {
    int mt, nt;
    if (!tile256(iter, 4, mt, nt)) break;
    const int m0 = mt * 256, n0 = nt * 256;
    f32x4 acc[2][2][4][2];
    acc256_zero(acc);
    gemm256(p.merged, D, W, 1024, 1024, m0, n0, (bfu*)smem, acc);
    const float* gate = p.mod + (size_t)(l * 5 + cond_of_tok(m0)) * 3072 + 2048;
    float4 px0[8], px1[8];
#define OUT_PRE px0[it_] = *(const float4*)(p.out + (size_t)(m0 + row) * D + n0 + c0); \
                px1[it_] = *(const float4*)(p.out + (size_t)(m0 + row) * D + n0 + c0 + 4);
    EPI256P(OUT_PRE, {
      float* xp = p.out + (size_t)(m0 + row) * D + n0 + c0;
      const float* gp = gate + n0 + c0;
      float4 x0 = px0[it_], x1 = px1[it_];
      float4 g0 = *(const float4*)gp, g1 = *(const float4*)(gp + 4);
      {
        const float4 h0 = *(const float4*)(gp + MODH), h1 = *(const float4*)(gp + MODH + 4);
        g0.x += h0.x; g0.y += h0.y; g0.z += h0.z; g0.w += h0.w;
        g1.x += h1.x; g1.y += h1.y; g1.z += h1.z; g1.w += h1.w;
      }
      x0.x += g0.x * v[0]; x0.y += g0.y * v[1]; x0.z += g0.z * v[2]; x0.w += g0.w * v[3];
      x1.x += g1.x * v[4]; x1.y += g1.y * v[5]; x1.z += g1.z * v[6]; x1.w += g1.w * v[7];
      *(float4*)xp = x0; *(float4*)(xp + 4) = x1;
    })
  }
}

DI void phase_final(const Params& p) {
  const int tid = tid_(), lane = tid & 63, w = tid >> 6;
  for (int it = VBID; it < NTOK / 4; it += NVB) {
    const int tok = it * 4 + w;
    float* xs = p.out + (size_t)tok * D;
    float4 v[4];
#pragma unroll
    for (int i = 0; i < 4; ++i) v[i] = *(const float4*)(xs + lane * 4 + 256 * i);
    float ss = 0.f;
#pragma unroll
    for (int i = 0; i < 4; ++i) ss += v[i].x * v[i].x + v[i].y * v[i].y + v[i].z * v[i].z + v[i].w * v[i].w;
    ss = wave_sum(ss);
    const float rstd = rsqrtf(ss * (1.f / 1024.f) + EPS);
#pragma unroll
    for (int i = 0; i < 4; ++i) {
      float4 g = *(const float4*)(p.final_g + lane * 4 + 256 * i);
      float4 o;
      o.x = v[i].x * rstd * g.x; o.y = v[i].y * rstd * g.y; o.z = v[i].z * rstd * g.z; o.w = v[i].w * rstd * g.w;
      *(float4*)(xs + lane * 4 + 256 * i) = o;
    }
  }
}

#define XB_TMO      128
#define XB_XCNT(j)  (256  + 64 * (j))
#define XB_XSUB(j)  (1280 + 64 * (j))
#define XB_XGEN(j)  (2304 + 64 * (j))
#define XB_TOP      3328
#define XB_TOPGEN   3392
#define XCD_BAR_WORDS 3456
#define XB_SPIN_CAP (1u << 18)
#define LAS __attribute__((address_space(3)))
DI unsigned xb_ld(unsigned* p) { return __hip_atomic_load(p, __ATOMIC_RELAXED, __HIP_MEMORY_SCOPE_AGENT); }
DI unsigned xb_add(unsigned* p, unsigned v) { return __hip_atomic_fetch_add(p, v, __ATOMIC_RELAXED, __HIP_MEMORY_SCOPE_AGENT); }
DI unsigned xb_xcc_id() { return (unsigned)__builtin_amdgcn_s_getreg((3 << 11) | 20) & 0xFu; }
#define XB_SPIN(cond, bar) do { unsigned _sp = 0; while (cond) { __builtin_amdgcn_s_sleep(1); \
    if ((++_sp & 255u) == 0u) { if (xb_ld(&(bar)[XB_TMO])) break; if (_sp > XB_SPIN_CAP) { atomicAdd(&(bar)[XB_TMO], 1u); break; } } } } while (0)
struct XcdBarrier { unsigned* bar; unsigned x; volatile LAS unsigned* st; };
DI XcdBarrier xcd_barrier_post(unsigned* bar, volatile LAS unsigned* st) {
  XcdBarrier b; b.bar = bar; b.x = xb_xcc_id(); b.st = st;
  if (threadIdx.x == 0) (void)xb_add(&bar[XB_XCNT(b.x)], 1u);
  return b;
}
DI void xcd_barrier_complete(unsigned* bar, unsigned x, unsigned& nloc, unsigned& nx) {
  const unsigned G = gridDim.x * gridDim.y * gridDim.z;
  unsigned sum, cnt, mine, sp = 0u;
  for (;;) {
    sum = 0u; cnt = 0u; mine = 0u;
#pragma unroll
    for (unsigned j = 0; j < 16; ++j) { const unsigned c = xb_ld(&bar[XB_XCNT(j)]); sum += c; cnt += (c > 0u) ? 1u : 0u; mine = (j == x) ? c : mine; }
    if (sum == G) break;
    __builtin_amdgcn_s_sleep(1);
    if ((++sp & 255u) == 0u) { if (xb_ld(&bar[XB_TMO])) break; if (sp > XB_SPIN_CAP) { atomicAdd(&bar[XB_TMO], 1u); break; } }
  }
  nloc = mine > 0u ? mine : 1u; nx = cnt > 0u ? cnt : 1u;
}
DI void xcd_barrier(const XcdBarrier& b) {
  asm volatile("s_waitcnt vmcnt(0)" ::: "memory");
  __syncthreads();
  if (threadIdx.x == 0) {
    unsigned* bar = b.bar;
    __builtin_amdgcn_s_waitcnt(0);
    unsigned nloc = b.st[0], nx = b.st[1];
    if (nloc == 0u) { xcd_barrier_complete(bar, b.x, nloc, nx); b.st[0] = nloc; b.st[1] = nx; }
    const unsigned old = xb_add(&bar[XB_XSUB(b.x)], 1u);
    const unsigned gen = old / nloc;
    if (old + 1u == (gen + 1u) * nloc) {
      __builtin_amdgcn_fence(__ATOMIC_RELEASE, "agent");
      asm volatile("s_waitcnt vmcnt(0)" ::: "memory");
      const unsigned og = xb_add(&bar[XB_TOP], 1u);
      const unsigned tg = og / nx;
      if (og + 1u == (tg + 1u) * nx) xb_add(&bar[XB_TOPGEN], 1u);
      else XB_SPIN(xb_ld(&bar[XB_TOPGEN]) == tg, bar);
      __builtin_amdgcn_fence(__ATOMIC_ACQUIRE, "agent");
      xb_add(&bar[XB_XGEN(b.x)], 1u);
      asm volatile("s_waitcnt vmcnt(0)" ::: "memory");
    } else {
      XB_SPIN(xb_ld(&bar[XB_XGEN(b.x)]) == gen, bar);
      __builtin_amdgcn_fence(__ATOMIC_ACQUIRE, "agent");
      asm volatile("s_waitcnt vmcnt(0)" ::: "memory");
    }
  }
  __syncthreads();
}

#ifndef REP_SYNC
#define REP_SYNC 0
#endif
__global__ void __launch_bounds__(512, 2) k_mega(Params p) {
  extern __shared__ __attribute__((aligned(16))) char smem_all[];
  cg::grid_group grid = cg::this_grid();
  char* smem = smem_all;
#define smh (smem_all + VHALF * 65536)
  volatile LAS unsigned* xst = (volatile LAS unsigned*)(smem_all + 131072);
  if (threadIdx.x < 4) xst[threadIdx.x] = 0u;
  __syncthreads();
  XcdBarrier xb = xcd_barrier_post(p.bar, xst);
#define GSYNC() xcd_barrier(xb)
  phase_prep(p, smh);
  phase_s5_gen(p, 0, smh);
  GSYNC();
  if (p.bar == nullptr) grid.sync();
  for (int l = 0; l < 2; ++l) {
    phase_h(p, l);
    GSYNC();
    phase_gemm_in(p, l, smem);
    GSYNC();
    phase_s5_e(p, smh);
    phase_gla_pass1(p, l, smh);
    GSYNC();
    phase_s5_scan(p, l);
    phase_gla_main(p, l, smh);
    GSYNC();
    phase_s5_y(p, l, smh);
    phase_gla_norm(p, l, 0);
    GSYNC();
    phase_glu(p, l, smh);
    phase_gla_norm(p, l, 1);
    GSYNC();
    phase_merge(p, l, smem);
    if (l == 0 && (blockIdx.x >> 3) >= 24) {
      const int hb = (int)((((blockIdx.x >> 3) - 24) * 8 + (blockIdx.x & 7)) * 2) + VHALF;
      s5_gen_item(p, 1, hb, smh);
    }
    GSYNC();
    phase_out(p, l, smem);
    if (l == 0 && (blockIdx.x >> 3) >= 24) {
      const int hb = (int)((((blockIdx.x >> 3) - 24) * 8 + (blockIdx.x & 7)) * 2) + VHALF;
      s5_gen_item(p, 1, hb + 128, smh);
    }
    GSYNC();
    for (int rep = 0; rep < REP_SYNC; ++rep) GSYNC();
  }
  phase_final(p);
}

extern "C" void kernel_launch(void* const* d_in, const int* in_sizes, int n_in, void* d_out, int out_size,
                              void* d_ws, size_t ws_size, hipStream_t stream) {
  Params p{};
  const float* const* in = (const float* const*)d_in;
  p.x_prompt = in[0]; p.x_sample = in[1]; p.c = in[2]; p.st_re = in[3]; p.st_im = in[4]; p.st_gla = in[5];
  p.c_ctx = in[6]; p.norm_g = in[7]; p.w_mod = in[8]; p.b_mod = in[9]; p.w_in = in[10]; p.wg_up = in[11];
  p.bg = in[12]; p.gla_norm_g = in[13]; p.lam_re = in[14]; p.lam_im = in[15]; p.log_dt = in[16];
  p.b_re = in[17]; p.b_im = in[18]; p.c_re = in[19]; p.c_im = in[20]; p.s5_d = in[21]; p.w_glu = in[22];
  p.b_glu = in[23]; p.w_pa = in[24]; p.w_pb = in[25]; p.w_o = in[26]; p.final_g = in[27];
  p.out = (float*)d_out;
  char* ws = (char*)d_ws;
  size_t off = 0;
  auto take = [&](size_t bytes) { char* r = ws + off; off += (bytes + 255) & ~(size_t)255; return r; };
  p.w_inT = (bfu*)take((size_t)2 * DINP * LDH * 2);
  p.w_gluT = (bfu*)take((size_t)2 * 512 * 512 * 2);
  p.w_paT = (bfu*)take((size_t)2 * 1024 * 512 * 2);
  p.w_pbT = (bfu*)take((size_t)2 * 1024 * 512 * 2);
  p.w_oT = (bfu*)take((size_t)2 * 1024 * 1024 * 2);
  p.pos_r = (float*)take((size_t)32 * 512 * 4);
  p.pos_c = (float*)take((size_t)64 * 512 * 4);
  p.h = (bfu*)take((size_t)NTOK * LDH * 2);
  p.proj = (bfu*)take((size_t)NTOK * PW * 2);
  p.ys5 = (bfu*)take((size_t)NTOK * 512 * 2);
  p.ya = (bfu*)take((size_t)NTOK * 512 * 2);
  p.yb = (bfu*)take((size_t)NTOK * 512 * 2);
  p.merged = (bfu*)take((size_t)NTOK * D * 2);
  p.tmp_s5 = nullptr;
  p.ebuf = (float*)p.merged;
  p.carry = (bfu*)((char*)p.merged + (size_t)32 * NCHUNK * 256 * 4);
  p.ug = (bfu*)take((size_t)32 * NTOK * 16 * 2);
  p.opMG = (bfu*)take((size_t)32 * 512 * 768 * 2);
  p.opE = (bfu*)take((size_t)32 * 256 * 512 * 2);
  p.gla_sloc = (float*)p.ys5;
  p.gla_aseg = (float*)((char*)p.ys5 + (size_t)256 * 8192 * 4);
  if (off > ws_size) fprintf(stderr, "workspace too small: %zu > %zu\n", off, ws_size);
  p.bar = (unsigned*)take((size_t)XCD_BAR_WORDS * 4);
  p.mod = (float*)take((size_t)2 * 2 * 5 * 3072 * 4);
  p.gla_o = (bfu*)p.h;
  p.tmp_gla = (float*)p.h;
  constexpr size_t kLds = 131072 + 16;
  static int grid_blocks = 0;
  if (!grid_blocks) {
    int dev = 0, cus = 0, per_cu = 0;
    hipGetDevice(&dev);
    hipDeviceGetAttribute(&cus, hipDeviceAttributeMultiprocessorCount, dev);
    hipFuncSetAttribute((const void*)k_mega, hipFuncAttributeMaxDynamicSharedMemorySize, (int)kLds);
    hipOccupancyMaxActiveBlocksPerMultiprocessor(&per_cu, k_mega, 512, kLds);
    if (per_cu > 1) per_cu = 1;
    grid_blocks = cus * per_cu;
    if (grid_blocks % 8 != 0 || grid_blocks <= 0) fprintf(stderr, "unexpected grid %d\n", grid_blocks);
  }
  hipMemsetAsync(p.bar, 0, (size_t)XCD_BAR_WORDS * 4, stream);
  void* args[] = {&p};
  hipError_t e = hipLaunchCooperativeKernel((void*)k_mega, dim3(grid_blocks), dim3(512), args, kLds, stream);
  if (e != hipSuccess) fprintf(stderr, "cooperative launch failed: %s (grid %d)\n", hipGetErrorString(e), grid_blocks);
}
```

```cpp
#include <hip/hip_runtime.h>
#include <hip/hip_cooperative_groups.h>
#include <stdint.h>
#include <math.h>
#include <stdio.h>
namespace cg = cooperative_groups;

#ifndef REP_PREP
#define REP_PREP 0
#endif
#ifndef REP_GIN
#define REP_GIN 0
#endif
#ifndef REP_X1
#define REP_X1 0
#endif
#ifndef REP_X2
#define REP_X2 0
#endif
#ifndef REP_Y
#define REP_Y 0
#endif
#ifndef REP_MERGE
#define REP_MERGE 0
#endif
#ifndef REP_SYNC
#define REP_SYNC 0
#endif
#ifndef ONE_LAUNCH
#define ONE_LAUNCH 1
#endif

typedef unsigned short bfu;
typedef __attribute__((ext_vector_type(8))) short bf16x8;
typedef __attribute__((ext_vector_type(16))) float f32x16;
typedef __attribute__((ext_vector_type(2))) __bf16 bf2_t;
typedef __attribute__((ext_vector_type(2))) float f2_t;

#define DI __device__ __forceinline__

constexpr int D = 1024;
constexpr int NTOK = 12288;
constexpr int NPROMPT = 4096;
constexpr int DIN = 4624;
constexpr int DINP = 4864;
constexpr int LDH = 1088;
constexpr int PW = 4112;
constexpr int OFF_GA = 0, OFF_Q = 512, OFF_K = 768, OFF_V = 1024, OFF_GB = 1536, OFF_GL = 2048,
              OFF_MA = 2064, OFF_MB = 3088;
constexpr int NCHUNK = NTOK / 32;
constexpr size_t OUT_RE = (size_t)NTOK * D;
constexpr size_t OUT_IM = OUT_RE + 131072;
constexpr size_t OUT_GLA = OUT_IM + 131072;
constexpr float EPS = 1e-6f;
constexpr int MODH = 2 * 5 * 3072;

struct Params {
  const float *x_prompt, *x_sample, *c, *st_re, *st_im, *st_gla, *c_ctx, *norm_g, *w_mod, *b_mod, *w_in,
      *wg_up, *bg, *gla_norm_g, *lam_re, *lam_im, *log_dt, *b_re, *b_im, *c_re, *c_im, *s5_d, *w_glu,
      *b_glu, *w_pa, *w_pb, *w_o, *final_g;
  float* out;
  bfu *w_inT, *w_gluT, *w_paT, *w_pbT, *w_oT;
  float *mod, *pos_r, *pos_c, *tmp_s5, *tmp_gla;
  bfu *h, *proj, *ys5, *ya, *yb, *merged;
  bfu *ug, *opMG, *opE, *carry;
  float *ebuf, *gla_sloc, *gla_aseg;
  unsigned* bar;
  bfu* gla_o;
};

DI int tid_() { int t = threadIdx.x & 255; asm volatile("" : "+v"(t)); return t; }
#define VHALF ((int)__builtin_amdgcn_readfirstlane((int)(threadIdx.x >> 8)))
#define VBID ((int)(blockIdx.x * 2 + VHALF))
#define NVB ((int)(gridDim.x * 2))
#define VXCD ((int)(blockIdx.x & 7))
#define VJ ((int)((blockIdx.x >> 3) * 2 + VHALF))
#define VNLOC ((int)((gridDim.x >> 3) * 2))
DI float bf2f(bfu v) { return __uint_as_float(((unsigned)v) << 16); }
DI bfu f2bf(float x) { __bf16 b = (__bf16)x; return __builtin_bit_cast(unsigned short, b); }
DI unsigned pack2(float lo, float hi) {
  f2_t v = {lo, hi};
  bf2_t w = __builtin_convertvector(v, bf2_t);
  return __builtin_bit_cast(unsigned, w);
}
DI float exp2f_(float x) { return __builtin_amdgcn_exp2f(x); }
DI float sigmoidf_(float x) { return __builtin_amdgcn_rcpf(1.f + exp2f_(-1.44269504f * x)); }
DI float siluf_(float x) { return x * sigmoidf_(x); }
DI float geluf_(float x) {
  float u = 0.7978845608028654f * (x + 0.044715f * x * x * x);
  float t = 1.f - 2.f * __builtin_amdgcn_rcpf(exp2f_(2.88539008f * u) + 1.f);
  return 0.5f * x * (1.f + t);
}
DI float logsigmoidf_(float x) {
  return fminf(x, 0.f) - 0.69314718f * __builtin_amdgcn_logf(1.f + exp2f_(-1.44269504f * fabsf(x)));
}
DI float wave_sum(float v) {
#pragma unroll
  for (int o = 32; o >= 1; o >>= 1) v += __shfl_xor(v, o);
  return v;
}
DI void unpack8(const uint4 v, float (&f)[8]) {
  f[0] = __uint_as_float(v.x << 16); f[1] = __uint_as_float(v.x & 0xffff0000u);
  f[2] = __uint_as_float(v.y << 16); f[3] = __uint_as_float(v.y & 0xffff0000u);
  f[4] = __uint_as_float(v.z << 16); f[5] = __uint_as_float(v.z & 0xffff0000u);
  f[6] = __uint_as_float(v.w << 16); f[7] = __uint_as_float(v.w & 0xffff0000u);
}
DI uint4 pack8(const float (&f)[8]) {
  uint4 o;
  o.x = pack2(f[0], f[1]); o.y = pack2(f[2], f[3]); o.z = pack2(f[4], f[5]); o.w = pack2(f[6], f[7]);
  return o;
}
DI int cond_of_tok(int tok) { return tok < NPROMPT ? 0 : 1 + ((tok - NPROMPT) >> 11); }

DI void transpose_tile(const float* __restrict__ src, int K, int N, bfu* __restrict__ dst, int kt, int nt,
                       float* sm, int ldd = 0) {
  if (ldd == 0) ldd = K;
  const int tid = tid_(), c = tid & 63, r4 = tid >> 6;
  const int k0 = kt * 64, n0 = nt * 64;
  float v[16];
  const bool inb = (n0 + c) < N;
#pragma unroll
  for (int i = 0; i < 16; ++i) v[i] = inb ? src[(size_t)(k0 + i * 4 + r4) * N + n0 + c] : 0.f;
#pragma unroll
  for (int i = 0; i < 16; ++i) sm[(i * 4 + r4) * 65 + c] = v[i];
  __syncthreads();
  {
    const int n = tid >> 2, kc = tid & 3;
    float o[16];
#pragma unroll
    for (int i = 0; i < 16; ++i) o[i] = sm[(kc * 16 + i) * 65 + n];
    bfu* dp = dst + (size_t)(n0 + n) * ldd + k0 + kc * 16;
    *(uint4*)dp = pack8(*(float(*)[8])&o[0]);
    *(uint4*)(dp + 8) = pack8(*(float(*)[8])&o[8]);
  }
  __syncthreads();
}

DI void phase_prep(const Params& p, char* smem) {
  float* sm = (float*)smem;
  const int tid = tid_();
  for (int it = VBID; it < 192; it += NVB) {
    const int kh = it & 1, jb = (it >> 1) % 48, l = it / 96;
    float* ssil = sm;
    float* sred = sm + 5 * 512;
    for (int idx = tid; idx < 2560; idx += 256) {
      int ci = idx >> 9, k = (idx & 511) + kh * 512;
      float cv = (ci == 0) ? p.c_ctx[k] : p.c[(ci - 1) * 1024 + k];
      ssil[idx] = cv / (1.f + expf(-cv));
    }
    __syncthreads();
    const int jj = tid & 63, kq = tid >> 6;
    const int j = jb * 64 + jj;
    float acc[5] = {0.f, 0.f, 0.f, 0.f, 0.f};
    const float* wp = p.w_mod + ((size_t)l * 1024 + kh * 512 + kq * 128) * 3072 + j;
#pragma unroll 16
    for (int k = 0; k < 128; ++k) {
      float w = wp[(size_t)k * 3072];
#pragma unroll
      for (int ci = 0; ci < 5; ++ci) acc[ci] += ssil[ci * 512 + kq * 128 + k] * w;
    }
#pragma unroll
    for (int ci = 0; ci < 5; ++ci) sred[(kq * 5 + ci) * 64 + jj] = acc[ci];
    __syncthreads();
    for (int idx = tid; idx < 320; idx += 256) {
      int ci = idx >> 6, j2 = idx & 63;
      float sv = kh == 0 ? p.b_mod[l * 3072 + jb * 64 + j2] : 0.f;
#pragma unroll
      for (int q = 0; q < 4; ++q) sv += sred[(q * 5 + ci) * 64 + j2];
      p.mod[((size_t)(kh * 2 + l) * 5 + ci) * 3072 + jb * 64 + j2] = sv;
    }
    __syncthreads();
  }
  for (int idx = VBID * 256 + tid; idx < 96 * 512; idx += NVB * 256) {
    int r = idx >> 9, i = idx & 511;
    int pos = r < 32 ? r : r - 32;
    int q = i & 255;
    double f = exp(-log(10000.0) * (double)q / 256.0);
    double ang = (double)pos * f;
    float v = (float)((i < 256) ? sin(ang) : cos(ang));
    if (r < 32) p.pos_r[r * 512 + i] = v; else p.pos_c[(r - 32) * 512 + i] = v;
  }
  for (int it = VBID; it < 3584; it += NVB) {
    int l = it / 1792, r = it % 1792;
    if (r < 1216) {
      transpose_tile(p.w_in + (size_t)l * 1024 * DIN, 1024, DIN, p.w_inT + (size_t)l * DINP * LDH, r % 16, r / 16, sm, LDH);
    } else if (r < 1280) {
      r -= 1216;
      transpose_tile(p.w_glu + (size_t)l * 512 * 512, 512, 512, p.w_gluT + (size_t)l * 512 * 512, r % 8, r / 8, sm);
    } else if (r < 1408) {
      r -= 1280;
      transpose_tile(p.w_pa + (size_t)l * 512 * 1024, 512, 1024, p.w_paT + (size_t)l * 1024 * 512, r % 8, r / 8, sm);
    } else if (r < 1536) {
      r -= 1408;
      transpose_tile(p.w_pb + (size_t)l * 512 * 1024, 512, 1024, p.w_pbT + (size_t)l * 1024 * 512, r % 8, r / 8, sm);
    } else {
      r -= 1536;
      transpose_tile(p.w_o + (size_t)l * 1024 * 1024, 1024, 1024, p.w_oT + (size_t)l * 1024 * 1024, r % 16, r / 16, sm);
    }
  }
}

DI void phase_h(const Params& p, int l) {
  const int tid = tid_(), lane = tid & 63, w = tid >> 6;
  for (int it = VBID; it < NTOK / 4; it += NVB) {
    const int tok = it * 4 + w;
    float4 v[4];
    float* xs = p.out + (size_t)tok * D;
    if (l == 0) {
      const float* src = tok < NPROMPT ? p.x_prompt + (size_t)tok * D : p.x_sample + (size_t)(tok - NPROMPT) * D;
#pragma unroll
      for (int i = 0; i < 4; ++i) v[i] = *(const float4*)(src + lane * 4 + 256 * i);
      if (tok >= NPROMPT) {
        int t = (tok - NPROMPT) & 2047, row = t >> 6, col = t & 63;
#pragma unroll
        for (int i = 0; i < 4; ++i) {
          int d = lane * 4 + 256 * i;
          const float* pe = d < 512 ? p.pos_r + row * 512 + d : p.pos_c + col * 512 + (d - 512);
          float4 e = *(const float4*)pe;
          v[i].x += e.x; v[i].y += e.y; v[i].z += e.z; v[i].w += e.w;
        }
      }
#pragma unroll
      for (int i = 0; i < 4; ++i) *(float4*)(xs + lane * 4 + 256 * i) = v[i];
    } else {
#pragma unroll
      for (int i = 0; i < 4; ++i) v[i] = *(const float4*)(xs + lane * 4 + 256 * i);
    }
    float ss = 0.f;
#pragma unroll
    for (int i = 0; i < 4; ++i) ss += v[i].x * v[i].x + v[i].y * v[i].y + v[i].z * v[i].z + v[i].w * v[i].w;
    ss = wave_sum(ss);
    const float rstd = rsqrtf(ss * (1.f / 1024.f) + EPS);
    const float* md = p.mod + (size_t)(l * 5 + cond_of_tok(tok)) * 3072;
    const float* ng = p.norm_g + l * 1024;
#pragma unroll
    for (int i = 0; i < 4; ++i) {
      int d = lane * 4 + 256 * i;
      float4 g = *(const float4*)(ng + d);
      float4 sh = *(const float4*)(md + d);
      float4 sc = *(const float4*)(md + 1024 + d);
      {
        const float4 sh1 = *(const float4*)(md + MODH + d);
        const float4 sc1 = *(const float4*)(md + MODH + 1024 + d);
        sh.x += sh1.x; sh.y += sh1.y; sh.z += sh1.z; sh.w += sh1.w;
        sc.x += sc1.x; sc.y += sc1.y; sc.z += sc1.z; sc.w += sc1.w;
      }
      float a0 = v[i].x * rstd * g.x * (1.f + sc.x) + sh.x;
      float a1 = v[i].y * rstd * g.y * (1.f + sc.y) + sh.y;
      float a2 = v[i].z * rstd * g.z * (1.f + sc.z) + sh.z;
      float a3 = v[i].w * rstd * g.w * (1.f + sc.w) + sh.w;
      uint2 o; o.x = pack2(a0, a1); o.y = pack2(a2, a3);
      *(uint2*)(p.h + (size_t)tok * LDH + d) = o;
    }
  }
}

DI void gemm_core(const bfu* A, int lda, const bfu* __restrict__ B, int ldb, int K, char* smem,
                  f32x16 (&acc)[2][2], const bfu* A2, int lda2, int K2) {
  const int tid = tid_(), lane = tid & 63, w = tid >> 6, wm = w >> 1, wn = w & 1;
  const int c8 = tid & 7, r0 = tid >> 3;
  const bfu* ga = A + (size_t)r0 * lda + c8 * 8;
  const bfu* gb = B + (size_t)r0 * ldb + c8 * 8;
  const int st_off = r0 * 128 + ((c8 ^ ((r0 >> 1) & 7)) * 16);
  const int fr = lane & 31, hh = lane >> 5, fsw = (fr >> 1) & 7;
  const int a_base = (wm * 64 + fr) * 128;
  const int b_base = 16384 + (wn * 64 + fr) * 128;
  uint4 ra0, ra1, ra2, ra3, rb0, rb1, rb2, rb3, qa0, qa1, qa2, qa3, qb0, qb1, qb2, qb3;
  const int KT1 = K >> 6, KT = (K + K2) >> 6;
  const bfu* ga2 = A2 + (size_t)r0 * lda2 + c8 * 8;
#define GEMM_LOADT(RA, RB, tile)                                                           \
  {                                                                                        \
    const int t_ = (tile) < KT ? (tile) : KT - 1;                                          \
    const bool s2_ = t_ >= KT1;                                                            \
    const bfu* ga_ = s2_ ? ga2 + (t_ - KT1) * 64 : ga + t_ * 64;                           \
    const size_t la_ = s2_ ? (size_t)lda2 : (size_t)lda;                                   \
    const bfu* gb_ = gb + t_ * 64;                                                         \
    RA##0 = *(const uint4*)(ga_);                 RB##0 = *(const uint4*)(gb_);                        \
    RA##1 = *(const uint4*)(ga_ + 32 * la_);      RB##1 = *(const uint4*)(gb_ + (size_t)32 * ldb);     \
    RA##2 = *(const uint4*)(ga_ + 64 * la_);      RB##2 = *(const uint4*)(gb_ + (size_t)64 * ldb);     \
    RA##3 = *(const uint4*)(ga_ + 96 * la_);      RB##3 = *(const uint4*)(gb_ + (size_t)96 * ldb);     \
  }
#define GEMM_STORET(buf, RA, RB)                                                           \
  {                                                                                        \
    *(uint4*)((buf) + st_off) = RA##0;          *(uint4*)((buf) + 16384 + st_off) = RB##0;          \
    *(uint4*)((buf) + st_off + 4096) = RA##1;   *(uint4*)((buf) + 16384 + st_off + 4096) = RB##1;   \
    *(uint4*)((buf) + st_off + 8192) = RA##2;   *(uint4*)((buf) + 16384 + st_off + 8192) = RB##2;   \
    *(uint4*)((buf) + st_off + 12288) = RA##3;  *(uint4*)((buf) + 16384 + st_off + 12288) = RB##3;  \
  }
#define GEMM_COMPUTE(cur)                                                                  \
  _Pragma("unroll") for (int s = 0; s < 4; ++s) {                                          \
    const int co = ((2 * s + hh) ^ fsw) * 16;                                              \
    bf16x8 a0 = *(const bf16x8*)((cur) + a_base + co);                                     \
    bf16x8 a1 = *(const bf16x8*)((cur) + a_base + 4096 + co);                              \
    bf16x8 b0 = *(const bf16x8*)((cur) + b_base + co);                                     \
    bf16x8 b1 = *(const bf16x8*)((cur) + b_base + 4096 + co);                              \
    acc[0][0] = __builtin_amdgcn_mfma_f32_32x32x16_bf16(a0, b0, acc[0][0], 0, 0, 0);       \
    acc[0][1] = __builtin_amdgcn_mfma_f32_32x32x16_bf16(a0, b1, acc[0][1], 0, 0, 0);       \
    acc[1][0] = __builtin_amdgcn_mfma_f32_32x32x16_bf16(a1, b0, acc[1][0], 0, 0, 0);       \
    acc[1][1] = __builtin_amdgcn_mfma_f32_32x32x16_bf16(a1, b1, acc[1][1], 0, 0, 0);       \
  }
  GEMM_LOADT(ra, rb, 0)
  GEMM_LOADT(qa, qb, 1)
  GEMM_STORET(smem, ra, rb)
  __syncthreads();
#pragma unroll 1
  for (int kt = 0; kt < KT; kt += 2) {
    GEMM_LOADT(ra, rb, kt + 2)
    __builtin_amdgcn_sched_barrier(0);
    GEMM_COMPUTE(smem)
    __builtin_amdgcn_sched_barrier(0);
    GEMM_STORET(smem + 32768, qa, qb)
    __syncthreads();
    GEMM_LOADT(qa, qb, kt + 3)
    __builtin_amdgcn_sched_barrier(0);
    GEMM_COMPUTE(smem + 32768)
    __builtin_amdgcn_sched_barrier(0);
    GEMM_STORET(smem, ra, rb)
    __syncthreads();
  }
}

DI void acc_zero(f32x16 (&acc)[2][2]) {
#pragma unroll
  for (int i = 0; i < 2; ++i)
#pragma unroll
    for (int j = 0; j < 2; ++j)
#pragma unroll
      for (int r = 0; r < 16; ++r) acc[i][j][r] = 0.f;
}

DI void acc_to_lds(const f32x16 (&acc)[2][2], char* smem) {
  float* sf = (float*)smem;
  const int tid = tid_(), lane = tid & 63, w = tid >> 6;
  const int rb = (w >> 1) * 64 + 4 * (lane >> 5), cb = (w & 1) * 64 + (lane & 31);
#pragma unroll
  for (int i = 0; i < 2; ++i)
#pragma unroll
    for (int j = 0; j < 2; ++j)
#pragma unroll
      for (int r = 0; r < 16; ++r)
        sf[(rb + i * 32 + (r & 3) + 8 * (r >> 2)) * 128 + cb + j * 32] = acc[i][j][r];
}
#define EPI_LDS(...)                                                             \
  {                                                                              \
    acc_to_lds(acc, smem);                                                       \
    __syncthreads();                                                             \
    _Pragma("unroll 1") for (int it_ = 0; it_ < 8; ++it_) {                      \
      const int row = (tid_() >> 4) + 16 * it_;                             \
      const int c0 = (tid_() & 15) * 8;                                     \
      float v[8];                                                                \
      {                                                                          \
        const float4 t0 = *(const float4*)(smem + (row * 128 + c0) * 4);         \
        const float4 t1 = *(const float4*)(smem + (row * 128 + c0 + 4) * 4);     \
        v[0] = t0.x; v[1] = t0.y; v[2] = t0.z; v[3] = t0.w;                      \
        v[4] = t1.x; v[5] = t1.y; v[6] = t1.z; v[7] = t1.w;                      \
      }                                                                          \
      __VA_ARGS__                                                                \
    }                                                                            \
    __syncthreads();                                                             \
  }

typedef __attribute__((ext_vector_type(4))) float f32x4;
constexpr int G_BK = 64, G_HALF = 128, G_HT = G_HALF * G_BK;
DI int g_lds_byte(int r, int c) {
  int st = (r >> 4) * 2 + (c >> 5), rr = r & 15, cc = c & 31, ob = rr * 64 + cc * 2;
  return st * 1024 + (ob ^ (((ob >> 9) & 1) << 5));
}
DI void g_stage_rc(int b, int& R, int& C) {
  int st = b / 1024, sb = b % 1024, swz = sb ^ (((sb >> 9) & 1) << 5);
  R = (st >> 1) * 16 + swz / 64; C = (st & 1) * 32 + (swz % 64) / 2;
}
DI const char* g_uniform(const char* ptr) {
  unsigned long long u = (unsigned long long)ptr;
  unsigned lo = __builtin_amdgcn_readfirstlane((unsigned)u), hi = __builtin_amdgcn_readfirstlane((unsigned)(u >> 32));
  return (const char*)(((unsigned long long)hi << 32) | lo);
}
DI void gemm256(const bfu* __restrict__ A, int lda, const bfu* __restrict__ Bt, int ldb, int K, int brow, int bcol,
                bfu* shm, f32x4 (&acc)[2][2][4][2]) {
#define G_SA(b, h) (shm + ((b) * 2 + (h)) * G_HT)
#define G_SB(b, h) (shm + (4 + (b) * 2 + (h)) * G_HT)
#define G_STAGE(P, BASE, LD, br, kt)                                                                   \
  do {                                                                                                 \
    const char* _u = g_uniform((const char*)((BASE) + ((long)(br) * (LD) + (long)(kt) * G_BK)));       \
    __builtin_amdgcn_global_load_lds((const unsigned*)(_u + soff_b),                                   \
        (__attribute__((address_space(3))) unsigned*)((char*)(P) + ldst), 16, 0, 0);                   \
    __builtin_amdgcn_global_load_lds((const unsigned*)(_u + 128 * (long)(LD) + soff_b),                \
        (__attribute__((address_space(3))) unsigned*)((char*)(P) + ldst + 8192), 16, 0, 0);            \
  } while (0)
#define G_LDA(dst, b, h) for (int m = 0; m < 4; ++m) for (int k = 0; k < 2; ++k) \
    dst[m][k] = *reinterpret_cast<const bf16x8*>((char*)G_SA(b, h) + a_rd + m * 2048 + k * 1024)
#define G_LDB(dst, b, h) for (int n = 0; n < 2; ++n) for (int k = 0; k < 2; ++k) \
    dst[n][k] = *reinterpret_cast<const bf16x8*>((char*)G_SB(b, h) + b_rd + n * 2048 + k * 1024)
#define G_MMA(ai, bj, At, Bt_)                                                                         \
  do {                                                                                                 \
    __builtin_amdgcn_s_setprio(1);                                                                     \
    for (int m = 0; m < 4; ++m) for (int n = 0; n < 2; ++n) for (int k = 0; k < 2; ++k)                \
      acc[ai][bj][m][n] = __builtin_amdgcn_mfma_f32_16x16x32_bf16(At[m][k], Bt_[n][k], acc[ai][bj][m][n], 0, 0, 0); \
    __builtin_amdgcn_s_setprio(0);                                                                     \
  } while (0)
#define G_WAIT_V(n) asm volatile("s_waitcnt vmcnt(" #n ")" ::: "memory")
#define G_WAIT_L(n) asm volatile("s_waitcnt lgkmcnt(" #n ")" ::: "memory")
#define G_BAR __builtin_amdgcn_s_barrier()
#define G_SCHED __builtin_amdgcn_sched_barrier(0)
  int t512 = threadIdx.x; asm volatile("" : "+v"(t512));
  const int wid = __builtin_amdgcn_readfirstlane(t512 >> 6), lane = t512 & 63, wr = wid >> 2, wc = wid & 3, fr = lane & 15, fq = lane >> 4;
  const int ldst = t512 * 16;
  unsigned soff_b;
  {
    int R0, C0;
    g_stage_rc(ldst, R0, C0);
    soff_b = (unsigned)(R0 * lda + C0) * 2u;
  }
  const int lane_off = (fr * 64 + fq * 16) ^ ((fr >> 3) << 5);
  const int a_rd = wr * 8192 + lane_off, b_rd = wc * 4096 + lane_off;
  bf16x8 At[4][2], B0[2][2], B1[2][2];
  const int nt = K / G_BK;
  G_STAGE(G_SB(0, 0), Bt, ldb, bcol, 0); G_STAGE(G_SA(0, 0), A, lda, brow, 0);
  G_STAGE(G_SB(0, 1), Bt, ldb, bcol + G_HALF, 0); G_STAGE(G_SA(0, 1), A, lda, brow + G_HALF, 0);
  if (wr == 1) G_BAR;
  G_WAIT_V(4); G_BAR;
  G_STAGE(G_SB(1, 0), Bt, ldb, bcol, 1); G_STAGE(G_SA(1, 0), A, lda, brow, 1); G_STAGE(G_SB(1, 1), Bt, ldb, bcol + G_HALF, 1);
  G_WAIT_V(6); G_BAR;
#pragma unroll 1
  for (int t = 0; t < nt - 2; t += 2) {
    G_LDB(B0, 0, 0); G_SCHED; G_LDA(At, 0, 0); G_STAGE(G_SA(1, 1), A, lda, brow + G_HALF, t + 1);
    G_WAIT_L(8); G_BAR; G_WAIT_L(0); G_MMA(0, 0, At, B0); G_BAR; G_SCHED;
    G_LDB(B1, 0, 1); G_STAGE(G_SB(0, 0), Bt, ldb, bcol, t + 2);
    G_BAR; G_WAIT_L(0); G_MMA(0, 1, At, B1); G_BAR;
    G_LDA(At, 0, 1); G_STAGE(G_SA(0, 0), A, lda, brow, t + 2);
    G_BAR; G_WAIT_L(0); G_MMA(1, 0, At, B0); G_BAR; G_SCHED;
    G_STAGE(G_SB(0, 1), Bt, ldb, bcol + G_HALF, t + 2);
    G_WAIT_V(6); G_BAR; G_MMA(1, 1, At, B1); G_BAR;
    G_LDB(B0, 1, 0); G_SCHED; G_LDA(At, 1, 0); G_STAGE(G_SA(0, 1), A, lda, brow + G_HALF, t + 2);
    G_WAIT_L(8); G_BAR; G_WAIT_L(0); G_MMA(0, 0, At, B0); G_BAR; G_SCHED;
    G_LDB(B1, 1, 1); G_STAGE(G_SB(1, 0), Bt, ldb, bcol, t + 3);
    G_BAR; G_WAIT_L(0); G_MMA(0, 1, At, B1); G_BAR;
    G_LDA(At, 1, 1); G_STAGE(G_SA(1, 0), A, lda, brow, t + 3);
    G_BAR; G_WAIT_L(0); G_MMA(1, 0, At, B0); G_BAR; G_SCHED;
    G_STAGE(G_SB(1, 1), Bt, ldb, bcol + G_HALF, t + 3);
    G_WAIT_V(6); G_BAR; G_MMA(1, 1, At, B1); G_BAR;
  }
  { G_LDB(B0, 0, 0); G_LDA(At, 0, 0); G_STAGE(G_SA(1, 1), A, lda, brow + G_HALF, nt - 1);
    G_BAR; G_WAIT_L(0); G_MMA(0, 0, At, B0); G_BAR;
    G_LDB(B1, 0, 1); G_BAR; G_WAIT_L(0); G_MMA(0, 1, At, B1); G_BAR;
    G_LDA(At, 0, 1); G_WAIT_V(4); G_BAR; G_WAIT_L(0); G_MMA(1, 0, At, B0); G_MMA(1, 1, At, B1); G_BAR; }
  { G_LDB(B0, 1, 0); G_LDA(At, 1, 0); G_WAIT_V(2); G_BAR; G_WAIT_L(0); G_MMA(0, 0, At, B0); G_BAR;
    G_LDB(B1, 1, 1); G_WAIT_V(0); G_BAR; G_WAIT_L(0); G_MMA(0, 1, At, B1); G_BAR;
    G_LDA(At, 1, 1); G_BAR; G_WAIT_L(0); G_MMA(1, 0, At, B0); G_MMA(1, 1, At, B1); G_BAR; }
  if (wr == 0) G_BAR;
}
DI void acc256_zero(f32x4 (&acc)[2][2][4][2]) {
#pragma unroll
  for (int a = 0; a < 2; ++a)
#pragma unroll
    for (int b = 0; b < 2; ++b)
#pragma unroll
      for (int m = 0; m < 4; ++m)
#pragma unroll
        for (int n = 0; n < 2; ++n) acc[a][b][m][n] = (f32x4){0.f, 0.f, 0.f, 0.f};
}
#define EPI_NOPRE
#define EPI256P(PRE, ...)                                                                              \
  {                                                                                                    \
    int t512_ = threadIdx.x; asm volatile("" : "+v"(t512_));     \
    const int wid_ = t512_ >> 6, lane_ = t512_ & 63, wr_ = wid_ >> 2, wc_ = wid_ & 3,                  \
              fr_ = lane_ & 15, fq_ = lane_ >> 4;                                                      \
    float* sf_ = (float*)smem;                                                                         \
    _Pragma("unroll") for (int ai_ = 0; ai_ < 2; ++ai_) {                                              \
      _Pragma("unroll") for (int it_ = 0; it_ < 8; ++it_) {     \
        const int idx_ = t512_ + 512 * it_;                                                            \
        const int rl_ = idx_ >> 5, c0 = (idx_ & 31) * 8;                                               \
        const int row = ai_ * 128 + rl_;                                                               \
        (void)rl_; (void)c0; (void)row;                                                                \
        PRE                                                                                            \
      }                                                                                                \
      __builtin_amdgcn_sched_barrier(0);              \
      __syncthreads();                                                                                 \
      _Pragma("unroll") for (int bj_ = 0; bj_ < 2; ++bj_)                                              \
      _Pragma("unroll") for (int m_ = 0; m_ < 4; ++m_)                                                 \
      _Pragma("unroll") for (int n_ = 0; n_ < 2; ++n_)                                                 \
      _Pragma("unroll") for (int j_ = 0; j_ < 4; ++j_)                                                 \
        sf_[(wr_ * 64 + m_ * 16 + fq_ * 4 + j_) * 256 + ((bj_ * 128 + wc_ * 32 + n_ * 16 + fr_) ^ (fq_ << 4))] = \
            acc[ai_][bj_][m_][n_][j_];                                                                 \
      __syncthreads();                                                                                 \
      _Pragma("unroll") for (int it_ = 0; it_ < 8; ++it_) {                                            \
        const int idx_ = t512_ + 512 * it_;                                                            \
        const int rl_ = idx_ >> 5, c0 = (idx_ & 31) * 8;                                               \
        const int row = ai_ * 128 + rl_;                                                               \
        float v[8];                                                                                    \
        {                                                                                              \
          const float* sp_ = sf_ + rl_ * 256 + (c0 ^ (((rl_ >> 2) & 3) << 4));                          \
          const float4 t0 = *(const float4*)sp_; const float4 t1 = *(const float4*)(sp_ + 4);          \
          v[0] = t0.x; v[1] = t0.y; v[2] = t0.z; v[3] = t0.w;                                          \
          v[4] = t1.x; v[5] = t1.y; v[6] = t1.z; v[7] = t1.w;                                          \
        }                                                                                              \
        __VA_ARGS__                                                                                    \
      }                                                                                                \
    }                                                                                                  \
    __syncthreads();                                                                                   \
  }
#define EPI256(...) EPI256P(EPI_NOPRE, __VA_ARGS__)

template <int MT, int NT, int BH>
DI bool xcd_tile(int iter, int& mt, int& nt) {
  constexpr int MPX = MT / 8, TPX = MPX * NT;
  const int xcd = VXCD, j = VJ, nloc = VNLOC;
  const int q = j + iter * nloc;
  if (q >= TPX) return false;
  const int band = q / (BH * NT), r = q % (BH * NT);
  nt = r / BH;
  mt = xcd * MPX + band * BH + (r % BH);
  return true;
}

DI bool tile256(int iter, int NT, int& mt, int& nt) {
  const int xcd = blockIdx.x & 7, j = blockIdx.x >> 3, nloc = gridDim.x >> 3;
  const int q = j + iter * nloc;
  if (q >= 6 * NT) return false;
  nt = q / 6; mt = xcd * 6 + q % 6;
  return true;
}
DI void phase_gemm_in(const Params& p, int l, char* smem) {
  const bfu* W = p.w_inT + (size_t)l * DINP * LDH;
  for (int iter = 0;; ++iter) {
    int mt, nt;
    if (!tile256(iter, 19, mt, nt)) break;
    f32x4 acc[2][2][4][2];
    acc256_zero(acc);
    gemm256(p.h, LDH, W, LDH, 1024, mt * 256, nt * 256, (bfu*)smem, acc);
    const int m0 = mt * 256, n0 = nt * 256;
    EPI256({
      const int n = n0 + c0;
      if (n < 512) *(uint4*)(p.ug + ((size_t)(n >> 4) * NTOK + (m0 + row)) * 16 + (n & 15)) = pack8(v);
      else if (n < DIN) *(uint4*)(p.proj + (size_t)(m0 + row) * PW + (n - 512)) = pack8(v);
    })
  }
}

DI void s5_gen_item(const Params& p, int l, int item, char* smem) {
  const int tid = tid_();
  const int g = item >> 3, r = item & 7;
  float* sBr = (float*)smem;
  float* sBi = sBr + 2048;
  float* sCr = sBi + 2048;
  float* sCi = sCr + 1024;
  float* sAK = sCi + 1024;
  float* sAE = sAK + 1024;
  float* sAG = sAE + 1024;
  float* sK = sAG + 1024;
  bfu* E = p.opE + (size_t)g * 256 * 512;
  bfu* MG = p.opMG + (size_t)g * 512 * 768;
  __syncthreads();
  if (tid < 128) {
    const int d = tid >> 6, pp = tid & 63;
    const size_t pi = ((size_t)(l * 2 + d) * 32 + g) * 64 + pp;
    const float lr = p.lam_re[pi], li = p.lam_im[pi];
    const float dt = expf(p.log_dt[(l * 2 + d) * 32 + g]);
    const float mag = expf(lr * dt);
    float sn, cs;
    sincosf(li * dt, &sn, &cs);
    const float are = mag * cs, aim = mag * sn;
    const float nr = are - 1.f, ni = aim, den = lr * lr + li * li;
    const float kr = (nr * lr + ni * li) / den, ki = (ni * lr - nr * li) / den;
#pragma unroll
    for (int c = 0; c < 16; ++c) {
      float br = p.b_re[((size_t)(l * 32 + g) * 64 + pp) * 16 + c];
      float bi = p.b_im[((size_t)(l * 32 + g) * 64 + pp) * 16 + c];
      sBr[(d * 64 + pp) * 16 + c] = kr * br - ki * bi;
      sBi[(d * 64 + pp) * 16 + c] = kr * bi + ki * br;
    }
#pragma unroll
    for (int q = 0; q < 4; ++q) {
      const int t = 4 * r + q;
      const int nK = t;
      const int nE = d == 0 ? 31 - t : t;
      const int nG = d == 0 ? t + 1 : 32 - t;
      const float er = lr * dt * 1.44269504f, rv = li * dt * 0.15915494f;
      float m, s_, c_, fr_;
      m = exp2f_(er * (float)nK); fr_ = rv * (float)nK; fr_ -= floorf(fr_);
      s_ = __builtin_amdgcn_sinf(fr_); c_ = __builtin_amdgcn_cosf(fr_);
      sAK[((d * 4 + q) * 64 + pp) * 2] = m * c_; sAK[((d * 4 + q) * 64 + pp) * 2 + 1] = m * s_;
      m = exp2f_(er * (float)nE); fr_ = rv * (float)nE; fr_ -= floorf(fr_);
      s_ = __builtin_amdgcn_sinf(fr_); c_ = __builtin_amdgcn_cosf(fr_);
      sAE[((d * 4 + q) * 64 + pp) * 2] = m * c_; sAE[((d * 4 + q) * 64 + pp) * 2 + 1] = m * s_;
      m = exp2f_(er * (float)nG); fr_ = rv * (float)nG; fr_ -= floorf(fr_);
      s_ = __builtin_amdgcn_sinf(fr_); c_ = __builtin_amdgcn_cosf(fr_);
      sAG[((d * 4 + q) * 64 + pp) * 2] = m * c_; sAG[((d * 4 + q) * 64 + pp) * 2 + 1] = m * s_;
    }
  } else {
    for (int idx = tid - 128; idx < 1024; idx += 128) {
      sCr[idx] = p.c_re[(size_t)(l * 32 + g) * 1024 + idx];
      sCi[idx] = p.c_im[(size_t)(l * 32 + g) * 1024 + idx];
    }
  }
  __syncthreads();
#pragma unroll 1
  for (int i = 0; i < 4; ++i) {
    const int idx = tid + 256 * i;
    const int row = idx >> 2, q = idx & 3;
    const int part = row >> 6, pp = row & 63, d = part >> 1;
    const float ar = sAE[((d * 4 + q) * 64 + pp) * 2], ai = sAE[((d * 4 + q) * 64 + pp) * 2 + 1];
    const float* br = sBr + (d * 64 + pp) * 16;
    const float* bi = sBi + (d * 64 + pp) * 16;
    float v[16];
#pragma unroll
    for (int c = 0; c < 16; ++c) v[c] = (part & 1) ? (ar * bi[c] + ai * br[c]) : (ar * br[c] - ai * bi[c]);
    bfu* dp = E + (size_t)row * 512 + (4 * r + q) * 16;
    *(uint4*)dp = pack8(*(float(*)[8])&v[0]);
    *(uint4*)(dp + 8) = pack8(*(float(*)[8])&v[8]);
  }
#pragma unroll 1
  for (int i = 0; i < 8; ++i) {
    const int idx = tid + 256 * i;
    const int rr = idx >> 5, cg = idx & 31, q = rr >> 4, c = rr & 15;
    const int part = cg >> 3, pp0 = (cg & 7) * 8, d = part >> 1;
    const float* ag = sAG + ((d * 4 + q) * 64 + pp0) * 2;
    const float* cr = sCr + c * 64 + pp0;
    const float* ci = sCi + c * 64 + pp0;
    float v[8];
#pragma unroll
    for (int e = 0; e < 8; ++e) {
      const float ar = ag[2 * e], ai = ag[2 * e + 1];
      v[e] = (part & 1) ? -(cr[e] * ai + ci[e] * ar) : (cr[e] * ar - ci[e] * ai);
    }
    *(uint4*)(MG + (size_t)((4 * r + q) * 16 + c) * 768 + 512 + cg * 8) = pack8(v);
  }
  {
    const int d = tid >> 7, q = (tid >> 5) & 3, c = (tid >> 1) & 15, ch = tid & 1;
    float acc[8];
#pragma unroll
    for (int e = 0; e < 8; ++e) acc[e] = 0.f;
    for (int pp = 0; pp < 64; ++pp) {
      const float ar = sAK[((d * 4 + q) * 64 + pp) * 2], ai = sAK[((d * 4 + q) * 64 + pp) * 2 + 1];
      const float cr = sCr[c * 64 + pp], ci = sCi[c * 64 + pp];
      const float wr = cr * ar - ci * ai, wi = cr * ai + ci * ar;
#pragma unroll
      for (int e = 0; e < 8; ++e)
        acc[e] += wr * sBr[(d * 64 + pp) * 16 + ch * 8 + e] - wi * sBi[(d * 64 + pp) * 16 + ch * 8 + e];
    }
#pragma unroll
    for (int e = 0; e < 8; ++e) sK[((d * 4 + q) * 16 + c) * 16 + ch * 8 + e] = acc[e];
  }
  __syncthreads();
  for (int idx = tid; idx < 8192; idx += 256) {
    const int ch = idx & 1, c = (idx >> 1) & 15, tp = (idx >> 5) & 31, q = (idx >> 10) & 3, d = idx >> 12;
    const int tau = 4 * r + q;
    int sp;
    bool valid;
    if (d == 0) { sp = tp - tau; valid = sp >= 0; } else { sp = tp + tau; valid = (sp <= 31) && (tau > 0); }
    if (valid) {
      float v[8];
#pragma unroll
      for (int e = 0; e < 8; ++e) {
        float x = sK[((d * 4 + q) * 16 + c) * 16 + ch * 8 + e];
        if (tau == 0) x += sK[((1 * 4 + q) * 16 + c) * 16 + ch * 8 + e];
        v[e] = x;
      }
      *(uint4*)(MG + (size_t)(tp * 16 + c) * 768 + sp * 16 + ch * 8) = pack8(v);
    }
  }
  __syncthreads();
}

DI void phase_s5_gen(const Params& p, int l, char* smem) {
  for (int it = NVB - 1 - VBID; it < 256; it += NVB) s5_gen_item(p, l, it, smem);
}

DI void phase_s5_e(const Params& p, char* smem) {
  for (int q = VJ; q < 24; q += VNLOC) {
    const int g = VXCD * 4 + q / 6, r6 = q % 6, mt = r6 >> 1, nt = r6 & 1;
    f32x16 acc[2][2];
    acc_zero(acc);
    gemm_core(p.ug + ((size_t)g * NCHUNK + mt * 128) * 512, 512, p.opE + ((size_t)g * 256 + nt * 128) * 512, 512, 512,
              smem, acc, p.ug, 512, 0);
    EPI_LDS({
      float* dst = p.ebuf + ((size_t)g * NCHUNK + mt * 128 + row) * 256 + nt * 128 + c0;
      *(float4*)dst = make_float4(v[0], v[1], v[2], v[3]);
      *(float4*)(dst + 4) = make_float4(v[4], v[5], v[6], v[7]);
    })
  }
}

DI void phase_s5_scan(const Params& p, int l) {
  const int tid = tid_();
  for (int it = VBID; it < 320; it += NVB) {
    const int wi = it * 2 + (tid >> 7);
    const int dir = (tid >> 6) & 1, pp = tid & 63;
    int chunk0, n, b, g;
    bool prompt;
    if (wi < 128) { b = wi >> 5; g = wi & 31; chunk0 = (NPROMPT + b * 2048) >> 5; n = 64; prompt = false; }
    else { int q = wi - 128; b = q >> 5; g = q & 31; chunk0 = (b * 256) >> 5; n = 8; prompt = true; }
    const size_t pi = ((size_t)(l * 2 + dir) * 32 + g) * 64 + pp;
    const float lr = p.lam_re[pi], li = p.lam_im[pi];
    const float dt = expf(p.log_dt[(l * 2 + dir) * 32 + g]);
    const float mag = expf(lr * dt * 32.f);
    float sn, cs;
    sincosf(li * dt * 32.f, &sn, &cs);
    const float are = mag * cs, aim = mag * sn;
    float hre = 0.f, him = 0.f;
    if (!prompt) {
      size_t si = ((size_t)((b * 2 + l) * 2 + dir)) * 2048 + g * 64 + pp;
      hre = p.st_re[si]; him = p.st_im[si];
    }
    const float* eb = p.ebuf + ((size_t)g * NCHUNK + chunk0) * 256 + dir * 128 + pp;
    bfu* cb = p.carry + ((size_t)g * NCHUNK + chunk0) * 256 + dir * 128 + pp;
    for (int k0 = 0; k0 < n; k0 += 8) {
      float er[8], ei[8];
#pragma unroll
      for (int j = 0; j < 8; ++j) {
        const int k = dir == 0 ? k0 + j : n - 1 - (k0 + j);
        er[j] = eb[(size_t)k * 256];
        ei[j] = eb[(size_t)k * 256 + 64];
      }
#pragma unroll
      for (int j = 0; j < 8; ++j) {
        const int k = dir == 0 ? k0 + j : n - 1 - (k0 + j);
        cb[(size_t)k * 256] = f2bf(hre);
        cb[(size_t)k * 256 + 64] = f2bf(him);
        const float nre = are * hre - aim * him + er[j];
        const float nim = are * him + aim * hre + ei[j];
        hre = nre; him = nim;
      }
    }
    if (prompt) {
      size_t oi = ((size_t)((b * 2 + l) * 2 + dir)) * 2048 + g * 64 + pp;
      p.out[OUT_RE + oi] = hre;
      p.out[OUT_IM + oi] = him;
    }
  }
}

DI void phase_s5_y(const Params& p, int l, char* smem) {
  for (int q = VJ; q < 48; q += VNLOC) {
    const int g = VXCD * 4 + q / 12, r12 = q % 12, mt = r12 >> 2, nt = r12 & 3;
    f32x16 acc[2][2];
    acc_zero(acc);
    const bfu* Bm = p.opMG + ((size_t)g * 512 + nt * 128) * 768;
    gemm_core(p.ug + ((size_t)g * NCHUNK + mt * 128) * 512, 512, Bm, 768, 512, smem, acc,
              p.carry + ((size_t)g * NCHUNK + mt * 128) * 256, 256, 256);
    EPI_LDS({
      const int chunk = mt * 128 + row, nn = nt * 128 + c0, tp = nn >> 4, c = nn & 15;
      const int tok = chunk * 32 + tp;
      float u[8], o[8];
      unpack8(*(const uint4*)(p.ug + ((size_t)g * NTOK + tok) * 16 + c), u);
      const float* dsk = p.s5_d + l * 512 + g * 16 + c;
      _Pragma("unroll") for (int e = 0; e < 8; ++e) o[e] = geluf_(v[e] + dsk[e] * u[e]);
      *(uint4*)(p.ys5 + (size_t)tok * 512 + g * 16 + c) = pack8(o);
    })
  }
}

DI void phase_glu(const Params& p, int l, char* smem) {
  const bfu* W = p.w_gluT + (size_t)l * 512 * 512;
  for (int iter = 0;; ++iter) {
    int mt, nt;
    if (!xcd_tile<96, 4, 12>(iter, mt, nt)) break;
    f32x16 acc[2][2];
    acc_zero(acc);
    gemm_core(p.ys5 + (size_t)mt * 128 * 512, 512, W + (size_t)nt * 128 * 512, 512, 512, smem, acc, p.ys5, 512, 0);
    const int m0 = mt * 128, n0 = nt * 128;
    EPI_LDS({
      const int n = n0 + c0;
      const size_t tk = (size_t)(m0 + row);
      float y[8], ga[8], o[8];
      unpack8(*(const uint4*)(p.ys5 + tk * 512 + n), y);
      unpack8(*(const uint4*)(p.proj + tk * PW + OFF_GA + n), ga);
      const float* bg = p.b_glu + l * 512 + n;
      _Pragma("unroll") for (int e = 0; e < 8; ++e) o[e] = y[e] * sigmoidf_(v[e] + bg[e]) * siluf_(ga[e]);
      *(uint4*)(p.ya + tk * 512 + n) = pack8(o);
    })
  }
}

constexpr int GL_QS = 0;
constexpr int GL_KS = GL_QS + 32 * 144;
constexpr int GL_KHT = GL_KS + 32 * 144;
constexpr int GL_VT = GL_KHT + 64 * 80;
constexpr int GL_PS = GL_VT + 128 * 80;
constexpr int GL_ST = GL_PS + 32 * 80;
constexpr int GL_AV = GL_ST + 128 * 144;
constexpr int GL_TOT = GL_AV + 256;
constexpr int GL_OS = GL_TOT + 1024;
static_assert(GL_OS + 32 * 132 * 4 <= 65536, "gla lds");

DI void gla_segment_info(int seg, int& tok_base, bool& prompt, int& b, int& sidx) {
  if (seg < 16) { prompt = true; b = seg; sidx = 0; tok_base = seg * 256; }
  else { int q = seg - 16; prompt = false; b = q >> 3; sidx = q & 7; tok_base = NPROMPT + b * 2048 + sidx * 256; }
}

template <bool STATE_ONLY>
DI void gla_chain(const Params& p, int l, char* smem, int seg, int hd, int dir) {
  const int tid = tid_(), lane = tid & 63, w = tid >> 6;
  const int fr = lane & 31, hh = lane >> 5;
  int tok_base, b, sidx;
  bool prompt;
  gla_segment_info(seg, tok_base, prompt, b, sidx);
  const int dk = tid & 63, tq = tid >> 6;
  const int dvl = tid & 127, th = tid >> 7;
  const int jw = w & 1, thw = w >> 1, dkm = 32 * jw + fr;
  bf16x8 wgB;
  {
    unsigned wp[4];
#pragma unroll
    for (int e = 0; e < 4; ++e) {
      const float w0 = p.wg_up[((size_t)(l * 2 + dir) * 16 + 8 * hh + 2 * e) * 256 + hd * 64 + dkm];
      const float w1 = p.wg_up[((size_t)(l * 2 + dir) * 16 + 8 * hh + 2 * e + 1) * 256 + hd * 64 + dkm];
      wp[e] = pack2(w0, w1);
    }
    wgB = __builtin_bit_cast(bf16x8, make_uint4(wp[0], wp[1], wp[2], wp[3]));
  }
  const float bgv = p.bg[(l * 2 + dir) * 256 + hd * 64 + dkm];
  float* sAv = (float*)(smem + GL_AV);
  float* sTot = (float*)(smem + GL_TOT);
  float* sOs = (float*)(smem + GL_OS);

  f32x16 S[2];
  {
    const int dvc = 32 * w + fr;
    if (STATE_ONLY || prompt) {
#pragma unroll
      for (int mt = 0; mt < 2; ++mt)
#pragma unroll
        for (int r = 0; r < 16; ++r) S[mt][r] = 0.f;
    } else {
      const float* sp = p.st_gla + ((size_t)(((b * 2 + l) * 2 + dir) * 4 + hd)) * 8192;
#pragma unroll
      for (int mt = 0; mt < 2; ++mt)
#pragma unroll
        for (int r = 0; r < 16; ++r) S[mt][r] = sp[(32 * mt + (r & 3) + 8 * (r >> 2) + 4 * hh) * 128 + dvc];
      const int nprev = dir == 0 ? sidx : 7 - sidx;
      if (nprev > 0) {
        f32x16 cs[2], ns[2];
        float4 ca[8], na[8];
#define GLA_SEG_LOAD(SS, AA, qq)                                                                       \
        {                                                                                              \
          const int sprev_ = dir == 0 ? (qq) : 7 - (qq);                                               \
          const size_t ci_ = (size_t)(((b * 8 + sprev_) * 4 + hd) * 2 + dir);                          \
          const float* sl_ = p.gla_sloc + ci_ * 8192 + dvc;                                            \
          const float* al_ = p.gla_aseg + ci_ * 64 + 4 * hh;                                           \
          _Pragma("unroll") for (int mt = 0; mt < 2; ++mt)                                             \
          _Pragma("unroll") for (int r = 0; r < 16; ++r)                                               \
            SS[mt][r] = sl_[(32 * mt + (r & 3) + 8 * (r >> 2) + 4 * hh) * 128];                        \
          _Pragma("unroll") for (int i = 0; i < 8; ++i) AA[i] = *(const float4*)(al_ + 8 * i);         \
        }
        GLA_SEG_LOAD(cs, ca, 0)
#pragma unroll 1
        for (int q = 0; q < nprev; ++q) {
          if (q + 1 < nprev) GLA_SEG_LOAD(ns, na, q + 1)
#pragma unroll
          for (int mt = 0; mt < 2; ++mt)
#pragma unroll
            for (int qq = 0; qq < 4; ++qq) {
              const float4 av = ca[mt * 4 + qq];
              S[mt][4 * qq + 0] = av.x * S[mt][4 * qq + 0] + cs[mt][4 * qq + 0];
              S[mt][4 * qq + 1] = av.y * S[mt][4 * qq + 1] + cs[mt][4 * qq + 1];
              S[mt][4 * qq + 2] = av.z * S[mt][4 * qq + 2] + cs[mt][4 * qq + 2];
              S[mt][4 * qq + 3] = av.w * S[mt][4 * qq + 3] + cs[mt][4 * qq + 3];
            }
          cs[0] = ns[0]; cs[1] = ns[1];
#pragma unroll
          for (int i = 0; i < 8; ++i) ca[i] = na[i];
        }
      }
    }
  }
  float bsum = 0.f;
  __syncthreads();
  if (!STATE_ONLY) {
    const int dvc = 32 * w + fr;
#pragma unroll
    for (int mt = 0; mt < 2; ++mt)
#pragma unroll
      for (int q = 0; q < 4; ++q) {
        uint2 pk;
        pk.x = pack2(S[mt][4 * q], S[mt][4 * q + 1]);
        pk.y = pack2(S[mt][4 * q + 2], S[mt][4 * q + 3]);
        *(uint2*)(smem + GL_ST + dvc * 144 + (32 * mt + 8 * q + 4 * hh) * 2) = pk;
      }
  }

  uint4 rq = make_uint4(0, 0, 0, 0), rk = rq, rv0 = rq, rv1 = rq, rgl = rq;
#define GLA_ISSUE(nn)                                                                                         \
  {                                                                                                           \
    const int cn_ = dir == 0 ? (nn) : 7 - (nn);                                                               \
    const int c0_ = tok_base + cn_ * 32;                                                                      \
    const int tA = dir == 0 ? (tid >> 3) : 31 - (tid >> 3);                                                   \
    const bfu* prA = p.proj + (size_t)(c0_ + tA) * PW + hd * 64 + (tid & 7) * 8;                              \
    if (!STATE_ONLY) rq = *(const uint4*)(prA + OFF_Q);                                                       \
    rk = *(const uint4*)(prA + OFF_K);                                                                        \
    const int tV0 = dir == 0 ? (tid >> 4) : 31 - (tid >> 4);                                                  \
    const int tV1 = dir == 0 ? (tid >> 4) + 16 : 15 - (tid >> 4);                                             \
    rv0 = *(const uint4*)(p.proj + (size_t)(c0_ + tV0) * PW + OFF_V + hd * 128 + (tid & 15) * 8);             \
    rv1 = *(const uint4*)(p.proj + (size_t)(c0_ + tV1) * PW + OFF_V + hd * 128 + (tid & 15) * 8);             \
    if (tid < 64) {                                                                                           \
      const int tG = dir == 0 ? (tid >> 1) : 31 - (tid >> 1);                                                 \
      rgl = *(const uint4*)(p.proj + (size_t)(c0_ + tG) * PW + OFF_GL + (tid & 1) * 8);                       \
    }                                                                                                         \
  }
  GLA_ISSUE(0)
  char* rawQ = smem + GL_OS;
  char* rawK = smem + GL_OS + 4096;
  char* rawV = smem + GL_OS + 8192;
  char* rawG = smem + GL_PS;

#pragma unroll 1
  for (int n = 0; n < 8; ++n) {
    const int cn = dir == 0 ? n : 7 - n;
    const int ctok0 = tok_base + cn * 32;
    __syncthreads();
    if (!STATE_ONLY) *(uint4*)(rawQ + (tid >> 3) * 128 + (tid & 7) * 16) = rq;
    *(uint4*)(rawK + (tid >> 3) * 128 + (tid & 7) * 16) = rk;
    *(uint4*)(rawV + (tid >> 4) * 256 + (tid & 15) * 16) = rv0;
    *(uint4*)(rawV + ((tid >> 4) + 16) * 256 + (tid & 15) * 16) = rv1;
    if (tid < 64) *(uint4*)(rawG + (tid >> 1) * 32 + (tid & 1) * 16) = rgl;
    if (n + 1 < 8) GLA_ISSUE(n + 1)
    __syncthreads();
    {
      f32x16 lg;
#pragma unroll
      for (int r = 0; r < 16; ++r) lg[r] = 0.f;
      const bf16x8 ga = *(const bf16x8*)(rawG + fr * 32 + hh * 16);
      lg = __builtin_amdgcn_mfma_f32_32x32x16_bf16(ga, wgB, lg, 0, 0, 0);
      float ls[16], gsum[4], psum[4];
#pragma unroll
      for (int r = 0; r < 16; ++r) {
        const float x = lg[r] + bgv;
        ls[r] = logsigmoidf_(x) * (1.f / 16.f);
      }
#pragma unroll
      for (int q = 0; q < 4; ++q) {
        gsum[q] = ls[4 * q] + ls[4 * q + 1] + ls[4 * q + 2] + ls[4 * q + 3];
        psum[q] = __shfl_xor(gsum[q], 32);
      }
      float off[4], run = 0.f;
#pragma unroll
      for (int q = 0; q < 4; ++q) {
        off[q] = run + (hh ? psum[q] : 0.f);
        run += gsum[q] + psum[q];
      }
      const float total = run;
#pragma unroll
      for (int qq = 0; qq < 2; ++qq) {
        float khv[4];
        float acc_b = 0.f;
#pragma unroll
        for (int i = 0; i < 4; ++i) {
          const float lsv = thw == 0 ? ls[4 * qq + i] : ls[8 + 4 * qq + i];
          const float offv = thw == 0 ? off[qq] : off[2 + qq];
          acc_b += lsv;
          const float bb = offv + acc_b;
          const int tau = 16 * thw + 8 * qq + 4 * hh + i;
          const float kvv = bf2f(*(const bfu*)(rawK + tau * 128 + dkm * 2));
          if (!STATE_ONLY) {
            const float qvv = bf2f(*(const bfu*)(rawQ + tau * 128 + dkm * 2)) * 0.125f;
            *(bfu*)(smem + GL_QS + tau * 144 + dkm * 2) = f2bf(qvv * __expf(bb));
            *(bfu*)(smem + GL_KS + tau * 144 + dkm * 2) = f2bf(kvv * __expf(-bb));
          }
          khv[i] = kvv * __expf(total - bb);
        }
        uint2 kh; kh.x = pack2(khv[0], khv[1]); kh.y = pack2(khv[2], khv[3]);
        *(uint2*)(smem + GL_KHT + dkm * 80 + (16 * thw + 8 * qq + 4 * hh) * 2) = kh;
      }
      if (thw == 0 && hh == 0) { sAv[dkm] = __expf(total); bsum += total; }
    }
    {
      unsigned pk[8];
#pragma unroll
      for (int i = 0; i < 8; ++i) {
        const int tau0 = th * 16 + 2 * i;
        const unsigned lo = *(const bfu*)(rawV + tau0 * 256 + dvl * 2);
        const unsigned hi = *(const bfu*)(rawV + (tau0 + 1) * 256 + dvl * 2);
        pk[i] = lo | (hi << 16);
      }
      *(uint4*)(smem + GL_VT + dvl * 80 + th * 32) = make_uint4(pk[0], pk[1], pk[2], pk[3]);
      *(uint4*)(smem + GL_VT + dvl * 80 + th * 32 + 16) = make_uint4(pk[4], pk[5], pk[6], pk[7]);
    }
    __syncthreads();
    f32x16 o;
    if (!STATE_ONLY) {
      f32x16 sc;
#pragma unroll
      for (int r = 0; r < 16; ++r) sc[r] = 0.f;
#pragma unroll
      for (int s4 = 0; s4 < 4; ++s4) {
        bf16x8 a = *(const bf16x8*)(smem + GL_QS + fr * 144 + (16 * s4 + 8 * hh) * 2);
        bf16x8 bq = *(const bf16x8*)(smem + GL_KS + fr * 144 + (16 * s4 + 8 * hh) * 2);
        sc = __builtin_amdgcn_mfma_f32_32x32x16_bf16(a, bq, sc, 0, 0, 0);
      }
#pragma unroll
      for (int rr = 0; rr < 4; ++rr) {
        float val = w == 0 ? sc[rr] : (w == 1 ? sc[4 + rr] : (w == 2 ? sc[8 + rr] : sc[12 + rr]));
        const int i = rr + 8 * w + 4 * hh;
        val = (fr <= i) ? val : 0.f;
        *(bfu*)(smem + GL_PS + i * 80 + fr * 2) = f2bf(val);
      }
      __syncthreads();
#pragma unroll
      for (int r = 0; r < 16; ++r) o[r] = 0.f;
    }
    {
      const int dvc = 32 * w + fr;
      bf16x8 vb0 = *(const bf16x8*)(smem + GL_VT + dvc * 80 + (8 * hh) * 2);
      bf16x8 vb1 = *(const bf16x8*)(smem + GL_VT + dvc * 80 + (16 + 8 * hh) * 2);
      if (!STATE_ONLY) {
        bf16x8 pa0 = *(const bf16x8*)(smem + GL_PS + fr * 80 + (8 * hh) * 2);
        bf16x8 pa1 = *(const bf16x8*)(smem + GL_PS + fr * 80 + (16 + 8 * hh) * 2);
        o = __builtin_amdgcn_mfma_f32_32x32x16_bf16(pa0, vb0, o, 0, 0, 0);
        o = __builtin_amdgcn_mfma_f32_32x32x16_bf16(pa1, vb1, o, 0, 0, 0);
#pragma unroll
        for (int s4 = 0; s4 < 4; ++s4) {
          bf16x8 a = *(const bf16x8*)(smem + GL_QS + fr * 144 + (16 * s4 + 8 * hh) * 2);
          bf16x8 sb = *(const bf16x8*)(smem + GL_ST + dvc * 144 + (16 * s4 + 8 * hh) * 2);
          o = __builtin_amdgcn_mfma_f32_32x32x16_bf16(a, sb, o, 0, 0, 0);
        }
      }
#pragma unroll
      for (int mt = 0; mt < 2; ++mt) {
        f32x16 U;
#pragma unroll
        for (int r = 0; r < 16; ++r) U[r] = 0.f;
        bf16x8 ka0 = *(const bf16x8*)(smem + GL_KHT + (32 * mt + fr) * 80 + (8 * hh) * 2);
        bf16x8 ka1 = *(const bf16x8*)(smem + GL_KHT + (32 * mt + fr) * 80 + (16 + 8 * hh) * 2);
        U = __builtin_amdgcn_mfma_f32_32x32x16_bf16(ka0, vb0, U, 0, 0, 0);
        U = __builtin_amdgcn_mfma_f32_32x32x16_bf16(ka1, vb1, U, 0, 0, 0);
#pragma unroll
        for (int q = 0; q < 4; ++q) {
          const float4 av = *(const float4*)(sAv + 32 * mt + 8 * q + 4 * hh);
          S[mt][4 * q + 0] = av.x * S[mt][4 * q + 0] + U[4 * q + 0];
          S[mt][4 * q + 1] = av.y * S[mt][4 * q + 1] + U[4 * q + 1];
          S[mt][4 * q + 2] = av.z * S[mt][4 * q + 2] + U[4 * q + 2];
          S[mt][4 * q + 3] = av.w * S[mt][4 * q + 3] + U[4 * q + 3];
          if (!STATE_ONLY) {
            uint2 pk;
            pk.x = pack2(S[mt][4 * q], S[mt][4 * q + 1]);
            pk.y = pack2(S[mt][4 * q + 2], S[mt][4 * q + 3]);
            *(uint2*)(smem + GL_ST + dvc * 144 + (32 * mt + 8 * q + 4 * hh) * 2) = pk;
          }
        }
      }
      if (!STATE_ONLY) {
#pragma unroll
        for (int r = 0; r < 16; ++r) sOs[((r & 3) + 8 * (r >> 2) + 4 * hh) * 132 + dvc] = o[r];
      }
    }
    __syncthreads();
    if (!STATE_ONLY) {
      const int t = tid >> 3, part = tid & 7;
      const int tau = dir == 0 ? t : 31 - t;
      const size_t tok = (size_t)(ctok0 + t);
      float ov[16];
#pragma unroll
      for (int q = 0; q < 4; ++q) {
        const float4 x = *(const float4*)(sOs + tau * 132 + part * 16 + 4 * q);
        ov[4 * q] = x.x; ov[4 * q + 1] = x.y; ov[4 * q + 2] = x.z; ov[4 * q + 3] = x.w;
      }
      bfu* op = p.gla_o + ((size_t)dir * NTOK + tok) * 512 + hd * 128 + part * 16;
      *(uint4*)op = pack8(*(float(*)[8])&ov[0]);
      *(uint4*)(op + 8) = pack8(*(float(*)[8])&ov[8]);
    }
  }
  const int dvc = 32 * w + fr;
  if (STATE_ONLY) {
    const size_t ci = (size_t)(((b * 8 + sidx) * 4 + hd) * 2 + dir);
    float* sl = p.gla_sloc + ci * 8192;
#pragma unroll
    for (int mt = 0; mt < 2; ++mt)
#pragma unroll
      for (int r = 0; r < 16; ++r) sl[(32 * mt + (r & 3) + 8 * (r >> 2) + 4 * hh) * 128 + dvc] = S[mt][r];
    if (thw == 0 && hh == 0) p.gla_aseg[ci * 64 + dkm] = __expf(bsum);
  } else if (prompt) {
    float* op = p.out + OUT_GLA + ((size_t)(((b * 2 + l) * 2 + dir) * 4 + hd)) * 8192;
#pragma unroll
    for (int mt = 0; mt < 2; ++mt)
#pragma unroll
      for (int r = 0; r < 16; ++r) op[(32 * mt + (r & 3) + 8 * (r >> 2) + 4 * hh) * 128 + dvc] = S[mt][r];
  }
  __syncthreads();
}

DI void phase_gla_pass1(const Params& p, int l, char* smem) {
  for (int it = NVB - 1 - VBID; it < 256; it += NVB) {
    const int dir = it & 1, hd = (it >> 1) & 3, seg = 16 + (it >> 3);
    gla_chain<true>(p, l, smem, seg, hd, dir);
  }
}
DI void phase_gla_main(const Params& p, int l, char* smem) {
  for (int it = NVB - 1 - VBID; it < 384; it += NVB) {
    const int dir = it & 1, hd = (it >> 1) & 3, seg = it >> 3;
    gla_chain<false>(p, l, smem, seg, hd, dir);
  }
}
DI void phase_gla_norm(const Params& p, int l, int part) {
  const int tid = tid_(), lane = tid & 63, w = tid >> 6;
  const int ib = (VJ - 48) * 8 + VXCD;
  for (int it = part * (NTOK / 8) + (VJ >= 48 ? ib : NTOK); it < (part + 1) * (NTOK / 8); it += 128) {
    const int tok = it * 4 + w;
    float a[8], b[8], gt[8], res[8];
    unpack8(*(const uint4*)(p.gla_o + (size_t)tok * 512 + lane * 8), a);
    unpack8(*(const uint4*)(p.gla_o + ((size_t)NTOK + tok) * 512 + lane * 8), b);
    unpack8(*(const uint4*)(p.proj + (size_t)tok * PW + OFF_GB + lane * 8), gt);
    float ss = 0.f;
#pragma unroll
    for (int e = 0; e < 8; ++e) { a[e] += b[e]; ss += a[e] * a[e]; }
    ss += __shfl_xor(ss, 1); ss += __shfl_xor(ss, 2); ss += __shfl_xor(ss, 4); ss += __shfl_xor(ss, 8);
    const float rs = rsqrtf(ss * (1.f / 128.f) + EPS);
    const float* g = p.gla_norm_g + l * 512 + lane * 8;
#pragma unroll
    for (int e = 0; e < 8; ++e) res[e] = a[e] * rs * g[e] * siluf_(gt[e]);
    *(uint4*)(p.yb + (size_t)tok * 512 + lane * 8) = pack8(res);
  }
}

DI void phase_merge(const Params& p, int l, char* smem) {
  const bfu* WA = p.w_paT + (size_t)l * 1024 * 512;
  const bfu* WB = p.w_pbT + (size_t)l * 1024 * 512;
  for (int iter = 0;; ++iter) {
    int mt, nt;
    if (!tile256(iter, 4, mt, nt)) break;
    const int m0 = mt * 256, n0 = nt * 256;
    f32x4 acc[2][2][4][2];
    acc256_zero(acc);
    gemm256(p.ya, 512, WA, 512, 512, m0, n0, (bfu*)smem, acc);
    uint4 pg[8], pq[8];
#define MERGE_PRE1 pg[it_] = *(const uint4*)(p.proj + (size_t)(m0 + row) * PW + OFF_MA + n0 + c0);
#define MERGE_PRE2 pg[it_] = *(const uint4*)(p.proj + (size_t)(m0 + row) * PW + OFF_MB + n0 + c0); \
                   pq[it_] = *(const uint4*)(p.merged + (size_t)(m0 + row) * D + n0 + c0);
    EPI256P(MERGE_PRE1, {
      float ma[8], o[8];
      unpack8(pg[it_], ma);
      _Pragma("unroll") for (int e = 0; e < 8; ++e) o[e] = sigmoidf_(ma[e]) * v[e];
      *(uint4*)(p.merged + (size_t)(m0 + row) * D + n0 + c0) = pack8(o);
    })
    acc256_zero(acc);
    gemm256(p.yb, 512, WB, 512, 512, m0, n0, (bfu*)smem, acc);
    EPI256P(MERGE_PRE2, {
      float mb[8], o[8], pr[8];
      unpack8(pg[it_], mb);
      uint4* mp = (uint4*)(p.merged + (size_t)(m0 + row) * D + n0 + c0);
      unpack8(pq[it_], pr);
      _Pragma("unroll") for (int e = 0; e < 8; ++e) o[e] = pr[e] + sigmoidf_(mb[e]) * v[e];
      *mp = pack8(o);
    })
  }
}

DI void phase_out(const Params& p, int l, char* smem) {
  const bfu* W = p.w_oT + (size_t)l * 1024 * 1024;
  for (int iter = 0;; ++iter) {
    int mt, nt;
    if (!tile256(iter, 4, mt, nt)) break;
    const int m0 = mt * 256, n0 = nt * 256;
    f32x4 acc[2][2][4][2];
    acc256_zero(acc);
    gemm256(p.merged, D, W, 1024, 1024, m0, n0, (bfu*)smem, acc);
    const float* gate = p.mod + (size_t)(l * 5 + cond_of_tok(m0)) * 3072 + 2048;
    float4 px0[8], px1[8];
#define OUT_PRE px0[it_] = *(const float4*)(p.out + (size_t)(m0 + row) * D + n0 + c0); \
                px1[it_] = *(const float4*)(p.out + (size_t)(m0 + row) * D + n0 + c0 + 4);
    EPI256P(OUT_PRE, {
      float* xp = p.out + (size_t)(m0 + row) * D + n0 + c0;
      const float* gp = gate + n0 + c0;
      float4 x0 = px0[it_], x1 = px1[it_];
      float4 g0 = *(const float4*)gp, g1 = *(const float4*)(gp + 4);
      {
        const float4 h0 = *(const float4*)(gp + MODH), h1 = *(const float4*)(gp + MODH + 4);
        g0.x += h0.x; g0.y += h0.y; g0.z += h0.z; g0.w += h0.w;
        g1.x += h1.x; g1.y += h1.y; g1.z += h1.z; g1.w += h1.w;
      }
      x0.x += g0.x * v[0]; x0.y += g0.y * v[1]; x0.z += g0.z * v[2]; x0.w += g0.w * v[3];
      x1.x += g1.x * v[4]; x1.y += g1.y * v[5]; x1.z += g1.z * v[6]; x1.w += g1.w * v[7];
      *(float4*)xp = x0; *(float4*)(xp + 4) = x1;
    })
  }
}

DI void phase_final(const Params& p) {
  const int tid = tid_(), lane = tid & 63, w = tid >> 6;
  for (int it = VBID; it < NTOK / 4; it += NVB) {
    const int tok = it * 4 + w;
    float* xs = p.out + (size_t)tok * D;
    float4 v[4];
#pragma unroll
    for (int i = 0; i < 4; ++i) v[i] = *(const float4*)(xs + lane * 4 + 256 * i);
    float ss = 0.f;
#pragma unroll
    for (int i = 0; i < 4; ++i) ss += v[i].x * v[i].x + v[i].y * v[i].y + v[i].z * v[i].z + v[i].w * v[i].w;
    ss = wave_sum(ss);
    const float rstd = rsqrtf(ss * (1.f / 1024.f) + EPS);
#pragma unroll
    for (int i = 0; i < 4; ++i) {
      float4 g = *(const float4*)(p.final_g + lane * 4 + 256 * i);
      float4 o;
      o.x = v[i].x * rstd * g.x; o.y = v[i].y * rstd * g.y; o.z = v[i].z * rstd * g.z; o.w = v[i].w * rstd * g.w;
      *(float4*)(xs + lane * 4 + 256 * i) = o;
    }
  }
}

#define XB_TMO      128
#define XB_XCNT(j)  (256  + 64 * (j))
#define XB_XSUB(j)  (1280 + 64 * (j))
#define XB_XGEN(j)  (2304 + 64 * (j))
#define XB_TOP      3328
#define XB_TOPGEN   3392
#define XCD_BAR_WORDS 3456
#define XB_SPIN_CAP (1u << 18)
#define LAS __attribute__((address_space(3)))
DI unsigned xb_ld(unsigned* p) { return __hip_atomic_load(p, __ATOMIC_RELAXED, __HIP_MEMORY_SCOPE_AGENT); }
DI unsigned xb_add(unsigned* p, unsigned v) { return __hip_atomic_fetch_add(p, v, __ATOMIC_RELAXED, __HIP_MEMORY_SCOPE_AGENT); }
DI unsigned xb_xcc_id() { return (unsigned)__builtin_amdgcn_s_getreg((3 << 11) | 20) & 0xFu; }
#define XB_SPIN(cond, bar) do { unsigned _sp = 0; while (cond) { __builtin_amdgcn_s_sleep(1); \
    if ((++_sp & 255u) == 0u) { if (xb_ld(&(bar)[XB_TMO])) break; if (_sp > XB_SPIN_CAP) { atomicAdd(&(bar)[XB_TMO], 1u); break; } } } } while (0)
struct XcdBarrier { unsigned* bar; unsigned x; volatile LAS unsigned* st; };
DI XcdBarrier xcd_barrier_post(unsigned* bar, volatile LAS unsigned* st) {
  XcdBarrier b; b.bar = bar; b.x = xb_xcc_id(); b.st = st;
  if (threadIdx.x == 0) (void)xb_add(&bar[XB_XCNT(b.x)], 1u);
  return b;
}
DI void xcd_barrier_complete(unsigned* bar, unsigned x, unsigned& nloc, unsigned& nx) {
  const unsigned G = gridDim.x * gridDim.y * gridDim.z;
  unsigned sum, cnt, mine, sp = 0u;
  for (;;) {
    sum = 0u; cnt = 0u; mine = 0u;
#pragma unroll
    for (unsigned j = 0; j < 16; ++j) { const unsigned c = xb_ld(&bar[XB_XCNT(j)]); sum += c; cnt += (c > 0u) ? 1u : 0u; mine = (j == x) ? c : mine; }
    if (sum == G) break;
    __builtin_amdgcn_s_sleep(1);
    if ((++sp & 255u) == 0u) { if (xb_ld(&bar[XB_TMO])) break; if (sp > XB_SPIN_CAP) { atomicAdd(&bar[XB_TMO], 1u); break; } }
  }
  nloc = mine > 0u ? mine : 1u; nx = cnt > 0u ? cnt : 1u;
}
DI void xcd_barrier(const XcdBarrier& b) {
  asm volatile("s_waitcnt vmcnt(0)" ::: "memory");
  __syncthreads();
  if (threadIdx.x == 0) {
    unsigned* bar = b.bar;
    __builtin_amdgcn_s_waitcnt(0);
    unsigned nloc = b.st[0], nx = b.st[1];
    if (nloc == 0u) { xcd_barrier_complete(bar, b.x, nloc, nx); b.st[0] = nloc; b.st[1] = nx; }
    const unsigned old = xb_add(&bar[XB_XSUB(b.x)], 1u);
    const unsigned gen = old / nloc;
    if (old + 1u == (gen + 1u) * nloc) {
      __builtin_amdgcn_fence(__ATOMIC_RELEASE, "agent");
      asm volatile("s_waitcnt vmcnt(0)" ::: "memory");
      const unsigned og = xb_add(&bar[XB_TOP], 1u);
      const unsigned tg = og / nx;
      if (og + 1u == (tg + 1u) * nx) xb_add(&bar[XB_TOPGEN], 1u);
      else XB_SPIN(xb_ld(&bar[XB_TOPGEN]) == tg, bar);
      __builtin_amdgcn_fence(__ATOMIC_ACQUIRE, "agent");
      xb_add(&bar[XB_XGEN(b.x)], 1u);
      asm volatile("s_waitcnt vmcnt(0)" ::: "memory");
    } else {
      XB_SPIN(xb_ld(&bar[XB_XGEN(b.x)]) == gen, bar);
      __builtin_amdgcn_fence(__ATOMIC_ACQUIRE, "agent");
      asm volatile("s_waitcnt vmcnt(0)" ::: "memory");
    }
  }
  __syncthreads();
}

#ifndef REP_SYNC
#define REP_SYNC 0
#endif
__global__ void __launch_bounds__(512, 2) k_mega(Params p) {
  extern __shared__ __attribute__((aligned(16))) char smem_all[];
  cg::grid_group grid = cg::this_grid();
  char* smem = smem_all;
#define smh (smem_all + VHALF * 65536)
  volatile LAS unsigned* xst = (volatile LAS unsigned*)(smem_all + 131072);
  if (threadIdx.x < 4) xst[threadIdx.x] = 0u;
  __syncthreads();
  XcdBarrier xb = xcd_barrier_post(p.bar, xst);
#define GSYNC() xcd_barrier(xb)
  phase_prep(p, smh);
  phase_s5_gen(p, 0, smh);
  GSYNC();
  if (p.bar == nullptr) grid.sync();
  for (int l = 0; l < 2; ++l) {
    phase_h(p, l);
    GSYNC();
    phase_gemm_in(p, l, smem);
    GSYNC();
    phase_s5_e(p, smh);
    phase_gla_pass1(p, l, smh);
    GSYNC();
    phase_s5_scan(p, l);
    phase_gla_main(p, l, smh);
    GSYNC();
    phase_s5_y(p, l, smh);
    phase_gla_norm(p, l, 0);
    GSYNC();
    phase_glu(p, l, smh);
    phase_gla_norm(p, l, 1);
    GSYNC();
    phase_merge(p, l, smem);
    if (l == 0 && (blockIdx.x >> 3) >= 24) {
      const int hb = (int)((((blockIdx.x >> 3) - 24) * 8 + (blockIdx.x & 7)) * 2) + VHALF;
      s5_gen_item(p, 1, hb, smh);
    }
    GSYNC();
    phase_out(p, l, smem);
    if (l == 0 && (blockIdx.x >> 3) >= 24) {
      const int hb = (int)((((blockIdx.x >> 3) - 24) * 8 + (blockIdx.x & 7)) * 2) + VHALF;
      s5_gen_item(p, 1, hb + 128, smh);
    }
    GSYNC();
    for (int rep = 0; rep < REP_SYNC; ++rep) GSYNC();
  }
  phase_final(p);
}

extern "C" void kernel_launch(void* const* d_in, const int* in_sizes, int n_in, void* d_out, int out_size,
                              void* d_ws, size_t ws_size, hipStream_t stream) {
  Params p{};
  const float* const* in = (const float* const*)d_in;
  p.x_prompt = in[0]; p.x_sample = in[1]; p.c = in[2]; p.st_re = in[3]; p.st_im = in[4]; p.st_gla = in[5];
  p.c_ctx = in[6]; p.norm_g = in[7]; p.w_mod = in[8]; p.b_mod = in[9]; p.w_in = in[10]; p.wg_up = in[11];
  p.bg = in[12]; p.gla_norm_g = in[13]; p.lam_re = in[14]; p.lam_im = in[15]; p.log_dt = in[16];
  p.b_re = in[17]; p.b_im = in[18]; p.c_re = in[19]; p.c_im = in[20]; p.s5_d = in[21]; p.w_glu = in[22];
  p.b_glu = in[23]; p.w_pa = in[24]; p.w_pb = in[25]; p.w_o = in[26]; p.final_g = in[27];
  p.out = (float*)d_out;
  char* ws = (char*)d_ws;
  size_t off = 0;
  auto take = [&](size_t bytes) { char* r = ws + off; off += (bytes + 255) & ~(size_t)255; return r; };
  p.w_inT = (bfu*)take((size_t)2 * DINP * LDH * 2);
  p.w_gluT = (bfu*)take((size_t)2 * 512 * 512 * 2);
  p.w_paT = (bfu*)take((size_t)2 * 1024 * 512 * 2);
  p.w_pbT = (bfu*)take((size_t)2 * 1024 * 512 * 2);
  p.w_oT = (bfu*)take((size_t)2 * 1024 * 1024 * 2);
  p.pos_r = (float*)take((size_t)32 * 512 * 4);
  p.pos_c = (float*)take((size_t)64 * 512 * 4);
  p.h = (bfu*)take((size_t)NTOK * LDH * 2);
  p.proj = (bfu*)take((size_t)NTOK * PW * 2);
  p.ys5 = (bfu*)take((size_t)NTOK * 512 * 2);
  p.ya = (bfu*)take((size_t)NTOK * 512 * 2);
  p.yb = (bfu*)take((size_t)NTOK * 512 * 2);
  p.merged = (bfu*)take((size_t)NTOK * D * 2);
  p.tmp_s5 = nullptr;
  p.ebuf = (float*)p.merged;
  p.carry = (bfu*)((char*)p.merged + (size_t)32 * NCHUNK * 256 * 4);
  p.ug = (bfu*)take((size_t)32 * NTOK * 16 * 2);
  p.opMG = (bfu*)take((size_t)32 * 512 * 768 * 2);
  p.opE = (bfu*)take((size_t)32 * 256 * 512 * 2);
  p.gla_sloc = (float*)p.ys5;
  p.gla_aseg = (float*)((char*)p.ys5 + (size_t)256 * 8192 * 4);
  if (off > ws_size) fprintf(stderr, "workspace too small: %zu > %zu\n", off, ws_size);
  p.bar = (unsigned*)take((size_t)XCD_BAR_WORDS * 4);
  p.mod = (float*)take((size_t)2 * 2 * 5 * 3072 * 4);
  p.gla_o = (bfu*)p.h;
  p.tmp_gla = (float*)p.h;
  constexpr size_t kLds = 131072 + 16;
  static int grid_blocks = 0;
  if (!grid_blocks) {
    int dev = 0, cus = 0, per_cu = 0;
    hipGetDevice(&dev);
    hipDeviceGetAttribute(&cus, hipDeviceAttributeMultiprocessorCount, dev);
    hipFuncSetAttribute((const void*)k_mega, hipFuncAttributeMaxDynamicSharedMemorySize, (int)kLds);
    hipOccupancyMaxActiveBlocksPerMultiprocessor(&per_cu, k_mega, 512, kLds);
    if (per_cu > 1) per_cu = 1;
    grid_blocks = cus * per_cu;
    if (grid_blocks % 8 != 0 || grid_blocks <= 0) fprintf(stderr, "unexpected grid %d\n", grid_blocks);
  }
  hipMemsetAsync(p.bar, 0, (size_t)XCD_BAR_WORDS * 4, stream);
  void* args[] = {&p};
  hipError_t e = hipLaunchCooperativeKernel((void*)k_mega, dim3(grid_blocks), dim3(512), args, kLds, stream);
  if (e != hipSuccess) fprintf(stderr, "cooperative launch failed: %s (grid %d)\n", hipGetErrorString(e), grid_blocks);
}
```

```cpp
#include <hip/hip_runtime.h>
#include <hip/hip_cooperative_groups.h>
#include <stdint.h>
#include <math.h>
#include <stdio.h>
namespace cg = cooperative_groups;

#ifndef REP_PREP
#define REP_PREP 0
#endif
#ifndef REP_GIN
#define REP_GIN 0
#endif
#ifndef REP_X1
#define REP_X1 0
#endif
#ifndef REP_X2
#define REP_X2 0
#endif
#ifndef REP_Y
#define REP_Y 0
#endif
#ifndef REP_MERGE
#define REP_MERGE 0
#endif
#ifndef REP_SYNC
#define REP_SYNC 0
#endif
#ifndef ONE_LAUNCH
#define ONE_LAUNCH 1
#endif

typedef unsigned short bfu;
typedef __attribute__((ext_vector_type(8))) short bf16x8;
typedef __attribute__((ext_vector_type(16))) float f32x16;
typedef __attribute__((ext_vector_type(2))) __bf16 bf2_t;
typedef __attribute__((ext_vector_type(2))) float f2_t;

#define DI __device__ __forceinline__

constexpr int D = 1024;
constexpr int NTOK = 12288;
constexpr int NPROMPT = 4096;
constexpr int DIN = 4624;
constexpr int DINP = 4864;
constexpr int LDH = 1088;
constexpr int PW = 4112;
constexpr int OFF_GA = 0, OFF_Q = 512, OFF_K = 768, OFF_V = 1024, OFF_GB = 1536, OFF_GL = 2048,
              OFF_MA = 2064, OFF_MB = 3088;
constexpr int NCHUNK = NTOK / 32;
constexpr size_t OUT_RE = (size_t)NTOK * D;
constexpr size_t OUT_IM = OUT_RE + 131072;
constexpr size_t OUT_GLA = OUT_IM + 131072;
constexpr float EPS = 1e-6f;
constexpr int MODH = 2 * 5 * 3072;

struct Params {
  const float *x_prompt, *x_sample, *c, *st_re, *st_im, *st_gla, *c_ctx, *norm_g, *w_mod, *b_mod, *w_in,
      *wg_up, *bg, *gla_norm_g, *lam_re, *lam_im, *log_dt, *b_re, *b_im, *c_re, *c_im, *s5_d, *w_glu,
      *b_glu, *w_pa, *w_pb, *w_o, *final_g;
  float* out;
  bfu *w_inT, *w_gluT, *w_paT, *w_pbT, *w_oT;
  float *mod, *pos_r, *pos_c, *tmp_s5, *tmp_gla;
  bfu *h, *proj, *ys5, *ya, *yb, *merged;
  bfu *ug, *opMG, *opE, *carry;
  float *ebuf, *gla_sloc, *gla_aseg;
  unsigned* bar;
  bfu* gla_o;
};

DI int tid_() { int t = threadIdx.x & 255; asm volatile("" : "+v"(t)); return t; }
#define VHALF ((int)__builtin_amdgcn_readfirstlane((int)(threadIdx.x >> 8)))
#define VBID ((int)(blockIdx.x * 2 + VHALF))
#define NVB ((int)(gridDim.x * 2))
#define VXCD ((int)(blockIdx.x & 7))
#define VJ ((int)((blockIdx.x >> 3) * 2 + VHALF))
#define VNLOC ((int)((gridDim.x >> 3) * 2))
DI float bf2f(bfu v) { return __uint_as_float(((unsigned)v) << 16); }
DI bfu f2bf(float x) { __bf16 b = (__bf16)x; return __builtin_bit_cast(unsigned short, b); }
DI unsigned pack2(float lo, float hi) {
  f2_t v = {lo, hi};
  bf2_t w = __builtin_convertvector(v, bf2_t);
  return __builtin_bit_cast(unsigned, w);
}
DI float exp2f_(float x) { return __builtin_amdgcn_exp2f(x); }
DI float sigmoidf_(float x) { return __builtin_amdgcn_rcpf(1.f + exp2f_(-1.44269504f * x)); }
DI float siluf_(float x) { return x * sigmoidf_(x); }
DI float geluf_(float x) {
  float u = 0.7978845608028654f * (x + 0.044715f * x * x * x);
  float t = 1.f - 2.f * __builtin_amdgcn_rcpf(exp2f_(2.88539008f * u) + 1.f);
  return 0.5f * x * (1.f + t);
}
DI float logsigmoidf_(float x) {
  return fminf(x, 0.f) - 0.69314718f * __builtin_amdgcn_logf(1.f + exp2f_(-1.44269504f * fabsf(x)));
}
DI float wave_sum(float v) {
#pragma unroll
  for (int o = 32; o >= 1; o >>= 1) v += __shfl_xor(v, o);
  return v;
}
DI void unpack8(const uint4 v, float (&f)[8]) {
  f[0] = __uint_as_float(v.x << 16); f[1] = __uint_as_float(v.x & 0xffff0000u);
  f[2] = __uint_as_float(v.y << 16); f[3] = __uint_as_float(v.y & 0xffff0000u);
  f[4] = __uint_as_float(v.z << 16); f[5] = __uint_as_float(v.z & 0xffff0000u);
  f[6] = __uint_as_float(v.w << 16); f[7] = __uint_as_float(v.w & 0xffff0000u);
}
DI uint4 pack8(const float (&f)[8]) {
  uint4 o;
  o.x = pack2(f[0], f[1]); o.y = pack2(f[2], f[3]); o.z = pack2(f[4], f[5]); o.w = pack2(f[6], f[7]);
  return o;
}
DI int cond_of_tok(int tok) { return tok < NPROMPT ? 0 : 1 + ((tok - NPROMPT) >> 11); }

DI void transpose_tile(const float* __restrict__ src, int K, int N, bfu* __restrict__ dst, int kt, int nt,
                       float* sm, int ldd = 0) {
  if (ldd == 0) ldd = K;
  const int tid = tid_(), c = tid & 63, r4 = tid >> 6;
  const int k0 = kt * 64, n0 = nt * 64;
  float v[16];
  const bool inb = (n0 + c) < N;
#pragma unroll
  for (int i = 0; i < 16; ++i) v[i] = inb ? src[(size_t)(k0 + i * 4 + r4) * N + n0 + c] : 0.f;
#pragma unroll
  for (int i = 0; i < 16; ++i) sm[(i * 4 + r4) * 65 + c] = v[i];
  __syncthreads();
  {
    const int n = tid >> 2, kc = tid & 3;
    float o[16];
#pragma unroll
    for (int i = 0; i < 16; ++i) o[i] = sm[(kc * 16 + i) * 65 + n];
    bfu* dp = dst + (size_t)(n0 + n) * ldd + k0 + kc * 16;
    *(uint4*)dp = pack8(*(float(*)[8])&o[0]);
    *(uint4*)(dp + 8) = pack8(*(float(*)[8])&o[8]);
  }
  __syncthreads();
}

DI void phase_prep(const Params& p, char* smem) {
  float* sm = (float*)smem;
  const int tid = tid_();
  for (int it = VBID; it < 192; it += NVB) {
    const int kh = it & 1, jb = (it >> 1) % 48, l = it / 96;
    float* ssil = sm;
    float* sred = sm + 5 * 512;
    for (int idx = tid; idx < 2560; idx += 256) {
      int ci = idx >> 9, k = (idx & 511) + kh * 512;
      float cv = (ci == 0) ? p.c_ctx[k] : p.c[(ci - 1) * 1024 + k];
      ssil[idx] = cv / (1.f + expf(-cv));
    }
    __syncthreads();
    const int jj = tid & 63, kq = tid >> 6;
    const int j = jb * 64 + jj;
    float acc[5] = {0.f, 0.f, 0.f, 0.f, 0.f};
    const float* wp = p.w_mod + ((size_t)l * 1024 + kh * 512 + kq * 128) * 3072 + j;
#pragma unroll 16
    for (int k = 0; k < 128; ++k) {
      float w = wp[(size_t)k * 3072];
#pragma unroll
      for (int ci = 0; ci < 5; ++ci) acc[ci] += ssil[ci * 512 + kq * 128 + k] * w;
    }
#pragma unroll
    for (int ci = 0; ci < 5; ++ci) sred[(kq * 5 + ci) * 64 + jj] = acc[ci];
    __syncthreads();
    for (int idx = tid; idx < 320; idx += 256) {
      int ci = idx >> 6, j2 = idx & 63;
      float sv = kh == 0 ? p.b_mod[l * 3072 + jb * 64 + j2] : 0.f;
#pragma unroll
      for (int q = 0; q < 4; ++q) sv += sred[(q * 5 + ci) * 64 + j2];
      p.mod[((size_t)(kh * 2 + l) * 5 + ci) * 3072 + jb * 64 + j2] = sv;
    }
    __syncthreads();
  }
  for (int idx = VBID * 256 + tid; idx < 96 * 512; idx += NVB * 256) {
    int r = idx >> 9, i = idx & 511;
    int pos = r < 32 ? r : r - 32;
    int q = i & 255;
    double f = exp(-log(10000.0) * (double)q / 256.0);
    double ang = (double)pos * f;
    float v = (float)((i < 256) ? sin(ang) : cos(ang));
    if (r < 32) p.pos_r[r * 512 + i] = v; else p.pos_c[(r - 32) * 512 + i] = v;
  }
  for (int it = VBID; it < 3584; it += NVB) {
    int l = it / 1792, r = it % 1792;
    if (r < 1216) {
      transpose_tile(p.w_in + (size_t)l * 1024 * DIN, 1024, DIN, p.w_inT + (size_t)l * DINP * LDH, r % 16, r / 16, sm, LDH);
    } else if (r < 1280) {
      r -= 1216;
      transpose_tile(p.w_glu + (size_t)l * 512 * 512, 512, 512, p.w_gluT + (size_t)l * 512 * 512, r % 8, r / 8, sm);
    } else if (r < 1408) {
      r -= 1280;
      transpose_tile(p.w_pa + (size_t)l * 512 * 1024, 512, 1024, p.w_paT + (size_t)l * 1024 * 512, r % 8, r / 8, sm);
    } else if (r < 1536) {
      r -= 1408;
      transpose_tile(p.w_pb + (size_t)l * 512 * 1024, 512, 1024, p.w_pbT + (size_t)l * 1024 * 512, r % 8, r / 8, sm);
    } else {
      r -= 1536;
      transpose_tile(p.w_o + (size_t)l * 1024 * 1024, 1024, 1024, p.w_oT + (size_t)l * 1024 * 1024, r % 16, r / 16, sm);
    }
  }
}

DI void phase_h(const Params& p, int l) {
  const int tid = tid_(), lane = tid & 63, w = tid >> 6;
  for (int it = VBID; it < NTOK / 4; it += NVB) {
    const int tok = it * 4 + w;
    float4 v[4];
    float* xs = p.out + (size_t)tok * D;
    if (l == 0) {
      const float* src = tok < NPROMPT ? p.x_prompt + (size_t)tok * D : p.x_sample + (size_t)(tok - NPROMPT) * D;
#pragma unroll
      for (int i = 0; i < 4; ++i) v[i] = *(const float4*)(src + lane * 4 + 256 * i);
      if (tok >= NPROMPT) {
        int t = (tok - NPROMPT) & 2047, row = t >> 6, col = t & 63;
#pragma unroll
        for (int i = 0; i < 4; ++i) {
          int d = lane * 4 + 256 * i;
          const float* pe = d < 512 ? p.pos_r + row * 512 + d : p.pos_c + col * 512 + (d - 512);
          float4 e = *(const float4*)pe;
          v[i].x += e.x; v[i].y += e.y; v[i].z += e.z; v[i].w += e.w;
        }
      }
    } else {
#pragma unroll
      for (int i = 0; i < 4; ++i) v[i] = *(const float4*)(xs + lane * 4 + 256 * i);
    }
    float ss = 0.f;
#pragma unroll
    for (int i = 0; i < 4; ++i) ss += v[i].x * v[i].x + v[i].y * v[i].y + v[i].z * v[i].z + v[i].w * v[i].w;
    ss = wave_sum(ss);
    const float rstd = rsqrtf(ss * (1.f / 1024.f) + EPS);
    const float* md = p.mod + (size_t)(l * 5 + cond_of_tok(tok)) * 3072;
    const float* ng = p.norm_g + l * 1024;
#pragma unroll
    for (int i = 0; i < 4; ++i) {
      int d = lane * 4 + 256 * i;
      float4 g = *(const float4*)(ng + d);
      float4 sh = *(const float4*)(md + d);
      float4 sc = *(const float4*)(md + 1024 + d);
      {
        const float4 sh1 = *(const float4*)(md + MODH + d);
        const float4 sc1 = *(const float4*)(md + MODH + 1024 + d);
        sh.x += sh1.x; sh.y += sh1.y; sh.z += sh1.z; sh.w += sh1.w;
        sc.x += sc1.x; sc.y += sc1.y; sc.z += sc1.z; sc.w += sc1.w;
      }
      float a0 = v[i].x * rstd * g.x * (1.f + sc.x) + sh.x;
      float a1 = v[i].y * rstd * g.y * (1.f + sc.y) + sh.y;
      float a2 = v[i].z * rstd * g.z * (1.f + sc.z) + sh.z;
      float a3 = v[i].w * rstd * g.w * (1.f + sc.w) + sh.w;
      uint2 o; o.x = pack2(a0, a1); o.y = pack2(a2, a3);
      *(uint2*)(p.h + (size_t)tok * LDH + d) = o;
    }
  }
}

DI void gemm_core(const bfu* A, int lda, const bfu* __restrict__ B, int ldb, int K, char* smem,
                  f32x16 (&acc)[2][2], const bfu* A2, int lda2, int K2) {
  const int tid = tid_(), lane = tid & 63, w = tid >> 6, wm = w >> 1, wn = w & 1;
  const int c8 = tid & 7, r0 = tid >> 3;
  const bfu* ga = A + (size_t)r0 * lda + c8 * 8;
  const bfu* gb = B + (size_t)r0 * ldb + c8 * 8;
  const int st_off = r0 * 128 + ((c8 ^ ((r0 >> 1) & 7)) * 16);
  const int fr = lane & 31, hh = lane >> 5, fsw = (fr >> 1) & 7;
  const int a_base = (wm * 64 + fr) * 128;
  const int b_base = 16384 + (wn * 64 + fr) * 128;
  uint4 ra0, ra1, ra2, ra3, rb0, rb1, rb2, rb3, qa0, qa1, qa2, qa3, qb0, qb1, qb2, qb3;
  const int KT1 = K >> 6, KT = (K + K2) >> 6;
  const bfu* ga2 = A2 + (size_t)r0 * lda2 + c8 * 8;
#define GEMM_LOADT(RA, RB, tile)                                                           \
  {                                                                                        \
    const int t_ = (tile) < KT ? (tile) : KT - 1;                                          \
    const bool s2_ = t_ >= KT1;                                                            \
    const bfu* ga_ = s2_ ? ga2 + (t_ - KT1) * 64 : ga + t_ * 64;                           \
    const size_t la_ = s2_ ? (size_t)lda2 : (size_t)lda;                                   \
    const bfu* gb_ = gb + t_ * 64;                                                         \
    RA##0 = *(const uint4*)(ga_);                 RB##0 = *(const uint4*)(gb_);                        \
    RA##1 = *(const uint4*)(ga_ + 32 * la_);      RB##1 = *(const uint4*)(gb_ + (size_t)32 * ldb);     \
    RA##2 = *(const uint4*)(ga_ + 64 * la_);      RB##2 = *(const uint4*)(gb_ + (size_t)64 * ldb);     \
    RA##3 = *(const uint4*)(ga_ + 96 * la_);      RB##3 = *(const uint4*)(gb_ + (size_t)96 * ldb);     \
  }
#define GEMM_STORET(buf, RA, RB)                                                           \
  {                                                                                        \
    *(uint4*)((buf) + st_off) = RA##0;          *(uint4*)((buf) + 16384 + st_off) = RB##0;          \
    *(uint4*)((buf) + st_off + 4096) = RA##1;   *(uint4*)((buf) + 16384 + st_off + 4096) = RB##1;   \
    *(uint4*)((buf) + st_off + 8192) = RA##2;   *(uint4*)((buf) + 16384 + st_off + 8192) = RB##2;   \
    *(uint4*)((buf) + st_off + 12288) = RA##3;  *(uint4*)((buf) + 16384 + st_off + 12288) = RB##3;  \
  }
#define GEMM_COMPUTE(cur)                                                                  \
  _Pragma("unroll") for (int s = 0; s < 4; ++s) {                                          \
    const int co = ((2 * s + hh) ^ fsw) * 16;                                              \
    bf16x8 a0 = *(const bf16x8*)((cur) + a_base + co);                                     \
    bf16x8 a1 = *(const bf16x8*)((cur) + a_base + 4096 + co);                              \
    bf16x8 b0 = *(const bf16x8*)((cur) + b_base + co);                                     \
    bf16x8 b1 = *(const bf16x8*)((cur) + b_base + 4096 + co);                              \
    acc[0][0] = __builtin_amdgcn_mfma_f32_32x32x16_bf16(a0, b0, acc[0][0], 0, 0, 0);       \
    acc[0][1] = __builtin_amdgcn_mfma_f32_32x32x16_bf16(a0, b1, acc[0][1], 0, 0, 0);       \
    acc[1][0] = __builtin_amdgcn_mfma_f32_32x32x16_bf16(a1, b0, acc[1][0], 0, 0, 0);       \
    acc[1][1] = __builtin_amdgcn_mfma_f32_32x32x16_bf16(a1, b1, acc[1][1], 0, 0, 0);       \
  }
  GEMM_LOADT(ra, rb, 0)
  GEMM_LOADT(qa, qb, 1)
  GEMM_STORET(smem, ra, rb)
  __syncthreads();
#pragma unroll 1
  for (int kt = 0; kt < KT; kt += 2) {
    GEMM_LOADT(ra, rb, kt + 2)
    __builtin_amdgcn_sched_barrier(0);
    GEMM_COMPUTE(smem)
    __builtin_amdgcn_sched_barrier(0);
    GEMM_STORET(smem + 32768, qa, qb)
    __syncthreads();
    GEMM_LOADT(qa, qb, kt + 3)
    __builtin_amdgcn_sched_barrier(0);
    GEMM_COMPUTE(smem + 32768)
    __builtin_amdgcn_sched_barrier(0);
    GEMM_STORET(smem, ra, rb)
    __syncthreads();
  }
}

DI void acc_zero(f32x16 (&acc)[2][2]) {
#pragma unroll
  for (int i = 0; i < 2; ++i)
#pragma unroll
    for (int j = 0; j < 2; ++j)
#pragma unroll
      for (int r = 0; r < 16; ++r) acc[i][j][r] = 0.f;
}

DI void acc_to_lds(const f32x16 (&acc)[2][2], char* smem) {
  float* sf = (float*)smem;
  const int tid = tid_(), lane = tid & 63, w = tid >> 6;
  const int rb = (w >> 1) * 64 + 4 * (lane >> 5), cb = (w & 1) * 64 + (lane & 31);
#pragma unroll
  for (int i = 0; i < 2; ++i)
#pragma unroll
    for (int j = 0; j < 2; ++j)
#pragma unroll
      for (int r = 0; r < 16; ++r)
        sf[(rb + i * 32 + (r & 3) + 8 * (r >> 2)) * 128 + cb + j * 32] = acc[i][j][r];
}
#define EPI_LDS(...)                                                             \
  {                                                                              \
    acc_to_lds(acc, smem);                                                       \
    __syncthreads();                                                             \
    _Pragma("unroll 1") for (int it_ = 0; it_ < 8; ++it_) {                      \
      const int row = (tid_() >> 4) + 16 * it_;                             \
      const int c0 = (tid_() & 15) * 8;                                     \
      float v[8];                                                                \
      {                                                                          \
        const float4 t0 = *(const float4*)(smem + (row * 128 + c0) * 4);         \
        const float4 t1 = *(const float4*)(smem + (row * 128 + c0 + 4) * 4);     \
        v[0] = t0.x; v[1] = t0.y; v[2] = t0.z; v[3] = t0.w;                      \
        v[4] = t1.x; v[5] = t1.y; v[6] = t1.z; v[7] = t1.w;                      \
      }                                                                          \
      __VA_ARGS__                                                                \
    }                                                                            \
    __syncthreads();                                                             \
  }

typedef __attribute__((ext_vector_type(4))) float f32x4;
constexpr int G_BK = 64, G_HALF = 128, G_HT = G_HALF * G_BK;
DI int g_lds_byte(int r, int c) {
  int st = (r >> 4) * 2 + (c >> 5), rr = r & 15, cc = c & 31, ob = rr * 64 + cc * 2;
  return st * 1024 + (ob ^ (((ob >> 9) & 1) << 5));
}
DI void g_stage_rc(int b, int& R, int& C) {
  int st = b / 1024, sb = b % 1024, swz = sb ^ (((sb >> 9) & 1) << 5);
  R = (st >> 1) * 16 + swz / 64; C = (st & 1) * 32 + (swz % 64) / 2;
}
DI const char* g_uniform(const char* ptr) {
  unsigned long long u = (unsigned long long)ptr;
  unsigned lo = __builtin_amdgcn_readfirstlane((unsigned)u), hi = __builtin_amdgcn_readfirstlane((unsigned)(u >> 32));
  return (const char*)(((unsigned long long)hi << 32) | lo);
}
DI void gemm256(const bfu* __restrict__ A, int lda, const bfu* __restrict__ Bt, int ldb, int K, int brow, int bcol,
                bfu* shm, f32x4 (&acc)[2][2][4][2]) {
#define G_SA(b, h) (shm + ((b) * 2 + (h)) * G_HT)
#define G_SB(b, h) (shm + (4 + (b) * 2 + (h)) * G_HT)
#define G_STAGE(P, BASE, LD, br, kt)                                                                   \
  do {                                                                                                 \
    const char* _u = g_uniform((const char*)((BASE) + ((long)(br) * (LD) + (long)(kt) * G_BK)));       \
    __builtin_amdgcn_global_load_lds((const unsigned*)(_u + soff_b),                                   \
        (__attribute__((address_space(3))) unsigned*)((char*)(P) + ldst), 16, 0, 0);                   \
    __builtin_amdgcn_global_load_lds((const unsigned*)(_u + 128 * (long)(LD) + soff_b),                \
        (__attribute__((address_space(3))) unsigned*)((char*)(P) + ldst + 8192), 16, 0, 0);            \
  } while (0)
#define G_LDA(dst, b, h) for (int m = 0; m < 4; ++m) for (int k = 0; k < 2; ++k) \
    dst[m][k] = *reinterpret_cast<const bf16x8*>((char*)G_SA(b, h) + a_rd + m * 2048 + k * 1024)
#define G_LDB(dst, b, h) for (int n = 0; n < 2; ++n) for (int k = 0; k < 2; ++k) \
    dst[n][k] = *reinterpret_cast<const bf16x8*>((char*)G_SB(b, h) + b_rd + n * 2048 + k * 1024)
#define G_MMA(ai, bj, At, Bt_)                                                                         \
  do {                                                                                                 \
    __builtin_amdgcn_s_setprio(1);                                                                     \
    for (int m = 0; m < 4; ++m) for (int n = 0; n < 2; ++n) for (int k = 0; k < 2; ++k)                \
      acc[ai][bj][m][n] = __builtin_amdgcn_mfma_f32_16x16x32_bf16(At[m][k], Bt_[n][k], acc[ai][bj][m][n], 0, 0, 0); \
    __builtin_amdgcn_s_setprio(0);                                                                     \
  } while (0)
#define G_WAIT_V(n) asm volatile("s_waitcnt vmcnt(" #n ")" ::: "memory")
#define G_WAIT_L(n) asm volatile("s_waitcnt lgkmcnt(" #n ")" ::: "memory")
#define G_BAR __builtin_amdgcn_s_barrier()
#define G_SCHED __builtin_amdgcn_sched_barrier(0)
  int t512 = threadIdx.x; asm volatile("" : "+v"(t512));
  const int wid = __builtin_amdgcn_readfirstlane(t512 >> 6), lane = t512 & 63, wr = wid >> 2, wc = wid & 3, fr = lane & 15, fq = lane >> 4;
  const int ldst = t512 * 16;
  unsigned soff_b;
  {
    int R0, C0;
    g_stage_rc(ldst, R0, C0);
    soff_b = (unsigned)(R0 * lda + C0) * 2u;
  }
  const int lane_off = (fr * 64 + fq * 16) ^ ((fr >> 3) << 5);
  const int a_rd = wr * 8192 + lane_off, b_rd = wc * 4096 + lane_off;
  bf16x8 At[4][2], B0[2][2], B1[2][2];
  const int nt = K / G_BK;
  G_STAGE(G_SB(0, 0), Bt, ldb, bcol, 0); G_STAGE(G_SA(0, 0), A, lda, brow, 0);
  G_STAGE(G_SB(0, 1), Bt, ldb, bcol + G_HALF, 0); G_STAGE(G_SA(0, 1), A, lda, brow + G_HALF, 0);
  if (wr == 1) G_BAR;
  G_WAIT_V(4); G_BAR;
  G_STAGE(G_SB(1, 0), Bt, ldb, bcol, 1); G_STAGE(G_SA(1, 0), A, lda, brow, 1); G_STAGE(G_SB(1, 1), Bt, ldb, bcol + G_HALF, 1);
  G_WAIT_V(6); G_BAR;
#pragma unroll 1
  for (int t = 0; t < nt - 2; t += 2) {
    G_LDB(B0, 0, 0); G_SCHED; G_LDA(At, 0, 0); G_STAGE(G_SA(1, 1), A, lda, brow + G_HALF, t + 1);
    G_WAIT_L(8); G_BAR; G_WAIT_L(0); G_MMA(0, 0, At, B0); G_BAR; G_SCHED;
    G_LDB(B1, 0, 1); G_STAGE(G_SB(0, 0), Bt, ldb, bcol, t + 2);
    G_BAR; G_WAIT_L(0); G_MMA(0, 1, At, B1); G_BAR;
    G_LDA(At, 0, 1); G_STAGE(G_SA(0, 0), A, lda, brow, t + 2);
    G_BAR; G_WAIT_L(0); G_MMA(1, 0, At, B0); G_BAR; G_SCHED;
    G_STAGE(G_SB(0, 1), Bt, ldb, bcol + G_HALF, t + 2);
    G_WAIT_V(6); G_BAR; G_MMA(1, 1, At, B1); G_BAR;
    G_LDB(B0, 1, 0); G_SCHED; G_LDA(At, 1, 0); G_STAGE(G_SA(0, 1), A, lda, brow + G_HALF, t + 2);
    G_WAIT_L(8); G_BAR; G_WAIT_L(0); G_MMA(0, 0, At, B0); G_BAR; G_SCHED;
    G_LDB(B1, 1, 1); G_STAGE(G_SB(1, 0), Bt, ldb, bcol, t + 3);
    G_BAR; G_WAIT_L(0); G_MMA(0, 1, At, B1); G_BAR;
    G_LDA(At, 1, 1); G_STAGE(G_SA(1, 0), A, lda, brow, t + 3);
    G_BAR; G_WAIT_L(0); G_MMA(1, 0, At, B0); G_BAR; G_SCHED;
    G_STAGE(G_SB(1, 1), Bt, ldb, bcol + G_HALF, t + 3);
    G_WAIT_V(6); G_BAR; G_MMA(1, 1, At, B1); G_BAR;
  }
  { G_LDB(B0, 0, 0); G_LDA(At, 0, 0); G_STAGE(G_SA(1, 1), A, lda, brow + G_HALF, nt - 1);
    G_BAR; G_WAIT_L(0); G_MMA(0, 0, At, B0); G_BAR;
    G_LDB(B1, 0, 1); G_BAR; G_WAIT_L(0); G_MMA(0, 1, At, B1); G_BAR;
    G_LDA(At, 0, 1); G_WAIT_V(4); G_BAR; G_WAIT_L(0); G_MMA(1, 0, At, B0); G_MMA(1, 1, At, B1); G_BAR; }
  { G_LDB(B0, 1, 0); G_LDA(At, 1, 0); G_WAIT_V(2); G_BAR; G_WAIT_L(0); G_MMA(0, 0, At, B0); G_BAR;
    G_LDB(B1, 1, 1); G_WAIT_V(0); G_BAR; G_WAIT_L(0); G_MMA(0, 1, At, B1); G_BAR;
    G_LDA(At, 1, 1); G_BAR; G_WAIT_L(0); G_MMA(1, 0, At, B0); G_MMA(1, 1, At, B1); G_BAR; }
  if (wr == 0) G_BAR;
}
DI void acc256_zero(f32x4 (&acc)[2][2][4][2]) {
#pragma unroll
  for (int a = 0; a < 2; ++a)
#pragma unroll
    for (int b = 0; b < 2; ++b)
#pragma unroll
      for (int m = 0; m < 4; ++m)
#pragma unroll
        for (int n = 0; n < 2; ++n) acc[a][b][m][n] = (f32x4){0.f, 0.f, 0.f, 0.f};
}
#define EPI_NOPRE
#define EPI256P(PRE, ...)                                                                              \
  {                                                                                                    \
    int t512_ = threadIdx.x; asm volatile("" : "+v"(t512_));     \
    const int wid_ = t512_ >> 6, lane_ = t512_ & 63, wr_ = wid_ >> 2, wc_ = wid_ & 3,                  \
              fr_ = lane_ & 15, fq_ = lane_ >> 4;                                                      \
    float* sf_ = (float*)smem;                                                                         \
    _Pragma("unroll") for (int ai_ = 0; ai_ < 2; ++ai_) {                                              \
      _Pragma("unroll") for (int it_ = 0; it_ < 8; ++it_) {     \
        const int idx_ = t512_ + 512 * it_;                                                            \
        const int rl_ = idx_ >> 5, c0 = (idx_ & 31) * 8;                                               \
        const int row = ai_ * 128 + rl_;                                                               \
        (void)rl_; (void)c0; (void)row;                                                                \
        PRE                                                                                            \
      }                                                                                                \
      __builtin_amdgcn_sched_barrier(0);              \
      __syncthreads();                                                                                 \
      _Pragma("unroll") for (int bj_ = 0; bj_ < 2; ++bj_)                                              \
      _Pragma("unroll") for (int m_ = 0; m_ < 4; ++m_)                                                 \
      _Pragma("unroll") for (int n_ = 0; n_ < 2; ++n_)                                                 \
      _Pragma("unroll") for (int j_ = 0; j_ < 4; ++j_)                                                 \
        sf_[(wr_ * 64 + m_ * 16 + fq_ * 4 + j_) * 256 + ((bj_ * 128 + wc_ * 32 + n_ * 16 + fr_) ^ (fq_ << 4))] = \
            acc[ai_][bj_][m_][n_][j_];                                                                 \
      __syncthreads();                                                                                 \
      _Pragma("unroll") for (int it_ = 0; it_ < 8; ++it_) {                                            \
        const int idx_ = t512_ + 512 * it_;                                                            \
        const int rl_ = idx_ >> 5, c0 = (idx_ & 31) * 8;                                               \
        const int row = ai_ * 128 + rl_;                                                               \
        float v[8];                                                                                    \
        {                                                                                              \
          const float* sp_ = sf_ + rl_ * 256 + (c0 ^ (((rl_ >> 2) & 3) << 4));                          \
          const float4 t0 = *(const float4*)sp_; const float4 t1 = *(const float4*)(sp_ + 4);          \
          v[0] = t0.x; v[1] = t0.y; v[2] = t0.z; v[3] = t0.w;                                          \
          v[4] = t1.x; v[5] = t1.y; v[6] = t1.z; v[7] = t1.w;                                          \
        }                                                                                              \
        __VA_ARGS__                                                                                    \
      }                                                                                                \
    }                                                                                                  \
    __syncthreads();                                                                                   \
  }
#define EPI256(...) EPI256P(EPI_NOPRE, __VA_ARGS__)

template <int MT, int NT, int BH>
DI bool xcd_tile(int iter, int& mt, int& nt) {
  constexpr int MPX = MT / 8, TPX = MPX * NT;
  const int xcd = VXCD, j = VJ, nloc = VNLOC;
  const int q = j + iter * nloc;
  if (q >= TPX) return false;
  const int band = q / (BH * NT), r = q % (BH * NT);
  nt = r / BH;
  mt = xcd * MPX + band * BH + (r % BH);
  return true;
}

DI bool tile256(int iter, int NT, int& mt, int& nt) {
  const int xcd = blockIdx.x & 7, j = blockIdx.x >> 3, nloc = gridDim.x >> 3;
  const int q = j + iter * nloc;
  if (q >= 6 * NT) return false;
  nt = q / 6; mt = xcd * 6 + q % 6;
  return true;
}
DI void phase_gemm_in(const Params& p, int l, char* smem) {
  const bfu* W = p.w_inT + (size_t)l * DINP * LDH;
  for (int iter = 0;; ++iter) {
    int mt, nt;
    if (!tile256(iter, 19, mt, nt)) break;
    f32x4 acc[2][2][4][2];
    acc256_zero(acc);
    gemm256(p.h, LDH, W, LDH, 1024, mt * 256, nt * 256, (bfu*)smem, acc);
    const int m0 = mt * 256, n0 = nt * 256;
    EPI256({
      const int n = n0 + c0;
      if (n < 512) *(uint4*)(p.ug + ((size_t)(n >> 4) * NTOK + (m0 + row)) * 16 + (n & 15)) = pack8(v);
      else if (n < DIN) *(uint4*)(p.proj + (size_t)(m0 + row) * PW + (n - 512)) = pack8(v);
    })
  }
}

DI void s5_gen_item(const Params& p, int l, int item, char* smem) {
  const int tid = tid_();
  const int g = item >> 3, r = item & 7;
  float* sBr = (float*)smem;
  float* sBi = sBr + 2048;
  float* sCr = sBi + 2048;
  float* sCi = sCr + 1024;
  float* sAK = sCi + 1024;
  float* sAE = sAK + 1024;
  float* sAG = sAE + 1024;
  float* sK = sAG + 1024;
  bfu* E = p.opE + (size_t)g * 256 * 512;
  bfu* MG = p.opMG + (size_t)g * 512 * 768;
  __syncthreads();
  if (tid < 128) {
    const int d = tid >> 6, pp = tid & 63;
    const size_t pi = ((size_t)(l * 2 + d) * 32 + g) * 64 + pp;
    const float lr = p.lam_re[pi], li = p.lam_im[pi];
    const float dt = expf(p.log_dt[(l * 2 + d) * 32 + g]);
    const float mag = expf(lr * dt);
    float sn, cs;
    sincosf(li * dt, &sn, &cs);
    const float are = mag * cs, aim = mag * sn;
    const float nr = are - 1.f, ni = aim, den = lr * lr + li * li;
    const float kr = (nr * lr + ni * li) / den, ki = (ni * lr - nr * li) / den;
#pragma unroll
    for (int c = 0; c < 16; ++c) {
      float br = p.b_re[((size_t)(l * 32 + g) * 64 + pp) * 16 + c];
      float bi = p.b_im[((size_t)(l * 32 + g) * 64 + pp) * 16 + c];
      sBr[(d * 64 + pp) * 16 + c] = kr * br - ki * bi;
      sBi[(d * 64 + pp) * 16 + c] = kr * bi + ki * br;
    }
#pragma unroll
    for (int q = 0; q < 4; ++q) {
      const int t = 4 * r + q;
      const int nK = t;
      const int nE = d == 0 ? 31 - t : t;
      const int nG = d == 0 ? t + 1 : 32 - t;
      const float er = lr * dt * 1.44269504f, rv = li * dt * 0.15915494f;
      float m, s_, c_, fr_;
      m = exp2f_(er * (float)nK); fr_ = rv * (float)nK; fr_ -= floorf(fr_);
      s_ = __builtin_amdgcn_sinf(fr_); c_ = __builtin_amdgcn_cosf(fr_);
      sAK[((d * 4 + q) * 64 + pp) * 2] = m * c_; sAK[((d * 4 + q) * 64 + pp) * 2 + 1] = m * s_;
      m = exp2f_(er * (float)nE); fr_ = rv * (float)nE; fr_ -= floorf(fr_);
      s_ = __builtin_amdgcn_sinf(fr_); c_ = __builtin_amdgcn_cosf(fr_);
      sAE[((d * 4 + q) * 64 + pp) * 2] = m * c_; sAE[((d * 4 + q) * 64 + pp) * 2 + 1] = m * s_;
      m = exp2f_(er * (float)nG); fr_ = rv * (float)nG; fr_ -= floorf(fr_);
      s_ = __builtin_amdgcn_sinf(fr_); c_ = __builtin_amdgcn_cosf(fr_);
      sAG[((d * 4 + q) * 64 + pp) * 2] = m * c_; sAG[((d * 4 + q) * 64 + pp) * 2 + 1] = m * s_;
    }
  } else {
    for (int idx = tid - 128; idx < 1024; idx += 128) {
      sCr[idx] = p.c_re[(size_t)(l * 32 + g) * 1024 + idx];
      sCi[idx] = p.c_im[(size_t)(l * 32 + g) * 1024 + idx];
    }
  }
  __syncthreads();
#pragma unroll 1
  for (int i = 0; i < 4; ++i) {
    const int idx = tid + 256 * i;
    const int row = idx >> 2, q = idx & 3;
    const int part = row >> 6, pp = row & 63, d = part >> 1;
    const float ar = sAE[((d * 4 + q) * 64 + pp) * 2], ai = sAE[((d * 4 + q) * 64 + pp) * 2 + 1];
    const float* br = sBr + (d * 64 + pp) * 16;
    const float* bi = sBi + (d * 64 + pp) * 16;
    float v[16];
#pragma unroll
    for (int c = 0; c < 16; ++c) v[c] = (part & 1) ? (ar * bi[c] + ai * br[c]) : (ar * br[c] - ai * bi[c]);
    bfu* dp = E + (size_t)row * 512 + (4 * r + q) * 16;
    *(uint4*)dp = pack8(*(float(*)[8])&v[0]);
    *(uint4*)(dp + 8) = pack8(*(float(*)[8])&v[8]);
  }
#pragma unroll 1
  for (int i = 0; i < 8; ++i) {
    const int idx = tid + 256 * i;
    const int rr = idx >> 5, cg = idx & 31, q = rr >> 4, c = rr & 15;
    const int part = cg >> 3, pp0 = (cg & 7) * 8, d = part >> 1;
    const float* ag = sAG + ((d * 4 + q) * 64 + pp0) * 2;
    const float* cr = sCr + c * 64 + pp0;
    const float* ci = sCi + c * 64 + pp0;
    float v[8];
#pragma unroll
    for (int e = 0; e < 8; ++e) {
      const float ar = ag[2 * e], ai = ag[2 * e + 1];
      v[e] = (part & 1) ? -(cr[e] * ai + ci[e] * ar) : (cr[e] * ar - ci[e] * ai);
    }
    *(uint4*)(MG + (size_t)((4 * r + q) * 16 + c) * 768 + 512 + cg * 8) = pack8(v);
  }
  {
    const int d = tid >> 7, q = (tid >> 5) & 3, c = (tid >> 1) & 15, ch = tid & 1;
    float acc[8];
#pragma unroll
    for (int e = 0; e < 8; ++e) acc[e] = 0.f;
    for (int pp = 0; pp < 64; ++pp) {
      const float ar = sAK[((d * 4 + q) * 64 + pp) * 2], ai = sAK[((d * 4 + q) * 64 + pp) * 2 + 1];
      const float cr = sCr[c * 64 + pp], ci = sCi[c * 64 + pp];
      const float wr = cr * ar - ci * ai, wi = cr * ai + ci * ar;
#pragma unroll
      for (int e = 0; e < 8; ++e)
        acc[e] += wr * sBr[(d * 64 + pp) * 16 + ch * 8 + e] - wi * sBi[(d * 64 + pp) * 16 + ch * 8 + e];
    }
#pragma unroll
    for (int e = 0; e < 8; ++e) sK[((d * 4 + q) * 16 + c) * 16 + ch * 8 + e] = acc[e];
  }
  __syncthreads();
  for (int idx = tid; idx < 8192; idx += 256) {
    const int ch = idx & 1, c = (idx >> 1) & 15, tp = (idx >> 5) & 31, q = (idx >> 10) & 3, d = idx >> 12;
    const int tau = 4 * r + q;
    int sp;
    bool valid;
    if (d == 0) { sp = tp - tau; valid = sp >= 0; } else { sp = tp + tau; valid = (sp <= 31) && (tau > 0); }
    if (valid) {
      float v[8];
#pragma unroll
      for (int e = 0; e < 8; ++e) {
        float x = sK[((d * 4 + q) * 16 + c) * 16 + ch * 8 + e];
        if (tau == 0) x += sK[((1 * 4 + q) * 16 + c) * 16 + ch * 8 + e];
        v[e] = x;
      }
      *(uint4*)(MG + (size_t)(tp * 16 + c) * 768 + sp * 16 + ch * 8) = pack8(v);
    }
  }
  __syncthreads();
}

DI void phase_s5_gen(const Params& p, int l, char* smem) {
  for (int it = NVB - 1 - VBID; it < 256; it += NVB) s5_gen_item(p, l, it, smem);
}

DI void phase_s5_e(const Params& p, char* smem) {
  for (int q = VJ; q < 24; q += VNLOC) {
    const int g = VXCD * 4 + q / 6, r6 = q % 6, mt = r6 >> 1, nt = r6 & 1;
    f32x16 acc[2][2];
    acc_zero(acc);
    gemm_core(p.ug + ((size_t)g * NCHUNK + mt * 128) * 512, 512, p.opE + ((size_t)g * 256 + nt * 128) * 512, 512, 512,
              smem, acc, p.ug, 512, 0);
    EPI_LDS({
      float* dst = p.ebuf + ((size_t)g * NCHUNK + mt * 128 + row) * 256 + nt * 128 + c0;
      *(float4*)dst = make_float4(v[0], v[1], v[2], v[3]);
      *(float4*)(dst + 4) = make_float4(v[4], v[5], v[6], v[7]);
    })
  }
}

DI void phase_s5_scan(const Params& p, int l) {
  const int tid = tid_();
  for (int it = VBID; it < 320; it += NVB) {
    const int wi = it * 2 + (tid >> 7);
    const int dir = (tid >> 6) & 1, pp = tid & 63;
    int chunk0, n, b, g;
    bool prompt;
    if (wi < 128) { b = wi >> 5; g = wi & 31; chunk0 = (NPROMPT + b * 2048) >> 5; n = 64; prompt = false; }
    else { int q = wi - 128; b = q >> 5; g = q & 31; chunk0 = (b * 256) >> 5; n = 8; prompt = true; }
    const size_t pi = ((size_t)(l * 2 + dir) * 32 + g) * 64 + pp;
    const float lr = p.lam_re[pi], li = p.lam_im[pi];
    const float dt = expf(p.log_dt[(l * 2 + dir) * 32 + g]);
    const float mag = expf(lr * dt * 32.f);
    float sn, cs;
    sincosf(li * dt * 32.f, &sn, &cs);
    const float are = mag * cs, aim = mag * sn;
    float hre = 0.f, him = 0.f;
    if (!prompt) {
      size_t si = ((size_t)((b * 2 + l) * 2 + dir)) * 2048 + g * 64 + pp;
      hre = p.st_re[si]; him = p.st_im[si];
    }
    const float* eb = p.ebuf + ((size_t)g * NCHUNK + chunk0) * 256 + dir * 128 + pp;
    bfu* cb = p.carry + ((size_t)g * NCHUNK + chunk0) * 256 + dir * 128 + pp;
    for (int k0 = 0; k0 < n; k0 += 8) {
      float er[8], ei[8];
#pragma unroll
      for (int j = 0; j < 8; ++j) {
        const int k = dir == 0 ? k0 + j : n - 1 - (k0 + j);
        er[j] = eb[(size_t)k * 256];
        ei[j] = eb[(size_t)k * 256 + 64];
      }
#pragma unroll
      for (int j = 0; j < 8; ++j) {
        const int k = dir == 0 ? k0 + j : n - 1 - (k0 + j);
        cb[(size_t)k * 256] = f2bf(hre);
        cb[(size_t)k * 256 + 64] = f2bf(him);
        const float nre = are * hre - aim * him + er[j];
        const float nim = are * him + aim * hre + ei[j];
        hre = nre; him = nim;
      }
    }
    if (prompt) {
      size_t oi = ((size_t)((b * 2 + l) * 2 + dir)) * 2048 + g * 64 + pp;
      p.out[OUT_RE + oi] = hre;
      p.out[OUT_IM + oi] = him;
    }
  }
}

DI void phase_s5_y(const Params& p, int l, char* smem) {
  for (int q = VJ; q < 48; q += VNLOC) {
    const int g = VXCD * 4 + q / 12, r12 = q % 12, mt = r12 >> 2, nt = r12 & 3;
    f32x16 acc[2][2];
    acc_zero(acc);
    const bfu* Bm = p.opMG + ((size_t)g * 512 + nt * 128) * 768;
    gemm_core(p.ug + ((size_t)g * NCHUNK + mt * 128) * 512, 512, Bm, 768, 512, smem, acc,
              p.carry + ((size_t)g * NCHUNK + mt * 128) * 256, 256, 256);
    EPI_LDS({
      const int chunk = mt * 128 + row, nn = nt * 128 + c0, tp = nn >> 4, c = nn & 15;
      const int tok = chunk * 32 + tp;
      float u[8], o[8];
      unpack8(*(const uint4*)(p.ug + ((size_t)g * NTOK + tok) * 16 + c), u);
      const float* dsk = p.s5_d + l * 512 + g * 16 + c;
      _Pragma("unroll") for (int e = 0; e < 8; ++e) o[e] = geluf_(v[e] + dsk[e] * u[e]);
      *(uint4*)(p.ys5 + (size_t)tok * 512 + g * 16 + c) = pack8(o);
    })
  }
}

DI void phase_glu(const Params& p, int l, char* smem) {
  const bfu* W = p.w_gluT + (size_t)l * 512 * 512;
  for (int iter = 0;; ++iter) {
    int mt, nt;
    if (!xcd_tile<96, 4, 12>(iter, mt, nt)) break;
    f32x16 acc[2][2];
    acc_zero(acc);
    gemm_core(p.ys5 + (size_t)mt * 128 * 512, 512, W + (size_t)nt * 128 * 512, 512, 512, smem, acc, p.ys5, 512, 0);
    const int m0 = mt * 128, n0 = nt * 128;
    EPI_LDS({
      const int n = n0 + c0;
      const size_t tk = (size_t)(m0 + row);
      float y[8], ga[8], o[8];
      unpack8(*(const uint4*)(p.ys5 + tk * 512 + n), y);
      unpack8(*(const uint4*)(p.proj + tk * PW + OFF_GA + n), ga);
      const float* bg = p.b_glu + l * 512 + n;
      _Pragma("unroll") for (int e = 0; e < 8; ++e) o[e] = y[e] * sigmoidf_(v[e] + bg[e]) * siluf_(ga[e]);
      *(uint4*)(p.ya + tk * 512 + n) = pack8(o);
    })
  }
}

constexpr int GL_QS = 0;
constexpr int GL_KS = GL_QS + 32 * 144;
constexpr int GL_KHT = GL_KS + 32 * 144;
constexpr int GL_VT = GL_KHT + 64 * 80;
constexpr int GL_PS = GL_VT + 128 * 80;
constexpr int GL_ST = GL_PS + 32 * 80;
constexpr int GL_AV = GL_ST + 128 * 144;
constexpr int GL_TOT = GL_AV + 256;
constexpr int GL_OS = GL_TOT + 1024;
static_assert(GL_OS + 32 * 132 * 4 <= 65536, "gla lds");

DI void gla_segment_info(int seg, int& tok_base, bool& prompt, int& b, int& sidx) {
  if (seg < 16) { prompt = true; b = seg; sidx = 0; tok_base = seg * 256; }
  else { int q = seg - 16; prompt = false; b = q >> 3; sidx = q & 7; tok_base = NPROMPT + b * 2048 + sidx * 256; }
}

template <bool STATE_ONLY>
DI void gla_chain(const Params& p, int l, char* smem, int seg, int hd, int dir) {
  const int tid = tid_(), lane = tid & 63, w = tid >> 6;
  const int fr = lane & 31, hh = lane >> 5;
  int tok_base, b, sidx;
  bool prompt;
  gla_segment_info(seg, tok_base, prompt, b, sidx);
  const int dk = tid & 63, tq = tid >> 6;
  const int dvl = tid & 127, th = tid >> 7;
  const int jw = w & 1, thw = w >> 1, dkm = 32 * jw + fr;
  bf16x8 wgB;
  {
    unsigned wp[4];
#pragma unroll
    for (int e = 0; e < 4; ++e) {
      const float w0 = p.wg_up[((size_t)(l * 2 + dir) * 16 + 8 * hh + 2 * e) * 256 + hd * 64 + dkm];
      const float w1 = p.wg_up[((size_t)(l * 2 + dir) * 16 + 8 * hh + 2 * e + 1) * 256 + hd * 64 + dkm];
      wp[e] = pack2(w0, w1);
    }
    wgB = __builtin_bit_cast(bf16x8, make_uint4(wp[0], wp[1], wp[2], wp[3]));
  }
  const float bgv = p.bg[(l * 2 + dir) * 256 + hd * 64 + dkm];
  float* sAv = (float*)(smem + GL_AV);
  float* sTot = (float*)(smem + GL_TOT);
  float* sOs = (float*)(smem + GL_OS);

  f32x16 S[2];
  {
    const int dvc = 32 * w + fr;
    if (STATE_ONLY || prompt) {
#pragma unroll
      for (int mt = 0; mt < 2; ++mt)
#pragma unroll
        for (int r = 0; r < 16; ++r) S[mt][r] = 0.f;
    } else {
      const float* sp = p.st_gla + ((size_t)(((b * 2 + l) * 2 + dir) * 4 + hd)) * 8192;
#pragma unroll
      for (int mt = 0; mt < 2; ++mt)
#pragma unroll
        for (int r = 0; r < 16; ++r) S[mt][r] = sp[(32 * mt + (r & 3) + 8 * (r >> 2) + 4 * hh) * 128 + dvc];
      const int nprev = dir == 0 ? sidx : 7 - sidx;
      if (nprev > 0) {
        f32x16 cs[2], ns[2];
        float4 ca[8], na[8];
#define GLA_SEG_LOAD(SS, AA, qq)                                                                       \
        {                                                                                              \
          const int sprev_ = dir == 0 ? (qq) : 7 - (qq);                                               \
          const size_t ci_ = (size_t)(((b * 8 + sprev_) * 4 + hd) * 2 + dir);                          \
          const float* sl_ = p.gla_sloc + ci_ * 8192 + dvc;                                            \
          const float* al_ = p.gla_aseg + ci_ * 64 + 4 * hh;                                           \
          _Pragma("unroll") for (int mt = 0; mt < 2; ++mt)                                             \
          _Pragma("unroll") for (int r = 0; r < 16; ++r)                                               \
            SS[mt][r] = sl_[(32 * mt + (r & 3) + 8 * (r >> 2) + 4 * hh) * 128];                        \
          _Pragma("unroll") for (int i = 0; i < 8; ++i) AA[i] = *(const float4*)(al_ + 8 * i);         \
        }
        GLA_SEG_LOAD(cs, ca, 0)
#pragma unroll 1
        for (int q = 0; q < nprev; ++q) {
          if (q + 1 < nprev) GLA_SEG_LOAD(ns, na, q + 1)
#pragma unroll
          for (int mt = 0; mt < 2; ++mt)
#pragma unroll
            for (int qq = 0; qq < 4; ++qq) {
              const float4 av = ca[mt * 4 + qq];
              S[mt][4 * qq + 0] = av.x * S[mt][4 * qq + 0] + cs[mt][4 * qq + 0];
              S[mt][4 * qq + 1] = av.y * S[mt][4 * qq + 1] + cs[mt][4 * qq + 1];
              S[mt][4 * qq + 2] = av.z * S[mt][4 * qq + 2] + cs[mt][4 * qq + 2];
              S[mt][4 * qq + 3] = av.w * S[mt][4 * qq + 3] + cs[mt][4 * qq + 3];
            }
          cs[0] = ns[0]; cs[1] = ns[1];
#pragma unroll
          for (int i = 0; i < 8; ++i) ca[i] = na[i];
        }
      }
    }
  }
  float bsum = 0.f;
  __syncthreads();
  if (!STATE_ONLY) {
    const int dvc = 32 * w + fr;
#pragma unroll
    for (int mt = 0; mt < 2; ++mt)
#pragma unroll
      for (int q = 0; q < 4; ++q) {
        uint2 pk;
        pk.x = pack2(S[mt][4 * q], S[mt][4 * q + 1]);
        pk.y = pack2(S[mt][4 * q + 2], S[mt][4 * q + 3]);
        *(uint2*)(smem + GL_ST + dvc * 144 + (32 * mt + 8 * q + 4 * hh) * 2) = pk;
      }
  }

  uint4 rq = make_uint4(0, 0, 0, 0), rk = rq, rv0 = rq, rv1 = rq, rgl = rq;
#define GLA_ISSUE(nn)                                                                                         \
  {                                                                                                           \
    const int cn_ = dir == 0 ? (nn) : 7 - (nn);                                                               \
    const int c0_ = tok_base + cn_ * 32;                                                                      \
    const int tA = dir == 0 ? (tid >> 3) : 31 - (tid >> 3);                                                   \
    const bfu* prA = p.proj + (size_t)(c0_ + tA) * PW + hd * 64 + (tid & 7) * 8;                              \
    if (!STATE_ONLY) rq = *(const uint4*)(prA + OFF_Q);                                                       \
    rk = *(const uint4*)(prA + OFF_K);                                                                        \
    const int tV0 = dir == 0 ? (tid >> 4) : 31 - (tid >> 4);                                                  \
    const int tV1 = dir == 0 ? (tid >> 4) + 16 : 15 - (tid >> 4);                                             \
    rv0 = *(const uint4*)(p.proj + (size_t)(c0_ + tV0) * PW + OFF_V + hd * 128 + (tid & 15) * 8);             \
    rv1 = *(const uint4*)(p.proj + (size_t)(c0_ + tV1) * PW + OFF_V + hd * 128 + (tid & 15) * 8);             \
    if (tid < 64) {                                                                                           \
      const int tG = dir == 0 ? (tid >> 1) : 31 - (tid >> 1);                                                 \
      rgl = *(const uint4*)(p.proj + (size_t)(c0_ + tG) * PW + OFF_GL + (tid & 1) * 8);                       \
    }                                                                                                         \
  }
  GLA_ISSUE(0)
  char* rawQ = smem + GL_OS;
  char* rawK = smem + GL_OS + 4096;
  char* rawV = smem + GL_OS + 8192;
  char* rawG = smem + GL_PS;

#pragma unroll 1
  for (int n = 0; n < 8; ++n) {
    const int cn = dir == 0 ? n : 7 - n;
    const int ctok0 = tok_base + cn * 32;
    __syncthreads();
    if (!STATE_ONLY) *(uint4*)(rawQ + (tid >> 3) * 128 + (tid & 7) * 16) = rq;
    *(uint4*)(rawK + (tid >> 3) * 128 + (tid & 7) * 16) = rk;
    *(uint4*)(rawV + (tid >> 4) * 256 + (tid & 15) * 16) = rv0;
    *(uint4*)(rawV + ((tid >> 4) + 16) * 256 + (tid & 15) * 16) = rv1;
    if (tid < 64) *(uint4*)(rawG + (tid >> 1) * 32 + (tid & 1) * 16) = rgl;
    if (n + 1 < 8) GLA_ISSUE(n + 1)
    __syncthreads();
    {
      f32x16 lg;
#pragma unroll
      for (int r = 0; r < 16; ++r) lg[r] = 0.f;
      const bf16x8 ga = *(const bf16x8*)(rawG + fr * 32 + hh * 16);
      lg = __builtin_amdgcn_mfma_f32_32x32x16_bf16(ga, wgB, lg, 0, 0, 0);
      float ls[16], gsum[4], psum[4];
#pragma unroll
      for (int r = 0; r < 16; ++r) {
        const float x = lg[r] + bgv;
        ls[r] = logsigmoidf_(x) * (1.f / 16.f);
      }
#pragma unroll
      for (int q = 0; q < 4; ++q) {
        gsum[q] = ls[4 * q] + ls[4 * q + 1] + ls[4 * q + 2] + ls[4 * q + 3];
        psum[q] = __shfl_xor(gsum[q], 32);
      }
      float off[4], run = 0.f;
#pragma unroll
      for (int q = 0; q < 4; ++q) {
        off[q] = run + (hh ? psum[q] : 0.f);
        run += gsum[q] + psum[q];
      }
      const float total = run;
#pragma unroll
      for (int qq = 0; qq < 2; ++qq) {
        float khv[4];
        float acc_b = 0.f;
#pragma unroll
        for (int i = 0; i < 4; ++i) {
          const float lsv = thw == 0 ? ls[4 * qq + i] : ls[8 + 4 * qq + i];
          const float offv = thw == 0 ? off[qq] : off[2 + qq];
          acc_b += lsv;
          const float bb = offv + acc_b;
          const int tau = 16 * thw + 8 * qq + 4 * hh + i;
          const float kvv = bf2f(*(const bfu*)(rawK + tau * 128 + dkm * 2));
          if (!STATE_ONLY) {
            const float qvv = bf2f(*(const bfu*)(rawQ + tau * 128 + dkm * 2)) * 0.125f;
            *(bfu*)(smem + GL_QS + tau * 144 + dkm * 2) = f2bf(qvv * __expf(bb));
            *(bfu*)(smem + GL_KS + tau * 144 + dkm * 2) = f2bf(kvv * __expf(-bb));
          }
          khv[i] = kvv * __expf(total - bb);
        }
        uint2 kh; kh.x = pack2(khv[0], khv[1]); kh.y = pack2(khv[2], khv[3]);
        *(uint2*)(smem + GL_KHT + dkm * 80 + (16 * thw + 8 * qq + 4 * hh) * 2) = kh;
      }
      if (thw == 0 && hh == 0) { sAv[dkm] = __expf(total); bsum += total; }
    }
    {
      unsigned pk[8];
#pragma unroll
      for (int i = 0; i < 8; ++i) {
        const int tau0 = th * 16 + 2 * i;
        const unsigned lo = *(const bfu*)(rawV + tau0 * 256 + dvl * 2);
        const unsigned hi = *(const bfu*)(rawV + (tau0 + 1) * 256 + dvl * 2);
        pk[i] = lo | (hi << 16);
      }
      *(uint4*)(smem + GL_VT + dvl * 80 + th * 32) = make_uint4(pk[0], pk[1], pk[2], pk[3]);
      *(uint4*)(smem + GL_VT + dvl * 80 + th * 32 + 16) = make_uint4(pk[4], pk[5], pk[6], pk[7]);
    }
    __syncthreads();
    f32x16 o;
    if (!STATE_ONLY) {
      f32x16 sc;
#pragma unroll
      for (int r = 0; r < 16; ++r) sc[r] = 0.f;
#pragma unroll
      for (int s4 = 0; s4 < 4; ++s4) {
        bf16x8 a = *(const bf16x8*)(smem + GL_QS + fr * 144 + (16 * s4 + 8 * hh) * 2);
        bf16x8 bq = *(const bf16x8*)(smem + GL_KS + fr * 144 + (16 * s4 + 8 * hh) * 2);
        sc = __builtin_amdgcn_mfma_f32_32x32x16_bf16(a, bq, sc, 0, 0, 0);
      }
#pragma unroll
      for (int rr = 0; rr < 4; ++rr) {
        float val = w == 0 ? sc[rr] : (w == 1 ? sc[4 + rr] : (w == 2 ? sc[8 + rr] : sc[12 + rr]));
        const int i = rr + 8 * w + 4 * hh;
        val = (fr <= i) ? val : 0.f;
        *(bfu*)(smem + GL_PS + i * 80 + fr * 2) = f2bf(val);
      }
      __syncthreads();
#pragma unroll
      for (int r = 0; r < 16; ++r) o[r] = 0.f;
    }
    {
      const int dvc = 32 * w + fr;
      bf16x8 vb0 = *(const bf16x8*)(smem + GL_VT + dvc * 80 + (8 * hh) * 2);
      bf16x8 vb1 = *(const bf16x8*)(smem + GL_VT + dvc * 80 + (16 + 8 * hh) * 2);
      if (!STATE_ONLY) {
        bf16x8 pa0 = *(const bf16x8*)(smem + GL_PS + fr * 80 + (8 * hh) * 2);
        bf16x8 pa1 = *(const bf16x8*)(smem + GL_PS + fr * 80 + (16 + 8 * hh) * 2);
        o = __builtin_amdgcn_mfma_f32_32x32x16_bf16(pa0, vb0, o, 0, 0, 0);
        o = __builtin_amdgcn_mfma_f32_32x32x16_bf16(pa1, vb1, o, 0, 0, 0);
#pragma unroll
        for (int s4 = 0; s4 < 4; ++s4) {
          bf16x8 a = *(const bf16x8*)(smem + GL_QS + fr * 144 + (16 * s4 + 8 * hh) * 2);
          bf16x8 sb = *(const bf16x8*)(smem + GL_ST + dvc * 144 + (16 * s4 + 8 * hh) * 2);
          o = __builtin_amdgcn_mfma_f32_32x32x16_bf16(a, sb, o, 0, 0, 0);
        }
      }
#pragma unroll
      for (int mt = 0; mt < 2; ++mt) {
        f32x16 U;
#pragma unroll
        for (int r = 0; r < 16; ++r) U[r] = 0.f;
        bf16x8 ka0 = *(const bf16x8*)(smem + GL_KHT + (32 * mt + fr) * 80 + (8 * hh) * 2);
        bf16x8 ka1 = *(const bf16x8*)(smem + GL_KHT + (32 * mt + fr) * 80 + (16 + 8 * hh) * 2);
        U = __builtin_amdgcn_mfma_f32_32x32x16_bf16(ka0, vb0, U, 0, 0, 0);
        U = __builtin_amdgcn_mfma_f32_32x32x16_bf16(ka1, vb1, U, 0, 0, 0);
#pragma unroll
        for (int q = 0; q < 4; ++q) {
          const float4 av = *(const float4*)(sAv + 32 * mt + 8 * q + 4 * hh);
          S[mt][4 * q + 0] = av.x * S[mt][4 * q + 0] + U[4 * q + 0];
          S[mt][4 * q + 1] = av.y * S[mt][4 * q + 1] + U[4 * q + 1];
          S[mt][4 * q + 2] = av.z * S[mt][4 * q + 2] + U[4 * q + 2];
          S[mt][4 * q + 3] = av.w * S[mt][4 * q + 3] + U[4 * q + 3];
          if (!STATE_ONLY) {
            uint2 pk;
            pk.x = pack2(S[mt][4 * q], S[mt][4 * q + 1]);
            pk.y = pack2(S[mt][4 * q + 2], S[mt][4 * q + 3]);
            *(uint2*)(smem + GL_ST + dvc * 144 + (32 * mt + 8 * q + 4 * hh) * 2) = pk;
          }
        }
      }
      if (!STATE_ONLY) {
#pragma unroll
        for (int r = 0; r < 16; ++r) sOs[((r & 3) + 8 * (r >> 2) + 4 * hh) * 132 + dvc] = o[r];
      }
    }
    __syncthreads();
    if (!STATE_ONLY) {
      const int t = tid >> 3, part = tid & 7;
      const int tau = dir == 0 ? t : 31 - t;
      const size_t tok = (size_t)(ctok0 + t);
      float ov[16];
#pragma unroll
      for (int q = 0; q < 4; ++q) {
        const float4 x = *(const float4*)(sOs + tau * 132 + part * 16 + 4 * q);
        ov[4 * q] = x.x; ov[4 * q + 1] = x.y; ov[4 * q + 2] = x.z; ov[4 * q + 3] = x.w;
      }
      bfu* op = p.gla_o + ((size_t)dir * NTOK + tok) * 512 + hd * 128 + part * 16;
      *(uint4*)op = pack8(*(float(*)[8])&ov[0]);
      *(uint4*)(op + 8) = pack8(*(float(*)[8])&ov[8]);
    }
  }
  const int dvc = 32 * w + fr;
  if (STATE_ONLY) {
    const size_t ci = (size_t)(((b * 8 + sidx) * 4 + hd) * 2 + dir);
    float* sl = p.gla_sloc + ci * 8192;
#pragma unroll
    for (int mt = 0; mt < 2; ++mt)
#pragma unroll
      for (int r = 0; r < 16; ++r) sl[(32 * mt + (r & 3) + 8 * (r >> 2) + 4 * hh) * 128 + dvc] = S[mt][r];
    if (thw == 0 && hh == 0) p.gla_aseg[ci * 64 + dkm] = __expf(bsum);
  } else if (prompt) {
    float* op = p.out + OUT_GLA + ((size_t)(((b * 2 + l) * 2 + dir) * 4 + hd)) * 8192;
#pragma unroll
    for (int mt = 0; mt < 2; ++mt)
#pragma unroll
      for (int r = 0; r < 16; ++r) op[(32 * mt + (r & 3) + 8 * (r >> 2) + 4 * hh) * 128 + dvc] = S[mt][r];
  }
  __syncthreads();
}

DI void phase_gla_pass1(const Params& p, int l, char* smem) {
  for (int it = NVB - 1 - VBID; it < 256; it += NVB) {
    const int dir = it & 1, hd = (it >> 1) & 3, seg = 16 + (it >> 3);
    gla_chain<true>(p, l, smem, seg, hd, dir);
  }
}
DI void phase_gla_main(const Params& p, int l, char* smem) {
  for (int it = NVB - 1 - VBID; it < 384; it += NVB) {
    const int dir = it & 1, hd = (it >> 1) & 3, seg = it >> 3;
    gla_chain<false>(p, l, smem, seg, hd, dir);
  }
}
DI void phase_gla_norm(const Params& p, int l, int part) {
  const int tid = tid_(), lane = tid & 63, w = tid >> 6;
  const int ib = (VJ - 48) * 8 + VXCD;
  for (int it = part * (NTOK / 8) + (VJ >= 48 ? ib : NTOK); it < (part + 1) * (NTOK / 8); it += 128) {
    const int tok = it * 4 + w;
    float a[8], b[8], gt[8], res[8];
    unpack8(*(const uint4*)(p.gla_o + (size_t)tok * 512 + lane * 8), a);
    unpack8(*(const uint4*)(p.gla_o + ((size_t)NTOK + tok) * 512 + lane * 8), b);
    unpack8(*(const uint4*)(p.proj + (size_t)tok * PW + OFF_GB + lane * 8), gt);
    float ss = 0.f;
#pragma unroll
    for (int e = 0; e < 8; ++e) { a[e] += b[e]; ss += a[e] * a[e]; }
    ss += __shfl_xor(ss, 1); ss += __shfl_xor(ss, 2); ss += __shfl_xor(ss, 4); ss += __shfl_xor(ss, 8);
    const float rs = rsqrtf(ss * (1.f / 128.f) + EPS);
    const float* g = p.gla_norm_g + l * 512 + lane * 8;
#pragma unroll
    for (int e = 0; e < 8; ++e) res[e] = a[e] * rs * g[e] * siluf_(gt[e]);
    *(uint4*)(p.yb + (size_t)tok * 512 + lane * 8) = pack8(res);
  }
}

DI void phase_merge(const Params& p, int l, char* smem) {
  const bfu* WA = p.w_paT + (size_t)l * 1024 * 512;
  const bfu* WB = p.w_pbT + (size_t)l * 1024 * 512;
  for (int iter = 0;; ++iter) {
    int mt, nt;
    if (!tile256(iter, 4, mt, nt)) break;
    const int m0 = mt * 256, n0 = nt * 256;
    f32x4 acc[2][2][4][2];
    acc256_zero(acc);
    gemm256(p.ya, 512, WA, 512, 512, m0, n0, (bfu*)smem, acc);
    uint4 pg[8], pq[8];
#define MERGE_PRE1 pg[it_] = *(const uint4*)(p.proj + (size_t)(m0 + row) * PW + OFF_MA + n0 + c0);
#define MERGE_PRE2 pg[it_] = *(const uint4*)(p.proj + (size_t)(m0 + row) * PW + OFF_MB + n0 + c0); \
                   pq[it_] = *(const uint4*)(p.merged + (size_t)(m0 + row) * D + n0 + c0);
    EPI256P(MERGE_PRE1, {
      float ma[8], o[8];
      unpack8(pg[it_], ma);
      _Pragma("unroll") for (int e = 0; e < 8; ++e) o[e] = sigmoidf_(ma[e]) * v[e];
      *(uint4*)(p.merged + (size_t)(m0 + row) * D + n0 + c0) = pack8(o);
    })
    acc256_zero(acc);
    gemm256(p.yb, 512, WB, 512, 512, m0, n0, (bfu*)smem, acc);
    EPI256P(MERGE_PRE2, {
      float mb[8], o[8], pr[8];
      unpack8(pg[it_], mb);
      uint4* mp = (uint4*)(p.merged + (size_t)(m0 + row) * D + n0 + c0);
      unpack8(pq[it_], pr);
      _Pragma("unroll") for (int e = 0; e < 8; ++e) o[e] = pr[e] + sigmoidf_(mb[e]) * v[e];
      *mp = pack8(o);
    })
  }
}

DI void phase_out(const Params& p, int l, char* smem) {
  const bfu* W = p.w_oT + (size_t)l * 1024 * 1024;
  for (int iter = 0;; ++iter) {
    int mt, nt;
    if (!tile256(iter, 4, mt, nt)) break;
    const int m0 = mt * 256, n0 = nt * 256;
    f32x4 acc[2][2][4][2];
    acc256_zero(acc);
    gemm256(p.merged, D, W, 1024, 1024, m0, n0, (bfu*)smem, acc);
    const float* gate = p.mod + (size_t)(l * 5 + cond_of_tok(m0)) * 3072 + 2048;
    float4 px0[8], px1[8];
    const float* xsrc = l == 0 ? (m0 < NPROMPT ? p.x_prompt : p.x_sample - (size_t)NPROMPT * D) : p.out;
#define OUT_PRE px0[it_] = *(const float4*)(xsrc + (size_t)(m0 + row) * D + n0 + c0); \
                px1[it_] = *(const float4*)(xsrc + (size_t)(m0 + row) * D + n0 + c0 + 4);
    EPI256P(OUT_PRE, {
      float* xp = p.out + (size_t)(m0 + row) * D + n0 + c0;
      const float* gp = gate + n0 + c0;
      float4 x0 = px0[it_], x1 = px1[it_];
      if (l == 0 && m0 >= NPROMPT) {
        const int t = (m0 + row - NPROMPT) & 2047, col = n0 + c0;
        const float* pe = col < 512 ? p.pos_r + (t >> 6) * 512 + col : p.pos_c + (t & 63) * 512 + (col - 512);
        const float4 e0 = *(const float4*)pe, e1 = *(const float4*)(pe + 4);
        x0.x += e0.x; x0.y += e0.y; x0.z += e0.z; x0.w += e0.w;
        x1.x += e1.x; x1.y += e1.y; x1.z += e1.z; x1.w += e1.w;
      }
      float4 g0 = *(const float4*)gp, g1 = *(const float4*)(gp + 4);
      {
        const float4 h0 = *(const float4*)(gp + MODH), h1 = *(const float4*)(gp + MODH + 4);
        g0.x += h0.x; g0.y += h0.y; g0.z += h0.z; g0.w += h0.w;
        g1.x += h1.x; g1.y += h1.y; g1.z += h1.z; g1.w += h1.w;
      }
      x0.x += g0.x * v[0]; x0.y += g0.y * v[1]; x0.z += g0.z * v[2]; x0.w += g0.w * v[3];
      x1.x += g1.x * v[4]; x1.y += g1.y * v[5]; x1.z += g1.z * v[6]; x1.w += g1.w * v[7];
      *(float4*)xp = x0; *(float4*)(xp + 4) = x1;
    })
  }
}

DI void phase_final(const Params& p) {
  const int tid = tid_(), lane = tid & 63, w = tid >> 6;
  for (int it = VBID; it < NTOK / 4; it += NVB) {
    const int tok = it * 4 + w;
    float* xs = p.out + (size_t)tok * D;
    float4 v[4];
#pragma unroll
    for (int i = 0; i < 4; ++i) v[i] = *(const float4*)(xs + lane * 4 + 256 * i);
    float ss = 0.f;
#pragma unroll
    for (int i = 0; i < 4; ++i) ss += v[i].x * v[i].x + v[i].y * v[i].y + v[i].z * v[i].z + v[i].w * v[i].w;
    ss = wave_sum(ss);
    const float rstd = rsqrtf(ss * (1.f / 1024.f) + EPS);
#pragma unroll
    for (int i = 0; i < 4; ++i) {
      float4 g = *(const float4*)(p.final_g + lane * 4 + 256 * i);
      float4 o;
      o.x = v[i].x * rstd * g.x; o.y = v[i].y * rstd * g.y; o.z = v[i].z * rstd * g.z; o.w = v[i].w * rstd * g.w;
      *(float4*)(xs + lane * 4 + 256 * i) = o;
    }
  }
}

#define XB_TMO      128
#define XB_XCNT(j)  (256  + 64 * (j))
#define XB_XSUB(j)  (1280 + 64 * (j))
#define XB_XGEN(j)  (2304 + 64 * (j))
#define XB_TOP      3328
#define XB_TOPGEN   3392
#define XCD_BAR_WORDS 3456
#define XB_SPIN_CAP (1u << 18)
#define LAS __attribute__((address_space(3)))
DI unsigned xb_ld(unsigned* p) { return __hip_atomic_load(p, __ATOMIC_RELAXED, __HIP_MEMORY_SCOPE_AGENT); }
DI unsigned xb_add(unsigned* p, unsigned v) { return __hip_atomic_fetch_add(p, v, __ATOMIC_RELAXED, __HIP_MEMORY_SCOPE_AGENT); }
DI unsigned xb_xcc_id() { return (unsigned)__builtin_amdgcn_s_getreg((3 << 11) | 20) & 0xFu; }
#define XB_SPIN(cond, bar) do { unsigned _sp = 0; while (cond) { __builtin_amdgcn_s_sleep(1); \
    if ((++_sp & 255u) == 0u) { if (xb_ld(&(bar)[XB_TMO])) break; if (_sp > XB_SPIN_CAP) { atomicAdd(&(bar)[XB_TMO], 1u); break; } } } } while (0)
struct XcdBarrier { unsigned* bar; unsigned x; volatile LAS unsigned* st; };
DI XcdBarrier xcd_barrier_post(unsigned* bar, volatile LAS unsigned* st) {
  XcdBarrier b; b.bar = bar; b.x = xb_xcc_id(); b.st = st;
  if (threadIdx.x == 0) (void)xb_add(&bar[XB_XCNT(b.x)], 1u);
  return b;
}
DI void xcd_barrier_complete(unsigned* bar, unsigned x, unsigned& nloc, unsigned& nx) {
  const unsigned G = gridDim.x * gridDim.y * gridDim.z;
  unsigned sum, cnt, mine, sp = 0u;
  for (;;) {
    sum = 0u; cnt = 0u; mine = 0u;
#pragma unroll
    for (unsigned j = 0; j < 16; ++j) { const unsigned c = xb_ld(&bar[XB_XCNT(j)]); sum += c; cnt += (c > 0u) ? 1u : 0u; mine = (j == x) ? c : mine; }
    if (sum == G) break;
    __builtin_amdgcn_s_sleep(1);
    if ((++sp & 255u) == 0u) { if (xb_ld(&bar[XB_TMO])) break; if (sp > XB_SPIN_CAP) { atomicAdd(&bar[XB_TMO], 1u); break; } }
  }
  nloc = mine > 0u ? mine : 1u; nx = cnt > 0u ? cnt : 1u;
}
DI void xcd_barrier(const XcdBarrier& b) {
  asm volatile("s_waitcnt vmcnt(0)" ::: "memory");
  __syncthreads();
  if (threadIdx.x == 0) {
    unsigned* bar = b.bar;
    __builtin_amdgcn_s_waitcnt(0);
    unsigned nloc = b.st[0], nx = b.st[1];
    if (nloc == 0u) { xcd_barrier_complete(bar, b.x, nloc, nx); b.st[0] = nloc; b.st[1] = nx; }
    const unsigned old = xb_add(&bar[XB_XSUB(b.x)], 1u);
    const unsigned gen = old / nloc;
    if (old + 1u == (gen + 1u) * nloc) {
      __builtin_amdgcn_fence(__ATOMIC_RELEASE, "agent");
      asm volatile("s_waitcnt vmcnt(0)" ::: "memory");
      const unsigned og = xb_add(&bar[XB_TOP], 1u);
      const unsigned tg = og / nx;
      if (og + 1u == (tg + 1u) * nx) xb_add(&bar[XB_TOPGEN], 1u);
      else XB_SPIN(xb_ld(&bar[XB_TOPGEN]) == tg, bar);
      __builtin_amdgcn_fence(__ATOMIC_ACQUIRE, "agent");
      xb_add(&bar[XB_XGEN(b.x)], 1u);
      asm volatile("s_waitcnt vmcnt(0)" ::: "memory");
    } else {
      XB_SPIN(xb_ld(&bar[XB_XGEN(b.x)]) == gen, bar);
      __builtin_amdgcn_fence(__ATOMIC_ACQUIRE, "agent");
      asm volatile("s_waitcnt vmcnt(0)" ::: "memory");
    }
  }
  __syncthreads();
}

#ifndef REP_SYNC
#define REP_SYNC 0
#endif
__global__ void __launch_bounds__(512, 2) k_mega(Params p) {
  extern __shared__ __attribute__((aligned(16))) char smem_all[];
  cg::grid_group grid = cg::this_grid();
  char* smem = smem_all;
#define smh (smem_all + VHALF * 65536)
  volatile LAS unsigned* xst = (volatile LAS unsigned*)(smem_all + 131072);
  if (threadIdx.x < 4) xst[threadIdx.x] = 0u;
  __syncthreads();
  XcdBarrier xb = xcd_barrier_post(p.bar, xst);
#define GSYNC() xcd_barrier(xb)
  phase_prep(p, smh);
  phase_s5_gen(p, 0, smh);
  GSYNC();
  if (p.bar == nullptr) grid.sync();
  for (int l = 0; l < 2; ++l) {
    phase_h(p, l);
    GSYNC();
    phase_gemm_in(p, l, smem);
    GSYNC();
    phase_s5_e(p, smh);
    phase_gla_pass1(p, l, smh);
    GSYNC();
    phase_s5_scan(p, l);
    phase_gla_main(p, l, smh);
    GSYNC();
    phase_s5_y(p, l, smh);
    phase_gla_norm(p, l, 0);
    GSYNC();
    phase_glu(p, l, smh);
    phase_gla_norm(p, l, 1);
    GSYNC();
    phase_merge(p, l, smem);
    if (l == 0 && (blockIdx.x >> 3) >= 24) {
      const int hb = (int)((((blockIdx.x >> 3) - 24) * 8 + (blockIdx.x & 7)) * 2) + VHALF;
      s5_gen_item(p, 1, hb, smh);
    }
    GSYNC();
    phase_out(p, l, smem);
    if (l == 0 && (blockIdx.x >> 3) >= 24) {
      const int hb = (int)((((blockIdx.x >> 3) - 24) * 8 + (blockIdx.x & 7)) * 2) + VHALF;
      s5_gen_item(p, 1, hb + 128, smh);
    }
    GSYNC();
    for (int rep = 0; rep < REP_SYNC; ++rep) GSYNC();
  }
  phase_final(p);
}

extern "C" void kernel_launch(void* const* d_in, const int* in_sizes, int n_in, void* d_out, int out_size,
                              void* d_ws, size_t ws_size, hipStream_t stream) {
  Params p{};
  const float* const* in = (const float* const*)d_in;
  p.x_prompt = in[0]; p.x_sample = in[1]; p.c = in[2]; p.st_re = in[3]; p.st_im = in[4]; p.st_gla = in[5];
  p.c_ctx = in[6]; p.norm_g = in[7]; p.w_mod = in[8]; p.b_mod = in[9]; p.w_in = in[10]; p.wg_up = in[11];
  p.bg = in[12]; p.gla_norm_g = in[13]; p.lam_re = in[14]; p.lam_im = in[15]; p.log_dt = in[16];
  p.b_re = in[17]; p.b_im = in[18]; p.c_re = in[19]; p.c_im = in[20]; p.s5_d = in[21]; p.w_glu = in[22];
  p.b_glu = in[23]; p.w_pa = in[24]; p.w_pb = in[25]; p.w_o = in[26]; p.final_g = in[27];
  p.out = (float*)d_out;
  char* ws = (char*)d_ws;
  size_t off = 0;
  auto take = [&](size_t bytes) { char* r = ws + off; off += (bytes + 255) & ~(size_t)255; return r; };
  p.w_inT = (bfu*)take((size_t)2 * DINP * LDH * 2);
  p.w_gluT = (bfu*)take((size_t)2 * 512 * 512 * 2);
  p.w_paT = (bfu*)take((size_t)2 * 1024 * 512 * 2);
  p.w_pbT = (bfu*)take((size_t)2 * 1024 * 512 * 2);
  p.w_oT = (bfu*)take((size_t)2 * 1024 * 1024 * 2);
  p.pos_r = (float*)take((size_t)32 * 512 * 4);
  p.pos_c = (float*)take((size_t)64 * 512 * 4);
  p.h = (bfu*)take((size_t)NTOK * LDH * 2);
  p.proj = (bfu*)take((size_t)NTOK * PW * 2);
  p.ys5 = (bfu*)take((size_t)NTOK * 512 * 2);
  p.ya = (bfu*)take((size_t)NTOK * 512 * 2);
  p.yb = (bfu*)take((size_t)NTOK * 512 * 2);
  p.merged = (bfu*)take((size_t)NTOK * D * 2);
  p.tmp_s5 = nullptr;
  p.ebuf = (float*)p.merged;
  p.carry = (bfu*)((char*)p.merged + (size_t)32 * NCHUNK * 256 * 4);
  p.ug = (bfu*)take((size_t)32 * NTOK * 16 * 2);
  p.opMG = (bfu*)take((size_t)32 * 512 * 768 * 2);
  p.opE = (bfu*)take((size_t)32 * 256 * 512 * 2);
  p.gla_sloc = (float*)p.ys5;
  p.gla_aseg = (float*)((char*)p.ys5 + (size_t)256 * 8192 * 4);
  if (off > ws_size) fprintf(stderr, "workspace too small: %zu > %zu\n", off, ws_size);
  p.bar = (unsigned*)take((size_t)XCD_BAR_WORDS * 4);
  p.mod = (float*)take((size_t)2 * 2 * 5 * 3072 * 4);
  p.gla_o = (bfu*)p.h;
  p.tmp_gla = (float*)p.h;
  constexpr size_t kLds = 131072 + 16;
  static int grid_blocks = 0;
  if (!grid_blocks) {
    int dev = 0, cus = 0, per_cu = 0;
    hipGetDevice(&dev);
    hipDeviceGetAttribute(&cus, hipDeviceAttributeMultiprocessorCount, dev);
    hipFuncSetAttribute((const void*)k_mega, hipFuncAttributeMaxDynamicSharedMemorySize, (int)kLds);
    hipOccupancyMaxActiveBlocksPerMultiprocessor(&per_cu, k_mega, 512, kLds);
    if (per_cu > 1) per_cu = 1;
    grid_blocks = cus * per_cu;
    if (grid_blocks % 8 != 0 || grid_blocks <= 0) fprintf(stderr, "unexpected grid %d\n", grid_blocks);
  }
  hipMemsetAsync(p.bar, 0, (size_t)XCD_BAR_WORDS * 4, stream);
  void* args[] = {&p};
  hipError_t e = hipLaunchCooperativeKernel((void*)k_mega, dim3(grid_blocks), dim3(512), args, kLds, stream);
  if (e != hipSuccess) fprintf(stderr, "cooperative launch failed: %s (grid %d)\n", hipGetErrorString(e), grid_blocks);
}
```

```cpp
#include <hip/hip_runtime.h>
#include <hip/hip_cooperative_groups.h>
#include <stdint.h>
#include <math.h>
#include <stdio.h>
namespace cg = cooperative_groups;

#ifndef REP_PREP
#define REP_PREP 0
#endif
#ifndef REP_GIN
#define REP_GIN 0
#endif
#ifndef REP_X1
#define REP_X1 0
#endif
#ifndef REP_X2
#define REP_X2 0
#endif
#ifndef REP_Y
#define REP_Y 0
#endif
#ifndef REP_MERGE
#define REP_MERGE 0
#endif
#ifndef REP_SYNC
#define REP_SYNC 0
#endif
#ifndef ONE_LAUNCH
#define ONE_LAUNCH 1
#endif

typedef unsigned short bfu;
typedef __attribute__((ext_vector_type(8))) short bf16x8;
typedef __attribute__((ext_vector_type(16))) float f32x16;
typedef __attribute__((ext_vector_type(2))) __bf16 bf2_t;
typedef __attribute__((ext_vector_type(2))) float f2_t;

#define DI __device__ __forceinline__

constexpr int D = 1024;
constexpr int NTOK = 12288;
constexpr int NPROMPT = 4096;
constexpr int DIN = 4624;
constexpr int DINP = 4864;
constexpr int LDH = 1088;
constexpr int PW = 4112;
constexpr int OFF_GA = 0, OFF_Q = 512, OFF_K = 768, OFF_V = 1024, OFF_GB = 1536, OFF_GL = 2048,
              OFF_MA = 2064, OFF_MB = 3088;
constexpr int NCHUNK = NTOK / 32;
constexpr size_t OUT_RE = (size_t)NTOK * D;
constexpr size_t OUT_IM = OUT_RE + 131072;
constexpr size_t OUT_GLA = OUT_IM + 131072;
constexpr float EPS = 1e-6f;
constexpr int MODH = 2 * 5 * 3072;

struct Params {
  const float *x_prompt, *x_sample, *c, *st_re, *st_im, *st_gla, *c_ctx, *norm_g, *w_mod, *b_mod, *w_in,
      *wg_up, *bg, *gla_norm_g, *lam_re, *lam_im, *log_dt, *b_re, *b_im, *c_re, *c_im, *s5_d, *w_glu,
      *b_glu, *w_pa, *w_pb, *w_o, *final_g;
  float* out;
  bfu *w_inT, *w_gluT, *w_paT, *w_pbT, *w_oT;
  float *mod, *pos_r, *pos_c, *tmp_s5, *tmp_gla;
  bfu *h, *proj, *ys5, *ya, *yb, *merged;
  bfu *ug, *opMG, *opE, *carry;
  float *ebuf, *gla_sloc, *gla_aseg;
  unsigned* bar;
  bfu* gla_o;
};

DI int tid_() { int t = threadIdx.x & 255; asm volatile("" : "+v"(t)); return t; }
#define VHALF ((int)__builtin_amdgcn_readfirstlane((int)(threadIdx.x >> 8)))
#define VBID ((int)(blockIdx.x * 2 + VHALF))
#define NVB ((int)(gridDim.x * 2))
#define VXCD ((int)(blockIdx.x & 7))
#define VJ ((int)((blockIdx.x >> 3) * 2 + VHALF))
#define VNLOC ((int)((gridDim.x >> 3) * 2))
DI float bf2f(bfu v) { return __uint_as_float(((unsigned)v) << 16); }
DI bfu f2bf(float x) { __bf16 b = (__bf16)x; return __builtin_bit_cast(unsigned short, b); }
DI unsigned pack2(float lo, float hi) {
  f2_t v = {lo, hi};
  bf2_t w = __builtin_convertvector(v, bf2_t);
  return __builtin_bit_cast(unsigned, w);
}
DI float exp2f_(float x) { return __builtin_amdgcn_exp2f(x); }
DI float sigmoidf_(float x) { return __builtin_amdgcn_rcpf(1.f + exp2f_(-1.44269504f * x)); }
DI float siluf_(float x) { return x * sigmoidf_(x); }
DI float geluf_(float x) {
  float u = 0.7978845608028654f * (x + 0.044715f * x * x * x);
  float t = 1.f - 2.f * __builtin_amdgcn_rcpf(exp2f_(2.88539008f * u) + 1.f);
  return 0.5f * x * (1.f + t);
}
DI float logsigmoidf_(float x) {
  return fminf(x, 0.f) - 0.69314718f * __builtin_amdgcn_logf(1.f + exp2f_(-1.44269504f * fabsf(x)));
}
DI float wave_sum(float v) {
#pragma unroll
  for (int o = 32; o >= 1; o >>= 1) v += __shfl_xor(v, o);
  return v;
}
DI void unpack8(const uint4 v, float (&f)[8]) {
  f[0] = __uint_as_float(v.x << 16); f[1] = __uint_as_float(v.x & 0xffff0000u);
  f[2] = __uint_as_float(v.y << 16); f[3] = __uint_as_float(v.y & 0xffff0000u);
  f[4] = __uint_as_float(v.z << 16); f[5] = __uint_as_float(v.z & 0xffff0000u);
  f[6] = __uint_as_float(v.w << 16); f[7] = __uint_as_float(v.w & 0xffff0000u);
}
DI uint4 pack8(const float (&f)[8]) {
  uint4 o;
  o.x = pack2(f[0], f[1]); o.y = pack2(f[2], f[3]); o.z = pack2(f[4], f[5]); o.w = pack2(f[6], f[7]);
  return o;
}
DI int cond_of_tok(int tok) { return tok < NPROMPT ? 0 : 1 + ((tok - NPROMPT) >> 11); }

DI void transpose_tile(const float* __restrict__ src, int K, int N, bfu* __restrict__ dst, int kt, int nt,
                       float* sm, int ldd = 0) {
  if (ldd == 0) ldd = K;
  const int tid = tid_(), c = tid & 63, r4 = tid >> 6;
  const int k0 = kt * 64, n0 = nt * 64;
  float v[16];
  const bool inb = (n0 + c) < N;
#pragma unroll
  for (int i = 0; i < 16; ++i) v[i] = inb ? src[(size_t)(k0 + i * 4 + r4) * N + n0 + c] : 0.f;
#pragma unroll
  for (int i = 0; i < 16; ++i) sm[(i * 4 + r4) * 65 + c] = v[i];
  __syncthreads();
  {
    const int n = tid >> 2, kc = tid & 3;
    float o[16];
#pragma unroll
    for (int i = 0; i < 16; ++i) o[i] = sm[(kc * 16 + i) * 65 + n];
    bfu* dp = dst + (size_t)(n0 + n) * ldd + k0 + kc * 16;
    *(uint4*)dp = pack8(*(float(*)[8])&o[0]);
    *(uint4*)(dp + 8) = pack8(*(float(*)[8])&o[8]);
  }
  __syncthreads();
}

DI void phase_prep(const Params& p, char* smem) {
  float* sm = (float*)smem;
  const int tid = tid_();
  for (int it = VBID; it < 192; it += NVB) {
    const int kh = it & 1, jb = (it >> 1) % 48, l = it / 96;
    float* ssil = sm;
    float* sred = sm + 5 * 512;
    for (int idx = tid; idx < 2560; idx += 256) {
      int ci = idx >> 9, k = (idx & 511) + kh * 512;
      float cv = (ci == 0) ? p.c_ctx[k] : p.c[(ci - 1) * 1024 + k];
      ssil[idx] = cv / (1.f + expf(-cv));
    }
    __syncthreads();
    const int jj = tid & 63, kq = tid >> 6;
    const int j = jb * 64 + jj;
    float acc[5] = {0.f, 0.f, 0.f, 0.f, 0.f};
    const float* wp = p.w_mod + ((size_t)l * 1024 + kh * 512 + kq * 128) * 3072 + j;
#pragma unroll 16
    for (int k = 0; k < 128; ++k) {
      float w = wp[(size_t)k * 3072];
#pragma unroll
      for (int ci = 0; ci < 5; ++ci) acc[ci] += ssil[ci * 512 + kq * 128 + k] * w;
    }
#pragma unroll
    for (int ci = 0; ci < 5; ++ci) sred[(kq * 5 + ci) * 64 + jj] = acc[ci];
    __syncthreads();
    for (int idx = tid; idx < 320; idx += 256) {
      int ci = idx >> 6, j2 = idx & 63;
      float sv = kh == 0 ? p.b_mod[l * 3072 + jb * 64 + j2] : 0.f;
#pragma unroll
      for (int q = 0; q < 4; ++q) sv += sred[(q * 5 + ci) * 64 + j2];
      p.mod[((size_t)(kh * 2 + l) * 5 + ci) * 3072 + jb * 64 + j2] = sv;
    }
    __syncthreads();
  }
  for (int idx = VBID * 256 + tid; idx < 96 * 512; idx += NVB * 256) {
    int r = idx >> 9, i = idx & 511;
    int pos = r < 32 ? r : r - 32;
    int q = i & 255;
    double f = exp(-log(10000.0) * (double)q / 256.0);
    double ang = (double)pos * f;
    float v = (float)((i < 256) ? sin(ang) : cos(ang));
    if (r < 32) p.pos_r[r * 512 + i] = v; else p.pos_c[(r - 32) * 512 + i] = v;
  }
  for (int it = VBID; it < 3584; it += NVB) {
    int l = it / 1792, r = it % 1792;
    if (r < 1216) {
      transpose_tile(p.w_in + (size_t)l * 1024 * DIN, 1024, DIN, p.w_inT + (size_t)l * DINP * LDH, r % 16, r / 16, sm, LDH);
    } else if (r < 1280) {
      r -= 1216;
      transpose_tile(p.w_glu + (size_t)l * 512 * 512, 512, 512, p.w_gluT + (size_t)l * 512 * 512, r % 8, r / 8, sm);
    } else if (r < 1408) {
      r -= 1280;
      transpose_tile(p.w_pa + (size_t)l * 512 * 1024, 512, 1024, p.w_paT + (size_t)l * 1024 * 512, r % 8, r / 8, sm);
    } else if (r < 1536) {
      r -= 1408;
      transpose_tile(p.w_pb + (size_t)l * 512 * 1024, 512, 1024, p.w_pbT + (size_t)l * 1024 * 512, r % 8, r / 8, sm);
    } else {
      r -= 1536;
      transpose_tile(p.w_o + (size_t)l * 1024 * 1024, 1024, 1024, p.w_oT + (size_t)l * 1024 * 1024, r % 16, r / 16, sm);
    }
  }
}

DI void phase_h(const Params& p, int l) {
  const int tid = tid_(), lane = tid & 63, w = tid >> 6;
  for (int it = VBID; it < NTOK / 4; it += NVB) {
    const int tok = it * 4 + w;
    float4 v[4];
    float* xs = p.out + (size_t)tok * D;
    if (l == 0) {
      const float* src = tok < NPROMPT ? p.x_prompt + (size_t)tok * D : p.x_sample + (size_t)(tok - NPROMPT) * D;
#pragma unroll
      for (int i = 0; i < 4; ++i) v[i] = *(const float4*)(src + lane * 4 + 256 * i);
      if (tok >= NPROMPT) {
        int t = (tok - NPROMPT) & 2047, row = t >> 6, col = t & 63;
#pragma unroll
        for (int i = 0; i < 4; ++i) {
          int d = lane * 4 + 256 * i;
          const float* pe = d < 512 ? p.pos_r + row * 512 + d : p.pos_c + col * 512 + (d - 512);
          float4 e = *(const float4*)pe;
          v[i].x += e.x; v[i].y += e.y; v[i].z += e.z; v[i].w += e.w;
        }
      }
    } else {
#pragma unroll
      for (int i = 0; i < 4; ++i) v[i] = *(const float4*)(xs + lane * 4 + 256 * i);
    }
    float ss = 0.f;
#pragma unroll
    for (int i = 0; i < 4; ++i) ss += v[i].x * v[i].x + v[i].y * v[i].y + v[i].z * v[i].z + v[i].w * v[i].w;
    ss = wave_sum(ss);
    const float rstd = rsqrtf(ss * (1.f / 1024.f) + EPS);
    const float* md = p.mod + (size_t)(l * 5 + cond_of_tok(tok)) * 3072;
    const float* ng = p.norm_g + l * 1024;
#pragma unroll
    for (int i = 0; i < 4; ++i) {
      int d = lane * 4 + 256 * i;
      float4 g = *(const float4*)(ng + d);
      float4 sh = *(const float4*)(md + d);
      float4 sc = *(const float4*)(md + 1024 + d);
      {
        const float4 sh1 = *(const float4*)(md + MODH + d);
        const float4 sc1 = *(const float4*)(md + MODH + 1024 + d);
        sh.x += sh1.x; sh.y += sh1.y; sh.z += sh1.z; sh.w += sh1.w;
        sc.x += sc1.x; sc.y += sc1.y; sc.z += sc1.z; sc.w += sc1.w;
      }
      float a0 = v[i].x * rstd * g.x * (1.f + sc.x) + sh.x;
      float a1 = v[i].y * rstd * g.y * (1.f + sc.y) + sh.y;
      float a2 = v[i].z * rstd * g.z * (1.f + sc.z) + sh.z;
      float a3 = v[i].w * rstd * g.w * (1.f + sc.w) + sh.w;
      uint2 o; o.x = pack2(a0, a1); o.y = pack2(a2, a3);
      *(uint2*)(p.h + (size_t)tok * LDH + d) = o;
    }
  }
}

DI void gemm_core(const bfu* A, int lda, const bfu* __restrict__ B, int ldb, int K, char* smem,
                  f32x16 (&acc)[2][2], const bfu* A2, int lda2, int K2) {
  const int tid = tid_(), lane = tid & 63, w = tid >> 6, wm = w >> 1, wn = w & 1;
  const int c8 = tid & 7, r0 = tid >> 3;
  const bfu* ga = A + (size_t)r0 * lda + c8 * 8;
  const bfu* gb = B + (size_t)r0 * ldb + c8 * 8;
  const int st_off = r0 * 128 + ((c8 ^ ((r0 >> 1) & 7)) * 16);
  const int fr = lane & 31, hh = lane >> 5, fsw = (fr >> 1) & 7;
  const int a_base = (wm * 64 + fr) * 128;
  const int b_base = 16384 + (wn * 64 + fr) * 128;
  uint4 ra0, ra1, ra2, ra3, rb0, rb1, rb2, rb3, qa0, qa1, qa2, qa3, qb0, qb1, qb2, qb3;
  const int KT1 = K >> 6, KT = (K + K2) >> 6;
  const bfu* ga2 = A2 + (size_t)r0 * lda2 + c8 * 8;
#define GEMM_LOADT(RA, RB, tile)                                                           \
  {                                                                                        \
    const int t_ = (tile) < KT ? (tile) : KT - 1;                                          \
    const bool s2_ = t_ >= KT1;                                                            \
    const bfu* ga_ = s2_ ? ga2 + (t_ - KT1) * 64 : ga + t_ * 64;                           \
    const size_t la_ = s2_ ? (size_t)lda2 : (size_t)lda;                                   \
    const bfu* gb_ = gb + t_ * 64;                                                         \
    RA##0 = *(const uint4*)(ga_);                 RB##0 = *(const uint4*)(gb_);                        \
    RA##1 = *(const uint4*)(ga_ + 32 * la_);      RB##1 = *(const uint4*)(gb_ + (size_t)32 * ldb);     \
    RA##2 = *(const uint4*)(ga_ + 64 * la_);      RB##2 = *(const uint4*)(gb_ + (size_t)64 * ldb);     \
    RA##3 = *(const uint4*)(ga_ + 96 * la_);      RB##3 = *(const uint4*)(gb_ + (size_t)96 * ldb);     \
  }
#define GEMM_STORET(buf, RA, RB)                                                           \
  {                                                                                        \
    *(uint4*)((buf) + st_off) = RA##0;          *(uint4*)((buf) + 16384 + st_off) = RB##0;          \
    *(uint4*)((buf) + st_off + 4096) = RA##1;   *(uint4*)((buf) + 16384 + st_off + 4096) = RB##1;   \
    *(uint4*)((buf) + st_off + 8192) = RA##2;   *(uint4*)((buf) + 16384 + st_off + 8192) = RB##2;   \
    *(uint4*)((buf) + st_off + 12288) = RA##3;  *(uint4*)((buf) + 16384 + st_off + 12288) = RB##3;  \
  }
#define GEMM_COMPUTE(cur)                                                                  \
  _Pragma("unroll") for (int s = 0; s < 4; ++s) {                                          \
    const int co = ((2 * s + hh) ^ fsw) * 16;                                              \
    bf16x8 a0 = *(const bf16x8*)((cur) + a_base + co);                                     \
    bf16x8 a1 = *(const bf16x8*)((cur) + a_base + 4096 + co);                              \
    bf16x8 b0 = *(const bf16x8*)((cur) + b_base + co);                                     \
    bf16x8 b1 = *(const bf16x8*)((cur) + b_base + 4096 + co);                              \
    acc[0][0] = __builtin_amdgcn_mfma_f32_32x32x16_bf16(a0, b0, acc[0][0], 0, 0, 0);       \
    acc[0][1] = __builtin_amdgcn_mfma_f32_32x32x16_bf16(a0, b1, acc[0][1], 0, 0, 0);       \
    acc[1][0] = __builtin_amdgcn_mfma_f32_32x32x16_bf16(a1, b0, acc[1][0], 0, 0, 0);       \
    acc[1][1] = __builtin_amdgcn_mfma_f32_32x32x16_bf16(a1, b1, acc[1][1], 0, 0, 0);       \
  }
  GEMM_LOADT(ra, rb, 0)
  GEMM_LOADT(qa, qb, 1)
  GEMM_STORET(smem, ra, rb)
  __syncthreads();
#pragma unroll 1
  for (int kt = 0; kt < KT; kt += 2) {
    GEMM_LOADT(ra, rb, kt + 2)
    __builtin_amdgcn_sched_barrier(0);
    GEMM_COMPUTE(smem)
    __builtin_amdgcn_sched_barrier(0);
    GEMM_STORET(smem + 32768, qa, qb)
    __syncthreads();
    GEMM_LOADT(qa, qb, kt + 3)
    __builtin_amdgcn_sched_barrier(0);
    GEMM_COMPUTE(smem + 32768)
    __builtin_amdgcn_sched_barrier(0);
    GEMM_STORET(smem, ra, rb)
    __syncthreads();
  }
}

DI void acc_zero(f32x16 (&acc)[2][2]) {
#pragma unroll
  for (int i = 0; i < 2; ++i)
#pragma unroll
    for (int j = 0; j < 2; ++j)
#pragma unroll
      for (int r = 0; r < 16; ++r) acc[i][j][r] = 0.f;
}

DI void acc_to_lds(const f32x16 (&acc)[2][2], char* smem) {
  float* sf = (float*)smem;
  const int tid = tid_(), lane = tid & 63, w = tid >> 6;
  const int rb = (w >> 1) * 64 + 4 * (lane >> 5), cb = (w & 1) * 64 + (lane & 31);
#pragma unroll
  for (int i = 0; i < 2; ++i)
#pragma unroll
    for (int j = 0; j < 2; ++j)
#pragma unroll
      for (int r = 0; r < 16; ++r)
        sf[(rb + i * 32 + (r & 3) + 8 * (r >> 2)) * 128 + cb + j * 32] = acc[i][j][r];
}
#define EPI_LDS(...)                                                             \
  {                                                                              \
    acc_to_lds(acc, smem);                                                       \
    __syncthreads();                                                             \
    _Pragma("unroll 1") for (int it_ = 0; it_ < 8; ++it_) {                      \
      const int row = (tid_() >> 4) + 16 * it_;                             \
      const int c0 = (tid_() & 15) * 8;                                     \
      float v[8];                                                                \
      {                                                                          \
        const float4 t0 = *(const float4*)(smem + (row * 128 + c0) * 4);         \
        const float4 t1 = *(const float4*)(smem + (row * 128 + c0 + 4) * 4);     \
        v[0] = t0.x; v[1] = t0.y; v[2] = t0.z; v[3] = t0.w;                      \
        v[4] = t1.x; v[5] = t1.y; v[6] = t1.z; v[7] = t1.w;                      \
      }                                                                          \
      __VA_ARGS__                                                                \
    }                                                                            \
    __syncthreads();                                                             \
  }

typedef __attribute__((ext_vector_type(4))) float f32x4;
constexpr int G_BK = 64, G_HALF = 128, G_HT = G_HALF * G_BK;
DI int g_lds_byte(int r, int c) {
  int st = (r >> 4) * 2 + (c >> 5), rr = r & 15, cc = c & 31, ob = rr * 64 + cc * 2;
  return st * 1024 + (ob ^ (((ob >> 9) & 1) << 5));
}
DI void g_stage_rc(int b, int& R, int& C) {
  int st = b / 1024, sb = b % 1024, swz = sb ^ (((sb >> 9) & 1) << 5);
  R = (st >> 1) * 16 + swz / 64; C = (st & 1) * 32 + (swz % 64) / 2;
}
DI const char* g_uniform(const char* ptr) {
  unsigned long long u = (unsigned long long)ptr;
  unsigned lo = __builtin_amdgcn_readfirstlane((unsigned)u), hi = __builtin_amdgcn_readfirstlane((unsigned)(u >> 32));
  return (const char*)(((unsigned long long)hi << 32) | lo);
}
DI void gemm256(const bfu* __restrict__ A, int lda, const bfu* __restrict__ Bt, int ldb, int K, int brow, int bcol,
                bfu* shm, f32x4 (&acc)[2][2][4][2]) {
#define G_SA(b, h) (shm + ((b) * 2 + (h)) * G_HT)
#define G_SB(b, h) (shm + (4 + (b) * 2 + (h)) * G_HT)
#define G_STAGE(P, BASE, LD, br, kt)                                                                   \
  do {                                                                                                 \
    const char* _u = g_uniform((const char*)((BASE) + ((long)(br) * (LD) + (long)(kt) * G_BK)));       \
    __builtin_amdgcn_global_load_lds((const unsigned*)(_u + soff_b),                                   \
        (__attribute__((address_space(3))) unsigned*)((char*)(P) + ldst), 16, 0, 0);                   \
    __builtin_amdgcn_global_load_lds((const unsigned*)(_u + 128 * (long)(LD) + soff_b),                \
        (__attribute__((address_space(3))) unsigned*)((char*)(P) + ldst + 8192), 16, 0, 0);            \
  } while (0)
#define G_LDA(dst, b, h) for (int m = 0; m < 4; ++m) for (int k = 0; k < 2; ++k) \
    dst[m][k] = *reinterpret_cast<const bf16x8*>((char*)G_SA(b, h) + a_rd + m * 2048 + k * 1024)
#define G_LDB(dst, b, h) for (int n = 0; n < 2; ++n) for (int k = 0; k < 2; ++k) \
    dst[n][k] = *reinterpret_cast<const bf16x8*>((char*)G_SB(b, h) + b_rd + n * 2048 + k * 1024)
#define G_MMA(ai, bj, At, Bt_)                                                                         \
  do {                                                                                                 \
    __builtin_amdgcn_s_setprio(1);                                                                     \
    for (int m = 0; m < 4; ++m) for (int n = 0; n < 2; ++n) for (int k = 0; k < 2; ++k)                \
      acc[ai][bj][m][n] = __builtin_amdgcn_mfma_f32_16x16x32_bf16(At[m][k], Bt_[n][k], acc[ai][bj][m][n], 0, 0, 0); \
    __builtin_amdgcn_s_setprio(0);                                                                     \
  } while (0)
#define G_WAIT_V(n) asm volatile("s_waitcnt vmcnt(" #n ")" ::: "memory")
#define G_WAIT_L(n) asm volatile("s_waitcnt lgkmcnt(" #n ")" ::: "memory")
#define G_BAR __builtin_amdgcn_s_barrier()
#define G_SCHED __builtin_amdgcn_sched_barrier(0)
  int t512 = threadIdx.x; asm volatile("" : "+v"(t512));
  const int wid = __builtin_amdgcn_readfirstlane(t512 >> 6), lane = t512 & 63, wr = wid >> 2, wc = wid & 3, fr = lane & 15, fq = lane >> 4;
  const int ldst = t512 * 16;
  unsigned soff_b;
  {
    int R0, C0;
    g_stage_rc(ldst, R0, C0);
    soff_b = (unsigned)(R0 * lda + C0) * 2u;
  }
  const int lane_off = (fr * 64 + fq * 16) ^ ((fr >> 3) << 5);
  const int a_rd = wr * 8192 + lane_off, b_rd = wc * 4096 + lane_off;
  bf16x8 At[4][2], B0[2][2], B1[2][2];
  const int nt = K / G_BK;
  G_STAGE(G_SB(0, 0), Bt, ldb, bcol, 0); G_STAGE(G_SA(0, 0), A, lda, brow, 0);
  G_STAGE(G_SB(0, 1), Bt, ldb, bcol + G_HALF, 0); G_STAGE(G_SA(0, 1), A, lda, brow + G_HALF, 0);
  if (wr == 1) G_BAR;
  G_WAIT_V(4); G_BAR;
  G_STAGE(G_SB(1, 0), Bt, ldb, bcol, 1); G_STAGE(G_SA(1, 0), A, lda, brow, 1); G_STAGE(G_SB(1, 1), Bt, ldb, bcol + G_HALF, 1);
  G_WAIT_V(6); G_BAR;
#pragma unroll 1
  for (int t = 0; t < nt - 2; t += 2) {
    G_LDB(B0, 0, 0); G_SCHED; G_LDA(At, 0, 0); G_STAGE(G_SA(1, 1), A, lda, brow + G_HALF, t + 1);
    G_WAIT_L(8); G_BAR; G_WAIT_L(0); G_MMA(0, 0, At, B0); G_BAR; G_SCHED;
    G_LDB(B1, 0, 1); G_STAGE(G_SB(0, 0), Bt, ldb, bcol, t + 2);
    G_BAR; G_WAIT_L(0); G_MMA(0, 1, At, B1); G_BAR;
    G_LDA(At, 0, 1); G_STAGE(G_SA(0, 0), A, lda, brow, t + 2);
    G_BAR; G_WAIT_L(0); G_MMA(1, 0, At, B0); G_BAR; G_SCHED;
    G_STAGE(G_SB(0, 1), Bt, ldb, bcol + G_HALF, t + 2);
    G_WAIT_V(6); G_BAR; G_MMA(1, 1, At, B1); G_BAR;
    G_LDB(B0, 1, 0); G_SCHED; G_LDA(At, 1, 0); G_STAGE(G_SA(0, 1), A, lda, brow + G_HALF, t + 2);
    G_WAIT_L(8); G_BAR; G_WAIT_L(0); G_MMA(0, 0, At, B0); G_BAR; G_SCHED;
    G_LDB(B1, 1, 1); G_STAGE(G_SB(1, 0), Bt, ldb, bcol, t + 3);
    G_BAR; G_WAIT_L(0); G_MMA(0, 1, At, B1); G_BAR;
    G_LDA(At, 1, 1); G_STAGE(G_SA(1, 0), A, lda, brow, t + 3);
    G_BAR; G_WAIT_L(0); G_MMA(1, 0, At, B0); G_BAR; G_SCHED;
    G_STAGE(G_SB(1, 1), Bt, ldb, bcol + G_HALF, t + 3);
    G_WAIT_V(6); G_BAR; G_MMA(1, 1, At, B1); G_BAR;
  }
  { G_LDB(B0, 0, 0); G_LDA(At, 0, 0); G_STAGE(G_SA(1, 1), A, lda, brow + G_HALF, nt - 1);
    G_BAR; G_WAIT_L(0); G_MMA(0, 0, At, B0); G_BAR;
    G_LDB(B1, 0, 1); G_BAR; G_WAIT_L(0); G_MMA(0, 1, At, B1); G_BAR;
    G_LDA(At, 0, 1); G_WAIT_V(4); G_BAR; G_WAIT_L(0); G_MMA(1, 0, At, B0); G_MMA(1, 1, At, B1); G_BAR; }
  { G_LDB(B0, 1, 0); G_LDA(At, 1, 0); G_WAIT_V(2); G_BAR; G_WAIT_L(0); G_MMA(0, 0, At, B0); G_BAR;
    G_LDB(B1, 1, 1); G_WAIT_V(0); G_BAR; G_WAIT_L(0); G_MMA(0, 1, At, B1); G_BAR;
    G_LDA(At, 1, 1); G_BAR; G_WAIT_L(0); G_MMA(1, 0, At, B0); G_MMA(1, 1, At, B1); G_BAR; }
  if (wr == 0) G_BAR;
}
DI void acc256_zero(f32x4 (&acc)[2][2][4][2]) {
#pragma unroll
  for (int a = 0; a < 2; ++a)
#pragma unroll
    for (int b = 0; b < 2; ++b)
#pragma unroll
      for (int m = 0; m < 4; ++m)
#pragma unroll
        for (int n = 0; n < 2; ++n) acc[a][b][m][n] = (f32x4){0.f, 0.f, 0.f, 0.f};
}
#define EPI_NOPRE
#define EPI256P(PRE, ...)                                                                              \
  {                                                                                                    \
    int t512_ = threadIdx.x; asm volatile("" : "+v"(t512_));     \
    const int wid_ = t512_ >> 6, lane_ = t512_ & 63, wr_ = wid_ >> 2, wc_ = wid_ & 3,                  \
              fr_ = lane_ & 15, fq_ = lane_ >> 4;                                                      \
    float* sf_ = (float*)smem;                                                                         \
    _Pragma("unroll") for (int ai_ = 0; ai_ < 2; ++ai_) {                                              \
      _Pragma("unroll") for (int it_ = 0; it_ < 8; ++it_) {     \
        const int idx_ = t512_ + 512 * it_;                                                            \
        const int rl_ = idx_ >> 5, c0 = (idx_ & 31) * 8;                                               \
        const int row = ai_ * 128 + rl_;                                                               \
        (void)rl_; (void)c0; (void)row;                                                                \
        PRE                                                                                            \
      }                                                                                                \
      __builtin_amdgcn_sched_barrier(0);              \
      __syncthreads();                                                                                 \
      _Pragma("unroll") for (int bj_ = 0; bj_ < 2; ++bj_)                                              \
      _Pragma("unroll") for (int m_ = 0; m_ < 4; ++m_)                                                 \
      _Pragma("unroll") for (int n_ = 0; n_ < 2; ++n_)                                                 \
      _Pragma("unroll") for (int j_ = 0; j_ < 4; ++j_)                                                 \
        sf_[(wr_ * 64 + m_ * 16 + fq_ * 4 + j_) * 256 + ((bj_ * 128 + wc_ * 32 + n_ * 16 + fr_) ^ (fq_ << 4))] = \
            acc[ai_][bj_][m_][n_][j_];                                                                 \
      __syncthreads();                                                                                 \
      _Pragma("unroll") for (int it_ = 0; it_ < 8; ++it_) {                                            \
        const int idx_ = t512_ + 512 * it_;                                                            \
        const int rl_ = idx_ >> 5, c0 = (idx_ & 31) * 8;                                               \
        const int row = ai_ * 128 + rl_;                                                               \
        float v[8];                                                                                    \
        {                                                                                              \
          const float* sp_ = sf_ + rl_ * 256 + (c0 ^ (((rl_ >> 2) & 3) << 4));                          \
          const float4 t0 = *(const float4*)sp_; const float4 t1 = *(const float4*)(sp_ + 4);          \
          v[0] = t0.x; v[1] = t0.y; v[2] = t0.z; v[3] = t0.w;                                          \
          v[4] = t1.x; v[5] = t1.y; v[6] = t1.z; v[7] = t1.w;                                          \
        }                                                                                              \
        __VA_ARGS__                                                                                    \
      }                                                                                                \
    }                                                                                                  \
    __syncthreads();                                                                                   \
  }
#define EPI256(...) EPI256P(EPI_NOPRE, __VA_ARGS__)

template <int MT, int NT, int BH>
DI bool xcd_tile(int iter, int& mt, int& nt) {
  constexpr int MPX = MT / 8, TPX = MPX * NT;
  const int xcd = VXCD, j = VJ, nloc = VNLOC;
  const int q = j + iter * nloc;
  if (q >= TPX) return false;
  const int band = q / (BH * NT), r = q % (BH * NT);
  nt = r / BH;
  mt = xcd * MPX + band * BH + (r % BH);
  return true;
}

DI bool tile256(int iter, int NT, int& mt, int& nt) {
  const int xcd = blockIdx.x & 7, j = blockIdx.x >> 3, nloc = gridDim.x >> 3;
  const int q = j + iter * nloc;
  if (q >= 6 * NT) return false;
  nt = q / 6; mt = xcd * 6 + q % 6;
  return true;
}
DI void phase_gemm_in(const Params& p, int l, char* smem) {
  const bfu* W = p.w_inT + (size_t)l * DINP * LDH;
  for (int iter = 0;; ++iter) {
    int mt, nt;
    if (!tile256(iter, 19, mt, nt)) break;
    f32x4 acc[2][2][4][2];
    acc256_zero(acc);
    gemm256(p.h, LDH, W, LDH, 1024, mt * 256, nt * 256, (bfu*)smem, acc);
    const int m0 = mt * 256, n0 = nt * 256;
    EPI256({
      const int n = n0 + c0;
      if (n < 512) *(uint4*)(p.ug + ((size_t)(n >> 4) * NTOK + (m0 + row)) * 16 + (n & 15)) = pack8(v);
      else if (n < DIN) *(uint4*)(p.proj + (size_t)(m0 + row) * PW + (n - 512)) = pack8(v);
    })
  }
}

DI void s5_gen_item(const Params& p, int l, int item, char* smem) {
  const int tid = tid_();
  const int g = item >> 3, r = item & 7;
  float* sBr = (float*)smem;
  float* sBi = sBr + 2048;
  float* sCr = sBi + 2048;
  float* sCi = sCr + 1024;
  float* sAK = sCi + 1024;
  float* sAE = sAK + 1024;
  float* sAG = sAE + 1024;
  float* sK = sAG + 1024;
  bfu* E = p.opE + (size_t)g * 256 * 512;
  bfu* MG = p.opMG + (size_t)g * 512 * 768;
  __syncthreads();
  if (tid < 128) {
    const int d = tid >> 6, pp = tid & 63;
    const size_t pi = ((size_t)(l * 2 + d) * 32 + g) * 64 + pp;
    const float lr = p.lam_re[pi], li = p.lam_im[pi];
    const float dt = expf(p.log_dt[(l * 2 + d) * 32 + g]);
    const float mag = expf(lr * dt);
    float sn, cs;
    sincosf(li * dt, &sn, &cs);
    const float are = mag * cs, aim = mag * sn;
    const float nr = are - 1.f, ni = aim, den = lr * lr + li * li;
    const float kr = (nr * lr + ni * li) / den, ki = (ni * lr - nr * li) / den;
#pragma unroll
    for (int c = 0; c < 16; ++c) {
      float br = p.b_re[((size_t)(l * 32 + g) * 64 + pp) * 16 + c];
      float bi = p.b_im[((size_t)(l * 32 + g) * 64 + pp) * 16 + c];
      sBr[(d * 64 + pp) * 16 + c] = kr * br - ki * bi;
      sBi[(d * 64 + pp) * 16 + c] = kr * bi + ki * br;
    }
#pragma unroll
    for (int q = 0; q < 4; ++q) {
      const int t = 4 * r + q;
      const int nK = t;
      const int nE = d == 0 ? 31 - t : t;
      const int nG = d == 0 ? t + 1 : 32 - t;
      const float er = lr * dt * 1.44269504f, rv = li * dt * 0.15915494f;
      float m, s_, c_, fr_;
      m = exp2f_(er * (float)nK); fr_ = rv * (float)nK; fr_ -= floorf(fr_);
      s_ = __builtin_amdgcn_sinf(fr_); c_ = __builtin_amdgcn_cosf(fr_);
      sAK[((d * 4 + q) * 64 + pp) * 2] = m * c_; sAK[((d * 4 + q) * 64 + pp) * 2 + 1] = m * s_;
      m = exp2f_(er * (float)nE); fr_ = rv * (float)nE; fr_ -= floorf(fr_);
      s_ = __builtin_amdgcn_sinf(fr_); c_ = __builtin_amdgcn_cosf(fr_);
      sAE[((d * 4 + q) * 64 + pp) * 2] = m * c_; sAE[((d * 4 + q) * 64 + pp) * 2 + 1] = m * s_;
      m = exp2f_(er * (float)nG); fr_ = rv * (float)nG; fr_ -= floorf(fr_);
      s_ = __builtin_amdgcn_sinf(fr_); c_ = __builtin_amdgcn_cosf(fr_);
      sAG[((d * 4 + q) * 64 + pp) * 2] = m * c_; sAG[((d * 4 + q) * 64 + pp) * 2 + 1] = m * s_;
    }
  } else {
    for (int idx = tid - 128; idx < 1024; idx += 128) {
      sCr[idx] = p.c_re[(size_t)(l * 32 + g) * 1024 + idx];
      sCi[idx] = p.c_im[(size_t)(l * 32 + g) * 1024 + idx];
    }
  }
  __syncthreads();
#pragma unroll 1
  for (int i = 0; i < 4; ++i) {
    const int idx = tid + 256 * i;
    const int row = idx >> 2, q = idx & 3;
    const int part = row >> 6, pp = row & 63, d = part >> 1;
    const float ar = sAE[((d * 4 + q) * 64 + pp) * 2], ai = sAE[((d * 4 + q) * 64 + pp) * 2 + 1];
    const float* br = sBr + (d * 64 + pp) * 16;
    const float* bi = sBi + (d * 64 + pp) * 16;
    float v[16];
#pragma unroll
    for (int c = 0; c < 16; ++c) v[c] = (part & 1) ? (ar * bi[c] + ai * br[c]) : (ar * br[c] - ai * bi[c]);
    bfu* dp = E + (size_t)row * 512 + (4 * r + q) * 16;
    *(uint4*)dp = pack8(*(float(*)[8])&v[0]);
    *(uint4*)(dp + 8) = pack8(*(float(*)[8])&v[8]);
  }
#pragma unroll 1
  for (int i = 0; i < 8; ++i) {
    const int idx = tid + 256 * i;
    const int rr = idx >> 5, cg = idx & 31, q = rr >> 4, c = rr & 15;
    const int part = cg >> 3, pp0 = (cg & 7) * 8, d = part >> 1;
    const float* ag = sAG + ((d * 4 + q) * 64 + pp0) * 2;
    const float* cr = sCr + c * 64 + pp0;
    const float* ci = sCi + c * 64 + pp0;
    float v[8];
#pragma unroll
    for (int e = 0; e < 8; ++e) {
      const float ar = ag[2 * e], ai = ag[2 * e + 1];
      v[e] = (part & 1) ? -(cr[e] * ai + ci[e] * ar) : (cr[e] * ar - ci[e] * ai);
    }
    *(uint4*)(MG + (size_t)((4 * r + q) * 16 + c) * 768 + 512 + cg * 8) = pack8(v);
  }
  {
    const int d = tid >> 7, q = (tid >> 5) & 3, c = (tid >> 1) & 15, ch = tid & 1;
    float acc[8];
#pragma unroll
    for (int e = 0; e < 8; ++e) acc[e] = 0.f;
    for (int pp = 0; pp < 64; ++pp) {
      const float ar = sAK[((d * 4 + q) * 64 + pp) * 2], ai = sAK[((d * 4 + q) * 64 + pp) * 2 + 1];
      const float cr = sCr[c * 64 + pp], ci = sCi[c * 64 + pp];
      const float wr = cr * ar - ci * ai, wi = cr * ai + ci * ar;
#pragma unroll
      for (int e = 0; e < 8; ++e)
        acc[e] += wr * sBr[(d * 64 + pp) * 16 + ch * 8 + e] - wi * sBi[(d * 64 + pp) * 16 + ch * 8 + e];
    }
#pragma unroll
    for (int e = 0; e < 8; ++e) sK[((d * 4 + q) * 16 + c) * 16 + ch * 8 + e] = acc[e];
  }
  __syncthreads();
  for (int idx = tid; idx < 8192; idx += 256) {
    const int ch = idx & 1, c = (idx >> 1) & 15, tp = (idx >> 5) & 31, q = (idx >> 10) & 3, d = idx >> 12;
    const int tau = 4 * r + q;
    int sp;
    bool valid;
    if (d == 0) { sp = tp - tau; valid = sp >= 0; } else { sp = tp + tau; valid = (sp <= 31) && (tau > 0); }
    if (valid) {
      float v[8];
#pragma unroll
      for (int e = 0; e < 8; ++e) {
        float x = sK[((d * 4 + q) * 16 + c) * 16 + ch * 8 + e];
        if (tau == 0) x += sK[((1 * 4 + q) * 16 + c) * 16 + ch * 8 + e];
        v[e] = x;
      }
      *(uint4*)(MG + (size_t)(tp * 16 + c) * 768 + sp * 16 + ch * 8) = pack8(v);
    }
  }
  __syncthreads();
}

DI void phase_s5_gen(const Params& p, int l, char* smem) {
  for (int it = NVB - 1 - VBID; it < 256; it += NVB) s5_gen_item(p, l, it, smem);
}

DI void phase_s5_e(const Params& p, char* smem) {
  for (int q = VJ; q < 24; q += VNLOC) {
    const int g = VXCD * 4 + q / 6, r6 = q % 6, mt = r6 >> 1, nt = r6 & 1;
    f32x16 acc[2][2];
    acc_zero(acc);
    gemm_core(p.ug + ((size_t)g * NCHUNK + mt * 128) * 512, 512, p.opE + ((size_t)g * 256 + nt * 128) * 512, 512, 512,
              smem, acc, p.ug, 512, 0);
    EPI_LDS({
      float* dst = p.ebuf + ((size_t)g * NCHUNK + mt * 128 + row) * 256 + nt * 128 + c0;
      *(float4*)dst = make_float4(v[0], v[1], v[2], v[3]);
      *(float4*)(dst + 4) = make_float4(v[4], v[5], v[6], v[7]);
    })
  }
}

DI void phase_s5_scan(const Params& p, int l) {
  const int tid = tid_();
  for (int it = (VBID < 128 ? VBID : 320); it < 320; it += 128) {
    const int wi = it * 2 + (tid >> 7);
    const int dir = (tid >> 6) & 1, pp = tid & 63;
    int chunk0, n, b, g;
    bool prompt;
    if (wi < 128) { b = wi >> 5; g = wi & 31; chunk0 = (NPROMPT + b * 2048) >> 5; n = 64; prompt = false; }
    else { int q = wi - 128; b = q >> 5; g = q & 31; chunk0 = (b * 256) >> 5; n = 8; prompt = true; }
    const size_t pi = ((size_t)(l * 2 + dir) * 32 + g) * 64 + pp;
    const float lr = p.lam_re[pi], li = p.lam_im[pi];
    const float dt = expf(p.log_dt[(l * 2 + dir) * 32 + g]);
    const float mag = expf(lr * dt * 32.f);
    float sn, cs;
    sincosf(li * dt * 32.f, &sn, &cs);
    const float are = mag * cs, aim = mag * sn;
    float hre = 0.f, him = 0.f;
    if (!prompt) {
      size_t si = ((size_t)((b * 2 + l) * 2 + dir)) * 2048 + g * 64 + pp;
      hre = p.st_re[si]; him = p.st_im[si];
    }
    const float* eb = p.ebuf + ((size_t)g * NCHUNK + chunk0) * 256 + dir * 128 + pp;
    bfu* cb = p.carry + ((size_t)g * NCHUNK + chunk0) * 256 + dir * 128 + pp;
    for (int k0 = 0; k0 < n; k0 += 8) {
      float er[8], ei[8];
#pragma unroll
      for (int j = 0; j < 8; ++j) {
        const int k = dir == 0 ? k0 + j : n - 1 - (k0 + j);
        er[j] = eb[(size_t)k * 256];
        ei[j] = eb[(size_t)k * 256 + 64];
      }
#pragma unroll
      for (int j = 0; j < 8; ++j) {
        const int k = dir == 0 ? k0 + j : n - 1 - (k0 + j);
        cb[(size_t)k * 256] = f2bf(hre);
        cb[(size_t)k * 256 + 64] = f2bf(him);
        const float nre = are * hre - aim * him + er[j];
        const float nim = are * him + aim * hre + ei[j];
        hre = nre; him = nim;
      }
    }
    if (prompt) {
      size_t oi = ((size_t)((b * 2 + l) * 2 + dir)) * 2048 + g * 64 + pp;
      p.out[OUT_RE + oi] = hre;
      p.out[OUT_IM + oi] = him;
    }
  }
}

DI void phase_s5_y(const Params& p, int l, char* smem) {
  for (int q = VJ; q < 48; q += VNLOC) {
    const int g = VXCD * 4 + q / 12, r12 = q % 12, mt = r12 >> 2, nt = r12 & 3;
    f32x16 acc[2][2];
    acc_zero(acc);
    const bfu* Bm = p.opMG + ((size_t)g * 512 + nt * 128) * 768;
    gemm_core(p.ug + ((size_t)g * NCHUNK + mt * 128) * 512, 512, Bm, 768, 512, smem, acc,
              p.carry + ((size_t)g * NCHUNK + mt * 128) * 256, 256, 256);
    EPI_LDS({
      const int chunk = mt * 128 + row, nn = nt * 128 + c0, tp = nn >> 4, c = nn & 15;
      const int tok = chunk * 32 + tp;
      float u[8], o[8];
      unpack8(*(const uint4*)(p.ug + ((size_t)g * NTOK + tok) * 16 + c), u);
      const float* dsk = p.s5_d + l * 512 + g * 16 + c;
      _Pragma("unroll") for (int e = 0; e < 8; ++e) o[e] = geluf_(v[e] + dsk[e] * u[e]);
      *(uint4*)(p.ys5 + (size_t)tok * 512 + g * 16 + c) = pack8(o);
    })
  }
}

DI void phase_glu(const Params& p, int l, char* smem) {
  const bfu* W = p.w_gluT + (size_t)l * 512 * 512;
  for (int iter = 0;; ++iter) {
    int mt, nt;
    if (!xcd_tile<96, 4, 12>(iter, mt, nt)) break;
    f32x16 acc[2][2];
    acc_zero(acc);
    gemm_core(p.ys5 + (size_t)mt * 128 * 512, 512, W + (size_t)nt * 128 * 512, 512, 512, smem, acc, p.ys5, 512, 0);
    const int m0 = mt * 128, n0 = nt * 128;
    EPI_LDS({
      const int n = n0 + c0;
      const size_t tk = (size_t)(m0 + row);
      float y[8], ga[8], o[8];
      unpack8(*(const uint4*)(p.ys5 + tk * 512 + n), y);
      unpack8(*(const uint4*)(p.proj + tk * PW + OFF_GA + n), ga);
      const float* bg = p.b_glu + l * 512 + n;
      _Pragma("unroll") for (int e = 0; e < 8; ++e) o[e] = y[e] * sigmoidf_(v[e] + bg[e]) * siluf_(ga[e]);
      *(uint4*)(p.ya + tk * 512 + n) = pack8(o);
    })
  }
}

constexpr int GL_QS = 0;
constexpr int GL_KS = GL_QS + 32 * 144;
constexpr int GL_KHT = GL_KS + 32 * 144;
constexpr int GL_VT = GL_KHT + 64 * 80;
constexpr int GL_PS = GL_VT + 128 * 80;
constexpr int GL_ST = GL_PS + 32 * 80;
constexpr int GL_AV = GL_ST + 128 * 144;
constexpr int GL_TOT = GL_AV + 256;
constexpr int GL_OS = GL_TOT + 1024;
static_assert(GL_OS + 32 * 132 * 4 <= 65536, "gla lds");

DI void gla_segment_info(int seg, int& tok_base, bool& prompt, int& b, int& sidx) {
  if (seg < 16) { prompt = true; b = seg; sidx = 0; tok_base = seg * 256; }
  else { int q = seg - 16; prompt = false; b = q >> 3; sidx = q & 7; tok_base = NPROMPT + b * 2048 + sidx * 256; }
}

template <bool STATE_ONLY>
DI void gla_chain(const Params& p, int l, char* smem, int seg, int hd, int dir) {
  const int tid = tid_(), lane = tid & 63, w = tid >> 6;
  const int fr = lane & 31, hh = lane >> 5;
  int tok_base, b, sidx;
  bool prompt;
  gla_segment_info(seg, tok_base, prompt, b, sidx);
  const int dk = tid & 63, tq = tid >> 6;
  const int dvl = tid & 127, th = tid >> 7;
  const int jw = w & 1, thw = w >> 1, dkm = 32 * jw + fr;
  bf16x8 wgB;
  {
    unsigned wp[4];
#pragma unroll
    for (int e = 0; e < 4; ++e) {
      const float w0 = p.wg_up[((size_t)(l * 2 + dir) * 16 + 8 * hh + 2 * e) * 256 + hd * 64 + dkm];
      const float w1 = p.wg_up[((size_t)(l * 2 + dir) * 16 + 8 * hh + 2 * e + 1) * 256 + hd * 64 + dkm];
      wp[e] = pack2(w0, w1);
    }
    wgB = __builtin_bit_cast(bf16x8, make_uint4(wp[0], wp[1], wp[2], wp[3]));
  }
  const float bgv = p.bg[(l * 2 + dir) * 256 + hd * 64 + dkm];
  float* sAv = (float*)(smem + GL_AV);
  float* sTot = (float*)(smem + GL_TOT);
  float* sOs = (float*)(smem + GL_OS);

  f32x16 S[2];
  {
    const int dvc = 32 * w + fr;
    if (STATE_ONLY || prompt) {
#pragma unroll
      for (int mt = 0; mt < 2; ++mt)
#pragma unroll
        for (int r = 0; r < 16; ++r) S[mt][r] = 0.f;
    } else {
      const float* sp = p.st_gla + ((size_t)(((b * 2 + l) * 2 + dir) * 4 + hd)) * 8192;
#pragma unroll
      for (int mt = 0; mt < 2; ++mt)
#pragma unroll
        for (int r = 0; r < 16; ++r) S[mt][r] = sp[(32 * mt + (r & 3) + 8 * (r >> 2) + 4 * hh) * 128 + dvc];
      const int nprev = dir == 0 ? sidx : 7 - sidx;
      if (nprev > 0) {
        f32x16 cs[2], ns[2];
        float4 ca[8], na[8];
#define GLA_SEG_LOAD(SS, AA, qq)                                                                       \
        {                                                                                              \
          const int sprev_ = dir == 0 ? (qq) : 7 - (qq);                                               \
          const size_t ci_ = (size_t)(((b * 8 + sprev_) * 4 + hd) * 2 + dir);                          \
          const float* sl_ = p.gla_sloc + ci_ * 8192 + dvc;                                            \
          const float* al_ = p.gla_aseg + ci_ * 64 + 4 * hh;                                           \
          _Pragma("unroll") for (int mt = 0; mt < 2; ++mt)                                             \
          _Pragma("unroll") for (int r = 0; r < 16; ++r)                                               \
            SS[mt][r] = sl_[(32 * mt + (r & 3) + 8 * (r >> 2) + 4 * hh) * 128];                        \
          _Pragma("unroll") for (int i = 0; i < 8; ++i) AA[i] = *(const float4*)(al_ + 8 * i);         \
        }
        GLA_SEG_LOAD(cs, ca, 0)
#pragma unroll 1
        for (int q = 0; q < nprev; ++q) {
          if (q + 1 < nprev) GLA_SEG_LOAD(ns, na, q + 1)
#pragma unroll
          for (int mt = 0; mt < 2; ++mt)
#pragma unroll
            for (int qq = 0; qq < 4; ++qq) {
              const float4 av = ca[mt * 4 + qq];
              S[mt][4 * qq + 0] = av.x * S[mt][4 * qq + 0] + cs[mt][4 * qq + 0];
              S[mt][4 * qq + 1] = av.y * S[mt][4 * qq + 1] + cs[mt][4 * qq + 1];
              S[mt][4 * qq + 2] = av.z * S[mt][4 * qq + 2] + cs[mt][4 * qq + 2];
              S[mt][4 * qq + 3] = av.w * S[mt][4 * qq + 3] + cs[mt][4 * qq + 3];
            }
          cs[0] = ns[0]; cs[1] = ns[1];
#pragma unroll
          for (int i = 0; i < 8; ++i) ca[i] = na[i];
        }
      }
    }
  }
  float bsum = 0.f;
  __syncthreads();
  if (!STATE_ONLY) {
    const int dvc = 32 * w + fr;
#pragma unroll
    for (int mt = 0; mt < 2; ++mt)
#pragma unroll
      for (int q = 0; q < 4; ++q) {
        uint2 pk;
        pk.x = pack2(S[mt][4 * q], S[mt][4 * q + 1]);
        pk.y = pack2(S[mt][4 * q + 2], S[mt][4 * q + 3]);
        *(uint2*)(smem + GL_ST + dvc * 144 + (32 * mt + 8 * q + 4 * hh) * 2) = pk;
      }
  }

  uint4 rq = make_uint4(0, 0, 0, 0), rk = rq, rv0 = rq, rv1 = rq, rgl = rq;
#define GLA_ISSUE(nn)                                                                                         \
  {                                                                                                           \
    const int cn_ = dir == 0 ? (nn) : 7 - (nn);                                                               \
    const int c0_ = tok_base + cn_ * 32;                                                                      \
    const int tA = dir == 0 ? (tid >> 3) : 31 - (tid >> 3);                                                   \
    const bfu* prA = p.proj + (size_t)(c0_ + tA) * PW + hd * 64 + (tid & 7) * 8;                              \
    if (!STATE_ONLY) rq = *(const uint4*)(prA + OFF_Q);                                                       \
    rk = *(const uint4*)(prA + OFF_K);                                                                        \
    const int tV0 = dir == 0 ? (tid >> 4) : 31 - (tid >> 4);                                                  \
    const int tV1 = dir == 0 ? (tid >> 4) + 16 : 15 - (tid >> 4);                                             \
    rv0 = *(const uint4*)(p.proj + (size_t)(c0_ + tV0) * PW + OFF_V + hd * 128 + (tid & 15) * 8);             \
    rv1 = *(const uint4*)(p.proj + (size_t)(c0_ + tV1) * PW + OFF_V + hd * 128 + (tid & 15) * 8);             \
    if (tid < 64) {                                                                                           \
      const int tG = dir == 0 ? (tid >> 1) : 31 - (tid >> 1);                                                 \
      rgl = *(const uint4*)(p.proj + (size_t)(c0_ + tG) * PW + OFF_GL + (tid & 1) * 8);                       \
    }                                                                                                         \
  }
  GLA_ISSUE(0)
  char* rawQ = smem + GL_OS;
  char* rawK = smem + GL_OS + 4096;
  char* rawV = smem + GL_OS + 8192;
  char* rawG = smem + GL_PS;

#pragma unroll 1
  for (int n = 0; n < 8; ++n) {
    const int cn = dir == 0 ? n : 7 - n;
    const int ctok0 = tok_base + cn * 32;
    __syncthreads();
    if (!STATE_ONLY) *(uint4*)(rawQ + (tid >> 3) * 128 + (tid & 7) * 16) = rq;
    *(uint4*)(rawK + (tid >> 3) * 128 + (tid & 7) * 16) = rk;
    *(uint4*)(rawV + (tid >> 4) * 256 + (tid & 15) * 16) = rv0;
    *(uint4*)(rawV + ((tid >> 4) + 16) * 256 + (tid & 15) * 16) = rv1;
    if (tid < 64) *(uint4*)(rawG + (tid >> 1) * 32 + (tid & 1) * 16) = rgl;
    if (n + 1 < 8) GLA_ISSUE(n + 1)
    __syncthreads();
    {
      f32x16 lg;
#pragma unroll
      for (int r = 0; r < 16; ++r) lg[r] = 0.f;
      const bf16x8 ga = *(const bf16x8*)(rawG + fr * 32 + hh * 16);
      lg = __builtin_amdgcn_mfma_f32_32x32x16_bf16(ga, wgB, lg, 0, 0, 0);
      float ls[16], gsum[4], psum[4];
#pragma unroll
      for (int r = 0; r < 16; ++r) {
        const float x = lg[r] + bgv;
        ls[r] = logsigmoidf_(x) * (1.f / 16.f);
      }
#pragma unroll
      for (int q = 0; q < 4; ++q) {
        gsum[q] = ls[4 * q] + ls[4 * q + 1] + ls[4 * q + 2] + ls[4 * q + 3];
        psum[q] = __shfl_xor(gsum[q], 32);
      }
      float off[4], run = 0.f;
#pragma unroll
      for (int q = 0; q < 4; ++q) {
        off[q] = run + (hh ? psum[q] : 0.f);
        run += gsum[q] + psum[q];
      }
      const float total = run;
#pragma unroll
      for (int qq = 0; qq < 2; ++qq) {
        float khv[4];
        float acc_b = 0.f;
#pragma unroll
        for (int i = 0; i < 4; ++i) {
          const float lsv = thw == 0 ? ls[4 * qq + i] : ls[8 + 4 * qq + i];
          const float offv = thw == 0 ? off[qq] : off[2 + qq];
          acc_b += lsv;
          const float bb = offv + acc_b;
          const int tau = 16 * thw + 8 * qq + 4 * hh + i;
          const float kvv = bf2f(*(const bfu*)(rawK + tau * 128 + dkm * 2));
          if (!STATE_ONLY) {
            const float qvv = bf2f(*(const bfu*)(rawQ + tau * 128 + dkm * 2)) * 0.125f;
            *(bfu*)(smem + GL_QS + tau * 144 + dkm * 2) = f2bf(qvv * __expf(bb));
            *(bfu*)(smem + GL_KS + tau * 144 + dkm * 2) = f2bf(kvv * __expf(-bb));
          }
          khv[i] = kvv * __expf(total - bb);
        }
        uint2 kh; kh.x = pack2(khv[0], khv[1]); kh.y = pack2(khv[2], khv[3]);
        *(uint2*)(smem + GL_KHT + dkm * 80 + (16 * thw + 8 * qq + 4 * hh) * 2) = kh;
      }
      if (thw == 0 && hh == 0) { sAv[dkm] = __expf(total); bsum += total; }
    }
    {
      unsigned pk[8];
#pragma unroll
      for (int i = 0; i < 8; ++i) {
        const int tau0 = th * 16 + 2 * i;
        const unsigned lo = *(const bfu*)(rawV + tau0 * 256 + dvl * 2);
        const unsigned hi = *(const bfu*)(rawV + (tau0 + 1) * 256 + dvl * 2);
        pk[i] = lo | (hi << 16);
      }
      *(uint4*)(smem + GL_VT + dvl * 80 + th * 32) = make_uint4(pk[0], pk[1], pk[2], pk[3]);
      *(uint4*)(smem + GL_VT + dvl * 80 + th * 32 + 16) = make_uint4(pk[4], pk[5], pk[6], pk[7]);
    }
    __syncthreads();
    f32x16 o;
    if (!STATE_ONLY) {
      f32x16 sc;
#pragma unroll
      for (int r = 0; r < 16; ++r) sc[r] = 0.f;
#pragma unroll
      for (int s4 = 0; s4 < 4; ++s4) {
        bf16x8 a = *(const bf16x8*)(smem + GL_QS + fr * 144 + (16 * s4 + 8 * hh) * 2);
        bf16x8 bq = *(const bf16x8*)(smem + GL_KS + fr * 144 + (16 * s4 + 8 * hh) * 2);
        sc = __builtin_amdgcn_mfma_f32_32x32x16_bf16(a, bq, sc, 0, 0, 0);
      }
#pragma unroll
      for (int rr = 0; rr < 4; ++rr) {
        float val = w == 0 ? sc[rr] : (w == 1 ? sc[4 + rr] : (w == 2 ? sc[8 + rr] : sc[12 + rr]));
        const int i = rr + 8 * w + 4 * hh;
        val = (fr <= i) ? val : 0.f;
        *(bfu*)(smem + GL_PS + i * 80 + fr * 2) = f2bf(val);
      }
      __syncthreads();
#pragma unroll
      for (int r = 0; r < 16; ++r) o[r] = 0.f;
    }
    {
      const int dvc = 32 * w + fr;
      bf16x8 vb0 = *(const bf16x8*)(smem + GL_VT + dvc * 80 + (8 * hh) * 2);
      bf16x8 vb1 = *(const bf16x8*)(smem + GL_VT + dvc * 80 + (16 + 8 * hh) * 2);
      if (!STATE_ONLY) {
        bf16x8 pa0 = *(const bf16x8*)(smem + GL_PS + fr * 80 + (8 * hh) * 2);
        bf16x8 pa1 = *(const bf16x8*)(smem + GL_PS + fr * 80 + (16 + 8 * hh) * 2);
        o = __builtin_amdgcn_mfma_f32_32x32x16_bf16(pa0, vb0, o, 0, 0, 0);
        o = __builtin_amdgcn_mfma_f32_32x32x16_bf16(pa1, vb1, o, 0, 0, 0);
#pragma unroll
        for (int s4 = 0; s4 < 4; ++s4) {
          bf16x8 a = *(const bf16x8*)(smem + GL_QS + fr * 144 + (16 * s4 + 8 * hh) * 2);
          bf16x8 sb = *(const bf16x8*)(smem + GL_ST + dvc * 144 + (16 * s4 + 8 * hh) * 2);
          o = __builtin_amdgcn_mfma_f32_32x32x16_bf16(a, sb, o, 0, 0, 0);
        }
      }
#pragma unroll
      for (int mt = 0; mt < 2; ++mt) {
        f32x16 U;
#pragma unroll
        for (int r = 0; r < 16; ++r) U[r] = 0.f;
        bf16x8 ka0 = *(const bf16x8*)(smem + GL_KHT + (32 * mt + fr) * 80 + (8 * hh) * 2);
        bf16x8 ka1 = *(const bf16x8*)(smem + GL_KHT + (32 * mt + fr) * 80 + (16 + 8 * hh) * 2);
        U = __builtin_amdgcn_mfma_f32_32x32x16_bf16(ka0, vb0, U, 0, 0, 0);
        U = __builtin_amdgcn_mfma_f32_32x32x16_bf16(ka1, vb1, U, 0, 0, 0);
#pragma unroll
        for (int q = 0; q < 4; ++q) {
          const float4 av = *(const float4*)(sAv + 32 * mt + 8 * q + 4 * hh);
          S[mt][4 * q + 0] = av.x * S[mt][4 * q + 0] + U[4 * q + 0];
          S[mt][4 * q + 1] = av.y * S[mt][4 * q + 1] + U[4 * q + 1];
          S[mt][4 * q + 2] = av.z * S[mt][4 * q + 2] + U[4 * q + 2];
          S[mt][4 * q + 3] = av.w * S[mt][4 * q + 3] + U[4 * q + 3];
          if (!STATE_ONLY) {
            uint2 pk;
            pk.x = pack2(S[mt][4 * q], S[mt][4 * q + 1]);
            pk.y = pack2(S[mt][4 * q + 2], S[mt][4 * q + 3]);
            *(uint2*)(smem + GL_ST + dvc * 144 + (32 * mt + 8 * q + 4 * hh) * 2) = pk;
          }
        }
      }
      if (!STATE_ONLY) {
#pragma unroll
        for (int r = 0; r < 16; ++r) sOs[((r & 3) + 8 * (r >> 2) + 4 * hh) * 132 + dvc] = o[r];
      }
    }
    __syncthreads();
    if (!STATE_ONLY) {
      const int t = tid >> 3, part = tid & 7;
      const int tau = dir == 0 ? t : 31 - t;
      const size_t tok = (size_t)(ctok0 + t);
      float ov[16];
#pragma unroll
      for (int q = 0; q < 4; ++q) {
        const float4 x = *(const float4*)(sOs + tau * 132 + part * 16 + 4 * q);
        ov[4 * q] = x.x; ov[4 * q + 1] = x.y; ov[4 * q + 2] = x.z; ov[4 * q + 3] = x.w;
      }
      bfu* op = p.gla_o + ((size_t)dir * NTOK + tok) * 512 + hd * 128 + part * 16;
      *(uint4*)op = pack8(*(float(*)[8])&ov[0]);
      *(uint4*)(op + 8) = pack8(*(float(*)[8])&ov[8]);
    }
  }
  const int dvc = 32 * w + fr;
  if (STATE_ONLY) {
    const size_t ci = (size_t)(((b * 8 + sidx) * 4 + hd) * 2 + dir);
    float* sl = p.gla_sloc + ci * 8192;
#pragma unroll
    for (int mt = 0; mt < 2; ++mt)
#pragma unroll
      for (int r = 0; r < 16; ++r) sl[(32 * mt + (r & 3) + 8 * (r >> 2) + 4 * hh) * 128 + dvc] = S[mt][r];
    if (thw == 0 && hh == 0) p.gla_aseg[ci * 64 + dkm] = __expf(bsum);
  } else if (prompt) {
    float* op = p.out + OUT_GLA + ((size_t)(((b * 2 + l) * 2 + dir) * 4 + hd)) * 8192;
#pragma unroll
    for (int mt = 0; mt < 2; ++mt)
#pragma unroll
      for (int r = 0; r < 16; ++r) op[(32 * mt + (r & 3) + 8 * (r >> 2) + 4 * hh) * 128 + dvc] = S[mt][r];
  }
  __syncthreads();
}

DI void phase_gla_pass1(const Params& p, int l, char* smem) {
  for (int it = NVB - 1 - VBID; it < 256; it += NVB) {
    const int dir = it & 1, hd = (it >> 1) & 3, seg = 16 + (it >> 3);
    gla_chain<true>(p, l, smem, seg, hd, dir);
  }
}
DI void phase_gla_main(const Params& p, int l, char* smem) {
  for (int it = NVB - 1 - VBID; it < 384; it += NVB) {
    const int dir = it & 1, hd = (it >> 1) & 3, seg = it >> 3;
    gla_chain<false>(p, l, smem, seg, hd, dir);
  }
}
DI void phase_gla_norm(const Params& p, int l, int part) {
  const int tid = tid_(), lane = tid & 63, w = tid >> 6;
  const int ib = (VJ - 48) * 8 + VXCD;
  for (int it = part * (NTOK / 8) + (VJ >= 48 ? ib : NTOK); it < (part + 1) * (NTOK / 8); it += 128) {
    const int tok = it * 4 + w;
    float a[8], b[8], gt[8], res[8];
    unpack8(*(const uint4*)(p.gla_o + (size_t)tok * 512 + lane * 8), a);
    unpack8(*(const uint4*)(p.gla_o + ((size_t)NTOK + tok) * 512 + lane * 8), b);
    unpack8(*(const uint4*)(p.proj + (size_t)tok * PW + OFF_GB + lane * 8), gt);
    float ss = 0.f;
#pragma unroll
    for (int e = 0; e < 8; ++e) { a[e] += b[e]; ss += a[e] * a[e]; }
    ss += __shfl_xor(ss, 1); ss += __shfl_xor(ss, 2); ss += __shfl_xor(ss, 4); ss += __shfl_xor(ss, 8);
    const float rs = rsqrtf(ss * (1.f / 128.f) + EPS);
    const float* g = p.gla_norm_g + l * 512 + lane * 8;
#pragma unroll
    for (int e = 0; e < 8; ++e) res[e] = a[e] * rs * g[e] * siluf_(gt[e]);
    *(uint4*)(p.yb + (size_t)tok * 512 + lane * 8) = pack8(res);
  }
}

DI void phase_merge(const Params& p, int l, char* smem) {
  const bfu* WA = p.w_paT + (size_t)l * 1024 * 512;
  const bfu* WB = p.w_pbT + (size_t)l * 1024 * 512;
  for (int iter = 0;; ++iter) {
    int mt, nt;
    if (!tile256(iter, 4, mt, nt)) break;
    const int m0 = mt * 256, n0 = nt * 256;
    f32x4 acc[2][2][4][2];
    acc256_zero(acc);
    gemm256(p.ya, 512, WA, 512, 512, m0, n0, (bfu*)smem, acc);
    uint4 pg[8], pq[8];
#define MERGE_PRE1 pg[it_] = *(const uint4*)(p.proj + (size_t)(m0 + row) * PW + OFF_MA + n0 + c0);
#define MERGE_PRE2 pg[it_] = *(const uint4*)(p.proj + (size_t)(m0 + row) * PW + OFF_MB + n0 + c0); \
                   pq[it_] = *(const uint4*)(p.merged + (size_t)(m0 + row) * D + n0 + c0);
    EPI256P(MERGE_PRE1, {
      float ma[8], o[8];
      unpack8(pg[it_], ma);
      _Pragma("unroll") for (int e = 0; e < 8; ++e) o[e] = sigmoidf_(ma[e]) * v[e];
      *(uint4*)(p.merged + (size_t)(m0 + row) * D + n0 + c0) = pack8(o);
    })
    acc256_zero(acc);
    gemm256(p.yb, 512, WB, 512, 512, m0, n0, (bfu*)smem, acc);
    EPI256P(MERGE_PRE2, {
      float mb[8], o[8], pr[8];
      unpack8(pg[it_], mb);
      uint4* mp = (uint4*)(p.merged + (size_t)(m0 + row) * D + n0 + c0);
      unpack8(pq[it_], pr);
      _Pragma("unroll") for (int e = 0; e < 8; ++e) o[e] = pr[e] + sigmoidf_(mb[e]) * v[e];
      *mp = pack8(o);
    })
  }
}

DI void phase_out(const Params& p, int l, char* smem) {
  const bfu* W = p.w_oT + (size_t)l * 1024 * 1024;
  for (int iter = 0;; ++iter) {
    int mt, nt;
    if (!tile256(iter, 4, mt, nt)) break;
    const int m0 = mt * 256, n0 = nt * 256;
    f32x4 acc[2][2][4][2];
    acc256_zero(acc);
    gemm256(p.merged, D, W, 1024, 1024, m0, n0, (bfu*)smem, acc);
    const float* gate = p.mod + (size_t)(l * 5 + cond_of_tok(m0)) * 3072 + 2048;
    float4 px0[8], px1[8];
    const float* xsrc = l == 0 ? (m0 < NPROMPT ? p.x_prompt : p.x_sample - (size_t)NPROMPT * D) : p.out;
#define OUT_PRE px0[it_] = *(const float4*)(xsrc + (size_t)(m0 + row) * D + n0 + c0); \
                px1[it_] = *(const float4*)(xsrc + (size_t)(m0 + row) * D + n0 + c0 + 4);
    EPI256P(OUT_PRE, {
      float* xp = p.out + (size_t)(m0 + row) * D + n0 + c0;
      const float* gp = gate + n0 + c0;
      float4 x0 = px0[it_], x1 = px1[it_];
      if (l == 0 && m0 >= NPROMPT) {
        const int t = (m0 + row - NPROMPT) & 2047, col = n0 + c0;
        const float* pe = col < 512 ? p.pos_r + (t >> 6) * 512 + col : p.pos_c + (t & 63) * 512 + (col - 512);
        const float4 e0 = *(const float4*)pe, e1 = *(const float4*)(pe + 4);
        x0.x += e0.x; x0.y += e0.y; x0.z += e0.z; x0.w += e0.w;
        x1.x += e1.x; x1.y += e1.y; x1.z += e1.z; x1.w += e1.w;
      }
      float4 g0 = *(const float4*)gp, g1 = *(const float4*)(gp + 4);
      {
        const float4 h0 = *(const float4*)(gp + MODH), h1 = *(const float4*)(gp + MODH + 4);
        g0.x += h0.x; g0.y += h0.y; g0.z += h0.z; g0.w += h0.w;
        g1.x += h1.x; g1.y += h1.y; g1.z += h1.z; g1.w += h1.w;
      }
      x0.x += g0.x * v[0]; x0.y += g0.y * v[1]; x0.z += g0.z * v[2]; x0.w += g0.w * v[3];
      x1.x += g1.x * v[4]; x1.y += g1.y * v[5]; x1.z += g1.z * v[6]; x1.w += g1.w * v[7];
      *(float4*)xp = x0; *(float4*)(xp + 4) = x1;
    })
  }
}

DI void phase_final(const Params& p) {
  const int tid = tid_(), lane = tid & 63, w = tid >> 6;
  for (int it = VBID; it < NTOK / 4; it += NVB) {
    const int tok = it * 4 + w;
    float* xs = p.out + (size_t)tok * D;
    float4 v[4];
#pragma unroll
    for (int i = 0; i < 4; ++i) v[i] = *(const float4*)(xs + lane * 4 + 256 * i);
    float ss = 0.f;
#pragma unroll
    for (int i = 0; i < 4; ++i) ss += v[i].x * v[i].x + v[i].y * v[i].y + v[i].z * v[i].z + v[i].w * v[i].w;
    ss = wave_sum(ss);
    const float rstd = rsqrtf(ss * (1.f / 1024.f) + EPS);
#pragma unroll
    for (int i = 0; i < 4; ++i) {
      float4 g = *(const float4*)(p.final_g + lane * 4 + 256 * i);
      float4 o;
      o.x = v[i].x * rstd * g.x; o.y = v[i].y * rstd * g.y; o.z = v[i].z * rstd * g.z; o.w = v[i].w * rstd * g.w;
      *(float4*)(xs + lane * 4 + 256 * i) = o;
    }
  }
}

#define XB_TMO      128
#define XB_XCNT(j)  (256  + 64 * (j))
#define XB_XSUB(j)  (1280 + 64 * (j))
#define XB_XGEN(j)  (2304 + 64 * (j))
#define XB_TOP      3328
#define XB_TOPGEN   3392
#define XCD_BAR_WORDS 3456
#define XB_SPIN_CAP (1u << 18)
#define LAS __attribute__((address_space(3)))
DI unsigned xb_ld(unsigned* p) { return __hip_atomic_load(p, __ATOMIC_RELAXED, __HIP_MEMORY_SCOPE_AGENT); }
DI unsigned xb_add(unsigned* p, unsigned v) { return __hip_atomic_fetch_add(p, v, __ATOMIC_RELAXED, __HIP_MEMORY_SCOPE_AGENT); }
DI unsigned xb_xcc_id() { return (unsigned)__builtin_amdgcn_s_getreg((3 << 11) | 20) & 0xFu; }
#define XB_SPIN(cond, bar) do { unsigned _sp = 0; while (cond) { __builtin_amdgcn_s_sleep(1); \
    if ((++_sp & 255u) == 0u) { if (xb_ld(&(bar)[XB_TMO])) break; if (_sp > XB_SPIN_CAP) { atomicAdd(&(bar)[XB_TMO], 1u); break; } } } } while (0)
struct XcdBarrier { unsigned* bar; unsigned x; volatile LAS unsigned* st; };
DI XcdBarrier xcd_barrier_post(unsigned* bar, volatile LAS unsigned* st) {
  XcdBarrier b; b.bar = bar; b.x = xb_xcc_id(); b.st = st;
  if (threadIdx.x == 0) (void)xb_add(&bar[XB_XCNT(b.x)], 1u);
  return b;
}
DI void xcd_barrier_complete(unsigned* bar, unsigned x, unsigned& nloc, unsigned& nx) {
  const unsigned G = gridDim.x * gridDim.y * gridDim.z;
  unsigned sum, cnt, mine, sp = 0u;
  for (;;) {
    sum = 0u; cnt = 0u; mine = 0u;
#pragma unroll
    for (unsigned j = 0; j < 16; ++j) { const unsigned c = xb_ld(&bar[XB_XCNT(j)]); sum += c; cnt += (c > 0u) ? 1u : 0u; mine = (j == x) ? c : mine; }
    if (sum == G) break;
    __builtin_amdgcn_s_sleep(1);
    if ((++sp & 255u) == 0u) { if (xb_ld(&bar[XB_TMO])) break; if (sp > XB_SPIN_CAP) { atomicAdd(&bar[XB_TMO], 1u); break; } }
  }
  nloc = mine > 0u ? mine : 1u; nx = cnt > 0u ? cnt : 1u;
}
DI void xcd_barrier(const XcdBarrier& b) {
  asm volatile("s_waitcnt vmcnt(0)" ::: "memory");
  __syncthreads();
  if (threadIdx.x == 0) {
    unsigned* bar = b.bar;
    __builtin_amdgcn_s_waitcnt(0);
    unsigned nloc = b.st[0], nx = b.st[1];
    if (nloc == 0u) { xcd_barrier_complete(bar, b.x, nloc, nx); b.st[0] = nloc; b.st[1] = nx; }
    const unsigned old = xb_add(&bar[XB_XSUB(b.x)], 1u);
    const unsigned gen = old / nloc;
    if (old + 1u == (gen + 1u) * nloc) {
      __builtin_amdgcn_fence(__ATOMIC_RELEASE, "agent");
      asm volatile("s_waitcnt vmcnt(0)" ::: "memory");
      const unsigned og = xb_add(&bar[XB_TOP], 1u);
      const unsigned tg = og / nx;
      if (og + 1u == (tg + 1u) * nx) xb_add(&bar[XB_TOPGEN], 1u);
      else XB_SPIN(xb_ld(&bar[XB_TOPGEN]) == tg, bar);
      __builtin_amdgcn_fence(__ATOMIC_ACQUIRE, "agent");
      xb_add(&bar[XB_XGEN(b.x)], 1u);
      asm volatile("s_waitcnt vmcnt(0)" ::: "memory");
    } else {
      XB_SPIN(xb_ld(&bar[XB_XGEN(b.x)]) == gen, bar);
      __builtin_amdgcn_fence(__ATOMIC_ACQUIRE, "agent");
      asm volatile("s_waitcnt vmcnt(0)" ::: "memory");
    }
  }
  __syncthreads();
}

#ifndef REP_SYNC
#define REP_SYNC 0
#endif
__global__ void __launch_bounds__(512, 2) k_mega(Params p) {
  extern __shared__ __attribute__((aligned(16))) char smem_all[];
  cg::grid_group grid = cg::this_grid();
  char* smem = smem_all;
#define smh (smem_all + VHALF * 65536)
  volatile LAS unsigned* xst = (volatile LAS unsigned*)(smem_all + 131072);
  if (threadIdx.x < 4) xst[threadIdx.x] = 0u;
  __syncthreads();
  XcdBarrier xb = xcd_barrier_post(p.bar, xst);
#define GSYNC() xcd_barrier(xb)
  phase_prep(p, smh);
  phase_s5_gen(p, 0, smh);
  GSYNC();
  if (p.bar == nullptr) grid.sync();
  for (int l = 0; l < 2; ++l) {
    phase_h(p, l);
    GSYNC();
    phase_gemm_in(p, l, smem);
    GSYNC();
    phase_s5_e(p, smh);
    phase_gla_pass1(p, l, smh);
    GSYNC();
    phase_s5_scan(p, l);
    phase_gla_main(p, l, smh);
    GSYNC();
    phase_s5_y(p, l, smh);
    phase_gla_norm(p, l, 0);
    GSYNC();
    phase_glu(p, l, smh);
    phase_gla_norm(p, l, 1);
    GSYNC();
    phase_merge(p, l, smem);
    if (l == 0 && (blockIdx.x >> 3) >= 24) {
      const int hb = (int)((((blockIdx.x >> 3) - 24) * 8 + (blockIdx.x & 7)) * 2) + VHALF;
      s5_gen_item(p, 1, hb, smh);
    }
    GSYNC();
    phase_out(p, l, smem);
    if (l == 0 && (blockIdx.x >> 3) >= 24) {
      const int hb = (int)((((blockIdx.x >> 3) - 24) * 8 + (blockIdx.x & 7)) * 2) + VHALF;
      s5_gen_item(p, 1, hb + 128, smh);
    }
    GSYNC();
    for (int rep = 0; rep < REP_SYNC; ++rep) GSYNC();
  }
  phase_final(p);
}

extern "C" void kernel_launch(void* const* d_in, const int* in_sizes, int n_in, void* d_out, int out_size,
                              void* d_ws, size_t ws_size, hipStream_t stream) {
  Params p{};
  const float* const* in = (const float* const*)d_in;
  p.x_prompt = in[0]; p.x_sample = in[1]; p.c = in[2]; p.st_re = in[3]; p.st_im = in[4]; p.st_gla = in[5];
  p.c_ctx = in[6]; p.norm_g = in[7]; p.w_mod = in[8]; p.b_mod = in[9]; p.w_in = in[10]; p.wg_up = in[11];
  p.bg = in[12]; p.gla_norm_g = in[13]; p.lam_re = in[14]; p.lam_im = in[15]; p.log_dt = in[16];
  p.b_re = in[17]; p.b_im = in[18]; p.c_re = in[19]; p.c_im = in[20]; p.s5_d = in[21]; p.w_glu = in[22];
  p.b_glu = in[23]; p.w_pa = in[24]; p.w_pb = in[25]; p.w_o = in[26]; p.final_g = in[27];
  p.out = (float*)d_out;
  char* ws = (char*)d_ws;
  size_t off = 0;
  auto take = [&](size_t bytes) { char* r = ws + off; off += (bytes + 255) & ~(size_t)255; return r; };
  p.w_inT = (bfu*)take((size_t)2 * DINP * LDH * 2);
  p.w_gluT = (bfu*)take((size_t)2 * 512 * 512 * 2);
  p.w_paT = (bfu*)take((size_t)2 * 1024 * 512 * 2);
  p.w_pbT = (bfu*)take((size_t)2 * 1024 * 512 * 2);
  p.w_oT = (bfu*)take((size_t)2 * 1024 * 1024 * 2);
  p.pos_r = (float*)take((size_t)32 * 512 * 4);
  p.pos_c = (float*)take((size_t)64 * 512 * 4);
  p.h = (bfu*)take((size_t)NTOK * LDH * 2);
  p.proj = (bfu*)take((size_t)NTOK * PW * 2);
  p.ys5 = (bfu*)take((size_t)NTOK * 512 * 2);
  p.ya = (bfu*)take((size_t)NTOK * 512 * 2);
  p.yb = (bfu*)take((size_t)NTOK * 512 * 2);
  p.merged = (bfu*)take((size_t)NTOK * D * 2);
  p.tmp_s5 = nullptr;
  p.ebuf = (float*)p.merged;
  p.carry = (bfu*)((char*)p.merged + (size_t)32 * NCHUNK * 256 * 4);
  p.ug = (bfu*)take((size_t)32 * NTOK * 16 * 2);
  p.opMG = (bfu*)take((size_t)32 * 512 * 768 * 2);
  p.opE = (bfu*)take((size_t)32 * 256 * 512 * 2);
  p.gla_sloc = (float*)p.ys5;
  p.gla_aseg = (float*)((char*)p.ys5 + (size_t)256 * 8192 * 4);
  if (off > ws_size) fprintf(stderr, "workspace too small: %zu > %zu\n", off, ws_size);
  p.bar = (unsigned*)take((size_t)XCD_BAR_WORDS * 4);
  p.mod = (float*)take((size_t)2 * 2 * 5 * 3072 * 4);
  p.gla_o = (bfu*)p.h;
  p.tmp_gla = (float*)p.h;
  constexpr size_t kLds = 131072 + 16;
  static int grid_blocks = 0;
  if (!grid_blocks) {
    int dev = 0, cus = 0, per_cu = 0;
    hipGetDevice(&dev);
    hipDeviceGetAttribute(&cus, hipDeviceAttributeMultiprocessorCount, dev);
    hipFuncSetAttribute((const void*)k_mega, hipFuncAttributeMaxDynamicSharedMemorySize, (int)kLds);
    hipOccupancyMaxActiveBlocksPerMultiprocessor(&per_cu, k_mega, 512, kLds);
    if (per_cu > 1) per_cu = 1;
    grid_blocks = cus * per_cu;
    if (grid_blocks % 8 != 0 || grid_blocks <= 0) fprintf(stderr, "unexpected grid %d\n", grid_blocks);
  }
  hipMemsetAsync(p.bar, 0, (size_t)XCD_BAR_WORDS * 4, stream);
  void* args[] = {&p};
  hipError_t e = hipLaunchCooperativeKernel((void*)k_mega, dim3(grid_blocks), dim3(512), args, kLds, stream);
  if (e != hipSuccess) fprintf(stderr, "cooperative launch failed: %s (grid %d)\n", hipGetErrorString(e), grid_blocks);
}
```

```cpp
#include <hip/hip_runtime.h>
#include <hip/hip_cooperative_groups.h>
#include <stdint.h>
#include <math.h>
#include <stdio.h>
namespace cg = cooperative_groups;

#ifndef REP_PREP
#define REP_PREP 0
#endif
#ifndef REP_GIN
#define REP_GIN 0
#endif
#ifndef REP_X1
#define REP_X1 0
#endif
#ifndef REP_X2
#define REP_X2 0
#endif
#ifndef REP_Y
#define REP_Y 0
#endif
#ifndef REP_MERGE
#define REP_MERGE 0
#endif
#ifndef REP_SYNC
#define REP_SYNC 0
#endif
#ifndef ONE_LAUNCH
#define ONE_LAUNCH 1
#endif

typedef unsigned short bfu;
typedef __attribute__((ext_vector_type(8))) short bf16x8;
typedef __attribute__((ext_vector_type(16))) float f32x16;
typedef __attribute__((ext_vector_type(2))) __bf16 bf2_t;
typedef __attribute__((ext_vector_type(2))) float f2_t;

#define DI __device__ __forceinline__

constexpr int D = 1024;
constexpr int NTOK = 12288;
constexpr int NPROMPT = 4096;
constexpr int DIN = 4624;
constexpr int DINP = 4864;
constexpr int LDH = 1088;
constexpr int PW = 4112;
constexpr int OFF_GA = 0, OFF_Q = 512, OFF_K = 768, OFF_V = 1024, OFF_GB = 1536, OFF_GL = 2048,
              OFF_MA = 2064, OFF_MB = 3088;
constexpr int NCHUNK = NTOK / 32;
constexpr size_t OUT_RE = (size_t)NTOK * D;
constexpr size_t OUT_IM = OUT_RE + 131072;
constexpr size_t OUT_GLA = OUT_IM + 131072;
constexpr float EPS = 1e-6f;
constexpr int MODH = 2 * 5 * 3072;

struct Params {
  const float *x_prompt, *x_sample, *c, *st_re, *st_im, *st_gla, *c_ctx, *norm_g, *w_mod, *b_mod, *w_in,
      *wg_up, *bg, *gla_norm_g, *lam_re, *lam_im, *log_dt, *b_re, *b_im, *c_re, *c_im, *s5_d, *w_glu,
      *b_glu, *w_pa, *w_pb, *w_o, *final_g;
  float* out;
  bfu *w_inT, *w_gluT, *w_paT, *w_pbT, *w_oT;
  float *mod, *pos_r, *pos_c, *tmp_s5, *tmp_gla;
  bfu *h, *proj, *ys5, *ya, *yb, *merged;
  bfu *ug, *opMG, *opE, *carry;
  float *ebuf, *gla_sloc, *gla_aseg;
  unsigned* bar;
  bfu* gla_o;
};

DI int tid_() { int t = threadIdx.x & 255; asm volatile("" : "+v"(t)); return t; }
#define VHALF ((int)__builtin_amdgcn_readfirstlane((int)(threadIdx.x >> 8)))
#define VBID ((int)(blockIdx.x * 2 + VHALF))
#define NVB ((int)(gridDim.x * 2))
#define VXCD ((int)(blockIdx.x & 7))
#define VJ ((int)((blockIdx.x >> 3) * 2 + VHALF))
#define VNLOC ((int)((gridDim.x >> 3) * 2))
DI float bf2f(bfu v) { return __uint_as_float(((unsigned)v) << 16); }
DI bfu f2bf(float x) { __bf16 b = (__bf16)x; return __builtin_bit_cast(unsigned short, b); }
DI unsigned pack2(float lo, float hi) {
  f2_t v = {lo, hi};
  bf2_t w = __builtin_convertvector(v, bf2_t);
  return __builtin_bit_cast(unsigned, w);
}
DI float exp2f_(float x) { return __builtin_amdgcn_exp2f(x); }
DI float sigmoidf_(float x) { return __builtin_amdgcn_rcpf(1.f + exp2f_(-1.44269504f * x)); }
DI float siluf_(float x) { return x * sigmoidf_(x); }
DI float geluf_(float x) {
  float u = 0.7978845608028654f * (x + 0.044715f * x * x * x);
  float t = 1.f - 2.f * __builtin_amdgcn_rcpf(exp2f_(2.88539008f * u) + 1.f);
  return 0.5f * x * (1.f + t);
}
DI float logsigmoidf_(float x) {
  return fminf(x, 0.f) - 0.69314718f * __builtin_amdgcn_logf(1.f + exp2f_(-1.44269504f * fabsf(x)));
}
DI float wave_sum(float v) {
#pragma unroll
  for (int o = 32; o >= 1; o >>= 1) v += __shfl_xor(v, o);
  return v;
}
DI void unpack8(const uint4 v, float (&f)[8]) {
  f[0] = __uint_as_float(v.x << 16); f[1] = __uint_as_float(v.x & 0xffff0000u);
  f[2] = __uint_as_float(v.y << 16); f[3] = __uint_as_float(v.y & 0xffff0000u);
  f[4] = __uint_as_float(v.z << 16); f[5] = __uint_as_float(v.z & 0xffff0000u);
  f[6] = __uint_as_float(v.w << 16); f[7] = __uint_as_float(v.w & 0xffff0000u);
}
DI uint4 pack8(const float (&f)[8]) {
  uint4 o;
  o.x = pack2(f[0], f[1]); o.y = pack2(f[2], f[3]); o.z = pack2(f[4], f[5]); o.w = pack2(f[6], f[7]);
  return o;
}
typedef float f32x4_nt __attribute__((ext_vector_type(4)));
DI float4 ld_nt4(const float* p) { f32x4_nt v = __builtin_nontemporal_load((const f32x4_nt*)p); return make_float4(v.x, v.y, v.z, v.w); }
DI void st_nt4(float* p, float4 a) { f32x4_nt v = {a.x, a.y, a.z, a.w}; __builtin_nontemporal_store(v, (f32x4_nt*)p); }
DI int cond_of_tok(int tok) { return tok < NPROMPT ? 0 : 1 + ((tok - NPROMPT) >> 11); }

DI void transpose_tile(const float* __restrict__ src, int K, int N, bfu* __restrict__ dst, int kt, int nt,
                       float* sm, int ldd = 0) {
  if (ldd == 0) ldd = K;
  const int tid = tid_(), c = tid & 63, r4 = tid >> 6;
  const int k0 = kt * 64, n0 = nt * 64;
  float v[16];
  const bool inb = (n0 + c) < N;
#pragma unroll
  for (int i = 0; i < 16; ++i) v[i] = inb ? src[(size_t)(k0 + i * 4 + r4) * N + n0 + c] : 0.f;
#pragma unroll
  for (int i = 0; i < 16; ++i) sm[(i * 4 + r4) * 65 + c] = v[i];
  __syncthreads();
  {
    const int n = tid >> 2, kc = tid & 3;
    float o[16];
#pragma unroll
    for (int i = 0; i < 16; ++i) o[i] = sm[(kc * 16 + i) * 65 + n];
    bfu* dp = dst + (size_t)(n0 + n) * ldd + k0 + kc * 16;
    *(uint4*)dp = pack8(*(float(*)[8])&o[0]);
    *(uint4*)(dp + 8) = pack8(*(float(*)[8])&o[8]);
  }
  __syncthreads();
}

DI void phase_prep(const Params& p, char* smem) {
  float* sm = (float*)smem;
  const int tid = tid_();
  for (int it = VBID; it < 192; it += NVB) {
    const int kh = it & 1, jb = (it >> 1) % 48, l = it / 96;
    float* ssil = sm;
    float* sred = sm + 5 * 512;
    for (int idx = tid; idx < 2560; idx += 256) {
      int ci = idx >> 9, k = (idx & 511) + kh * 512;
      float cv = (ci == 0) ? p.c_ctx[k] : p.c[(ci - 1) * 1024 + k];
      ssil[idx] = cv / (1.f + expf(-cv));
    }
    __syncthreads();
    const int jj = tid & 63, kq = tid >> 6;
    const int j = jb * 64 + jj;
    float acc[5] = {0.f, 0.f, 0.f, 0.f, 0.f};
    const float* wp = p.w_mod + ((size_t)l * 1024 + kh * 512 + kq * 128) * 3072 + j;
#pragma unroll 16
    for (int k = 0; k < 128; ++k) {
      float w = wp[(size_t)k * 3072];
#pragma unroll
      for (int ci = 0; ci < 5; ++ci) acc[ci] += ssil[ci * 512 + kq * 128 + k] * w;
    }
#pragma unroll
    for (int ci = 0; ci < 5; ++ci) sred[(kq * 5 + ci) * 64 + jj] = acc[ci];
    __syncthreads();
    for (int idx = tid; idx < 320; idx += 256) {
      int ci = idx >> 6, j2 = idx & 63;
      float sv = kh == 0 ? p.b_mod[l * 3072 + jb * 64 + j2] : 0.f;
#pragma unroll
      for (int q = 0; q < 4; ++q) sv += sred[(q * 5 + ci) * 64 + j2];
      p.mod[((size_t)(kh * 2 + l) * 5 + ci) * 3072 + jb * 64 + j2] = sv;
    }
    __syncthreads();
  }
  for (int idx = VBID * 256 + tid; idx < 96 * 512; idx += NVB * 256) {
    int r = idx >> 9, i = idx & 511;
    int pos = r < 32 ? r : r - 32;
    int q = i & 255;
    double f = exp(-log(10000.0) * (double)q / 256.0);
    double ang = (double)pos * f;
    float v = (float)((i < 256) ? sin(ang) : cos(ang));
    if (r < 32) p.pos_r[r * 512 + i] = v; else p.pos_c[(r - 32) * 512 + i] = v;
  }
  for (int it = VBID; it < 3584; it += NVB) {
    int l = it / 1792, r = it % 1792;
    if (r < 1216) {
      transpose_tile(p.w_in + (size_t)l * 1024 * DIN, 1024, DIN, p.w_inT + (size_t)l * DINP * LDH, r % 16, r / 16, sm, LDH);
    } else if (r < 1280) {
      r -= 1216;
      transpose_tile(p.w_glu + (size_t)l * 512 * 512, 512, 512, p.w_gluT + (size_t)l * 512 * 512, r % 8, r / 8, sm);
    } else if (r < 1408) {
      r -= 1280;
      transpose_tile(p.w_pa + (size_t)l * 512 * 1024, 512, 1024, p.w_paT + (size_t)l * 1024 * 512, r % 8, r / 8, sm);
    } else if (r < 1536) {
      r -= 1408;
      transpose_tile(p.w_pb + (size_t)l * 512 * 1024, 512, 1024, p.w_pbT + (size_t)l * 1024 * 512, r % 8, r / 8, sm);
    } else {
      r -= 1536;
      transpose_tile(p.w_o + (size_t)l * 1024 * 1024, 1024, 1024, p.w_oT + (size_t)l * 1024 * 1024, r % 16, r / 16, sm);
    }
  }
}

DI void phase_h(const Params& p, int l) {
  const int tid = tid_(), lane = tid & 63, w = tid >> 6;
  for (int it = VBID; it < NTOK / 4; it += NVB) {
    const int tok = it * 4 + w;
    float4 v[4];
    float* xs = p.out + (size_t)tok * D;
    if (l == 0) {
      const float* src = tok < NPROMPT ? p.x_prompt + (size_t)tok * D : p.x_sample + (size_t)(tok - NPROMPT) * D;
#pragma unroll
      for (int i = 0; i < 4; ++i) v[i] = ld_nt4(src + lane * 4 + 256 * i);
      if (tok >= NPROMPT) {
        int t = (tok - NPROMPT) & 2047, row = t >> 6, col = t & 63;
#pragma unroll
        for (int i = 0; i < 4; ++i) {
          int d = lane * 4 + 256 * i;
          const float* pe = d < 512 ? p.pos_r + row * 512 + d : p.pos_c + col * 512 + (d - 512);
          float4 e = *(const float4*)pe;
          v[i].x += e.x; v[i].y += e.y; v[i].z += e.z; v[i].w += e.w;
        }
      }
    } else {
#pragma unroll
      for (int i = 0; i < 4; ++i) v[i] = ld_nt4(xs + lane * 4 + 256 * i);
    }
    float ss = 0.f;
#pragma unroll
    for (int i = 0; i < 4; ++i) ss += v[i].x * v[i].x + v[i].y * v[i].y + v[i].z * v[i].z + v[i].w * v[i].w;
    ss = wave_sum(ss);
    const float rstd = rsqrtf(ss * (1.f / 1024.f) + EPS);
    const float* md = p.mod + (size_t)(l * 5 + cond_of_tok(tok)) * 3072;
    const float* ng = p.norm_g + l * 1024;
#pragma unroll
    for (int i = 0; i < 4; ++i) {
      int d = lane * 4 + 256 * i;
      float4 g = *(const float4*)(ng + d);
      float4 sh = *(const float4*)(md + d);
      float4 sc = *(const float4*)(md + 1024 + d);
      {
        const float4 sh1 = *(const float4*)(md + MODH + d);
        const float4 sc1 = *(const float4*)(md + MODH + 1024 + d);
        sh.x += sh1.x; sh.y += sh1.y; sh.z += sh1.z; sh.w += sh1.w;
        sc.x += sc1.x; sc.y += sc1.y; sc.z += sc1.z; sc.w += sc1.w;
      }
      float a0 = v[i].x * rstd * g.x * (1.f + sc.x) + sh.x;
      float a1 = v[i].y * rstd * g.y * (1.f + sc.y) + sh.y;
      float a2 = v[i].z * rstd * g.z * (1.f + sc.z) + sh.z;
      float a3 = v[i].w * rstd * g.w * (1.f + sc.w) + sh.w;
      uint2 o; o.x = pack2(a0, a1); o.y = pack2(a2, a3);
      *(uint2*)(p.h + (size_t)tok * LDH + d) = o;
    }
  }
}

DI void gemm_core(const bfu* A, int lda, const bfu* __restrict__ B, int ldb, int K, char* smem,
                  f32x16 (&acc)[2][2], const bfu* A2, int lda2, int K2) {
  const int tid = tid_(), lane = tid & 63, w = tid >> 6, wm = w >> 1, wn = w & 1;
  const int c8 = tid & 7, r0 = tid >> 3;
  const bfu* ga = A + (size_t)r0 * lda + c8 * 8;
  const bfu* gb = B + (size_t)r0 * ldb + c8 * 8;
  const int st_off = r0 * 128 + ((c8 ^ ((r0 >> 1) & 7)) * 16);
  const int fr = lane & 31, hh = lane >> 5, fsw = (fr >> 1) & 7;
  const int a_base = (wm * 64 + fr) * 128;
  const int b_base = 16384 + (wn * 64 + fr) * 128;
  uint4 ra0, ra1, ra2, ra3, rb0, rb1, rb2, rb3, qa0, qa1, qa2, qa3, qb0, qb1, qb2, qb3;
  const int KT1 = K >> 6, KT = (K + K2) >> 6;
  const bfu* ga2 = A2 + (size_t)r0 * lda2 + c8 * 8;
#define GEMM_LOADT(RA, RB, tile)                                                           \
  {                                                                                        \
    const int t_ = (tile) < KT ? (tile) : KT - 1;                                          \
    const bool s2_ = t_ >= KT1;                                                            \
    const bfu* ga_ = s2_ ? ga2 + (t_ - KT1) * 64 : ga + t_ * 64;                           \
    const size_t la_ = s2_ ? (size_t)lda2 : (size_t)lda;                                   \
    const bfu* gb_ = gb + t_ * 64;                                                         \
    RA##0 = *(const uint4*)(ga_);                 RB##0 = *(const uint4*)(gb_);                        \
    RA##1 = *(const uint4*)(ga_ + 32 * la_);      RB##1 = *(const uint4*)(gb_ + (size_t)32 * ldb);     \
    RA##2 = *(const uint4*)(ga_ + 64 * la_);      RB##2 = *(const uint4*)(gb_ + (size_t)64 * ldb);     \
    RA##3 = *(const uint4*)(ga_ + 96 * la_);      RB##3 = *(const uint4*)(gb_ + (size_t)96 * ldb);     \
  }
#define GEMM_STORET(buf, RA, RB)                                                           \
  {                                                                                        \
    *(uint4*)((buf) + st_off) = RA##0;          *(uint4*)((buf) + 16384 + st_off) = RB##0;          \
    *(uint4*)((buf) + st_off + 4096) = RA##1;   *(uint4*)((buf) + 16384 + st_off + 4096) = RB##1;   \
    *(uint4*)((buf) + st_off + 8192) = RA##2;   *(uint4*)((buf) + 16384 + st_off + 8192) = RB##2;   \
    *(uint4*)((buf) + st_off + 12288) = RA##3;  *(uint4*)((buf) + 16384 + st_off + 12288) = RB##3;  \
  }
#define GEMM_COMPUTE(cur)                                                                  \
  _Pragma("unroll") for (int s = 0; s < 4; ++s) {                                          \
    const int co = ((2 * s + hh) ^ fsw) * 16;                                              \
    bf16x8 a0 = *(const bf16x8*)((cur) + a_base + co);                                     \
    bf16x8 a1 = *(const bf16x8*)((cur) + a_base + 4096 + co);                              \
    bf16x8 b0 = *(const bf16x8*)((cur) + b_base + co);                                     \
    bf16x8 b1 = *(const bf16x8*)((cur) + b_base + 4096 + co);                              \
    acc[0][0] = __builtin_amdgcn_mfma_f32_32x32x16_bf16(a0, b0, acc[0][0], 0, 0, 0);       \
    acc[0][1] = __builtin_amdgcn_mfma_f32_32x32x16_bf16(a0, b1, acc[0][1], 0, 0, 0);       \
    acc[1][0] = __builtin_amdgcn_mfma_f32_32x32x16_bf16(a1, b0, acc[1][0], 0, 0, 0);       \
    acc[1][1] = __builtin_amdgcn_mfma_f32_32x32x16_bf16(a1, b1, acc[1][1], 0, 0, 0);       \
  }
  GEMM_LOADT(ra, rb, 0)
  GEMM_LOADT(qa, qb, 1)
  GEMM_STORET(smem, ra, rb)
  __syncthreads();
#pragma unroll 1
  for (int kt = 0; kt < KT; kt += 2) {
    GEMM_LOADT(ra, rb, kt + 2)
    __builtin_amdgcn_sched_barrier(0);
    GEMM_COMPUTE(smem)
    __builtin_amdgcn_sched_barrier(0);
    GEMM_STORET(smem + 32768, qa, qb)
    __syncthreads();
    GEMM_LOADT(qa, qb, kt + 3)
    __builtin_amdgcn_sched_barrier(0);
    GEMM_COMPUTE(smem + 32768)
    __builtin_amdgcn_sched_barrier(0);
    GEMM_STORET(smem, ra, rb)
    __syncthreads();
  }
}

DI void acc_zero(f32x16 (&acc)[2][2]) {
#pragma unroll
  for (int i = 0; i < 2; ++i)
#pragma unroll
    for (int j = 0; j < 2; ++j)
#pragma unroll
      for (int r = 0; r < 16; ++r) acc[i][j][r] = 0.f;
}

DI void acc_to_lds(const f32x16 (&acc)[2][2], char* smem) {
  float* sf = (float*)smem;
  const int tid = tid_(), lane = tid & 63, w = tid >> 6;
  const int rb = (w >> 1) * 64 + 4 * (lane >> 5), cb = (w & 1) * 64 + (lane & 31);
#pragma unroll
  for (int i = 0; i < 2; ++i)
#pragma unroll
    for (int j = 0; j < 2; ++j)
#pragma unroll
      for (int r = 0; r < 16; ++r)
        sf[(rb + i * 32 + (r & 3) + 8 * (r >> 2)) * 128 + cb + j * 32] = acc[i][j][r];
}
#define EPI_LDS(...)                                                             \
  {                                                                              \
    acc_to_lds(acc, smem);                                                       \
    __syncthreads();                                                             \
    _Pragma("unroll 1") for (int it_ = 0; it_ < 8; ++it_) {                      \
      const int row = (tid_() >> 4) + 16 * it_;                             \
      const int c0 = (tid_() & 15) * 8;                                     \
      float v[8];                                                                \
      {                                                                          \
        const float4 t0 = *(const float4*)(smem + (row * 128 + c0) * 4);         \
        const float4 t1 = *(const float4*)(smem + (row * 128 + c0 + 4) * 4);     \
        v[0] = t0.x; v[1] = t0.y; v[2] = t0.z; v[3] = t0.w;                      \
        v[4] = t1.x; v[5] = t1.y; v[6] = t1.z; v[7] = t1.w;                      \
      }                                                                          \
      __VA_ARGS__                                                                \
    }                                                                            \
    __syncthreads();                                                             \
  }

typedef __attribute__((ext_vector_type(4))) float f32x4;
constexpr int G_BK = 64, G_HALF = 128, G_HT = G_HALF * G_BK;
DI int g_lds_byte(int r, int c) {
  int st = (r >> 4) * 2 + (c >> 5), rr = r & 15, cc = c & 31, ob = rr * 64 + cc * 2;
  return st * 1024 + (ob ^ (((ob >> 9) & 1) << 5));
}
DI void g_stage_rc(int b, int& R, int& C) {
  int st = b / 1024, sb = b % 1024, swz = sb ^ (((sb >> 9) & 1) << 5);
  R = (st >> 1) * 16 + swz / 64; C = (st & 1) * 32 + (swz % 64) / 2;
}
DI const char* g_uniform(const char* ptr) {
  unsigned long long u = (unsigned long long)ptr;
  unsigned lo = __builtin_amdgcn_readfirstlane((unsigned)u), hi = __builtin_amdgcn_readfirstlane((unsigned)(u >> 32));
  return (const char*)(((unsigned long long)hi << 32) | lo);
}
DI void gemm256(const bfu* __restrict__ A, int lda, const bfu* __restrict__ Bt, int ldb, int K, int brow, int bcol,
                bfu* shm, f32x4 (&acc)[2][2][4][2]) {
#define G_SA(b, h) (shm + ((b) * 2 + (h)) * G_HT)
#define G_SB(b, h) (shm + (4 + (b) * 2 + (h)) * G_HT)
#define G_STAGE(P, BASE, LD, br, kt)                                                                   \
  do {                                                                                                 \
    const char* _u = g_uniform((const char*)((BASE) + ((long)(br) * (LD) + (long)(kt) * G_BK)));       \
    __builtin_amdgcn_global_load_lds((const unsigned*)(_u + soff_b),                                   \
        (__attribute__((address_space(3))) unsigned*)((char*)(P) + ldst), 16, 0, 0);                   \
    __builtin_amdgcn_global_load_lds((const unsigned*)(_u + 128 * (long)(LD) + soff_b),                \
        (__attribute__((address_space(3))) unsigned*)((char*)(P) + ldst + 8192), 16, 0, 0);            \
  } while (0)
#define G_LDA(dst, b, h) for (int m = 0; m < 4; ++m) for (int k = 0; k < 2; ++k) \
    dst[m][k] = *reinterpret_cast<const bf16x8*>((char*)G_SA(b, h) + a_rd + m * 2048 + k * 1024)
#define G_LDB(dst, b, h) for (int n = 0; n < 2; ++n) for (int k = 0; k < 2; ++k) \
    dst[n][k] = *reinterpret_cast<const bf16x8*>((char*)G_SB(b, h) + b_rd + n * 2048 + k * 1024)
#define G_MMA(ai, bj, At, Bt_)                                                                         \
  do {                                                                                                 \
    __builtin_amdgcn_s_setprio(1);                                                                     \
    for (int m = 0; m < 4; ++m) for (int n = 0; n < 2; ++n) for (int k = 0; k < 2; ++k)                \
      acc[ai][bj][m][n] = __builtin_amdgcn_mfma_f32_16x16x32_bf16(At[m][k], Bt_[n][k], acc[ai][bj][m][n], 0, 0, 0); \
    __builtin_amdgcn_s_setprio(0);                                                                     \
  } while (0)
#define G_WAIT_V(n) asm volatile("s_waitcnt vmcnt(" #n ")" ::: "memory")
#define G_WAIT_L(n) asm volatile("s_waitcnt lgkmcnt(" #n ")" ::: "memory")
#define G_BAR __builtin_amdgcn_s_barrier()
#define G_SCHED __builtin_amdgcn_sched_barrier(0)
  int t512 = threadIdx.x; asm volatile("" : "+v"(t512));
  const int wid = __builtin_amdgcn_readfirstlane(t512 >> 6), lane = t512 & 63, wr = wid >> 2, wc = wid & 3, fr = lane & 15, fq = lane >> 4;
  const int ldst = t512 * 16;
  unsigned soff_b;
  {
    int R0, C0;
    g_stage_rc(ldst, R0, C0);
    soff_b = (unsigned)(R0 * lda + C0) * 2u;
  }
  const int lane_off = (fr * 64 + fq * 16) ^ ((fr >> 3) << 5);
  const int a_rd = wr * 8192 + lane_off, b_rd = wc * 4096 + lane_off;
  bf16x8 At[4][2], B0[2][2], B1[2][2];
  const int nt = K / G_BK;
  G_STAGE(G_SB(0, 0), Bt, ldb, bcol, 0); G_STAGE(G_SA(0, 0), A, lda, brow, 0);
  G_STAGE(G_SB(0, 1), Bt, ldb, bcol + G_HALF, 0); G_STAGE(G_SA(0, 1), A, lda, brow + G_HALF, 0);
  if (wr == 1) G_BAR;
  G_WAIT_V(4); G_BAR;
  G_STAGE(G_SB(1, 0), Bt, ldb, bcol, 1); G_STAGE(G_SA(1, 0), A, lda, brow, 1); G_STAGE(G_SB(1, 1), Bt, ldb, bcol + G_HALF, 1);
  G_WAIT_V(6); G_BAR;
#pragma unroll 1
  for (int t = 0; t < nt - 2; t += 2) {
    G_LDB(B0, 0, 0); G_SCHED; G_LDA(At, 0, 0); G_STAGE(G_SA(1, 1), A, lda, brow + G_HALF, t + 1);
    G_WAIT_L(8); G_BAR; G_WAIT_L(0); G_MMA(0, 0, At, B0); G_BAR; G_SCHED;
    G_LDB(B1, 0, 1); G_STAGE(G_SB(0, 0), Bt, ldb, bcol, t + 2);
    G_BAR; G_WAIT_L(0); G_MMA(0, 1, At, B1); G_BAR;
    G_LDA(At, 0, 1); G_STAGE(G_SA(0, 0), A, lda, brow, t + 2);
    G_BAR; G_WAIT_L(0); G_MMA(1, 0, At, B0); G_BAR; G_SCHED;
    G_STAGE(G_SB(0, 1), Bt, ldb, bcol + G_HALF, t + 2);
    G_WAIT_V(6); G_BAR; G_MMA(1, 1, At, B1); G_BAR;
    G_LDB(B0, 1, 0); G_SCHED; G_LDA(At, 1, 0); G_STAGE(G_SA(0, 1), A, lda, brow + G_HALF, t + 2);
    G_WAIT_L(8); G_BAR; G_WAIT_L(0); G_MMA(0, 0, At, B0); G_BAR; G_SCHED;
    G_LDB(B1, 1, 1); G_STAGE(G_SB(1, 0), Bt, ldb, bcol, t + 3);
    G_BAR; G_WAIT_L(0); G_MMA(0, 1, At, B1); G_BAR;
    G_LDA(At, 1, 1); G_STAGE(G_SA(1, 0), A, lda, brow, t + 3);
    G_BAR; G_WAIT_L(0); G_MMA(1, 0, At, B0); G_BAR; G_SCHED;
    G_STAGE(G_SB(1, 1), Bt, ldb, bcol + G_HALF, t + 3);
    G_WAIT_V(6); G_BAR; G_MMA(1, 1, At, B1); G_BAR;
  }
  { G_LDB(B0, 0, 0); G_LDA(At, 0, 0); G_STAGE(G_SA(1, 1), A, lda, brow + G_HALF, nt - 1);
    G_BAR; G_WAIT_L(0); G_MMA(0, 0, At, B0); G_BAR;
    G_LDB(B1, 0, 1); G_BAR; G_WAIT_L(0); G_MMA(0, 1, At, B1); G_BAR;
    G_LDA(At, 0, 1); G_WAIT_V(4); G_BAR; G_WAIT_L(0); G_MMA(1, 0, At, B0); G_MMA(1, 1, At, B1); G_BAR; }
  { G_LDB(B0, 1, 0); G_LDA(At, 1, 0); G_WAIT_V(2); G_BAR; G_WAIT_L(0); G_MMA(0, 0, At, B0); G_BAR;
    G_LDB(B1, 1, 1); G_WAIT_V(0); G_BAR; G_WAIT_L(0); G_MMA(0, 1, At, B1); G_BAR;
    G_LDA(At, 1, 1); G_BAR; G_WAIT_L(0); G_MMA(1, 0, At, B0); G_MMA(1, 1, At, B1); G_BAR; }
  if (wr == 0) G_BAR;
}
DI void acc256_zero(f32x4 (&acc)[2][2][4][2]) {
#pragma unroll
  for (int a = 0; a < 2; ++a)
#pragma unroll
    for (int b = 0; b < 2; ++b)
#pragma unroll
      for (int m = 0; m < 4; ++m)
#pragma unroll
        for (int n = 0; n < 2; ++n) acc[a][b][m][n] = (f32x4){0.f, 0.f, 0.f, 0.f};
}
#define EPI_NOPRE
#define EPI256P(PRE, ...)                                                                              \
  {                                                                                                    \
    int t512_ = threadIdx.x; asm volatile("" : "+v"(t512_));     \
    const int wid_ = t512_ >> 6, lane_ = t512_ & 63, wr_ = wid_ >> 2, wc_ = wid_ & 3,                  \
              fr_ = lane_ & 15, fq_ = lane_ >> 4;                                                      \
    float* sf_ = (float*)smem;                                                                         \
    _Pragma("unroll") for (int ai_ = 0; ai_ < 2; ++ai_) {                                              \
      _Pragma("unroll") for (int it_ = 0; it_ < 8; ++it_) {     \
        const int idx_ = t512_ + 512 * it_;                                                            \
        const int rl_ = idx_ >> 5, c0 = (idx_ & 31) * 8;                                               \
        const int row = ai_ * 128 + rl_;                                                               \
        (void)rl_; (void)c0; (void)row;                                                                \
        PRE                                                                                            \
      }                                                                                                \
      __builtin_amdgcn_sched_barrier(0);              \
      __syncthreads();                                                                                 \
      _Pragma("unroll") for (int bj_ = 0; bj_ < 2; ++bj_)                                              \
      _Pragma("unroll") for (int m_ = 0; m_ < 4; ++m_)                                                 \
      _Pragma("unroll") for (int n_ = 0; n_ < 2; ++n_)                                                 \
      _Pragma("unroll") for (int j_ = 0; j_ < 4; ++j_)                                                 \
        sf_[(wr_ * 64 + m_ * 16 + fq_ * 4 + j_) * 256 + ((bj_ * 128 + wc_ * 32 + n_ * 16 + fr_) ^ (fq_ << 4))] = \
            acc[ai_][bj_][m_][n_][j_];                                                                 \
      __syncthreads();                                                                                 \
      _Pragma("unroll") for (int it_ = 0; it_ < 8; ++it_) {                                            \
        const int idx_ = t512_ + 512 * it_;                                                            \
        const int rl_ = idx_ >> 5, c0 = (idx_ & 31) * 8;                                               \
        const int row = ai_ * 128 + rl_;                                                               \
        float v[8];                                                                                    \
        {                                                                                              \
          const float* sp_ = sf_ + rl_ * 256 + (c0 ^ (((rl_ >> 2) & 3) << 4));                          \
          const float4 t0 = *(const float4*)sp_; const float4 t1 = *(const float4*)(sp_ + 4);          \
          v[0] = t0.x; v[1] = t0.y; v[2] = t0.z; v[3] = t0.w;                                          \
          v[4] = t1.x; v[5] = t1.y; v[6] = t1.z; v[7] = t1.w;                                          \
        }                                                                                              \
        __VA_ARGS__                                                                                    \
      }                                                                                                \
    }                                                                                                  \
    __syncthreads();                                                                                   \
  }
#define EPI256(...) EPI256P(EPI_NOPRE, __VA_ARGS__)

template <int MT, int NT, int BH>
DI bool xcd_tile(int iter, int& mt, int& nt) {
  constexpr int MPX = MT / 8, TPX = MPX * NT;
  const int xcd = VXCD, j = VJ, nloc = VNLOC;
  const int q = j + iter * nloc;
  if (q >= TPX) return false;
  const int band = q / (BH * NT), r = q % (BH * NT);
  nt = r / BH;
  mt = xcd * MPX + band * BH + (r % BH);
  return true;
}

DI bool tile256(int iter, int NT, int& mt, int& nt) {
  const int xcd = blockIdx.x & 7, j = blockIdx.x >> 3, nloc = gridDim.x >> 3;
  const int q = j + iter * nloc;
  if (q >= 6 * NT) return false;
  nt = q / 6; mt = xcd * 6 + q % 6;
  return true;
}
DI void phase_gemm_in(const Params& p, int l, char* smem) {
  const bfu* W = p.w_inT + (size_t)l * DINP * LDH;
  for (int iter = 0;; ++iter) {
    int mt, nt;
    if (!tile256(iter, 19, mt, nt)) break;
    f32x4 acc[2][2][4][2];
    acc256_zero(acc);
    gemm256(p.h, LDH, W, LDH, 1024, mt * 256, nt * 256, (bfu*)smem, acc);
    const int m0 = mt * 256, n0 = nt * 256;
    EPI256({
      const int n = n0 + c0;
      if (n < 512) *(uint4*)(p.ug + ((size_t)(n >> 4) * NTOK + (m0 + row)) * 16 + (n & 15)) = pack8(v);
      else if (n < DIN) *(uint4*)(p.proj + (size_t)(m0 + row) * PW + (n - 512)) = pack8(v);
    })
  }
}

DI void s5_gen_item(const Params& p, int l, int item, char* smem) {
  const int tid = tid_();
  const int g = item >> 3, r = item & 7;
  float* sBr = (float*)smem;
  float* sBi = sBr + 2048;
  float* sCr = sBi + 2048;
  float* sCi = sCr + 1024;
  float* sAK = sCi + 1024;
  float* sAE = sAK + 1024;
  float* sAG = sAE + 1024;
  float* sK = sAG + 1024;
  bfu* E = p.opE + (size_t)g * 256 * 512;
  bfu* MG = p.opMG + (size_t)g * 512 * 768;
  __syncthreads();
  if (tid < 128) {
    const int d = tid >> 6, pp = tid & 63;
    const size_t pi = ((size_t)(l * 2 + d) * 32 + g) * 64 + pp;
    const float lr = p.lam_re[pi], li = p.lam_im[pi];
    const float dt = expf(p.log_dt[(l * 2 + d) * 32 + g]);
    const float mag = expf(lr * dt);
    float sn, cs;
    sincosf(li * dt, &sn, &cs);
    const float are = mag * cs, aim = mag * sn;
    const float nr = are - 1.f, ni = aim, den = lr * lr + li * li;
    const float kr = (nr * lr + ni * li) / den, ki = (ni * lr - nr * li) / den;
#pragma unroll
    for (int c = 0; c < 16; ++c) {
      float br = p.b_re[((size_t)(l * 32 + g) * 64 + pp) * 16 + c];
      float bi = p.b_im[((size_t)(l * 32 + g) * 64 + pp) * 16 + c];
      sBr[(d * 64 + pp) * 16 + c] = kr * br - ki * bi;
      sBi[(d * 64 + pp) * 16 + c] = kr * bi + ki * br;
    }
#pragma unroll
    for (int q = 0; q < 4; ++q) {
      const int t = 4 * r + q;
      const int nK = t;
      const int nE = d == 0 ? 31 - t : t;
      const int nG = d == 0 ? t + 1 : 32 - t;
      const float er = lr * dt * 1.44269504f, rv = li * dt * 0.15915494f;
      float m, s_, c_, fr_;
      m = exp2f_(er * (float)nK); fr_ = rv * (float)nK; fr_ -= floorf(fr_);
      s_ = __builtin_amdgcn_sinf(fr_); c_ = __builtin_amdgcn_cosf(fr_);
      sAK[((d * 4 + q) * 64 + pp) * 2] = m * c_; sAK[((d * 4 + q) * 64 + pp) * 2 + 1] = m * s_;
      m = exp2f_(er * (float)nE); fr_ = rv * (float)nE; fr_ -= floorf(fr_);
      s_ = __builtin_amdgcn_sinf(fr_); c_ = __builtin_amdgcn_cosf(fr_);
      sAE[((d * 4 + q) * 64 + pp) * 2] = m * c_; sAE[((d * 4 + q) * 64 + pp) * 2 + 1] = m * s_;
      m = exp2f_(er * (float)nG); fr_ = rv * (float)nG; fr_ -= floorf(fr_);
      s_ = __builtin_amdgcn_sinf(fr_); c_ = __builtin_amdgcn_cosf(fr_);
      sAG[((d * 4 + q) * 64 + pp) * 2] = m * c_; sAG[((d * 4 + q) * 64 + pp) * 2 + 1] = m * s_;
    }
  } else {
    for (int idx = tid - 128; idx < 1024; idx += 128) {
      sCr[idx] = p.c_re[(size_t)(l * 32 + g) * 1024 + idx];
      sCi[idx] = p.c_im[(size_t)(l * 32 + g) * 1024 + idx];
    }
  }
  __syncthreads();
#pragma unroll 1
  for (int i = 0; i < 4; ++i) {
    const int idx = tid + 256 * i;
    const int row = idx >> 2, q = idx & 3;
    const int part = row >> 6, pp = row & 63, d = part >> 1;
    const float ar = sAE[((d * 4 + q) * 64 + pp) * 2], ai = sAE[((d * 4 + q) * 64 + pp) * 2 + 1];
    const float* br = sBr + (d * 64 + pp) * 16;
    const float* bi = sBi + (d * 64 + pp) * 16;
    float v[16];
#pragma unroll
    for (int c = 0; c < 16; ++c) v[c] = (part & 1) ? (ar * bi[c] + ai * br[c]) : (ar * br[c] - ai * bi[c]);
    bfu* dp = E + (size_t)row * 512 + (4 * r + q) * 16;
    *(uint4*)dp = pack8(*(float(*)[8])&v[0]);
    *(uint4*)(dp + 8) = pack8(*(float(*)[8])&v[8]);
  }
#pragma unroll 1
  for (int i = 0; i < 8; ++i) {
    const int idx = tid + 256 * i;
    const int rr = idx >> 5, cg = idx & 31, q = rr >> 4, c = rr & 15;
    const int part = cg >> 3, pp0 = (cg & 7) * 8, d = part >> 1;
    const float* ag = sAG + ((d * 4 + q) * 64 + pp0) * 2;
    const float* cr = sCr + c * 64 + pp0;
    const float* ci = sCi + c * 64 + pp0;
    float v[8];
#pragma unroll
    for (int e = 0; e < 8; ++e) {
      const float ar = ag[2 * e], ai = ag[2 * e + 1];
      v[e] = (part & 1) ? -(cr[e] * ai + ci[e] * ar) : (cr[e] * ar - ci[e] * ai);
    }
    *(uint4*)(MG + (size_t)((4 * r + q) * 16 + c) * 768 + 512 + cg * 8) = pack8(v);
  }
  {
    const int d = tid >> 7, q = (tid >> 5) & 3, c = (tid >> 1) & 15, ch = tid & 1;
    float acc[8];
#pragma unroll
    for (int e = 0; e < 8; ++e) acc[e] = 0.f;
    for (int pp = 0; pp < 64; ++pp) {
      const float ar = sAK[((d * 4 + q) * 64 + pp) * 2], ai = sAK[((d * 4 + q) * 64 + pp) * 2 + 1];
      const float cr = sCr[c * 64 + pp], ci = sCi[c * 64 + pp];
      const float wr = cr * ar - ci * ai, wi = cr * ai + ci * ar;
#pragma unroll
      for (int e = 0; e < 8; ++e)
        acc[e] += wr * sBr[(d * 64 + pp) * 16 + ch * 8 + e] - wi * sBi[(d * 64 + pp) * 16 + ch * 8 + e];
    }
#pragma unroll
    for (int e = 0; e < 8; ++e) sK[((d * 4 + q) * 16 + c) * 16 + ch * 8 + e] = acc[e];
  }
  __syncthreads();
  for (int idx = tid; idx < 8192; idx += 256) {
    const int ch = idx & 1, c = (idx >> 1) & 15, tp = (idx >> 5) & 31, q = (idx >> 10) & 3, d = idx >> 12;
    const int tau = 4 * r + q;
    int sp;
    bool valid;
    if (d == 0) { sp = tp - tau; valid = sp >= 0; } else { sp = tp + tau; valid = (sp <= 31) && (tau > 0); }
    if (valid) {
      float v[8];
#pragma unroll
      for (int e = 0; e < 8; ++e) {
        float x = sK[((d * 4 + q) * 16 + c) * 16 + ch * 8 + e];
        if (tau == 0) x += sK[((1 * 4 + q) * 16 + c) * 16 + ch * 8 + e];
        v[e] = x;
      }
      *(uint4*)(MG + (size_t)(tp * 16 + c) * 768 + sp * 16 + ch * 8) = pack8(v);
    }
  }
  __syncthreads();
}

DI void phase_s5_gen(const Params& p, int l, char* smem) {
  for (int it = NVB - 1 - VBID; it < 256; it += NVB) s5_gen_item(p, l, it, smem);
}

DI void phase_s5_e(const Params& p, char* smem) {
  for (int q = VJ; q < 24; q += VNLOC) {
    const int g = VXCD * 4 + q / 6, r6 = q % 6, mt = r6 >> 1, nt = r6 & 1;
    f32x16 acc[2][2];
    acc_zero(acc);
    gemm_core(p.ug + ((size_t)g * NCHUNK + mt * 128) * 512, 512, p.opE + ((size_t)g * 256 + nt * 128) * 512, 512, 512,
              smem, acc, p.ug, 512, 0);
    EPI_LDS({
      float* dst = p.ebuf + ((size_t)g * NCHUNK + mt * 128 + row) * 256 + nt * 128 + c0;
      *(float4*)dst = make_float4(v[0], v[1], v[2], v[3]);
      *(float4*)(dst + 4) = make_float4(v[4], v[5], v[6], v[7]);
    })
  }
}

DI void phase_s5_scan(const Params& p, int l) {
  const int tid = tid_();
  for (int it = (VBID < 128 ? VBID : 320); it < 320; it += 128) {
    const int wi = it * 2 + (tid >> 7);
    const int dir = (tid >> 6) & 1, pp = tid & 63;
    int chunk0, n, b, g;
    bool prompt;
    if (wi < 128) { b = wi >> 5; g = wi & 31; chunk0 = (NPROMPT + b * 2048) >> 5; n = 64; prompt = false; }
    else { int q = wi - 128; b = q >> 5; g = q & 31; chunk0 = (b * 256) >> 5; n = 8; prompt = true; }
    const size_t pi = ((size_t)(l * 2 + dir) * 32 + g) * 64 + pp;
    const float lr = p.lam_re[pi], li = p.lam_im[pi];
    const float dt = expf(p.log_dt[(l * 2 + dir) * 32 + g]);
    const float mag = expf(lr * dt * 32.f);
    float sn, cs;
    sincosf(li * dt * 32.f, &sn, &cs);
    const float are = mag * cs, aim = mag * sn;
    float hre = 0.f, him = 0.f;
    if (!prompt) {
      size_t si = ((size_t)((b * 2 + l) * 2 + dir)) * 2048 + g * 64 + pp;
      hre = p.st_re[si]; him = p.st_im[si];
    }
    const float* eb = p.ebuf + ((size_t)g * NCHUNK + chunk0) * 256 + dir * 128 + pp;
    bfu* cb = p.carry + ((size_t)g * NCHUNK + chunk0) * 256 + dir * 128 + pp;
    for (int k0 = 0; k0 < n; k0 += 8) {
      float er[8], ei[8];
#pragma unroll
      for (int j = 0; j < 8; ++j) {
        const int k = dir == 0 ? k0 + j : n - 1 - (k0 + j);
        er[j] = eb[(size_t)k * 256];
        ei[j] = eb[(size_t)k * 256 + 64];
      }
#pragma unroll
      for (int j = 0; j < 8; ++j) {
        const int k = dir == 0 ? k0 + j : n - 1 - (k0 + j);
        cb[(size_t)k * 256] = f2bf(hre);
        cb[(size_t)k * 256 + 64] = f2bf(him);
        const float nre = are * hre - aim * him + er[j];
        const float nim = are * him + aim * hre + ei[j];
        hre = nre; him = nim;
      }
    }
    if (prompt) {
      size_t oi = ((size_t)((b * 2 + l) * 2 + dir)) * 2048 + g * 64 + pp;
      p.out[OUT_RE + oi] = hre;
      p.out[OUT_IM + oi] = him;
    }
  }
}

DI void phase_s5_y(const Params& p, int l, char* smem) {
  for (int q = VJ; q < 48; q += VNLOC) {
    const int g = VXCD * 4 + q / 12, r12 = q % 12, mt = r12 >> 2, nt = r12 & 3;
    f32x16 acc[2][2];
    acc_zero(acc);
    const bfu* Bm = p.opMG + ((size_t)g * 512 + nt * 128) * 768;
    gemm_core(p.ug + ((size_t)g * NCHUNK + mt * 128) * 512, 512, Bm, 768, 512, smem, acc,
              p.carry + ((size_t)g * NCHUNK + mt * 128) * 256, 256, 256);
    EPI_LDS({
      const int chunk = mt * 128 + row, nn = nt * 128 + c0, tp = nn >> 4, c = nn & 15;
      const int tok = chunk * 32 + tp;
      float u[8], o[8];
      unpack8(*(const uint4*)(p.ug + ((size_t)g * NTOK + tok) * 16 + c), u);
      const float* dsk = p.s5_d + l * 512 + g * 16 + c;
      _Pragma("unroll") for (int e = 0; e < 8; ++e) o[e] = geluf_(v[e] + dsk[e] * u[e]);
      *(uint4*)(p.ys5 + (size_t)tok * 512 + g * 16 + c) = pack8(o);
    })
  }
}

DI void phase_glu(const Params& p, int l, char* smem) {
  const bfu* W = p.w_gluT + (size_t)l * 512 * 512;
  for (int iter = 0;; ++iter) {
    int mt, nt;
    if (!xcd_tile<96, 4, 12>(iter, mt, nt)) break;
    f32x16 acc[2][2];
    acc_zero(acc);
    gemm_core(p.ys5 + (size_t)mt * 128 * 512, 512, W + (size_t)nt * 128 * 512, 512, 512, smem, acc, p.ys5, 512, 0);
    const int m0 = mt * 128, n0 = nt * 128;
    EPI_LDS({
      const int n = n0 + c0;
      const size_t tk = (size_t)(m0 + row);
      float y[8], ga[8], o[8];
      unpack8(*(const uint4*)(p.ys5 + tk * 512 + n), y);
      unpack8(*(const uint4*)(p.proj + tk * PW + OFF_GA + n), ga);
      const float* bg = p.b_glu + l * 512 + n;
      _Pragma("unroll") for (int e = 0; e < 8; ++e) o[e] = y[e] * sigmoidf_(v[e] + bg[e]) * siluf_(ga[e]);
      *(uint4*)(p.ya + tk * 512 + n) = pack8(o);
    })
  }
}

constexpr int GL_QS = 0;
constexpr int GL_KS = GL_QS + 32 * 144;
constexpr int GL_KHT = GL_KS + 32 * 144;
constexpr int GL_VT = GL_KHT + 64 * 80;
constexpr int GL_PS = GL_VT + 128 * 80;
constexpr int GL_ST = GL_PS + 32 * 80;
constexpr int GL_AV = GL_ST + 128 * 144;
constexpr int GL_TOT = GL_AV + 256;
constexpr int GL_OS = GL_TOT + 1024;
static_assert(GL_OS + 32 * 132 * 4 <= 65536, "gla lds");

DI void gla_segment_info(int seg, int& tok_base, bool& prompt, int& b, int& sidx) {
  if (seg < 16) { prompt = true; b = seg; sidx = 0; tok_base = seg * 256; }
  else { int q = seg - 16; prompt = false; b = q >> 3; sidx = q & 7; tok_base = NPROMPT + b * 2048 + sidx * 256; }
}

template <bool STATE_ONLY>
DI void gla_chain(const Params& p, int l, char* smem, int seg, int hd, int dir) {
  const int tid = tid_(), lane = tid & 63, w = tid >> 6;
  const int fr = lane & 31, hh = lane >> 5;
  int tok_base, b, sidx;
  bool prompt;
  gla_segment_info(seg, tok_base, prompt, b, sidx);
  const int dk = tid & 63, tq = tid >> 6;
  const int dvl = tid & 127, th = tid >> 7;
  const int jw = w & 1, thw = w >> 1, dkm = 32 * jw + fr;
  bf16x8 wgB;
  {
    unsigned wp[4];
#pragma unroll
    for (int e = 0; e < 4; ++e) {
      const float w0 = p.wg_up[((size_t)(l * 2 + dir) * 16 + 8 * hh + 2 * e) * 256 + hd * 64 + dkm];
      const float w1 = p.wg_up[((size_t)(l * 2 + dir) * 16 + 8 * hh + 2 * e + 1) * 256 + hd * 64 + dkm];
      wp[e] = pack2(w0, w1);
    }
    wgB = __builtin_bit_cast(bf16x8, make_uint4(wp[0], wp[1], wp[2], wp[3]));
  }
  const float bgv = p.bg[(l * 2 + dir) * 256 + hd * 64 + dkm];
  float* sAv = (float*)(smem + GL_AV);
  float* sTot = (float*)(smem + GL_TOT);
  float* sOs = (float*)(smem + GL_OS);

  f32x16 S[2];
  {
    const int dvc = 32 * w + fr;
    if (STATE_ONLY || prompt) {
#pragma unroll
      for (int mt = 0; mt < 2; ++mt)
#pragma unroll
        for (int r = 0; r < 16; ++r) S[mt][r] = 0.f;
    } else {
      const float* sp = p.st_gla + ((size_t)(((b * 2 + l) * 2 + dir) * 4 + hd)) * 8192;
#pragma unroll
      for (int mt = 0; mt < 2; ++mt)
#pragma unroll
        for (int r = 0; r < 16; ++r) S[mt][r] = sp[(32 * mt + (r & 3) + 8 * (r >> 2) + 4 * hh) * 128 + dvc];
      const int nprev = dir == 0 ? sidx : 7 - sidx;
      if (nprev > 0) {
        f32x16 cs[2], ns[2];
        float4 ca[8], na[8];
#define GLA_SEG_LOAD(SS, AA, qq)                                                                       \
        {                                                                                              \
          const int sprev_ = dir == 0 ? (qq) : 7 - (qq);                                               \
          const size_t ci_ = (size_t)(((b * 8 + sprev_) * 4 + hd) * 2 + dir);                          \
          const float* sl_ = p.gla_sloc + ci_ * 8192 + dvc;                                            \
          const float* al_ = p.gla_aseg + ci_ * 64 + 4 * hh;                                           \
          _Pragma("unroll") for (int mt = 0; mt < 2; ++mt)                                             \
          _Pragma("unroll") for (int r = 0; r < 16; ++r)                                               \
            SS[mt][r] = sl_[(32 * mt + (r & 3) + 8 * (r >> 2) + 4 * hh) * 128];                        \
          _Pragma("unroll") for (int i = 0; i < 8; ++i) AA[i] = *(const float4*)(al_ + 8 * i);         \
        }
        GLA_SEG_LOAD(cs, ca, 0)
#pragma unroll 1
        for (int q = 0; q < nprev; ++q) {
          if (q + 1 < nprev) GLA_SEG_LOAD(ns, na, q + 1)
#pragma unroll
          for (int mt = 0; mt < 2; ++mt)
#pragma unroll
            for (int qq = 0; qq < 4; ++qq) {
              const float4 av = ca[mt * 4 + qq];
              S[mt][4 * qq + 0] = av.x * S[mt][4 * qq + 0] + cs[mt][4 * qq + 0];
              S[mt][4 * qq + 1] = av.y * S[mt][4 * qq + 1] + cs[mt][4 * qq + 1];
              S[mt][4 * qq + 2] = av.z * S[mt][4 * qq + 2] + cs[mt][4 * qq + 2];
              S[mt][4 * qq + 3] = av.w * S[mt][4 * qq + 3] + cs[mt][4 * qq + 3];
            }
          cs[0] = ns[0]; cs[1] = ns[1];
#pragma unroll
          for (int i = 0; i < 8; ++i) ca[i] = na[i];
        }
      }
    }
  }
  float bsum = 0.f;
  __syncthreads();
  if (!STATE_ONLY) {
    const int dvc = 32 * w + fr;
#pragma unroll
    for (int mt = 0; mt < 2; ++mt)
#pragma unroll
      for (int q = 0; q < 4; ++q) {
        uint2 pk;
        pk.x = pack2(S[mt][4 * q], S[mt][4 * q + 1]);
        pk.y = pack2(S[mt][4 * q + 2], S[mt][4 * q + 3]);
        *(uint2*)(smem + GL_ST + dvc * 144 + (32 * mt + 8 * q + 4 * hh) * 2) = pk;
      }
  }

  uint4 rq = make_uint4(0, 0, 0, 0), rk = rq, rv0 = rq, rv1 = rq, rgl = rq;
#define GLA_ISSUE(nn)                                                                                         \
  {                                                                                                           \
    const int cn_ = dir == 0 ? (nn) : 7 - (nn);                                                               \
    const int c0_ = tok_base + cn_ * 32;                                                                      \
    const int tA = dir == 0 ? (tid >> 3) : 31 - (tid >> 3);                                                   \
    const bfu* prA = p.proj + (size_t)(c0_ + tA) * PW + hd * 64 + (tid & 7) * 8;                              \
    if (!STATE_ONLY) rq = *(const uint4*)(prA + OFF_Q);                                                       \
    rk = *(const uint4*)(prA + OFF_K);                                                                        \
    const int tV0 = dir == 0 ? (tid >> 4) : 31 - (tid >> 4);                                                  \
    const int tV1 = dir == 0 ? (tid >> 4) + 16 : 15 - (tid >> 4);                                             \
    rv0 = *(const uint4*)(p.proj + (size_t)(c0_ + tV0) * PW + OFF_V + hd * 128 + (tid & 15) * 8);             \
    rv1 = *(const uint4*)(p.proj + (size_t)(c0_ + tV1) * PW + OFF_V + hd * 128 + (tid & 15) * 8);             \
    if (tid < 64) {                                                                                           \
      const int tG = dir == 0 ? (tid >> 1) : 31 - (tid >> 1);                                                 \
      rgl = *(const uint4*)(p.proj + (size_t)(c0_ + tG) * PW + OFF_GL + (tid & 1) * 8);                       \
    }                                                                                                         \
  }
  GLA_ISSUE(0)
  char* rawQ = smem + GL_OS;
  char* rawK = smem + GL_OS + 4096;
  char* rawV = smem + GL_OS + 8192;
  char* rawG = smem + GL_PS;

#pragma unroll 1
  for (int n = 0; n < 8; ++n) {
    const int cn = dir == 0 ? n : 7 - n;
    const int ctok0 = tok_base + cn * 32;
    __syncthreads();
    if (!STATE_ONLY) *(uint4*)(rawQ + (tid >> 3) * 128 + (tid & 7) * 16) = rq;
    *(uint4*)(rawK + (tid >> 3) * 128 + (tid & 7) * 16) = rk;
    *(uint4*)(rawV + (tid >> 4) * 256 + (tid & 15) * 16) = rv0;
    *(uint4*)(rawV + ((tid >> 4) + 16) * 256 + (tid & 15) * 16) = rv1;
    if (tid < 64) *(uint4*)(rawG + (tid >> 1) * 32 + (tid & 1) * 16) = rgl;
    if (n + 1 < 8) GLA_ISSUE(n + 1)
    __syncthreads();
    {
      f32x16 lg;
#pragma unroll
      for (int r = 0; r < 16; ++r) lg[r] = 0.f;
      const bf16x8 ga = *(const bf16x8*)(rawG + fr * 32 + hh * 16);
      lg = __builtin_amdgcn_mfma_f32_32x32x16_bf16(ga, wgB, lg, 0, 0, 0);
      float ls[16], gsum[4], psum[4];
#pragma unroll
      for (int r = 0; r < 16; ++r) {
        const float x = lg[r] + bgv;
        ls[r] = logsigmoidf_(x) * (1.f / 16.f);
      }
#pragma unroll
      for (int q = 0; q < 4; ++q) {
        gsum[q] = ls[4 * q] + ls[4 * q + 1] + ls[4 * q + 2] + ls[4 * q + 3];
        psum[q] = __shfl_xor(gsum[q], 32);
      }
      float off[4], run = 0.f;
#pragma unroll
      for (int q = 0; q < 4; ++q) {
        off[q] = run + (hh ? psum[q] : 0.f);
        run += gsum[q] + psum[q];
      }
      const float total = run;
#pragma unroll
      for (int qq = 0; qq < 2; ++qq) {
        float khv[4];
        float acc_b = 0.f;
#pragma unroll
        for (int i = 0; i < 4; ++i) {
          const float lsv = thw == 0 ? ls[4 * qq + i] : ls[8 + 4 * qq + i];
          const float offv = thw == 0 ? off[qq] : off[2 + qq];
          acc_b += lsv;
          const float bb = offv + acc_b;
          const int tau = 16 * thw + 8 * qq + 4 * hh + i;
          const float kvv = bf2f(*(const bfu*)(rawK + tau * 128 + dkm * 2));
          if (!STATE_ONLY) {
            const float qvv = bf2f(*(const bfu*)(rawQ + tau * 128 + dkm * 2)) * 0.125f;
            *(bfu*)(smem + GL_QS + tau * 144 + dkm * 2) = f2bf(qvv * __expf(bb));
            *(bfu*)(smem + GL_KS + tau * 144 + dkm * 2) = f2bf(kvv * __expf(-bb));
          }
          khv[i] = kvv * __expf(total - bb);
        }
        uint2 kh; kh.x = pack2(khv[0], khv[1]); kh.y = pack2(khv[2], khv[3]);
        *(uint2*)(smem + GL_KHT + dkm * 80 + (16 * thw + 8 * qq + 4 * hh) * 2) = kh;
      }
      if (thw == 0 && hh == 0) { sAv[dkm] = __expf(total); bsum += total; }
    }
    {
      unsigned pk[8];
#pragma unroll
      for (int i = 0; i < 8; ++i) {
        const int tau0 = th * 16 + 2 * i;
        const unsigned lo = *(const bfu*)(rawV + tau0 * 256 + dvl * 2);
        const unsigned hi = *(const bfu*)(rawV + (tau0 + 1) * 256 + dvl * 2);
        pk[i] = lo | (hi << 16);
      }
      *(uint4*)(smem + GL_VT + dvl * 80 + th * 32) = make_uint4(pk[0], pk[1], pk[2], pk[3]);
      *(uint4*)(smem + GL_VT + dvl * 80 + th * 32 + 16) = make_uint4(pk[4], pk[5], pk[6], pk[7]);
    }
    __syncthreads();
    f32x16 o;
    if (!STATE_ONLY) {
      f32x16 sc;
#pragma unroll
      for (int r = 0; r < 16; ++r) sc[r] = 0.f;
#pragma unroll
      for (int s4 = 0; s4 < 4; ++s4) {
        bf16x8 a = *(const bf16x8*)(smem + GL_QS + fr * 144 + (16 * s4 + 8 * hh) * 2);
        bf16x8 bq = *(const bf16x8*)(smem + GL_KS + fr * 144 + (16 * s4 + 8 * hh) * 2);
        sc = __builtin_amdgcn_mfma_f32_32x32x16_bf16(a, bq, sc, 0, 0, 0);
      }
#pragma unroll
      for (int rr = 0; rr < 4; ++rr) {
        float val = w == 0 ? sc[rr] : (w == 1 ? sc[4 + rr] : (w == 2 ? sc[8 + rr] : sc[12 + rr]));
        const int i = rr + 8 * w + 4 * hh;
        val = (fr <= i) ? val : 0.f;
        *(bfu*)(smem + GL_PS + i * 80 + fr * 2) = f2bf(val);
      }
      __syncthreads();
#pragma unroll
      for (int r = 0; r < 16; ++r) o[r] = 0.f;
    }
    {
      const int dvc = 32 * w + fr;
      bf16x8 vb0 = *(const bf16x8*)(smem + GL_VT + dvc * 80 + (8 * hh) * 2);
      bf16x8 vb1 = *(const bf16x8*)(smem + GL_VT + dvc * 80 + (16 + 8 * hh) * 2);
      if (!STATE_ONLY) {
        bf16x8 pa0 = *(const bf16x8*)(smem + GL_PS + fr * 80 + (8 * hh) * 2);
        bf16x8 pa1 = *(const bf16x8*)(smem + GL_PS + fr * 80 + (16 + 8 * hh) * 2);
        o = __builtin_amdgcn_mfma_f32_32x32x16_bf16(pa0, vb0, o, 0, 0, 0);
        o = __builtin_amdgcn_mfma_f32_32x32x16_bf16(pa1, vb1, o, 0, 0, 0);
#pragma unroll
        for (int s4 = 0; s4 < 4; ++s4) {
          bf16x8 a = *(const bf16x8*)(smem + GL_QS + fr * 144 + (16 * s4 + 8 * hh) * 2);
          bf16x8 sb = *(const bf16x8*)(smem + GL_ST + dvc * 144 + (16 * s4 + 8 * hh) * 2);
          o = __builtin_amdgcn_mfma_f32_32x32x16_bf16(a, sb, o, 0, 0, 0);
        }
      }
#pragma unroll
      for (int mt = 0; mt < 2; ++mt) {
        f32x16 U;
#pragma unroll
        for (int r = 0; r < 16; ++r) U[r] = 0.f;
        bf16x8 ka0 = *(const bf16x8*)(smem + GL_KHT + (32 * mt + fr) * 80 + (8 * hh) * 2);
        bf16x8 ka1 = *(const bf16x8*)(smem + GL_KHT + (32 * mt + fr) * 80 + (16 + 8 * hh) * 2);
        U = __builtin_amdgcn_mfma_f32_32x32x16_bf16(ka0, vb0, U, 0, 0, 0);
        U = __builtin_amdgcn_mfma_f32_32x32x16_bf16(ka1, vb1, U, 0, 0, 0);
#pragma unroll
        for (int q = 0; q < 4; ++q) {
          const float4 av = *(const float4*)(sAv + 32 * mt + 8 * q + 4 * hh);
          S[mt][4 * q + 0] = av.x * S[mt][4 * q + 0] + U[4 * q + 0];
          S[mt][4 * q + 1] = av.y * S[mt][4 * q + 1] + U[4 * q + 1];
          S[mt][4 * q + 2] = av.z * S[mt][4 * q + 2] + U[4 * q + 2];
          S[mt][4 * q + 3] = av.w * S[mt][4 * q + 3] + U[4 * q + 3];
          if (!STATE_ONLY) {
            uint2 pk;
            pk.x = pack2(S[mt][4 * q], S[mt][4 * q + 1]);
            pk.y = pack2(S[mt][4 * q + 2], S[mt][4 * q + 3]);
            *(uint2*)(smem + GL_ST + dvc * 144 + (32 * mt + 8 * q + 4 * hh) * 2) = pk;
          }
        }
      }
      if (!STATE_ONLY) {
#pragma unroll
        for (int r = 0; r < 16; ++r) sOs[((r & 3) + 8 * (r >> 2) + 4 * hh) * 132 + dvc] = o[r];
      }
    }
    __syncthreads();
    if (!STATE_ONLY) {
      const int t = tid >> 3, part = tid & 7;
      const int tau = dir == 0 ? t : 31 - t;
      const size_t tok = (size_t)(ctok0 + t);
      float ov[16];
#pragma unroll
      for (int q = 0; q < 4; ++q) {
        const float4 x = *(const float4*)(sOs + tau * 132 + part * 16 + 4 * q);
        ov[4 * q] = x.x; ov[4 * q + 1] = x.y; ov[4 * q + 2] = x.z; ov[4 * q + 3] = x.w;
      }
      bfu* op = p.gla_o + ((size_t)dir * NTOK + tok) * 512 + hd * 128 + part * 16;
      *(uint4*)op = pack8(*(float(*)[8])&ov[0]);
      *(uint4*)(op + 8) = pack8(*(float(*)[8])&ov[8]);
    }
  }
  const int dvc = 32 * w + fr;
  if (STATE_ONLY) {
    const size_t ci = (size_t)(((b * 8 + sidx) * 4 + hd) * 2 + dir);
    float* sl = p.gla_sloc + ci * 8192;
#pragma unroll
    for (int mt = 0; mt < 2; ++mt)
#pragma unroll
      for (int r = 0; r < 16; ++r) sl[(32 * mt + (r & 3) + 8 * (r >> 2) + 4 * hh) * 128 + dvc] = S[mt][r];
    if (thw == 0 && hh == 0) p.gla_aseg[ci * 64 + dkm] = __expf(bsum);
  } else if (prompt) {
    float* op = p.out + OUT_GLA + ((size_t)(((b * 2 + l) * 2 + dir) * 4 + hd)) * 8192;
#pragma unroll
    for (int mt = 0; mt < 2; ++mt)
#pragma unroll
      for (int r = 0; r < 16; ++r) op[(32 * mt + (r & 3) + 8 * (r >> 2) + 4 * hh) * 128 + dvc] = S[mt][r];
  }
  __syncthreads();
}

DI void phase_gla_pass1(const Params& p, int l, char* smem) {
  for (int it = NVB - 1 - VBID; it < 256; it += NVB) {
    const int dir = it & 1, hd = (it >> 1) & 3, seg = 16 + (it >> 3);
    gla_chain<true>(p, l, smem, seg, hd, dir);
  }
}
DI void phase_gla_main(const Params& p, int l, char* smem) {
  for (int it = NVB - 1 - VBID; it < 384; it += NVB) {
    const int dir = it & 1, hd = (it >> 1) & 3, seg = it >> 3;
    gla_chain<false>(p, l, smem, seg, hd, dir);
  }
}
DI void phase_gla_norm(const Params& p, int l, int part) {
  const int tid = tid_(), lane = tid & 63, w = tid >> 6;
  const int ib = (VJ - 48) * 8 + VXCD;
  for (int it = part * (NTOK / 8) + (VJ >= 48 ? ib : NTOK); it < (part + 1) * (NTOK / 8); it += 128) {
    const int tok = it * 4 + w;
    float a[8], b[8], gt[8], res[8];
    unpack8(*(const uint4*)(p.gla_o + (size_t)tok * 512 + lane * 8), a);
    unpack8(*(const uint4*)(p.gla_o + ((size_t)NTOK + tok) * 512 + lane * 8), b);
    unpack8(*(const uint4*)(p.proj + (size_t)tok * PW + OFF_GB + lane * 8), gt);
    float ss = 0.f;
#pragma unroll
    for (int e = 0; e < 8; ++e) { a[e] += b[e]; ss += a[e] * a[e]; }
    ss += __shfl_xor(ss, 1); ss += __shfl_xor(ss, 2); ss += __shfl_xor(ss, 4); ss += __shfl_xor(ss, 8);
    const float rs = rsqrtf(ss * (1.f / 128.f) + EPS);
    const float* g = p.gla_norm_g + l * 512 + lane * 8;
#pragma unroll
    for (int e = 0; e < 8; ++e) res[e] = a[e] * rs * g[e] * siluf_(gt[e]);
    *(uint4*)(p.yb + (size_t)tok * 512 + lane * 8) = pack8(res);
  }
}

DI void phase_merge(const Params& p, int l, char* smem) {
  const bfu* WA = p.w_paT + (size_t)l * 1024 * 512;
  const bfu* WB = p.w_pbT + (size_t)l * 1024 * 512;
  for (int iter = 0;; ++iter) {
    int mt, nt;
    if (!tile256(iter, 4, mt, nt)) break;
    const int m0 = mt * 256, n0 = nt * 256;
    f32x4 acc[2][2][4][2];
    acc256_zero(acc);
    gemm256(p.ya, 512, WA, 512, 512, m0, n0, (bfu*)smem, acc);
    uint4 pg[8], pq[8];
#define MERGE_PRE1 pg[it_] = *(const uint4*)(p.proj + (size_t)(m0 + row) * PW + OFF_MA + n0 + c0);
#define MERGE_PRE2 pg[it_] = *(const uint4*)(p.proj + (size_t)(m0 + row) * PW + OFF_MB + n0 + c0); \
                   pq[it_] = *(const uint4*)(p.merged + (size_t)(m0 + row) * D + n0 + c0);
    EPI256P(MERGE_PRE1, {
      float ma[8], o[8];
      unpack8(pg[it_], ma);
      _Pragma("unroll") for (int e = 0; e < 8; ++e) o[e] = sigmoidf_(ma[e]) * v[e];
      *(uint4*)(p.merged + (size_t)(m0 + row) * D + n0 + c0) = pack8(o);
    })
    acc256_zero(acc);
    gemm256(p.yb, 512, WB, 512, 512, m0, n0, (bfu*)smem, acc);
    EPI256P(MERGE_PRE2, {
      float mb[8], o[8], pr[8];
      unpack8(pg[it_], mb);
      uint4* mp = (uint4*)(p.merged + (size_t)(m0 + row) * D + n0 + c0);
      unpack8(pq[it_], pr);
      _Pragma("unroll") for (int e = 0; e < 8; ++e) o[e] = pr[e] + sigmoidf_(mb[e]) * v[e];
      *mp = pack8(o);
    })
  }
}

DI void phase_out(const Params& p, int l, char* smem) {
  const bfu* W = p.w_oT + (size_t)l * 1024 * 1024;
  for (int iter = 0;; ++iter) {
    int mt, nt;
    if (!tile256(iter, 4, mt, nt)) break;
    const int m0 = mt * 256, n0 = nt * 256;
    f32x4 acc[2][2][4][2];
    acc256_zero(acc);
    gemm256(p.merged, D, W, 1024, 1024, m0, n0, (bfu*)smem, acc);
    const float* gate = p.mod + (size_t)(l * 5 + cond_of_tok(m0)) * 3072 + 2048;
    float4 px0[8], px1[8];
    const float* xsrc = l == 0 ? (m0 < NPROMPT ? p.x_prompt : p.x_sample - (size_t)NPROMPT * D) : p.out;
#define OUT_PRE px0[it_] = *(const float4*)(xsrc + (size_t)(m0 + row) * D + n0 + c0); \
                px1[it_] = *(const float4*)(xsrc + (size_t)(m0 + row) * D + n0 + c0 + 4);
    EPI256P(OUT_PRE, {
      float* xp = p.out + (size_t)(m0 + row) * D + n0 + c0;
      const float* gp = gate + n0 + c0;
      float4 x0 = px0[it_], x1 = px1[it_];
      if (l == 0 && m0 >= NPROMPT) {
        const int t = (m0 + row - NPROMPT) & 2047, col = n0 + c0;
        const float* pe = col < 512 ? p.pos_r + (t >> 6) * 512 + col : p.pos_c + (t & 63) * 512 + (col - 512);
        const float4 e0 = *(const float4*)pe, e1 = *(const float4*)(pe + 4);
        x0.x += e0.x; x0.y += e0.y; x0.z += e0.z; x0.w += e0.w;
        x1.x += e1.x; x1.y += e1.y; x1.z += e1.z; x1.w += e1.w;
      }
      float4 g0 = *(const float4*)gp, g1 = *(const float4*)(gp + 4);
      {
        const float4 h0 = *(const float4*)(gp + MODH), h1 = *(const float4*)(gp + MODH + 4);
        g0.x += h0.x; g0.y += h0.y; g0.z += h0.z; g0.w += h0.w;
        g1.x += h1.x; g1.y += h1.y; g1.z += h1.z; g1.w += h1.w;
      }
      x0.x += g0.x * v[0]; x0.y += g0.y * v[1]; x0.z += g0.z * v[2]; x0.w += g0.w * v[3];
      x1.x += g1.x * v[4]; x1.y += g1.y * v[5]; x1.z += g1.z * v[6]; x1.w += g1.w * v[7];
      *(float4*)xp = x0; *(float4*)(xp + 4) = x1;
    })
  }
}

DI void phase_final(const Params& p) {
  const int tid = tid_(), lane = tid & 63, w = tid >> 6;
  for (int it = VBID; it < NTOK / 4; it += NVB) {
    const int tok = it * 4 + w;
    float* xs = p.out + (size_t)tok * D;
    float4 v[4];
#pragma unroll
    for (int i = 0; i < 4; ++i) v[i] = ld_nt4(xs + lane * 4 + 256 * i);
    float ss = 0.f;
#pragma unroll
    for (int i = 0; i < 4; ++i) ss += v[i].x * v[i].x + v[i].y * v[i].y + v[i].z * v[i].z + v[i].w * v[i].w;
    ss = wave_sum(ss);
    const float rstd = rsqrtf(ss * (1.f / 1024.f) + EPS);
#pragma unroll
    for (int i = 0; i < 4; ++i) {
      float4 g = *(const float4*)(p.final_g + lane * 4 + 256 * i);
      float4 o;
      o.x = v[i].x * rstd * g.x; o.y = v[i].y * rstd * g.y; o.z = v[i].z * rstd * g.z; o.w = v[i].w * rstd * g.w;
      st_nt4(xs + lane * 4 + 256 * i, o);
    }
  }
}

#define XB_TMO      128
#define XB_XCNT(j)  (256  + 64 * (j))
#define XB_XSUB(j)  (1280 + 64 * (j))
#define XB_XGEN(j)  (2304 + 64 * (j))
#define XB_TOP      3328
#define XB_TOPGEN   3392
#define XCD_BAR_WORDS 3456
#define XB_SPIN_CAP (1u << 18)
#define LAS __attribute__((address_space(3)))
DI unsigned xb_ld(unsigned* p) { return __hip_atomic_load(p, __ATOMIC_RELAXED, __HIP_MEMORY_SCOPE_AGENT); }
DI unsigned xb_add(unsigned* p, unsigned v) { return __hip_atomic_fetch_add(p, v, __ATOMIC_RELAXED, __HIP_MEMORY_SCOPE_AGENT); }
DI unsigned xb_xcc_id() { return (unsigned)__builtin_amdgcn_s_getreg((3 << 11) | 20) & 0xFu; }
#define XB_SPIN(cond, bar) do { unsigned _sp = 0; while (cond) { __builtin_amdgcn_s_sleep(1); \
    if ((++_sp & 255u) == 0u) { if (xb_ld(&(bar)[XB_TMO])) break; if (_sp > XB_SPIN_CAP) { atomicAdd(&(bar)[XB_TMO], 1u); break; } } } } while (0)
struct XcdBarrier { unsigned* bar; unsigned x; volatile LAS unsigned* st; };
DI XcdBarrier xcd_barrier_post(unsigned* bar, volatile LAS unsigned* st) {
  XcdBarrier b; b.bar = bar; b.x = xb_xcc_id(); b.st = st;
  if (threadIdx.x == 0) (void)xb_add(&bar[XB_XCNT(b.x)], 1u);
  return b;
}
DI void xcd_barrier_complete(unsigned* bar, unsigned x, unsigned& nloc, unsigned& nx) {
  const unsigned G = gridDim.x * gridDim.y * gridDim.z;
  unsigned sum, cnt, mine, sp = 0u;
  for (;;) {
    sum = 0u; cnt = 0u; mine = 0u;
#pragma unroll
    for (unsigned j = 0; j < 16; ++j) { const unsigned c = xb_ld(&bar[XB_XCNT(j)]); sum += c; cnt += (c > 0u) ? 1u : 0u; mine = (j == x) ? c : mine; }
    if (sum == G) break;
    __builtin_amdgcn_s_sleep(1);
    if ((++sp & 255u) == 0u) { if (xb_ld(&bar[XB_TMO])) break; if (sp > XB_SPIN_CAP) { atomicAdd(&bar[XB_TMO], 1u); break; } }
  }
  nloc = mine > 0u ? mine : 1u; nx = cnt > 0u ? cnt : 1u;
}
DI void xcd_barrier(const XcdBarrier& b) {
  asm volatile("s_waitcnt vmcnt(0)" ::: "memory");
  __syncthreads();
  if (threadIdx.x == 0) {
    unsigned* bar = b.bar;
    __builtin_amdgcn_s_waitcnt(0);
    unsigned nloc = b.st[0], nx = b.st[1];
    if (nloc == 0u) { xcd_barrier_complete(bar, b.x, nloc, nx); b.st[0] = nloc; b.st[1] = nx; }
    const unsigned old = xb_add(&bar[XB_XSUB(b.x)], 1u);
    const unsigned gen = old / nloc;
    if (old + 1u == (gen + 1u) * nloc) {
      __builtin_amdgcn_fence(__ATOMIC_RELEASE, "agent");
      asm volatile("s_waitcnt vmcnt(0)" ::: "memory");
      const unsigned og = xb_add(&bar[XB_TOP], 1u);
      const unsigned tg = og / nx;
      if (og + 1u == (tg + 1u) * nx) xb_add(&bar[XB_TOPGEN], 1u);
      else XB_SPIN(xb_ld(&bar[XB_TOPGEN]) == tg, bar);
      __builtin_amdgcn_fence(__ATOMIC_ACQUIRE, "agent");
      xb_add(&bar[XB_XGEN(b.x)], 1u);
      asm volatile("s_waitcnt vmcnt(0)" ::: "memory");
    } else {
      XB_SPIN(xb_ld(&bar[XB_XGEN(b.x)]) == gen, bar);
      __builtin_amdgcn_fence(__ATOMIC_ACQUIRE, "agent");
      asm volatile("s_waitcnt vmcnt(0)" ::: "memory");
    }
  }
  __syncthreads();
}

#ifndef REP_SYNC
#define REP_SYNC 0
#endif
__global__ void __launch_bounds__(512, 2) k_mega(Params p) {
  extern __shared__ __attribute__((aligned(16))) char smem_all[];
  cg::grid_group grid = cg::this_grid();
  char* smem = smem_all;
#define smh (smem_all + VHALF * 65536)
  volatile LAS unsigned* xst = (volatile LAS unsigned*)(smem_all + 131072);
  if (threadIdx.x < 4) xst[threadIdx.x] = 0u;
  __syncthreads();
  XcdBarrier xb = xcd_barrier_post(p.bar, xst);
#define GSYNC() xcd_barrier(xb)
  phase_prep(p, smh);
  phase_s5_gen(p, 0, smh);
  GSYNC();
  if (p.bar == nullptr) grid.sync();
  for (int l = 0; l < 2; ++l) {
    phase_h(p, l);
    GSYNC();
    phase_gemm_in(p, l, smem);
    GSYNC();
    phase_s5_e(p, smh);
    phase_gla_pass1(p, l, smh);
    GSYNC();
    phase_s5_scan(p, l);
    phase_gla_main(p, l, smh);
    GSYNC();
    phase_s5_y(p, l, smh);
    phase_gla_norm(p, l, 0);
    GSYNC();
    phase_glu(p, l, smh);
    phase_gla_norm(p, l, 1);
    GSYNC();
    phase_merge(p, l, smem);
    if (l == 0 && (blockIdx.x >> 3) >= 24) {
      const int hb = (int)((((blockIdx.x >> 3) - 24) * 8 + (blockIdx.x & 7)) * 2) + VHALF;
      s5_gen_item(p, 1, hb, smh);
    }
    GSYNC();
    phase_out(p, l, smem);
    if (l == 0 && (blockIdx.x >> 3) >= 24) {
      const int hb = (int)((((blockIdx.x >> 3) - 24) * 8 + (blockIdx.x & 7)) * 2) + VHALF;
      s5_gen_item(p, 1, hb + 128, smh);
    }
    GSYNC();
    for (int rep = 0; rep < REP_SYNC; ++rep) GSYNC();
  }
  phase_final(p);
}

extern "C" void kernel_launch(void* const* d_in, const int* in_sizes, int n_in, void* d_out, int out_size,
                              void* d_ws, size_t ws_size, hipStream_t stream) {
  Params p{};
  const float* const* in = (const float* const*)d_in;
  p.x_prompt = in[0]; p.x_sample = in[1]; p.c = in[2]; p.st_re = in[3]; p.st_im = in[4]; p.st_gla = in[5];
  p.c_ctx = in[6]; p.norm_g = in[7]; p.w_mod = in[8]; p.b_mod = in[9]; p.w_in = in[10]; p.wg_up = in[11];
  p.bg = in[12]; p.gla_norm_g = in[13]; p.lam_re = in[14]; p.lam_im = in[15]; p.log_dt = in[16];
  p.b_re = in[17]; p.b_im = in[18]; p.c_re = in[19]; p.c_im = in[20]; p.s5_d = in[21]; p.w_glu = in[22];
  p.b_glu = in[23]; p.w_pa = in[24]; p.w_pb = in[25]; p.w_o = in[26]; p.final_g = in[27];
  p.out = (float*)d_out;
  char* ws = (char*)d_ws;
  size_t off = 0;
  auto take = [&](size_t bytes) { char* r = ws + off; off += (bytes + 255) & ~(size_t)255; return r; };
  p.w_inT = (bfu*)take((size_t)2 * DINP * LDH * 2);
  p.w_gluT = (bfu*)take((size_t)2 * 512 * 512 * 2);
  p.w_paT = (bfu*)take((size_t)2 * 1024 * 512 * 2);
  p.w_pbT = (bfu*)take((size_t)2 * 1024 * 512 * 2);
  p.w_oT = (bfu*)take((size_t)2 * 1024 * 1024 * 2);
  p.pos_r = (float*)take((size_t)32 * 512 * 4);
  p.pos_c = (float*)take((size_t)64 * 512 * 4);
  p.h = (bfu*)take((size_t)NTOK * LDH * 2);
  p.proj = (bfu*)take((size_t)NTOK * PW * 2);
  p.ys5 = (bfu*)take((size_t)NTOK * 512 * 2);
  p.ya = (bfu*)take((size_t)NTOK * 512 * 2);
  p.yb = (bfu*)take((size_t)NTOK * 512 * 2);
  p.merged = (bfu*)take((size_t)NTOK * D * 2);
  p.tmp_s5 = nullptr;
  p.ebuf = (float*)p.merged;
  p.carry = (bfu*)((char*)p.merged + (size_t)32 * NCHUNK * 256 * 4);
  p.ug = (bfu*)take((size_t)32 * NTOK * 16 * 2);
  p.opMG = (bfu*)take((size_t)32 * 512 * 768 * 2);
  p.opE = (bfu*)take((size_t)32 * 256 * 512 * 2);
  p.gla_sloc = (float*)p.ys5;
  p.gla_aseg = (float*)((char*)p.ys5 + (size_t)256 * 8192 * 4);
  if (off > ws_size) fprintf(stderr, "workspace too small: %zu > %zu\n", off, ws_size);
  p.bar = (unsigned*)take((size_t)XCD_BAR_WORDS * 4);
  p.mod = (float*)take((size_t)2 * 2 * 5 * 3072 * 4);
  p.gla_o = (bfu*)p.h;
  p.tmp_gla = (float*)p.h;
  constexpr size_t kLds = 131072 + 16;
  static int grid_blocks = 0;
  if (!grid_blocks) {
    int dev = 0, cus = 0, per_cu = 0;
    hipGetDevice(&dev);
    hipDeviceGetAttribute(&cus, hipDeviceAttributeMultiprocessorCount, dev);
    hipFuncSetAttribute((const void*)k_mega, hipFuncAttributeMaxDynamicSharedMemorySize, (int)kLds);
    hipOccupancyMaxActiveBlocksPerMultiprocessor(&per_cu, k_mega, 512, kLds);
    if (per_cu > 1) per_cu = 1;
    grid_blocks = cus * per_cu;
    if (grid_blocks % 8 != 0 || grid_blocks <= 0) fprintf(stderr, "unexpected grid %d\n", grid_blocks);
  }
  hipMemsetAsync(p.bar, 0, (size_t)XCD_BAR_WORDS * 4, stream);
  void* args[] = {&p};
  hipError_t e = hipLaunchCooperativeKernel((void*)k_mega, dim3(grid_blocks), dim3(512), args, kLds, stream);
  if (e != hipSuccess) fprintf(stderr, "cooperative launch failed: %s (grid %d)\n", hipGetErrorString(e), grid_blocks);
}
```

```cpp
#include <hip/hip_runtime.h>
#include <hip/hip_cooperative_groups.h>
#include <stdint.h>
#include <math.h>
#include <stdio.h>
namespace cg = cooperative_groups;

#ifndef REP_PREP
#define REP_PREP 0
#endif
#ifndef REP_GIN
#define REP_GIN 0
#endif
#ifndef REP_X1
#define REP_X1 0
#endif
#ifndef REP_X2
#define REP_X2 0
#endif
#ifndef REP_Y
#define REP_Y 0
#endif
#ifndef REP_MERGE
#define REP_MERGE 0
#endif
#ifndef REP_SYNC
#define REP_SYNC 0
#endif
#ifndef ONE_LAUNCH
#define ONE_LAUNCH 1
#endif

typedef unsigned short bfu;
typedef __attribute__((ext_vector_type(8))) short bf16x8;
typedef __attribute__((ext_vector_type(16))) float f32x16;
typedef __attribute__((ext_vector_type(2))) __bf16 bf2_t;
typedef __attribute__((ext_vector_type(2))) float f2_t;

#define DI __device__ __forceinline__

constexpr int D = 1024;
constexpr int NTOK = 12288;
constexpr int NPROMPT = 4096;
constexpr int DIN = 4624;
constexpr int DINP = 4864;
constexpr int LDH = 1088;
constexpr int PW = 4112;
constexpr int OFF_GA = 0, OFF_Q = 512, OFF_K = 768, OFF_V = 1024, OFF_GB = 1536, OFF_GL = 2048,
              OFF_MA = 2064, OFF_MB = 3088;
constexpr int NCHUNK = NTOK / 32;
constexpr size_t OUT_RE = (size_t)NTOK * D;
constexpr size_t OUT_IM = OUT_RE + 131072;
constexpr size_t OUT_GLA = OUT_IM + 131072;
constexpr float EPS = 1e-6f;
constexpr int MODH = 2 * 5 * 3072;

struct Params {
  const float *x_prompt, *x_sample, *c, *st_re, *st_im, *st_gla, *c_ctx, *norm_g, *w_mod, *b_mod, *w_in,
      *wg_up, *bg, *gla_norm_g, *lam_re, *lam_im, *log_dt, *b_re, *b_im, *c_re, *c_im, *s5_d, *w_glu,
      *b_glu, *w_pa, *w_pb, *w_o, *final_g;
  float* out;
  bfu *w_inT, *w_gluT, *w_paT, *w_pbT, *w_oT;
  float *mod, *pos_r, *pos_c, *tmp_s5, *tmp_gla;
  bfu *h, *proj, *ys5, *ya, *yb, *merged;
  bfu *ug, *opMG, *opE, *carry;
  float *ebuf, *gla_sloc, *gla_aseg;
  unsigned* bar;
  bfu* gla_o;
};

DI int tid_() { int t = threadIdx.x & 255; asm volatile("" : "+v"(t)); return t; }
#define VHALF ((int)__builtin_amdgcn_readfirstlane((int)(threadIdx.x >> 8)))
#define VBID ((int)(blockIdx.x * 2 + VHALF))
#define NVB ((int)(gridDim.x * 2))
#define VXCD ((int)(blockIdx.x & 7))
#define VJ ((int)((blockIdx.x >> 3) * 2 + VHALF))
#define VNLOC ((int)((gridDim.x >> 3) * 2))
DI float bf2f(bfu v) { return __uint_as_float(((unsigned)v) << 16); }
DI bfu f2bf(float x) { __bf16 b = (__bf16)x; return __builtin_bit_cast(unsigned short, b); }
DI unsigned pack2(float lo, float hi) {
  f2_t v = {lo, hi};
  bf2_t w = __builtin_convertvector(v, bf2_t);
  return __builtin_bit_cast(unsigned, w);
}
DI float exp2f_(float x) { return __builtin_amdgcn_exp2f(x); }
DI float sigmoidf_(float x) { return __builtin_amdgcn_rcpf(1.f + exp2f_(-1.44269504f * x)); }
DI float siluf_(float x) { return x * sigmoidf_(x); }
DI float geluf_(float x) {
  float u = 0.7978845608028654f * (x + 0.044715f * x * x * x);
  float t = 1.f - 2.f * __builtin_amdgcn_rcpf(exp2f_(2.88539008f * u) + 1.f);
  return 0.5f * x * (1.f + t);
}
DI float logsigmoidf_(float x) {
  return fminf(x, 0.f) - 0.69314718f * __builtin_amdgcn_logf(1.f + exp2f_(-1.44269504f * fabsf(x)));
}
DI float wave_sum(float v) {
#pragma unroll
  for (int o = 32; o >= 1; o >>= 1) v += __shfl_xor(v, o);
  return v;
}
DI void unpack8(const uint4 v, float (&f)[8]) {
  f[0] = __uint_as_float(v.x << 16); f[1] = __uint_as_float(v.x & 0xffff0000u);
  f[2] = __uint_as_float(v.y << 16); f[3] = __uint_as_float(v.y & 0xffff0000u);
  f[4] = __uint_as_float(v.z << 16); f[5] = __uint_as_float(v.z & 0xffff0000u);
  f[6] = __uint_as_float(v.w << 16); f[7] = __uint_as_float(v.w & 0xffff0000u);
}
DI uint4 pack8(const float (&f)[8]) {
  uint4 o;
  o.x = pack2(f[0], f[1]); o.y = pack2(f[2], f[3]); o.z = pack2(f[4], f[5]); o.w = pack2(f[6], f[7]);
  return o;
}
typedef float f32x4_nt __attribute__((ext_vector_type(4)));
DI float4 ld_nt4(const float* p) { f32x4_nt v = __builtin_nontemporal_load((const f32x4_nt*)p); return make_float4(v.x, v.y, v.z, v.w); }
DI void st_nt4(float* p, float4 a) { f32x4_nt v = {a.x, a.y, a.z, a.w}; __builtin_nontemporal_store(v, (f32x4_nt*)p); }
typedef unsigned u32x4_nt __attribute__((ext_vector_type(4)));
DI uint4 ld_nt16(const void* p) { u32x4_nt v = __builtin_nontemporal_load((const u32x4_nt*)p); return make_uint4(v.x, v.y, v.z, v.w); }
DI float ld_nt1(const float* p) { return __builtin_nontemporal_load(p); }
DI int cond_of_tok(int tok) { return tok < NPROMPT ? 0 : 1 + ((tok - NPROMPT) >> 11); }

DI void transpose_tile(const float* __restrict__ src, int K, int N, bfu* __restrict__ dst, int kt, int nt,
                       float* sm, int ldd = 0) {
  if (ldd == 0) ldd = K;
  const int tid = tid_(), c = tid & 63, r4 = tid >> 6;
  const int k0 = kt * 64, n0 = nt * 64;
  float v[16];
  const bool inb = (n0 + c) < N;
#pragma unroll
  for (int i = 0; i < 16; ++i) v[i] = inb ? ld_nt1(src + (size_t)(k0 + i * 4 + r4) * N + n0 + c) : 0.f;
#pragma unroll
  for (int i = 0; i < 16; ++i) sm[(i * 4 + r4) * 65 + c] = v[i];
  __syncthreads();
  {
    const int n = tid >> 2, kc = tid & 3;
    float o[16];
#pragma unroll
    for (int i = 0; i < 16; ++i) o[i] = sm[(kc * 16 + i) * 65 + n];
    bfu* dp = dst + (size_t)(n0 + n) * ldd + k0 + kc * 16;
    *(uint4*)dp = pack8(*(float(*)[8])&o[0]);
    *(uint4*)(dp + 8) = pack8(*(float(*)[8])&o[8]);
  }
  __syncthreads();
}

DI void phase_prep(const Params& p, char* smem) {
  float* sm = (float*)smem;
  const int tid = tid_();
  for (int it = VBID; it < 192; it += NVB) {
    const int kh = it & 1, jb = (it >> 1) % 48, l = it / 96;
    float* ssil = sm;
    float* sred = sm + 5 * 512;
    for (int idx = tid; idx < 2560; idx += 256) {
      int ci = idx >> 9, k = (idx & 511) + kh * 512;
      float cv = (ci == 0) ? p.c_ctx[k] : p.c[(ci - 1) * 1024 + k];
      ssil[idx] = cv / (1.f + expf(-cv));
    }
    __syncthreads();
    const int jj = tid & 63, kq = tid >> 6;
    const int j = jb * 64 + jj;
    float acc[5] = {0.f, 0.f, 0.f, 0.f, 0.f};
    const float* wp = p.w_mod + ((size_t)l * 1024 + kh * 512 + kq * 128) * 3072 + j;
#pragma unroll 16
    for (int k = 0; k < 128; ++k) {
      float w = ld_nt1(wp + (size_t)k * 3072);
#pragma unroll
      for (int ci = 0; ci < 5; ++ci) acc[ci] += ssil[ci * 512 + kq * 128 + k] * w;
    }
#pragma unroll
    for (int ci = 0; ci < 5; ++ci) sred[(kq * 5 + ci) * 64 + jj] = acc[ci];
    __syncthreads();
    for (int idx = tid; idx < 320; idx += 256) {
      int ci = idx >> 6, j2 = idx & 63;
      float sv = kh == 0 ? p.b_mod[l * 3072 + jb * 64 + j2] : 0.f;
#pragma unroll
      for (int q = 0; q < 4; ++q) sv += sred[(q * 5 + ci) * 64 + j2];
      p.mod[((size_t)(kh * 2 + l) * 5 + ci) * 3072 + jb * 64 + j2] = sv;
    }
    __syncthreads();
  }
  for (int idx = VBID * 256 + tid; idx < 96 * 512; idx += NVB * 256) {
    int r = idx >> 9, i = idx & 511;
    int pos = r < 32 ? r : r - 32;
    int q = i & 255;
    double f = exp(-log(10000.0) * (double)q / 256.0);
    double ang = (double)pos * f;
    float v = (float)((i < 256) ? sin(ang) : cos(ang));
    if (r < 32) p.pos_r[r * 512 + i] = v; else p.pos_c[(r - 32) * 512 + i] = v;
  }
  for (int it = VBID; it < 3584; it += NVB) {
    int l = it / 1792, r = it % 1792;
    if (r < 1216) {
      transpose_tile(p.w_in + (size_t)l * 1024 * DIN, 1024, DIN, p.w_inT + (size_t)l * DINP * LDH, r % 16, r / 16, sm, LDH);
    } else if (r < 1280) {
      r -= 1216;
      transpose_tile(p.w_glu + (size_t)l * 512 * 512, 512, 512, p.w_gluT + (size_t)l * 512 * 512, r % 8, r / 8, sm);
    } else if (r < 1408) {
      r -= 1280;
      transpose_tile(p.w_pa + (size_t)l * 512 * 1024, 512, 1024, p.w_paT + (size_t)l * 1024 * 512, r % 8, r / 8, sm);
    } else if (r < 1536) {
      r -= 1408;
      transpose_tile(p.w_pb + (size_t)l * 512 * 1024, 512, 1024, p.w_pbT + (size_t)l * 1024 * 512, r % 8, r / 8, sm);
    } else {
      r -= 1536;
      transpose_tile(p.w_o + (size_t)l * 1024 * 1024, 1024, 1024, p.w_oT + (size_t)l * 1024 * 1024, r % 16, r / 16, sm);
    }
  }
}

DI void phase_h(const Params& p, int l) {
  const int tid = tid_(), lane = tid & 63, w = tid >> 6;
  for (int it = VBID; it < NTOK / 4; it += NVB) {
    const int tok = it * 4 + w;
    float4 v[4];
    float* xs = p.out + (size_t)tok * D;
    if (l == 0) {
      const float* src = tok < NPROMPT ? p.x_prompt + (size_t)tok * D : p.x_sample + (size_t)(tok - NPROMPT) * D;
#pragma unroll
      for (int i = 0; i < 4; ++i) v[i] = ld_nt4(src + lane * 4 + 256 * i);
      if (tok >= NPROMPT) {
        int t = (tok - NPROMPT) & 2047, row = t >> 6, col = t & 63;
#pragma unroll
        for (int i = 0; i < 4; ++i) {
          int d = lane * 4 + 256 * i;
          const float* pe = d < 512 ? p.pos_r + row * 512 + d : p.pos_c + col * 512 + (d - 512);
          float4 e = *(const float4*)pe;
          v[i].x += e.x; v[i].y += e.y; v[i].z += e.z; v[i].w += e.w;
        }
      }
    } else {
#pragma unroll
      for (int i = 0; i < 4; ++i) v[i] = ld_nt4(xs + lane * 4 + 256 * i);
    }
    float ss = 0.f;
#pragma unroll
    for (int i = 0; i < 4; ++i) ss += v[i].x * v[i].x + v[i].y * v[i].y + v[i].z * v[i].z + v[i].w * v[i].w;
    ss = wave_sum(ss);
    const float rstd = rsqrtf(ss * (1.f / 1024.f) + EPS);
    const float* md = p.mod + (size_t)(l * 5 + cond_of_tok(tok)) * 3072;
    const float* ng = p.norm_g + l * 1024;
#pragma unroll
    for (int i = 0; i < 4; ++i) {
      int d = lane * 4 + 256 * i;
      float4 g = *(const float4*)(ng + d);
      float4 sh = *(const float4*)(md + d);
      float4 sc = *(const float4*)(md + 1024 + d);
      {
        const float4 sh1 = *(const float4*)(md + MODH + d);
        const float4 sc1 = *(const float4*)(md + MODH + 1024 + d);
        sh.x += sh1.x; sh.y += sh1.y; sh.z += sh1.z; sh.w += sh1.w;
        sc.x += sc1.x; sc.y += sc1.y; sc.z += sc1.z; sc.w += sc1.w;
      }
      float a0 = v[i].x * rstd * g.x * (1.f + sc.x) + sh.x;
      float a1 = v[i].y * rstd * g.y * (1.f + sc.y) + sh.y;
      float a2 = v[i].z * rstd * g.z * (1.f + sc.z) + sh.z;
      float a3 = v[i].w * rstd * g.w * (1.f + sc.w) + sh.w;
      uint2 o; o.x = pack2(a0, a1); o.y = pack2(a2, a3);
      *(uint2*)(p.h + (size_t)tok * LDH + d) = o;
    }
  }
}

DI void gemm_core(const bfu* A, int lda, const bfu* __restrict__ B, int ldb, int K, char* smem,
                  f32x16 (&acc)[2][2], const bfu* A2, int lda2, int K2) {
  const int tid = tid_(), lane = tid & 63, w = tid >> 6, wm = w >> 1, wn = w & 1;
  const int c8 = tid & 7, r0 = tid >> 3;
  const bfu* ga = A + (size_t)r0 * lda + c8 * 8;
  const bfu* gb = B + (size_t)r0 * ldb + c8 * 8;
  const int st_off = r0 * 128 + ((c8 ^ ((r0 >> 1) & 7)) * 16);
  const int fr = lane & 31, hh = lane >> 5, fsw = (fr >> 1) & 7;
  const int a_base = (wm * 64 + fr) * 128;
  const int b_base = 16384 + (wn * 64 + fr) * 128;
  uint4 ra0, ra1, ra2, ra3, rb0, rb1, rb2, rb3, qa0, qa1, qa2, qa3, qb0, qb1, qb2, qb3;
  const int KT1 = K >> 6, KT = (K + K2) >> 6;
  const bfu* ga2 = A2 + (size_t)r0 * lda2 + c8 * 8;
#define GEMM_LOADT(RA, RB, tile)                                                           \
  {                                                                                        \
    const int t_ = (tile) < KT ? (tile) : KT - 1;                                          \
    const bool s2_ = t_ >= KT1;                                                            \
    const bfu* ga_ = s2_ ? ga2 + (t_ - KT1) * 64 : ga + t_ * 64;                           \
    const size_t la_ = s2_ ? (size_t)lda2 : (size_t)lda;                                   \
    const bfu* gb_ = gb + t_ * 64;                                                         \
    RA##0 = *(const uint4*)(ga_);                 RB##0 = *(const uint4*)(gb_);                        \
    RA##1 = *(const uint4*)(ga_ + 32 * la_);      RB##1 = *(const uint4*)(gb_ + (size_t)32 * ldb);     \
    RA##2 = *(const uint4*)(ga_ + 64 * la_);      RB##2 = *(const uint4*)(gb_ + (size_t)64 * ldb);     \
    RA##3 = *(const uint4*)(ga_ + 96 * la_);      RB##3 = *(const uint4*)(gb_ + (size_t)96 * ldb);     \
  }
#define GEMM_STORET(buf, RA, RB)                                                           \
  {                                                                                        \
    *(uint4*)((buf) + st_off) = RA##0;          *(uint4*)((buf) + 16384 + st_off) = RB##0;          \
    *(uint4*)((buf) + st_off + 4096) = RA##1;   *(uint4*)((buf) + 16384 + st_off + 4096) = RB##1;   \
    *(uint4*)((buf) + st_off + 8192) = RA##2;   *(uint4*)((buf) + 16384 + st_off + 8192) = RB##2;   \
    *(uint4*)((buf) + st_off + 12288) = RA##3;  *(uint4*)((buf) + 16384 + st_off + 12288) = RB##3;  \
  }
#define GEMM_COMPUTE(cur)                                                                  \
  _Pragma("unroll") for (int s = 0; s < 4; ++s) {                                          \
    const int co = ((2 * s + hh) ^ fsw) * 16;                                              \
    bf16x8 a0 = *(const bf16x8*)((cur) + a_base + co);                                     \
    bf16x8 a1 = *(const bf16x8*)((cur) + a_base + 4096 + co);                              \
    bf16x8 b0 = *(const bf16x8*)((cur) + b_base + co);                                     \
    bf16x8 b1 = *(const bf16x8*)((cur) + b_base + 4096 + co);                              \
    acc[0][0] = __builtin_amdgcn_mfma_f32_32x32x16_bf16(a0, b0, acc[0][0], 0, 0, 0);       \
    acc[0][1] = __builtin_amdgcn_mfma_f32_32x32x16_bf16(a0, b1, acc[0][1], 0, 0, 0);       \
    acc[1][0] = __builtin_amdgcn_mfma_f32_32x32x16_bf16(a1, b0, acc[1][0], 0, 0, 0);       \
    acc[1][1] = __builtin_amdgcn_mfma_f32_32x32x16_bf16(a1, b1, acc[1][1], 0, 0, 0);       \
  }
  GEMM_LOADT(ra, rb, 0)
  GEMM_LOADT(qa, qb, 1)
  GEMM_STORET(smem, ra, rb)
  __syncthreads();
#pragma unroll 1
  for (int kt = 0; kt < KT; kt += 2) {
    GEMM_LOADT(ra, rb, kt + 2)
    __builtin_amdgcn_sched_barrier(0);
    GEMM_COMPUTE(smem)
    __builtin_amdgcn_sched_barrier(0);
    GEMM_STORET(smem + 32768, qa, qb)
    __syncthreads();
    GEMM_LOADT(qa, qb, kt + 3)
    __builtin_amdgcn_sched_barrier(0);
    GEMM_COMPUTE(smem + 32768)
    __builtin_amdgcn_sched_barrier(0);
    GEMM_STORET(smem, ra, rb)
    __syncthreads();
  }
}

DI void acc_zero(f32x16 (&acc)[2][2]) {
#pragma unroll
  for (int i = 0; i < 2; ++i)
#pragma unroll
    for (int j = 0; j < 2; ++j)
#pragma unroll
      for (int r = 0; r < 16; ++r) acc[i][j][r] = 0.f;
}

DI void acc_to_lds(const f32x16 (&acc)[2][2], char* smem) {
  float* sf = (float*)smem;
  const int tid = tid_(), lane = tid & 63, w = tid >> 6;
  const int rb = (w >> 1) * 64 + 4 * (lane >> 5), cb = (w & 1) * 64 + (lane & 31);
#pragma unroll
  for (int i = 0; i < 2; ++i)
#pragma unroll
    for (int j = 0; j < 2; ++j)
#pragma unroll
      for (int r = 0; r < 16; ++r)
        sf[(rb + i * 32 + (r & 3) + 8 * (r >> 2)) * 128 + cb + j * 32] = acc[i][j][r];
}
#define EPI_LDS(...)                                                             \
  {                                                                              \
    acc_to_lds(acc, smem);                                                       \
    __syncthreads();                                                             \
    _Pragma("unroll 1") for (int it_ = 0; it_ < 8; ++it_) {                      \
      const int row = (tid_() >> 4) + 16 * it_;                             \
      const int c0 = (tid_() & 15) * 8;                                     \
      float v[8];                                                                \
      {                                                                          \
        const float4 t0 = *(const float4*)(smem + (row * 128 + c0) * 4);         \
        const float4 t1 = *(const float4*)(smem + (row * 128 + c0 + 4) * 4);     \
        v[0] = t0.x; v[1] = t0.y; v[2] = t0.z; v[3] = t0.w;                      \
        v[4] = t1.x; v[5] = t1.y; v[6] = t1.z; v[7] = t1.w;                      \
      }                                                                          \
      __VA_ARGS__                                                                \
    }                                                                            \
    __syncthreads();                                                             \
  }

typedef __attribute__((ext_vector_type(4))) float f32x4;
constexpr int G_BK = 64, G_HALF = 128, G_HT = G_HALF * G_BK;
DI int g_lds_byte(int r, int c) {
  int st = (r >> 4) * 2 + (c >> 5), rr = r & 15, cc = c & 31, ob = rr * 64 + cc * 2;
  return st * 1024 + (ob ^ (((ob >> 9) & 1) << 5));
}
DI void g_stage_rc(int b, int& R, int& C) {
  int st = b / 1024, sb = b % 1024, swz = sb ^ (((sb >> 9) & 1) << 5);
  R = (st >> 1) * 16 + swz / 64; C = (st & 1) * 32 + (swz % 64) / 2;
}
DI const char* g_uniform(const char* ptr) {
  unsigned long long u = (unsigned long long)ptr;
  unsigned lo = __builtin_amdgcn_readfirstlane((unsigned)u), hi = __builtin_amdgcn_readfirstlane((unsigned)(u >> 32));
  return (const char*)(((unsigned long long)hi << 32) | lo);
}
DI void gemm256(const bfu* __restrict__ A, int lda, const bfu* __restrict__ Bt, int ldb, int K, int brow, int bcol,
                bfu* shm, f32x4 (&acc)[2][2][4][2]) {
#define G_SA(b, h) (shm + ((b) * 2 + (h)) * G_HT)
#define G_SB(b, h) (shm + (4 + (b) * 2 + (h)) * G_HT)
#define G_STAGE(P, BASE, LD, br, kt)                                                                   \
  do {                                                                                                 \
    const char* _u = g_uniform((const char*)((BASE) + ((long)(br) * (LD) + (long)(kt) * G_BK)));       \
    __builtin_amdgcn_global_load_lds((const unsigned*)(_u + soff_b),                                   \
        (__attribute__((address_space(3))) unsigned*)((char*)(P) + ldst), 16, 0, 0);                   \
    __builtin_amdgcn_global_load_lds((const unsigned*)(_u + 128 * (long)(LD) + soff_b),                \
        (__attribute__((address_space(3))) unsigned*)((char*)(P) + ldst + 8192), 16, 0, 0);            \
  } while (0)
#define G_LDA(dst, b, h) for (int m = 0; m < 4; ++m) for (int k = 0; k < 2; ++k) \
    dst[m][k] = *reinterpret_cast<const bf16x8*>((char*)G_SA(b, h) + a_rd + m * 2048 + k * 1024)
#define G_LDB(dst, b, h) for (int n = 0; n < 2; ++n) for (int k = 0; k < 2; ++k) \
    dst[n][k] = *reinterpret_cast<const bf16x8*>((char*)G_SB(b, h) + b_rd + n * 2048 + k * 1024)
#define G_MMA(ai, bj, At, Bt_)                                                                         \
  do {                                                                                                 \
    __builtin_amdgcn_s_setprio(1);                                                                     \
    for (int m = 0; m < 4; ++m) for (int n = 0; n < 2; ++n) for (int k = 0; k < 2; ++k)                \
      acc[ai][bj][m][n] = __builtin_amdgcn_mfma_f32_16x16x32_bf16(At[m][k], Bt_[n][k], acc[ai][bj][m][n], 0, 0, 0); \
    __builtin_amdgcn_s_setprio(0);                                                                     \
  } while (0)
#define G_WAIT_V(n) asm volatile("s_waitcnt vmcnt(" #n ")" ::: "memory")
#define G_WAIT_L(n) asm volatile("s_waitcnt lgkmcnt(" #n ")" ::: "memory")
#define G_BAR __builtin_amdgcn_s_barrier()
#define G_SCHED __builtin_amdgcn_sched_barrier(0)
  int t512 = threadIdx.x; asm volatile("" : "+v"(t512));
  const int wid = __builtin_amdgcn_readfirstlane(t512 >> 6), lane = t512 & 63, wr = wid >> 2, wc = wid & 3, fr = lane & 15, fq = lane >> 4;
  const int ldst = t512 * 16;
  unsigned soff_b;
  {
    int R0, C0;
    g_stage_rc(ldst, R0, C0);
    soff_b = (unsigned)(R0 * lda + C0) * 2u;
  }
  const int lane_off = (fr * 64 + fq * 16) ^ ((fr >> 3) << 5);
  const int a_rd = wr * 8192 + lane_off, b_rd = wc * 4096 + lane_off;
  bf16x8 At[4][2], B0[2][2], B1[2][2];
  const int nt = K / G_BK;
  G_STAGE(G_SB(0, 0), Bt, ldb, bcol, 0); G_STAGE(G_SA(0, 0), A, lda, brow, 0);
  G_STAGE(G_SB(0, 1), Bt, ldb, bcol + G_HALF, 0); G_STAGE(G_SA(0, 1), A, lda, brow + G_HALF, 0);
  if (wr == 1) G_BAR;
  G_WAIT_V(4); G_BAR;
  G_STAGE(G_SB(1, 0), Bt, ldb, bcol, 1); G_STAGE(G_SA(1, 0), A, lda, brow, 1); G_STAGE(G_SB(1, 1), Bt, ldb, bcol + G_HALF, 1);
  G_WAIT_V(6); G_BAR;
#pragma unroll 1
  for (int t = 0; t < nt - 2; t += 2) {
    G_LDB(B0, 0, 0); G_SCHED; G_LDA(At, 0, 0); G_STAGE(G_SA(1, 1), A, lda, brow + G_HALF, t + 1);
    G_WAIT_L(8); G_BAR; G_WAIT_L(0); G_MMA(0, 0, At, B0); G_BAR; G_SCHED;
    G_LDB(B1, 0, 1); G_STAGE(G_SB(0, 0), Bt, ldb, bcol, t + 2);
    G_BAR; G_WAIT_L(0); G_MMA(0, 1, At, B1); G_BAR;
    G_LDA(At, 0, 1); G_STAGE(G_SA(0, 0), A, lda, brow, t + 2);
    G_BAR; G_WAIT_L(0); G_MMA(1, 0, At, B0); G_BAR; G_SCHED;
    G_STAGE(G_SB(0, 1), Bt, ldb, bcol + G_HALF, t + 2);
    G_WAIT_V(6); G_BAR; G_MMA(1, 1, At, B1); G_BAR;
    G_LDB(B0, 1, 0); G_SCHED; G_LDA(At, 1, 0); G_STAGE(G_SA(0, 1), A, lda, brow + G_HALF, t + 2);
    G_WAIT_L(8); G_BAR; G_WAIT_L(0); G_MMA(0, 0, At, B0); G_BAR; G_SCHED;
    G_LDB(B1, 1, 1); G_STAGE(G_SB(1, 0), Bt, ldb, bcol, t + 3);
    G_BAR; G_WAIT_L(0); G_MMA(0, 1, At, B1); G_BAR;
    G_LDA(At, 1, 1); G_STAGE(G_SA(1, 0), A, lda, brow, t + 3);
    G_BAR; G_WAIT_L(0); G_MMA(1, 0, At, B0); G_BAR; G_SCHED;
    G_STAGE(G_SB(1, 1), Bt, ldb, bcol + G_HALF, t + 3);
    G_WAIT_V(6); G_BAR; G_MMA(1, 1, At, B1); G_BAR;
  }
  { G_LDB(B0, 0, 0); G_LDA(At, 0, 0); G_STAGE(G_SA(1, 1), A, lda, brow + G_HALF, nt - 1);
    G_BAR; G_WAIT_L(0); G_MMA(0, 0, At, B0); G_BAR;
    G_LDB(B1, 0, 1); G_BAR; G_WAIT_L(0); G_MMA(0, 1, At, B1); G_BAR;
    G_LDA(At, 0, 1); G_WAIT_V(4); G_BAR; G_WAIT_L(0); G_MMA(1, 0, At, B0); G_MMA(1, 1, At, B1); G_BAR; }
  { G_LDB(B0, 1, 0); G_LDA(At, 1, 0); G_WAIT_V(2); G_BAR; G_WAIT_L(0); G_MMA(0, 0, At, B0); G_BAR;
    G_LDB(B1, 1, 1); G_WAIT_V(0); G_BAR; G_WAIT_L(0); G_MMA(0, 1, At, B1); G_BAR;
    G_LDA(At, 1, 1); G_BAR; G_WAIT_L(0); G_MMA(1, 0, At, B0); G_MMA(1, 1, At, B1); G_BAR; }
  if (wr == 0) G_BAR;
}
DI void acc256_zero(f32x4 (&acc)[2][2][4][2]) {
#pragma unroll
  for (int a = 0; a < 2; ++a)
#pragma unroll
    for (int b = 0; b < 2; ++b)
#pragma unroll
      for (int m = 0; m < 4; ++m)
#pragma unroll
        for (int n = 0; n < 2; ++n) acc[a][b][m][n] = (f32x4){0.f, 0.f, 0.f, 0.f};
}
#define EPI_NOPRE
#define EPI256P(PRE, ...)                                                                              \
  {                                                                                                    \
    int t512_ = threadIdx.x; asm volatile("" : "+v"(t512_));     \
    const int wid_ = t512_ >> 6, lane_ = t512_ & 63, wr_ = wid_ >> 2, wc_ = wid_ & 3,                  \
              fr_ = lane_ & 15, fq_ = lane_ >> 4;                                                      \
    float* sf_ = (float*)smem;                                                                         \
    _Pragma("unroll") for (int ai_ = 0; ai_ < 2; ++ai_) {                                              \
      _Pragma("unroll") for (int it_ = 0; it_ < 8; ++it_) {     \
        const int idx_ = t512_ + 512 * it_;                                                            \
        const int rl_ = idx_ >> 5, c0 = (idx_ & 31) * 8;                                               \
        const int row = ai_ * 128 + rl_;                                                               \
        (void)rl_; (void)c0; (void)row;                                                                \
        PRE                                                                                            \
      }                                                                                                \
      __builtin_amdgcn_sched_barrier(0);              \
      __syncthreads();                                                                                 \
      _Pragma("unroll") for (int bj_ = 0; bj_ < 2; ++bj_)                                              \
      _Pragma("unroll") for (int m_ = 0; m_ < 4; ++m_)                                                 \
      _Pragma("unroll") for (int n_ = 0; n_ < 2; ++n_)                                                 \
      _Pragma("unroll") for (int j_ = 0; j_ < 4; ++j_)                                                 \
        sf_[(wr_ * 64 + m_ * 16 + fq_ * 4 + j_) * 256 + ((bj_ * 128 + wc_ * 32 + n_ * 16 + fr_) ^ (fq_ << 4))] = \
            acc[ai_][bj_][m_][n_][j_];                                                                 \
      __syncthreads();                                                                                 \
      _Pragma("unroll") for (int it_ = 0; it_ < 8; ++it_) {                                            \
        const int idx_ = t512_ + 512 * it_;                                                            \
        const int rl_ = idx_ >> 5, c0 = (idx_ & 31) * 8;                                               \
        const int row = ai_ * 128 + rl_;                                                               \
        float v[8];                                                                                    \
        {                                                                                              \
          const float* sp_ = sf_ + rl_ * 256 + (c0 ^ (((rl_ >> 2) & 3) << 4));                          \
          const float4 t0 = *(const float4*)sp_; const float4 t1 = *(const float4*)(sp_ + 4);          \
          v[0] = t0.x; v[1] = t0.y; v[2] = t0.z; v[3] = t0.w;                                          \
          v[4] = t1.x; v[5] = t1.y; v[6] = t1.z; v[7] = t1.w;                                          \
        }                                                                                              \
        __VA_ARGS__                                                                                    \
      }                                                                                                \
    }                                                                                                  \
    __syncthreads();                                                                                   \
  }
#define EPI256(...) EPI256P(EPI_NOPRE, __VA_ARGS__)

template <int MT, int NT, int BH>
DI bool xcd_tile(int iter, int& mt, int& nt) {
  constexpr int MPX = MT / 8, TPX = MPX * NT;
  const int xcd = VXCD, j = VJ, nloc = VNLOC;
  const int q = j + iter * nloc;
  if (q >= TPX) return false;
  const int band = q / (BH * NT), r = q % (BH * NT);
  nt = r / BH;
  mt = xcd * MPX + band * BH + (r % BH);
  return true;
}

DI bool tile256(int iter, int NT, int& mt, int& nt) {
  const int xcd = blockIdx.x & 7, j = blockIdx.x >> 3, nloc = gridDim.x >> 3;
  const int q = j + iter * nloc;
  if (q >= 6 * NT) return false;
  nt = q / 6; mt = xcd * 6 + q % 6;
  return true;
}
DI void phase_gemm_in(const Params& p, int l, char* smem) {
  const bfu* W = p.w_inT + (size_t)l * DINP * LDH;
  for (int iter = 0;; ++iter) {
    int mt, nt;
    if (!tile256(iter, 19, mt, nt)) break;
    f32x4 acc[2][2][4][2];
    acc256_zero(acc);
    gemm256(p.h, LDH, W, LDH, 1024, mt * 256, nt * 256, (bfu*)smem, acc);
    const int m0 = mt * 256, n0 = nt * 256;
    EPI256({
      const int n = n0 + c0;
      if (n < 512) *(uint4*)(p.ug + ((size_t)(n >> 4) * NTOK + (m0 + row)) * 16 + (n & 15)) = pack8(v);
      else if (n < DIN) *(uint4*)(p.proj + (size_t)(m0 + row) * PW + (n - 512)) = pack8(v);
    })
  }
}

DI void s5_gen_item(const Params& p, int l, int item, char* smem) {
  const int tid = tid_();
  const int g = item >> 3, r = item & 7;
  float* sBr = (float*)smem;
  float* sBi = sBr + 2048;
  float* sCr = sBi + 2048;
  float* sCi = sCr + 1024;
  float* sAK = sCi + 1024;
  float* sAE = sAK + 1024;
  float* sAG = sAE + 1024;
  float* sK = sAG + 1024;
  bfu* E = p.opE + (size_t)g * 256 * 512;
  bfu* MG = p.opMG + (size_t)g * 512 * 768;
  __syncthreads();
  if (tid < 128) {
    const int d = tid >> 6, pp = tid & 63;
    const size_t pi = ((size_t)(l * 2 + d) * 32 + g) * 64 + pp;
    const float lr = p.lam_re[pi], li = p.lam_im[pi];
    const float dt = expf(p.log_dt[(l * 2 + d) * 32 + g]);
    const float mag = expf(lr * dt);
    float sn, cs;
    sincosf(li * dt, &sn, &cs);
    const float are = mag * cs, aim = mag * sn;
    const float nr = are - 1.f, ni = aim, den = lr * lr + li * li;
    const float kr = (nr * lr + ni * li) / den, ki = (ni * lr - nr * li) / den;
#pragma unroll
    for (int c = 0; c < 16; ++c) {
      float br = p.b_re[((size_t)(l * 32 + g) * 64 + pp) * 16 + c];
      float bi = p.b_im[((size_t)(l * 32 + g) * 64 + pp) * 16 + c];
      sBr[(d * 64 + pp) * 16 + c] = kr * br - ki * bi;
      sBi[(d * 64 + pp) * 16 + c] = kr * bi + ki * br;
    }
#pragma unroll
    for (int q = 0; q < 4; ++q) {
      const int t = 4 * r + q;
      const int nK = t;
      const int nE = d == 0 ? 31 - t : t;
      const int nG = d == 0 ? t + 1 : 32 - t;
      const float er = lr * dt * 1.44269504f, rv = li * dt * 0.15915494f;
      float m, s_, c_, fr_;
      m = exp2f_(er * (float)nK); fr_ = rv * (float)nK; fr_ -= floorf(fr_);
      s_ = __builtin_amdgcn_sinf(fr_); c_ = __builtin_amdgcn_cosf(fr_);
      sAK[((d * 4 + q) * 64 + pp) * 2] = m * c_; sAK[((d * 4 + q) * 64 + pp) * 2 + 1] = m * s_;
      m = exp2f_(er * (float)nE); fr_ = rv * (float)nE; fr_ -= floorf(fr_);
      s_ = __builtin_amdgcn_sinf(fr_); c_ = __builtin_amdgcn_cosf(fr_);
      sAE[((d * 4 + q) * 64 + pp) * 2] = m * c_; sAE[((d * 4 + q) * 64 + pp) * 2 + 1] = m * s_;
      m = exp2f_(er * (float)nG); fr_ = rv * (float)nG; fr_ -= floorf(fr_);
      s_ = __builtin_amdgcn_sinf(fr_); c_ = __builtin_amdgcn_cosf(fr_);
      sAG[((d * 4 + q) * 64 + pp) * 2] = m * c_; sAG[((d * 4 + q) * 64 + pp) * 2 + 1] = m * s_;
    }
  } else {
    for (int idx = tid - 128; idx < 1024; idx += 128) {
      sCr[idx] = p.c_re[(size_t)(l * 32 + g) * 1024 + idx];
      sCi[idx] = p.c_im[(size_t)(l * 32 + g) * 1024 + idx];
    }
  }
  __syncthreads();
#pragma unroll 1
  for (int i = 0; i < 4; ++i) {
    const int idx = tid + 256 * i;
    const int row = idx >> 2, q = idx & 3;
    const int part = row >> 6, pp = row & 63, d = part >> 1;
    const float ar = sAE[((d * 4 + q) * 64 + pp) * 2], ai = sAE[((d * 4 + q) * 64 + pp) * 2 + 1];
    const float* br = sBr + (d * 64 + pp) * 16;
    const float* bi = sBi + (d * 64 + pp) * 16;
    float v[16];
#pragma unroll
    for (int c = 0; c < 16; ++c) v[c] = (part & 1) ? (ar * bi[c] + ai * br[c]) : (ar * br[c] - ai * bi[c]);
    bfu* dp = E + (size_t)row * 512 + (4 * r + q) * 16;
    *(uint4*)dp = pack8(*(float(*)[8])&v[0]);
    *(uint4*)(dp + 8) = pack8(*(float(*)[8])&v[8]);
  }
#pragma unroll 1
  for (int i = 0; i < 8; ++i) {
    const int idx = tid + 256 * i;
    const int rr = idx >> 5, cg = idx & 31, q = rr >> 4, c = rr & 15;
    const int part = cg >> 3, pp0 = (cg & 7) * 8, d = part >> 1;
    const float* ag = sAG + ((d * 4 + q) * 64 + pp0) * 2;
    const float* cr = sCr + c * 64 + pp0;
    const float* ci = sCi + c * 64 + pp0;
    float v[8];
#pragma unroll
    for (int e = 0; e < 8; ++e) {
      const float ar = ag[2 * e], ai = ag[2 * e + 1];
      v[e] = (part & 1) ? -(cr[e] * ai + ci[e] * ar) : (cr[e] * ar - ci[e] * ai);
    }
    *(uint4*)(MG + (size_t)((4 * r + q) * 16 + c) * 768 + 512 + cg * 8) = pack8(v);
  }
  {
    const int d = tid >> 7, q = (tid >> 5) & 3, c = (tid >> 1) & 15, ch = tid & 1;
    float acc[8];
#pragma unroll
    for (int e = 0; e < 8; ++e) acc[e] = 0.f;
    for (int pp = 0; pp < 64; ++pp) {
      const float ar = sAK[((d * 4 + q) * 64 + pp) * 2], ai = sAK[((d * 4 + q) * 64 + pp) * 2 + 1];
      const float cr = sCr[c * 64 + pp], ci = sCi[c * 64 + pp];
      const float wr = cr * ar - ci * ai, wi = cr * ai + ci * ar;
#pragma unroll
      for (int e = 0; e < 8; ++e)
        acc[e] += wr * sBr[(d * 64 + pp) * 16 + ch * 8 + e] - wi * sBi[(d * 64 + pp) * 16 + ch * 8 + e];
    }
#pragma unroll
    for (int e = 0; e < 8; ++e) sK[((d * 4 + q) * 16 + c) * 16 + ch * 8 + e] = acc[e];
  }
  __syncthreads();
  for (int idx = tid; idx < 8192; idx += 256) {
    const int ch = idx & 1, c = (idx >> 1) & 15, tp = (idx >> 5) & 31, q = (idx >> 10) & 3, d = idx >> 12;
    const int tau = 4 * r + q;
    int sp;
    bool valid;
    if (d == 0) { sp = tp - tau; valid = sp >= 0; } else { sp = tp + tau; valid = (sp <= 31) && (tau > 0); }
    if (valid) {
      float v[8];
#pragma unroll
      for (int e = 0; e < 8; ++e) {
        float x = sK[((d * 4 + q) * 16 + c) * 16 + ch * 8 + e];
        if (tau == 0) x += sK[((1 * 4 + q) * 16 + c) * 16 + ch * 8 + e];
        v[e] = x;
      }
      *(uint4*)(MG + (size_t)(tp * 16 + c) * 768 + sp * 16 + ch * 8) = pack8(v);
    }
  }
  __syncthreads();
}

DI void phase_s5_gen(const Params& p, int l, char* smem) {
  for (int it = NVB - 1 - VBID; it < 256; it += NVB) s5_gen_item(p, l, it, smem);
}

DI void phase_s5_e(const Params& p, char* smem) {
  for (int q = VJ; q < 24; q += VNLOC) {
    const int g = VXCD * 4 + q / 6, r6 = q % 6, mt = r6 >> 1, nt = r6 & 1;
    f32x16 acc[2][2];
    acc_zero(acc);
    gemm_core(p.ug + ((size_t)g * NCHUNK + mt * 128) * 512, 512, p.opE + ((size_t)g * 256 + nt * 128) * 512, 512, 512,
              smem, acc, p.ug, 512, 0);
    EPI_LDS({
      float* dst = p.ebuf + ((size_t)g * NCHUNK + mt * 128 + row) * 256 + nt * 128 + c0;
      *(float4*)dst = make_float4(v[0], v[1], v[2], v[3]);
      *(float4*)(dst + 4) = make_float4(v[4], v[5], v[6], v[7]);
    })
  }
}

DI void phase_s5_scan(const Params& p, int l) {
  const int tid = tid_();
  for (int it = (VBID < 128 ? VBID : 320); it < 320; it += 128) {
    const int wi = it * 2 + (tid >> 7);
    const int dir = (tid >> 6) & 1, pp = tid & 63;
    int chunk0, n, b, g;
    bool prompt;
    if (wi < 128) { b = wi >> 5; g = wi & 31; chunk0 = (NPROMPT + b * 2048) >> 5; n = 64; prompt = false; }
    else { int q = wi - 128; b = q >> 5; g = q & 31; chunk0 = (b * 256) >> 5; n = 8; prompt = true; }
    const size_t pi = ((size_t)(l * 2 + dir) * 32 + g) * 64 + pp;
    const float lr = p.lam_re[pi], li = p.lam_im[pi];
    const float dt = expf(p.log_dt[(l * 2 + dir) * 32 + g]);
    const float mag = expf(lr * dt * 32.f);
    float sn, cs;
    sincosf(li * dt * 32.f, &sn, &cs);
    const float are = mag * cs, aim = mag * sn;
    float hre = 0.f, him = 0.f;
    if (!prompt) {
      size_t si = ((size_t)((b * 2 + l) * 2 + dir)) * 2048 + g * 64 + pp;
      hre = p.st_re[si]; him = p.st_im[si];
    }
    const float* eb = p.ebuf + ((size_t)g * NCHUNK + chunk0) * 256 + dir * 128 + pp;
    bfu* cb = p.carry + ((size_t)g * NCHUNK + chunk0) * 256 + dir * 128 + pp;
    for (int k0 = 0; k0 < n; k0 += 8) {
      float er[8], ei[8];
#pragma unroll
      for (int j = 0; j < 8; ++j) {
        const int k = dir == 0 ? k0 + j : n - 1 - (k0 + j);
        er[j] = eb[(size_t)k * 256];
        ei[j] = eb[(size_t)k * 256 + 64];
      }
#pragma unroll
      for (int j = 0; j < 8; ++j) {
        const int k = dir == 0 ? k0 + j : n - 1 - (k0 + j);
        cb[(size_t)k * 256] = f2bf(hre);
        cb[(size_t)k * 256 + 64] = f2bf(him);
        const float nre = are * hre - aim * him + er[j];
        const float nim = are * him + aim * hre + ei[j];
        hre = nre; him = nim;
      }
    }
    if (prompt) {
      size_t oi = ((size_t)((b * 2 + l) * 2 + dir)) * 2048 + g * 64 + pp;
      p.out[OUT_RE + oi] = hre;
      p.out[OUT_IM + oi] = him;
    }
  }
}

DI void phase_s5_y(const Params& p, int l, char* smem) {
  for (int q = VJ; q < 48; q += VNLOC) {
    const int g = VXCD * 4 + q / 12, r12 = q % 12, mt = r12 >> 2, nt = r12 & 3;
    f32x16 acc[2][2];
    acc_zero(acc);
    const bfu* Bm = p.opMG + ((size_t)g * 512 + nt * 128) * 768;
    gemm_core(p.ug + ((size_t)g * NCHUNK + mt * 128) * 512, 512, Bm, 768, 512, smem, acc,
              p.carry + ((size_t)g * NCHUNK + mt * 128) * 256, 256, 256);
    EPI_LDS({
      const int chunk = mt * 128 + row, nn = nt * 128 + c0, tp = nn >> 4, c = nn & 15;
      const int tok = chunk * 32 + tp;
      float u[8], o[8];
      unpack8(*(const uint4*)(p.ug + ((size_t)g * NTOK + tok) * 16 + c), u);
      const float* dsk = p.s5_d + l * 512 + g * 16 + c;
      _Pragma("unroll") for (int e = 0; e < 8; ++e) o[e] = geluf_(v[e] + dsk[e] * u[e]);
      *(uint4*)(p.ys5 + (size_t)tok * 512 + g * 16 + c) = pack8(o);
    })
  }
}

DI void phase_glu(const Params& p, int l, char* smem) {
  const bfu* W = p.w_gluT + (size_t)l * 512 * 512;
  for (int iter = 0;; ++iter) {
    int mt, nt;
    if (!xcd_tile<96, 4, 12>(iter, mt, nt)) break;
    f32x16 acc[2][2];
    acc_zero(acc);
    gemm_core(p.ys5 + (size_t)mt * 128 * 512, 512, W + (size_t)nt * 128 * 512, 512, 512, smem, acc, p.ys5, 512, 0);
    const int m0 = mt * 128, n0 = nt * 128;
    EPI_LDS({
      const int n = n0 + c0;
      const size_t tk = (size_t)(m0 + row);
      float y[8], ga[8], o[8];
      unpack8(*(const uint4*)(p.ys5 + tk * 512 + n), y);
      unpack8(*(const uint4*)(p.proj + tk * PW + OFF_GA + n), ga);
      const float* bg = p.b_glu + l * 512 + n;
      _Pragma("unroll") for (int e = 0; e < 8; ++e) o[e] = y[e] * sigmoidf_(v[e] + bg[e]) * siluf_(ga[e]);
      *(uint4*)(p.ya + tk * 512 + n) = pack8(o);
    })
  }
}

constexpr int GL_QS = 0;
constexpr int GL_KS = GL_QS + 32 * 144;
constexpr int GL_KHT = GL_KS + 32 * 144;
constexpr int GL_VT = GL_KHT + 64 * 80;
constexpr int GL_PS = GL_VT + 128 * 80;
constexpr int GL_ST = GL_PS + 32 * 80;
constexpr int GL_AV = GL_ST + 128 * 144;
constexpr int GL_TOT = GL_AV + 256;
constexpr int GL_OS = GL_TOT + 1024;
static_assert(GL_OS + 32 * 132 * 4 <= 65536, "gla lds");

DI void gla_segment_info(int seg, int& tok_base, bool& prompt, int& b, int& sidx) {
  if (seg < 16) { prompt = true; b = seg; sidx = 0; tok_base = seg * 256; }
  else { int q = seg - 16; prompt = false; b = q >> 3; sidx = q & 7; tok_base = NPROMPT + b * 2048 + sidx * 256; }
}

template <bool STATE_ONLY>
DI void gla_chain(const Params& p, int l, char* smem, int seg, int hd, int dir) {
  const int tid = tid_(), lane = tid & 63, w = tid >> 6;
  const int fr = lane & 31, hh = lane >> 5;
  int tok_base, b, sidx;
  bool prompt;
  gla_segment_info(seg, tok_base, prompt, b, sidx);
  const int dk = tid & 63, tq = tid >> 6;
  const int dvl = tid & 127, th = tid >> 7;
  const int jw = w & 1, thw = w >> 1, dkm = 32 * jw + fr;
  bf16x8 wgB;
  {
    unsigned wp[4];
#pragma unroll
    for (int e = 0; e < 4; ++e) {
      const float w0 = p.wg_up[((size_t)(l * 2 + dir) * 16 + 8 * hh + 2 * e) * 256 + hd * 64 + dkm];
      const float w1 = p.wg_up[((size_t)(l * 2 + dir) * 16 + 8 * hh + 2 * e + 1) * 256 + hd * 64 + dkm];
      wp[e] = pack2(w0, w1);
    }
    wgB = __builtin_bit_cast(bf16x8, make_uint4(wp[0], wp[1], wp[2], wp[3]));
  }
  const float bgv = p.bg[(l * 2 + dir) * 256 + hd * 64 + dkm];
  float* sAv = (float*)(smem + GL_AV);
  float* sTot = (float*)(smem + GL_TOT);
  float* sOs = (float*)(smem + GL_OS);

  f32x16 S[2];
  {
    const int dvc = 32 * w + fr;
    if (STATE_ONLY || prompt) {
#pragma unroll
      for (int mt = 0; mt < 2; ++mt)
#pragma unroll
        for (int r = 0; r < 16; ++r) S[mt][r] = 0.f;
    } else {
      const float* sp = p.st_gla + ((size_t)(((b * 2 + l) * 2 + dir) * 4 + hd)) * 8192;
#pragma unroll
      for (int mt = 0; mt < 2; ++mt)
#pragma unroll
        for (int r = 0; r < 16; ++r) S[mt][r] = sp[(32 * mt + (r & 3) + 8 * (r >> 2) + 4 * hh) * 128 + dvc];
      const int nprev = dir == 0 ? sidx : 7 - sidx;
      if (nprev > 0) {
        f32x16 cs[2], ns[2];
        float4 ca[8], na[8];
#define GLA_SEG_LOAD(SS, AA, qq)                                                                       \
        {                                                                                              \
          const int sprev_ = dir == 0 ? (qq) : 7 - (qq);                                               \
          const size_t ci_ = (size_t)(((b * 8 + sprev_) * 4 + hd) * 2 + dir);                          \
          const float* sl_ = p.gla_sloc + ci_ * 8192 + dvc;                                            \
          const float* al_ = p.gla_aseg + ci_ * 64 + 4 * hh;                                           \
          _Pragma("unroll") for (int mt = 0; mt < 2; ++mt)                                             \
          _Pragma("unroll") for (int r = 0; r < 16; ++r)                                               \
            SS[mt][r] = sl_[(32 * mt + (r & 3) + 8 * (r >> 2) + 4 * hh) * 128];                        \
          _Pragma("unroll") for (int i = 0; i < 8; ++i) AA[i] = *(const float4*)(al_ + 8 * i);         \
        }
        GLA_SEG_LOAD(cs, ca, 0)
#pragma unroll 1
        for (int q = 0; q < nprev; ++q) {
          if (q + 1 < nprev) GLA_SEG_LOAD(ns, na, q + 1)
#pragma unroll
          for (int mt = 0; mt < 2; ++mt)
#pragma unroll
            for (int qq = 0; qq < 4; ++qq) {
              const float4 av = ca[mt * 4 + qq];
              S[mt][4 * qq + 0] = av.x * S[mt][4 * qq + 0] + cs[mt][4 * qq + 0];
              S[mt][4 * qq + 1] = av.y * S[mt][4 * qq + 1] + cs[mt][4 * qq + 1];
              S[mt][4 * qq + 2] = av.z * S[mt][4 * qq + 2] + cs[mt][4 * qq + 2];
              S[mt][4 * qq + 3] = av.w * S[mt][4 * qq + 3] + cs[mt][4 * qq + 3];
            }
          cs[0] = ns[0]; cs[1] = ns[1];
#pragma unroll
          for (int i = 0; i < 8; ++i) ca[i] = na[i];
        }
      }
    }
  }
  float bsum = 0.f;
  __syncthreads();
  if (!STATE_ONLY) {
    const int dvc = 32 * w + fr;
#pragma unroll
    for (int mt = 0; mt < 2; ++mt)
#pragma unroll
      for (int q = 0; q < 4; ++q) {
        uint2 pk;
        pk.x = pack2(S[mt][4 * q], S[mt][4 * q + 1]);
        pk.y = pack2(S[mt][4 * q + 2], S[mt][4 * q + 3]);
        *(uint2*)(smem + GL_ST + dvc * 144 + (32 * mt + 8 * q + 4 * hh) * 2) = pk;
      }
  }

  uint4 rq = make_uint4(0, 0, 0, 0), rk = rq, rv0 = rq, rv1 = rq, rgl = rq;
#define GLA_ISSUE(nn)                                                                                         \
  {                                                                                                           \
    const int cn_ = dir == 0 ? (nn) : 7 - (nn);                                                               \
    const int c0_ = tok_base + cn_ * 32;                                                                      \
    const int tA = dir == 0 ? (tid >> 3) : 31 - (tid >> 3);                                                   \
    const bfu* prA = p.proj + (size_t)(c0_ + tA) * PW + hd * 64 + (tid & 7) * 8;                              \
    if (!STATE_ONLY) rq = *(const uint4*)(prA + OFF_Q);                                                       \
    rk = *(const uint4*)(prA + OFF_K);                                                                        \
    const int tV0 = dir == 0 ? (tid >> 4) : 31 - (tid >> 4);                                                  \
    const int tV1 = dir == 0 ? (tid >> 4) + 16 : 15 - (tid >> 4);                                             \
    rv0 = *(const uint4*)(p.proj + (size_t)(c0_ + tV0) * PW + OFF_V + hd * 128 + (tid & 15) * 8);             \
    rv1 = *(const uint4*)(p.proj + (size_t)(c0_ + tV1) * PW + OFF_V + hd * 128 + (tid & 15) * 8);             \
    if (tid < 64) {                                                                                           \
      const int tG = dir == 0 ? (tid >> 1) : 31 - (tid >> 1);                                                 \
      rgl = *(const uint4*)(p.proj + (size_t)(c0_ + tG) * PW + OFF_GL + (tid & 1) * 8);                       \
    }                                                                                                         \
  }
  GLA_ISSUE(0)
  char* rawQ = smem + GL_OS;
  char* rawK = smem + GL_OS + 4096;
  char* rawV = smem + GL_OS + 8192;
  char* rawG = smem + GL_PS;

#pragma unroll 1
  for (int n = 0; n < 8; ++n) {
    const int cn = dir == 0 ? n : 7 - n;
    const int ctok0 = tok_base + cn * 32;
    __syncthreads();
    if (!STATE_ONLY) *(uint4*)(rawQ + (tid >> 3) * 128 + (tid & 7) * 16) = rq;
    *(uint4*)(rawK + (tid >> 3) * 128 + (tid & 7) * 16) = rk;
    *(uint4*)(rawV + (tid >> 4) * 256 + (tid & 15) * 16) = rv0;
    *(uint4*)(rawV + ((tid >> 4) + 16) * 256 + (tid & 15) * 16) = rv1;
    if (tid < 64) *(uint4*)(rawG + (tid >> 1) * 32 + (tid & 1) * 16) = rgl;
    if (n + 1 < 8) GLA_ISSUE(n + 1)
    __syncthreads();
    {
      f32x16 lg;
#pragma unroll
      for (int r = 0; r < 16; ++r) lg[r] = 0.f;
      const bf16x8 ga = *(const bf16x8*)(rawG + fr * 32 + hh * 16);
      lg = __builtin_amdgcn_mfma_f32_32x32x16_bf16(ga, wgB, lg, 0, 0, 0);
      float ls[16], gsum[4], psum[4];
#pragma unroll
      for (int r = 0; r < 16; ++r) {
        const float x = lg[r] + bgv;
        ls[r] = logsigmoidf_(x) * (1.f / 16.f);
      }
#pragma unroll
      for (int q = 0; q < 4; ++q) {
        gsum[q] = ls[4 * q] + ls[4 * q + 1] + ls[4 * q + 2] + ls[4 * q + 3];
        psum[q] = __shfl_xor(gsum[q], 32);
      }
      float off[4], run = 0.f;
#pragma unroll
      for (int q = 0; q < 4; ++q) {
        off[q] = run + (hh ? psum[q] : 0.f);
        run += gsum[q] + psum[q];
      }
      const float total = run;
#pragma unroll
      for (int qq = 0; qq < 2; ++qq) {
        float khv[4];
        float acc_b = 0.f;
#pragma unroll
        for (int i = 0; i < 4; ++i) {
          const float lsv = thw == 0 ? ls[4 * qq + i] : ls[8 + 4 * qq + i];
          const float offv = thw == 0 ? off[qq] : off[2 + qq];
          acc_b += lsv;
          const float bb = offv + acc_b;
          const int tau = 16 * thw + 8 * qq + 4 * hh + i;
          const float kvv = bf2f(*(const bfu*)(rawK + tau * 128 + dkm * 2));
          if (!STATE_ONLY) {
            const float qvv = bf2f(*(const bfu*)(rawQ + tau * 128 + dkm * 2)) * 0.125f;
            *(bfu*)(smem + GL_QS + tau * 144 + dkm * 2) = f2bf(qvv * __expf(bb));
            *(bfu*)(smem + GL_KS + tau * 144 + dkm * 2) = f2bf(kvv * __expf(-bb));
          }
          khv[i] = kvv * __expf(total - bb);
        }
        uint2 kh; kh.x = pack2(khv[0], khv[1]); kh.y = pack2(khv[2], khv[3]);
        *(uint2*)(smem + GL_KHT + dkm * 80 + (16 * thw + 8 * qq + 4 * hh) * 2) = kh;
      }
      if (thw == 0 && hh == 0) { sAv[dkm] = __expf(total); bsum += total; }
    }
    {
      unsigned pk[8];
#pragma unroll
      for (int i = 0; i < 8; ++i) {
        const int tau0 = th * 16 + 2 * i;
        const unsigned lo = *(const bfu*)(rawV + tau0 * 256 + dvl * 2);
        const unsigned hi = *(const bfu*)(rawV + (tau0 + 1) * 256 + dvl * 2);
        pk[i] = lo | (hi << 16);
      }
      *(uint4*)(smem + GL_VT + dvl * 80 + th * 32) = make_uint4(pk[0], pk[1], pk[2], pk[3]);
      *(uint4*)(smem + GL_VT + dvl * 80 + th * 32 + 16) = make_uint4(pk[4], pk[5], pk[6], pk[7]);
    }
    __syncthreads();
    f32x16 o;
    if (!STATE_ONLY) {
      f32x16 sc;
#pragma unroll
      for (int r = 0; r < 16; ++r) sc[r] = 0.f;
#pragma unroll
      for (int s4 = 0; s4 < 4; ++s4) {
        bf16x8 a = *(const bf16x8*)(smem + GL_QS + fr * 144 + (16 * s4 + 8 * hh) * 2);
        bf16x8 bq = *(const bf16x8*)(smem + GL_KS + fr * 144 + (16 * s4 + 8 * hh) * 2);
        sc = __builtin_amdgcn_mfma_f32_32x32x16_bf16(a, bq, sc, 0, 0, 0);
      }
#pragma unroll
      for (int rr = 0; rr < 4; ++rr) {
        float val = w == 0 ? sc[rr] : (w == 1 ? sc[4 + rr] : (w == 2 ? sc[8 + rr] : sc[12 + rr]));
        const int i = rr + 8 * w + 4 * hh;
        val = (fr <= i) ? val : 0.f;
        *(bfu*)(smem + GL_PS + i * 80 + fr * 2) = f2bf(val);
      }
      __syncthreads();
#pragma unroll
      for (int r = 0; r < 16; ++r) o[r] = 0.f;
    }
    {
      const int dvc = 32 * w + fr;
      bf16x8 vb0 = *(const bf16x8*)(smem + GL_VT + dvc * 80 + (8 * hh) * 2);
      bf16x8 vb1 = *(const bf16x8*)(smem + GL_VT + dvc * 80 + (16 + 8 * hh) * 2);
      if (!STATE_ONLY) {
        bf16x8 pa0 = *(const bf16x8*)(smem + GL_PS + fr * 80 + (8 * hh) * 2);
        bf16x8 pa1 = *(const bf16x8*)(smem + GL_PS + fr * 80 + (16 + 8 * hh) * 2);
        o = __builtin_amdgcn_mfma_f32_32x32x16_bf16(pa0, vb0, o, 0, 0, 0);
        o = __builtin_amdgcn_mfma_f32_32x32x16_bf16(pa1, vb1, o, 0, 0, 0);
#pragma unroll
        for (int s4 = 0; s4 < 4; ++s4) {
          bf16x8 a = *(const bf16x8*)(smem + GL_QS + fr * 144 + (16 * s4 + 8 * hh) * 2);
          bf16x8 sb = *(const bf16x8*)(smem + GL_ST + dvc * 144 + (16 * s4 + 8 * hh) * 2);
          o = __builtin_amdgcn_mfma_f32_32x32x16_bf16(a, sb, o, 0, 0, 0);
        }
      }
#pragma unroll
      for (int mt = 0; mt < 2; ++mt) {
        f32x16 U;
#pragma unroll
        for (int r = 0; r < 16; ++r) U[r] = 0.f;
        bf16x8 ka0 = *(const bf16x8*)(smem + GL_KHT + (32 * mt + fr) * 80 + (8 * hh) * 2);
        bf16x8 ka1 = *(const bf16x8*)(smem + GL_KHT + (32 * mt + fr) * 80 + (16 + 8 * hh) * 2);
        U = __builtin_amdgcn_mfma_f32_32x32x16_bf16(ka0, vb0, U, 0, 0, 0);
        U = __builtin_amdgcn_mfma_f32_32x32x16_bf16(ka1, vb1, U, 0, 0, 0);
#pragma unroll
        for (int q = 0; q < 4; ++q) {
          const float4 av = *(const float4*)(sAv + 32 * mt + 8 * q + 4 * hh);
          S[mt][4 * q + 0] = av.x * S[mt][4 * q + 0] + U[4 * q + 0];
          S[mt][4 * q + 1] = av.y * S[mt][4 * q + 1] + U[4 * q + 1];
          S[mt][4 * q + 2] = av.z * S[mt][4 * q + 2] + U[4 * q + 2];
          S[mt][4 * q + 3] = av.w * S[mt][4 * q + 3] + U[4 * q + 3];
          if (!STATE_ONLY) {
            uint2 pk;
            pk.x = pack2(S[mt][4 * q], S[mt][4 * q + 1]);
            pk.y = pack2(S[mt][4 * q + 2], S[mt][4 * q + 3]);
            *(uint2*)(smem + GL_ST + dvc * 144 + (32 * mt + 8 * q + 4 * hh) * 2) = pk;
          }
        }
      }
      if (!STATE_ONLY) {
#pragma unroll
        for (int r = 0; r < 16; ++r) sOs[((r & 3) + 8 * (r >> 2) + 4 * hh) * 132 + dvc] = o[r];
      }
    }
    __syncthreads();
    if (!STATE_ONLY) {
      const int t = tid >> 3, part = tid & 7;
      const int tau = dir == 0 ? t : 31 - t;
      const size_t tok = (size_t)(ctok0 + t);
      float ov[16];
#pragma unroll
      for (int q = 0; q < 4; ++q) {
        const float4 x = *(const float4*)(sOs + tau * 132 + part * 16 + 4 * q);
        ov[4 * q] = x.x; ov[4 * q + 1] = x.y; ov[4 * q + 2] = x.z; ov[4 * q + 3] = x.w;
      }
      bfu* op = p.gla_o + ((size_t)dir * NTOK + tok) * 512 + hd * 128 + part * 16;
      *(uint4*)op = pack8(*(float(*)[8])&ov[0]);
      *(uint4*)(op + 8) = pack8(*(float(*)[8])&ov[8]);
    }
  }
  const int dvc = 32 * w + fr;
  if (STATE_ONLY) {
    const size_t ci = (size_t)(((b * 8 + sidx) * 4 + hd) * 2 + dir);
    float* sl = p.gla_sloc + ci * 8192;
#pragma unroll
    for (int mt = 0; mt < 2; ++mt)
#pragma unroll
      for (int r = 0; r < 16; ++r) sl[(32 * mt + (r & 3) + 8 * (r >> 2) + 4 * hh) * 128 + dvc] = S[mt][r];
    if (thw == 0 && hh == 0) p.gla_aseg[ci * 64 + dkm] = __expf(bsum);
  } else if (prompt) {
    float* op = p.out + OUT_GLA + ((size_t)(((b * 2 + l) * 2 + dir) * 4 + hd)) * 8192;
#pragma unroll
    for (int mt = 0; mt < 2; ++mt)
#pragma unroll
      for (int r = 0; r < 16; ++r) op[(32 * mt + (r & 3) + 8 * (r >> 2) + 4 * hh) * 128 + dvc] = S[mt][r];
  }
  __syncthreads();
}

DI void phase_gla_pass1(const Params& p, int l, char* smem) {
  for (int it = NVB - 1 - VBID; it < 256; it += NVB) {
    const int dir = it & 1, hd = (it >> 1) & 3, seg = 16 + (it >> 3);
    gla_chain<true>(p, l, smem, seg, hd, dir);
  }
}
DI void phase_gla_main(const Params& p, int l, char* smem) {
  for (int it = NVB - 1 - VBID; it < 384; it += NVB) {
    const int dir = it & 1, hd = (it >> 1) & 3, seg = it >> 3;
    gla_chain<false>(p, l, smem, seg, hd, dir);
  }
}
DI void phase_gla_norm(const Params& p, int l, int part) {
  const int tid = tid_(), lane = tid & 63, w = tid >> 6;
  const int ib = (VJ - 48) * 8 + VXCD;
  for (int it = part * (NTOK / 8) + (VJ >= 48 ? ib : NTOK); it < (part + 1) * (NTOK / 8); it += 128) {
    const int tok = it * 4 + w;
    float a[8], b[8], gt[8], res[8];
    unpack8(ld_nt16(p.gla_o + (size_t)tok * 512 + lane * 8), a);
    unpack8(ld_nt16(p.gla_o + ((size_t)NTOK + tok) * 512 + lane * 8), b);
    unpack8(ld_nt16(p.proj + (size_t)tok * PW + OFF_GB + lane * 8), gt);
    float ss = 0.f;
#pragma unroll
    for (int e = 0; e < 8; ++e) { a[e] += b[e]; ss += a[e] * a[e]; }
    ss += __shfl_xor(ss, 1); ss += __shfl_xor(ss, 2); ss += __shfl_xor(ss, 4); ss += __shfl_xor(ss, 8);
    const float rs = rsqrtf(ss * (1.f / 128.f) + EPS);
    const float* g = p.gla_norm_g + l * 512 + lane * 8;
#pragma unroll
    for (int e = 0; e < 8; ++e) res[e] = a[e] * rs * g[e] * siluf_(gt[e]);
    *(uint4*)(p.yb + (size_t)tok * 512 + lane * 8) = pack8(res);
  }
}

DI void phase_merge(const Params& p, int l, char* smem) {
  const bfu* WA = p.w_paT + (size_t)l * 1024 * 512;
  const bfu* WB = p.w_pbT + (size_t)l * 1024 * 512;
  for (int iter = 0;; ++iter) {
    int mt, nt;
    if (!tile256(iter, 4, mt, nt)) break;
    const int m0 = mt * 256, n0 = nt * 256;
    f32x4 acc[2][2][4][2];
    acc256_zero(acc);
    gemm256(p.ya, 512, WA, 512, 512, m0, n0, (bfu*)smem, acc);
    uint4 pg[8], pq[8];
#define MERGE_PRE1 pg[it_] = ld_nt16(p.proj + (size_t)(m0 + row) * PW + OFF_MA + n0 + c0);
#define MERGE_PRE2 pg[it_] = ld_nt16(p.proj + (size_t)(m0 + row) * PW + OFF_MB + n0 + c0); \
                   pq[it_] = *(const uint4*)(p.merged + (size_t)(m0 + row) * D + n0 + c0);
    EPI256P(MERGE_PRE1, {
      float ma[8], o[8];
      unpack8(pg[it_], ma);
      _Pragma("unroll") for (int e = 0; e < 8; ++e) o[e] = sigmoidf_(ma[e]) * v[e];
      *(uint4*)(p.merged + (size_t)(m0 + row) * D + n0 + c0) = pack8(o);
    })
    acc256_zero(acc);
    gemm256(p.yb, 512, WB, 512, 512, m0, n0, (bfu*)smem, acc);
    EPI256P(MERGE_PRE2, {
      float mb[8], o[8], pr[8];
      unpack8(pg[it_], mb);
      uint4* mp = (uint4*)(p.merged + (size_t)(m0 + row) * D + n0 + c0);
      unpack8(pq[it_], pr);
      _Pragma("unroll") for (int e = 0; e < 8; ++e) o[e] = pr[e] + sigmoidf_(mb[e]) * v[e];
      *mp = pack8(o);
    })
  }
}

DI void phase_out(const Params& p, int l, char* smem) {
  const bfu* W = p.w_oT + (size_t)l * 1024 * 1024;
  for (int iter = 0;; ++iter) {
    int mt, nt;
    if (!tile256(iter, 4, mt, nt)) break;
    const int m0 = mt * 256, n0 = nt * 256;
    f32x4 acc[2][2][4][2];
    acc256_zero(acc);
    gemm256(p.merged, D, W, 1024, 1024, m0, n0, (bfu*)smem, acc);
    const float* gate = p.mod + (size_t)(l * 5 + cond_of_tok(m0)) * 3072 + 2048;
    float4 px0[8], px1[8];
    const float* xsrc = l == 0 ? (m0 < NPROMPT ? p.x_prompt : p.x_sample - (size_t)NPROMPT * D) : p.out;
#define OUT_PRE px0[it_] = ld_nt4(xsrc + (size_t)(m0 + row) * D + n0 + c0); \
                px1[it_] = ld_nt4(xsrc + (size_t)(m0 + row) * D + n0 + c0 + 4);
    EPI256P(OUT_PRE, {
      float* xp = p.out + (size_t)(m0 + row) * D + n0 + c0;
      const float* gp = gate + n0 + c0;
      float4 x0 = px0[it_], x1 = px1[it_];
      if (l == 0 && m0 >= NPROMPT) {
        const int t = (m0 + row - NPROMPT) & 2047, col = n0 + c0;
        const float* pe = col < 512 ? p.pos_r + (t >> 6) * 512 + col : p.pos_c + (t & 63) * 512 + (col - 512);
        const float4 e0 = *(const float4*)pe, e1 = *(const float4*)(pe + 4);
        x0.x += e0.x; x0.y += e0.y; x0.z += e0.z; x0.w += e0.w;
        x1.x += e1.x; x1.y += e1.y; x1.z += e1.z; x1.w += e1.w;
      }
      float4 g0 = *(const float4*)gp, g1 = *(const float4*)(gp + 4);
      {
        const float4 h0 = *(const float4*)(gp + MODH), h1 = *(const float4*)(gp + MODH + 4);
        g0.x += h0.x; g0.y += h0.y; g0.z += h0.z; g0.w += h0.w;
        g1.x += h1.x; g1.y += h1.y; g1.z += h1.z; g1.w += h1.w;
      }
      x0.x += g0.x * v[0]; x0.y += g0.y * v[1]; x0.z += g0.z * v[2]; x0.w += g0.w * v[3];
      x1.x += g1.x * v[4]; x1.y += g1.y * v[5]; x1.z += g1.z * v[6]; x1.w += g1.w * v[7];
      *(float4*)xp = x0; *(float4*)(xp + 4) = x1;
    })
  }
}

DI void phase_final(const Params& p) {
  const int tid = tid_(), lane = tid & 63, w = tid >> 6;
  for (int it = VBID; it < NTOK / 4; it += NVB) {
    const int tok = it * 4 + w;
    float* xs = p.out + (size_t)tok * D;
    float4 v[4];
#pragma unroll
    for (int i = 0; i < 4; ++i) v[i] = ld_nt4(xs + lane * 4 + 256 * i);
    float ss = 0.f;
#pragma unroll
    for (int i = 0; i < 4; ++i) ss += v[i].x * v[i].x + v[i].y * v[i].y + v[i].z * v[i].z + v[i].w * v[i].w;
    ss = wave_sum(ss);
    const float rstd = rsqrtf(ss * (1.f / 1024.f) + EPS);
#pragma unroll
    for (int i = 0; i < 4; ++i) {
      float4 g = *(const float4*)(p.final_g + lane * 4 + 256 * i);
      float4 o;
      o.x = v[i].x * rstd * g.x; o.y = v[i].y * rstd * g.y; o.z = v[i].z * rstd * g.z; o.w = v[i].w * rstd * g.w;
      st_nt4(xs + lane * 4 + 256 * i, o);
    }
  }
}

#define XB_TMO      128
#define XB_XCNT(j)  (256  + 64 * (j))
#define XB_XSUB(j)  (1280 + 64 * (j))
#define XB_XGEN(j)  (2304 + 64 * (j))
#define XB_TOP      3328
#define XB_TOPGEN   3392
#define XCD_BAR_WORDS 3456
#define XB_SPIN_CAP (1u << 18)
#define LAS __attribute__((address_space(3)))
DI unsigned xb_ld(unsigned* p) { return __hip_atomic_load(p, __ATOMIC_RELAXED, __HIP_MEMORY_SCOPE_AGENT); }
DI unsigned xb_add(unsigned* p, unsigned v) { return __hip_atomic_fetch_add(p, v, __ATOMIC_RELAXED, __HIP_MEMORY_SCOPE_AGENT); }
DI unsigned xb_xcc_id() { return (unsigned)__builtin_amdgcn_s_getreg((3 << 11) | 20) & 0xFu; }
#define XB_SPIN(cond, bar) do { unsigned _sp = 0; while (cond) { __builtin_amdgcn_s_sleep(1); \
    if ((++_sp & 255u) == 0u) { if (xb_ld(&(bar)[XB_TMO])) break; if (_sp > XB_SPIN_CAP) { atomicAdd(&(bar)[XB_TMO], 1u); break; } } } } while (0)
struct XcdBarrier { unsigned* bar; unsigned x; volatile LAS unsigned* st; };
DI XcdBarrier xcd_barrier_post(unsigned* bar, volatile LAS unsigned* st) {
  XcdBarrier b; b.bar = bar; b.x = xb_xcc_id(); b.st = st;
  if (threadIdx.x == 0) (void)xb_add(&bar[XB_XCNT(b.x)], 1u);
  return b;
}
DI void xcd_barrier_complete(unsigned* bar, unsigned x, unsigned& nloc, unsigned& nx) {
  const unsigned G = gridDim.x * gridDim.y * gridDim.z;
  unsigned sum, cnt, mine, sp = 0u;
  for (;;) {
    sum = 0u; cnt = 0u; mine = 0u;
#pragma unroll
    for (unsigned j = 0; j < 16; ++j) { const unsigned c = xb_ld(&bar[XB_XCNT(j)]); sum += c; cnt += (c > 0u) ? 1u : 0u; mine = (j == x) ? c : mine; }
    if (sum == G) break;
    __builtin_amdgcn_s_sleep(1);
    if ((++sp & 255u) == 0u) { if (xb_ld(&bar[XB_TMO])) break; if (sp > XB_SPIN_CAP) { atomicAdd(&bar[XB_TMO], 1u); break; } }
  }
  nloc = mine > 0u ? mine : 1u; nx = cnt > 0u ? cnt : 1u;
}
DI void xcd_barrier(const XcdBarrier& b) {
  asm volatile("s_waitcnt vmcnt(0)" ::: "memory");
  __syncthreads();
  if (threadIdx.x == 0) {
    unsigned* bar = b.bar;
    __builtin_amdgcn_s_waitcnt(0);
    unsigned nloc = b.st[0], nx = b.st[1];
    if (nloc == 0u) { xcd_barrier_complete(bar, b.x, nloc, nx); b.st[0] = nloc; b.st[1] = nx; }
    const unsigned old = xb_add(&bar[XB_XSUB(b.x)], 1u);
    const unsigned gen = old / nloc;
    if (old + 1u == (gen + 1u) * nloc) {
      __builtin_amdgcn_fence(__ATOMIC_RELEASE, "agent");
      asm volatile("s_waitcnt vmcnt(0)" ::: "memory");
      const unsigned og = xb_add(&bar[XB_TOP], 1u);
      const unsigned tg = og / nx;
      if (og + 1u == (tg + 1u) * nx) xb_add(&bar[XB_TOPGEN], 1u);
      else XB_SPIN(xb_ld(&bar[XB_TOPGEN]) == tg, bar);
      __builtin_amdgcn_fence(__ATOMIC_ACQUIRE, "agent");
      xb_add(&bar[XB_XGEN(b.x)], 1u);
      asm volatile("s_waitcnt vmcnt(0)" ::: "memory");
    } else {
      XB_SPIN(xb_ld(&bar[XB_XGEN(b.x)]) == gen, bar);
      __builtin_amdgcn_fence(__ATOMIC_ACQUIRE, "agent");
      asm volatile("s_waitcnt vmcnt(0)" ::: "memory");
    }
  }
  __syncthreads();
}

#ifndef REP_SYNC
#define REP_SYNC 0
#endif
__global__ void __launch_bounds__(512, 2) k_mega(Params p) {
  extern __shared__ __attribute__((aligned(16))) char smem_all[];
  cg::grid_group grid = cg::this_grid();
  char* smem = smem_all;
#define smh (smem_all + VHALF * 65536)
  volatile LAS unsigned* xst = (volatile LAS unsigned*)(smem_all + 131072);
  if (threadIdx.x < 4) xst[threadIdx.x] = 0u;
  __syncthreads();
  XcdBarrier xb = xcd_barrier_post(p.bar, xst);
#define GSYNC() xcd_barrier(xb)
  phase_prep(p, smh);
  phase_s5_gen(p, 0, smh);
  GSYNC();
  if (p.bar == nullptr) grid.sync();
  for (int l = 0; l < 2; ++l) {
    phase_h(p, l);
    GSYNC();
    phase_gemm_in(p, l, smem);
    GSYNC();
    phase_s5_e(p, smh);
    phase_gla_pass1(p, l, smh);
    GSYNC();
    phase_s5_scan(p, l);
    phase_gla_main(p, l, smh);
    GSYNC();
    phase_s5_y(p, l, smh);
    phase_gla_norm(p, l, 0);
    GSYNC();
    phase_glu(p, l, smh);
    phase_gla_norm(p, l, 1);
    GSYNC();
    phase_merge(p, l, smem);
    if (l == 0 && (blockIdx.x >> 3) >= 24) {
      const int hb = (int)((((blockIdx.x >> 3) - 24) * 8 + (blockIdx.x & 7)) * 2) + VHALF;
      s5_gen_item(p, 1, hb, smh);
    }
    GSYNC();
    phase_out(p, l, smem);
    if (l == 0 && (blockIdx.x >> 3) >= 24) {
      const int hb = (int)((((blockIdx.x >> 3) - 24) * 8 + (blockIdx.x & 7)) * 2) + VHALF;
      s5_gen_item(p, 1, hb + 128, smh);
    }
    GSYNC();
    for (int rep = 0; rep < REP_SYNC; ++rep) GSYNC();
  }
  phase_final(p);
}

extern "C" void kernel_launch(void* const* d_in, const int* in_sizes, int n_in, void* d_out, int out_size,
                              void* d_ws, size_t ws_size, hipStream_t stream) {
  Params p{};
  const float* const* in = (const float* const*)d_in;
  p.x_prompt = in[0]; p.x_sample = in[1]; p.c = in[2]; p.st_re = in[3]; p.st_im = in[4]; p.st_gla = in[5];
  p.c_ctx = in[6]; p.norm_g = in[7]; p.w_mod = in[8]; p.b_mod = in[9]; p.w_in = in[10]; p.wg_up = in[11];
  p.bg = in[12]; p.gla_norm_g = in[13]; p.lam_re = in[14]; p.lam_im = in[15]; p.log_dt = in[16];
  p.b_re = in[17]; p.b_im = in[18]; p.c_re = in[19]; p.c_im = in[20]; p.s5_d = in[21]; p.w_glu = in[22];
  p.b_glu = in[23]; p.w_pa = in[24]; p.w_pb = in[25]; p.w_o = in[26]; p.final_g = in[27];
  p.out = (float*)d_out;
  char* ws = (char*)d_ws;
  size_t off = 0;
  auto take = [&](size_t bytes) { char* r = ws + off; off += (bytes + 255) & ~(size_t)255; return r; };
  p.w_inT = (bfu*)take((size_t)2 * DINP * LDH * 2);
  p.w_gluT = (bfu*)take((size_t)2 * 512 * 512 * 2);
  p.w_paT = (bfu*)take((size_t)2 * 1024 * 512 * 2);
  p.w_pbT = (bfu*)take((size_t)2 * 1024 * 512 * 2);
  p.w_oT = (bfu*)take((size_t)2 * 1024 * 1024 * 2);
  p.pos_r = (float*)take((size_t)32 * 512 * 4);
  p.pos_c = (float*)take((size_t)64 * 512 * 4);
  p.h = (bfu*)take((size_t)NTOK * LDH * 2);
  p.proj = (bfu*)take((size_t)NTOK * PW * 2);
  p.ys5 = (bfu*)take((size_t)NTOK * 512 * 2);
  p.ya = (bfu*)take((size_t)NTOK * 512 * 2);
  p.yb = (bfu*)take((size_t)NTOK * 512 * 2);
  p.merged = (bfu*)take((size_t)NTOK * D * 2);
  p.tmp_s5 = nullptr;
  p.ebuf = (float*)p.merged;
  p.carry = (bfu*)((char*)p.merged + (size_t)32 * NCHUNK * 256 * 4);
  p.ug = (bfu*)take((size_t)32 * NTOK * 16 * 2);
  p.opMG = (bfu*)take((size_t)32 * 512 * 768 * 2);
  p.opE = (bfu*)take((size_t)32 * 256 * 512 * 2);
  p.gla_sloc = (float*)p.ys5;
  p.gla_aseg = (float*)((char*)p.ys5 + (size_t)256 * 8192 * 4);
  if (off > ws_size) fprintf(stderr, "workspace too small: %zu > %zu\n", off, ws_size);
  p.bar = (unsigned*)take((size_t)XCD_BAR_WORDS * 4);
  p.mod = (float*)take((size_t)2 * 2 * 5 * 3072 * 4);
  p.gla_o = (bfu*)p.h;
  p.tmp_gla = (float*)p.h;
  constexpr size_t kLds = 131072 + 16;
  static int grid_blocks = 0;
  if (!grid_blocks) {
    int dev = 0, cus = 0, per_cu = 0;
    hipGetDevice(&dev);
    hipDeviceGetAttribute(&cus, hipDeviceAttributeMultiprocessorCount, dev);
    hipFuncSetAttribute((const void*)k_mega, hipFuncAttributeMaxDynamicSharedMemorySize, (int)kLds);
    hipOccupancyMaxActiveBlocksPerMultiprocessor(&per_cu, k_mega, 512, kLds);
    if (per_cu > 1) per_cu = 1;
    grid_blocks = cus * per_cu;
    if (grid_blocks % 8 != 0 || grid_blocks <= 0) fprintf(stderr, "unexpected grid %d\n", grid_blocks);
  }
  hipMemsetAsync(p.bar, 0, (size_t)XCD_BAR_WORDS * 4, stream);
  void* args[] = {&p};
  hipError_t e = hipLaunchCooperativeKernel((void*)k_mega, dim3(grid_blocks), dim3(512), args, kLds, stream);
  if (e != hipSuccess) fprintf(stderr, "cooperative launch failed: %s (grid %d)\n", hipGetErrorString(e), grid_blocks);
}
```
